# Optimizing an MI355X kernel written in HIP

```python
import math
import jax
import jax.numpy as jnp
from jax import lax
import numpy as np

D_MODEL = 2048
BATCH = 4
SEQ = 4096
DEPTH = 2

GRID_W = 64
CTX_LEN = 256
BRANCH_W = D_MODEL // 2
N_BRANCH = 3
MLA_NOPE = 128
MLA_ROPE = 64
MLA_V = 128
MLA_HEADS = BRANCH_W // MLA_V
MLA_Q_LORA = 512
MLA_KV_LORA = 512
ROPE_THETA = 10000.0
Q_BLOCK = 128
RWKV_HEAD = 64
RWKV_HEADS = BRANCH_W // RWKV_HEAD
RWKV_W = BRANCH_W
RWKV_DECAY_LORA = 64
RWKV_A_LORA = 64
RWKV_GATE_LORA = 160
RWKV_CONV = 3
RWKV_GN_EPS = 64e-5
L2_EPS = 1e-12
S5_WIDTH = BRANCH_W
S5_GROUP = 16
S5_GROUPS = S5_WIDTH // S5_GROUP
S5_STATE = 64
S5_DT_MIN = 1e-3
S5_DT_MAX = 1e-1
D_FF = 4 * D_MODEL
NORM_EPS = 1e-6
IN_SPLITS = (MLA_Q_LORA, MLA_KV_LORA, MLA_ROPE,
             RWKV_W, RWKV_W, RWKV_W,
             RWKV_DECAY_LORA, RWKV_DECAY_LORA, RWKV_A_LORA, RWKV_A_LORA, RWKV_GATE_LORA,
             S5_WIDTH, N_BRANCH * D_MODEL)
N_IN = sum(IN_SPLITS)

kernel_name = 'hybrid_mla_rwkv7_s5_prefix_dit'


def rms_norm(x, g, eps=NORM_EPS):
    xf = x.astype(jnp.float32)
    y = xf * lax.rsqrt(jnp.mean(xf * xf, axis=-1, keepdims=True) + eps)
    return (y * g.astype(jnp.float32)).astype(x.dtype)


def modulate(h, shift, scale):
    return h * (1.0 + scale) + shift


def split_cols(z):
    out, start = [], 0
    for n in IN_SPLITS:
        out.append(z[..., start:start + n])
        start += n
    return out


def axial_rope_tables(rows, dtype):
    row = jnp.repeat(jnp.arange(rows, dtype=jnp.float32), GRID_W)
    col = jnp.tile(jnp.arange(GRID_W, dtype=jnp.float32), rows)
    n_freq = MLA_ROPE // 4
    inv = ROPE_THETA ** (-jnp.arange(n_freq, dtype=jnp.float32) / n_freq)
    ang = jnp.concatenate([row[:, None] * inv, col[:, None] * inv], axis=-1)
    return jnp.cos(ang).astype(dtype), jnp.sin(ang).astype(dtype)


def apply_rope(x, cos, sin):
    cos = cos[None, :, None, :]
    sin = sin[None, :, None, :]
    x1, x2 = jnp.split(x, 2, axis=-1)
    return jnp.concatenate([x1 * cos - x2 * sin, x1 * sin + x2 * cos], axis=-1)


def mla_queries(cq, q_lora_g, w_uq, qn_nope_g, qn_rope_g, rope):
    b, t, _ = cq.shape
    q = (rms_norm(cq, q_lora_g) @ w_uq).reshape(b, t, MLA_HEADS, MLA_NOPE + MLA_ROPE)
    q_nope = rms_norm(q[..., :MLA_NOPE], qn_nope_g)
    q_rope = rms_norm(q[..., MLA_NOPE:], qn_rope_g)
    if rope is not None:
        q_rope = apply_rope(q_rope, rope[0], rope[1])
    return jnp.concatenate([q_nope, q_rope], axis=-1)


def mla_keys_values(ckv, kr, kv_lora_g, w_ukv, kn_nope_g, kn_rope_g, rope):
    b, t, _ = ckv.shape
    kv = (rms_norm(ckv, kv_lora_g) @ w_ukv).reshape(b, t, MLA_HEADS, MLA_NOPE + MLA_V)
    k_nope = rms_norm(kv[..., :MLA_NOPE], kn_nope_g)
    k_rope = rms_norm(kr, kn_rope_g)[:, :, None, :]
    if rope is not None:
        k_rope = apply_rope(k_rope, rope[0], rope[1])
    k = jnp.concatenate([k_nope, jnp.broadcast_to(k_rope, (b, t, MLA_HEADS, MLA_ROPE))], axis=-1)
    return k, kv[..., MLA_NOPE:]


def softmax_attend(q, k, v):
    s = jnp.einsum('bqhd,bkhd->bhqk', q, k).astype(jnp.float32) * (1.0 / math.sqrt(q.shape[-1]))
    p = jax.nn.softmax(s, axis=-1).astype(v.dtype)
    return jnp.einsum('bhqk,bkhd->bqhd', p, v)


def blocked_attend(q, k, v):
    b, t, h, d = q.shape
    nb = t // Q_BLOCK
    qb = q.reshape(b, nb, Q_BLOCK, h, d).transpose(1, 0, 2, 3, 4)
    o = lax.map(lambda qi: softmax_attend(qi, k, v), qb)
    return o.transpose(1, 0, 2, 3, 4).reshape(b, t, h * v.shape[-1])


def centred_dwconv(x, w):
    return lax.conv_general_dilated(x, w[:, None, :].astype(x.dtype), window_strides=(1,), padding='SAME',
                                    dimension_numbers=('NWC', 'WIO', 'NWC'), feature_group_count=x.shape[-1])


def rwkv7_scan(r, decay, k, v, kk, a, s0, reverse, readout):
    f32 = jnp.float32
    xs = [jnp.swapaxes(z, 0, 1).astype(f32) for z in (r, decay, k, v, kk, a)]

    def step(S, inp):
        r_t, w_t, k_t, v_t, kk_t, a_t = inp
        sa = jnp.einsum('bhij,bhj->bhi', S, -kk_t)
        S = (S * w_t[:, :, None, :] + sa[..., None] * (kk_t * a_t)[:, :, None, :]
             + v_t[..., None] * k_t[:, :, None, :])
        y = jnp.einsum('bhij,bhj->bhi', S, r_t) if readout else None
        return S, y

    s, ys = lax.scan(step, s0, xs, reverse=reverse)
    return (jnp.swapaxes(ys, 0, 1) if readout else None), s


def rwkv_branch(r, k, v, wd, ad, gd, conv_w, w0, w2, a0, a2, g2, k_k, k_a, r_k, ln_g, ln_b, s0, readout):
    b, t, _ = r.shape
    heads = lambda z: z.reshape(b, t, RWKV_HEADS, RWKV_HEAD)
    r, k, v = jnp.split(centred_dwconv(jnp.concatenate([r, k, v], axis=-1), conv_w), 3, axis=-1)
    kk = heads(k * k_k).astype(jnp.float32)
    kk = kk * lax.rsqrt(jnp.sum(kk * kk, axis=-1, keepdims=True) + L2_EPS)
    ys, states, k_reps = [], [], []
    for d in range(2):
        w_log = -jax.nn.softplus(-(w0[d] + jnp.tanh(wd[d]) @ w2[d])) - 0.5
        decay = jnp.exp(-jnp.exp(w_log))
        a = jax.nn.sigmoid(a0[d] + ad[d] @ a2[d])
        k_rep = heads(k * (1.0 + (a - 1.0) * k_a))
        y, s = rwkv7_scan(heads(r), heads(decay), k_rep, heads(v), kk, heads(a), s0[d], d == 1, readout)
        ys.append(y)
        states.append(s)
        k_reps.append(k_rep)
    if not readout:
        return None, states
    y = ys[0] + ys[1]
    mu = jnp.mean(y, axis=-1, keepdims=True)
    var = jnp.mean(jnp.square(y - mu), axis=-1, keepdims=True)
    yn = ((y - mu) * lax.rsqrt(var + RWKV_GN_EPS)).reshape(b, t, RWKV_W) * ln_g + ln_b
    k_bonus = 0.5 * (k_reps[0] + k_reps[1])
    bonus = (jnp.sum(heads(r) * k_bonus * r_k, axis=-1, keepdims=True) * heads(v)).reshape(b, t, RWKV_W)
    out = (yn + bonus) * (jax.nn.sigmoid(gd) @ g2)
    return out.astype(r.dtype), states


def s5_discretise(lam_re, lam_im, log_dt, b_re, b_im):
    f32 = jnp.float32
    lam_re, lam_im, b_re, b_im = (z.astype(f32) for z in (lam_re, lam_im, b_re, b_im))
    dt = jnp.exp(log_dt.astype(f32))[:, None]
    mag = jnp.exp(lam_re * dt)
    a_re = mag * jnp.cos(lam_im * dt)
    a_im = mag * jnp.sin(lam_im * dt)
    den = lam_re * lam_re + lam_im * lam_im
    q_re = ((a_re - 1.0) * lam_re + a_im * lam_im) / den
    q_im = (a_im * lam_re - (a_re - 1.0) * lam_im) / den
    bb_re = q_re[..., None] * b_re - q_im[..., None] * b_im
    bb_im = q_re[..., None] * b_im + q_im[..., None] * b_re
    return a_re, a_im, bb_re, bb_im


def complex_linear_combine(e1, e2):
    a1r, a1i, b1r, b1i = e1
    a2r, a2i, b2r, b2i = e2
    return (a2r * a1r - a2i * a1i, a2r * a1i + a2i * a1r,
            a2r * b1r - a2i * b1i + b2r, a2r * b1i + a2i * b1r + b2i)


def s5_states(u, a_re, a_im, bb_re, bb_im, h0, reverse):
    bu_re = jnp.einsum('gpi,tbgi->tbgp', bb_re, u)
    bu_im = jnp.einsum('gpi,tbgi->tbgp', bb_im, u)
    if h0 is not None:
        h0_re, h0_im = h0
        first = -1 if reverse else 0
        bu_re = bu_re.at[first].add(a_re * h0_re - a_im * h0_im)
        bu_im = bu_im.at[first].add(a_re * h0_im + a_im * h0_re)
    t = u.shape[0]
    a_re_t = jnp.broadcast_to(a_re, (t, 1) + a_re.shape)
    a_im_t = jnp.broadcast_to(a_im, (t, 1) + a_im.shape)
    _, _, h_re, h_im = lax.associative_scan(complex_linear_combine, (a_re_t, a_im_t, bu_re, bu_im),
                                            reverse=reverse, axis=0)
    return h_re, h_im


def s5_branch(u, lam_re, lam_im, log_dt, b_re, b_im, c_re, c_im, d_skip, glu_w, glu_b, h0, readout):
    b, t, _ = u.shape
    f32 = jnp.float32
    ut = jnp.swapaxes(u, 0, 1).astype(f32).reshape(t, b, S5_GROUPS, S5_GROUP)
    ys, finals = [], []
    for d in range(2):
        rev = d == 1
        a_re, a_im, bb_re, bb_im = s5_discretise(lam_re[d], lam_im[d], log_dt[d], b_re[d], b_im[d])
        h_re, h_im = s5_states(ut, a_re, a_im, bb_re, bb_im, None if h0 is None else h0[d], rev)
        fin = 0 if rev else -1
        finals.append((h_re[fin], h_im[fin]))
        if readout:
            ys.append(jnp.einsum('gip,tbgp->tbgi', c_re[d].astype(f32), h_re)
                      - jnp.einsum('gip,tbgp->tbgi', c_im[d].astype(f32), h_im))
    if not readout:
        return None, finals
    y = jnp.swapaxes(ys[0] + ys[1], 0, 1).reshape(b, t, S5_WIDTH) + d_skip * u.astype(f32)
    z = jax.nn.gelu(y)
    out = z * jax.nn.sigmoid(z @ glu_w.astype(f32) + glu_b)
    return out.astype(u.dtype), finals


def gated_merge(gate_logits, branches, w_branch, w_out):
    b, t, _ = gate_logits.shape
    gates = jax.nn.sigmoid(gate_logits).reshape(b, t, N_BRANCH, D_MODEL)
    proj = jnp.einsum('btnc,ncd->btnd', jnp.stack(branches, axis=2), w_branch)
    return jnp.einsum('btnd,btnd->btd', gates, proj) @ w_out


def sq_relu_mlp(h, w1, w2):
    return jnp.square(jax.nn.relu(h @ w1)) @ w2


def setup_inputs(seed: int = 0) -> dict:
    key = jax.random.key(seed)
    ks = iter(jax.random.split(key, 48))
    f32 = jnp.float32
    L, D = DEPTH, D_MODEL

    def nrm(shape, scale):
        return scale * jax.random.normal(next(ks), shape, f32)

    def gain(shape):
        return 1.0 + nrm(shape, 0.02)

    n_frac = jnp.arange(RWKV_W, dtype=f32) / (RWKV_W - 1)
    depth_frac = jnp.arange(L, dtype=f32) / max(L - 1, 1)
    decay_speed = -7.0 + 5.0 * n_frac[None, :] ** (0.85 + depth_frac[:, None] ** 0.5)
    lam_im0 = math.pi * jnp.arange(S5_STATE, dtype=f32)
    s5_state_shape = (L, 2, S5_GROUPS, S5_STATE)
    return {
        'x': nrm((BATCH, SEQ, D), 1.0),
        'c': nrm((BATCH, D), 1.0),
        'ctx': nrm((BATCH, CTX_LEN, D), 1.0),
        'c_ctx': nrm((D,), 1.0),
        'ada_w': nrm((L, D, 6 * D), 0.5 * D ** -0.5),
        'ada_b': nrm((L, 6 * D), 0.02),
        'norm1_g': gain((L, D)),
        'norm2_g': gain((L, D)),
        'w_in': nrm((L, D, N_IN), D ** -0.5),
        'mla_q_lora_g': gain((L, MLA_Q_LORA)),
        'mla_kv_lora_g': gain((L, MLA_KV_LORA)),
        'mla_w_uq': nrm((L, MLA_Q_LORA, MLA_HEADS * (MLA_NOPE + MLA_ROPE)), MLA_Q_LORA ** -0.5),
        'mla_w_ukv': nrm((L, MLA_KV_LORA, MLA_HEADS * (MLA_NOPE + MLA_V)), MLA_KV_LORA ** -0.5),
        'mla_qn_nope_g': gain((L, MLA_NOPE)),
        'mla_qn_rope_g': gain((L, MLA_ROPE)),
        'mla_kn_nope_g': gain((L, MLA_NOPE)),
        'mla_kn_rope_g': gain((L, MLA_ROPE)),
        'rwkv_conv': 1.0 / RWKV_CONV + nrm((L, RWKV_CONV, 3 * RWKV_W), 0.1),
        'rwkv_w0': (decay_speed + 0.5)[:, None, :] + nrm((L, 2, RWKV_W), 0.05),
        'rwkv_w2': nrm((L, 2, RWKV_DECAY_LORA, RWKV_W), 0.1 * RWKV_DECAY_LORA ** -0.5),
        'rwkv_a0': nrm((L, 2, RWKV_W), 0.1),
        'rwkv_a2': nrm((L, 2, RWKV_A_LORA, RWKV_W), 0.5 * RWKV_A_LORA ** -0.5),
        'rwkv_g2': nrm((L, RWKV_GATE_LORA, RWKV_W), RWKV_GATE_LORA ** -0.5),
        'rwkv_k_k': 0.85 + nrm((L, RWKV_W), 0.02),
        'rwkv_k_a': 1.0 + nrm((L, RWKV_W), 0.02),
        'rwkv_r_k': nrm((L, RWKV_HEADS, RWKV_HEAD), 0.1),
        'rwkv_ln_g': gain((L, RWKV_W)),
        'rwkv_ln_b': nrm((L, RWKV_W), 0.02),
        's5_lam_re': -0.5 + nrm(s5_state_shape, 0.01),
        's5_lam_im': lam_im0 + nrm(s5_state_shape, 0.01),
        's5_log_dt': jax.random.uniform(next(ks), (L, 2, S5_GROUPS), f32,
                                        math.log(S5_DT_MIN), math.log(S5_DT_MAX)),
        's5_b_re': nrm((L, 2, S5_GROUPS, S5_STATE, S5_GROUP), (2 * S5_GROUP) ** -0.5),
        's5_b_im': nrm((L, 2, S5_GROUPS, S5_STATE, S5_GROUP), (2 * S5_GROUP) ** -0.5),
        's5_c_re': nrm((L, 2, S5_GROUPS, S5_GROUP, S5_STATE), (2 * S5_STATE) ** -0.5),
        's5_c_im': nrm((L, 2, S5_GROUPS, S5_GROUP, S5_STATE), (2 * S5_STATE) ** -0.5),
        's5_d': nrm((L, S5_WIDTH), 1.0),
        's5_glu_w': nrm((L, S5_WIDTH, S5_WIDTH), S5_WIDTH ** -0.5),
        's5_glu_b': nrm((L, S5_WIDTH), 0.02),
        'w_branch': nrm((L, N_BRANCH, BRANCH_W, D), BRANCH_W ** -0.5),
        'w_out': nrm((L, D, D), D ** -0.5),
        'w_mlp1': nrm((L, D, D_FF), D ** -0.5),
        'w_mlp2': nrm((L, D_FF, D), D_FF ** -0.5),
    }


def reference(x, c, ctx, c_ctx, ada_w, ada_b, norm1_g, norm2_g, w_in,
              mla_q_lora_g, mla_kv_lora_g, mla_w_uq, mla_w_ukv,
              mla_qn_nope_g, mla_qn_rope_g, mla_kn_nope_g, mla_kn_rope_g,
              rwkv_conv, rwkv_w0, rwkv_w2, rwkv_a0, rwkv_a2, rwkv_g2,
              rwkv_k_k, rwkv_k_a, rwkv_r_k, rwkv_ln_g, rwkv_ln_b,
              s5_lam_re, s5_lam_im, s5_log_dt, s5_b_re, s5_b_im, s5_c_re, s5_c_im,
              s5_d, s5_glu_w, s5_glu_b, w_branch, w_out, w_mlp1, w_mlp2):
    bsz, n_tok, _ = x.shape
    rows = n_tok // GRID_W
    rope = axial_rope_tables(rows, x.dtype)
    zero = jnp.zeros((bsz, RWKV_HEADS, RWKV_HEAD, RWKV_HEAD), jnp.float32)
    xc = ctx
    for l in range(DEPTH):
        last = l == DEPTH - 1
        mod_t = [m[:, None, :] for m in jnp.split(jax.nn.silu(c) @ ada_w[l] + ada_b[l], 6, axis=-1)]
        mod_c = jnp.split(jax.nn.silu(c_ctx) @ ada_w[l] + ada_b[l], 6, axis=-1)
        (cq_t, ckv_t, kr_t, r_t, k_t, v_t, wdf_t, wdb_t, adf_t, adb_t, gd_t, u_t, gate_t) = split_cols(
            modulate(rms_norm(x, norm1_g[l]), mod_t[0], mod_t[1]) @ w_in[l])
        (cq_c, ckv_c, kr_c, r_c, k_c, v_c, wdf_c, wdb_c, adf_c, adb_c, gd_c, u_c, gate_c) = split_cols(
            modulate(rms_norm(xc, norm1_g[l]), mod_c[0], mod_c[1]) @ w_in[l])

        key_c, val_c = mla_keys_values(ckv_c, kr_c, mla_kv_lora_g[l], mla_w_ukv[l],
                                       mla_kn_nope_g[l], mla_kn_rope_g[l], None)
        key_t, val_t = mla_keys_values(ckv_t, kr_t, mla_kv_lora_g[l], mla_w_ukv[l],
                                       mla_kn_nope_g[l], mla_kn_rope_g[l], rope)
        q_t = mla_queries(cq_t, mla_q_lora_g[l], mla_w_uq[l], mla_qn_nope_g[l], mla_qn_rope_g[l], rope)
        o_a_t = blocked_attend(q_t, jnp.concatenate([key_t, key_c], axis=1),
                               jnp.concatenate([val_t, val_c], axis=1))

        rwkv_p = (rwkv_conv[l], rwkv_w0[l], rwkv_w2[l], rwkv_a0[l], rwkv_a2[l], rwkv_g2[l],
                  rwkv_k_k[l], rwkv_k_a[l], rwkv_r_k[l], rwkv_ln_g[l], rwkv_ln_b[l])
        o_b_c, s_ctx = rwkv_branch(r_c, k_c, v_c, (wdf_c, wdb_c), (adf_c, adb_c), gd_c, *rwkv_p,
                                   (zero, zero), not last)
        o_b_t, _ = rwkv_branch(r_t, k_t, v_t, (wdf_t, wdb_t), (adf_t, adb_t), gd_t, *rwkv_p, s_ctx, True)

        s5_p = (s5_lam_re[l], s5_lam_im[l], s5_log_dt[l], s5_b_re[l], s5_b_im[l], s5_c_re[l], s5_c_im[l],
                s5_d[l], s5_glu_w[l], s5_glu_b[l])
        o_c_c, h_ctx = s5_branch(u_c, *s5_p, None, not last)
        o_c_t, _ = s5_branch(u_t, *s5_p, h_ctx, True)

        x = x + mod_t[2] * gated_merge(gate_t, (o_a_t, o_b_t, o_c_t), w_branch[l], w_out[l])
        x = x + mod_t[5] * sq_relu_mlp(modulate(rms_norm(x, norm2_g[l]), mod_t[3], mod_t[4]),
                                       w_mlp1[l], w_mlp2[l])

        if not last:
            q_c = mla_queries(cq_c, mla_q_lora_g[l], mla_w_uq[l], mla_qn_nope_g[l], mla_qn_rope_g[l], None)
            o_a_c = softmax_attend(q_c, key_c, val_c).reshape(bsz, xc.shape[1], BRANCH_W)
            xc = xc + mod_c[2] * gated_merge(gate_c, (o_a_c, o_b_c, o_c_c), w_branch[l], w_out[l])
            xc = xc + mod_c[5] * sq_relu_mlp(modulate(rms_norm(xc, norm2_g[l]), mod_c[3], mod_c[4]),
                                             w_mlp1[l], w_mlp2[l])
    return x
```

```cpp
#include <hip/hip_runtime.h>
#include <hip/hip_cooperative_groups.h>
#include <stdint.h>
#include <cstdio>
namespace cg = cooperative_groups;

#ifndef MULTI_LAUNCH
#define MULTI_LAUNCH 0
#endif

typedef unsigned short bf16;
using bf16x8 = __attribute__((ext_vector_type(8))) short;
using f32x4 = __attribute__((ext_vector_type(4))) float;
using f32x16 = __attribute__((ext_vector_type(16))) float;

#define DEV __device__ __forceinline__

constexpr int DM = 2048, ML = 16384, MC = 1024, MT = 17408, NIN = 11744, DFF = 8192, NKEY = 4352;
constexpr int C_CQ = 0, C_CKV = 512, C_KR = 1024, C_R = 1088, C_WD = 4160, C_AD = 4288, C_GD = 4416, C_U = 4576, C_GATE = 5600;

constexpr size_t OW_IN = 0;
constexpr size_t OW_UQ = OW_IN + (size_t)NIN * 2048;
constexpr size_t OW_UKV = OW_UQ + 1536 * 512;
constexpr size_t OW_W2 = OW_UKV + 2048 * 512;
constexpr size_t OW_A2 = OW_W2 + 2 * 1024 * 64;
constexpr size_t OW_G2 = OW_A2 + 2 * 1024 * 64;
constexpr size_t OW_GLU = OW_G2 + 1024 * 160;
constexpr size_t OW_BR = OW_GLU + 1024 * 1024;
constexpr size_t OW_OUT = OW_BR + (size_t)3 * 2048 * 1024;
constexpr size_t OW_M1 = OW_OUT + (size_t)2048 * 2048;
constexpr size_t OW_M2 = OW_M1 + (size_t)8192 * 2048;
constexpr size_t OW_END = OW_M2 + (size_t)8192 * 2048;

constexpr size_t SZ1K = (size_t)MT * 1024 * 2;
constexpr size_t B_WB = 0;
constexpr size_t B_HB = B_WB + OW_END * 2;
constexpr size_t B_ZB = B_HB + (size_t)MT * 2048 * 2;
constexpr size_t B_QB = B_ZB + (size_t)MT * NIN * 2;
constexpr size_t B_KN = B_QB + (size_t)MT * 1536 * 2;
constexpr size_t B_VT = B_KN + SZ1K;
constexpr size_t B_KR = B_VT + SZ1K;
constexpr size_t B_AF = B_KR + (size_t)MT * 64 * 2;
constexpr size_t B_AB = B_AF + SZ1K;
constexpr size_t B_GB = B_AB + SZ1K;
constexpr size_t B_SY = B_GB + SZ1K;
constexpr size_t B_XC = B_SY + SZ1K;
constexpr size_t B_MOD = B_XC + (size_t)MC * 2048 * 4;
constexpr size_t B_CNT = B_MOD + (size_t)2 * 5 * 12288 * 4;
constexpr size_t B_END = B_CNT + 256;

struct Params {
  const float* in[42];
  float* out;
  char* ws;
};

DEV bf16 f2bf(float f) {
  uint32_t u = __float_as_uint(f);
  u += 0x7fffu + ((u >> 16) & 1u);
  return (bf16)(u >> 16);
}
DEV float bf2f(bf16 h) { return __uint_as_float(((uint32_t)h) << 16); }
DEV uint32_t pack2(float a, float b) { return (uint32_t)f2bf(a) | ((uint32_t)f2bf(b) << 16); }
DEV float wsum(float v) {
#pragma unroll
  for (int o = 32; o > 0; o >>= 1) v += __shfl_xor(v, o);
  return v;
}
DEV float sigmoidf_(float x) { return 1.f / (1.f + __expf(-x)); }

DEV void phase_mod(int tidv, int bidv, const Params& p, char* smem) {
  float* s_in = (float*)smem;
  float* red = s_in + 5 * 2048;
  float* mod = (float*)(p.ws + B_MOD);
  for (int i = tidv; i < 5 * 2048; i += 256) {
    int r = i >> 11, k = i & 2047;
    float v = r < 4 ? p.in[1][r * 2048 + k] : p.in[3][k];
    s_in[i] = v / (1.f + expf(-v));
  }
  __syncthreads();
  int kg = tidv >> 6, c = tidv & 63;
  for (int task = bidv; task < 2 * 192; task += gridDim.x) {
    int l = task / 192, n = (task % 192) * 64 + c;
    const float* w = p.in[4] + (size_t)l * 2048 * 12288 + n;
    float a0 = 0, a1 = 0, a2 = 0, a3 = 0, a4 = 0;
    int kb = kg * 512;
#pragma unroll 8
    for (int k = 0; k < 512; k++) {
      float wv = w[(size_t)(kb + k) * 12288];
      a0 += s_in[kb + k] * wv;
      a1 += s_in[2048 + kb + k] * wv;
      a2 += s_in[4096 + kb + k] * wv;
      a3 += s_in[6144 + kb + k] * wv;
      a4 += s_in[8192 + kb + k] * wv;
    }
    red[(kg * 5 + 0) * 64 + c] = a0;
    red[(kg * 5 + 1) * 64 + c] = a1;
    red[(kg * 5 + 2) * 64 + c] = a2;
    red[(kg * 5 + 3) * 64 + c] = a3;
    red[(kg * 5 + 4) * 64 + c] = a4;
    __syncthreads();
    if (kg == 0) {
      float bias = p.in[5][l * 12288 + n];
#pragma unroll
      for (int r = 0; r < 5; r++) {
        float v = red[(0 * 5 + r) * 64 + c] + red[(1 * 5 + r) * 64 + c] + red[(2 * 5 + r) * 64 + c] + red[(3 * 5 + r) * 64 + c];
        mod[(size_t)(l * 5 + r) * 12288 + n] = v + bias;
      }
    }
    __syncthreads();
  }
}

DEV void convT(int tidv, int bidv, const float* __restrict__ src, bf16* __restrict__ dst, int K, int N, const float* __restrict__ gain, char* smem) {
  float* t = (float*)smem;
  int tk = (K + 63) >> 6, tn = (N + 63) >> 6;
  for (int tile = bidv; tile < tk * tn; tile += gridDim.x) {
    int k0 = (tile / tn) * 64, n0 = (tile % tn) * 64;
    __syncthreads();
#pragma unroll 4
    for (int i = 0; i < 16; i++) {
      int kk = i * 4 + (tidv >> 6), nn = tidv & 63;
      float v = 0.f;
      if (k0 + kk < K && n0 + nn < N) {
        v = src[(size_t)(k0 + kk) * N + n0 + nn];
        if (gain) v *= gain[k0 + kk];
      }
      t[kk * 65 + nn] = v;
    }
    __syncthreads();
#pragma unroll
    for (int i = 0; i < 2; i++) {
      int c = tidv + 256 * i;
      int nn = c >> 3, kc = c & 7;
      if (n0 + nn < N && k0 + kc * 8 < K) {
        uint4 o;
        o.x = pack2(t[(kc * 8 + 0) * 65 + nn], t[(kc * 8 + 1) * 65 + nn]);
        o.y = pack2(t[(kc * 8 + 2) * 65 + nn], t[(kc * 8 + 3) * 65 + nn]);
        o.z = pack2(t[(kc * 8 + 4) * 65 + nn], t[(kc * 8 + 5) * 65 + nn]);
        o.w = pack2(t[(kc * 8 + 6) * 65 + nn], t[(kc * 8 + 7) * 65 + nn]);
        *(uint4*)(dst + (size_t)(n0 + nn) * K + k0 + kc * 8) = o;
      }
    }
  }
}

DEV void phase_convw(int tidv, int bidv, const Params& p, int l, char* smem) {
  bf16* wb = (bf16*)(p.ws + B_WB);
  convT(tidv, bidv, p.in[8] + (size_t)l * 2048 * NIN, wb + OW_IN, 2048, NIN, nullptr, smem);
  convT(tidv, bidv, p.in[40] + (size_t)l * 2048 * 8192, wb + OW_M1, 2048, 8192, nullptr, smem);
  convT(tidv, bidv, p.in[41] + (size_t)l * 8192 * 2048, wb + OW_M2, 8192, 2048, nullptr, smem);
  for (int n = 0; n < 3; n++)
    convT(tidv, bidv, p.in[38] + (size_t)(l * 3 + n) * 1024 * 2048, wb + OW_BR + (size_t)n * 2048 * 1024, 1024, 2048, nullptr, smem);
  convT(tidv, bidv, p.in[39] + (size_t)l * 2048 * 2048, wb + OW_OUT, 2048, 2048, nullptr, smem);
  convT(tidv, bidv, p.in[11] + (size_t)l * 512 * 1536, wb + OW_UQ, 512, 1536, p.in[9] + l * 512, smem);
  convT(tidv, bidv, p.in[12] + (size_t)l * 512 * 2048, wb + OW_UKV, 512, 2048, p.in[10] + l * 512, smem);
  convT(tidv, bidv, p.in[36] + (size_t)l * 1024 * 1024, wb + OW_GLU, 1024, 1024, nullptr, smem);
  for (int d = 0; d < 2; d++) {
    convT(tidv, bidv, p.in[19] + (size_t)(l * 2 + d) * 64 * 1024, wb + OW_W2 + (size_t)d * 65536, 64, 1024, nullptr, smem);
    convT(tidv, bidv, p.in[21] + (size_t)(l * 2 + d) * 64 * 1024, wb + OW_A2 + (size_t)d * 65536, 64, 1024, nullptr, smem);
  }
  convT(tidv, bidv, p.in[22] + (size_t)l * 160 * 1024, wb + OW_G2, 160, 1024, nullptr, smem);
}

DEV void phase_norm(int tidv, int bidv, const float* xlat, const float* xctx, const float* g, const float* mod, int shOff, int scOff, bf16* H, int nrows) {
  int wave = tidv >> 6, lane = tidv & 63;
  for (int row = bidv * 4 + wave; row < nrows; row += gridDim.x * 4) {
    const float* x = row < ML ? xlat + (size_t)row * 2048 : xctx + (size_t)(row - ML) * 2048;
    int b = row < ML ? (row >> 12) : 4;
    const float* sh = mod + b * 12288 + shOff;
    const float* sc = mod + b * 12288 + scOff;
    float4 v[8];
    float ss = 0.f;
#pragma unroll
    for (int i = 0; i < 8; i++) {
      v[i] = *(const float4*)(x + i * 256 + lane * 4);
      ss += v[i].x * v[i].x + v[i].y * v[i].y + v[i].z * v[i].z + v[i].w * v[i].w;
    }
    ss = wsum(ss);
    float rinv = rsqrtf(ss * (1.f / 2048.f) + 1e-6f);
#pragma unroll
    for (int i = 0; i < 8; i++) {
      int c = i * 256 + lane * 4;
      float4 g4 = *(const float4*)(g + c), s4 = *(const float4*)(sc + c), h4 = *(const float4*)(sh + c);
      float y0 = v[i].x * rinv * g4.x * (1.f + s4.x) + h4.x;
      float y1 = v[i].y * rinv * g4.y * (1.f + s4.y) + h4.y;
      float y2 = v[i].z * rinv * g4.z * (1.f + s4.z) + h4.z;
      float y3 = v[i].w * rinv * g4.w * (1.f + s4.w) + h4.w;
      uint2 o;
      o.x = pack2(y0, y1);
      o.y = pack2(y2, y3);
      *(uint2*)(H + (size_t)row * 2048 + c) = o;
    }
  }
}

constexpr int LDT = 40;
DEV float sumsq8(uint4 r) {
  float s = 0.f, x;
  x = bf2f((bf16)(r.x & 0xffff)); s += x * x; x = bf2f((bf16)(r.x >> 16)); s += x * x;
  x = bf2f((bf16)(r.y & 0xffff)); s += x * x; x = bf2f((bf16)(r.y >> 16)); s += x * x;
  x = bf2f((bf16)(r.z & 0xffff)); s += x * x; x = bf2f((bf16)(r.z >> 16)); s += x * x;
  x = bf2f((bf16)(r.w & 0xffff)); s += x * x; x = bf2f((bf16)(r.w >> 16)); s += x * x;
  return s;
}

template <bool ROWNORM>
DEV void gemm_mainloop(int tidv, int bidv, const bf16* __restrict__ A, int lda, bool amap, const bf16* __restrict__ Bt, int K, int N, int m0, int n0,
                       char* smem, f32x4 (&acc)[4][4]) {
  bf16* sa = (bf16*)smem;
  bf16* sb = sa + 128 * LDT;
  float* srinv = (float*)(sb + 128 * LDT);
  const int tid = tidv, lane = tid & 63, wave = tid >> 6;
  const int wm = wave >> 1, wn = wave & 1;
  const int lr = tid >> 2, kc = tid & 3;
  const bf16* pa0 = A + (size_t)(m0 + lr) * lda + kc * 8;
  const bf16* pa1 = pa0 + (size_t)64 * lda;
  int nr0 = n0 + lr; if (nr0 > N - 1) nr0 = N - 1;
  int nr1 = n0 + lr + 64; if (nr1 > N - 1) nr1 = N - 1;
  const bf16* pb0 = Bt + (size_t)nr0 * K + kc * 8;
  const bf16* pb1 = Bt + (size_t)nr1 * K + kc * 8;
  const int nk = K >> 5;
  uint4 ra0, ra1, rb0, rb1;
  float ss0 = 0.f, ss1 = 0.f;
  {
    ra0 = *(const uint4*)(pa0);
    ra1 = *(const uint4*)(pa1);
    rb0 = *(const uint4*)(pb0);
    rb1 = *(const uint4*)(pb1);
  }
  for (int kt = 0; kt < nk; kt++) {
    __syncthreads();
    *(uint4*)(sa + lr * LDT + kc * 8) = ra0;
    *(uint4*)(sa + (lr + 64) * LDT + kc * 8) = ra1;
    *(uint4*)(sb + lr * LDT + kc * 8) = rb0;
    *(uint4*)(sb + (lr + 64) * LDT + kc * 8) = rb1;
    if (ROWNORM) { ss0 += sumsq8(ra0); ss1 += sumsq8(ra1); }
    __syncthreads();
    if (kt + 1 < nk) {
      int k0 = (kt + 1) << 5;
      int ka = amap ? ((k0 >> 7) * 192 + (k0 & 127)) : k0;
      ra0 = *(const uint4*)(pa0 + ka);
      ra1 = *(const uint4*)(pa1 + ka);
      rb0 = *(const uint4*)(pb0 + k0);
      rb1 = *(const uint4*)(pb1 + k0);
    }
    bf16x8 af[4], bfr[4];
#pragma unroll
    for (int i = 0; i < 4; i++) af[i] = *(const bf16x8*)(sa + (wm * 64 + i * 16 + (lane & 15)) * LDT + (lane >> 4) * 8);
#pragma unroll
    for (int j = 0; j < 4; j++) bfr[j] = *(const bf16x8*)(sb + (wn * 64 + j * 16 + (lane & 15)) * LDT + (lane >> 4) * 8);
#pragma unroll
    for (int i = 0; i < 4; i++)
#pragma unroll
      for (int j = 0; j < 4; j++) acc[i][j] = __builtin_amdgcn_mfma_f32_16x16x32_bf16(af[i], bfr[j], acc[i][j], 0, 0, 0);
  }
  if (ROWNORM) {
    ss0 += __shfl_xor(ss0, 1); ss0 += __shfl_xor(ss0, 2);
    ss1 += __shfl_xor(ss1, 1); ss1 += __shfl_xor(ss1, 2);
    __syncthreads();
    if (kc == 0) {
      srinv[lr] = rsqrtf(ss0 / (float)K + 1e-6f);
      srinv[lr + 64] = rsqrtf(ss1 / (float)K + 1e-6f);
    }
    __syncthreads();
  }
}

DEV void zero_acc(f32x4 (&acc)[4][4]) {
#pragma unroll
  for (int i = 0; i < 4; i++)
#pragma unroll
    for (int j = 0; j < 4; j++) acc[i][j] = f32x4{0.f, 0.f, 0.f, 0.f};
}

template <class F>
DEV void epi_loop(int tidv, int bidv, f32x4 (&acc)[4][4], int m0, int n0, int N, F f) {
  const int lane = tidv & 63, wave = tidv >> 6;
  const int wm = wave >> 1, wn = wave & 1;
#pragma unroll
  for (int i = 0; i < 4; i++)
#pragma unroll
    for (int j = 0; j < 4; j++) {
      int col = n0 + wn * 64 + j * 16 + (lane & 15);
      if (col < N) {
#pragma unroll
        for (int r = 0; r < 4; r++) {
          int lrow = wm * 64 + i * 16 + (lane >> 4) * 4 + r;
          f(m0 + lrow, lrow, col, acc[i][j][r], i, j, r);
        }
      }
    }
}

enum { G_IN = 0, G_UQ, G_UKV, G_W2, G_A2, G_G2, G_GLU, G_OUT, G_M1, G_M2 };

template <int MODE>
DEV void run_gemm(int tidv, int bidv, const Params& p, int l, char* smem, const bf16* A, int lda, const bf16* Bt, int K, int N, int M, int aux,
                  const float* xin_lat, const float* xin_ctx, float* xout_lat, float* xout_ctx) {
  const int nt = (N + 127) >> 7, mt = M >> 7;
  char* ws = p.ws;
  bf16* Z = (bf16*)(ws + B_ZB);
  const float* srinv = (const float*)(smem + 2 * 128 * LDT * 2);
  const float* mod = (const float*)(ws + B_MOD) + (size_t)l * 5 * 12288;
  for (int tile = bidv; tile < nt * mt; tile += gridDim.x) {
    int m0 = (tile / nt) << 7, n0 = (tile % nt) << 7;
    f32x4 acc[4][4];
    zero_acc(acc);
    gemm_mainloop<(MODE == G_UQ || MODE == G_UKV)>(tidv, bidv, A, lda, false, Bt, K, N, m0, n0, smem, acc);
    epi_loop(tidv, bidv, acc, m0, n0, N, [&](int row, int lrow, int col, float v, int, int, int) {
      if constexpr (MODE == G_IN) {
        float o = v;
        if (col >= C_GATE) o = sigmoidf_(v);
        else if (col >= C_WD && col < C_AD) o = tanhf(v);
        else if (col >= C_GD && col < C_U) o = sigmoidf_(v);
        Z[(size_t)row * NIN + col] = f2bf(o);
      } else if constexpr (MODE == G_UQ) {
        ((bf16*)(ws + B_QB))[(size_t)row * 1536 + col] = f2bf(v * srinv[lrow]);
      } else if constexpr (MODE == G_UKV) {
        float o = v * srinv[lrow];
        int h = col >> 8, c = col & 255;
        if (c < 128) {
          ((bf16*)(ws + B_KN))[(size_t)row * 1024 + h * 128 + c] = f2bf(o);
        } else {
          int b, kp;
          if (row < ML) { b = row >> 12; kp = row & 4095; } else { int r2 = row - ML; b = r2 >> 8; kp = 4096 + (r2 & 255); }
          ((bf16*)(ws + B_VT))[((size_t)((b * 8 + h) * 128 + (c - 128))) * NKEY + kp] = f2bf(o);
        }
      } else if constexpr (MODE == G_W2) {
        float x = p.in[18][(l * 2 + aux) * 1024 + col] + v;
        float e = 0.60653066f * sigmoidf_(x);
        ((bf16*)(ws + B_HB + (size_t)aux * SZ1K))[(size_t)row * 1024 + col] = f2bf(e);
      } else if constexpr (MODE == G_A2) {
        float a = sigmoidf_(p.in[20][(l * 2 + aux) * 1024 + col] + v);
        ((bf16*)(ws + (aux ? B_AB : B_AF)))[(size_t)row * 1024 + col] = f2bf(a);
      } else if constexpr (MODE == G_G2) {
        ((bf16*)(ws + B_GB))[(size_t)row * 1024 + col] = f2bf(v);
      } else if constexpr (MODE == G_GLU) {
        float zz = bf2f(((const bf16*)(ws + B_SY))[(size_t)row * 1024 + col]);
        float o = zz * sigmoidf_(v + p.in[37][l * 1024 + col]);
        Z[(size_t)row * NIN + col] = f2bf(o);
      } else if constexpr (MODE == G_OUT) {
        int b = row < ML ? (row >> 12) : 4;
        float g = mod[b * 12288 + 4096 + col];
        const float* xi = row < ML ? xin_lat + (size_t)row * 2048 : xin_ctx + (size_t)(row - ML) * 2048;
        float* xo = row < ML ? xout_lat + (size_t)row * 2048 : xout_ctx + (size_t)(row - ML) * 2048;
        xo[col] = xi[col] + g * v;
      } else if constexpr (MODE == G_M1) {
        float r = fmaxf(v, 0.f);
        Z[(size_t)row * DFF + col] = f2bf(r * r);
      } else if constexpr (MODE == G_M2) {
        int b = row < ML ? (row >> 12) : 4;
        float g = mod[b * 12288 + 10240 + col];
        float* xo = row < ML ? xout_lat + (size_t)row * 2048 : xout_ctx + (size_t)(row - ML) * 2048;
        xo[col] = xo[col] + g * v;
      }
    });
  }
}

DEV void phase_merge(int tidv, int bidv, const Params& p, char* smem, int M) {
  char* ws = p.ws;
  const bf16* Z = (const bf16*)(ws + B_ZB);
  const bf16* wb = (const bf16*)(ws + B_WB);
  bf16* MG = (bf16*)(ws + B_HB);
  const int nt = 16, mt = M >> 7;
  for (int tile = bidv; tile < nt * mt; tile += gridDim.x) {
    int m0 = (tile / nt) << 7, n0 = (tile % nt) << 7;
#pragma unroll 1
    for (int n = 0; n < 3; n++) {
      f32x4 acc[4][4];
      zero_acc(acc);
      const bf16* A = n == 0 ? (const bf16*)(ws + B_QB) : (n == 1 ? (const bf16*)(ws + B_GB) : Z);
      int lda = n == 0 ? 1536 : (n == 1 ? 1024 : NIN);
      gemm_mainloop<false>(tidv, bidv, A, lda, n == 0, wb + OW_BR + (size_t)n * 2048 * 1024, 1024, 2048, m0, n0, smem, acc);
      epi_loop(tidv, bidv, acc, m0, n0, 2048, [&](int row, int, int col, float v, int, int, int) {
        float g = bf2f(Z[(size_t)row * NIN + C_GATE + n * 2048 + col]);
        float prev = n > 0 ? bf2f(MG[(size_t)row * 2048 + col]) : 0.f;
        MG[(size_t)row * 2048 + col] = f2bf(prev + g * v);
      });
    }
  }
}

DEV void phase_mla_post(int tidv, int bidv, const Params& p, int l) {
  char* ws = p.ws;
  const float* qng = p.in[13] + l * 128;
  const float* qrg = p.in[14] + l * 64;
  const float* kng = p.in[15] + l * 128;
  const float* krg = p.in[16] + l * 64;
  bf16* QB = (bf16*)(ws + B_QB);
  bf16* KN = (bf16*)(ws + B_KN);
  bf16* KR = (bf16*)(ws + B_KR);
  const bf16* Z = (const bf16*)(ws + B_ZB);
  const int wave = tidv >> 6, lane = tidv & 63;
  const float QS = 1.4426950408889634f * 0.07216878364870322f;
  const int idx = lane & 31;
  const float inv = powf(10000.f, -(float)(idx & 15) / 16.f);
  const float gq0 = qng[2 * lane], gq1 = qng[2 * lane + 1], gk0 = kng[2 * lane], gk1 = kng[2 * lane + 1];
  const float gqr = qrg[lane], gkr = krg[lane];
  for (int row = bidv * 4 + wave; row < MT; row += gridDim.x * 4) {
    bool lat = row < ML;
    int t = row & 4095;
    float pos = (idx < 16) ? (float)(t >> 6) : (float)(t & 63);
    float ang = pos * inv;
    float cs = 1.f, sn = 0.f;
    if (lat) { cs = cosf(ang); sn = sinf(ang); }
#pragma unroll 1
    for (int h = 0; h < 8; h++) {
      bf16* q = QB + (size_t)row * 1536 + h * 192;
      uint32_t u = *(const uint32_t*)(q + 2 * lane);
      float x0 = bf2f((bf16)(u & 0xffff)), x1 = bf2f((bf16)(u >> 16));
      float ss = wsum(x0 * x0 + x1 * x1);
      float rinv = rsqrtf(ss * (1.f / 128.f) + 1e-6f) * QS;
      *(uint32_t*)(q + 2 * lane) = pack2(x0 * rinv * gq0, x1 * rinv * gq1);
      float xr = bf2f(q[128 + lane]);
      float ss2 = wsum(xr * xr);
      float y = xr * rsqrtf(ss2 * (1.f / 64.f) + 1e-6f) * gqr;
      float yp = __shfl_xor(y, 32);
      float o = lane < 32 ? (y * cs - yp * sn) : (yp * sn + y * cs);
      q[128 + lane] = f2bf(o * QS);
      bf16* k = KN + (size_t)row * 1024 + h * 128;
      uint32_t uk = *(const uint32_t*)(k + 2 * lane);
      float k0 = bf2f((bf16)(uk & 0xffff)), k1 = bf2f((bf16)(uk >> 16));
      float ssk = wsum(k0 * k0 + k1 * k1);
      float rk = rsqrtf(ssk * (1.f / 128.f) + 1e-6f);
      *(uint32_t*)(k + 2 * lane) = pack2(k0 * rk * gk0, k1 * rk * gk1);
    }
    {
      float xr = bf2f(Z[(size_t)row * NIN + C_KR + lane]);
      float ss2 = wsum(xr * xr);
      float y = xr * rsqrtf(ss2 * (1.f / 64.f) + 1e-6f) * gkr;
      float yp = __shfl_xor(y, 32);
      float o = lane < 32 ? (y * cs - yp * sn) : (yp * sn + y * cs);
      KR[(size_t)row * 64 + lane] = f2bf(o);
    }
  }
}

DEV void step_row(int s, int d, int b, int& row, int& tau, int& len) {
  if (s < 256) { tau = d ? 255 - s : s; len = 256; row = ML + b * 256 + tau; }
  else { int q = s - 256; tau = d ? 4095 - q : q; len = 4096; row = b * 4096 + tau; }
}

DEV void rwkv_scan(int tidv, int bidv, const Params& p, int l, int chain, char* smem) {
  char* ws = p.ws;
  float* op = (float*)smem;
  float* vb = op + 16 * 320;
  float* yb = vb + 16 * 64;
  const int tid = tidv, wave = tid >> 6, lane = tid & 63;
  const int d = chain & 1, h = (chain >> 1) & 15, b = chain >> 5;
  const int ch = h * 64 + lane;
  const float* cw = p.in[17] + (size_t)l * 3 * 3072;
  const float cr0 = cw[ch], cr1 = cw[3072 + ch], cr2 = cw[6144 + ch];
  const float ck0 = cw[1024 + ch], ck1 = cw[3072 + 1024 + ch], ck2 = cw[6144 + 1024 + ch];
  const float cv0 = cw[2048 + ch], cv1 = cw[3072 + 2048 + ch], cv2 = cw[6144 + 2048 + ch];
  const float kkc = p.in[23][l * 1024 + ch], kac = p.in[24][l * 1024 + ch];
  const bf16* Z = (const bf16*)(ws + B_ZB);
  bf16* ED = (bf16*)(ws + B_HB + (size_t)d * SZ1K);
  const bf16* AD = (const bf16*)(ws + (d ? B_AB : B_AF));
  float S[16];
#pragma unroll
  for (int j = 0; j < 16; j++) S[j] = 0.f;
  const int ri = lane >> 2, jq = lane & 3, irow = wave * 16 + ri;
  for (int chunk = 0; chunk < 272; chunk++) {
#pragma unroll
    for (int si = 0; si < 4; si++) {
      int t = wave * 4 + si;
      int row, tau, len;
      step_row(chunk * 16 + t, d, b, row, tau, len);
      const bf16* z = Z + (size_t)row * NIN + C_R + ch;
      float r1 = bf2f(z[0]), k1 = bf2f(z[1024]), v1 = bf2f(z[2048]);
      float r0 = 0.f, k0 = 0.f, v0 = 0.f, r2 = 0.f, k2 = 0.f, v2 = 0.f;
      if (tau > 0) { const bf16* zm = z - NIN; r0 = bf2f(zm[0]); k0 = bf2f(zm[1024]); v0 = bf2f(zm[2048]); }
      if (tau < len - 1) { const bf16* zp = z + NIN; r2 = bf2f(zp[0]); k2 = bf2f(zp[1024]); v2 = bf2f(zp[2048]); }
      float rr = cr0 * r0 + cr1 * r1 + cr2 * r2;
      float kk_ = ck0 * k0 + ck1 * k1 + ck2 * k2;
      float vv = cv0 * v0 + cv1 * v1 + cv2 * v2;
      float kkv = kk_ * kkc;
      float ssq = wsum(kkv * kkv);
      float kn = kkv * rsqrtf(ssq + 1e-12f);
      float a = bf2f(AD[(size_t)row * 1024 + ch]);
      float e = bf2f(ED[(size_t)row * 1024 + ch]);
      float w = __expf(-e);
      float krep = kk_ * (1.f + (a - 1.f) * kac);
      float* o = op + t * 320;
      o[lane] = w;
      o[64 + lane] = kn * a;
      o[128 + lane] = krep;
      o[192 + lane] = -kn;
      o[256 + lane] = rr;
      vb[t * 64 + lane] = vv;
    }
    __syncthreads();
#pragma unroll 2
    for (int t = 0; t < 16; t++) {
      const float* o = op + t * 320 + jq * 16;
      float sa0 = 0.f, sa1 = 0.f;
#pragma unroll
      for (int j = 0; j < 16; j += 2) { sa0 += S[j] * o[192 + j]; sa1 += S[j + 1] * o[192 + j + 1]; }
      float sa = sa0 + sa1;
      sa += __shfl_xor(sa, 1);
      sa += __shfl_xor(sa, 2);
      float vi = vb[t * 64 + irow];
      float y0 = 0.f, y1 = 0.f;
#pragma unroll
      for (int j = 0; j < 16; j += 2) {
        S[j] = S[j] * o[j] + sa * o[64 + j] + vi * o[128 + j];
        S[j + 1] = S[j + 1] * o[j + 1] + sa * o[64 + j + 1] + vi * o[128 + j + 1];
        y0 += S[j] * o[256 + j];
        y1 += S[j + 1] * o[256 + j + 1];
      }
      float y = y0 + y1;
      y += __shfl_xor(y, 1);
      y += __shfl_xor(y, 2);
      if (jq == 0) yb[t * 64 + irow] = y;
    }
    __syncthreads();
#pragma unroll
    for (int it = 0; it < 4; it++) {
      int t = it * 4 + wave;
      int row, tau, len;
      step_row(chunk * 16 + t, d, b, row, tau, len);
      ED[(size_t)row * 1024 + h * 64 + lane] = f2bf(yb[t * 64 + lane]);
    }
  }
}

DEV void s5_scan(int tidv, int bidv, const Params& p, int l, int chain, char* smemw) {
  char* ws = p.ws;
  const int lane = tidv & 63;
  const int d = chain & 1, g = (chain >> 1) & 63, b = chain >> 7;
  float* ub = (float*)smemw;
  float* hb = ub + 256;
  const size_t pg = (size_t)(l * 2 + d) * 64 + g;
  const float lre = p.in[28][pg * 64 + lane], lim = p.in[29][pg * 64 + lane];
  const float dt = expf(p.in[30][pg]);
  const float mag = expf(lre * dt);
  const float are = mag * cosf(lim * dt), aim = mag * sinf(lim * dt);
  const float den = lre * lre + lim * lim;
  const float qre = ((are - 1.f) * lre + aim * lim) / den;
  const float qim = (aim * lre - (are - 1.f) * lim) / den;
  float bbre[16], bbim[16];
  {
    const float* br = p.in[31] + (pg * 64 + lane) * 16;
    const float* bi = p.in[32] + (pg * 64 + lane) * 16;
#pragma unroll
    for (int i = 0; i < 16; i++) {
      float x = br[i], y = bi[i];
      bbre[i] = qre * x - qim * y;
      bbim[i] = qre * y + qim * x;
    }
  }
  float hre = 0.f, him = 0.f;
  const bf16* Z = (const bf16*)(ws + B_ZB);
  const int tt = lane >> 2, i0 = (lane & 3) * 4;
  const float* cre = p.in[33] + (pg * 16 + i0) * 64;
  const float* cim = p.in[34] + (pg * 16 + i0) * 64;
  for (int chunk = 0; chunk < 272; chunk++) {
    int row, tau, len;
    step_row(chunk * 16 + tt, d, b, row, tau, len);
    {
      uint2 u = *(const uint2*)(Z + (size_t)row * NIN + C_U + g * 16 + i0);
      float4 f;
      f.x = bf2f((bf16)(u.x & 0xffff)); f.y = bf2f((bf16)(u.x >> 16));
      f.z = bf2f((bf16)(u.y & 0xffff)); f.w = bf2f((bf16)(u.y >> 16));
      *(float4*)(ub + tt * 16 + i0) = f;
    }
    __syncthreads();
#pragma unroll 2
    for (int t = 0; t < 16; t++) {
      const float* u = ub + t * 16;
      float br0 = 0.f, bi0 = 0.f;
#pragma unroll
      for (int i = 0; i < 16; i++) { float uv = u[i]; br0 += bbre[i] * uv; bi0 += bbim[i] * uv; }
      float nr = are * hre - aim * him + br0;
      float ni = are * him + aim * hre + bi0;
      hre = nr; him = ni;
      hb[t * 132 + lane] = hre;
      hb[t * 132 + 64 + lane] = him;
    }
    __syncthreads();
    {
      float y0 = 0.f, y1 = 0.f, y2 = 0.f, y3 = 0.f;
      const float* hr = hb + tt * 132;
#pragma unroll 1
      for (int pp = 0; pp < 64; pp += 4) {
        float4 a = *(const float4*)(hr + pp), bq = *(const float4*)(hr + 64 + pp);
        float4 c0 = *(const float4*)(cre + pp), d0 = *(const float4*)(cim + pp);
        float4 c1 = *(const float4*)(cre + 64 + pp), d1 = *(const float4*)(cim + 64 + pp);
        float4 c2 = *(const float4*)(cre + 128 + pp), d2 = *(const float4*)(cim + 128 + pp);
        float4 c3 = *(const float4*)(cre + 192 + pp), d3 = *(const float4*)(cim + 192 + pp);
        y0 += c0.x * a.x + c0.y * a.y + c0.z * a.z + c0.w * a.w - d0.x * bq.x - d0.y * bq.y - d0.z * bq.z - d0.w * bq.w;
        y1 += c1.x * a.x + c1.y * a.y + c1.z * a.z + c1.w * a.w - d1.x * bq.x - d1.y * bq.y - d1.z * bq.z - d1.w * bq.w;
        y2 += c2.x * a.x + c2.y * a.y + c2.z * a.z + c2.w * a.w - d2.x * bq.x - d2.y * bq.y - d2.z * bq.z - d2.w * bq.w;
        y3 += c3.x * a.x + c3.y * a.y + c3.z * a.z + c3.w * a.w - d3.x * bq.x - d3.y * bq.y - d3.z * bq.z - d3.w * bq.w;
      }
      uint2 o;
      o.x = pack2(y0, y1);
      o.y = pack2(y2, y3);
      bf16* dst = d == 0 ? (bf16*)(ws + B_SY) + (size_t)row * 1024 + g * 16 + i0 : (bf16*)(ws + B_ZB) + (size_t)row * NIN + g * 16 + i0;
      *(uint2*)dst = o;
    }
    __syncthreads();
  }
}

DEV int perm23(int r) { return (r & 0x13) | ((r & 4) << 1) | ((r & 8) >> 1); }

DEV void attn_item(int tidv, int bidv, const Params& p, int item, bool ctxq, char* smem) {
  char* ws = p.ws;
  bf16* sK = (bf16*)smem;
  bf16* sV = sK + 64 * 200;
  const int tid = tidv, wave = tid >> 6, lane = tid & 63;
  const int r = lane & 31, hf = lane >> 5;
  int b, hd, qt;
  if (!ctxq) { b = item >> 8; hd = (item >> 5) & 7; qt = item & 31; }
  else { b = item >> 4; hd = (item >> 1) & 7; qt = item & 1; }
  const int qrow0 = ctxq ? ML + b * 256 + qt * 128 : b * 4096 + qt * 128;
  const int kt0 = ctxq ? 64 : 0, kt1 = 68;
  bf16* QB = (bf16*)(ws + B_QB);
  const bf16* KN = (const bf16*)(ws + B_KN);
  const bf16* KR = (const bf16*)(ws + B_KR);
  const bf16* VT = (const bf16*)(ws + B_VT);
  bf16x8 qf[12];
  {
    const bf16* qp = QB + (size_t)(qrow0 + wave * 32 + r) * 1536 + hd * 192 + hf * 8;
#pragma unroll
    for (int kk = 0; kk < 12; kk++) qf[kk] = *(const bf16x8*)(qp + kk * 16);
  }
  f32x16 oacc[4];
#pragma unroll
  for (int i = 0; i < 4; i++)
#pragma unroll
    for (int e = 0; e < 16; e++) oacc[i][e] = 0.f;
  float mrun = -1e30f, lrun = 0.f;
  const int pr = perm23(r);
  for (int kt = kt0; kt < kt1; kt++) {
    __syncthreads();
    const int key0 = kt * 64;
    const int rowbase = key0 < 4096 ? b * 4096 + key0 : ML + b * 256 + (key0 - 4096);
#pragma unroll
    for (int i = 0; i < 6; i++) {
      int c = tid + 256 * i;
      int kr = c / 24, cc = c - kr * 24;
      const bf16* src = cc < 16 ? KN + (size_t)(rowbase + kr) * 1024 + hd * 128 + cc * 8 : KR + (size_t)(rowbase + kr) * 64 + (cc - 16) * 8;
      *(uint4*)(sK + kr * 200 + cc * 8) = *(const uint4*)src;
    }
#pragma unroll
    for (int i = 0; i < 4; i++) {
      int c = tid + 256 * i;
      int dv = c >> 3, cc = c & 7;
      const bf16* src = VT + ((size_t)((b * 8 + hd) * 128 + dv)) * NKEY + key0 + cc * 8;
      *(uint4*)(sV + dv * 72 + cc * 8) = *(const uint4*)src;
    }
    __syncthreads();
    f32x16 sacc[2];
#pragma unroll
    for (int m = 0; m < 2; m++) {
#pragma unroll
      for (int e = 0; e < 16; e++) sacc[m][e] = 0.f;
      const bf16* kp = sK + (m * 32 + pr) * 200 + hf * 8;
#pragma unroll
      for (int kk = 0; kk < 12; kk++) {
        bf16x8 kf = *(const bf16x8*)(kp + kk * 16);
        sacc[m] = __builtin_amdgcn_mfma_f32_32x32x16_bf16(kf, qf[kk], sacc[m], 0, 0, 0);
      }
    }
    float tmax = sacc[0][0];
#pragma unroll
    for (int e = 1; e < 16; e++) tmax = fmaxf(tmax, sacc[0][e]);
#pragma unroll
    for (int e = 0; e < 16; e++) tmax = fmaxf(tmax, sacc[1][e]);
    tmax = fmaxf(tmax, __shfl_xor(tmax, 32));
    float mnew = fmaxf(mrun, tmax);
    float alpha = exp2f(mrun - mnew);
    mrun = mnew;
    float psum = 0.f;
#pragma unroll
    for (int m = 0; m < 2; m++)
#pragma unroll
      for (int e = 0; e < 16; e++) { float pv = exp2f(sacc[m][e] - mnew); sacc[m][e] = pv; psum += pv; }
    lrun = lrun * alpha + psum;
#pragma unroll
    for (int i = 0; i < 4; i++)
#pragma unroll
      for (int e = 0; e < 16; e++) oacc[i][e] *= alpha;
#pragma unroll
    for (int s = 0; s < 4; s++) {
      const int m = s >> 1, s2 = s & 1;
      bf16x8 pf;
#pragma unroll
      for (int j = 0; j < 8; j++) pf[j] = (short)f2bf(sacc[m][8 * s2 + j]);
#pragma unroll
      for (int i = 0; i < 4; i++) {
        bf16x8 vf = *(const bf16x8*)(sV + (i * 32 + r) * 72 + m * 32 + s2 * 16 + hf * 8);
        oacc[i] = __builtin_amdgcn_mfma_f32_32x32x16_bf16(vf, pf, oacc[i], 0, 0, 0);
      }
    }
  }
  lrun += __shfl_xor(lrun, 32);
  const float inv = 1.f / lrun;
  bf16* op = QB + (size_t)(qrow0 + wave * 32 + r) * 1536 + hd * 192;
#pragma unroll
  for (int i = 0; i < 4; i++)
#pragma unroll
    for (int g = 0; g < 4; g++) {
      uint2 o;
      o.x = pack2(oacc[i][4 * g] * inv, oacc[i][4 * g + 1] * inv);
      o.y = pack2(oacc[i][4 * g + 2] * inv, oacc[i][4 * g + 3] * inv);
      *(uint2*)(op + 32 * i + 8 * g + 4 * hf) = o;
    }
}

DEV void phase_mixers(int tidv, int bidv, const Params& p, int l, char* smem) {
  __shared__ int s_item;
  for (int task = bidv; task < 256; task += gridDim.x) {
#if !defined(MIX_ONLY) || MIX_ONLY == 0
    if (task < 128) rwkv_scan(tidv, bidv, p, l, task, smem);
#endif
#if !defined(MIX_ONLY) || MIX_ONLY == 1
    if (task >= 128) s5_scan(tidv, bidv, p, l, (task - 128) * 4 + (tidv >> 6), smem + (tidv >> 6) * 9472);
#endif
  }
  const int nlat = 1024, ntot = (l == 0) ? 1088 : 1024;
  int* cnt = (int*)(p.ws + B_CNT) + l;
#if !defined(MIX_ONLY) || MIX_ONLY == 2
  while (true) {
    __syncthreads();
    if (tidv == 0) s_item = atomicAdd(cnt, 1);
    __syncthreads();
    int item = s_item;
    if (item >= ntot) break;
    if (item < nlat) attn_item(tidv, bidv, p, item, false, smem);
    else attn_item(tidv, bidv, p, item - nlat, true, smem);
  }
#endif
}

DEV float gelu_tanh(float x) {
  float u = 0.7978845608028654f * (x + 0.044715f * x * x * x);
  return 0.5f * x * (1.f + tanhf(u));
}

DEV void phase_post(int tidv, int bidv, const Params& p, int l, int M) {
  char* ws = p.ws;
  const bf16* Z = (const bf16*)(ws + B_ZB);
  const int wave = tidv >> 6, lane = tidv & 63;
  const float* cw = p.in[17] + (size_t)l * 3 * 3072;
  const bf16* YF = (const bf16*)(ws + B_HB);
  const bf16* YB = (const bf16*)(ws + B_HB + SZ1K);
  const bf16* AF = (const bf16*)(ws + B_AF);
  const bf16* AB = (const bf16*)(ws + B_AB);
  bf16* GB = (bf16*)(ws + B_GB);
  const int nitem = M * 16;
  for (int it = bidv * 4 + wave; it < nitem; it += gridDim.x * 4) {
    int row = it >> 4, h = it & 15;
    int ch = h * 64 + lane;
    int tau, len;
    if (row < ML) { tau = row & 4095; len = 4096; } else { tau = (row - ML) & 255; len = 256; }
    size_t o = (size_t)row * 1024 + ch;
    float y = bf2f(YF[o]) + bf2f(YB[o]);
    float mu = wsum(y) * (1.f / 64.f);
    float dv = y - mu;
    float var = wsum(dv * dv) * (1.f / 64.f);
    float yn = dv * rsqrtf(var + 64e-5f) * p.in[26][l * 1024 + ch] + p.in[27][l * 1024 + ch];
    const bf16* z = Z + (size_t)row * NIN + C_R + ch;
    float r1 = bf2f(z[0]), k1 = bf2f(z[1024]), v1 = bf2f(z[2048]);
    float r0 = 0.f, k0 = 0.f, v0 = 0.f, r2 = 0.f, k2 = 0.f, v2 = 0.f;
    if (tau > 0) { const bf16* zm = z - NIN; r0 = bf2f(zm[0]); k0 = bf2f(zm[1024]); v0 = bf2f(zm[2048]); }
    if (tau < len - 1) { const bf16* zp = z + NIN; r2 = bf2f(zp[0]); k2 = bf2f(zp[1024]); v2 = bf2f(zp[2048]); }
    float rr = cw[ch] * r0 + cw[3072 + ch] * r1 + cw[6144 + ch] * r2;
    float kk = cw[1024 + ch] * k0 + cw[3072 + 1024 + ch] * k1 + cw[6144 + 1024 + ch] * k2;
    float vv = cw[2048 + ch] * v0 + cw[3072 + 2048 + ch] * v1 + cw[6144 + 2048 + ch] * v2;
    float am = 0.5f * (bf2f(AF[o]) + bf2f(AB[o]));
    float kbon = kk * (1.f + (am - 1.f) * p.in[24][l * 1024 + ch]);
    float s = wsum(rr * kbon * p.in[25][l * 1024 + ch]);
    float outv = (yn + s * vv) * bf2f(GB[o]);
    GB[o] = f2bf(outv);
  }
  bf16* SY = (bf16*)(ws + B_SY);
  const float* dsk = p.in[35] + l * 1024;
  const int n4 = M * 256;
  for (int i = bidv * 256 + tidv; i < n4; i += gridDim.x * 256) {
    int row = i >> 8, c = (i & 255) * 4;
    uint2 a = *(const uint2*)(SY + (size_t)row * 1024 + c);
    uint2 bq = *(const uint2*)(Z + (size_t)row * NIN + c);
    uint2 u = *(const uint2*)(Z + (size_t)row * NIN + C_U + c);
    float4 dd = *(const float4*)(dsk + c);
    float y0 = bf2f((bf16)(a.x & 0xffff)) + bf2f((bf16)(bq.x & 0xffff)) + dd.x * bf2f((bf16)(u.x & 0xffff));
    float y1 = bf2f((bf16)(a.x >> 16)) + bf2f((bf16)(bq.x >> 16)) + dd.y * bf2f((bf16)(u.x >> 16));
    float y2 = bf2f((bf16)(a.y & 0xffff)) + bf2f((bf16)(bq.y & 0xffff)) + dd.z * bf2f((bf16)(u.y & 0xffff));
    float y3 = bf2f((bf16)(a.y >> 16)) + bf2f((bf16)(bq.y >> 16)) + dd.w * bf2f((bf16)(u.y >> 16));
    uint2 o;
    o.x = pack2(gelu_tanh(y0), gelu_tanh(y1));
    o.y = pack2(gelu_tanh(y2), gelu_tanh(y3));
    *(uint2*)(SY + (size_t)row * 1024 + c) = o;
  }
}

constexpr int NPH = 25;

DEV void run_phase(int tidv, int bidv, const Params& p, int ph, char* smem) {
  char* ws = p.ws;
#ifndef ONLY_S
  if (ph == 0) {
    if (bidv == 0 && tidv < 4) ((int*)(ws + B_CNT))[tidv] = 0;
    phase_mod(tidv, bidv, p, smem);
    phase_convw(tidv, bidv, p, 0, smem);
    return;
  }
#endif
  const int l = (ph - 1) / 12, s = (ph - 1) % 12;
#ifdef ONLY_S
  if (s != ONLY_S) return;
#endif
  const bf16* wb = (const bf16*)(ws + B_WB);
  const float* mod = (const float*)(ws + B_MOD) + (size_t)l * 5 * 12288;
  float* XC = (float*)(ws + B_XC);
  const float* xin_lat = l == 0 ? p.in[0] : p.out;
  const float* xin_ctx = l == 0 ? p.in[2] : XC;
  bf16* HB = (bf16*)(ws + B_HB);
  bf16* Z = (bf16*)(ws + B_ZB);
  bf16* H2 = (bf16*)(ws + B_KN);
  const int Mpost = l == 0 ? MT : ML;
  switch (s) {
    case 0:
      if (l == 1) phase_convw(tidv, bidv, p, 1, smem);
      phase_norm(tidv, bidv, xin_lat, xin_ctx, p.in[6] + l * 2048, mod, 0, 2048, HB, MT);
      break;
    case 1:
      run_gemm<G_IN>(tidv, bidv, p, l, smem, HB, 2048, wb + OW_IN, 2048, NIN, MT, 0, nullptr, nullptr, nullptr, nullptr);
      break;
    case 2:
      run_gemm<G_UKV>(tidv, bidv, p, l, smem, Z + C_CKV, NIN, wb + OW_UKV, 512, 2048, MT, 0, nullptr, nullptr, nullptr, nullptr);
      run_gemm<G_UQ>(tidv, bidv, p, l, smem, Z + C_CQ, NIN, wb + OW_UQ, 512, 1536, MT, 0, nullptr, nullptr, nullptr, nullptr);
      run_gemm<G_G2>(tidv, bidv, p, l, smem, Z + C_GD, NIN, wb + OW_G2, 160, 1024, MT, 0, nullptr, nullptr, nullptr, nullptr);
      for (int d = 0; d < 2; d++) {
        run_gemm<G_W2>(tidv, bidv, p, l, smem, Z + C_WD + 64 * d, NIN, wb + OW_W2 + (size_t)d * 65536, 64, 1024, MT, d, nullptr, nullptr, nullptr, nullptr);
        run_gemm<G_A2>(tidv, bidv, p, l, smem, Z + C_AD + 64 * d, NIN, wb + OW_A2 + (size_t)d * 65536, 64, 1024, MT, d, nullptr, nullptr, nullptr, nullptr);
      }
      break;
    case 3: phase_mla_post(tidv, bidv, p, l); break;
    case 4: phase_mixers(tidv, bidv, p, l, smem); break;
    case 5: phase_post(tidv, bidv, p, l, Mpost); break;
    case 6:
      run_gemm<G_GLU>(tidv, bidv, p, l, smem, (const bf16*)(ws + B_SY), 1024, wb + OW_GLU, 1024, 1024, Mpost, 0, nullptr, nullptr, nullptr, nullptr);
      break;
    case 7: phase_merge(tidv, bidv, p, smem, Mpost); break;
    case 8:
      run_gemm<G_OUT>(tidv, bidv, p, l, smem, HB, 2048, wb + OW_OUT, 2048, 2048, Mpost, 0, xin_lat, xin_ctx, p.out, XC);
      break;
    case 9:
      phase_norm(tidv, bidv, p.out, XC, p.in[7] + l * 2048, mod, 6144, 8192, H2, Mpost);
      break;
    case 10:
      run_gemm<G_M1>(tidv, bidv, p, l, smem, H2, 2048, wb + OW_M1, 2048, 8192, Mpost, 0, nullptr, nullptr, nullptr, nullptr);
      break;
    case 11:
      run_gemm<G_M2>(tidv, bidv, p, l, smem, Z, 8192, wb + OW_M2, 8192, 2048, Mpost, 0, nullptr, nullptr, p.out, XC);
      break;
  }
}

__global__ void __launch_bounds__(256, 1) fwd_megakernel(Params p, int ph0, int ph1) {
  __shared__ __attribute__((aligned(16))) char smem[46080];
  for (int ph = ph0; ph < ph1; ph++) {
    int tidv = threadIdx.x, bidv = blockIdx.x;
    asm volatile("" : "+v"(tidv));
    asm volatile("" : "+s"(bidv));
    run_phase(tidv, bidv, p, ph, smem);
    if (ph + 1 < ph1) cg::this_grid().sync();
  }
}

extern "C" void kernel_launch(void* const* d_in, const int* in_sizes, int n_in, void* d_out, int out_size, void* d_ws, size_t ws_size,
                              hipStream_t stream) {
  static int grid_blocks = 0;
  if (!grid_blocks) {
    int dev = 0, cus = 0, per_cu = 0;
    hipGetDevice(&dev);
    hipDeviceGetAttribute(&cus, hipDeviceAttributeMultiprocessorCount, dev);
    hipOccupancyMaxActiveBlocksPerMultiprocessor(&per_cu, fwd_megakernel, 256, 0);
    if (per_cu < 1) per_cu = 1;
    if (per_cu > 2) per_cu = 2;
    grid_blocks = cus * per_cu;
  }
  Params p{};
  for (int i = 0; i < 42; i++) p.in[i] = (const float*)d_in[i];
  p.out = (float*)d_out;
  p.ws = (char*)d_ws;
  if (ws_size < B_END) { fprintf(stderr, "workspace too small\n"); return; }
#if MULTI_LAUNCH
  for (int ph = 0; ph < NPH; ph++) {
    hipLaunchKernelGGL(fwd_megakernel, dim3(grid_blocks), dim3(256), 0, stream, p, ph, ph + 1);
  }
#else
  int ph0 = 0, ph1 = NPH;
  void* args[] = {&p, &ph0, &ph1};
  hipError_t e = hipLaunchCooperativeKernel((void*)fwd_megakernel, dim3(grid_blocks), dim3(256), args, 0, stream);
  if (e != hipSuccess) fprintf(stderr, "cooperative launch failed: %s (grid %d)\n", hipGetErrorString(e), grid_blocks);
#endif
}
```

```cpp
#include <hip/hip_runtime.h>
#include <hip/hip_cooperative_groups.h>
#include <stdint.h>
#include <cstdio>
namespace cg = cooperative_groups;

#ifndef MULTI_LAUNCH
#define MULTI_LAUNCH 0
#endif

typedef unsigned short bf16;
using bf16x8 = __attribute__((ext_vector_type(8))) short;
using f32x4 = __attribute__((ext_vector_type(4))) float;
using f32x16 = __attribute__((ext_vector_type(16))) float;

#define DEV __device__ __forceinline__

constexpr int DM = 2048, ML = 16384, MC = 1024, MT = 17408, NIN = 11744, DFF = 8192, NKEY = 4352;
constexpr int C_CQ = 0, C_CKV = 512, C_KR = 1024, C_R = 1088, C_WD = 4160, C_AD = 4288, C_GD = 4416, C_U = 4576, C_GATE = 5600;

constexpr size_t OW_IN = 0;
constexpr size_t OW_UQ = OW_IN + (size_t)NIN * 2048;
constexpr size_t OW_UKV = OW_UQ + 1536 * 512;
constexpr size_t OW_W2 = OW_UKV + 2048 * 512;
constexpr size_t OW_A2 = OW_W2 + 2 * 1024 * 64;
constexpr size_t OW_G2 = OW_A2 + 2 * 1024 * 64;
constexpr size_t OW_GLU = OW_G2 + 1024 * 160;
constexpr size_t OW_BR = OW_GLU + 1024 * 1024;
constexpr size_t OW_OUT = OW_BR + (size_t)3 * 2048 * 1024;
constexpr size_t OW_M1 = OW_OUT + (size_t)2048 * 2048;
constexpr size_t OW_M2 = OW_M1 + (size_t)8192 * 2048;
constexpr size_t OW_END = OW_M2 + (size_t)8192 * 2048;

constexpr size_t SZ1K = (size_t)MT * 1024 * 2;
constexpr size_t B_WB = 0;
constexpr size_t B_HB = B_WB + OW_END * 2;
constexpr size_t B_ZB = B_HB + (size_t)MT * 2048 * 2;
constexpr size_t B_QB = B_ZB + (size_t)MT * NIN * 2;
constexpr size_t B_KN = B_QB + (size_t)MT * 1536 * 2;
constexpr size_t B_VT = B_KN + SZ1K;
constexpr size_t B_KR = B_VT + SZ1K;
constexpr size_t B_AF = B_KR + (size_t)MT * 64 * 2;
constexpr size_t B_AB = B_AF + SZ1K;
constexpr size_t B_GB = B_AB + SZ1K;
constexpr size_t B_SY = B_GB + SZ1K;
constexpr size_t B_XC = B_SY + SZ1K;
constexpr size_t B_MOD = B_XC + (size_t)MC * 2048 * 4;
constexpr size_t B_CNT = B_MOD + (size_t)2 * 5 * 12288 * 4;
constexpr size_t B_END = B_CNT + 256;

struct Params {
  const float* in[42];
  float* out;
  char* ws;
};

typedef __attribute__((ext_vector_type(2))) __bf16 hbf2;
DEV bf16 f2bf(float f) {
  __bf16 h = (__bf16)f;
  return *(unsigned short*)&h;
}
DEV float bf2f(bf16 h) { return __uint_as_float(((uint32_t)h) << 16); }
DEV uint32_t pack2(float a, float b) {
  hbf2 v;
  v[0] = (__bf16)a;
  v[1] = (__bf16)b;
  return *(uint32_t*)&v;
}
DEV float wsum(float v) {
#pragma unroll
  for (int o = 32; o > 0; o >>= 1) v += __shfl_xor(v, o);
  return v;
}
DEV float sigmoidf_(float x) { return 1.f / (1.f + __expf(-x)); }

DEV void phase_mod(int tidv, int bidv, const Params& p, char* smem) {
  float* s_in = (float*)smem;
  float* red = s_in + 5 * 2048;
  float* mod = (float*)(p.ws + B_MOD);
  for (int i = tidv; i < 5 * 2048; i += 256) {
    int r = i >> 11, k = i & 2047;
    float v = r < 4 ? p.in[1][r * 2048 + k] : p.in[3][k];
    s_in[i] = v / (1.f + expf(-v));
  }
  __syncthreads();
  int kg = tidv >> 6, c = tidv & 63;
  for (int task = bidv; task < 2 * 192; task += gridDim.x) {
    int l = task / 192, n = (task % 192) * 64 + c;
    const float* w = p.in[4] + (size_t)l * 2048 * 12288 + n;
    float a0 = 0, a1 = 0, a2 = 0, a3 = 0, a4 = 0;
    int kb = kg * 512;
#pragma unroll 8
    for (int k = 0; k < 512; k++) {
      float wv = w[(size_t)(kb + k) * 12288];
      a0 += s_in[kb + k] * wv;
      a1 += s_in[2048 + kb + k] * wv;
      a2 += s_in[4096 + kb + k] * wv;
      a3 += s_in[6144 + kb + k] * wv;
      a4 += s_in[8192 + kb + k] * wv;
    }
    red[(kg * 5 + 0) * 64 + c] = a0;
    red[(kg * 5 + 1) * 64 + c] = a1;
    red[(kg * 5 + 2) * 64 + c] = a2;
    red[(kg * 5 + 3) * 64 + c] = a3;
    red[(kg * 5 + 4) * 64 + c] = a4;
    __syncthreads();
    if (kg == 0) {
      float bias = p.in[5][l * 12288 + n];
#pragma unroll
      for (int r = 0; r < 5; r++) {
        float v = red[(0 * 5 + r) * 64 + c] + red[(1 * 5 + r) * 64 + c] + red[(2 * 5 + r) * 64 + c] + red[(3 * 5 + r) * 64 + c];
        mod[(size_t)(l * 5 + r) * 12288 + n] = v + bias;
      }
    }
    __syncthreads();
  }
}

DEV void convT(int tidv, int bidv, const float* __restrict__ src, bf16* __restrict__ dst, int K, int N, const float* __restrict__ gain, char* smem) {
  float* t = (float*)smem;
  int tk = (K + 63) >> 6, tn = (N + 63) >> 6;
  for (int tile = bidv; tile < tk * tn; tile += gridDim.x) {
    int k0 = (tile / tn) * 64, n0 = (tile % tn) * 64;
    __syncthreads();
#pragma unroll 4
    for (int i = 0; i < 16; i++) {
      int kk = i * 4 + (tidv >> 6), nn = tidv & 63;
      float v = 0.f;
      if (k0 + kk < K && n0 + nn < N) {
        v = src[(size_t)(k0 + kk) * N + n0 + nn];
        if (gain) v *= gain[k0 + kk];
      }
      t[kk * 65 + nn] = v;
    }
    __syncthreads();
#pragma unroll
    for (int i = 0; i < 2; i++) {
      int c = tidv + 256 * i;
      int nn = c >> 3, kc = c & 7;
      if (n0 + nn < N && k0 + kc * 8 < K) {
        uint4 o;
        o.x = pack2(t[(kc * 8 + 0) * 65 + nn], t[(kc * 8 + 1) * 65 + nn]);
        o.y = pack2(t[(kc * 8 + 2) * 65 + nn], t[(kc * 8 + 3) * 65 + nn]);
        o.z = pack2(t[(kc * 8 + 4) * 65 + nn], t[(kc * 8 + 5) * 65 + nn]);
        o.w = pack2(t[(kc * 8 + 6) * 65 + nn], t[(kc * 8 + 7) * 65 + nn]);
        *(uint4*)(dst + (size_t)(n0 + nn) * K + k0 + kc * 8) = o;
      }
    }
  }
}

DEV void phase_convw(int tidv, int bidv, const Params& p, int l, char* smem) {
  bf16* wb = (bf16*)(p.ws + B_WB);
  convT(tidv, bidv, p.in[8] + (size_t)l * 2048 * NIN, wb + OW_IN, 2048, NIN, nullptr, smem);
  convT(tidv, bidv, p.in[40] + (size_t)l * 2048 * 8192, wb + OW_M1, 2048, 8192, nullptr, smem);
  convT(tidv, bidv, p.in[41] + (size_t)l * 8192 * 2048, wb + OW_M2, 8192, 2048, nullptr, smem);
  for (int n = 0; n < 3; n++)
    convT(tidv, bidv, p.in[38] + (size_t)(l * 3 + n) * 1024 * 2048, wb + OW_BR + (size_t)n * 2048 * 1024, 1024, 2048, nullptr, smem);
  convT(tidv, bidv, p.in[39] + (size_t)l * 2048 * 2048, wb + OW_OUT, 2048, 2048, nullptr, smem);
  convT(tidv, bidv, p.in[11] + (size_t)l * 512 * 1536, wb + OW_UQ, 512, 1536, p.in[9] + l * 512, smem);
  convT(tidv, bidv, p.in[12] + (size_t)l * 512 * 2048, wb + OW_UKV, 512, 2048, p.in[10] + l * 512, smem);
  convT(tidv, bidv, p.in[36] + (size_t)l * 1024 * 1024, wb + OW_GLU, 1024, 1024, nullptr, smem);
  for (int d = 0; d < 2; d++) {
    convT(tidv, bidv, p.in[19] + (size_t)(l * 2 + d) * 64 * 1024, wb + OW_W2 + (size_t)d * 65536, 64, 1024, nullptr, smem);
    convT(tidv, bidv, p.in[21] + (size_t)(l * 2 + d) * 64 * 1024, wb + OW_A2 + (size_t)d * 65536, 64, 1024, nullptr, smem);
  }
  convT(tidv, bidv, p.in[22] + (size_t)l * 160 * 1024, wb + OW_G2, 160, 1024, nullptr, smem);
}

DEV void phase_norm(int tidv, int bidv, const float* xlat, const float* xctx, const float* g, const float* mod, int shOff, int scOff, bf16* H, int nrows) {
  int wave = tidv >> 6, lane = tidv & 63;
  for (int row = bidv * 4 + wave; row < nrows; row += gridDim.x * 4) {
    const float* x = row < ML ? xlat + (size_t)row * 2048 : xctx + (size_t)(row - ML) * 2048;
    int b = row < ML ? (row >> 12) : 4;
    const float* sh = mod + b * 12288 + shOff;
    const float* sc = mod + b * 12288 + scOff;
    float4 v[8];
    float ss = 0.f;
#pragma unroll
    for (int i = 0; i < 8; i++) {
      v[i] = *(const float4*)(x + i * 256 + lane * 4);
      ss += v[i].x * v[i].x + v[i].y * v[i].y + v[i].z * v[i].z + v[i].w * v[i].w;
    }
    ss = wsum(ss);
    float rinv = rsqrtf(ss * (1.f / 2048.f) + 1e-6f);
#pragma unroll
    for (int i = 0; i < 8; i++) {
      int c = i * 256 + lane * 4;
      float4 g4 = *(const float4*)(g + c), s4 = *(const float4*)(sc + c), h4 = *(const float4*)(sh + c);
      float y0 = v[i].x * rinv * g4.x * (1.f + s4.x) + h4.x;
      float y1 = v[i].y * rinv * g4.y * (1.f + s4.y) + h4.y;
      float y2 = v[i].z * rinv * g4.z * (1.f + s4.z) + h4.z;
      float y3 = v[i].w * rinv * g4.w * (1.f + s4.w) + h4.w;
      uint2 o;
      o.x = pack2(y0, y1);
      o.y = pack2(y2, y3);
      *(uint2*)(H + (size_t)row * 2048 + c) = o;
    }
  }
}

constexpr int LDT = 40;
DEV float sumsq8(uint4 r) {
  float s = 0.f, x;
  x = bf2f((bf16)(r.x & 0xffff)); s += x * x; x = bf2f((bf16)(r.x >> 16)); s += x * x;
  x = bf2f((bf16)(r.y & 0xffff)); s += x * x; x = bf2f((bf16)(r.y >> 16)); s += x * x;
  x = bf2f((bf16)(r.z & 0xffff)); s += x * x; x = bf2f((bf16)(r.z >> 16)); s += x * x;
  x = bf2f((bf16)(r.w & 0xffff)); s += x * x; x = bf2f((bf16)(r.w >> 16)); s += x * x;
  return s;
}

template <bool ROWNORM>
DEV void gemm_mainloop(int tidv, int bidv, const bf16* __restrict__ A, int lda, bool amap, const bf16* __restrict__ Bt, int K, int N, int m0, int n0,
                       char* smem, f32x4 (&acc)[4][4]) {
  bf16* sa = (bf16*)smem;
  bf16* sb = sa + 128 * LDT;
  float* srinv = (float*)(sb + 128 * LDT);
  const int tid = tidv, lane = tid & 63, wave = tid >> 6;
  const int wm = wave >> 1, wn = wave & 1;
  const int lr = tid >> 2, kc = tid & 3;
  const bf16* pa0 = A + (size_t)(m0 + lr) * lda + kc * 8;
  const bf16* pa1 = pa0 + (size_t)64 * lda;
  int nr0 = n0 + lr; if (nr0 > N - 1) nr0 = N - 1;
  int nr1 = n0 + lr + 64; if (nr1 > N - 1) nr1 = N - 1;
  const bf16* pb0 = Bt + (size_t)nr0 * K + kc * 8;
  const bf16* pb1 = Bt + (size_t)nr1 * K + kc * 8;
  const int nk = K >> 5;
  uint4 ra0, ra1, rb0, rb1;
  float ss0 = 0.f, ss1 = 0.f;
  {
    ra0 = *(const uint4*)(pa0);
    ra1 = *(const uint4*)(pa1);
    rb0 = *(const uint4*)(pb0);
    rb1 = *(const uint4*)(pb1);
  }
  for (int kt = 0; kt < nk; kt++) {
    __syncthreads();
    *(uint4*)(sa + lr * LDT + kc * 8) = ra0;
    *(uint4*)(sa + (lr + 64) * LDT + kc * 8) = ra1;
    *(uint4*)(sb + lr * LDT + kc * 8) = rb0;
    *(uint4*)(sb + (lr + 64) * LDT + kc * 8) = rb1;
    if (ROWNORM) { ss0 += sumsq8(ra0); ss1 += sumsq8(ra1); }
    __syncthreads();
    if (kt + 1 < nk) {
      int k0 = (kt + 1) << 5;
      int ka = amap ? ((k0 >> 7) * 192 + (k0 & 127)) : k0;
      ra0 = *(const uint4*)(pa0 + ka);
      ra1 = *(const uint4*)(pa1 + ka);
      rb0 = *(const uint4*)(pb0 + k0);
      rb1 = *(const uint4*)(pb1 + k0);
    }
    bf16x8 af[4], bfr[4];
#pragma unroll
    for (int i = 0; i < 4; i++) af[i] = *(const bf16x8*)(sa + (wm * 64 + i * 16 + (lane & 15)) * LDT + (lane >> 4) * 8);
#pragma unroll
    for (int j = 0; j < 4; j++) bfr[j] = *(const bf16x8*)(sb + (wn * 64 + j * 16 + (lane & 15)) * LDT + (lane >> 4) * 8);
#pragma unroll
    for (int i = 0; i < 4; i++)
#pragma unroll
      for (int j = 0; j < 4; j++) acc[i][j] = __builtin_amdgcn_mfma_f32_16x16x32_bf16(af[i], bfr[j], acc[i][j], 0, 0, 0);
  }
  if (ROWNORM) {
    ss0 += __shfl_xor(ss0, 1); ss0 += __shfl_xor(ss0, 2);
    ss1 += __shfl_xor(ss1, 1); ss1 += __shfl_xor(ss1, 2);
    __syncthreads();
    if (kc == 0) {
      srinv[lr] = rsqrtf(ss0 / (float)K + 1e-6f);
      srinv[lr + 64] = rsqrtf(ss1 / (float)K + 1e-6f);
    }
    __syncthreads();
  }
}

DEV void zero_acc(f32x4 (&acc)[4][4]) {
#pragma unroll
  for (int i = 0; i < 4; i++)
#pragma unroll
    for (int j = 0; j < 4; j++) acc[i][j] = f32x4{0.f, 0.f, 0.f, 0.f};
}

template <class F>
DEV void epi_loop(int tidv, int bidv, f32x4 (&acc)[4][4], int m0, int n0, int N, F f) {
  const int lane = tidv & 63, wave = tidv >> 6;
  const int wm = wave >> 1, wn = wave & 1;
#pragma unroll
  for (int i = 0; i < 4; i++)
#pragma unroll
    for (int j = 0; j < 4; j++) {
      int col = n0 + wn * 64 + j * 16 + (lane & 15);
      if (col < N) {
#pragma unroll
        for (int r = 0; r < 4; r++) {
          int lrow = wm * 64 + i * 16 + (lane >> 4) * 4 + r;
          f(m0 + lrow, lrow, col, acc[i][j][r], i, j, r);
        }
      }
      __builtin_amdgcn_sched_barrier(0);
    }
}

enum { G_IN = 0, G_UQ, G_UKV, G_W2, G_A2, G_G2, G_GLU, G_OUT, G_M1, G_M2, G_MG0, G_MG1, G_MG2 };

template <int MODE>
DEV void run_gemm(int tidv, int bidv, const Params& p, int l, char* smem, const bf16* A, int lda, const bf16* Bt, int K, int N, int M, int aux,
                  const float* xin_lat, const float* xin_ctx, float* xout_lat, float* xout_ctx) {
  const int nt = (N + 127) >> 7, mt = M >> 7;
  char* ws = p.ws;
  bf16* Z = (bf16*)(ws + B_ZB);
  const float* srinv = (const float*)(smem + 2 * 128 * LDT * 2);
  const float* mod = (const float*)(ws + B_MOD) + (size_t)l * 5 * 12288;
  for (int tile = bidv; tile < nt * mt; tile += gridDim.x) {
    int m0 = (tile / nt) << 7, n0 = (tile % nt) << 7;
    f32x4 acc[4][4];
    zero_acc(acc);
    gemm_mainloop<(MODE == G_UQ || MODE == G_UKV)>(tidv, bidv, A, lda, MODE == G_MG0, Bt, K, N, m0, n0, smem, acc);
    epi_loop(tidv, bidv, acc, m0, n0, N, [&](int row, int lrow, int col, float v, int, int, int) {
      if constexpr (MODE == G_IN) {
        float o = v;
        if (col >= C_GATE) o = sigmoidf_(v);
        else if (col >= C_WD && col < C_AD) o = tanhf(v);
        else if (col >= C_GD && col < C_U) o = sigmoidf_(v);
        Z[(size_t)row * NIN + col] = f2bf(o);
      } else if constexpr (MODE == G_UQ) {
        ((bf16*)(ws + B_QB))[(size_t)row * 1536 + col] = f2bf(v * srinv[lrow]);
      } else if constexpr (MODE == G_UKV) {
        float o = v * srinv[lrow];
        int h = col >> 8, c = col & 255;
        if (c < 128) {
          ((bf16*)(ws + B_KN))[(size_t)row * 1024 + h * 128 + c] = f2bf(o);
        } else {
          int b, kp;
          if (row < ML) { b = row >> 12; kp = row & 4095; } else { int r2 = row - ML; b = r2 >> 8; kp = 4096 + (r2 & 255); }
          ((bf16*)(ws + B_VT))[((size_t)((b * 8 + h) * 128 + (c - 128))) * NKEY + kp] = f2bf(o);
        }
      } else if constexpr (MODE == G_W2) {
        float x = p.in[18][(l * 2 + aux) * 1024 + col] + v;
        float e = 0.60653066f * sigmoidf_(x);
        ((bf16*)(ws + B_HB + (size_t)aux * SZ1K))[(size_t)row * 1024 + col] = f2bf(e);
      } else if constexpr (MODE == G_A2) {
        float a = sigmoidf_(p.in[20][(l * 2 + aux) * 1024 + col] + v);
        ((bf16*)(ws + (aux ? B_AB : B_AF)))[(size_t)row * 1024 + col] = f2bf(a);
      } else if constexpr (MODE == G_G2) {
        ((bf16*)(ws + B_GB))[(size_t)row * 1024 + col] = f2bf(v);
      } else if constexpr (MODE == G_GLU) {
        float zz = bf2f(((const bf16*)(ws + B_SY))[(size_t)row * 1024 + col]);
        float o = zz * sigmoidf_(v + p.in[37][l * 1024 + col]);
        Z[(size_t)row * NIN + col] = f2bf(o);
      } else if constexpr (MODE == G_OUT) {
        int b = row < ML ? (row >> 12) : 4;
        float g = mod[b * 12288 + 4096 + col];
        const float* xi = row < ML ? xin_lat + (size_t)row * 2048 : xin_ctx + (size_t)(row - ML) * 2048;
        float* xo = row < ML ? xout_lat + (size_t)row * 2048 : xout_ctx + (size_t)(row - ML) * 2048;
        xo[col] = xi[col] + g * v;
      } else if constexpr (MODE == G_M1) {
        float r = fmaxf(v, 0.f);
        Z[(size_t)row * DFF + col] = f2bf(r * r);
      } else if constexpr (MODE == G_MG0 || MODE == G_MG1 || MODE == G_MG2) {
        constexpr int nb = MODE - G_MG0;
        bf16* MG = (bf16*)(ws + B_HB);
        float g = bf2f(Z[(size_t)row * NIN + C_GATE + nb * 2048 + col]);
        float prev = 0.f;
        if constexpr (nb > 0) prev = bf2f(MG[(size_t)row * 2048 + col]);
        MG[(size_t)row * 2048 + col] = f2bf(prev + g * v);
      } else if constexpr (MODE == G_M2) {
        int b = row < ML ? (row >> 12) : 4;
        float g = mod[b * 12288 + 10240 + col];
        float* xo = row < ML ? xout_lat + (size_t)row * 2048 : xout_ctx + (size_t)(row - ML) * 2048;
        xo[col] = xo[col] + g * v;
      }
    });
  }
}

DEV void phase_mla_post(int tidv, int bidv, const Params& p, int l) {
  char* ws = p.ws;
  const float* qng = p.in[13] + l * 128;
  const float* qrg = p.in[14] + l * 64;
  const float* kng = p.in[15] + l * 128;
  const float* krg = p.in[16] + l * 64;
  bf16* QB = (bf16*)(ws + B_QB);
  bf16* KN = (bf16*)(ws + B_KN);
  bf16* KR = (bf16*)(ws + B_KR);
  const bf16* Z = (const bf16*)(ws + B_ZB);
  const int wave = tidv >> 6, lane = tidv & 63;
  const float QS = 1.4426950408889634f * 0.07216878364870322f;
  const int idx = lane & 31;
  const float inv = powf(10000.f, -(float)(idx & 15) / 16.f);
  const float gq0 = qng[2 * lane], gq1 = qng[2 * lane + 1], gk0 = kng[2 * lane], gk1 = kng[2 * lane + 1];
  const float gqr = qrg[lane], gkr = krg[lane];
  for (int row = bidv * 4 + wave; row < MT; row += gridDim.x * 4) {
    bool lat = row < ML;
    int t = row & 4095;
    float pos = (idx < 16) ? (float)(t >> 6) : (float)(t & 63);
    float ang = pos * inv;
    float cs = 1.f, sn = 0.f;
    if (lat) { cs = cosf(ang); sn = sinf(ang); }
#pragma unroll 1
    for (int h = 0; h < 8; h++) {
      bf16* q = QB + (size_t)row * 1536 + h * 192;
      uint32_t u = *(const uint32_t*)(q + 2 * lane);
      float x0 = bf2f((bf16)(u & 0xffff)), x1 = bf2f((bf16)(u >> 16));
      float ss = wsum(x0 * x0 + x1 * x1);
      float rinv = rsqrtf(ss * (1.f / 128.f) + 1e-6f) * QS;
      *(uint32_t*)(q + 2 * lane) = pack2(x0 * rinv * gq0, x1 * rinv * gq1);
      float xr = bf2f(q[128 + lane]);
      float ss2 = wsum(xr * xr);
      float y = xr * rsqrtf(ss2 * (1.f / 64.f) + 1e-6f) * gqr;
      float yp = __shfl_xor(y, 32);
      float o = lane < 32 ? (y * cs - yp * sn) : (yp * sn + y * cs);
      q[128 + lane] = f2bf(o * QS);
      bf16* k = KN + (size_t)row * 1024 + h * 128;
      uint32_t uk = *(const uint32_t*)(k + 2 * lane);
      float k0 = bf2f((bf16)(uk & 0xffff)), k1 = bf2f((bf16)(uk >> 16));
      float ssk = wsum(k0 * k0 + k1 * k1);
      float rk = rsqrtf(ssk * (1.f / 128.f) + 1e-6f);
      *(uint32_t*)(k + 2 * lane) = pack2(k0 * rk * gk0, k1 * rk * gk1);
    }
    {
      float xr = bf2f(Z[(size_t)row * NIN + C_KR + lane]);
      float ss2 = wsum(xr * xr);
      float y = xr * rsqrtf(ss2 * (1.f / 64.f) + 1e-6f) * gkr;
      float yp = __shfl_xor(y, 32);
      float o = lane < 32 ? (y * cs - yp * sn) : (yp * sn + y * cs);
      KR[(size_t)row * 64 + lane] = f2bf(o);
    }
  }
}

DEV void step_row(int s, int d, int b, int& row, int& tau, int& len) {
  if (s < 256) { tau = d ? 255 - s : s; len = 256; row = ML + b * 256 + tau; }
  else { int q = s - 256; tau = d ? 4095 - q : q; len = 4096; row = b * 4096 + tau; }
}

struct RwPre { bf16 r0, r1, r2, k0, k1, k2, v0, v1, v2, a, e; };

DEV void rwkv_fetch(RwPre& q, const bf16* Z, const bf16* AD, const bf16* ED, int s, int d, int b, int ch) {
  int row, tau, len;
  step_row(s, d, b, row, tau, len);
  const bf16* z = Z + (size_t)row * NIN + C_R + ch;
  q.r1 = z[0]; q.k1 = z[1024]; q.v1 = z[2048];
  q.r0 = 0; q.k0 = 0; q.v0 = 0; q.r2 = 0; q.k2 = 0; q.v2 = 0;
  if (tau > 0) { const bf16* zm = z - NIN; q.r0 = zm[0]; q.k0 = zm[1024]; q.v0 = zm[2048]; }
  if (tau < len - 1) { const bf16* zp = z + NIN; q.r2 = zp[0]; q.k2 = zp[1024]; q.v2 = zp[2048]; }
  q.a = AD[(size_t)row * 1024 + ch];
  q.e = ED[(size_t)row * 1024 + ch];
}

DEV void rwkv_scan(int tidv, int bidv, const Params& p, int l, int chain, char* smem, int dry) {
  char* ws = p.ws;
  float* op = (float*)smem;
  float* vb = op + 16 * 320;
  float* yb = vb + 16 * 64;
  const int tid = tidv, wave = tid >> 6, lane = tid & 63;
  const int d = chain & 1, h = (chain >> 1) & 15, b = chain >> 5;
  const int ch = h * 64 + lane;
  const float* cw = p.in[17] + (size_t)l * 3 * 3072;
  const float cr0 = cw[ch], cr1 = cw[3072 + ch], cr2 = cw[6144 + ch];
  const float ck0 = cw[1024 + ch], ck1 = cw[3072 + 1024 + ch], ck2 = cw[6144 + 1024 + ch];
  const float cv0 = cw[2048 + ch], cv1 = cw[3072 + 2048 + ch], cv2 = cw[6144 + 2048 + ch];
  const float kkc = p.in[23][l * 1024 + ch], kac = p.in[24][l * 1024 + ch];
  const bf16* Z = (const bf16*)(ws + B_ZB);
  bf16* ED = (bf16*)(ws + B_HB + (size_t)d * SZ1K);
  const bf16* AD = (const bf16*)(ws + (d ? B_AB : B_AF));
  float S[16];
#pragma unroll
  for (int j = 0; j < 16; j++) S[j] = 0.f;
  const int ri = lane >> 2, jq = lane & 3, irow = wave * 16 + ri;
  RwPre pre[4];
#pragma unroll
  for (int si = 0; si < 4; si++) rwkv_fetch(pre[si], Z, AD, ED, wave * 4 + si, d, b, ch);
  for (int chunk = 0; chunk < 272; chunk++) {
#pragma unroll
    for (int si = 0; si < 4; si++) {
      int t = wave * 4 + si;
      const RwPre& q = pre[si];
      float rr = cr0 * bf2f(q.r0) + cr1 * bf2f(q.r1) + cr2 * bf2f(q.r2);
      float kk_ = ck0 * bf2f(q.k0) + ck1 * bf2f(q.k1) + ck2 * bf2f(q.k2);
      float vv = cv0 * bf2f(q.v0) + cv1 * bf2f(q.v1) + cv2 * bf2f(q.v2);
      float kkv = kk_ * kkc;
      float ssq = wsum(kkv * kkv);
      float kn = kkv * rsqrtf(ssq + 1e-12f);
      float a = bf2f(q.a);
      float w = __expf(-bf2f(q.e));
      float krep = kk_ * (1.f + (a - 1.f) * kac);
      float* o = op + t * 320;
      o[lane] = w;
      o[64 + lane] = kn * a;
      o[128 + lane] = krep;
      o[192 + lane] = -kn;
      o[256 + lane] = rr;
      vb[t * 64 + lane] = vv;
    }
    __syncthreads();
    if (chunk + 1 < 272) {
#pragma unroll
      for (int si = 0; si < 4; si++) rwkv_fetch(pre[si], Z, AD, ED, (chunk + 1) * 16 + wave * 4 + si, d, b, ch);
    }
#pragma unroll 2
    for (int t = 0; t < 16; t++) {
      const float* o = op + t * 320 + jq * 16;
      float sa0 = 0.f, sa1 = 0.f;
#pragma unroll
      for (int j = 0; j < 16; j += 2) { sa0 += S[j] * o[192 + j]; sa1 += S[j + 1] * o[192 + j + 1]; }
      float sa = sa0 + sa1;
      sa += __shfl_xor(sa, 1);
      sa += __shfl_xor(sa, 2);
      float vi = vb[t * 64 + irow];
      float y0 = 0.f, y1 = 0.f;
#pragma unroll
      for (int j = 0; j < 16; j += 2) {
        S[j] = S[j] * o[j] + sa * o[64 + j] + vi * o[128 + j];
        S[j + 1] = S[j + 1] * o[j + 1] + sa * o[64 + j + 1] + vi * o[128 + j + 1];
        y0 += S[j] * o[256 + j];
        y1 += S[j + 1] * o[256 + j + 1];
      }
      float y = y0 + y1;
      y += __shfl_xor(y, 1);
      y += __shfl_xor(y, 2);
      if (jq == 0) yb[t * 64 + irow] = y;
    }
    __syncthreads();
#pragma unroll
    for (int it = 0; it < 4; it++) {
      int t = it * 4 + wave;
      int row, tau, len;
      step_row(chunk * 16 + t, d, b, row, tau, len);
      bf16* yd = dry ? (bf16*)(ws + B_END) + (((size_t)row * 1024 + h * 64 + lane) & 0x3fffff) : ED + (size_t)row * 1024 + h * 64 + lane;
      *yd = f2bf(yb[t * 64 + lane]);
    }
  }
}

DEV void s5_scan(int tidv, int bidv, const Params& p, int l, int chain, char* smemw, int dry) {
  char* ws = p.ws;
  const int lane = tidv & 63;
  const int d = chain & 1, g = (chain >> 1) & 63, b = chain >> 7;
  float* ub = (float*)smemw;
  float* hb = ub + 256;
  const size_t pg = (size_t)(l * 2 + d) * 64 + g;
  const float lre = p.in[28][pg * 64 + lane], lim = p.in[29][pg * 64 + lane];
  const float dt = expf(p.in[30][pg]);
  const float mag = expf(lre * dt);
  const float are = mag * cosf(lim * dt), aim = mag * sinf(lim * dt);
  const float den = lre * lre + lim * lim;
  const float qre = ((are - 1.f) * lre + aim * lim) / den;
  const float qim = (aim * lre - (are - 1.f) * lim) / den;
  float bbre[16], bbim[16];
  {
    const float* br = p.in[31] + (pg * 64 + lane) * 16;
    const float* bi = p.in[32] + (pg * 64 + lane) * 16;
#pragma unroll
    for (int i = 0; i < 16; i++) {
      float x = br[i], y = bi[i];
      bbre[i] = qre * x - qim * y;
      bbim[i] = qre * y + qim * x;
    }
  }
  bf16x8 cfr[4];
  {
    const int i = lane & 15, quad = lane >> 4;
    const float* cre = p.in[33] + (pg * 16 + i) * 64;
    const float* cim = p.in[34] + (pg * 16 + i) * 64;
#pragma unroll
    for (int ks = 0; ks < 4; ks++)
#pragma unroll
      for (int j = 0; j < 8; j++) {
        int k = ks * 32 + quad * 8 + j;
        float c = ks < 2 ? cre[k] : -cim[k - 64];
        cfr[ks][j] = (short)f2bf(c);
      }
  }
  float hre = 0.f, him = 0.f;
  const bf16* Z = (const bf16*)(ws + B_ZB);
  const int tt = lane >> 2, i0 = (lane & 3) * 4;
  uint2 unext;
  {
    int row, tau, len;
    step_row(tt, d, b, row, tau, len);
    unext = *(const uint2*)(Z + (size_t)row * NIN + C_U + g * 16 + i0);
  }
  for (int chunk = 0; chunk < 272; chunk++) {
    {
      uint2 u = unext;
      float4 f;
      f.x = bf2f((bf16)(u.x & 0xffff)); f.y = bf2f((bf16)(u.x >> 16));
      f.z = bf2f((bf16)(u.y & 0xffff)); f.w = bf2f((bf16)(u.y >> 16));
      *(float4*)(ub + tt * 16 + i0) = f;
    }
    __syncthreads();
    if (chunk + 1 < 272) {
      int row, tau, len;
      step_row((chunk + 1) * 16 + tt, d, b, row, tau, len);
      unext = *(const uint2*)(Z + (size_t)row * NIN + C_U + g * 16 + i0);
    }
#pragma unroll 2
    for (int t = 0; t < 16; t++) {
      const float* u = ub + t * 16;
      float br0 = 0.f, bi0 = 0.f;
#pragma unroll
      for (int i = 0; i < 16; i++) { float uv = u[i]; br0 += bbre[i] * uv; bi0 += bbim[i] * uv; }
      float nr = are * hre - aim * him + br0;
      float ni = are * him + aim * hre + bi0;
      hre = nr; him = ni;
      hb[t * 132 + lane] = hre;
      hb[t * 132 + 64 + lane] = him;
    }
    __syncthreads();
    {
      f32x4 yacc = {0.f, 0.f, 0.f, 0.f};
      const float* hr = hb + (lane & 15) * 132 + (lane >> 4) * 8;
#pragma unroll
      for (int ks = 0; ks < 4; ks++) {
        float4 x0 = *(const float4*)(hr + ks * 32), x1 = *(const float4*)(hr + ks * 32 + 4);
        union { bf16x8 v; uint32_t u[4]; } af;
        af.u[0] = pack2(x0.x, x0.y); af.u[1] = pack2(x0.z, x0.w);
        af.u[2] = pack2(x1.x, x1.y); af.u[3] = pack2(x1.z, x1.w);
        yacc = __builtin_amdgcn_mfma_f32_16x16x32_bf16(af.v, cfr[ks], yacc, 0, 0, 0);
      }
      const int ii = lane & 15;
#pragma unroll
      for (int r = 0; r < 4; r++) {
        int row, tau, len;
        step_row(chunk * 16 + (lane >> 4) * 4 + r, d, b, row, tau, len);
        bf16* dst = d == 0 ? (bf16*)(ws + B_SY) + (size_t)row * 1024 + g * 16 + ii : (bf16*)(ws + B_ZB) + (size_t)row * NIN + g * 16 + ii;
        if (dry) dst = (bf16*)(ws + B_END) + ((((size_t)row * 1024 + g * 16 + ii)) & 0x3fffff);
        *dst = f2bf(yacc[r]);
      }
    }
    __syncthreads();
  }
}

DEV int perm23(int r) { return (r & 0x13) | ((r & 4) << 1) | ((r & 8) >> 1); }

DEV void attn_item(int tidv, int bidv, const Params& p, int item, bool ctxq, char* smem, int dry) {
  char* ws = p.ws;
  bf16* sK = (bf16*)smem;
  bf16* sV = sK + 64 * 200;
  const int tid = tidv, wave = tid >> 6, lane = tid & 63;
  const int r = lane & 31, hf = lane >> 5;
  int b, hd, qt;
  if (!ctxq) { b = item >> 8; hd = (item >> 5) & 7; qt = item & 31; }
  else { b = item >> 4; hd = (item >> 1) & 7; qt = item & 1; }
  const int qrow0 = ctxq ? ML + b * 256 + qt * 128 : b * 4096 + qt * 128;
  const int kt0 = ctxq ? 64 : 0, kt1 = 68;
  bf16* QB = (bf16*)(ws + B_QB);
  const bf16* KN = (const bf16*)(ws + B_KN);
  const bf16* KR = (const bf16*)(ws + B_KR);
  const bf16* VT = (const bf16*)(ws + B_VT);
  bf16x8 qf[12];
  {
    const bf16* qp = QB + (size_t)(qrow0 + wave * 32 + r) * 1536 + hd * 192 + hf * 8;
#pragma unroll
    for (int kk = 0; kk < 12; kk++) qf[kk] = *(const bf16x8*)(qp + kk * 16);
  }
  f32x16 oacc[4];
#pragma unroll
  for (int i = 0; i < 4; i++)
#pragma unroll
    for (int e = 0; e < 16; e++) oacc[i][e] = 0.f;
  float mrun = -1e30f, lrun = 0.f;
  const int pr = perm23(r);
  for (int kt = kt0; kt < kt1; kt++) {
    __syncthreads();
    const int key0 = kt * 64;
    const int rowbase = key0 < 4096 ? b * 4096 + key0 : ML + b * 256 + (key0 - 4096);
    {
      const char* bk = (const char*)(KN + (size_t)rowbase * 1024 + hd * 128);
      const char* br = (const char*)(KR + (size_t)rowbase * 64);
      const char* bv = (const char*)(VT + ((size_t)((b * 8 + hd) * 128)) * NKEY + key0);
      const uint32_t vo_n = (uint32_t)((tid >> 4) * 2048 + (tid & 15) * 16);
      const uint32_t lo_n = (uint32_t)((tid >> 4) * 400 + (tid & 15) * 16);
      const uint32_t vo_r = (uint32_t)((tid >> 3) * 128 + (tid & 7) * 16);
      const uint32_t lo_r = (uint32_t)((tid >> 3) * 400 + 256 + (tid & 7) * 16);
      const uint32_t vo_v = (uint32_t)((tid >> 3) * (NKEY * 2) + (tid & 7) * 16);
      const uint32_t lo_v = (uint32_t)((tid >> 3) * 144 + (tid & 7) * 16);
      uint4 t0 = *(const uint4*)(bk + vo_n);
      uint4 t1 = *(const uint4*)(bk + 16 * 2048 + vo_n);
      uint4 t2 = *(const uint4*)(bk + 32 * 2048 + vo_n);
      uint4 t3 = *(const uint4*)(bk + 48 * 2048 + vo_n);
      uint4 t4 = *(const uint4*)(br + vo_r);
      uint4 t5 = *(const uint4*)(br + 32 * 128 + vo_r);
      *(uint4*)((char*)sK + lo_n) = t0;
      *(uint4*)((char*)sK + 16 * 400 + lo_n) = t1;
      *(uint4*)((char*)sK + 32 * 400 + lo_n) = t2;
      *(uint4*)((char*)sK + 48 * 400 + lo_n) = t3;
      *(uint4*)((char*)sK + lo_r) = t4;
      *(uint4*)((char*)sK + 32 * 400 + lo_r) = t5;
      __builtin_amdgcn_sched_barrier(0);
      uint4 u0 = *(const uint4*)(bv + vo_v);
      uint4 u1 = *(const uint4*)(bv + (size_t)32 * NKEY * 2 + vo_v);
      uint4 u2 = *(const uint4*)(bv + (size_t)64 * NKEY * 2 + vo_v);
      uint4 u3 = *(const uint4*)(bv + (size_t)96 * NKEY * 2 + vo_v);
      *(uint4*)((char*)sV + lo_v) = u0;
      *(uint4*)((char*)sV + 32 * 144 + lo_v) = u1;
      *(uint4*)((char*)sV + 64 * 144 + lo_v) = u2;
      *(uint4*)((char*)sV + 96 * 144 + lo_v) = u3;
    }
    __syncthreads();
    f32x16 sacc[2];
#pragma unroll
    for (int m = 0; m < 2; m++) {
#pragma unroll
      for (int e = 0; e < 16; e++) sacc[m][e] = 0.f;
      const bf16* kp = sK + (m * 32 + pr) * 200 + hf * 8;
#pragma unroll
      for (int kk = 0; kk < 12; kk++) {
        bf16x8 kf = *(const bf16x8*)(kp + kk * 16);
        sacc[m] = __builtin_amdgcn_mfma_f32_32x32x16_bf16(kf, qf[kk], sacc[m], 0, 0, 0);
        if ((kk & 3) == 3) __builtin_amdgcn_sched_barrier(0);
      }
      __builtin_amdgcn_sched_barrier(0);
    }
    float tmax = sacc[0][0];
#pragma unroll
    for (int e = 1; e < 16; e++) tmax = fmaxf(tmax, sacc[0][e]);
#pragma unroll
    for (int e = 0; e < 16; e++) tmax = fmaxf(tmax, sacc[1][e]);
    tmax = fmaxf(tmax, __shfl_xor(tmax, 32));
    float mnew = fmaxf(mrun, tmax);
    float alpha = __builtin_amdgcn_exp2f(mrun - mnew);
    mrun = mnew;
    float psum = 0.f;
#pragma unroll
    for (int m = 0; m < 2; m++)
#pragma unroll
      for (int e = 0; e < 16; e++) { float pv = __builtin_amdgcn_exp2f(sacc[m][e] - mnew); sacc[m][e] = pv; psum += pv; }
    lrun = lrun * alpha + psum;
#pragma unroll
    for (int i = 0; i < 4; i++)
#pragma unroll
      for (int e = 0; e < 16; e++) oacc[i][e] *= alpha;
#pragma unroll
    for (int s = 0; s < 4; s++) {
      const int m = s >> 1, s2 = s & 1;
      bf16x8 pf;
#pragma unroll
      for (int j = 0; j < 8; j++) pf[j] = (short)f2bf(sacc[m][8 * s2 + j]);
#pragma unroll
      for (int i = 0; i < 4; i++) {
        bf16x8 vf = *(const bf16x8*)(sV + (i * 32 + r) * 72 + m * 32 + s2 * 16 + hf * 8);
        oacc[i] = __builtin_amdgcn_mfma_f32_32x32x16_bf16(vf, pf, oacc[i], 0, 0, 0);
      }
      __builtin_amdgcn_sched_barrier(0);
    }
  }
  lrun += __shfl_xor(lrun, 32);
  const float inv = 1.f / lrun;
  bf16* op = QB + (size_t)(qrow0 + wave * 32 + r) * 1536 + hd * 192;
  if (dry) op = (bf16*)(ws + B_END) + ((((size_t)(qrow0 + wave * 32 + r) * 1536 + hd * 192)) & 0x3ffff8);
#pragma unroll
  for (int i = 0; i < 4; i++)
#pragma unroll
    for (int g = 0; g < 4; g++) {
      uint2 o;
      o.x = pack2(oacc[i][4 * g] * inv, oacc[i][4 * g + 1] * inv);
      o.y = pack2(oacc[i][4 * g + 2] * inv, oacc[i][4 * g + 3] * inv);
      *(uint2*)(op + 32 * i + 8 * g + 4 * hf) = o;
    }
}

DEV void phase_mixers(int tidv, int bidv, const Params& p, int l, char* smem, int dry) {
  __shared__ int s_item;
  for (int task = bidv; task < 256; task += gridDim.x) {
#if !defined(MIX_ONLY) || MIX_ONLY == 0
    if (task < 128) rwkv_scan(tidv, bidv, p, l, task, smem, dry);
#endif
#if !defined(MIX_ONLY) || MIX_ONLY == 1
    if (task >= 128) s5_scan(tidv, bidv, p, l, (task - 128) * 4 + (tidv >> 6), smem + (tidv >> 6) * 9472, dry);
#endif
  }
  const int nlat = 1024, ntot = (l == 0) ? 1088 : 1024;
  int* cnt = (int*)(p.ws + B_CNT) + l + 2 * dry;
#if !defined(MIX_ONLY) || MIX_ONLY == 2
  while (true) {
    __syncthreads();
    if (tidv == 0) s_item = atomicAdd(cnt, 1);
    __syncthreads();
    int item = s_item;
    if (item >= ntot) break;
    if (item < nlat) attn_item(tidv, bidv, p, item, false, smem, dry);
    else attn_item(tidv, bidv, p, item - nlat, true, smem, dry);
  }
#endif
}

DEV float gelu_tanh(float x) {
  float u = 0.7978845608028654f * (x + 0.044715f * x * x * x);
  return 0.5f * x * (1.f + tanhf(u));
}

DEV void phase_post(int tidv, int bidv, const Params& p, int l, int M) {
  char* ws = p.ws;
  const bf16* Z = (const bf16*)(ws + B_ZB);
  const int wave = tidv >> 6, lane = tidv & 63;
  const float* cw = p.in[17] + (size_t)l * 3 * 3072;
  const bf16* YF = (const bf16*)(ws + B_HB);
  const bf16* YB = (const bf16*)(ws + B_HB + SZ1K);
  const bf16* AF = (const bf16*)(ws + B_AF);
  const bf16* AB = (const bf16*)(ws + B_AB);
  bf16* GB = (bf16*)(ws + B_GB);
  const int nitem = M * 16;
  for (int it = bidv * 4 + wave; it < nitem; it += gridDim.x * 4) {
    int row = it >> 4, h = it & 15;
    int ch = h * 64 + lane;
    int tau, len;
    if (row < ML) { tau = row & 4095; len = 4096; } else { tau = (row - ML) & 255; len = 256; }
    size_t o = (size_t)row * 1024 + ch;
    float y = bf2f(YF[o]) + bf2f(YB[o]);
    float mu = wsum(y) * (1.f / 64.f);
    float dv = y - mu;
    float var = wsum(dv * dv) * (1.f / 64.f);
    float yn = dv * rsqrtf(var + 64e-5f) * p.in[26][l * 1024 + ch] + p.in[27][l * 1024 + ch];
    const bf16* z = Z + (size_t)row * NIN + C_R + ch;
    float r1 = bf2f(z[0]), k1 = bf2f(z[1024]), v1 = bf2f(z[2048]);
    float r0 = 0.f, k0 = 0.f, v0 = 0.f, r2 = 0.f, k2 = 0.f, v2 = 0.f;
    if (tau > 0) { const bf16* zm = z - NIN; r0 = bf2f(zm[0]); k0 = bf2f(zm[1024]); v0 = bf2f(zm[2048]); }
    if (tau < len - 1) { const bf16* zp = z + NIN; r2 = bf2f(zp[0]); k2 = bf2f(zp[1024]); v2 = bf2f(zp[2048]); }
    float rr = cw[ch] * r0 + cw[3072 + ch] * r1 + cw[6144 + ch] * r2;
    float kk = cw[1024 + ch] * k0 + cw[3072 + 1024 + ch] * k1 + cw[6144 + 1024 + ch] * k2;
    float vv = cw[2048 + ch] * v0 + cw[3072 + 2048 + ch] * v1 + cw[6144 + 2048 + ch] * v2;
    float am = 0.5f * (bf2f(AF[o]) + bf2f(AB[o]));
    float kbon = kk * (1.f + (am - 1.f) * p.in[24][l * 1024 + ch]);
    float s = wsum(rr * kbon * p.in[25][l * 1024 + ch]);
    float outv = (yn + s * vv) * bf2f(GB[o]);
    GB[o] = f2bf(outv);
  }
  bf16* SY = (bf16*)(ws + B_SY);
  const float* dsk = p.in[35] + l * 1024;
  const int n4 = M * 256;
  for (int i = bidv * 256 + tidv; i < n4; i += gridDim.x * 256) {
    int row = i >> 8, c = (i & 255) * 4;
    uint2 a = *(const uint2*)(SY + (size_t)row * 1024 + c);
    uint2 bq = *(const uint2*)(Z + (size_t)row * NIN + c);
    uint2 u = *(const uint2*)(Z + (size_t)row * NIN + C_U + c);
    float4 dd = *(const float4*)(dsk + c);
    float y0 = bf2f((bf16)(a.x & 0xffff)) + bf2f((bf16)(bq.x & 0xffff)) + dd.x * bf2f((bf16)(u.x & 0xffff));
    float y1 = bf2f((bf16)(a.x >> 16)) + bf2f((bf16)(bq.x >> 16)) + dd.y * bf2f((bf16)(u.x >> 16));
    float y2 = bf2f((bf16)(a.y & 0xffff)) + bf2f((bf16)(bq.y & 0xffff)) + dd.z * bf2f((bf16)(u.y & 0xffff));
    float y3 = bf2f((bf16)(a.y >> 16)) + bf2f((bf16)(bq.y >> 16)) + dd.w * bf2f((bf16)(u.y >> 16));
    uint2 o;
    o.x = pack2(gelu_tanh(y0), gelu_tanh(y1));
    o.y = pack2(gelu_tanh(y2), gelu_tanh(y3));
    *(uint2*)(SY + (size_t)row * 1024 + c) = o;
  }
}

constexpr int NPH = 25;

DEV void run_phase(int tidv, int bidv, const Params& p, int ph, char* smem, int dry) {
  char* ws = p.ws;
#ifndef ONLY_S
  if (ph == 0) {
    if (bidv == 0 && tidv < 4) ((int*)(ws + B_CNT))[tidv] = 0;
    phase_mod(tidv, bidv, p, smem);
    phase_convw(tidv, bidv, p, 0, smem);
    return;
  }
#endif
  const int l = (ph - 1) / 12, s = (ph - 1) % 12;
#ifdef ONLY_S
  if (s != ONLY_S) return;
#endif
  const bf16* wb = (const bf16*)(ws + B_WB);
  const float* mod = (const float*)(ws + B_MOD) + (size_t)l * 5 * 12288;
  float* XC = (float*)(ws + B_XC);
  const float* xin_lat = l == 0 ? p.in[0] : p.out;
  const float* xin_ctx = l == 0 ? p.in[2] : XC;
  bf16* HB = (bf16*)(ws + B_HB);
  bf16* Z = (bf16*)(ws + B_ZB);
  bf16* H2 = (bf16*)(ws + B_KN);
  const int Mpost = l == 0 ? MT : ML;
  switch (s) {
    case 0:
      if (l == 1) phase_convw(tidv, bidv, p, 1, smem);
      phase_norm(tidv, bidv, xin_lat, xin_ctx, p.in[6] + l * 2048, mod, 0, 2048, HB, MT);
      break;
    case 1:
      run_gemm<G_IN>(tidv, bidv, p, l, smem, HB, 2048, wb + OW_IN, 2048, NIN, MT, 0, nullptr, nullptr, nullptr, nullptr);
      break;
    case 2:
      run_gemm<G_UKV>(tidv, bidv, p, l, smem, Z + C_CKV, NIN, wb + OW_UKV, 512, 2048, MT, 0, nullptr, nullptr, nullptr, nullptr);
      run_gemm<G_UQ>(tidv, bidv, p, l, smem, Z + C_CQ, NIN, wb + OW_UQ, 512, 1536, MT, 0, nullptr, nullptr, nullptr, nullptr);
      run_gemm<G_G2>(tidv, bidv, p, l, smem, Z + C_GD, NIN, wb + OW_G2, 160, 1024, MT, 0, nullptr, nullptr, nullptr, nullptr);
      for (int d = 0; d < 2; d++) {
        run_gemm<G_W2>(tidv, bidv, p, l, smem, Z + C_WD + 64 * d, NIN, wb + OW_W2 + (size_t)d * 65536, 64, 1024, MT, d, nullptr, nullptr, nullptr, nullptr);
        run_gemm<G_A2>(tidv, bidv, p, l, smem, Z + C_AD + 64 * d, NIN, wb + OW_A2 + (size_t)d * 65536, 64, 1024, MT, d, nullptr, nullptr, nullptr, nullptr);
      }
      break;
    case 3: phase_mla_post(tidv, bidv, p, l); break;
    case 4: phase_mixers(tidv, bidv, p, l, smem, dry); break;
    case 5: phase_post(tidv, bidv, p, l, Mpost); break;
    case 6:
      run_gemm<G_GLU>(tidv, bidv, p, l, smem, (const bf16*)(ws + B_SY), 1024, wb + OW_GLU, 1024, 1024, Mpost, 0, nullptr, nullptr, nullptr, nullptr);
      break;
    case 7:
      run_gemm<G_MG0>(tidv, bidv, p, l, smem, (const bf16*)(ws + B_QB), 1536, wb + OW_BR, 1024, 2048, Mpost, 0, nullptr, nullptr, nullptr, nullptr);
      run_gemm<G_MG1>(tidv, bidv, p, l, smem, (const bf16*)(ws + B_GB), 1024, wb + OW_BR + (size_t)2048 * 1024, 1024, 2048, Mpost, 0, nullptr, nullptr, nullptr, nullptr);
      run_gemm<G_MG2>(tidv, bidv, p, l, smem, Z, NIN, wb + OW_BR + (size_t)2 * 2048 * 1024, 1024, 2048, Mpost, 0, nullptr, nullptr, nullptr, nullptr);
      break;
    case 8:
      run_gemm<G_OUT>(tidv, bidv, p, l, smem, HB, 2048, wb + OW_OUT, 2048, 2048, Mpost, 0, xin_lat, xin_ctx, p.out, XC);
      break;
    case 9:
      phase_norm(tidv, bidv, p.out, XC, p.in[7] + l * 2048, mod, 6144, 8192, H2, Mpost);
      break;
    case 10:
      run_gemm<G_M1>(tidv, bidv, p, l, smem, H2, 2048, wb + OW_M1, 2048, 8192, Mpost, 0, nullptr, nullptr, nullptr, nullptr);
      break;
    case 11:
      run_gemm<G_M2>(tidv, bidv, p, l, smem, Z, 8192, wb + OW_M2, 8192, 2048, Mpost, 0, nullptr, nullptr, p.out, XC);
      break;
  }
}

__global__ void __launch_bounds__(256, 2) fwd_megakernel(Params p, int ph0, int ph1, int dryflag) {
  __shared__ __attribute__((aligned(16))) char smem[46080];
  for (int ph = ph0; ph < ph1; ph++) {
    int tidv = threadIdx.x, bidv = blockIdx.x;
    asm volatile("" : "+v"(tidv));
    asm volatile("" : "+s"(bidv));
#ifdef PROBE_MASK
    if (dryflag && ((ph == 0 && (PROBE_MASK & 0x1000)) || (ph > 0 && ((PROBE_MASK >> ((ph - 1) % 12)) & 1)))) {
      run_phase(tidv, bidv, p, ph, smem, dryflag);
      cg::this_grid().sync();
    }
#endif
    run_phase(tidv, bidv, p, ph, smem, 0);
    if (ph + 1 < ph1) cg::this_grid().sync();
  }
}

extern "C" void kernel_launch(void* const* d_in, const int* in_sizes, int n_in, void* d_out, int out_size, void* d_ws, size_t ws_size,
                              hipStream_t stream) {
  static int grid_blocks = 0;
  if (!grid_blocks) {
    int dev = 0, cus = 0, per_cu = 0;
    hipGetDevice(&dev);
    hipDeviceGetAttribute(&cus, hipDeviceAttributeMultiprocessorCount, dev);
    hipOccupancyMaxActiveBlocksPerMultiprocessor(&per_cu, fwd_megakernel, 256, 0);
    if (per_cu < 1) per_cu = 1;
    if (per_cu > 2) per_cu = 2;
    grid_blocks = cus * per_cu;
  }
  Params p{};
  for (int i = 0; i < 42; i++) p.in[i] = (const float*)d_in[i];
  p.out = (float*)d_out;
  p.ws = (char*)d_ws;
  if (ws_size < B_END + (8u << 20)) { fprintf(stderr, "workspace too small\n"); return; }
#if MULTI_LAUNCH
  for (int ph = 0; ph < NPH; ph++) {
    hipLaunchKernelGGL(fwd_megakernel, dim3(grid_blocks), dim3(256), 0, stream, p, ph, ph + 1, 0);
  }
#else
  int ph0 = 0, ph1 = NPH;
  int dryflag = 1;
  void* args[] = {&p, &ph0, &ph1, &dryflag};
  hipError_t e = hipLaunchCooperativeKernel((void*)fwd_megakernel, dim3(grid_blocks), dim3(256), args, 0, stream);
  if (e != hipSuccess) fprintf(stderr, "cooperative launch failed: %s (grid %d)\n", hipGetErrorString(e), grid_blocks);
#endif
}
```

```cpp
#include <hip/hip_runtime.h>
#include <hip/hip_cooperative_groups.h>
#include <stdint.h>
#include <cstdio>
namespace cg = cooperative_groups;

#ifndef MULTI_LAUNCH
#define MULTI_LAUNCH 0
#endif

typedef unsigned short bf16;
using bf16x8 = __attribute__((ext_vector_type(8))) short;
using f32x4 = __attribute__((ext_vector_type(4))) float;
using f32x16 = __attribute__((ext_vector_type(16))) float;

#define DEV __device__ __forceinline__

constexpr int DM = 2048, ML = 16384, MC = 1024, MT = 17408, NIN = 11744, DFF = 8192, NKEY = 4352;
constexpr int C_CQ = 0, C_CKV = 512, C_KR = 1024, C_R = 1088, C_WD = 4160, C_AD = 4288, C_GD = 4416, C_U = 4576, C_GATE = 5600;

constexpr size_t OW_IN = 0;
constexpr size_t OW_UQ = OW_IN + (size_t)NIN * 2048;
constexpr size_t OW_UKV = OW_UQ + 1536 * 512;
constexpr size_t OW_W2 = OW_UKV + 2048 * 512;
constexpr size_t OW_A2 = OW_W2 + 2 * 1024 * 64;
constexpr size_t OW_G2 = OW_A2 + 2 * 1024 * 64;
constexpr size_t OW_GLU = OW_G2 + 1024 * 192;
constexpr size_t OW_BR = OW_GLU + 1024 * 1024;
constexpr size_t OW_OUT = OW_BR + (size_t)3 * 2048 * 1024;
constexpr size_t OW_M1 = OW_OUT + (size_t)2048 * 2048;
constexpr size_t OW_M2 = OW_M1 + (size_t)8192 * 2048;
constexpr size_t OW_END = OW_M2 + (size_t)8192 * 2048;

constexpr size_t SZ1K = (size_t)MT * 1024 * 2;
constexpr size_t B_WB = 0;
constexpr size_t B_HB = B_WB + OW_END * 2;
constexpr size_t B_ZB = B_HB + (size_t)MT * 2048 * 2;
constexpr size_t B_QB = B_ZB + (size_t)MT * NIN * 2;
constexpr size_t B_KN = B_QB + (size_t)MT * 1536 * 2;
constexpr size_t B_VT = B_KN + SZ1K;
constexpr size_t B_KR = B_VT + SZ1K;
constexpr size_t B_AF = B_KR + (size_t)MT * 64 * 2;
constexpr size_t B_AB = B_AF + SZ1K;
constexpr size_t B_GB = B_AB + SZ1K;
constexpr size_t B_SY = B_GB + SZ1K;
constexpr size_t B_XC = B_SY + SZ1K;
constexpr size_t B_MOD = B_XC + (size_t)MC * 2048 * 4;
constexpr size_t B_CNT = B_MOD + (size_t)2 * 5 * 12288 * 4;
constexpr size_t B_END = B_CNT + 256;

struct Params {
  const float* in[42];
  float* out;
  char* ws;
};

typedef __attribute__((ext_vector_type(2))) __bf16 hbf2;
DEV bf16 f2bf(float f) {
  __bf16 h = (__bf16)f;
  return *(unsigned short*)&h;
}
DEV float bf2f(bf16 h) { return __uint_as_float(((uint32_t)h) << 16); }
DEV uint32_t pack2(float a, float b) {
  hbf2 v;
  v[0] = (__bf16)a;
  v[1] = (__bf16)b;
  return *(uint32_t*)&v;
}
DEV float wsum(float v) {
#pragma unroll
  for (int o = 32; o > 0; o >>= 1) v += __shfl_xor(v, o);
  return v;
}
DEV float dpp_xor1(float v) {
  int i = __float_as_int(v);
  return __int_as_float(__builtin_amdgcn_update_dpp(i, i, 0xB1, 0xF, 0xF, false));
}
DEV float dpp_xor2(float v) {
  int i = __float_as_int(v);
  return __int_as_float(__builtin_amdgcn_update_dpp(i, i, 0x4E, 0xF, 0xF, false));
}
DEV float sigmoidf_(float x) { return 1.f / (1.f + __expf(-x)); }

DEV void phase_mod(int tidv, int bidv, const Params& p, char* smem) {
  float* s_in = (float*)smem;
  float* red = s_in + 5 * 2048;
  float* mod = (float*)(p.ws + B_MOD);
  for (int i = tidv; i < 5 * 2048; i += 256) {
    int r = i >> 11, k = i & 2047;
    float v = r < 4 ? p.in[1][r * 2048 + k] : p.in[3][k];
    s_in[i] = v / (1.f + expf(-v));
  }
  __syncthreads();
  int kg = tidv >> 6, c = tidv & 63;
  for (int task = bidv; task < 2 * 192; task += gridDim.x) {
    int l = task / 192, n = (task % 192) * 64 + c;
    const float* w = p.in[4] + (size_t)l * 2048 * 12288 + n;
    float a0 = 0, a1 = 0, a2 = 0, a3 = 0, a4 = 0;
    int kb = kg * 512;
#pragma unroll 8
    for (int k = 0; k < 512; k++) {
      float wv = w[(size_t)(kb + k) * 12288];
      a0 += s_in[kb + k] * wv;
      a1 += s_in[2048 + kb + k] * wv;
      a2 += s_in[4096 + kb + k] * wv;
      a3 += s_in[6144 + kb + k] * wv;
      a4 += s_in[8192 + kb + k] * wv;
    }
    red[(kg * 5 + 0) * 64 + c] = a0;
    red[(kg * 5 + 1) * 64 + c] = a1;
    red[(kg * 5 + 2) * 64 + c] = a2;
    red[(kg * 5 + 3) * 64 + c] = a3;
    red[(kg * 5 + 4) * 64 + c] = a4;
    __syncthreads();
    if (kg == 0) {
      float bias = p.in[5][l * 12288 + n];
#pragma unroll
      for (int r = 0; r < 5; r++) {
        float v = red[(0 * 5 + r) * 64 + c] + red[(1 * 5 + r) * 64 + c] + red[(2 * 5 + r) * 64 + c] + red[(3 * 5 + r) * 64 + c];
        mod[(size_t)(l * 5 + r) * 12288 + n] = v + bias;
      }
    }
    __syncthreads();
  }
}

DEV void convT(int tidv, int bidv, const float* __restrict__ src, bf16* __restrict__ dst, int K, int N, const float* __restrict__ gain, char* smem, int dK = 0) {
  if (dK == 0) dK = K;
  float* t = (float*)smem;
  int tk = (K + 63) >> 6, tn = (N + 63) >> 6;
  for (int tile = bidv; tile < tk * tn; tile += gridDim.x) {
    int k0 = (tile / tn) * 64, n0 = (tile % tn) * 64;
    __syncthreads();
#pragma unroll 4
    for (int i = 0; i < 16; i++) {
      int kk = i * 4 + (tidv >> 6), nn = tidv & 63;
      float v = 0.f;
      if (k0 + kk < K && n0 + nn < N) {
        v = src[(size_t)(k0 + kk) * N + n0 + nn];
        if (gain) v *= gain[k0 + kk];
      }
      t[kk * 65 + nn] = v;
    }
    __syncthreads();
#pragma unroll
    for (int i = 0; i < 2; i++) {
      int c = tidv + 256 * i;
      int nn = c >> 3, kc = c & 7;
      if (n0 + nn < N && k0 + kc * 8 < dK) {
        uint4 o;
        o.x = pack2(t[(kc * 8 + 0) * 65 + nn], t[(kc * 8 + 1) * 65 + nn]);
        o.y = pack2(t[(kc * 8 + 2) * 65 + nn], t[(kc * 8 + 3) * 65 + nn]);
        o.z = pack2(t[(kc * 8 + 4) * 65 + nn], t[(kc * 8 + 5) * 65 + nn]);
        o.w = pack2(t[(kc * 8 + 6) * 65 + nn], t[(kc * 8 + 7) * 65 + nn]);
        *(uint4*)(dst + (size_t)(n0 + nn) * dK + k0 + kc * 8) = o;
      }
    }
  }
}

DEV void phase_convw(int tidv, int bidv, const Params& p, int l, char* smem) {
  bf16* wb = (bf16*)(p.ws + B_WB);
  convT(tidv, bidv, p.in[8] + (size_t)l * 2048 * NIN, wb + OW_IN, 2048, NIN, nullptr, smem);
  convT(tidv, bidv, p.in[40] + (size_t)l * 2048 * 8192, wb + OW_M1, 2048, 8192, nullptr, smem);
  convT(tidv, bidv, p.in[41] + (size_t)l * 8192 * 2048, wb + OW_M2, 8192, 2048, nullptr, smem);
  for (int n = 0; n < 3; n++)
    convT(tidv, bidv, p.in[38] + (size_t)(l * 3 + n) * 1024 * 2048, wb + OW_BR + (size_t)n * 2048 * 1024, 1024, 2048, nullptr, smem);
  convT(tidv, bidv, p.in[39] + (size_t)l * 2048 * 2048, wb + OW_OUT, 2048, 2048, nullptr, smem);
  convT(tidv, bidv, p.in[11] + (size_t)l * 512 * 1536, wb + OW_UQ, 512, 1536, p.in[9] + l * 512, smem);
  convT(tidv, bidv, p.in[12] + (size_t)l * 512 * 2048, wb + OW_UKV, 512, 2048, p.in[10] + l * 512, smem);
  convT(tidv, bidv, p.in[36] + (size_t)l * 1024 * 1024, wb + OW_GLU, 1024, 1024, nullptr, smem);
  for (int d = 0; d < 2; d++) {
    convT(tidv, bidv, p.in[19] + (size_t)(l * 2 + d) * 64 * 1024, wb + OW_W2 + (size_t)d * 65536, 64, 1024, nullptr, smem);
    convT(tidv, bidv, p.in[21] + (size_t)(l * 2 + d) * 64 * 1024, wb + OW_A2 + (size_t)d * 65536, 64, 1024, nullptr, smem);
  }
  convT(tidv, bidv, p.in[22] + (size_t)l * 160 * 1024, wb + OW_G2, 160, 1024, nullptr, smem, 192);
}

DEV void phase_norm(int tidv, int bidv, const float* xlat, const float* xctx, const float* g, const float* mod, int shOff, int scOff, bf16* H, int nrows) {
  int wave = tidv >> 6, lane = tidv & 63;
  for (int row = bidv * 4 + wave; row < nrows; row += gridDim.x * 4) {
    const float* x = row < ML ? xlat + (size_t)row * 2048 : xctx + (size_t)(row - ML) * 2048;
    int b = row < ML ? (row >> 12) : 4;
    const float* sh = mod + b * 12288 + shOff;
    const float* sc = mod + b * 12288 + scOff;
    float4 v[8];
    float ss = 0.f;
#pragma unroll
    for (int i = 0; i < 8; i++) {
      v[i] = *(const float4*)(x + i * 256 + lane * 4);
      ss += v[i].x * v[i].x + v[i].y * v[i].y + v[i].z * v[i].z + v[i].w * v[i].w;
    }
    ss = wsum(ss);
    float rinv = rsqrtf(ss * (1.f / 2048.f) + 1e-6f);
#pragma unroll
    for (int i = 0; i < 8; i++) {
      int c = i * 256 + lane * 4;
      float4 g4 = *(const float4*)(g + c), s4 = *(const float4*)(sc + c), h4 = *(const float4*)(sh + c);
      float y0 = v[i].x * rinv * g4.x * (1.f + s4.x) + h4.x;
      float y1 = v[i].y * rinv * g4.y * (1.f + s4.y) + h4.y;
      float y2 = v[i].z * rinv * g4.z * (1.f + s4.z) + h4.z;
      float y3 = v[i].w * rinv * g4.w * (1.f + s4.w) + h4.w;
      uint2 o;
      o.x = pack2(y0, y1);
      o.y = pack2(y2, y3);
      *(uint2*)(H + (size_t)row * 2048 + c) = o;
    }
  }
}

constexpr int LDT = 72;
constexpr int GSTAGE = 2 * 128 * LDT * 2;
DEV float sumsq8(uint4 r) {
  float s = 0.f, x;
  x = bf2f((bf16)(r.x & 0xffff)); s += x * x; x = bf2f((bf16)(r.x >> 16)); s += x * x;
  x = bf2f((bf16)(r.y & 0xffff)); s += x * x; x = bf2f((bf16)(r.y >> 16)); s += x * x;
  x = bf2f((bf16)(r.z & 0xffff)); s += x * x; x = bf2f((bf16)(r.z >> 16)); s += x * x;
  x = bf2f((bf16)(r.w & 0xffff)); s += x * x; x = bf2f((bf16)(r.w >> 16)); s += x * x;
  return s;
}

template <bool ROWNORM>
DEV void gemm_mainloop(int tidv, int bidv, const bf16* __restrict__ A, int lda, bool amap, const bf16* __restrict__ Bt, int K, int N, int m0, int n0,
                       char* smem, f32x4 (&acc)[4][4]) {
  float* srinv = (float*)(smem + 2 * GSTAGE);
  const int tid = tidv, lane = tid & 63, wave = tid >> 6;
  const int wm = wave >> 1, wn = wave & 1;
  const int lr = tid >> 3, kc = tid & 7;
  const char* abase = (const char*)(A + (size_t)m0 * lda);
  const char* bbase = (const char*)(Bt + (size_t)n0 * K);
  const uint32_t voa = (uint32_t)(lr * lda + kc * 8) * 2u;
  const uint32_t astep = (uint32_t)(32 * lda) * 2u;
  uint32_t vob[4];
#pragma unroll
  for (int i = 0; i < 4; i++) {
    int nr = n0 + lr + 32 * i;
    if (nr > N - 1) nr = N - 1;
    vob[i] = (uint32_t)((nr - n0) * K + kc * 8) * 2u;
  }
  const uint32_t lds_st = (uint32_t)(lr * LDT + kc * 8) * 2u;
  const int nk = K >> 6;
  uint4 ra0, ra1, ra2, ra3, rb0, rb1, rb2, rb3;
  float ss0 = 0.f, ss1 = 0.f, ss2 = 0.f, ss3 = 0.f;
  const uint32_t vob0 = vob[0], vob1 = vob[1], vob2 = vob[2], vob3 = vob[3];
#define G_LOAD(KA, KB)                                              \
  ra0 = *(const uint4*)(abase + (size_t)(KA) * 2 + voa);            \
  ra1 = *(const uint4*)(abase + (size_t)(KA) * 2 + astep + voa);    \
  ra2 = *(const uint4*)(abase + (size_t)(KA) * 2 + 2 * astep + voa);\
  ra3 = *(const uint4*)(abase + (size_t)(KA) * 2 + 3 * astep + voa);\
  rb0 = *(const uint4*)(bbase + (size_t)(KB) * 2 + vob0);           \
  rb1 = *(const uint4*)(bbase + (size_t)(KB) * 2 + vob1);           \
  rb2 = *(const uint4*)(bbase + (size_t)(KB) * 2 + vob2);           \
  rb3 = *(const uint4*)(bbase + (size_t)(KB) * 2 + vob3);
#define G_STORE(SN)                                                       \
  *(uint4*)((SN) + lds_st) = ra0;                                         \
  *(uint4*)((SN) + 1 * (32 * LDT * 2) + lds_st) = ra1;                    \
  *(uint4*)((SN) + 2 * (32 * LDT * 2) + lds_st) = ra2;                    \
  *(uint4*)((SN) + 3 * (32 * LDT * 2) + lds_st) = ra3;                    \
  *(uint4*)((SN) + 128 * LDT * 2 + lds_st) = rb0;                         \
  *(uint4*)((SN) + 128 * LDT * 2 + 1 * (32 * LDT * 2) + lds_st) = rb1;    \
  *(uint4*)((SN) + 128 * LDT * 2 + 2 * (32 * LDT * 2) + lds_st) = rb2;    \
  *(uint4*)((SN) + 128 * LDT * 2 + 3 * (32 * LDT * 2) + lds_st) = rb3;    \
  if (ROWNORM) { ss0 += sumsq8(ra0); ss1 += sumsq8(ra1); ss2 += sumsq8(ra2); ss3 += sumsq8(ra3); }
  G_LOAD(0, 0)
  __syncthreads();
  G_STORE(smem)
  __syncthreads();
  const uint32_t fa = (uint32_t)((wm * 64 + (lane & 15)) * LDT + (lane >> 4) * 8) * 2u;
  const uint32_t fb = (uint32_t)(128 * LDT + (wn * 64 + (lane & 15)) * LDT + (lane >> 4) * 8) * 2u;
  for (int kt = 0; kt < nk; kt++) {
    const char* st = smem + (kt & 1) * GSTAGE;
    if (kt + 1 < nk) {
      int k0 = (kt + 1) << 6;
      int ka = amap ? ((k0 >> 7) * 192 + (k0 & 127)) : k0;
      G_LOAD(ka, k0)
    }
#pragma unroll
    for (int ks = 0; ks < 2; ks++) {
      bf16x8 af[4], bfr[4];
#pragma unroll
      for (int i = 0; i < 4; i++) af[i] = *(const bf16x8*)(st + fa + i * (16 * LDT * 2) + ks * 64);
#pragma unroll
      for (int j = 0; j < 4; j++) bfr[j] = *(const bf16x8*)(st + fb + j * (16 * LDT * 2) + ks * 64);
#pragma unroll
      for (int i = 0; i < 4; i++)
#pragma unroll
        for (int j = 0; j < 4; j++) acc[i][j] = __builtin_amdgcn_mfma_f32_16x16x32_bf16(bfr[j], af[i], acc[i][j], 0, 0, 0);
    }
    if (kt + 1 < nk) {
      char* sn = smem + ((kt + 1) & 1) * GSTAGE;
      G_STORE(sn)
    }
    __syncthreads();
  }
  if (ROWNORM) {
    float v;
    v = ss0; v += __shfl_xor(v, 1); v += __shfl_xor(v, 2); v += __shfl_xor(v, 4); if (kc == 0) srinv[lr] = rsqrtf(v / (float)K + 1e-6f);
    v = ss1; v += __shfl_xor(v, 1); v += __shfl_xor(v, 2); v += __shfl_xor(v, 4); if (kc == 0) srinv[lr + 32] = rsqrtf(v / (float)K + 1e-6f);
    v = ss2; v += __shfl_xor(v, 1); v += __shfl_xor(v, 2); v += __shfl_xor(v, 4); if (kc == 0) srinv[lr + 64] = rsqrtf(v / (float)K + 1e-6f);
    v = ss3; v += __shfl_xor(v, 1); v += __shfl_xor(v, 2); v += __shfl_xor(v, 4); if (kc == 0) srinv[lr + 96] = rsqrtf(v / (float)K + 1e-6f);
    __syncthreads();
  }
#undef G_LOAD
#undef G_STORE
}

DEV void zero_acc(f32x4 (&acc)[4][4]) {
#pragma unroll
  for (int i = 0; i < 4; i++)
#pragma unroll
    for (int j = 0; j < 4; j++) acc[i][j] = f32x4{0.f, 0.f, 0.f, 0.f};
}

template <class F>
DEV void epi_loop(int tidv, int bidv, f32x4 (&acc)[4][4], int m0, int n0, int N, F f) {
  const int lane = tidv & 63, wave = tidv >> 6;
  const int wm = wave >> 1, wn = wave & 1;
#pragma unroll
  for (int i = 0; i < 4; i++) {
    const int lrow = wm * 64 + i * 16 + (lane & 15);
#pragma unroll
    for (int j = 0; j < 4; j++) {
      int col = n0 + wn * 64 + j * 16 + (lane >> 4) * 4;
      if (col < N) f(m0 + lrow, lrow, col, acc[i][j]);
    }
    __builtin_amdgcn_sched_barrier(0);
  }
}

DEV uint2 pack4(f32x4 v) {
  uint2 o;
  o.x = pack2(v[0], v[1]);
  o.y = pack2(v[2], v[3]);
  return o;
}
DEV f32x4 unpack4(uint2 u) {
  f32x4 v;
  v[0] = bf2f((bf16)(u.x & 0xffff)); v[1] = bf2f((bf16)(u.x >> 16));
  v[2] = bf2f((bf16)(u.y & 0xffff)); v[3] = bf2f((bf16)(u.y >> 16));
  return v;
}

enum { G_IN = 0, G_UQ, G_UKV, G_W2, G_A2, G_G2, G_GLU, G_OUT, G_M1, G_M2, G_MG0, G_MG1, G_MG2 };

template <int MODE>
DEV void run_gemm(int tidv, int bidv, const Params& p, int l, char* smem, const bf16* A, int lda, const bf16* Bt, int K, int N, int M, int aux,
                  const float* xin_lat, const float* xin_ctx, float* xout_lat, float* xout_ctx) {
  const int nt = (N + 127) >> 7, mt = M >> 7;
  char* ws = p.ws;
  bf16* Z = (bf16*)(ws + B_ZB);
  const float* srinv = (const float*)(smem + 2 * GSTAGE);
  const float* mod = (const float*)(ws + B_MOD) + (size_t)l * 5 * 12288;
  for (int tile = bidv; tile < nt * mt; tile += gridDim.x) {
    int m0 = (tile / nt) << 7, n0 = (tile % nt) << 7;
    f32x4 acc[4][4];
    zero_acc(acc);
    gemm_mainloop<(MODE == G_UQ || MODE == G_UKV)>(tidv, bidv, A, lda, MODE == G_MG0, Bt, K, N, m0, n0, smem, acc);
    epi_loop(tidv, bidv, acc, m0, n0, N, [&](int row, int lrow, int col, f32x4 v) {
      if constexpr (MODE == G_IN) {
        f32x4 o = v;
        if (col >= C_GATE || (col >= C_GD && col < C_U)) {
#pragma unroll
          for (int r = 0; r < 4; r++) o[r] = sigmoidf_(v[r]);
        } else if (col >= C_WD && col < C_AD) {
#pragma unroll
          for (int r = 0; r < 4; r++) o[r] = tanhf(v[r]);
        }
        *(uint2*)(Z + (size_t)row * NIN + col) = pack4(o);
      } else if constexpr (MODE == G_UQ) {
        float ri = srinv[lrow];
        *(uint2*)((bf16*)(ws + B_QB) + (size_t)row * 1536 + col) = pack4(v * ri);
      } else if constexpr (MODE == G_UKV) {
        float ri = srinv[lrow];
        f32x4 o = v * ri;
        int h = col >> 8, c = col & 255;
        if (c < 128) {
          *(uint2*)((bf16*)(ws + B_KN) + (size_t)row * 1024 + h * 128 + c) = pack4(o);
        } else {
          int b, kp;
          if (row < ML) { b = row >> 12; kp = row & 4095; } else { int r2 = row - ML; b = r2 >> 8; kp = 4096 + (r2 & 255); }
          bf16* vt = (bf16*)(ws + B_VT) + ((size_t)((b * 8 + h) * 128 + (c - 128))) * NKEY + kp;
#pragma unroll
          for (int r = 0; r < 4; r++) vt[(size_t)r * NKEY] = f2bf(o[r]);
        }
      } else if constexpr (MODE == G_W2) {
        float4 w0 = *(const float4*)(p.in[18] + (l * 2 + aux) * 1024 + col);
        f32x4 o;
        o[0] = 0.60653066f * sigmoidf_(w0.x + v[0]);
        o[1] = 0.60653066f * sigmoidf_(w0.y + v[1]);
        o[2] = 0.60653066f * sigmoidf_(w0.z + v[2]);
        o[3] = 0.60653066f * sigmoidf_(w0.w + v[3]);
        *(uint2*)((bf16*)(ws + B_HB + (size_t)aux * SZ1K) + (size_t)row * 1024 + col) = pack4(o);
      } else if constexpr (MODE == G_A2) {
        float4 a0 = *(const float4*)(p.in[20] + (l * 2 + aux) * 1024 + col);
        f32x4 o;
        o[0] = sigmoidf_(a0.x + v[0]);
        o[1] = sigmoidf_(a0.y + v[1]);
        o[2] = sigmoidf_(a0.z + v[2]);
        o[3] = sigmoidf_(a0.w + v[3]);
        *(uint2*)((bf16*)(ws + (aux ? B_AB : B_AF)) + (size_t)row * 1024 + col) = pack4(o);
      } else if constexpr (MODE == G_G2) {
        *(uint2*)((bf16*)(ws + B_GB) + (size_t)row * 1024 + col) = pack4(v);
      } else if constexpr (MODE == G_GLU) {
        f32x4 zz = unpack4(*(const uint2*)((const bf16*)(ws + B_SY) + (size_t)row * 1024 + col));
        float4 gb = *(const float4*)(p.in[37] + l * 1024 + col);
        f32x4 o;
        o[0] = zz[0] * sigmoidf_(v[0] + gb.x);
        o[1] = zz[1] * sigmoidf_(v[1] + gb.y);
        o[2] = zz[2] * sigmoidf_(v[2] + gb.z);
        o[3] = zz[3] * sigmoidf_(v[3] + gb.w);
        *(uint2*)(Z + (size_t)row * NIN + col) = pack4(o);
      } else if constexpr (MODE == G_OUT) {
        int b = row < ML ? (row >> 12) : 4;
        float4 g = *(const float4*)(mod + b * 12288 + 4096 + col);
        const float* xi = row < ML ? xin_lat + (size_t)row * 2048 : xin_ctx + (size_t)(row - ML) * 2048;
        float* xo = row < ML ? xout_lat + (size_t)row * 2048 : xout_ctx + (size_t)(row - ML) * 2048;
        float4 x = *(const float4*)(xi + col);
        x.x += g.x * v[0]; x.y += g.y * v[1]; x.z += g.z * v[2]; x.w += g.w * v[3];
        *(float4*)(xo + col) = x;
      } else if constexpr (MODE == G_M1) {
        f32x4 o;
#pragma unroll
        for (int r = 0; r < 4; r++) { float t = fmaxf(v[r], 0.f); o[r] = t * t; }
        *(uint2*)(Z + (size_t)row * DFF + col) = pack4(o);
      } else if constexpr (MODE == G_MG0 || MODE == G_MG1 || MODE == G_MG2) {
        constexpr int nb = MODE - G_MG0;
        bf16* MG = (bf16*)(ws + B_HB);
        f32x4 g = unpack4(*(const uint2*)(Z + (size_t)row * NIN + C_GATE + nb * 2048 + col));
        f32x4 o = g * v;
        if constexpr (nb > 0) o += unpack4(*(const uint2*)(MG + (size_t)row * 2048 + col));
        *(uint2*)(MG + (size_t)row * 2048 + col) = pack4(o);
      } else if constexpr (MODE == G_M2) {
        int b = row < ML ? (row >> 12) : 4;
        float4 g = *(const float4*)(mod + b * 12288 + 10240 + col);
        float* xo = row < ML ? xout_lat + (size_t)row * 2048 : xout_ctx + (size_t)(row - ML) * 2048;
        float4 x = *(const float4*)(xo + col);
        x.x += g.x * v[0]; x.y += g.y * v[1]; x.z += g.z * v[2]; x.w += g.w * v[3];
        *(float4*)(xo + col) = x;
      }
    });
  }
}

DEV void phase_mla_post(int tidv, int bidv, const Params& p, int l) {
  char* ws = p.ws;
  const float* qng = p.in[13] + l * 128;
  const float* qrg = p.in[14] + l * 64;
  const float* kng = p.in[15] + l * 128;
  const float* krg = p.in[16] + l * 64;
  bf16* QB = (bf16*)(ws + B_QB);
  bf16* KN = (bf16*)(ws + B_KN);
  bf16* KR = (bf16*)(ws + B_KR);
  const bf16* Z = (const bf16*)(ws + B_ZB);
  const int wave = tidv >> 6, lane = tidv & 63;
  const float QS = 1.4426950408889634f * 0.07216878364870322f;
  const int idx = lane & 31;
  const float inv = powf(10000.f, -(float)(idx & 15) / 16.f);
  const float gq0 = qng[2 * lane], gq1 = qng[2 * lane + 1], gk0 = kng[2 * lane], gk1 = kng[2 * lane + 1];
  const float gqr = qrg[lane], gkr = krg[lane];
  for (int row = bidv * 4 + wave; row < MT; row += gridDim.x * 4) {
    bool lat = row < ML;
    int t = row & 4095;
    float pos = (idx < 16) ? (float)(t >> 6) : (float)(t & 63);
    float ang = pos * inv;
    float cs = 1.f, sn = 0.f;
    if (lat) { cs = cosf(ang); sn = sinf(ang); }
#pragma unroll 1
    for (int h = 0; h < 8; h++) {
      bf16* q = QB + (size_t)row * 1536 + h * 192;
      uint32_t u = *(const uint32_t*)(q + 2 * lane);
      float x0 = bf2f((bf16)(u & 0xffff)), x1 = bf2f((bf16)(u >> 16));
      float ss = wsum(x0 * x0 + x1 * x1);
      float rinv = rsqrtf(ss * (1.f / 128.f) + 1e-6f) * QS;
      *(uint32_t*)(q + 2 * lane) = pack2(x0 * rinv * gq0, x1 * rinv * gq1);
      float xr = bf2f(q[128 + lane]);
      float ss2 = wsum(xr * xr);
      float y = xr * rsqrtf(ss2 * (1.f / 64.f) + 1e-6f) * gqr;
      float yp = __shfl_xor(y, 32);
      float o = lane < 32 ? (y * cs - yp * sn) : (yp * sn + y * cs);
      q[128 + lane] = f2bf(o * QS);
      bf16* k = KN + (size_t)row * 1024 + h * 128;
      uint32_t uk = *(const uint32_t*)(k + 2 * lane);
      float k0 = bf2f((bf16)(uk & 0xffff)), k1 = bf2f((bf16)(uk >> 16));
      float ssk = wsum(k0 * k0 + k1 * k1);
      float rk = rsqrtf(ssk * (1.f / 128.f) + 1e-6f);
      *(uint32_t*)(k + 2 * lane) = pack2(k0 * rk * gk0, k1 * rk * gk1);
    }
    {
      float xr = bf2f(Z[(size_t)row * NIN + C_KR + lane]);
      float ss2 = wsum(xr * xr);
      float y = xr * rsqrtf(ss2 * (1.f / 64.f) + 1e-6f) * gkr;
      float yp = __shfl_xor(y, 32);
      float o = lane < 32 ? (y * cs - yp * sn) : (yp * sn + y * cs);
      KR[(size_t)row * 64 + lane] = f2bf(o);
    }
  }
}

DEV void step_row(int s, int d, int b, int& row, int& tau, int& len) {
  if (s < 256) { tau = d ? 255 - s : s; len = 256; row = ML + b * 256 + tau; }
  else { int q = s - 256; tau = d ? 4095 - q : q; len = 4096; row = b * 4096 + tau; }
}

struct RwPre { bf16 r0, r1, r2, k0, k1, k2, v0, v1, v2, a, e; };

DEV void rwkv_fetch(RwPre& q, const bf16* Z, const bf16* AD, const bf16* ED, int s, int d, int b, int ch) {
  int row, tau, len;
  step_row(s, d, b, row, tau, len);
  const bf16* z = Z + (size_t)row * NIN + C_R + ch;
  q.r1 = z[0]; q.k1 = z[1024]; q.v1 = z[2048];
  q.r0 = 0; q.k0 = 0; q.v0 = 0; q.r2 = 0; q.k2 = 0; q.v2 = 0;
  if (tau > 0) { const bf16* zm = z - NIN; q.r0 = zm[0]; q.k0 = zm[1024]; q.v0 = zm[2048]; }
  if (tau < len - 1) { const bf16* zp = z + NIN; q.r2 = zp[0]; q.k2 = zp[1024]; q.v2 = zp[2048]; }
  q.a = AD[(size_t)row * 1024 + ch];
  q.e = ED[(size_t)row * 1024 + ch];
}

DEV void rwkv_scan(int tidv, int bidv, const Params& p, int l, int chain, char* smem, int dry) {
  char* ws = p.ws;
  float* op = (float*)smem;
  float* vb = op + 16 * 320;
  float* yb = vb + 16 * 64;
  const int tid = tidv, wave = tid >> 6, lane = tid & 63;
  const int d = chain & 1, h = (chain >> 1) & 15, b = chain >> 5;
  const int ch = h * 64 + lane;
  const float* cw = p.in[17] + (size_t)l * 3 * 3072;
  const float cr0 = cw[ch], cr1 = cw[3072 + ch], cr2 = cw[6144 + ch];
  const float ck0 = cw[1024 + ch], ck1 = cw[3072 + 1024 + ch], ck2 = cw[6144 + 1024 + ch];
  const float cv0 = cw[2048 + ch], cv1 = cw[3072 + 2048 + ch], cv2 = cw[6144 + 2048 + ch];
  const float kkc = p.in[23][l * 1024 + ch], kac = p.in[24][l * 1024 + ch];
  const bf16* Z = (const bf16*)(ws + B_ZB);
  bf16* ED = (bf16*)(ws + B_HB + (size_t)d * SZ1K);
  const bf16* AD = (const bf16*)(ws + (d ? B_AB : B_AF));
  float S[16];
#pragma unroll
  for (int j = 0; j < 16; j++) S[j] = 0.f;
  const int ri = lane >> 2, jq = lane & 3, irow = wave * 16 + ri;
  RwPre pre[4];
#pragma unroll
  for (int si = 0; si < 4; si++) rwkv_fetch(pre[si], Z, AD, ED, wave * 4 + si, d, b, ch);
  for (int chunk = 0; chunk < 272; chunk++) {
#pragma unroll
    for (int si = 0; si < 4; si++) {
      int t = wave * 4 + si;
      const RwPre& q = pre[si];
      float rr = cr0 * bf2f(q.r0) + cr1 * bf2f(q.r1) + cr2 * bf2f(q.r2);
      float kk_ = ck0 * bf2f(q.k0) + ck1 * bf2f(q.k1) + ck2 * bf2f(q.k2);
      float vv = cv0 * bf2f(q.v0) + cv1 * bf2f(q.v1) + cv2 * bf2f(q.v2);
      float kkv = kk_ * kkc;
      float ssq = wsum(kkv * kkv);
      float kn = kkv * rsqrtf(ssq + 1e-12f);
      float a = bf2f(q.a);
      float w = __expf(-bf2f(q.e));
      float krep = kk_ * (1.f + (a - 1.f) * kac);
      float* o = op + t * 320;
      o[lane] = w;
      o[64 + lane] = kn * a;
      o[128 + lane] = krep;
      o[192 + lane] = -kn;
      o[256 + lane] = rr;
      vb[t * 64 + lane] = vv;
    }
    __syncthreads();
    if (chunk + 1 < 272) {
#pragma unroll
      for (int si = 0; si < 4; si++) rwkv_fetch(pre[si], Z, AD, ED, (chunk + 1) * 16 + wave * 4 + si, d, b, ch);
    }
    {
      const float4* o4 = (const float4*)(op + jq * 16);
      float4 n0 = o4[48], n1 = o4[49], n2 = o4[50], n3 = o4[51];
#pragma unroll 4
      for (int t = 0; t < 16; t++) {
        const float4* ot = o4 + t * 80;
        const float4 w0 = ot[0], w1 = ot[1], w2 = ot[2], w3 = ot[3];
        const float4 a0 = ot[16], a1 = ot[17], a2 = ot[18], a3 = ot[19];
        const float4 k0 = ot[32], k1 = ot[33], k2 = ot[34], k3 = ot[35];
        const float4 r0 = ot[64], r1 = ot[65], r2 = ot[66], r3 = ot[67];
        const float vi = vb[t * 64 + irow];
        const int tn = t < 15 ? t + 1 : 15;
        const float4* on = o4 + tn * 80;
        const float4 m0 = on[48], m1 = on[49], m2 = on[50], m3 = on[51];
        float sa0 = S[0] * n0.x + S[1] * n0.y + S[2] * n0.z + S[3] * n0.w;
        float sa1 = S[4] * n1.x + S[5] * n1.y + S[6] * n1.z + S[7] * n1.w;
        float sa2 = S[8] * n2.x + S[9] * n2.y + S[10] * n2.z + S[11] * n2.w;
        float sa3 = S[12] * n3.x + S[13] * n3.y + S[14] * n3.z + S[15] * n3.w;
        float sa = (sa0 + sa1) + (sa2 + sa3);
        sa += dpp_xor1(sa);
        sa += dpp_xor2(sa);
#define RW_UPD(J, W, A, K) S[J] = S[J] * (W) + sa * (A) + vi * (K);
        RW_UPD(0, w0.x, a0.x, k0.x) RW_UPD(1, w0.y, a0.y, k0.y) RW_UPD(2, w0.z, a0.z, k0.z) RW_UPD(3, w0.w, a0.w, k0.w)
        RW_UPD(4, w1.x, a1.x, k1.x) RW_UPD(5, w1.y, a1.y, k1.y) RW_UPD(6, w1.z, a1.z, k1.z) RW_UPD(7, w1.w, a1.w, k1.w)
        RW_UPD(8, w2.x, a2.x, k2.x) RW_UPD(9, w2.y, a2.y, k2.y) RW_UPD(10, w2.z, a2.z, k2.z) RW_UPD(11, w2.w, a2.w, k2.w)
        RW_UPD(12, w3.x, a3.x, k3.x) RW_UPD(13, w3.y, a3.y, k3.y) RW_UPD(14, w3.z, a3.z, k3.z) RW_UPD(15, w3.w, a3.w, k3.w)
#undef RW_UPD
        float y0 = S[0] * r0.x + S[1] * r0.y + S[2] * r0.z + S[3] * r0.w;
        float y1 = S[4] * r1.x + S[5] * r1.y + S[6] * r1.z + S[7] * r1.w;
        float y2 = S[8] * r2.x + S[9] * r2.y + S[10] * r2.z + S[11] * r2.w;
        float y3 = S[12] * r3.x + S[13] * r3.y + S[14] * r3.z + S[15] * r3.w;
        float y = (y0 + y1) + (y2 + y3);
        y += dpp_xor1(y);
        y += dpp_xor2(y);
        if (jq == 0) yb[t * 64 + irow] = y;
        n0 = m0; n1 = m1; n2 = m2; n3 = m3;
      }
    }
    __syncthreads();
#pragma unroll
    for (int it = 0; it < 4; it++) {
      int t = it * 4 + wave;
      int row, tau, len;
      step_row(chunk * 16 + t, d, b, row, tau, len);
      bf16* yd = dry ? (bf16*)(ws + B_END) + (((size_t)row * 1024 + h * 64 + lane) & 0x3fffff) : ED + (size_t)row * 1024 + h * 64 + lane;
      *yd = f2bf(yb[t * 64 + lane]);
    }
  }
}

DEV void s5_scan(int tidv, int bidv, const Params& p, int l, int chain, char* smemw, int dry) {
  char* ws = p.ws;
  const int lane = tidv & 63;
  const int d = chain & 1, g = (chain >> 1) & 63, b = chain >> 7;
  float* ub = (float*)smemw;
  float* hb = ub + 256;
  const size_t pg = (size_t)(l * 2 + d) * 64 + g;
  const float lre = p.in[28][pg * 64 + lane], lim = p.in[29][pg * 64 + lane];
  const float dt = expf(p.in[30][pg]);
  const float mag = expf(lre * dt);
  const float are = mag * cosf(lim * dt), aim = mag * sinf(lim * dt);
  const float den = lre * lre + lim * lim;
  const float qre = ((are - 1.f) * lre + aim * lim) / den;
  const float qim = (aim * lre - (are - 1.f) * lim) / den;
  float bbre[16], bbim[16];
  {
    const float* br = p.in[31] + (pg * 64 + lane) * 16;
    const float* bi = p.in[32] + (pg * 64 + lane) * 16;
#pragma unroll
    for (int i = 0; i < 16; i++) {
      float x = br[i], y = bi[i];
      bbre[i] = qre * x - qim * y;
      bbim[i] = qre * y + qim * x;
    }
  }
  bf16x8 cfr[4];
  {
    const int i = lane & 15, quad = lane >> 4;
    const float* cre = p.in[33] + (pg * 16 + i) * 64;
    const float* cim = p.in[34] + (pg * 16 + i) * 64;
#pragma unroll
    for (int ks = 0; ks < 4; ks++)
#pragma unroll
      for (int j = 0; j < 8; j++) {
        int k = ks * 32 + quad * 8 + j;
        float c = ks < 2 ? cre[k] : -cim[k - 64];
        cfr[ks][j] = (short)f2bf(c);
      }
  }
  float hre = 0.f, him = 0.f;
  const bf16* Z = (const bf16*)(ws + B_ZB);
  const int tt = lane >> 2, i0 = (lane & 3) * 4;
  uint2 unext;
  {
    int row, tau, len;
    step_row(tt, d, b, row, tau, len);
    unext = *(const uint2*)(Z + (size_t)row * NIN + C_U + g * 16 + i0);
  }
  for (int chunk = 0; chunk < 272; chunk++) {
    {
      uint2 u = unext;
      float4 f;
      f.x = bf2f((bf16)(u.x & 0xffff)); f.y = bf2f((bf16)(u.x >> 16));
      f.z = bf2f((bf16)(u.y & 0xffff)); f.w = bf2f((bf16)(u.y >> 16));
      *(float4*)(ub + tt * 16 + i0) = f;
    }
    __syncthreads();
    if (chunk + 1 < 272) {
      int row, tau, len;
      step_row((chunk + 1) * 16 + tt, d, b, row, tau, len);
      unext = *(const uint2*)(Z + (size_t)row * NIN + C_U + g * 16 + i0);
    }
#pragma unroll 2
    for (int t = 0; t < 16; t++) {
      const float* u = ub + t * 16;
      float br0 = 0.f, bi0 = 0.f;
#pragma unroll
      for (int i = 0; i < 16; i++) { float uv = u[i]; br0 += bbre[i] * uv; bi0 += bbim[i] * uv; }
      float nr = are * hre - aim * him + br0;
      float ni = are * him + aim * hre + bi0;
      hre = nr; him = ni;
      hb[t * 132 + lane] = hre;
      hb[t * 132 + 64 + lane] = him;
    }
    __syncthreads();
    {
      f32x4 yacc = {0.f, 0.f, 0.f, 0.f};
      const float* hr = hb + (lane & 15) * 132 + (lane >> 4) * 8;
#pragma unroll
      for (int ks = 0; ks < 4; ks++) {
        float4 x0 = *(const float4*)(hr + ks * 32), x1 = *(const float4*)(hr + ks * 32 + 4);
        union { bf16x8 v; uint32_t u[4]; } af;
        af.u[0] = pack2(x0.x, x0.y); af.u[1] = pack2(x0.z, x0.w);
        af.u[2] = pack2(x1.x, x1.y); af.u[3] = pack2(x1.z, x1.w);
        yacc = __builtin_amdgcn_mfma_f32_16x16x32_bf16(af.v, cfr[ks], yacc, 0, 0, 0);
      }
      const int ii = lane & 15;
#pragma unroll
      for (int r = 0; r < 4; r++) {
        int row, tau, len;
        step_row(chunk * 16 + (lane >> 4) * 4 + r, d, b, row, tau, len);
        bf16* dst = d == 0 ? (bf16*)(ws + B_SY) + (size_t)row * 1024 + g * 16 + ii : (bf16*)(ws + B_ZB) + (size_t)row * NIN + g * 16 + ii;
        if (dry) dst = (bf16*)(ws + B_END) + ((((size_t)row * 1024 + g * 16 + ii)) & 0x3fffff);
        *dst = f2bf(yacc[r]);
      }
    }
    __syncthreads();
  }
}

DEV int perm23(int r) { return (r & 0x13) | ((r & 4) << 1) | ((r & 8) >> 1); }

DEV void attn_item(int tidv, int bidv, const Params& p, int item, bool ctxq, char* smem, int dry) {
  char* ws = p.ws;
  bf16* sK = (bf16*)smem;
  bf16* sV = sK + 64 * 200;
  const int tid = tidv, wave = tid >> 6, lane = tid & 63;
  const int r = lane & 31, hf = lane >> 5;
  int b, hd, qt;
  if (!ctxq) { b = item >> 8; hd = (item >> 5) & 7; qt = item & 31; }
  else { b = item >> 4; hd = (item >> 1) & 7; qt = item & 1; }
  const int qrow0 = ctxq ? ML + b * 256 + qt * 128 : b * 4096 + qt * 128;
  const int kt0 = ctxq ? 64 : 0, kt1 = 68;
  bf16* QB = (bf16*)(ws + B_QB);
  const bf16* KN = (const bf16*)(ws + B_KN);
  const bf16* KR = (const bf16*)(ws + B_KR);
  const bf16* VT = (const bf16*)(ws + B_VT);
  bf16x8 qf[12];
  {
    const bf16* qp = QB + (size_t)(qrow0 + wave * 32 + r) * 1536 + hd * 192 + hf * 8;
#pragma unroll
    for (int kk = 0; kk < 12; kk++) qf[kk] = *(const bf16x8*)(qp + kk * 16);
  }
  f32x16 oacc[4];
#pragma unroll
  for (int i = 0; i < 4; i++)
#pragma unroll
    for (int e = 0; e < 16; e++) oacc[i][e] = 0.f;
  float mrun = -1e30f, lrun = 0.f;
  const int pr = perm23(r);
  for (int kt = kt0; kt < kt1; kt++) {
    __syncthreads();
    const int key0 = kt * 64;
    const int rowbase = key0 < 4096 ? b * 4096 + key0 : ML + b * 256 + (key0 - 4096);
    {
      const char* bk = (const char*)(KN + (size_t)rowbase * 1024 + hd * 128);
      const char* br = (const char*)(KR + (size_t)rowbase * 64);
      const char* bv = (const char*)(VT + ((size_t)((b * 8 + hd) * 128)) * NKEY + key0);
      const uint32_t vo_n = (uint32_t)((tid >> 4) * 2048 + (tid & 15) * 16);
      const uint32_t lo_n = (uint32_t)((tid >> 4) * 400 + (tid & 15) * 16);
      const uint32_t vo_r = (uint32_t)((tid >> 3) * 128 + (tid & 7) * 16);
      const uint32_t lo_r = (uint32_t)((tid >> 3) * 400 + 256 + (tid & 7) * 16);
      const uint32_t vo_v = (uint32_t)((tid >> 3) * (NKEY * 2) + (tid & 7) * 16);
      const uint32_t lo_v = (uint32_t)((tid >> 3) * 144 + (tid & 7) * 16);
      uint4 t0 = *(const uint4*)(bk + vo_n);
      uint4 t1 = *(const uint4*)(bk + 16 * 2048 + vo_n);
      uint4 t2 = *(const uint4*)(bk + 32 * 2048 + vo_n);
      uint4 t3 = *(const uint4*)(bk + 48 * 2048 + vo_n);
      uint4 t4 = *(const uint4*)(br + vo_r);
      uint4 t5 = *(const uint4*)(br + 32 * 128 + vo_r);
      *(uint4*)((char*)sK + lo_n) = t0;
      *(uint4*)((char*)sK + 16 * 400 + lo_n) = t1;
      *(uint4*)((char*)sK + 32 * 400 + lo_n) = t2;
      *(uint4*)((char*)sK + 48 * 400 + lo_n) = t3;
      *(uint4*)((char*)sK + lo_r) = t4;
      *(uint4*)((char*)sK + 32 * 400 + lo_r) = t5;
      __builtin_amdgcn_sched_barrier(0);
      uint4 u0 = *(const uint4*)(bv + vo_v);
      uint4 u1 = *(const uint4*)(bv + (size_t)32 * NKEY * 2 + vo_v);
      uint4 u2 = *(const uint4*)(bv + (size_t)64 * NKEY * 2 + vo_v);
      uint4 u3 = *(const uint4*)(bv + (size_t)96 * NKEY * 2 + vo_v);
      *(uint4*)((char*)sV + lo_v) = u0;
      *(uint4*)((char*)sV + 32 * 144 + lo_v) = u1;
      *(uint4*)((char*)sV + 64 * 144 + lo_v) = u2;
      *(uint4*)((char*)sV + 96 * 144 + lo_v) = u3;
    }
    __syncthreads();
    f32x16 sacc[2];
#pragma unroll
    for (int m = 0; m < 2; m++) {
#pragma unroll
      for (int e = 0; e < 16; e++) sacc[m][e] = 0.f;
      const bf16* kp = sK + (m * 32 + pr) * 200 + hf * 8;
#pragma unroll
      for (int kk = 0; kk < 12; kk++) {
        bf16x8 kf = *(const bf16x8*)(kp + kk * 16);
        sacc[m] = __builtin_amdgcn_mfma_f32_32x32x16_bf16(kf, qf[kk], sacc[m], 0, 0, 0);
        if ((kk & 3) == 3) __builtin_amdgcn_sched_barrier(0);
      }
      __builtin_amdgcn_sched_barrier(0);
    }
    float tmax = sacc[0][0];
#pragma unroll
    for (int e = 1; e < 16; e++) tmax = fmaxf(tmax, sacc[0][e]);
#pragma unroll
    for (int e = 0; e < 16; e++) tmax = fmaxf(tmax, sacc[1][e]);
    tmax = fmaxf(tmax, __shfl_xor(tmax, 32));
    float mnew = fmaxf(mrun, tmax);
    float alpha = __builtin_amdgcn_exp2f(mrun - mnew);
    mrun = mnew;
    float psum = 0.f;
#pragma unroll
    for (int m = 0; m < 2; m++)
#pragma unroll
      for (int e = 0; e < 16; e++) { float pv = __builtin_amdgcn_exp2f(sacc[m][e] - mnew); sacc[m][e] = pv; psum += pv; }
    lrun = lrun * alpha + psum;
#pragma unroll
    for (int i = 0; i < 4; i++)
#pragma unroll
      for (int e = 0; e < 16; e++) oacc[i][e] *= alpha;
#pragma unroll
    for (int s = 0; s < 4; s++) {
      const int m = s >> 1, s2 = s & 1;
      bf16x8 pf;
#pragma unroll
      for (int j = 0; j < 8; j++) pf[j] = (short)f2bf(sacc[m][8 * s2 + j]);
#pragma unroll
      for (int i = 0; i < 4; i++) {
        bf16x8 vf = *(const bf16x8*)(sV + (i * 32 + r) * 72 + m * 32 + s2 * 16 + hf * 8);
        oacc[i] = __builtin_amdgcn_mfma_f32_32x32x16_bf16(vf, pf, oacc[i], 0, 0, 0);
      }
      __builtin_amdgcn_sched_barrier(0);
    }
  }
  lrun += __shfl_xor(lrun, 32);
  const float inv = 1.f / lrun;
  bf16* op = QB + (size_t)(qrow0 + wave * 32 + r) * 1536 + hd * 192;
  if (dry) op = (bf16*)(ws + B_END) + ((((size_t)(qrow0 + wave * 32 + r) * 1536 + hd * 192)) & 0x3ffff8);
#pragma unroll
  for (int i = 0; i < 4; i++)
#pragma unroll
    for (int g = 0; g < 4; g++) {
      uint2 o;
      o.x = pack2(oacc[i][4 * g] * inv, oacc[i][4 * g + 1] * inv);
      o.y = pack2(oacc[i][4 * g + 2] * inv, oacc[i][4 * g + 3] * inv);
      *(uint2*)(op + 32 * i + 8 * g + 4 * hf) = o;
    }
}

DEV void phase_mixers(int tidv, int bidv, const Params& p, int l, char* smem, int dry) {
  __shared__ int s_item;
  for (int task = bidv; task < 256; task += gridDim.x) {
#if !defined(MIX_ONLY) || MIX_ONLY == 0
    if (task < 128) rwkv_scan(tidv, bidv, p, l, task, smem, dry);
#endif
#if !defined(MIX_ONLY) || MIX_ONLY == 1
    if (task >= 128) s5_scan(tidv, bidv, p, l, (task - 128) * 4 + (tidv >> 6), smem + (tidv >> 6) * 9472, dry);
#endif
  }
  const int nlat = 1024, ntot = (l == 0) ? 1088 : 1024;
  int* cnt = (int*)(p.ws + B_CNT) + l + 2 * dry;
#if !defined(MIX_ONLY) || MIX_ONLY == 2
  while (true) {
    __syncthreads();
    if (tidv == 0) s_item = atomicAdd(cnt, 1);
    __syncthreads();
    int item = s_item;
    if (item >= ntot) break;
    if (item < nlat) attn_item(tidv, bidv, p, item, false, smem, dry);
    else attn_item(tidv, bidv, p, item - nlat, true, smem, dry);
  }
#endif
}

DEV float gelu_tanh(float x) {
  float u = 0.7978845608028654f * (x + 0.044715f * x * x * x);
  return 0.5f * x * (1.f + tanhf(u));
}

DEV void phase_post(int tidv, int bidv, const Params& p, int l, int M) {
  char* ws = p.ws;
  const bf16* Z = (const bf16*)(ws + B_ZB);
  const int wave = tidv >> 6, lane = tidv & 63;
  const float* cw = p.in[17] + (size_t)l * 3 * 3072;
  const bf16* YF = (const bf16*)(ws + B_HB);
  const bf16* YB = (const bf16*)(ws + B_HB + SZ1K);
  const bf16* AF = (const bf16*)(ws + B_AF);
  const bf16* AB = (const bf16*)(ws + B_AB);
  bf16* GB = (bf16*)(ws + B_GB);
  const int nitem = M * 16;
  for (int it = bidv * 4 + wave; it < nitem; it += gridDim.x * 4) {
    int row = it >> 4, h = it & 15;
    int ch = h * 64 + lane;
    int tau, len;
    if (row < ML) { tau = row & 4095; len = 4096; } else { tau = (row - ML) & 255; len = 256; }
    size_t o = (size_t)row * 1024 + ch;
    float y = bf2f(YF[o]) + bf2f(YB[o]);
    float mu = wsum(y) * (1.f / 64.f);
    float dv = y - mu;
    float var = wsum(dv * dv) * (1.f / 64.f);
    float yn = dv * rsqrtf(var + 64e-5f) * p.in[26][l * 1024 + ch] + p.in[27][l * 1024 + ch];
    const bf16* z = Z + (size_t)row * NIN + C_R + ch;
    float r1 = bf2f(z[0]), k1 = bf2f(z[1024]), v1 = bf2f(z[2048]);
    float r0 = 0.f, k0 = 0.f, v0 = 0.f, r2 = 0.f, k2 = 0.f, v2 = 0.f;
    if (tau > 0) { const bf16* zm = z - NIN; r0 = bf2f(zm[0]); k0 = bf2f(zm[1024]); v0 = bf2f(zm[2048]); }
    if (tau < len - 1) { const bf16* zp = z + NIN; r2 = bf2f(zp[0]); k2 = bf2f(zp[1024]); v2 = bf2f(zp[2048]); }
    float rr = cw[ch] * r0 + cw[3072 + ch] * r1 + cw[6144 + ch] * r2;
    float kk = cw[1024 + ch] * k0 + cw[3072 + 1024 + ch] * k1 + cw[6144 + 1024 + ch] * k2;
    float vv = cw[2048 + ch] * v0 + cw[3072 + 2048 + ch] * v1 + cw[6144 + 2048 + ch] * v2;
    float am = 0.5f * (bf2f(AF[o]) + bf2f(AB[o]));
    float kbon = kk * (1.f + (am - 1.f) * p.in[24][l * 1024 + ch]);
    float s = wsum(rr * kbon * p.in[25][l * 1024 + ch]);
    float outv = (yn + s * vv) * bf2f(GB[o]);
    GB[o] = f2bf(outv);
  }
  bf16* SY = (bf16*)(ws + B_SY);
  const float* dsk = p.in[35] + l * 1024;
  const int n4 = M * 256;
  for (int i = bidv * 256 + tidv; i < n4; i += gridDim.x * 256) {
    int row = i >> 8, c = (i & 255) * 4;
    uint2 a = *(const uint2*)(SY + (size_t)row * 1024 + c);
    uint2 bq = *(const uint2*)(Z + (size_t)row * NIN + c);
    uint2 u = *(const uint2*)(Z + (size_t)row * NIN + C_U + c);
    float4 dd = *(const float4*)(dsk + c);
    float y0 = bf2f((bf16)(a.x & 0xffff)) + bf2f((bf16)(bq.x & 0xffff)) + dd.x * bf2f((bf16)(u.x & 0xffff));
    float y1 = bf2f((bf16)(a.x >> 16)) + bf2f((bf16)(bq.x >> 16)) + dd.y * bf2f((bf16)(u.x >> 16));
    float y2 = bf2f((bf16)(a.y & 0xffff)) + bf2f((bf16)(bq.y & 0xffff)) + dd.z * bf2f((bf16)(u.y & 0xffff));
    float y3 = bf2f((bf16)(a.y >> 16)) + bf2f((bf16)(bq.y >> 16)) + dd.w * bf2f((bf16)(u.y >> 16));
    uint2 o;
    o.x = pack2(gelu_tanh(y0), gelu_tanh(y1));
    o.y = pack2(gelu_tanh(y2), gelu_tanh(y3));
    *(uint2*)(SY + (size_t)row * 1024 + c) = o;
  }
}

constexpr int NPH = 25;

DEV void run_phase(int tidv, int bidv, const Params& p, int ph, char* smem, int dry) {
  char* ws = p.ws;
#ifndef ONLY_S
  if (ph == 0) {
    if (bidv == 0 && tidv < 4) ((int*)(ws + B_CNT))[tidv] = 0;
    phase_mod(tidv, bidv, p, smem);
    phase_convw(tidv, bidv, p, 0, smem);
    return;
  }
#endif
  const int l = (ph - 1) / 12, s = (ph - 1) % 12;
#ifdef ONLY_S
  if (s != ONLY_S) return;
#endif
  const bf16* wb = (const bf16*)(ws + B_WB);
  const float* mod = (const float*)(ws + B_MOD) + (size_t)l * 5 * 12288;
  float* XC = (float*)(ws + B_XC);
  const float* xin_lat = l == 0 ? p.in[0] : p.out;
  const float* xin_ctx = l == 0 ? p.in[2] : XC;
  bf16* HB = (bf16*)(ws + B_HB);
  bf16* Z = (bf16*)(ws + B_ZB);
  bf16* H2 = (bf16*)(ws + B_KN);
  const int Mpost = l == 0 ? MT : ML;
  switch (s) {
    case 0:
      if (l == 1) phase_convw(tidv, bidv, p, 1, smem);
      phase_norm(tidv, bidv, xin_lat, xin_ctx, p.in[6] + l * 2048, mod, 0, 2048, HB, MT);
      break;
    case 1:
      run_gemm<G_IN>(tidv, bidv, p, l, smem, HB, 2048, wb + OW_IN, 2048, NIN, MT, 0, nullptr, nullptr, nullptr, nullptr);
      break;
    case 2:
      run_gemm<G_UKV>(tidv, bidv, p, l, smem, Z + C_CKV, NIN, wb + OW_UKV, 512, 2048, MT, 0, nullptr, nullptr, nullptr, nullptr);
      run_gemm<G_UQ>(tidv, bidv, p, l, smem, Z + C_CQ, NIN, wb + OW_UQ, 512, 1536, MT, 0, nullptr, nullptr, nullptr, nullptr);
      run_gemm<G_G2>(tidv, bidv, p, l, smem, Z + C_GD, NIN, wb + OW_G2, 192, 1024, MT, 0, nullptr, nullptr, nullptr, nullptr);
      for (int d = 0; d < 2; d++) {
        run_gemm<G_W2>(tidv, bidv, p, l, smem, Z + C_WD + 64 * d, NIN, wb + OW_W2 + (size_t)d * 65536, 64, 1024, MT, d, nullptr, nullptr, nullptr, nullptr);
        run_gemm<G_A2>(tidv, bidv, p, l, smem, Z + C_AD + 64 * d, NIN, wb + OW_A2 + (size_t)d * 65536, 64, 1024, MT, d, nullptr, nullptr, nullptr, nullptr);
      }
      break;
    case 3: phase_mla_post(tidv, bidv, p, l); break;
    case 4: phase_mixers(tidv, bidv, p, l, smem, dry); break;
    case 5: phase_post(tidv, bidv, p, l, Mpost); break;
    case 6:
      run_gemm<G_GLU>(tidv, bidv, p, l, smem, (const bf16*)(ws + B_SY), 1024, wb + OW_GLU, 1024, 1024, Mpost, 0, nullptr, nullptr, nullptr, nullptr);
      break;
    case 7:
      run_gemm<G_MG0>(tidv, bidv, p, l, smem, (const bf16*)(ws + B_QB), 1536, wb + OW_BR, 1024, 2048, Mpost, 0, nullptr, nullptr, nullptr, nullptr);
      run_gemm<G_MG1>(tidv, bidv, p, l, smem, (const bf16*)(ws + B_GB), 1024, wb + OW_BR + (size_t)2048 * 1024, 1024, 2048, Mpost, 0, nullptr, nullptr, nullptr, nullptr);
      run_gemm<G_MG2>(tidv, bidv, p, l, smem, Z, NIN, wb + OW_BR + (size_t)2 * 2048 * 1024, 1024, 2048, Mpost, 0, nullptr, nullptr, nullptr, nullptr);
      break;
    case 8:
      run_gemm<G_OUT>(tidv, bidv, p, l, smem, HB, 2048, wb + OW_OUT, 2048, 2048, Mpost, 0, xin_lat, xin_ctx, p.out, XC);
      break;
    case 9:
      phase_norm(tidv, bidv, p.out, XC, p.in[7] + l * 2048, mod, 6144, 8192, H2, Mpost);
      break;
    case 10:
      run_gemm<G_M1>(tidv, bidv, p, l, smem, H2, 2048, wb + OW_M1, 2048, 8192, Mpost, 0, nullptr, nullptr, nullptr, nullptr);
      break;
    case 11:
      run_gemm<G_M2>(tidv, bidv, p, l, smem, Z, 8192, wb + OW_M2, 8192, 2048, Mpost, 0, nullptr, nullptr, p.out, XC);
      break;
  }
}

__global__ void __launch_bounds__(256, 2) fwd_megakernel(Params p, int ph0, int ph1, int dryflag) {
  __shared__ __attribute__((aligned(16))) char smem[2 * GSTAGE + 512];
  for (int ph = ph0; ph < ph1; ph++) {
    int tidv = threadIdx.x, bidv = blockIdx.x;
    asm volatile("" : "+v"(tidv));
    asm volatile("" : "+s"(bidv));
#ifdef PROBE_MASK
    if (dryflag && ((ph == 0 && (PROBE_MASK & 0x1000)) || (ph > 0 && ((PROBE_MASK >> ((ph - 1) % 12)) & 1)))) {
      run_phase(tidv, bidv, p, ph, smem, dryflag);
      cg::this_grid().sync();
    }
#endif
    run_phase(tidv, bidv, p, ph, smem, 0);
    if (ph + 1 < ph1) cg::this_grid().sync();
  }
}

extern "C" void kernel_launch(void* const* d_in, const int* in_sizes, int n_in, void* d_out, int out_size, void* d_ws, size_t ws_size,
                              hipStream_t stream) {
  static int grid_blocks = 0;
  if (!grid_blocks) {
    int dev = 0, cus = 0, per_cu = 0;
    hipGetDevice(&dev);
    hipDeviceGetAttribute(&cus, hipDeviceAttributeMultiprocessorCount, dev);
    hipOccupancyMaxActiveBlocksPerMultiprocessor(&per_cu, fwd_megakernel, 256, 0);
    if (per_cu < 1) per_cu = 1;
    if (per_cu > 2) per_cu = 2;
    grid_blocks = cus * per_cu;
  }
  Params p{};
  for (int i = 0; i < 42; i++) p.in[i] = (const float*)d_in[i];
  p.out = (float*)d_out;
  p.ws = (char*)d_ws;
  if (ws_size < B_END + (8u << 20)) { fprintf(stderr, "workspace too small\n"); return; }
#if MULTI_LAUNCH
  for (int ph = 0; ph < NPH; ph++) {
    hipLaunchKernelGGL(fwd_megakernel, dim3(grid_blocks), dim3(256), 0, stream, p, ph, ph + 1, 0);
  }
#else
  int ph0 = 0, ph1 = NPH;
  int dryflag = 1;
  void* args[] = {&p, &ph0, &ph1, &dryflag};
  hipError_t e = hipLaunchCooperativeKernel((void*)fwd_megakernel, dim3(grid_blocks), dim3(256), args, 0, stream);
  if (e != hipSuccess) fprintf(stderr, "cooperative launch failed: %s (grid %d)\n", hipGetErrorString(e), grid_blocks);
#endif
}
```

```cpp
#include <hip/hip_runtime.h>
#include <hip/hip_cooperative_groups.h>
#include <stdint.h>
#include <cstdio>
namespace cg = cooperative_groups;

#ifndef MULTI_LAUNCH
#define MULTI_LAUNCH 0
#endif

typedef unsigned short bf16;
using bf16x8 = __attribute__((ext_vector_type(8))) short;
using f32x4 = __attribute__((ext_vector_type(4))) float;
using f32x16 = __attribute__((ext_vector_type(16))) float;

#define DEV __device__ __forceinline__

constexpr int DM = 2048, ML = 16384, MC = 1024, MT = 17408, NIN = 11744, DFF = 8192, NKEY = 4352;
constexpr int C_CQ = 0, C_CKV = 512, C_KR = 1024, C_R = 1088, C_WD = 4160, C_AD = 4288, C_GD = 4416, C_U = 4576, C_GATE = 5600;

constexpr size_t OW_IN = 0;
constexpr size_t OW_UQ = OW_IN + (size_t)NIN * 2048;
constexpr size_t OW_UKV = OW_UQ + 1536 * 512;
constexpr size_t OW_W2 = OW_UKV + 2048 * 512;
constexpr size_t OW_A2 = OW_W2 + 2 * 1024 * 64;
constexpr size_t OW_G2 = OW_A2 + 2 * 1024 * 64;
constexpr size_t OW_GLU = OW_G2 + 1024 * 192;
constexpr size_t OW_BR = OW_GLU + 1024 * 1024;
constexpr size_t OW_OUT = OW_BR + (size_t)3 * 2048 * 1024;
constexpr size_t OW_M1 = OW_OUT + (size_t)2048 * 2048;
constexpr size_t OW_M2 = OW_M1 + (size_t)8192 * 2048;
constexpr size_t OW_END = OW_M2 + (size_t)8192 * 2048;

constexpr size_t SZ1K = (size_t)MT * 1024 * 2;
constexpr size_t B_WB = 0;
constexpr size_t B_HB = B_WB + OW_END * 2;
constexpr size_t B_ZB = B_HB + (size_t)MT * 2048 * 2;
constexpr size_t B_QB = B_ZB + (size_t)MT * NIN * 2;
constexpr size_t B_KN = B_QB + (size_t)MT * 1536 * 2;
constexpr size_t B_VT = B_KN + SZ1K;
constexpr size_t B_KR = B_VT + SZ1K;
constexpr size_t B_AF = B_KR + (size_t)MT * 64 * 2;
constexpr size_t B_AB = B_AF + SZ1K;
constexpr size_t B_GB = B_AB + SZ1K;
constexpr size_t B_SY = B_GB + SZ1K;
constexpr size_t B_XC = B_SY + SZ1K;
constexpr size_t B_MOD = B_XC + (size_t)MC * 2048 * 4;
constexpr size_t B_CNT = B_MOD + (size_t)2 * 5 * 12288 * 4;
constexpr size_t B_FLG = B_CNT + 256;
constexpr size_t B_END = B_FLG + 4096;

struct Params {
  const float* in[42];
  float* out;
  char* ws;
};

typedef __attribute__((ext_vector_type(2))) __bf16 hbf2;
DEV bf16 f2bf(float f) {
  __bf16 h = (__bf16)f;
  return *(unsigned short*)&h;
}
DEV float bf2f(bf16 h) { return __uint_as_float(((uint32_t)h) << 16); }
DEV uint32_t pack2(float a, float b) {
  hbf2 v;
  v[0] = (__bf16)a;
  v[1] = (__bf16)b;
  return *(uint32_t*)&v;
}
DEV float wsum(float v) {
#pragma unroll
  for (int o = 32; o > 0; o >>= 1) v += __shfl_xor(v, o);
  return v;
}
DEV float dpp_xor1(float v) {
  int i = __float_as_int(v);
  return __int_as_float(__builtin_amdgcn_update_dpp(i, i, 0xB1, 0xF, 0xF, false));
}
DEV float dpp_xor2(float v) {
  int i = __float_as_int(v);
  return __int_as_float(__builtin_amdgcn_update_dpp(i, i, 0x4E, 0xF, 0xF, false));
}
DEV float sigmoidf_(float x) { return 1.f / (1.f + __expf(-x)); }

DEV void phase_mod(int tidv, int bidv, const Params& p, char* smem) {
  float* s_in = (float*)smem;
  float* red = s_in + 5 * 2048;
  float* mod = (float*)(p.ws + B_MOD);
  for (int i = tidv; i < 5 * 2048; i += 256) {
    int r = i >> 11, k = i & 2047;
    float v = r < 4 ? p.in[1][r * 2048 + k] : p.in[3][k];
    s_in[i] = v / (1.f + expf(-v));
  }
  __syncthreads();
  int kg = tidv >> 6, c = tidv & 63;
  for (int task = bidv; task < 2 * 192; task += gridDim.x) {
    int l = task / 192, n = (task % 192) * 64 + c;
    const float* w = p.in[4] + (size_t)l * 2048 * 12288 + n;
    float a0 = 0, a1 = 0, a2 = 0, a3 = 0, a4 = 0;
    int kb = kg * 512;
#pragma unroll 8
    for (int k = 0; k < 512; k++) {
      float wv = w[(size_t)(kb + k) * 12288];
      a0 += s_in[kb + k] * wv;
      a1 += s_in[2048 + kb + k] * wv;
      a2 += s_in[4096 + kb + k] * wv;
      a3 += s_in[6144 + kb + k] * wv;
      a4 += s_in[8192 + kb + k] * wv;
    }
    red[(kg * 5 + 0) * 64 + c] = a0;
    red[(kg * 5 + 1) * 64 + c] = a1;
    red[(kg * 5 + 2) * 64 + c] = a2;
    red[(kg * 5 + 3) * 64 + c] = a3;
    red[(kg * 5 + 4) * 64 + c] = a4;
    __syncthreads();
    if (kg == 0) {
      float bias = p.in[5][l * 12288 + n];
#pragma unroll
      for (int r = 0; r < 5; r++) {
        float v = red[(0 * 5 + r) * 64 + c] + red[(1 * 5 + r) * 64 + c] + red[(2 * 5 + r) * 64 + c] + red[(3 * 5 + r) * 64 + c];
        mod[(size_t)(l * 5 + r) * 12288 + n] = v + bias;
      }
    }
    __syncthreads();
  }
}

DEV void convT(int tidv, int bidv, const float* __restrict__ src, bf16* __restrict__ dst, int K, int N, const float* __restrict__ gain, char* smem, int dK = 0) {
  if (dK == 0) dK = K;
  float* t = (float*)smem;
  int tk = (K + 63) >> 6, tn = (N + 63) >> 6;
  for (int tile = bidv; tile < tk * tn; tile += gridDim.x) {
    int k0 = (tile / tn) * 64, n0 = (tile % tn) * 64;
    __syncthreads();
#pragma unroll 4
    for (int i = 0; i < 16; i++) {
      int kk = i * 4 + (tidv >> 6), nn = tidv & 63;
      float v = 0.f;
      if (k0 + kk < K && n0 + nn < N) {
        v = src[(size_t)(k0 + kk) * N + n0 + nn];
        if (gain) v *= gain[k0 + kk];
      }
      t[kk * 65 + nn] = v;
    }
    __syncthreads();
#pragma unroll
    for (int i = 0; i < 2; i++) {
      int c = tidv + 256 * i;
      int nn = c >> 3, kc = c & 7;
      if (n0 + nn < N && k0 + kc * 8 < dK) {
        uint4 o;
        o.x = pack2(t[(kc * 8 + 0) * 65 + nn], t[(kc * 8 + 1) * 65 + nn]);
        o.y = pack2(t[(kc * 8 + 2) * 65 + nn], t[(kc * 8 + 3) * 65 + nn]);
        o.z = pack2(t[(kc * 8 + 4) * 65 + nn], t[(kc * 8 + 5) * 65 + nn]);
        o.w = pack2(t[(kc * 8 + 6) * 65 + nn], t[(kc * 8 + 7) * 65 + nn]);
        *(uint4*)(dst + (size_t)(n0 + nn) * dK + k0 + kc * 8) = o;
      }
    }
  }
}

DEV void phase_convw(int tidv, int bidv, const Params& p, int l, char* smem) {
  bf16* wb = (bf16*)(p.ws + B_WB);
  convT(tidv, bidv, p.in[8] + (size_t)l * 2048 * NIN, wb + OW_IN, 2048, NIN, nullptr, smem);
  convT(tidv, bidv, p.in[40] + (size_t)l * 2048 * 8192, wb + OW_M1, 2048, 8192, nullptr, smem);
  convT(tidv, bidv, p.in[41] + (size_t)l * 8192 * 2048, wb + OW_M2, 8192, 2048, nullptr, smem);
  for (int n = 0; n < 3; n++)
    convT(tidv, bidv, p.in[38] + (size_t)(l * 3 + n) * 1024 * 2048, wb + OW_BR + (size_t)n * 2048 * 1024, 1024, 2048, nullptr, smem);
  convT(tidv, bidv, p.in[39] + (size_t)l * 2048 * 2048, wb + OW_OUT, 2048, 2048, nullptr, smem);
  convT(tidv, bidv, p.in[11] + (size_t)l * 512 * 1536, wb + OW_UQ, 512, 1536, p.in[9] + l * 512, smem);
  convT(tidv, bidv, p.in[12] + (size_t)l * 512 * 2048, wb + OW_UKV, 512, 2048, p.in[10] + l * 512, smem);
  convT(tidv, bidv, p.in[36] + (size_t)l * 1024 * 1024, wb + OW_GLU, 1024, 1024, nullptr, smem);
  for (int d = 0; d < 2; d++) {
    convT(tidv, bidv, p.in[19] + (size_t)(l * 2 + d) * 64 * 1024, wb + OW_W2 + (size_t)d * 65536, 64, 1024, nullptr, smem);
    convT(tidv, bidv, p.in[21] + (size_t)(l * 2 + d) * 64 * 1024, wb + OW_A2 + (size_t)d * 65536, 64, 1024, nullptr, smem);
  }
  convT(tidv, bidv, p.in[22] + (size_t)l * 160 * 1024, wb + OW_G2, 160, 1024, nullptr, smem, 192);
}

DEV void phase_norm(int tidv, int bidv, const float* xlat, const float* xctx, const float* g, const float* mod, int shOff, int scOff, bf16* H, int nrows) {
  int wave = tidv >> 6, lane = tidv & 63;
  for (int row = bidv * 4 + wave; row < nrows; row += gridDim.x * 4) {
    const float* x = row < ML ? xlat + (size_t)row * 2048 : xctx + (size_t)(row - ML) * 2048;
    int b = row < ML ? (row >> 12) : 4;
    const float* sh = mod + b * 12288 + shOff;
    const float* sc = mod + b * 12288 + scOff;
    float4 v[8];
    float ss = 0.f;
#pragma unroll
    for (int i = 0; i < 8; i++) {
      v[i] = *(const float4*)(x + i * 256 + lane * 4);
      ss += v[i].x * v[i].x + v[i].y * v[i].y + v[i].z * v[i].z + v[i].w * v[i].w;
    }
    ss = wsum(ss);
    float rinv = rsqrtf(ss * (1.f / 2048.f) + 1e-6f);
#pragma unroll
    for (int i = 0; i < 8; i++) {
      int c = i * 256 + lane * 4;
      float4 g4 = *(const float4*)(g + c), s4 = *(const float4*)(sc + c), h4 = *(const float4*)(sh + c);
      float y0 = v[i].x * rinv * g4.x * (1.f + s4.x) + h4.x;
      float y1 = v[i].y * rinv * g4.y * (1.f + s4.y) + h4.y;
      float y2 = v[i].z * rinv * g4.z * (1.f + s4.z) + h4.z;
      float y3 = v[i].w * rinv * g4.w * (1.f + s4.w) + h4.w;
      uint2 o;
      o.x = pack2(y0, y1);
      o.y = pack2(y2, y3);
      *(uint2*)(H + (size_t)row * 2048 + c) = o;
    }
  }
}

constexpr int LDT = 72;
constexpr int GSTAGE = 2 * 128 * LDT * 2;
DEV float sumsq8(uint4 r) {
  float s = 0.f, x;
  x = bf2f((bf16)(r.x & 0xffff)); s += x * x; x = bf2f((bf16)(r.x >> 16)); s += x * x;
  x = bf2f((bf16)(r.y & 0xffff)); s += x * x; x = bf2f((bf16)(r.y >> 16)); s += x * x;
  x = bf2f((bf16)(r.z & 0xffff)); s += x * x; x = bf2f((bf16)(r.z >> 16)); s += x * x;
  x = bf2f((bf16)(r.w & 0xffff)); s += x * x; x = bf2f((bf16)(r.w >> 16)); s += x * x;
  return s;
}

template <bool ROWNORM>
DEV void gemm_mainloop(int tidv, int bidv, const bf16* __restrict__ A, int lda, bool amap, const bf16* __restrict__ Bt, int K, int N, int m0, int n0,
                       char* smem, f32x4 (&acc)[4][4]) {
  float* srinv = (float*)(smem + 2 * GSTAGE);
  const int tid = tidv, lane = tid & 63, wave = tid >> 6;
  const int wm = wave >> 1, wn = wave & 1;
  const int lr = tid >> 3, kc = tid & 7;
  const char* abase = (const char*)(A + (size_t)m0 * lda);
  const char* bbase = (const char*)(Bt + (size_t)n0 * K);
  const uint32_t voa = (uint32_t)(lr * lda + kc * 8) * 2u;
  const uint32_t astep = (uint32_t)(32 * lda) * 2u;
  uint32_t vob[4];
#pragma unroll
  for (int i = 0; i < 4; i++) {
    int nr = n0 + lr + 32 * i;
    if (nr > N - 1) nr = N - 1;
    vob[i] = (uint32_t)((nr - n0) * K + kc * 8) * 2u;
  }
  const uint32_t lds_st = (uint32_t)(lr * LDT + kc * 8) * 2u;
  const int nk = K >> 6;
  uint4 ra0, ra1, ra2, ra3, rb0, rb1, rb2, rb3;
  float ss0 = 0.f, ss1 = 0.f, ss2 = 0.f, ss3 = 0.f;
  const uint32_t vob0 = vob[0], vob1 = vob[1], vob2 = vob[2], vob3 = vob[3];
#define G_LOAD(KA, KB)                                              \
  ra0 = *(const uint4*)(abase + (size_t)(KA) * 2 + voa);            \
  ra1 = *(const uint4*)(abase + (size_t)(KA) * 2 + astep + voa);    \
  ra2 = *(const uint4*)(abase + (size_t)(KA) * 2 + 2 * astep + voa);\
  ra3 = *(const uint4*)(abase + (size_t)(KA) * 2 + 3 * astep + voa);\
  rb0 = *(const uint4*)(bbase + (size_t)(KB) * 2 + vob0);           \
  rb1 = *(const uint4*)(bbase + (size_t)(KB) * 2 + vob1);           \
  rb2 = *(const uint4*)(bbase + (size_t)(KB) * 2 + vob2);           \
  rb3 = *(const uint4*)(bbase + (size_t)(KB) * 2 + vob3);
#define G_STORE(SN)                                                       \
  *(uint4*)((SN) + lds_st) = ra0;                                         \
  *(uint4*)((SN) + 1 * (32 * LDT * 2) + lds_st) = ra1;                    \
  *(uint4*)((SN) + 2 * (32 * LDT * 2) + lds_st) = ra2;                    \
  *(uint4*)((SN) + 3 * (32 * LDT * 2) + lds_st) = ra3;                    \
  *(uint4*)((SN) + 128 * LDT * 2 + lds_st) = rb0;                         \
  *(uint4*)((SN) + 128 * LDT * 2 + 1 * (32 * LDT * 2) + lds_st) = rb1;    \
  *(uint4*)((SN) + 128 * LDT * 2 + 2 * (32 * LDT * 2) + lds_st) = rb2;    \
  *(uint4*)((SN) + 128 * LDT * 2 + 3 * (32 * LDT * 2) + lds_st) = rb3;    \
  if (ROWNORM) { ss0 += sumsq8(ra0); ss1 += sumsq8(ra1); ss2 += sumsq8(ra2); ss3 += sumsq8(ra3); }
  G_LOAD(0, 0)
  __syncthreads();
  G_STORE(smem)
  __syncthreads();
  const uint32_t fa = (uint32_t)((wm * 64 + (lane & 15)) * LDT + (lane >> 4) * 8) * 2u;
  const uint32_t fb = (uint32_t)(128 * LDT + (wn * 64 + (lane & 15)) * LDT + (lane >> 4) * 8) * 2u;
  for (int kt = 0; kt < nk; kt++) {
    const char* st = smem + (kt & 1) * GSTAGE;
    if (kt + 1 < nk) {
      int k0 = (kt + 1) << 6;
      int ka = amap ? ((k0 >> 7) * 192 + (k0 & 127)) : k0;
      G_LOAD(ka, k0)
    }
#pragma unroll
    for (int ks = 0; ks < 2; ks++) {
      bf16x8 af[4], bfr[4];
#pragma unroll
      for (int i = 0; i < 4; i++) af[i] = *(const bf16x8*)(st + fa + i * (16 * LDT * 2) + ks * 64);
#pragma unroll
      for (int j = 0; j < 4; j++) bfr[j] = *(const bf16x8*)(st + fb + j * (16 * LDT * 2) + ks * 64);
#pragma unroll
      for (int i = 0; i < 4; i++)
#pragma unroll
        for (int j = 0; j < 4; j++) acc[i][j] = __builtin_amdgcn_mfma_f32_16x16x32_bf16(bfr[j], af[i], acc[i][j], 0, 0, 0);
    }
    if (kt + 1 < nk) {
      char* sn = smem + ((kt + 1) & 1) * GSTAGE;
      G_STORE(sn)
    }
    __syncthreads();
  }
  if (ROWNORM) {
    float v;
    v = ss0; v += __shfl_xor(v, 1); v += __shfl_xor(v, 2); v += __shfl_xor(v, 4); if (kc == 0) srinv[lr] = rsqrtf(v / (float)K + 1e-6f);
    v = ss1; v += __shfl_xor(v, 1); v += __shfl_xor(v, 2); v += __shfl_xor(v, 4); if (kc == 0) srinv[lr + 32] = rsqrtf(v / (float)K + 1e-6f);
    v = ss2; v += __shfl_xor(v, 1); v += __shfl_xor(v, 2); v += __shfl_xor(v, 4); if (kc == 0) srinv[lr + 64] = rsqrtf(v / (float)K + 1e-6f);
    v = ss3; v += __shfl_xor(v, 1); v += __shfl_xor(v, 2); v += __shfl_xor(v, 4); if (kc == 0) srinv[lr + 96] = rsqrtf(v / (float)K + 1e-6f);
    __syncthreads();
  }
#undef G_LOAD
#undef G_STORE
}

DEV void zero_acc(f32x4 (&acc)[4][4]) {
#pragma unroll
  for (int i = 0; i < 4; i++)
#pragma unroll
    for (int j = 0; j < 4; j++) acc[i][j] = f32x4{0.f, 0.f, 0.f, 0.f};
}

template <class F>
DEV void epi_loop(int tidv, int bidv, f32x4 (&acc)[4][4], int m0, int n0, int N, F f) {
  const int lane = tidv & 63, wave = tidv >> 6;
  const int wm = wave >> 1, wn = wave & 1;
#pragma unroll
  for (int i = 0; i < 4; i++) {
    const int lrow = wm * 64 + i * 16 + (lane & 15);
#pragma unroll
    for (int j = 0; j < 4; j++) {
      int col = n0 + wn * 64 + j * 16 + (lane >> 4) * 4;
      if (col < N) f(m0 + lrow, lrow, col, acc[i][j]);
    }
    __builtin_amdgcn_sched_barrier(0);
  }
}

DEV uint2 pack4(f32x4 v) {
  uint2 o;
  o.x = pack2(v[0], v[1]);
  o.y = pack2(v[2], v[3]);
  return o;
}
DEV f32x4 unpack4(uint2 u) {
  f32x4 v;
  v[0] = bf2f((bf16)(u.x & 0xffff)); v[1] = bf2f((bf16)(u.x >> 16));
  v[2] = bf2f((bf16)(u.y & 0xffff)); v[3] = bf2f((bf16)(u.y >> 16));
  return v;
}

enum { G_IN = 0, G_UQ, G_UKV, G_W2, G_A2, G_G2, G_GLU, G_OUT, G_M1, G_M2, G_MG0, G_MG1, G_MG2 };

template <int MODE>
DEV void run_gemm(int tidv, int bidv, const Params& p, int l, char* smem, const bf16* A, int lda, const bf16* Bt, int K, int N, int M, int aux,
                  const float* xin_lat, const float* xin_ctx, float* xout_lat, float* xout_ctx) {
  const int nt = (N + 127) >> 7, mt = M >> 7;
  char* ws = p.ws;
  bf16* Z = (bf16*)(ws + B_ZB);
  const float* srinv = (const float*)(smem + 2 * GSTAGE);
  const float* mod = (const float*)(ws + B_MOD) + (size_t)l * 5 * 12288;
  for (int tile = bidv; tile < nt * mt; tile += gridDim.x) {
    int m0 = (tile / nt) << 7, n0 = (tile % nt) << 7;
    f32x4 acc[4][4];
    zero_acc(acc);
    gemm_mainloop<(MODE == G_UQ || MODE == G_UKV)>(tidv, bidv, A, lda, MODE == G_MG0, Bt, K, N, m0, n0, smem, acc);
    epi_loop(tidv, bidv, acc, m0, n0, N, [&](int row, int lrow, int col, f32x4 v) {
      if constexpr (MODE == G_IN) {
        f32x4 o = v;
        if (col >= C_GATE || (col >= C_GD && col < C_U)) {
#pragma unroll
          for (int r = 0; r < 4; r++) o[r] = sigmoidf_(v[r]);
        } else if (col >= C_WD && col < C_AD) {
#pragma unroll
          for (int r = 0; r < 4; r++) o[r] = tanhf(v[r]);
        }
        *(uint2*)(Z + (size_t)row * NIN + col) = pack4(o);
      } else if constexpr (MODE == G_UQ) {
        float ri = srinv[lrow];
        *(uint2*)((bf16*)(ws + B_QB) + (size_t)row * 1536 + col) = pack4(v * ri);
      } else if constexpr (MODE == G_UKV) {
        float ri = srinv[lrow];
        f32x4 o = v * ri;
        int h = col >> 8, c = col & 255;
        if (c < 128) {
          *(uint2*)((bf16*)(ws + B_KN) + (size_t)row * 1024 + h * 128 + c) = pack4(o);
        } else {
          int b, kp;
          if (row < ML) { b = row >> 12; kp = row & 4095; } else { int r2 = row - ML; b = r2 >> 8; kp = 4096 + (r2 & 255); }
          bf16* vt = (bf16*)(ws + B_VT) + ((size_t)((b * 8 + h) * 128 + (c - 128))) * NKEY + kp;
#pragma unroll
          for (int r = 0; r < 4; r++) vt[(size_t)r * NKEY] = f2bf(o[r]);
        }
      } else if constexpr (MODE == G_W2) {
        float4 w0 = *(const float4*)(p.in[18] + (l * 2 + aux) * 1024 + col);
        f32x4 o;
        o[0] = 0.60653066f * sigmoidf_(w0.x + v[0]);
        o[1] = 0.60653066f * sigmoidf_(w0.y + v[1]);
        o[2] = 0.60653066f * sigmoidf_(w0.z + v[2]);
        o[3] = 0.60653066f * sigmoidf_(w0.w + v[3]);
        *(uint2*)((bf16*)(ws + B_HB + (size_t)aux * SZ1K) + (size_t)row * 1024 + col) = pack4(o);
      } else if constexpr (MODE == G_A2) {
        float4 a0 = *(const float4*)(p.in[20] + (l * 2 + aux) * 1024 + col);
        f32x4 o;
        o[0] = sigmoidf_(a0.x + v[0]);
        o[1] = sigmoidf_(a0.y + v[1]);
        o[2] = sigmoidf_(a0.z + v[2]);
        o[3] = sigmoidf_(a0.w + v[3]);
        *(uint2*)((bf16*)(ws + (aux ? B_AB : B_AF)) + (size_t)row * 1024 + col) = pack4(o);
      } else if constexpr (MODE == G_G2) {
        *(uint2*)((bf16*)(ws + B_GB) + (size_t)row * 1024 + col) = pack4(v);
      } else if constexpr (MODE == G_GLU) {
        f32x4 zz = unpack4(*(const uint2*)((const bf16*)(ws + B_SY) + (size_t)row * 1024 + col));
        float4 gb = *(const float4*)(p.in[37] + l * 1024 + col);
        f32x4 o;
        o[0] = zz[0] * sigmoidf_(v[0] + gb.x);
        o[1] = zz[1] * sigmoidf_(v[1] + gb.y);
        o[2] = zz[2] * sigmoidf_(v[2] + gb.z);
        o[3] = zz[3] * sigmoidf_(v[3] + gb.w);
        *(uint2*)(Z + (size_t)row * NIN + col) = pack4(o);
      } else if constexpr (MODE == G_OUT) {
        int b = row < ML ? (row >> 12) : 4;
        float4 g = *(const float4*)(mod + b * 12288 + 4096 + col);
        const float* xi = row < ML ? xin_lat + (size_t)row * 2048 : xin_ctx + (size_t)(row - ML) * 2048;
        float* xo = row < ML ? xout_lat + (size_t)row * 2048 : xout_ctx + (size_t)(row - ML) * 2048;
        float4 x = *(const float4*)(xi + col);
        x.x += g.x * v[0]; x.y += g.y * v[1]; x.z += g.z * v[2]; x.w += g.w * v[3];
        *(float4*)(xo + col) = x;
      } else if constexpr (MODE == G_M1) {
        f32x4 o;
#pragma unroll
        for (int r = 0; r < 4; r++) { float t = fmaxf(v[r], 0.f); o[r] = t * t; }
        *(uint2*)(Z + (size_t)row * DFF + col) = pack4(o);
      } else if constexpr (MODE == G_MG0 || MODE == G_MG1 || MODE == G_MG2) {
        constexpr int nb = MODE - G_MG0;
        bf16* MG = (bf16*)(ws + B_HB);
        f32x4 g = unpack4(*(const uint2*)(Z + (size_t)row * NIN + C_GATE + nb * 2048 + col));
        f32x4 o = g * v;
        if constexpr (nb > 0) o += unpack4(*(const uint2*)(MG + (size_t)row * 2048 + col));
        *(uint2*)(MG + (size_t)row * 2048 + col) = pack4(o);
      } else if constexpr (MODE == G_M2) {
        int b = row < ML ? (row >> 12) : 4;
        float4 g = *(const float4*)(mod + b * 12288 + 10240 + col);
        float* xo = row < ML ? xout_lat + (size_t)row * 2048 : xout_ctx + (size_t)(row - ML) * 2048;
        float4 x = *(const float4*)(xo + col);
        x.x += g.x * v[0]; x.y += g.y * v[1]; x.z += g.z * v[2]; x.w += g.w * v[3];
        *(float4*)(xo + col) = x;
      }
    });
  }
}

DEV void phase_mla_post(int tidv, int bidv, const Params& p, int l) {
  char* ws = p.ws;
  const float* qng = p.in[13] + l * 128;
  const float* qrg = p.in[14] + l * 64;
  const float* kng = p.in[15] + l * 128;
  const float* krg = p.in[16] + l * 64;
  bf16* QB = (bf16*)(ws + B_QB);
  bf16* KN = (bf16*)(ws + B_KN);
  bf16* KR = (bf16*)(ws + B_KR);
  const bf16* Z = (const bf16*)(ws + B_ZB);
  const int wave = tidv >> 6, lane = tidv & 63;
  const float QS = 1.4426950408889634f * 0.07216878364870322f;
  const int idx = lane & 31;
  const float inv = powf(10000.f, -(float)(idx & 15) / 16.f);
  const float gq0 = qng[2 * lane], gq1 = qng[2 * lane + 1], gk0 = kng[2 * lane], gk1 = kng[2 * lane + 1];
  const float gqr = qrg[lane], gkr = krg[lane];
  for (int row = bidv * 4 + wave; row < MT; row += gridDim.x * 4) {
    bool lat = row < ML;
    int t = row & 4095;
    float pos = (idx < 16) ? (float)(t >> 6) : (float)(t & 63);
    float ang = pos * inv;
    float cs = 1.f, sn = 0.f;
    if (lat) { cs = cosf(ang); sn = sinf(ang); }
#pragma unroll 1
    for (int h = 0; h < 8; h++) {
      bf16* q = QB + (size_t)row * 1536 + h * 192;
      uint32_t u = *(const uint32_t*)(q + 2 * lane);
      float x0 = bf2f((bf16)(u & 0xffff)), x1 = bf2f((bf16)(u >> 16));
      float ss = wsum(x0 * x0 + x1 * x1);
      float rinv = rsqrtf(ss * (1.f / 128.f) + 1e-6f) * QS;
      *(uint32_t*)(q + 2 * lane) = pack2(x0 * rinv * gq0, x1 * rinv * gq1);
      float xr = bf2f(q[128 + lane]);
      float ss2 = wsum(xr * xr);
      float y = xr * rsqrtf(ss2 * (1.f / 64.f) + 1e-6f) * gqr;
      float yp = __shfl_xor(y, 32);
      float o = lane < 32 ? (y * cs - yp * sn) : (yp * sn + y * cs);
      q[128 + lane] = f2bf(o * QS);
      bf16* k = KN + (size_t)row * 1024 + h * 128;
      uint32_t uk = *(const uint32_t*)(k + 2 * lane);
      float k0 = bf2f((bf16)(uk & 0xffff)), k1 = bf2f((bf16)(uk >> 16));
      float ssk = wsum(k0 * k0 + k1 * k1);
      float rk = rsqrtf(ssk * (1.f / 128.f) + 1e-6f);
      *(uint32_t*)(k + 2 * lane) = pack2(k0 * rk * gk0, k1 * rk * gk1);
    }
    {
      float xr = bf2f(Z[(size_t)row * NIN + C_KR + lane]);
      float ss2 = wsum(xr * xr);
      float y = xr * rsqrtf(ss2 * (1.f / 64.f) + 1e-6f) * gkr;
      float yp = __shfl_xor(y, 32);
      float o = lane < 32 ? (y * cs - yp * sn) : (yp * sn + y * cs);
      KR[(size_t)row * 64 + lane] = f2bf(o);
    }
  }
}

DEV void step_row(int s, int d, int b, int& row, int& tau, int& len) {
  if (s < 256) { tau = d ? 255 - s : s; len = 256; row = ML + b * 256 + tau; }
  else { int q = s - 256; tau = d ? 4095 - q : q; len = 4096; row = b * 4096 + tau; }
}

struct RwPre { bf16 r0, r1, r2, k0, k1, k2, v0, v1, v2, a, e; };

DEV void rwkv_fetch(RwPre& q, const bf16* Z, const bf16* AD, const bf16* ED, int s, int d, int b, int ch) {
  int row, tau, len;
  step_row(s, d, b, row, tau, len);
  const bf16* z = Z + (size_t)row * NIN + C_R + ch;
  q.r1 = z[0]; q.k1 = z[1024]; q.v1 = z[2048];
  q.r0 = 0; q.k0 = 0; q.v0 = 0; q.r2 = 0; q.k2 = 0; q.v2 = 0;
  if (tau > 0) { const bf16* zm = z - NIN; q.r0 = zm[0]; q.k0 = zm[1024]; q.v0 = zm[2048]; }
  if (tau < len - 1) { const bf16* zp = z + NIN; q.r2 = zp[0]; q.k2 = zp[1024]; q.v2 = zp[2048]; }
  q.a = AD[(size_t)row * 1024 + ch];
  q.e = ED[(size_t)row * 1024 + ch];
}

typedef float f2v __attribute__((ext_vector_type(2)));
DEV float dpp_hmirror(float v) {
  int i = __float_as_int(v);
  return __int_as_float(__builtin_amdgcn_update_dpp(i, i, 0x141, 0xF, 0xF, false));
}
DEV f2v lo2(float4 v) { return f2v{v.x, v.y}; }
DEV f2v hi2(float4 v) { return f2v{v.z, v.w}; }

DEV void rwkv_scan(int tidv, int bidv, const Params& p, int l, int task, char* smem, int dry) {
  char* ws = p.ws;
  float* op = (float*)smem;
  float* vb = op + 16 * 320;
  float* yb = vb + 16 * 64;
  const int tid = tidv, wave = tid >> 6, lane = tid & 63;
  const int half = task & 1, chain = task >> 1;
  const int d = chain & 1, h = (chain >> 1) & 15, b = chain >> 5;
  const int ch = h * 64 + lane;
  const float* cw = p.in[17] + (size_t)l * 3 * 3072;
  const float cr0 = cw[ch], cr1 = cw[3072 + ch], cr2 = cw[6144 + ch];
  const float ck0 = cw[1024 + ch], ck1 = cw[3072 + 1024 + ch], ck2 = cw[6144 + 1024 + ch];
  const float cv0 = cw[2048 + ch], cv1 = cw[3072 + 2048 + ch], cv2 = cw[6144 + 2048 + ch];
  const float kkc = p.in[23][l * 1024 + ch], kac = p.in[24][l * 1024 + ch];
  const bf16* Z = (const bf16*)(ws + B_ZB);
  bf16* ED = (bf16*)(ws + B_HB + (size_t)d * SZ1K);
  const bf16* AD = (const bf16*)(ws + (d ? B_AB : B_AF));
  f2v S0 = {0.f, 0.f}, S1 = {0.f, 0.f}, S2 = {0.f, 0.f}, S3 = {0.f, 0.f};
  int* flg = (int*)(ws + B_FLG) + (l * 2 + (dry ? 1 : 0)) * 256;
  const int ri = lane >> 3, jo = lane & 7, lrow = wave * 8 + ri, irow = half * 32 + lrow;
  RwPre pre[4];
#pragma unroll
  for (int si = 0; si < 4; si++) rwkv_fetch(pre[si], Z, AD, ED, wave * 4 + si, d, b, ch);
  for (int chunk = 0; chunk < 272; chunk++) {
#pragma unroll
    for (int si = 0; si < 4; si++) {
      int t = wave * 4 + si;
      const RwPre& q = pre[si];
      float rr = cr0 * bf2f(q.r0) + cr1 * bf2f(q.r1) + cr2 * bf2f(q.r2);
      float kk_ = ck0 * bf2f(q.k0) + ck1 * bf2f(q.k1) + ck2 * bf2f(q.k2);
      float vv = cv0 * bf2f(q.v0) + cv1 * bf2f(q.v1) + cv2 * bf2f(q.v2);
      float kkv = kk_ * kkc;
      float ssq = wsum(kkv * kkv);
      float kn = kkv * rsqrtf(ssq + 1e-12f);
      float a = bf2f(q.a);
      float w = __expf(-bf2f(q.e));
      float krep = kk_ * (1.f + (a - 1.f) * kac);
      float* o = op + t * 320;
      o[lane] = w;
      o[64 + lane] = kn * a;
      o[128 + lane] = krep;
      o[192 + lane] = -kn;
      o[256 + lane] = rr;
      vb[t * 64 + lane] = vv;
    }
    __syncthreads();
    if (tid == 0) __hip_atomic_store(flg + task, chunk + 1, __ATOMIC_RELAXED, __HIP_MEMORY_SCOPE_AGENT);
    if (chunk + 1 < 272) {
#pragma unroll
      for (int si = 0; si < 4; si++) rwkv_fetch(pre[si], Z, AD, ED, (chunk + 1) * 16 + wave * 4 + si, d, b, ch);
    }
    {
      const float4* o4 = (const float4*)(op + jo * 8);
      float4 n0 = o4[48], n1 = o4[49];
#pragma unroll 4
      for (int t = 0; t < 16; t++) {
        const float4* ot = o4 + t * 80;
        const float4 w0 = ot[0], w1 = ot[1];
        const float4 a0 = ot[16], a1 = ot[17];
        const float4 k0 = ot[32], k1 = ot[33];
        const float4 r0 = ot[64], r1 = ot[65];
        const float vi = vb[t * 64 + irow];
        const int tn = t < 15 ? t + 1 : 15;
        const float4* on = o4 + tn * 80;
        const float4 m0 = on[48], m1 = on[49];
        f2v sv = S0 * lo2(n0) + S1 * hi2(n0) + (S2 * lo2(n1) + S3 * hi2(n1));
        float sa = sv.x + sv.y;
        sa += dpp_xor1(sa);
        sa += dpp_xor2(sa);
        sa += dpp_hmirror(sa);
        const f2v sa2 = {sa, sa}, vi2 = {vi, vi};
        S0 = S0 * lo2(w0) + sa2 * lo2(a0) + vi2 * lo2(k0);
        S1 = S1 * hi2(w0) + sa2 * hi2(a0) + vi2 * hi2(k0);
        S2 = S2 * lo2(w1) + sa2 * lo2(a1) + vi2 * lo2(k1);
        S3 = S3 * hi2(w1) + sa2 * hi2(a1) + vi2 * hi2(k1);
        f2v yv = S0 * lo2(r0) + S1 * hi2(r0) + (S2 * lo2(r1) + S3 * hi2(r1));
        float y = yv.x + yv.y;
        y += dpp_xor1(y);
        y += dpp_xor2(y);
        y += dpp_hmirror(y);
        if (jo == 0) yb[t * 32 + lrow] = y;
        n0 = m0; n1 = m1;
      }
    }
    if (tid == 0) {
      while (__hip_atomic_load(flg + (task ^ 1), __ATOMIC_RELAXED, __HIP_MEMORY_SCOPE_AGENT) < chunk + 1) __builtin_amdgcn_s_sleep(1);
    }
    __syncthreads();
#pragma unroll
    for (int it = 0; it < 2; it++) {
      int idx = it * 256 + tid;
      int t = idx >> 5, i = idx & 31;
      int row, tau, len;
      step_row(chunk * 16 + t, d, b, row, tau, len);
      size_t off = (size_t)row * 1024 + h * 64 + half * 32 + i;
      bf16* yd = dry ? (bf16*)(ws + B_END) + (off & 0x3fffff) : ED + off;
      *yd = f2bf(yb[t * 32 + i]);
    }
  }
}

DEV void s5_scan(int tidv, int bidv, const Params& p, int l, int chain, char* smemw, int dry) {
  char* ws = p.ws;
  const int lane = tidv & 63;
  const int d = chain & 1, g = (chain >> 1) & 63, b = chain >> 7;
  float* ub = (float*)smemw;
  float* hb = ub + 256;
  const size_t pg = (size_t)(l * 2 + d) * 64 + g;
  const float lre = p.in[28][pg * 64 + lane], lim = p.in[29][pg * 64 + lane];
  const float dt = expf(p.in[30][pg]);
  const float mag = expf(lre * dt);
  const float are = mag * cosf(lim * dt), aim = mag * sinf(lim * dt);
  const float den = lre * lre + lim * lim;
  const float qre = ((are - 1.f) * lre + aim * lim) / den;
  const float qim = (aim * lre - (are - 1.f) * lim) / den;
  float bbre[16], bbim[16];
  {
    const float* br = p.in[31] + (pg * 64 + lane) * 16;
    const float* bi = p.in[32] + (pg * 64 + lane) * 16;
#pragma unroll
    for (int i = 0; i < 16; i++) {
      float x = br[i], y = bi[i];
      bbre[i] = qre * x - qim * y;
      bbim[i] = qre * y + qim * x;
    }
  }
  bf16x8 cfr[4];
  {
    const int i = lane & 15, quad = lane >> 4;
    const float* cre = p.in[33] + (pg * 16 + i) * 64;
    const float* cim = p.in[34] + (pg * 16 + i) * 64;
#pragma unroll
    for (int ks = 0; ks < 4; ks++)
#pragma unroll
      for (int j = 0; j < 8; j++) {
        int k = ks * 32 + quad * 8 + j;
        float c = ks < 2 ? cre[k] : -cim[k - 64];
        cfr[ks][j] = (short)f2bf(c);
      }
  }
  float hre = 0.f, him = 0.f;
  const bf16* Z = (const bf16*)(ws + B_ZB);
  const int tt = lane >> 2, i0 = (lane & 3) * 4;
  uint2 unext;
  {
    int row, tau, len;
    step_row(tt, d, b, row, tau, len);
    unext = *(const uint2*)(Z + (size_t)row * NIN + C_U + g * 16 + i0);
  }
  for (int chunk = 0; chunk < 272; chunk++) {
    {
      uint2 u = unext;
      float4 f;
      f.x = bf2f((bf16)(u.x & 0xffff)); f.y = bf2f((bf16)(u.x >> 16));
      f.z = bf2f((bf16)(u.y & 0xffff)); f.w = bf2f((bf16)(u.y >> 16));
      *(float4*)(ub + tt * 16 + i0) = f;
    }
    __syncthreads();
    if (chunk + 1 < 272) {
      int row, tau, len;
      step_row((chunk + 1) * 16 + tt, d, b, row, tau, len);
      unext = *(const uint2*)(Z + (size_t)row * NIN + C_U + g * 16 + i0);
    }
#pragma unroll 2
    for (int t = 0; t < 16; t++) {
      const float* u = ub + t * 16;
      float br0 = 0.f, bi0 = 0.f;
#pragma unroll
      for (int i = 0; i < 16; i++) { float uv = u[i]; br0 += bbre[i] * uv; bi0 += bbim[i] * uv; }
      float nr = are * hre - aim * him + br0;
      float ni = are * him + aim * hre + bi0;
      hre = nr; him = ni;
      hb[t * 132 + lane] = hre;
      hb[t * 132 + 64 + lane] = him;
    }
    __syncthreads();
    {
      f32x4 yacc = {0.f, 0.f, 0.f, 0.f};
      const float* hr = hb + (lane & 15) * 132 + (lane >> 4) * 8;
#pragma unroll
      for (int ks = 0; ks < 4; ks++) {
        float4 x0 = *(const float4*)(hr + ks * 32), x1 = *(const float4*)(hr + ks * 32 + 4);
        union { bf16x8 v; uint32_t u[4]; } af;
        af.u[0] = pack2(x0.x, x0.y); af.u[1] = pack2(x0.z, x0.w);
        af.u[2] = pack2(x1.x, x1.y); af.u[3] = pack2(x1.z, x1.w);
        yacc = __builtin_amdgcn_mfma_f32_16x16x32_bf16(af.v, cfr[ks], yacc, 0, 0, 0);
      }
      const int ii = lane & 15;
#pragma unroll
      for (int r = 0; r < 4; r++) {
        int row, tau, len;
        step_row(chunk * 16 + (lane >> 4) * 4 + r, d, b, row, tau, len);
        bf16* dst = d == 0 ? (bf16*)(ws + B_SY) + (size_t)row * 1024 + g * 16 + ii : (bf16*)(ws + B_ZB) + (size_t)row * NIN + g * 16 + ii;
        if (dry) dst = (bf16*)(ws + B_END) + ((((size_t)row * 1024 + g * 16 + ii)) & 0x3fffff);
        *dst = f2bf(yacc[r]);
      }
    }
    __syncthreads();
  }
}

DEV int perm23(int r) { return (r & 0x13) | ((r & 4) << 1) | ((r & 8) >> 1); }

DEV void attn_item(int tidv, int bidv, const Params& p, int item, bool ctxq, char* smem, int dry) {
  char* ws = p.ws;
  bf16* sK = (bf16*)smem;
  bf16* sV = sK + 64 * 200;
  const int tid = tidv, wave = tid >> 6, lane = tid & 63;
  const int r = lane & 31, hf = lane >> 5;
  int b, hd, qt;
  if (!ctxq) { b = item >> 8; hd = (item >> 5) & 7; qt = item & 31; }
  else { b = item >> 4; hd = (item >> 1) & 7; qt = item & 1; }
  const int qrow0 = ctxq ? ML + b * 256 + qt * 128 : b * 4096 + qt * 128;
  const int kt0 = ctxq ? 64 : 0, kt1 = 68;
  bf16* QB = (bf16*)(ws + B_QB);
  const bf16* KN = (const bf16*)(ws + B_KN);
  const bf16* KR = (const bf16*)(ws + B_KR);
  const bf16* VT = (const bf16*)(ws + B_VT);
  bf16x8 qf[12];
  {
    const bf16* qp = QB + (size_t)(qrow0 + wave * 32 + r) * 1536 + hd * 192 + hf * 8;
#pragma unroll
    for (int kk = 0; kk < 12; kk++) qf[kk] = *(const bf16x8*)(qp + kk * 16);
  }
  f32x16 oacc[4];
#pragma unroll
  for (int i = 0; i < 4; i++)
#pragma unroll
    for (int e = 0; e < 16; e++) oacc[i][e] = 0.f;
  float mrun = -1e30f, lrun = 0.f;
  const int pr = perm23(r);
  for (int kt = kt0; kt < kt1; kt++) {
    __syncthreads();
    const int key0 = kt * 64;
    const int rowbase = key0 < 4096 ? b * 4096 + key0 : ML + b * 256 + (key0 - 4096);
    {
      const char* bk = (const char*)(KN + (size_t)rowbase * 1024 + hd * 128);
      const char* br = (const char*)(KR + (size_t)rowbase * 64);
      const char* bv = (const char*)(VT + ((size_t)((b * 8 + hd) * 128)) * NKEY + key0);
      const uint32_t vo_n = (uint32_t)((tid >> 4) * 2048 + (tid & 15) * 16);
      const uint32_t lo_n = (uint32_t)((tid >> 4) * 400 + (tid & 15) * 16);
      const uint32_t vo_r = (uint32_t)((tid >> 3) * 128 + (tid & 7) * 16);
      const uint32_t lo_r = (uint32_t)((tid >> 3) * 400 + 256 + (tid & 7) * 16);
      const uint32_t vo_v = (uint32_t)((tid >> 3) * (NKEY * 2) + (tid & 7) * 16);
      const uint32_t lo_v = (uint32_t)((tid >> 3) * 144 + (tid & 7) * 16);
      uint4 t0 = *(const uint4*)(bk + vo_n);
      uint4 t1 = *(const uint4*)(bk + 16 * 2048 + vo_n);
      uint4 t2 = *(const uint4*)(bk + 32 * 2048 + vo_n);
      uint4 t3 = *(const uint4*)(bk + 48 * 2048 + vo_n);
      uint4 t4 = *(const uint4*)(br + vo_r);
      uint4 t5 = *(const uint4*)(br + 32 * 128 + vo_r);
      *(uint4*)((char*)sK + lo_n) = t0;
      *(uint4*)((char*)sK + 16 * 400 + lo_n) = t1;
      *(uint4*)((char*)sK + 32 * 400 + lo_n) = t2;
      *(uint4*)((char*)sK + 48 * 400 + lo_n) = t3;
      *(uint4*)((char*)sK + lo_r) = t4;
      *(uint4*)((char*)sK + 32 * 400 + lo_r) = t5;
      __builtin_amdgcn_sched_barrier(0);
      uint4 u0 = *(const uint4*)(bv + vo_v);
      uint4 u1 = *(const uint4*)(bv + (size_t)32 * NKEY * 2 + vo_v);
      uint4 u2 = *(const uint4*)(bv + (size_t)64 * NKEY * 2 + vo_v);
      uint4 u3 = *(const uint4*)(bv + (size_t)96 * NKEY * 2 + vo_v);
      *(uint4*)((char*)sV + lo_v) = u0;
      *(uint4*)((char*)sV + 32 * 144 + lo_v) = u1;
      *(uint4*)((char*)sV + 64 * 144 + lo_v) = u2;
      *(uint4*)((char*)sV + 96 * 144 + lo_v) = u3;
    }
    __syncthreads();
    f32x16 sacc[2];
#pragma unroll
    for (int m = 0; m < 2; m++) {
#pragma unroll
      for (int e = 0; e < 16; e++) sacc[m][e] = 0.f;
      const bf16* kp = sK + (m * 32 + pr) * 200 + hf * 8;
#pragma unroll
      for (int kk = 0; kk < 12; kk++) {
        bf16x8 kf = *(const bf16x8*)(kp + kk * 16);
        sacc[m] = __builtin_amdgcn_mfma_f32_32x32x16_bf16(kf, qf[kk], sacc[m], 0, 0, 0);
        if ((kk & 3) == 3) __builtin_amdgcn_sched_barrier(0);
      }
      __builtin_amdgcn_sched_barrier(0);
    }
    float tmax = sacc[0][0];
#pragma unroll
    for (int e = 1; e < 16; e++) tmax = fmaxf(tmax, sacc[0][e]);
#pragma unroll
    for (int e = 0; e < 16; e++) tmax = fmaxf(tmax, sacc[1][e]);
    tmax = fmaxf(tmax, __shfl_xor(tmax, 32));
    float mnew = fmaxf(mrun, tmax);
    float alpha = __builtin_amdgcn_exp2f(mrun - mnew);
    mrun = mnew;
    float psum = 0.f;
#pragma unroll
    for (int m = 0; m < 2; m++)
#pragma unroll
      for (int e = 0; e < 16; e++) { float pv = __builtin_amdgcn_exp2f(sacc[m][e] - mnew); sacc[m][e] = pv; psum += pv; }
    lrun = lrun * alpha + psum;
#pragma unroll
    for (int i = 0; i < 4; i++)
#pragma unroll
      for (int e = 0; e < 16; e++) oacc[i][e] *= alpha;
#pragma unroll
    for (int s = 0; s < 4; s++) {
      const int m = s >> 1, s2 = s & 1;
      bf16x8 pf;
#pragma unroll
      for (int j = 0; j < 8; j++) pf[j] = (short)f2bf(sacc[m][8 * s2 + j]);
#pragma unroll
      for (int i = 0; i < 4; i++) {
        bf16x8 vf = *(const bf16x8*)(sV + (i * 32 + r) * 72 + m * 32 + s2 * 16 + hf * 8);
        oacc[i] = __builtin_amdgcn_mfma_f32_32x32x16_bf16(vf, pf, oacc[i], 0, 0, 0);
      }
      __builtin_amdgcn_sched_barrier(0);
    }
  }
  lrun += __shfl_xor(lrun, 32);
  const float inv = 1.f / lrun;
  bf16* op = QB + (size_t)(qrow0 + wave * 32 + r) * 1536 + hd * 192;
  if (dry) op = (bf16*)(ws + B_END) + ((((size_t)(qrow0 + wave * 32 + r) * 1536 + hd * 192)) & 0x3ffff8);
#pragma unroll
  for (int i = 0; i < 4; i++)
#pragma unroll
    for (int g = 0; g < 4; g++) {
      uint2 o;
      o.x = pack2(oacc[i][4 * g] * inv, oacc[i][4 * g + 1] * inv);
      o.y = pack2(oacc[i][4 * g + 2] * inv, oacc[i][4 * g + 3] * inv);
      *(uint2*)(op + 32 * i + 8 * g + 4 * hf) = o;
    }
}

DEV void phase_mixers(int tidv, int bidv, const Params& p, int l, char* smem, int dry) {
  __shared__ int s_item;
#ifdef PROBE_PARTS
  const int parts = dry ? PROBE_PARTS : 7;
#else
  const int parts = 7;
#endif
  for (int task = bidv; task < 384; task += gridDim.x) {
    if (task < 256 && !(parts & 1)) continue;
    if (task >= 256 && !(parts & 2)) continue;
    if (task < 256) rwkv_scan(tidv, bidv, p, l, task, smem, dry);
    else s5_scan(tidv, bidv, p, l, (task - 256) * 4 + (tidv >> 6), smem + (tidv >> 6) * 9472, dry);
  }
  const int nlat = 1024, ntot = (parts & 4) ? ((l == 0) ? 1088 : 1024) : 0;
  int* cnt = (int*)(p.ws + B_CNT) + l + 2 * dry;
#if !defined(MIX_ONLY) || MIX_ONLY == 2
  while (true) {
    __syncthreads();
    if (tidv == 0) s_item = atomicAdd(cnt, 1);
    __syncthreads();
    int item = s_item;
    if (item >= ntot) break;
    if (item < nlat) attn_item(tidv, bidv, p, item, false, smem, dry);
    else attn_item(tidv, bidv, p, item - nlat, true, smem, dry);
  }
#endif
}

DEV float gelu_tanh(float x) {
  float u = 0.7978845608028654f * (x + 0.044715f * x * x * x);
  return 0.5f * x * (1.f + tanhf(u));
}

DEV void phase_post(int tidv, int bidv, const Params& p, int l, int M) {
  char* ws = p.ws;
  const bf16* Z = (const bf16*)(ws + B_ZB);
  const int wave = tidv >> 6, lane = tidv & 63;
  const float* cw = p.in[17] + (size_t)l * 3 * 3072;
  const bf16* YF = (const bf16*)(ws + B_HB);
  const bf16* YB = (const bf16*)(ws + B_HB + SZ1K);
  const bf16* AF = (const bf16*)(ws + B_AF);
  const bf16* AB = (const bf16*)(ws + B_AB);
  bf16* GB = (bf16*)(ws + B_GB);
  const int nitem = M * 16;
  for (int it = bidv * 4 + wave; it < nitem; it += gridDim.x * 4) {
    int row = it >> 4, h = it & 15;
    int ch = h * 64 + lane;
    int tau, len;
    if (row < ML) { tau = row & 4095; len = 4096; } else { tau = (row - ML) & 255; len = 256; }
    size_t o = (size_t)row * 1024 + ch;
    float y = bf2f(YF[o]) + bf2f(YB[o]);
    float mu = wsum(y) * (1.f / 64.f);
    float dv = y - mu;
    float var = wsum(dv * dv) * (1.f / 64.f);
    float yn = dv * rsqrtf(var + 64e-5f) * p.in[26][l * 1024 + ch] + p.in[27][l * 1024 + ch];
    const bf16* z = Z + (size_t)row * NIN + C_R + ch;
    float r1 = bf2f(z[0]), k1 = bf2f(z[1024]), v1 = bf2f(z[2048]);
    float r0 = 0.f, k0 = 0.f, v0 = 0.f, r2 = 0.f, k2 = 0.f, v2 = 0.f;
    if (tau > 0) { const bf16* zm = z - NIN; r0 = bf2f(zm[0]); k0 = bf2f(zm[1024]); v0 = bf2f(zm[2048]); }
    if (tau < len - 1) { const bf16* zp = z + NIN; r2 = bf2f(zp[0]); k2 = bf2f(zp[1024]); v2 = bf2f(zp[2048]); }
    float rr = cw[ch] * r0 + cw[3072 + ch] * r1 + cw[6144 + ch] * r2;
    float kk = cw[1024 + ch] * k0 + cw[3072 + 1024 + ch] * k1 + cw[6144 + 1024 + ch] * k2;
    float vv = cw[2048 + ch] * v0 + cw[3072 + 2048 + ch] * v1 + cw[6144 + 2048 + ch] * v2;
    float am = 0.5f * (bf2f(AF[o]) + bf2f(AB[o]));
    float kbon = kk * (1.f + (am - 1.f) * p.in[24][l * 1024 + ch]);
    float s = wsum(rr * kbon * p.in[25][l * 1024 + ch]);
    float outv = (yn + s * vv) * bf2f(GB[o]);
    GB[o] = f2bf(outv);
  }
  bf16* SY = (bf16*)(ws + B_SY);
  const float* dsk = p.in[35] + l * 1024;
  const int n4 = M * 256;
  for (int i = bidv * 256 + tidv; i < n4; i += gridDim.x * 256) {
    int row = i >> 8, c = (i & 255) * 4;
    uint2 a = *(const uint2*)(SY + (size_t)row * 1024 + c);
    uint2 bq = *(const uint2*)(Z + (size_t)row * NIN + c);
    uint2 u = *(const uint2*)(Z + (size_t)row * NIN + C_U + c);
    float4 dd = *(const float4*)(dsk + c);
    float y0 = bf2f((bf16)(a.x & 0xffff)) + bf2f((bf16)(bq.x & 0xffff)) + dd.x * bf2f((bf16)(u.x & 0xffff));
    float y1 = bf2f((bf16)(a.x >> 16)) + bf2f((bf16)(bq.x >> 16)) + dd.y * bf2f((bf16)(u.x >> 16));
    float y2 = bf2f((bf16)(a.y & 0xffff)) + bf2f((bf16)(bq.y & 0xffff)) + dd.z * bf2f((bf16)(u.y & 0xffff));
    float y3 = bf2f((bf16)(a.y >> 16)) + bf2f((bf16)(bq.y >> 16)) + dd.w * bf2f((bf16)(u.y >> 16));
    uint2 o;
    o.x = pack2(gelu_tanh(y0), gelu_tanh(y1));
    o.y = pack2(gelu_tanh(y2), gelu_tanh(y3));
    *(uint2*)(SY + (size_t)row * 1024 + c) = o;
  }
}

constexpr int NPH = 25;

DEV void run_phase(int tidv, int bidv, const Params& p, int ph, char* smem, int dry) {
  char* ws = p.ws;
#ifndef ONLY_S
  if (ph == 0) {
    if (bidv == 0 && tidv < 4) ((int*)(ws + B_CNT))[tidv] = 0;
    if (bidv == 0) { ((int*)(ws + B_FLG))[tidv] = 0; ((int*)(ws + B_FLG))[tidv + 256] = 0; ((int*)(ws + B_FLG))[tidv + 512] = 0; ((int*)(ws + B_FLG))[tidv + 768] = 0; }
    phase_mod(tidv, bidv, p, smem);
    phase_convw(tidv, bidv, p, 0, smem);
    return;
  }
#endif
  const int l = (ph - 1) / 12, s = (ph - 1) % 12;
#ifdef ONLY_S
  if (s != ONLY_S) return;
#endif
  const bf16* wb = (const bf16*)(ws + B_WB);
  const float* mod = (const float*)(ws + B_MOD) + (size_t)l * 5 * 12288;
  float* XC = (float*)(ws + B_XC);
  const float* xin_lat = l == 0 ? p.in[0] : p.out;
  const float* xin_ctx = l == 0 ? p.in[2] : XC;
  bf16* HB = (bf16*)(ws + B_HB);
  bf16* Z = (bf16*)(ws + B_ZB);
  bf16* H2 = (bf16*)(ws + B_KN);
  const int Mpost = l == 0 ? MT : ML;
  switch (s) {
    case 0:
      if (l == 1) phase_convw(tidv, bidv, p, 1, smem);
      phase_norm(tidv, bidv, xin_lat, xin_ctx, p.in[6] + l * 2048, mod, 0, 2048, HB, MT);
      break;
    case 1:
      run_gemm<G_IN>(tidv, bidv, p, l, smem, HB, 2048, wb + OW_IN, 2048, NIN, MT, 0, nullptr, nullptr, nullptr, nullptr);
      break;
    case 2:
      run_gemm<G_UKV>(tidv, bidv, p, l, smem, Z + C_CKV, NIN, wb + OW_UKV, 512, 2048, MT, 0, nullptr, nullptr, nullptr, nullptr);
      run_gemm<G_UQ>(tidv, bidv, p, l, smem, Z + C_CQ, NIN, wb + OW_UQ, 512, 1536, MT, 0, nullptr, nullptr, nullptr, nullptr);
      run_gemm<G_G2>(tidv, bidv, p, l, smem, Z + C_GD, NIN, wb + OW_G2, 192, 1024, MT, 0, nullptr, nullptr, nullptr, nullptr);
      for (int d = 0; d < 2; d++) {
        run_gemm<G_W2>(tidv, bidv, p, l, smem, Z + C_WD + 64 * d, NIN, wb + OW_W2 + (size_t)d * 65536, 64, 1024, MT, d, nullptr, nullptr, nullptr, nullptr);
        run_gemm<G_A2>(tidv, bidv, p, l, smem, Z + C_AD + 64 * d, NIN, wb + OW_A2 + (size_t)d * 65536, 64, 1024, MT, d, nullptr, nullptr, nullptr, nullptr);
      }
      break;
    case 3: phase_mla_post(tidv, bidv, p, l); break;
    case 4: phase_mixers(tidv, bidv, p, l, smem, dry); break;
    case 5: phase_post(tidv, bidv, p, l, Mpost); break;
    case 6:
      run_gemm<G_GLU>(tidv, bidv, p, l, smem, (const bf16*)(ws + B_SY), 1024, wb + OW_GLU, 1024, 1024, Mpost, 0, nullptr, nullptr, nullptr, nullptr);
      break;
    case 7:
      run_gemm<G_MG0>(tidv, bidv, p, l, smem, (const bf16*)(ws + B_QB), 1536, wb + OW_BR, 1024, 2048, Mpost, 0, nullptr, nullptr, nullptr, nullptr);
      run_gemm<G_MG1>(tidv, bidv, p, l, smem, (const bf16*)(ws + B_GB), 1024, wb + OW_BR + (size_t)2048 * 1024, 1024, 2048, Mpost, 0, nullptr, nullptr, nullptr, nullptr);
      run_gemm<G_MG2>(tidv, bidv, p, l, smem, Z, NIN, wb + OW_BR + (size_t)2 * 2048 * 1024, 1024, 2048, Mpost, 0, nullptr, nullptr, nullptr, nullptr);
      break;
    case 8:
      run_gemm<G_OUT>(tidv, bidv, p, l, smem, HB, 2048, wb + OW_OUT, 2048, 2048, Mpost, 0, xin_lat, xin_ctx, p.out, XC);
      break;
    case 9:
      phase_norm(tidv, bidv, p.out, XC, p.in[7] + l * 2048, mod, 6144, 8192, H2, Mpost);
      break;
    case 10:
      run_gemm<G_M1>(tidv, bidv, p, l, smem, H2, 2048, wb + OW_M1, 2048, 8192, Mpost, 0, nullptr, nullptr, nullptr, nullptr);
      break;
    case 11:
      run_gemm<G_M2>(tidv, bidv, p, l, smem, Z, 8192, wb + OW_M2, 8192, 2048, Mpost, 0, nullptr, nullptr, p.out, XC);
      break;
  }
}

__global__ void __launch_bounds__(256, 2) fwd_megakernel(Params p, int ph0, int ph1, int dryflag) {
  __shared__ __attribute__((aligned(16))) char smem[2 * GSTAGE + 512];
  for (int ph = ph0; ph < ph1; ph++) {
    int tidv = threadIdx.x, bidv = blockIdx.x;
    asm volatile("" : "+v"(tidv));
    asm volatile("" : "+s"(bidv));
#ifdef PROBE_MASK
    if (dryflag && ((ph == 0 && (PROBE_MASK & 0x1000)) || (ph > 0 && ((PROBE_MASK >> ((ph - 1) % 12)) & 1)))) {
      run_phase(tidv, bidv, p, ph, smem, dryflag);
      cg::this_grid().sync();
    }
#endif
    run_phase(tidv, bidv, p, ph, smem, 0);
    if (ph + 1 < ph1) cg::this_grid().sync();
  }
}

extern "C" void kernel_launch(void* const* d_in, const int* in_sizes, int n_in, void* d_out, int out_size, void* d_ws, size_t ws_size,
                              hipStream_t stream) {
  static int grid_blocks = 0;
  if (!grid_blocks) {
    int dev = 0, cus = 0, per_cu = 0;
    hipGetDevice(&dev);
    hipDeviceGetAttribute(&cus, hipDeviceAttributeMultiprocessorCount, dev);
    hipOccupancyMaxActiveBlocksPerMultiprocessor(&per_cu, fwd_megakernel, 256, 0);
    if (per_cu < 1) per_cu = 1;
    if (per_cu > 2) per_cu = 2;
    grid_blocks = cus * per_cu;
  }
  Params p{};
  for (int i = 0; i < 42; i++) p.in[i] = (const float*)d_in[i];
  p.out = (float*)d_out;
  p.ws = (char*)d_ws;
  if (ws_size < B_END + (8u << 20)) { fprintf(stderr, "workspace too small\n"); return; }
#if MULTI_LAUNCH
  for (int ph = 0; ph < NPH; ph++) {
    hipLaunchKernelGGL(fwd_megakernel, dim3(grid_blocks), dim3(256), 0, stream, p, ph, ph + 1, 0);
  }
#else
  int ph0 = 0, ph1 = NPH;
  int dryflag = 1;
  void* args[] = {&p, &ph0, &ph1, &dryflag};
  hipError_t e = hipLaunchCooperativeKernel((void*)fwd_megakernel, dim3(grid_blocks), dim3(256), args, 0, stream);
  if (e != hipSuccess) fprintf(stderr, "cooperative launch failed: %s (grid %d)\n", hipGetErrorString(e), grid_blocks);
#endif
}
```

```cpp
#include <hip/hip_runtime.h>
#include <hip/hip_cooperative_groups.h>
#include <stdint.h>
#include <cstdio>
namespace cg = cooperative_groups;

#ifndef MULTI_LAUNCH
#define MULTI_LAUNCH 0
#endif

typedef unsigned short bf16;
using bf16x8 = __attribute__((ext_vector_type(8))) short;
using f32x4 = __attribute__((ext_vector_type(4))) float;
using f32x16 = __attribute__((ext_vector_type(16))) float;

#define DEV __device__ __forceinline__

constexpr int DM = 2048, ML = 16384, MC = 1024, MT = 17408, NIN = 11744, DFF = 8192, NKEY = 4352;
constexpr int C_CQ = 0, C_CKV = 512, C_KR = 1024, C_R = 1088, C_WD = 4160, C_AD = 4288, C_GD = 4416, C_U = 4576, C_GATE = 5600;

constexpr size_t OW_IN = 0;
constexpr size_t OW_UQ = OW_IN + (size_t)NIN * 2048;
constexpr size_t OW_UKV = OW_UQ + 1536 * 512;
constexpr size_t OW_W2 = OW_UKV + 2048 * 512;
constexpr size_t OW_A2 = OW_W2 + 2 * 1024 * 64;
constexpr size_t OW_G2 = OW_A2 + 2 * 1024 * 64;
constexpr size_t OW_GLU = OW_G2 + 1024 * 192;
constexpr size_t OW_BR = OW_GLU + 1024 * 1024;
constexpr size_t OW_OUT = OW_BR + (size_t)3 * 2048 * 1024;
constexpr size_t OW_M1 = OW_OUT + (size_t)2048 * 2048;
constexpr size_t OW_M2 = OW_M1 + (size_t)8192 * 2048;
constexpr size_t OW_END = OW_M2 + (size_t)8192 * 2048;

constexpr size_t SZ1K = (size_t)MT * 1024 * 2;
constexpr size_t B_WB = 0;
constexpr size_t B_HB = B_WB + OW_END * 2;
constexpr size_t B_ZB = B_HB + (size_t)MT * 2048 * 2;
constexpr size_t B_QB = B_ZB + (size_t)MT * NIN * 2;
constexpr size_t B_KN = B_QB + (size_t)MT * 1536 * 2;
constexpr size_t B_VT = B_KN + SZ1K;
constexpr size_t B_KR = B_VT + SZ1K;
constexpr size_t B_AF = B_KR + (size_t)MT * 64 * 2;
constexpr size_t B_AB = B_AF + SZ1K;
constexpr size_t B_GB = B_AB + SZ1K;
constexpr size_t B_SY = B_GB + SZ1K;
constexpr size_t B_XC = B_SY + SZ1K;
constexpr size_t B_MOD = B_XC + (size_t)MC * 2048 * 4;
constexpr size_t B_CNT = B_MOD + (size_t)2 * 5 * 12288 * 4;
constexpr size_t B_FLG = B_CNT + 256;
constexpr size_t B_END = B_FLG + 4096;

struct Params {
  const float* in[42];
  float* out;
  char* ws;
};

typedef __attribute__((ext_vector_type(2))) __bf16 hbf2;
DEV bf16 f2bf(float f) {
  __bf16 h = (__bf16)f;
  return *(unsigned short*)&h;
}
DEV float bf2f(bf16 h) { return __uint_as_float(((uint32_t)h) << 16); }
DEV uint32_t pack2(float a, float b) {
  hbf2 v;
  v[0] = (__bf16)a;
  v[1] = (__bf16)b;
  return *(uint32_t*)&v;
}
DEV float wsum(float v) {
#pragma unroll
  for (int o = 32; o > 0; o >>= 1) v += __shfl_xor(v, o);
  return v;
}
DEV float dpp_xor1(float v) {
  int i = __float_as_int(v);
  return __int_as_float(__builtin_amdgcn_update_dpp(i, i, 0xB1, 0xF, 0xF, false));
}
DEV float dpp_xor2(float v) {
  int i = __float_as_int(v);
  return __int_as_float(__builtin_amdgcn_update_dpp(i, i, 0x4E, 0xF, 0xF, false));
}
DEV float sigmoidf_(float x) { return __builtin_amdgcn_rcpf(1.f + __expf(-x)); }

DEV void phase_mod(int tidv, int bidv, const Params& p, char* smem) {
  float* s_in = (float*)smem;
  float* red = s_in + 5 * 2048;
  float* mod = (float*)(p.ws + B_MOD);
  for (int i = tidv; i < 5 * 2048; i += 256) {
    int r = i >> 11, k = i & 2047;
    float v = r < 4 ? p.in[1][r * 2048 + k] : p.in[3][k];
    s_in[i] = v / (1.f + expf(-v));
  }
  __syncthreads();
  int kg = tidv >> 6, c = tidv & 63;
  for (int task = bidv; task < 2 * 192; task += gridDim.x) {
    int l = task / 192, n = (task % 192) * 64 + c;
    const float* w = p.in[4] + (size_t)l * 2048 * 12288 + n;
    float a0 = 0, a1 = 0, a2 = 0, a3 = 0, a4 = 0;
    int kb = kg * 512;
#pragma unroll 8
    for (int k = 0; k < 512; k++) {
      float wv = w[(size_t)(kb + k) * 12288];
      a0 += s_in[kb + k] * wv;
      a1 += s_in[2048 + kb + k] * wv;
      a2 += s_in[4096 + kb + k] * wv;
      a3 += s_in[6144 + kb + k] * wv;
      a4 += s_in[8192 + kb + k] * wv;
    }
    red[(kg * 5 + 0) * 64 + c] = a0;
    red[(kg * 5 + 1) * 64 + c] = a1;
    red[(kg * 5 + 2) * 64 + c] = a2;
    red[(kg * 5 + 3) * 64 + c] = a3;
    red[(kg * 5 + 4) * 64 + c] = a4;
    __syncthreads();
    if (kg == 0) {
      float bias = p.in[5][l * 12288 + n];
#pragma unroll
      for (int r = 0; r < 5; r++) {
        float v = red[(0 * 5 + r) * 64 + c] + red[(1 * 5 + r) * 64 + c] + red[(2 * 5 + r) * 64 + c] + red[(3 * 5 + r) * 64 + c];
        mod[(size_t)(l * 5 + r) * 12288 + n] = v + bias;
      }
    }
    __syncthreads();
  }
}

DEV void convT(int tidv, int bidv, const float* __restrict__ src, bf16* __restrict__ dst, int K, int N, const float* __restrict__ gain, char* smem, int dK = 0) {
  if (dK == 0) dK = K;
  float* t = (float*)smem;
  int tk = (K + 63) >> 6, tn = (N + 63) >> 6;
  for (int tile = bidv; tile < tk * tn; tile += gridDim.x) {
    int k0 = (tile / tn) * 64, n0 = (tile % tn) * 64;
    __syncthreads();
#pragma unroll 4
    for (int i = 0; i < 16; i++) {
      int kk = i * 4 + (tidv >> 6), nn = tidv & 63;
      float v = 0.f;
      if (k0 + kk < K && n0 + nn < N) {
        v = src[(size_t)(k0 + kk) * N + n0 + nn];
        if (gain) v *= gain[k0 + kk];
      }
      t[kk * 65 + nn] = v;
    }
    __syncthreads();
#pragma unroll
    for (int i = 0; i < 2; i++) {
      int c = tidv + 256 * i;
      int nn = c >> 3, kc = c & 7;
      if (n0 + nn < N && k0 + kc * 8 < dK) {
        uint4 o;
        o.x = pack2(t[(kc * 8 + 0) * 65 + nn], t[(kc * 8 + 1) * 65 + nn]);
        o.y = pack2(t[(kc * 8 + 2) * 65 + nn], t[(kc * 8 + 3) * 65 + nn]);
        o.z = pack2(t[(kc * 8 + 4) * 65 + nn], t[(kc * 8 + 5) * 65 + nn]);
        o.w = pack2(t[(kc * 8 + 6) * 65 + nn], t[(kc * 8 + 7) * 65 + nn]);
        *(uint4*)(dst + (size_t)(n0 + nn) * dK + k0 + kc * 8) = o;
      }
    }
  }
}

DEV void phase_convw(int tidv, int bidv, const Params& p, int l, char* smem) {
  bf16* wb = (bf16*)(p.ws + B_WB);
  convT(tidv, bidv, p.in[8] + (size_t)l * 2048 * NIN, wb + OW_IN, 2048, NIN, nullptr, smem);
  convT(tidv, bidv, p.in[40] + (size_t)l * 2048 * 8192, wb + OW_M1, 2048, 8192, nullptr, smem);
  convT(tidv, bidv, p.in[41] + (size_t)l * 8192 * 2048, wb + OW_M2, 8192, 2048, nullptr, smem);
  for (int n = 0; n < 3; n++)
    convT(tidv, bidv, p.in[38] + (size_t)(l * 3 + n) * 1024 * 2048, wb + OW_BR + (size_t)n * 2048 * 1024, 1024, 2048, nullptr, smem);
  convT(tidv, bidv, p.in[39] + (size_t)l * 2048 * 2048, wb + OW_OUT, 2048, 2048, nullptr, smem);
  convT(tidv, bidv, p.in[11] + (size_t)l * 512 * 1536, wb + OW_UQ, 512, 1536, p.in[9] + l * 512, smem);
  convT(tidv, bidv, p.in[12] + (size_t)l * 512 * 2048, wb + OW_UKV, 512, 2048, p.in[10] + l * 512, smem);
  convT(tidv, bidv, p.in[36] + (size_t)l * 1024 * 1024, wb + OW_GLU, 1024, 1024, nullptr, smem);
  for (int d = 0; d < 2; d++) {
    convT(tidv, bidv, p.in[19] + (size_t)(l * 2 + d) * 64 * 1024, wb + OW_W2 + (size_t)d * 65536, 64, 1024, nullptr, smem);
    convT(tidv, bidv, p.in[21] + (size_t)(l * 2 + d) * 64 * 1024, wb + OW_A2 + (size_t)d * 65536, 64, 1024, nullptr, smem);
  }
  convT(tidv, bidv, p.in[22] + (size_t)l * 160 * 1024, wb + OW_G2, 160, 1024, nullptr, smem, 192);
}

DEV void phase_norm(int tidv, int bidv, const float* xlat, const float* xctx, const float* g, const float* mod, int shOff, int scOff, bf16* H, int nrows) {
  int wave = tidv >> 6, lane = tidv & 63;
  for (int row = bidv * 4 + wave; row < nrows; row += gridDim.x * 4) {
    const float* x = row < ML ? xlat + (size_t)row * 2048 : xctx + (size_t)(row - ML) * 2048;
    int b = row < ML ? (row >> 12) : 4;
    const float* sh = mod + b * 12288 + shOff;
    const float* sc = mod + b * 12288 + scOff;
    float4 v[8];
    float ss = 0.f;
#pragma unroll
    for (int i = 0; i < 8; i++) {
      v[i] = *(const float4*)(x + i * 256 + lane * 4);
      ss += v[i].x * v[i].x + v[i].y * v[i].y + v[i].z * v[i].z + v[i].w * v[i].w;
    }
    ss = wsum(ss);
    float rinv = rsqrtf(ss * (1.f / 2048.f) + 1e-6f);
#pragma unroll
    for (int i = 0; i < 8; i++) {
      int c = i * 256 + lane * 4;
      float4 g4 = *(const float4*)(g + c), s4 = *(const float4*)(sc + c), h4 = *(const float4*)(sh + c);
      float y0 = v[i].x * rinv * g4.x * (1.f + s4.x) + h4.x;
      float y1 = v[i].y * rinv * g4.y * (1.f + s4.y) + h4.y;
      float y2 = v[i].z * rinv * g4.z * (1.f + s4.z) + h4.z;
      float y3 = v[i].w * rinv * g4.w * (1.f + s4.w) + h4.w;
      uint2 o;
      o.x = pack2(y0, y1);
      o.y = pack2(y2, y3);
      *(uint2*)(H + (size_t)row * 2048 + c) = o;
    }
  }
}

constexpr int LDT = 40;
constexpr int GA_BYTES = 256 * LDT * 2;
constexpr int GSTAGE = (256 + 128) * LDT * 2;
DEV float sumsq8(uint4 r) {
  float s = 0.f, x;
  x = bf2f((bf16)(r.x & 0xffff)); s += x * x; x = bf2f((bf16)(r.x >> 16)); s += x * x;
  x = bf2f((bf16)(r.y & 0xffff)); s += x * x; x = bf2f((bf16)(r.y >> 16)); s += x * x;
  x = bf2f((bf16)(r.z & 0xffff)); s += x * x; x = bf2f((bf16)(r.z >> 16)); s += x * x;
  x = bf2f((bf16)(r.w & 0xffff)); s += x * x; x = bf2f((bf16)(r.w >> 16)); s += x * x;
  return s;
}

template <bool ROWNORM>
DEV void gemm_mainloop(int tidv, int bidv, const bf16* __restrict__ A, int lda, bool amap, const bf16* __restrict__ Bt, int K, int N, int m0, int n0,
                       char* smem, f32x4 (&acc)[8][4]) {
  float* srinv = (float*)(smem + 2 * GSTAGE);
  const int tid = tidv, lane = tid & 63, wave = tid >> 6;
  const int wm = wave >> 1, wn = wave & 1;
  const int lr = tid >> 2, kc = tid & 3;
  const char* abase = (const char*)(A + (size_t)m0 * lda);
  const char* bbase = (const char*)(Bt + (size_t)n0 * K);
  const uint32_t voa = (uint32_t)(lr * lda + kc * 8) * 2u;
  const uint32_t astep = (uint32_t)(64 * lda) * 2u;
  int nr0 = n0 + lr; if (nr0 > N - 1) nr0 = N - 1;
  int nr1 = n0 + lr + 64; if (nr1 > N - 1) nr1 = N - 1;
  const uint32_t vob0 = (uint32_t)((nr0 - n0) * K + kc * 8) * 2u;
  const uint32_t vob1 = (uint32_t)((nr1 - n0) * K + kc * 8) * 2u;
  const uint32_t lds_st = (uint32_t)(lr * LDT + kc * 8) * 2u;
  const int nk = K >> 5;
  uint4 xa0, xa1, xa2, xa3, xb0, xb1;
  float ss0 = 0.f, ss1 = 0.f, ss2 = 0.f, ss3 = 0.f;
#define G_LOAD(KT)                                                         \
  {                                                                        \
    const int k0_ = (KT) << 5;                                             \
    const int ka_ = amap ? ((k0_ >> 7) * 192 + (k0_ & 127)) : k0_;         \
    xa0 = *(const uint4*)(abase + (size_t)ka_ * 2 + voa);                  \
    xa1 = *(const uint4*)(abase + (size_t)ka_ * 2 + astep + voa);          \
    xa2 = *(const uint4*)(abase + (size_t)ka_ * 2 + 2 * astep + voa);      \
    xa3 = *(const uint4*)(abase + (size_t)ka_ * 2 + 3 * astep + voa);      \
    xb0 = *(const uint4*)(bbase + (size_t)k0_ * 2 + vob0);                 \
    xb1 = *(const uint4*)(bbase + (size_t)k0_ * 2 + vob1);                 \
  }
#define G_STORE(SN)                                                  \
  *(uint4*)((SN) + lds_st) = xa0;                                    \
  *(uint4*)((SN) + 1 * (64 * LDT * 2) + lds_st) = xa1;               \
  *(uint4*)((SN) + 2 * (64 * LDT * 2) + lds_st) = xa2;               \
  *(uint4*)((SN) + 3 * (64 * LDT * 2) + lds_st) = xa3;               \
  *(uint4*)((SN) + GA_BYTES + lds_st) = xb0;                         \
  *(uint4*)((SN) + GA_BYTES + 64 * LDT * 2 + lds_st) = xb1;          \
  if (ROWNORM) { ss0 += sumsq8(xa0); ss1 += sumsq8(xa1); ss2 += sumsq8(xa2); ss3 += sumsq8(xa3); }
  const uint32_t fa = (uint32_t)((wm * 128 + (lane & 15)) * LDT + (lane >> 4) * 8) * 2u;
  const uint32_t fb = (uint32_t)GA_BYTES + (uint32_t)((wn * 64 + (lane & 15)) * LDT + (lane >> 4) * 8) * 2u;
  const int nkm = nk - 1;
  G_LOAD(0)
  __syncthreads();
  G_STORE(smem)
  G_LOAD((1 < nkm ? 1 : nkm))
  __syncthreads();
  for (int kt = 0; kt < nk; kt++) {
    const char* st = smem + (kt & 1) * GSTAGE;
    {
      bf16x8 af[8], bfr[4];
#pragma unroll
      for (int i = 0; i < 8; i++) af[i] = *(const bf16x8*)(st + fa + i * (16 * LDT * 2));
#pragma unroll
      for (int j = 0; j < 4; j++) bfr[j] = *(const bf16x8*)(st + fb + j * (16 * LDT * 2));
#pragma unroll
      for (int i = 0; i < 8; i++)
#pragma unroll
        for (int j = 0; j < 4; j++) acc[i][j] = __builtin_amdgcn_mfma_f32_16x16x32_bf16(bfr[j], af[i], acc[i][j], 0, 0, 0);
    }
    if (kt + 1 < nk) {
      char* sn = smem + ((kt + 1) & 1) * GSTAGE;
      G_STORE(sn)
    }
    G_LOAD((kt + 2 < nkm ? kt + 2 : nkm))
    __syncthreads();
  }
  if (ROWNORM) {
    float v;
    v = ss0; v += __shfl_xor(v, 1); v += __shfl_xor(v, 2); if (kc == 0) srinv[lr] = rsqrtf(v / (float)K + 1e-6f);
    v = ss1; v += __shfl_xor(v, 1); v += __shfl_xor(v, 2); if (kc == 0) srinv[lr + 64] = rsqrtf(v / (float)K + 1e-6f);
    v = ss2; v += __shfl_xor(v, 1); v += __shfl_xor(v, 2); if (kc == 0) srinv[lr + 128] = rsqrtf(v / (float)K + 1e-6f);
    v = ss3; v += __shfl_xor(v, 1); v += __shfl_xor(v, 2); if (kc == 0) srinv[lr + 192] = rsqrtf(v / (float)K + 1e-6f);
    __syncthreads();
  }
#undef G_LOAD
#undef G_STORE
}

DEV void zero_acc(f32x4 (&acc)[8][4]) {
#pragma unroll
  for (int i = 0; i < 8; i++)
#pragma unroll
    for (int j = 0; j < 4; j++) acc[i][j] = f32x4{0.f, 0.f, 0.f, 0.f};
}

template <class F>
DEV void epi_loop(int tidv, int bidv, f32x4 (&acc)[8][4], int m0, int n0, int N, F f) {
  const int lane = tidv & 63, wave = tidv >> 6;
  const int wm = wave >> 1, wn = wave & 1;
#pragma unroll
  for (int i = 0; i < 8; i++) {
    const int lrow = wm * 128 + i * 16 + (lane & 15);
#pragma unroll
    for (int j = 0; j < 4; j++) {
      int col = n0 + wn * 64 + j * 16 + (lane >> 4) * 4;
      if (col < N) f(m0 + lrow, lrow, col, acc[i][j]);
    }
    __builtin_amdgcn_sched_barrier(0);
  }
}

DEV uint2 pack4(f32x4 v) {
  uint2 o;
  o.x = pack2(v[0], v[1]);
  o.y = pack2(v[2], v[3]);
  return o;
}
DEV f32x4 unpack4(uint2 u) {
  f32x4 v;
  v[0] = bf2f((bf16)(u.x & 0xffff)); v[1] = bf2f((bf16)(u.x >> 16));
  v[2] = bf2f((bf16)(u.y & 0xffff)); v[3] = bf2f((bf16)(u.y >> 16));
  return v;
}

enum { G_IN = 0, G_UQ, G_UKV, G_W2, G_A2, G_G2, G_GLU, G_OUT, G_M1, G_M2, G_MG0, G_MG1, G_MG2 };

template <int MODE>
DEV void run_gemm(int tidv, int bidv, const Params& p, int l, char* smem, const bf16* A, int lda, const bf16* Bt, int K, int N, int M, int aux,
                  const float* xin_lat, const float* xin_ctx, float* xout_lat, float* xout_ctx) {
  const int nt = (N + 127) >> 7, mt = M >> 8;
  char* ws = p.ws;
  bf16* Z = (bf16*)(ws + B_ZB);
  const float* srinv = (const float*)(smem + 2 * GSTAGE);
  const float* mod = (const float*)(ws + B_MOD) + (size_t)l * 5 * 12288;
  for (int tile = bidv; tile < nt * mt; tile += gridDim.x) {
    int m0 = (tile / nt) << 8, n0 = (tile % nt) << 7;
    f32x4 acc[8][4];
    zero_acc(acc);
    gemm_mainloop<(MODE == G_UQ || MODE == G_UKV)>(tidv, bidv, A, lda, MODE == G_MG0, Bt, K, N, m0, n0, smem, acc);
    epi_loop(tidv, bidv, acc, m0, n0, N, [&](int row, int lrow, int col, f32x4 v) {
      if constexpr (MODE == G_IN) {
        f32x4 o = v;
        if (col >= C_GATE || (col >= C_GD && col < C_U)) {
#pragma unroll
          for (int r = 0; r < 4; r++) o[r] = sigmoidf_(v[r]);
        } else if (col >= C_WD && col < C_AD) {
#pragma unroll
          for (int r = 0; r < 4; r++) o[r] = tanhf(v[r]);
        }
        *(uint2*)(Z + (size_t)row * NIN + col) = pack4(o);
      } else if constexpr (MODE == G_UQ) {
        float ri = srinv[lrow];
        *(uint2*)((bf16*)(ws + B_QB) + (size_t)row * 1536 + col) = pack4(v * ri);
      } else if constexpr (MODE == G_UKV) {
        float ri = srinv[lrow];
        f32x4 o = v * ri;
        int h = col >> 8, c = col & 255;
        if (c < 128) {
          *(uint2*)((bf16*)(ws + B_KN) + (size_t)row * 1024 + h * 128 + c) = pack4(o);
        } else {
          int b, kp;
          if (row < ML) { b = row >> 12; kp = row & 4095; } else { int r2 = row - ML; b = r2 >> 8; kp = 4096 + (r2 & 255); }
          bf16* vt = (bf16*)(ws + B_VT) + ((size_t)((b * 8 + h) * 128 + (c - 128))) * NKEY + kp;
#pragma unroll
          for (int r = 0; r < 4; r++) vt[(size_t)r * NKEY] = f2bf(o[r]);
        }
      } else if constexpr (MODE == G_W2) {
        float4 w0 = *(const float4*)(p.in[18] + (l * 2 + aux) * 1024 + col);
        f32x4 o;
        o[0] = 0.60653066f * sigmoidf_(w0.x + v[0]);
        o[1] = 0.60653066f * sigmoidf_(w0.y + v[1]);
        o[2] = 0.60653066f * sigmoidf_(w0.z + v[2]);
        o[3] = 0.60653066f * sigmoidf_(w0.w + v[3]);
        *(uint2*)((bf16*)(ws + B_HB + (size_t)aux * SZ1K) + (size_t)row * 1024 + col) = pack4(o);
      } else if constexpr (MODE == G_A2) {
        float4 a0 = *(const float4*)(p.in[20] + (l * 2 + aux) * 1024 + col);
        f32x4 o;
        o[0] = sigmoidf_(a0.x + v[0]);
        o[1] = sigmoidf_(a0.y + v[1]);
        o[2] = sigmoidf_(a0.z + v[2]);
        o[3] = sigmoidf_(a0.w + v[3]);
        *(uint2*)((bf16*)(ws + (aux ? B_AB : B_AF)) + (size_t)row * 1024 + col) = pack4(o);
      } else if constexpr (MODE == G_G2) {
        *(uint2*)((bf16*)(ws + B_GB) + (size_t)row * 1024 + col) = pack4(v);
      } else if constexpr (MODE == G_GLU) {
        f32x4 zz = unpack4(*(const uint2*)((const bf16*)(ws + B_SY) + (size_t)row * 1024 + col));
        float4 gb = *(const float4*)(p.in[37] + l * 1024 + col);
        f32x4 o;
        o[0] = zz[0] * sigmoidf_(v[0] + gb.x);
        o[1] = zz[1] * sigmoidf_(v[1] + gb.y);
        o[2] = zz[2] * sigmoidf_(v[2] + gb.z);
        o[3] = zz[3] * sigmoidf_(v[3] + gb.w);
        *(uint2*)(Z + (size_t)row * NIN + col) = pack4(o);
      } else if constexpr (MODE == G_OUT) {
        int b = row < ML ? (row >> 12) : 4;
        float4 g = *(const float4*)(mod + b * 12288 + 4096 + col);
        const float* xi = row < ML ? xin_lat + (size_t)row * 2048 : xin_ctx + (size_t)(row - ML) * 2048;
        float* xo = row < ML ? xout_lat + (size_t)row * 2048 : xout_ctx + (size_t)(row - ML) * 2048;
        float4 x = *(const float4*)(xi + col);
        x.x += g.x * v[0]; x.y += g.y * v[1]; x.z += g.z * v[2]; x.w += g.w * v[3];
        *(float4*)(xo + col) = x;
      } else if constexpr (MODE == G_M1) {
        f32x4 o;
#pragma unroll
        for (int r = 0; r < 4; r++) { float t = fmaxf(v[r], 0.f); o[r] = t * t; }
        *(uint2*)(Z + (size_t)row * DFF + col) = pack4(o);
      } else if constexpr (MODE == G_MG0 || MODE == G_MG1 || MODE == G_MG2) {
        constexpr int nb = MODE - G_MG0;
        bf16* MG = (bf16*)(ws + B_HB);
        f32x4 g = unpack4(*(const uint2*)(Z + (size_t)row * NIN + C_GATE + nb * 2048 + col));
        f32x4 o = g * v;
        if constexpr (nb > 0) o += unpack4(*(const uint2*)(MG + (size_t)row * 2048 + col));
        *(uint2*)(MG + (size_t)row * 2048 + col) = pack4(o);
      } else if constexpr (MODE == G_M2) {
        int b = row < ML ? (row >> 12) : 4;
        float4 g = *(const float4*)(mod + b * 12288 + 10240 + col);
        float* xo = row < ML ? xout_lat + (size_t)row * 2048 : xout_ctx + (size_t)(row - ML) * 2048;
        float4 x = *(const float4*)(xo + col);
        x.x += g.x * v[0]; x.y += g.y * v[1]; x.z += g.z * v[2]; x.w += g.w * v[3];
        *(float4*)(xo + col) = x;
      }
    });
  }
}

DEV void phase_mla_post(int tidv, int bidv, const Params& p, int l) {
  char* ws = p.ws;
  const float* qng = p.in[13] + l * 128;
  const float* qrg = p.in[14] + l * 64;
  const float* kng = p.in[15] + l * 128;
  const float* krg = p.in[16] + l * 64;
  bf16* QB = (bf16*)(ws + B_QB);
  bf16* KN = (bf16*)(ws + B_KN);
  bf16* KR = (bf16*)(ws + B_KR);
  const bf16* Z = (const bf16*)(ws + B_ZB);
  const int wave = tidv >> 6, lane = tidv & 63;
  const float QS = 1.4426950408889634f * 0.07216878364870322f;
  const int idx = lane & 31;
  const float inv = powf(10000.f, -(float)(idx & 15) / 16.f);
  const float gq0 = qng[2 * lane], gq1 = qng[2 * lane + 1], gk0 = kng[2 * lane], gk1 = kng[2 * lane + 1];
  const float gqr = qrg[lane], gkr = krg[lane];
  for (int row = bidv * 4 + wave; row < MT; row += gridDim.x * 4) {
    bool lat = row < ML;
    int t = row & 4095;
    float pos = (idx < 16) ? (float)(t >> 6) : (float)(t & 63);
    float ang = pos * inv;
    float cs = 1.f, sn = 0.f;
    if (lat) { cs = cosf(ang); sn = sinf(ang); }
#pragma unroll 1
    for (int h = 0; h < 8; h++) {
      bf16* q = QB + (size_t)row * 1536 + h * 192;
      uint32_t u = *(const uint32_t*)(q + 2 * lane);
      float x0 = bf2f((bf16)(u & 0xffff)), x1 = bf2f((bf16)(u >> 16));
      float ss = wsum(x0 * x0 + x1 * x1);
      float rinv = rsqrtf(ss * (1.f / 128.f) + 1e-6f) * QS;
      *(uint32_t*)(q + 2 * lane) = pack2(x0 * rinv * gq0, x1 * rinv * gq1);
      float xr = bf2f(q[128 + lane]);
      float ss2 = wsum(xr * xr);
      float y = xr * rsqrtf(ss2 * (1.f / 64.f) + 1e-6f) * gqr;
      float yp = __shfl_xor(y, 32);
      float o = lane < 32 ? (y * cs - yp * sn) : (yp * sn + y * cs);
      q[128 + lane] = f2bf(o * QS);
      bf16* k = KN + (size_t)row * 1024 + h * 128;
      uint32_t uk = *(const uint32_t*)(k + 2 * lane);
      float k0 = bf2f((bf16)(uk & 0xffff)), k1 = bf2f((bf16)(uk >> 16));
      float ssk = wsum(k0 * k0 + k1 * k1);
      float rk = rsqrtf(ssk * (1.f / 128.f) + 1e-6f);
      *(uint32_t*)(k + 2 * lane) = pack2(k0 * rk * gk0, k1 * rk * gk1);
    }
    {
      float xr = bf2f(Z[(size_t)row * NIN + C_KR + lane]);
      float ss2 = wsum(xr * xr);
      float y = xr * rsqrtf(ss2 * (1.f / 64.f) + 1e-6f) * gkr;
      float yp = __shfl_xor(y, 32);
      float o = lane < 32 ? (y * cs - yp * sn) : (yp * sn + y * cs);
      KR[(size_t)row * 64 + lane] = f2bf(o);
    }
  }
}

DEV void step_row(int s, int d, int b, int& row, int& tau, int& len) {
  if (s < 256) { tau = d ? 255 - s : s; len = 256; row = ML + b * 256 + tau; }
  else { int q = s - 256; tau = d ? 4095 - q : q; len = 4096; row = b * 4096 + tau; }
}

struct RwPre { bf16 r0, r1, r2, k0, k1, k2, v0, v1, v2, a, e; };

DEV void rwkv_fetch(RwPre& q, const bf16* Z, const bf16* AD, const bf16* ED, int s, int d, int b, int ch) {
  int row, tau, len;
  step_row(s, d, b, row, tau, len);
  const bf16* z = Z + (size_t)row * NIN + C_R + ch;
  q.r1 = z[0]; q.k1 = z[1024]; q.v1 = z[2048];
  q.r0 = 0; q.k0 = 0; q.v0 = 0; q.r2 = 0; q.k2 = 0; q.v2 = 0;
  if (tau > 0) { const bf16* zm = z - NIN; q.r0 = zm[0]; q.k0 = zm[1024]; q.v0 = zm[2048]; }
  if (tau < len - 1) { const bf16* zp = z + NIN; q.r2 = zp[0]; q.k2 = zp[1024]; q.v2 = zp[2048]; }
  q.a = AD[(size_t)row * 1024 + ch];
  q.e = ED[(size_t)row * 1024 + ch];
}

typedef float f2v __attribute__((ext_vector_type(2)));
DEV float dpp_hmirror(float v) {
  int i = __float_as_int(v);
  return __int_as_float(__builtin_amdgcn_update_dpp(i, i, 0x141, 0xF, 0xF, false));
}
DEV f2v lo2(float4 v) { return f2v{v.x, v.y}; }
DEV f2v hi2(float4 v) { return f2v{v.z, v.w}; }

DEV void rwkv_scan(int tidv, int bidv, const Params& p, int l, int task, char* smem, int dry) {
  char* ws = p.ws;
  float* op = (float*)smem;
  float* vb = op + 16 * 320;
  float* yb = vb + 16 * 64;
  const int tid = tidv, wave = tid >> 6, lane = tid & 63;
  const int half = task & 1, chain = task >> 1;
  const int d = chain & 1, h = (chain >> 1) & 15, b = chain >> 5;
  const int ch = h * 64 + lane;
  const float* cw = p.in[17] + (size_t)l * 3 * 3072;
  const float cr0 = cw[ch], cr1 = cw[3072 + ch], cr2 = cw[6144 + ch];
  const float ck0 = cw[1024 + ch], ck1 = cw[3072 + 1024 + ch], ck2 = cw[6144 + 1024 + ch];
  const float cv0 = cw[2048 + ch], cv1 = cw[3072 + 2048 + ch], cv2 = cw[6144 + 2048 + ch];
  const float kkc = p.in[23][l * 1024 + ch], kac = p.in[24][l * 1024 + ch];
  const bf16* Z = (const bf16*)(ws + B_ZB);
  bf16* ED = (bf16*)(ws + B_HB + (size_t)d * SZ1K);
  const bf16* AD = (const bf16*)(ws + (d ? B_AB : B_AF));
  f2v S0 = {0.f, 0.f}, S1 = {0.f, 0.f}, S2 = {0.f, 0.f}, S3 = {0.f, 0.f};
  int* flg = (int*)(ws + B_FLG) + (l * 2 + (dry ? 1 : 0)) * 256;
  const int ri = lane >> 3, jo = lane & 7, lrow = wave * 8 + ri, irow = half * 32 + lrow;
  RwPre pre[4];
#pragma unroll
  for (int si = 0; si < 4; si++) rwkv_fetch(pre[si], Z, AD, ED, wave * 4 + si, d, b, ch);
  for (int chunk = 0; chunk < 272; chunk++) {
#pragma unroll
    for (int si = 0; si < 4; si++) {
      int t = wave * 4 + si;
      const RwPre& q = pre[si];
      float rr = cr0 * bf2f(q.r0) + cr1 * bf2f(q.r1) + cr2 * bf2f(q.r2);
      float kk_ = ck0 * bf2f(q.k0) + ck1 * bf2f(q.k1) + ck2 * bf2f(q.k2);
      float vv = cv0 * bf2f(q.v0) + cv1 * bf2f(q.v1) + cv2 * bf2f(q.v2);
      float kkv = kk_ * kkc;
      float ssq = wsum(kkv * kkv);
      float kn = kkv * rsqrtf(ssq + 1e-12f);
      float a = bf2f(q.a);
      float w = __expf(-bf2f(q.e));
      float krep = kk_ * (1.f + (a - 1.f) * kac);
      float* o = op + t * 320;
      o[lane] = w;
      o[64 + lane] = kn * a;
      o[128 + lane] = krep;
      o[192 + lane] = -kn;
      o[256 + lane] = rr;
      vb[t * 64 + lane] = vv;
    }
    __syncthreads();
    if (tid == 0) __hip_atomic_store(flg + task, chunk + 1, __ATOMIC_RELAXED, __HIP_MEMORY_SCOPE_AGENT);
    if (chunk + 1 < 272) {
#pragma unroll
      for (int si = 0; si < 4; si++) rwkv_fetch(pre[si], Z, AD, ED, (chunk + 1) * 16 + wave * 4 + si, d, b, ch);
    }
    {
      const float4* o4 = (const float4*)(op + jo * 8);
      float4 n0 = o4[48], n1 = o4[49];
#pragma unroll 4
      for (int t = 0; t < 16; t++) {
        const float4* ot = o4 + t * 80;
        const float4 w0 = ot[0], w1 = ot[1];
        const float4 a0 = ot[16], a1 = ot[17];
        const float4 k0 = ot[32], k1 = ot[33];
        const float4 r0 = ot[64], r1 = ot[65];
        const float vi = vb[t * 64 + irow];
        const int tn = t < 15 ? t + 1 : 15;
        const float4* on = o4 + tn * 80;
        const float4 m0 = on[48], m1 = on[49];
        f2v sv = S0 * lo2(n0) + S1 * hi2(n0) + (S2 * lo2(n1) + S3 * hi2(n1));
        float sa = sv.x + sv.y;
        sa += dpp_xor1(sa);
        sa += dpp_xor2(sa);
        sa += dpp_hmirror(sa);
        const f2v sa2 = {sa, sa}, vi2 = {vi, vi};
        S0 = S0 * lo2(w0) + sa2 * lo2(a0) + vi2 * lo2(k0);
        S1 = S1 * hi2(w0) + sa2 * hi2(a0) + vi2 * hi2(k0);
        S2 = S2 * lo2(w1) + sa2 * lo2(a1) + vi2 * lo2(k1);
        S3 = S3 * hi2(w1) + sa2 * hi2(a1) + vi2 * hi2(k1);
        f2v yv = S0 * lo2(r0) + S1 * hi2(r0) + (S2 * lo2(r1) + S3 * hi2(r1));
        float y = yv.x + yv.y;
        y += dpp_xor1(y);
        y += dpp_xor2(y);
        y += dpp_hmirror(y);
        if (jo == 0) yb[t * 32 + lrow] = y;
        n0 = m0; n1 = m1;
      }
    }
    if (tid == 0) {
      while (__hip_atomic_load(flg + (task ^ 1), __ATOMIC_RELAXED, __HIP_MEMORY_SCOPE_AGENT) < chunk + 1) __builtin_amdgcn_s_sleep(1);
    }
    __syncthreads();
#pragma unroll
    for (int it = 0; it < 2; it++) {
      int idx = it * 256 + tid;
      int t = idx >> 5, i = idx & 31;
      int row, tau, len;
      step_row(chunk * 16 + t, d, b, row, tau, len);
      size_t off = (size_t)row * 1024 + h * 64 + half * 32 + i;
      bf16* yd = dry ? (bf16*)(ws + B_END) + (off & 0x3fffff) : ED + off;
      *yd = f2bf(yb[t * 32 + i]);
    }
  }
}

DEV void s5_scan(int tidv, int bidv, const Params& p, int l, int chain, char* smemw, int dry) {
  char* ws = p.ws;
  const int lane = tidv & 63;
  const int d = chain & 1, g = (chain >> 1) & 63, b = chain >> 7;
  float* ub = (float*)smemw;
  float* hb = ub + 256;
  const size_t pg = (size_t)(l * 2 + d) * 64 + g;
  const float lre = p.in[28][pg * 64 + lane], lim = p.in[29][pg * 64 + lane];
  const float dt = expf(p.in[30][pg]);
  const float mag = expf(lre * dt);
  const float are = mag * cosf(lim * dt), aim = mag * sinf(lim * dt);
  const float den = lre * lre + lim * lim;
  const float qre = ((are - 1.f) * lre + aim * lim) / den;
  const float qim = (aim * lre - (are - 1.f) * lim) / den;
  float bbre[16], bbim[16];
  {
    const float* br = p.in[31] + (pg * 64 + lane) * 16;
    const float* bi = p.in[32] + (pg * 64 + lane) * 16;
#pragma unroll
    for (int i = 0; i < 16; i++) {
      float x = br[i], y = bi[i];
      bbre[i] = qre * x - qim * y;
      bbim[i] = qre * y + qim * x;
    }
  }
  bf16x8 cfr[4];
  {
    const int i = lane & 15, quad = lane >> 4;
    const float* cre = p.in[33] + (pg * 16 + i) * 64;
    const float* cim = p.in[34] + (pg * 16 + i) * 64;
#pragma unroll
    for (int ks = 0; ks < 4; ks++)
#pragma unroll
      for (int j = 0; j < 8; j++) {
        int k = ks * 32 + quad * 8 + j;
        float c = ks < 2 ? cre[k] : -cim[k - 64];
        cfr[ks][j] = (short)f2bf(c);
      }
  }
  float hre = 0.f, him = 0.f;
  const bf16* Z = (const bf16*)(ws + B_ZB);
  const int tt = lane >> 2, i0 = (lane & 3) * 4;
  uint2 unext;
  {
    int row, tau, len;
    step_row(tt, d, b, row, tau, len);
    unext = *(const uint2*)(Z + (size_t)row * NIN + C_U + g * 16 + i0);
  }
  for (int chunk = 0; chunk < 272; chunk++) {
    {
      uint2 u = unext;
      float4 f;
      f.x = bf2f((bf16)(u.x & 0xffff)); f.y = bf2f((bf16)(u.x >> 16));
      f.z = bf2f((bf16)(u.y & 0xffff)); f.w = bf2f((bf16)(u.y >> 16));
      *(float4*)(ub + tt * 16 + i0) = f;
    }
    __syncthreads();
    if (chunk + 1 < 272) {
      int row, tau, len;
      step_row((chunk + 1) * 16 + tt, d, b, row, tau, len);
      unext = *(const uint2*)(Z + (size_t)row * NIN + C_U + g * 16 + i0);
    }
#pragma unroll 2
    for (int t = 0; t < 16; t++) {
      const float* u = ub + t * 16;
      float br0 = 0.f, bi0 = 0.f;
#pragma unroll
      for (int i = 0; i < 16; i++) { float uv = u[i]; br0 += bbre[i] * uv; bi0 += bbim[i] * uv; }
      float nr = are * hre - aim * him + br0;
      float ni = are * him + aim * hre + bi0;
      hre = nr; him = ni;
      hb[t * 132 + lane] = hre;
      hb[t * 132 + 64 + lane] = him;
    }
    __syncthreads();
    {
      f32x4 yacc = {0.f, 0.f, 0.f, 0.f};
      const float* hr = hb + (lane & 15) * 132 + (lane >> 4) * 8;
#pragma unroll
      for (int ks = 0; ks < 4; ks++) {
        float4 x0 = *(const float4*)(hr + ks * 32), x1 = *(const float4*)(hr + ks * 32 + 4);
        union { bf16x8 v; uint32_t u[4]; } af;
        af.u[0] = pack2(x0.x, x0.y); af.u[1] = pack2(x0.z, x0.w);
        af.u[2] = pack2(x1.x, x1.y); af.u[3] = pack2(x1.z, x1.w);
        yacc = __builtin_amdgcn_mfma_f32_16x16x32_bf16(af.v, cfr[ks], yacc, 0, 0, 0);
      }
      const int ii = lane & 15;
#pragma unroll
      for (int r = 0; r < 4; r++) {
        int row, tau, len;
        step_row(chunk * 16 + (lane >> 4) * 4 + r, d, b, row, tau, len);
        bf16* dst = d == 0 ? (bf16*)(ws + B_SY) + (size_t)row * 1024 + g * 16 + ii : (bf16*)(ws + B_ZB) + (size_t)row * NIN + g * 16 + ii;
        if (dry) dst = (bf16*)(ws + B_END) + ((((size_t)row * 1024 + g * 16 + ii)) & 0x3fffff);
        *dst = f2bf(yacc[r]);
      }
    }
    __syncthreads();
  }
}

DEV int perm23(int r) { return (r & 0x13) | ((r & 4) << 1) | ((r & 8) >> 1); }

DEV void attn_item(int tidv, int bidv, const Params& p, int item, bool ctxq, char* smem, int dry) {
  char* ws = p.ws;
  bf16* sK = (bf16*)smem;
  bf16* sV = sK + 64 * 200;
  const int tid = tidv, wave = tid >> 6, lane = tid & 63;
  const int r = lane & 31, hf = lane >> 5;
  int b, hd, qt;
  if (!ctxq) { b = item >> 8; hd = (item >> 5) & 7; qt = item & 31; }
  else { b = item >> 4; hd = (item >> 1) & 7; qt = item & 1; }
  const int qrow0 = ctxq ? ML + b * 256 + qt * 128 : b * 4096 + qt * 128;
  const int kt0 = ctxq ? 64 : 0, kt1 = 68;
  bf16* QB = (bf16*)(ws + B_QB);
  const bf16* KN = (const bf16*)(ws + B_KN);
  const bf16* KR = (const bf16*)(ws + B_KR);
  const bf16* VT = (const bf16*)(ws + B_VT);
  bf16x8 qf[12];
  {
    const bf16* qp = QB + (size_t)(qrow0 + wave * 32 + r) * 1536 + hd * 192 + hf * 8;
#pragma unroll
    for (int kk = 0; kk < 12; kk++) qf[kk] = *(const bf16x8*)(qp + kk * 16);
  }
  f32x16 oacc[4];
#pragma unroll
  for (int i = 0; i < 4; i++)
#pragma unroll
    for (int e = 0; e < 16; e++) oacc[i][e] = 0.f;
  float mrun = -1e30f, lrun = 0.f;
  const int pr = perm23(r);
  for (int kt = kt0; kt < kt1; kt++) {
    __syncthreads();
    const int key0 = kt * 64;
    const int rowbase = key0 < 4096 ? b * 4096 + key0 : ML + b * 256 + (key0 - 4096);
    {
      const char* bk = (const char*)(KN + (size_t)rowbase * 1024 + hd * 128);
      const char* br = (const char*)(KR + (size_t)rowbase * 64);
      const char* bv = (const char*)(VT + ((size_t)((b * 8 + hd) * 128)) * NKEY + key0);
      const uint32_t vo_n = (uint32_t)((tid >> 4) * 2048 + (tid & 15) * 16);
      const uint32_t lo_n = (uint32_t)((tid >> 4) * 400 + (tid & 15) * 16);
      const uint32_t vo_r = (uint32_t)((tid >> 3) * 128 + (tid & 7) * 16);
      const uint32_t lo_r = (uint32_t)((tid >> 3) * 400 + 256 + (tid & 7) * 16);
      const uint32_t vo_v = (uint32_t)((tid >> 3) * (NKEY * 2) + (tid & 7) * 16);
      const uint32_t lo_v = (uint32_t)((tid >> 3) * 144 + (tid & 7) * 16);
      uint4 t0 = *(const uint4*)(bk + vo_n);
      uint4 t1 = *(const uint4*)(bk + 16 * 2048 + vo_n);
      uint4 t2 = *(const uint4*)(bk + 32 * 2048 + vo_n);
      uint4 t3 = *(const uint4*)(bk + 48 * 2048 + vo_n);
      uint4 t4 = *(const uint4*)(br + vo_r);
      uint4 t5 = *(const uint4*)(br + 32 * 128 + vo_r);
      *(uint4*)((char*)sK + lo_n) = t0;
      *(uint4*)((char*)sK + 16 * 400 + lo_n) = t1;
      *(uint4*)((char*)sK + 32 * 400 + lo_n) = t2;
      *(uint4*)((char*)sK + 48 * 400 + lo_n) = t3;
      *(uint4*)((char*)sK + lo_r) = t4;
      *(uint4*)((char*)sK + 32 * 400 + lo_r) = t5;
      __builtin_amdgcn_sched_barrier(0);
      uint4 u0 = *(const uint4*)(bv + vo_v);
      uint4 u1 = *(const uint4*)(bv + (size_t)32 * NKEY * 2 + vo_v);
      uint4 u2 = *(const uint4*)(bv + (size_t)64 * NKEY * 2 + vo_v);
      uint4 u3 = *(const uint4*)(bv + (size_t)96 * NKEY * 2 + vo_v);
      *(uint4*)((char*)sV + lo_v) = u0;
      *(uint4*)((char*)sV + 32 * 144 + lo_v) = u1;
      *(uint4*)((char*)sV + 64 * 144 + lo_v) = u2;
      *(uint4*)((char*)sV + 96 * 144 + lo_v) = u3;
    }
    __syncthreads();
    f32x16 sacc[2];
#pragma unroll
    for (int m = 0; m < 2; m++) {
#pragma unroll
      for (int e = 0; e < 16; e++) sacc[m][e] = 0.f;
      const bf16* kp = sK + (m * 32 + pr) * 200 + hf * 8;
#pragma unroll
      for (int kk = 0; kk < 12; kk++) {
        bf16x8 kf = *(const bf16x8*)(kp + kk * 16);
        sacc[m] = __builtin_amdgcn_mfma_f32_32x32x16_bf16(kf, qf[kk], sacc[m], 0, 0, 0);
        if ((kk & 3) == 3) __builtin_amdgcn_sched_barrier(0);
      }
      __builtin_amdgcn_sched_barrier(0);
    }
    float tmax = sacc[0][0];
#pragma unroll
    for (int e = 1; e < 16; e++) tmax = fmaxf(tmax, sacc[0][e]);
#pragma unroll
    for (int e = 0; e < 16; e++) tmax = fmaxf(tmax, sacc[1][e]);
    tmax = fmaxf(tmax, __shfl_xor(tmax, 32));
    float mnew = fmaxf(mrun, tmax);
    float alpha = __builtin_amdgcn_exp2f(mrun - mnew);
    mrun = mnew;
    float psum = 0.f;
#pragma unroll
    for (int m = 0; m < 2; m++)
#pragma unroll
      for (int e = 0; e < 16; e++) { float pv = __builtin_amdgcn_exp2f(sacc[m][e] - mnew); sacc[m][e] = pv; psum += pv; }
    lrun = lrun * alpha + psum;
#pragma unroll
    for (int i = 0; i < 4; i++)
#pragma unroll
      for (int e = 0; e < 16; e++) oacc[i][e] *= alpha;
#pragma unroll
    for (int s = 0; s < 4; s++) {
      const int m = s >> 1, s2 = s & 1;
      bf16x8 pf;
#pragma unroll
      for (int j = 0; j < 8; j++) pf[j] = (short)f2bf(sacc[m][8 * s2 + j]);
#pragma unroll
      for (int i = 0; i < 4; i++) {
        bf16x8 vf = *(const bf16x8*)(sV + (i * 32 + r) * 72 + m * 32 + s2 * 16 + hf * 8);
        oacc[i] = __builtin_amdgcn_mfma_f32_32x32x16_bf16(vf, pf, oacc[i], 0, 0, 0);
      }
      __builtin_amdgcn_sched_barrier(0);
    }
  }
  lrun += __shfl_xor(lrun, 32);
  const float inv = 1.f / lrun;
  bf16* op = QB + (size_t)(qrow0 + wave * 32 + r) * 1536 + hd * 192;
  if (dry) op = (bf16*)(ws + B_END) + ((((size_t)(qrow0 + wave * 32 + r) * 1536 + hd * 192)) & 0x3ffff8);
#pragma unroll
  for (int i = 0; i < 4; i++)
#pragma unroll
    for (int g = 0; g < 4; g++) {
      uint2 o;
      o.x = pack2(oacc[i][4 * g] * inv, oacc[i][4 * g + 1] * inv);
      o.y = pack2(oacc[i][4 * g + 2] * inv, oacc[i][4 * g + 3] * inv);
      *(uint2*)(op + 32 * i + 8 * g + 4 * hf) = o;
    }
}

DEV void phase_mixers(int tidv, int bidv, const Params& p, int l, char* smem, int dry) {
  __shared__ int s_item;
#ifdef PROBE_PARTS
  const int parts = dry ? PROBE_PARTS : 7;
#else
  const int parts = 7;
#endif
  for (int task = bidv; task < 384; task += gridDim.x) {
    if (task < 256 && !(parts & 1)) continue;
    if (task >= 256 && !(parts & 2)) continue;
    if (task < 256) rwkv_scan(tidv, bidv, p, l, task, smem, dry);
    else s5_scan(tidv, bidv, p, l, (task - 256) * 4 + (tidv >> 6), smem + (tidv >> 6) * 9472, dry);
  }
  const int nlat = 1024, ntot = (parts & 4) ? ((l == 0) ? 1088 : 1024) : 0;
  int* cnt = (int*)(p.ws + B_CNT) + l + 2 * dry;
#if !defined(MIX_ONLY) || MIX_ONLY == 2
  while (true) {
    __syncthreads();
    if (tidv == 0) s_item = atomicAdd(cnt, 1);
    __syncthreads();
    int item = s_item;
    if (item >= ntot) break;
    if (item < nlat) attn_item(tidv, bidv, p, item, false, smem, dry);
    else attn_item(tidv, bidv, p, item - nlat, true, smem, dry);
  }
#endif
}

DEV float gelu_tanh(float x) {
  float u = 0.7978845608028654f * (x + 0.044715f * x * x * x);
  return 0.5f * x * (1.f + tanhf(u));
}

DEV void phase_post(int tidv, int bidv, const Params& p, int l, int M) {
  char* ws = p.ws;
  const bf16* Z = (const bf16*)(ws + B_ZB);
  const int wave = tidv >> 6, lane = tidv & 63;
  const float* cw = p.in[17] + (size_t)l * 3 * 3072;
  const bf16* YF = (const bf16*)(ws + B_HB);
  const bf16* YB = (const bf16*)(ws + B_HB + SZ1K);
  const bf16* AF = (const bf16*)(ws + B_AF);
  const bf16* AB = (const bf16*)(ws + B_AB);
  bf16* GB = (bf16*)(ws + B_GB);
  const int nitem = M * 16;
  for (int it = bidv * 4 + wave; it < nitem; it += gridDim.x * 4) {
    int row = it >> 4, h = it & 15;
    int ch = h * 64 + lane;
    int tau, len;
    if (row < ML) { tau = row & 4095; len = 4096; } else { tau = (row - ML) & 255; len = 256; }
    size_t o = (size_t)row * 1024 + ch;
    float y = bf2f(YF[o]) + bf2f(YB[o]);
    float mu = wsum(y) * (1.f / 64.f);
    float dv = y - mu;
    float var = wsum(dv * dv) * (1.f / 64.f);
    float yn = dv * rsqrtf(var + 64e-5f) * p.in[26][l * 1024 + ch] + p.in[27][l * 1024 + ch];
    const bf16* z = Z + (size_t)row * NIN + C_R + ch;
    float r1 = bf2f(z[0]), k1 = bf2f(z[1024]), v1 = bf2f(z[2048]);
    float r0 = 0.f, k0 = 0.f, v0 = 0.f, r2 = 0.f, k2 = 0.f, v2 = 0.f;
    if (tau > 0) { const bf16* zm = z - NIN; r0 = bf2f(zm[0]); k0 = bf2f(zm[1024]); v0 = bf2f(zm[2048]); }
    if (tau < len - 1) { const bf16* zp = z + NIN; r2 = bf2f(zp[0]); k2 = bf2f(zp[1024]); v2 = bf2f(zp[2048]); }
    float rr = cw[ch] * r0 + cw[3072 + ch] * r1 + cw[6144 + ch] * r2;
    float kk = cw[1024 + ch] * k0 + cw[3072 + 1024 + ch] * k1 + cw[6144 + 1024 + ch] * k2;
    float vv = cw[2048 + ch] * v0 + cw[3072 + 2048 + ch] * v1 + cw[6144 + 2048 + ch] * v2;
    float am = 0.5f * (bf2f(AF[o]) + bf2f(AB[o]));
    float kbon = kk * (1.f + (am - 1.f) * p.in[24][l * 1024 + ch]);
    float s = wsum(rr * kbon * p.in[25][l * 1024 + ch]);
    float outv = (yn + s * vv) * bf2f(GB[o]);
    GB[o] = f2bf(outv);
  }
  bf16* SY = (bf16*)(ws + B_SY);
  const float* dsk = p.in[35] + l * 1024;
  const int n4 = M * 256;
  for (int i = bidv * 256 + tidv; i < n4; i += gridDim.x * 256) {
    int row = i >> 8, c = (i & 255) * 4;
    uint2 a = *(const uint2*)(SY + (size_t)row * 1024 + c);
    uint2 bq = *(const uint2*)(Z + (size_t)row * NIN + c);
    uint2 u = *(const uint2*)(Z + (size_t)row * NIN + C_U + c);
    float4 dd = *(const float4*)(dsk + c);
    float y0 = bf2f((bf16)(a.x & 0xffff)) + bf2f((bf16)(bq.x & 0xffff)) + dd.x * bf2f((bf16)(u.x & 0xffff));
    float y1 = bf2f((bf16)(a.x >> 16)) + bf2f((bf16)(bq.x >> 16)) + dd.y * bf2f((bf16)(u.x >> 16));
    float y2 = bf2f((bf16)(a.y & 0xffff)) + bf2f((bf16)(bq.y & 0xffff)) + dd.z * bf2f((bf16)(u.y & 0xffff));
    float y3 = bf2f((bf16)(a.y >> 16)) + bf2f((bf16)(bq.y >> 16)) + dd.w * bf2f((bf16)(u.y >> 16));
    uint2 o;
    o.x = pack2(gelu_tanh(y0), gelu_tanh(y1));
    o.y = pack2(gelu_tanh(y2), gelu_tanh(y3));
    *(uint2*)(SY + (size_t)row * 1024 + c) = o;
  }
}

constexpr int NPH = 25;

DEV void run_phase(int tidv, int bidv, const Params& p, int ph, char* smem, int dry) {
  char* ws = p.ws;
#ifndef ONLY_S
  if (ph == 0) {
    if (bidv == 0 && tidv < 4) ((int*)(ws + B_CNT))[tidv] = 0;
    if (bidv == 0) { ((int*)(ws + B_FLG))[tidv] = 0; ((int*)(ws + B_FLG))[tidv + 256] = 0; ((int*)(ws + B_FLG))[tidv + 512] = 0; ((int*)(ws + B_FLG))[tidv + 768] = 0; }
    phase_mod(tidv, bidv, p, smem);
    phase_convw(tidv, bidv, p, 0, smem);
    return;
  }
#endif
  const int l = (ph - 1) / 12, s = (ph - 1) % 12;
#ifdef ONLY_S
  if (s != ONLY_S) return;
#endif
  const bf16* wb = (const bf16*)(ws + B_WB);
  const float* mod = (const float*)(ws + B_MOD) + (size_t)l * 5 * 12288;
  float* XC = (float*)(ws + B_XC);
  const float* xin_lat = l == 0 ? p.in[0] : p.out;
  const float* xin_ctx = l == 0 ? p.in[2] : XC;
  bf16* HB = (bf16*)(ws + B_HB);
  bf16* Z = (bf16*)(ws + B_ZB);
  bf16* H2 = (bf16*)(ws + B_KN);
  const int Mpost = l == 0 ? MT : ML;
  switch (s) {
    case 0:
      if (l == 1) phase_convw(tidv, bidv, p, 1, smem);
      phase_norm(tidv, bidv, xin_lat, xin_ctx, p.in[6] + l * 2048, mod, 0, 2048, HB, MT);
      break;
    case 1:
      run_gemm<G_IN>(tidv, bidv, p, l, smem, HB, 2048, wb + OW_IN, 2048, NIN, MT, 0, nullptr, nullptr, nullptr, nullptr);
      break;
    case 2:
      run_gemm<G_UKV>(tidv, bidv, p, l, smem, Z + C_CKV, NIN, wb + OW_UKV, 512, 2048, MT, 0, nullptr, nullptr, nullptr, nullptr);
      run_gemm<G_UQ>(tidv, bidv, p, l, smem, Z + C_CQ, NIN, wb + OW_UQ, 512, 1536, MT, 0, nullptr, nullptr, nullptr, nullptr);
      run_gemm<G_G2>(tidv, bidv, p, l, smem, Z + C_GD, NIN, wb + OW_G2, 192, 1024, MT, 0, nullptr, nullptr, nullptr, nullptr);
      for (int d = 0; d < 2; d++) {
        run_gemm<G_W2>(tidv, bidv, p, l, smem, Z + C_WD + 64 * d, NIN, wb + OW_W2 + (size_t)d * 65536, 64, 1024, MT, d, nullptr, nullptr, nullptr, nullptr);
        run_gemm<G_A2>(tidv, bidv, p, l, smem, Z + C_AD + 64 * d, NIN, wb + OW_A2 + (size_t)d * 65536, 64, 1024, MT, d, nullptr, nullptr, nullptr, nullptr);
      }
      break;
    case 3: phase_mla_post(tidv, bidv, p, l); break;
    case 4: phase_mixers(tidv, bidv, p, l, smem, dry); break;
    case 5: phase_post(tidv, bidv, p, l, Mpost); break;
    case 6:
      run_gemm<G_GLU>(tidv, bidv, p, l, smem, (const bf16*)(ws + B_SY), 1024, wb + OW_GLU, 1024, 1024, Mpost, 0, nullptr, nullptr, nullptr, nullptr);
      break;
    case 7:
      run_gemm<G_MG0>(tidv, bidv, p, l, smem, (const bf16*)(ws + B_QB), 1536, wb + OW_BR, 1024, 2048, Mpost, 0, nullptr, nullptr, nullptr, nullptr);
      run_gemm<G_MG1>(tidv, bidv, p, l, smem, (const bf16*)(ws + B_GB), 1024, wb + OW_BR + (size_t)2048 * 1024, 1024, 2048, Mpost, 0, nullptr, nullptr, nullptr, nullptr);
      run_gemm<G_MG2>(tidv, bidv, p, l, smem, Z, NIN, wb + OW_BR + (size_t)2 * 2048 * 1024, 1024, 2048, Mpost, 0, nullptr, nullptr, nullptr, nullptr);
      break;
    case 8:
      run_gemm<G_OUT>(tidv, bidv, p, l, smem, HB, 2048, wb + OW_OUT, 2048, 2048, Mpost, 0, xin_lat, xin_ctx, p.out, XC);
      break;
    case 9:
      phase_norm(tidv, bidv, p.out, XC, p.in[7] + l * 2048, mod, 6144, 8192, H2, Mpost);
      break;
    case 10:
      run_gemm<G_M1>(tidv, bidv, p, l, smem, H2, 2048, wb + OW_M1, 2048, 8192, Mpost, 0, nullptr, nullptr, nullptr, nullptr);
      break;
    case 11:
      run_gemm<G_M2>(tidv, bidv, p, l, smem, Z, 8192, wb + OW_M2, 8192, 2048, Mpost, 0, nullptr, nullptr, p.out, XC);
      break;
  }
}

__global__ void __launch_bounds__(256, 2) fwd_megakernel(Params p, int ph0, int ph1, int dryflag) {
  __shared__ __attribute__((aligned(16))) char smem[2 * GSTAGE + 1024];
  for (int ph = ph0; ph < ph1; ph++) {
    int tidv = threadIdx.x, bidv = blockIdx.x;
    asm volatile("" : "+v"(tidv));
    asm volatile("" : "+s"(bidv));
#ifdef PROBE_MASK
    if (dryflag && ((ph == 0 && (PROBE_MASK & 0x1000)) || (ph > 0 && ((PROBE_MASK >> ((ph - 1) % 12)) & 1)))) {
      run_phase(tidv, bidv, p, ph, smem, dryflag);
      cg::this_grid().sync();
    }
#endif
    run_phase(tidv, bidv, p, ph, smem, 0);
    if (ph + 1 < ph1) cg::this_grid().sync();
  }
}

extern "C" void kernel_launch(void* const* d_in, const int* in_sizes, int n_in, void* d_out, int out_size, void* d_ws, size_t ws_size,
                              hipStream_t stream) {
  static int grid_blocks = 0;
  if (!grid_blocks) {
    int dev = 0, cus = 0, per_cu = 0;
    hipGetDevice(&dev);
    hipDeviceGetAttribute(&cus, hipDeviceAttributeMultiprocessorCount, dev);
    hipOccupancyMaxActiveBlocksPerMultiprocessor(&per_cu, fwd_megakernel, 256, 0);
    if (per_cu < 1) per_cu = 1;
    if (per_cu > 2) per_cu = 2;
    grid_blocks = cus * per_cu;
  }
  Params p{};
  for (int i = 0; i < 42; i++) p.in[i] = (const float*)d_in[i];
  p.out = (float*)d_out;
  p.ws = (char*)d_ws;
  if (ws_size < B_END + (8u << 20)) { fprintf(stderr, "workspace too small\n"); return; }
#if MULTI_LAUNCH
  for (int ph = 0; ph < NPH; ph++) {
    hipLaunchKernelGGL(fwd_megakernel, dim3(grid_blocks), dim3(256), 0, stream, p, ph, ph + 1, 0);
  }
#else
  int ph0 = 0, ph1 = NPH;
  int dryflag = 1;
  void* args[] = {&p, &ph0, &ph1, &dryflag};
  hipError_t e = hipLaunchCooperativeKernel((void*)fwd_megakernel, dim3(grid_blocks), dim3(256), args, 0, stream);
  if (e != hipSuccess) fprintf(stderr, "cooperative launch failed: %s (grid %d)\n", hipGetErrorString(e), grid_blocks);
#endif
}
```

```cpp
#include <hip/hip_runtime.h>
#include <hip/hip_cooperative_groups.h>
#include <stdint.h>
#include <cstdio>
namespace cg = cooperative_groups;

#ifndef MULTI_LAUNCH
#define MULTI_LAUNCH 0
#endif

typedef unsigned short bf16;
using bf16x8 = __attribute__((ext_vector_type(8))) short;
using f32x4 = __attribute__((ext_vector_type(4))) float;
using f32x16 = __attribute__((ext_vector_type(16))) float;

#define DEV __device__ __forceinline__
constexpr int NT = 512, NW = 8;

constexpr int DM = 2048, ML = 16384, MC = 1024, MT = 17408, NIN = 11744, DFF = 8192, NKEY = 4352;
constexpr int C_CQ = 0, C_CKV = 512, C_KR = 1024, C_R = 1088, C_WD = 4160, C_AD = 4288, C_GD = 4416, C_U = 4576, C_GATE = 5600;

constexpr size_t OW_IN = 0;
constexpr size_t OW_UQ = OW_IN + (size_t)NIN * 2048;
constexpr size_t OW_UKV = OW_UQ + 1536 * 512;
constexpr size_t OW_W2 = OW_UKV + 2048 * 512;
constexpr size_t OW_A2 = OW_W2 + 2 * 1024 * 64;
constexpr size_t OW_G2 = OW_A2 + 2 * 1024 * 64;
constexpr size_t OW_GLU = OW_G2 + 1024 * 192;
constexpr size_t OW_BR = OW_GLU + 1024 * 1024;
constexpr size_t OW_OUT = OW_BR + (size_t)3 * 2048 * 1024;
constexpr size_t OW_M1 = OW_OUT + (size_t)2048 * 2048;
constexpr size_t OW_M2 = OW_M1 + (size_t)8192 * 2048;
constexpr size_t OW_END = OW_M2 + (size_t)8192 * 2048;

constexpr size_t SZ1K = (size_t)MT * 1024 * 2;
constexpr size_t B_WB = 0;
constexpr size_t B_HB = B_WB + OW_END * 2;
constexpr size_t B_ZB = B_HB + (size_t)MT * 2048 * 2;
constexpr size_t B_QB = B_ZB + (size_t)MT * NIN * 2;
constexpr size_t B_KN = B_QB + (size_t)MT * 1536 * 2;
constexpr size_t B_VT = B_KN + SZ1K;
constexpr size_t B_KR = B_VT + SZ1K;
constexpr size_t B_AF = B_KR + (size_t)MT * 64 * 2;
constexpr size_t B_AB = B_AF + SZ1K;
constexpr size_t B_GB = B_AB + SZ1K;
constexpr size_t B_SY = B_GB + SZ1K;
constexpr size_t B_XC = B_SY + SZ1K;
constexpr size_t B_MOD = B_XC + (size_t)MC * 2048 * 4;
constexpr size_t B_CNT = B_MOD + (size_t)2 * 5 * 12288 * 4;
constexpr size_t B_FLG = B_CNT + 256;
constexpr size_t B_END = B_FLG + 4096;

struct Params {
  const float* in[42];
  float* out;
  char* ws;
};

typedef __attribute__((ext_vector_type(2))) __bf16 hbf2;
DEV bf16 f2bf(float f) {
  __bf16 h = (__bf16)f;
  return *(unsigned short*)&h;
}
DEV float bf2f(bf16 h) { return __uint_as_float(((uint32_t)h) << 16); }
DEV uint32_t pack2(float a, float b) {
  hbf2 v;
  v[0] = (__bf16)a;
  v[1] = (__bf16)b;
  return *(uint32_t*)&v;
}
DEV float wsum(float v) {
#pragma unroll
  for (int o = 32; o > 0; o >>= 1) v += __shfl_xor(v, o);
  return v;
}
DEV float dpp_xor1(float v) {
  int i = __float_as_int(v);
  return __int_as_float(__builtin_amdgcn_update_dpp(i, i, 0xB1, 0xF, 0xF, false));
}
DEV float dpp_xor2(float v) {
  int i = __float_as_int(v);
  return __int_as_float(__builtin_amdgcn_update_dpp(i, i, 0x4E, 0xF, 0xF, false));
}
DEV float sigmoidf_(float x) { return __builtin_amdgcn_rcpf(1.f + __expf(-x)); }

DEV void phase_mod(int tidv, int bidv, const Params& p, char* smem) {
  float* s_in = (float*)smem;
  float* red = s_in + 5 * 2048;
  float* mod = (float*)(p.ws + B_MOD);
  for (int i = tidv; i < 5 * 2048; i += NT) {
    int r = i >> 11, k = i & 2047;
    float v = r < 4 ? p.in[1][r * 2048 + k] : p.in[3][k];
    s_in[i] = v / (1.f + expf(-v));
  }
  __syncthreads();
  int kg = tidv >> 6, c = tidv & 63;
  for (int task = bidv; task < 2 * 192; task += gridDim.x) {
    int l = task / 192, n = (task % 192) * 64 + c;
    const float* w = p.in[4] + (size_t)l * 2048 * 12288 + n;
    float a0 = 0, a1 = 0, a2 = 0, a3 = 0, a4 = 0;
    int kb = kg * 256;
#pragma unroll 8
    for (int k = 0; k < 256; k++) {
      float wv = w[(size_t)(kb + k) * 12288];
      a0 += s_in[kb + k] * wv;
      a1 += s_in[2048 + kb + k] * wv;
      a2 += s_in[4096 + kb + k] * wv;
      a3 += s_in[6144 + kb + k] * wv;
      a4 += s_in[8192 + kb + k] * wv;
    }
    red[(kg * 5 + 0) * 64 + c] = a0;
    red[(kg * 5 + 1) * 64 + c] = a1;
    red[(kg * 5 + 2) * 64 + c] = a2;
    red[(kg * 5 + 3) * 64 + c] = a3;
    red[(kg * 5 + 4) * 64 + c] = a4;
    __syncthreads();
    if (kg == 0) {
      float bias = p.in[5][l * 12288 + n];
#pragma unroll
      for (int r = 0; r < 5; r++) {
        float v = 0.f;
#pragma unroll
        for (int g = 0; g < 8; g++) v += red[(g * 5 + r) * 64 + c];
        mod[(size_t)(l * 5 + r) * 12288 + n] = v + bias;
      }
    }
    __syncthreads();
  }
}

DEV void convT(int tidv, int bidv, const float* __restrict__ src, bf16* __restrict__ dst, int K, int N, const float* __restrict__ gain, char* smem, int dK = 0) {
  if (dK == 0) dK = K;
  float* t = (float*)smem;
  int tk = (K + 63) >> 6, tn = (N + 63) >> 6;
  for (int tile = bidv; tile < tk * tn; tile += gridDim.x) {
    int k0 = (tile / tn) * 64, n0 = (tile % tn) * 64;
    __syncthreads();
#pragma unroll 4
    for (int i = 0; i < 8; i++) {
      int kk = i * 8 + (tidv >> 6), nn = tidv & 63;
      float v = 0.f;
      if (k0 + kk < K && n0 + nn < N) {
        v = src[(size_t)(k0 + kk) * N + n0 + nn];
        if (gain) v *= gain[k0 + kk];
      }
      t[kk * 65 + nn] = v;
    }
    __syncthreads();
    {
      int c = tidv;
      int nn = c >> 3, kc = c & 7;
      if (n0 + nn < N && k0 + kc * 8 < dK) {
        uint4 o;
        o.x = pack2(t[(kc * 8 + 0) * 65 + nn], t[(kc * 8 + 1) * 65 + nn]);
        o.y = pack2(t[(kc * 8 + 2) * 65 + nn], t[(kc * 8 + 3) * 65 + nn]);
        o.z = pack2(t[(kc * 8 + 4) * 65 + nn], t[(kc * 8 + 5) * 65 + nn]);
        o.w = pack2(t[(kc * 8 + 6) * 65 + nn], t[(kc * 8 + 7) * 65 + nn]);
        *(uint4*)(dst + (size_t)(n0 + nn) * dK + k0 + kc * 8) = o;
      }
    }
  }
}

DEV void phase_convw(int tidv, int bidv, const Params& p, int l, char* smem) {
  bf16* wb = (bf16*)(p.ws + B_WB);
  convT(tidv, bidv, p.in[8] + (size_t)l * 2048 * NIN, wb + OW_IN, 2048, NIN, nullptr, smem);
  convT(tidv, bidv, p.in[40] + (size_t)l * 2048 * 8192, wb + OW_M1, 2048, 8192, nullptr, smem);
  convT(tidv, bidv, p.in[41] + (size_t)l * 8192 * 2048, wb + OW_M2, 8192, 2048, nullptr, smem);
  for (int n = 0; n < 3; n++)
    convT(tidv, bidv, p.in[38] + (size_t)(l * 3 + n) * 1024 * 2048, wb + OW_BR + (size_t)n * 2048 * 1024, 1024, 2048, nullptr, smem);
  convT(tidv, bidv, p.in[39] + (size_t)l * 2048 * 2048, wb + OW_OUT, 2048, 2048, nullptr, smem);
  convT(tidv, bidv, p.in[11] + (size_t)l * 512 * 1536, wb + OW_UQ, 512, 1536, p.in[9] + l * 512, smem);
  convT(tidv, bidv, p.in[12] + (size_t)l * 512 * 2048, wb + OW_UKV, 512, 2048, p.in[10] + l * 512, smem);
  convT(tidv, bidv, p.in[36] + (size_t)l * 1024 * 1024, wb + OW_GLU, 1024, 1024, nullptr, smem);
  for (int d = 0; d < 2; d++) {
    convT(tidv, bidv, p.in[19] + (size_t)(l * 2 + d) * 64 * 1024, wb + OW_W2 + (size_t)d * 65536, 64, 1024, nullptr, smem);
    convT(tidv, bidv, p.in[21] + (size_t)(l * 2 + d) * 64 * 1024, wb + OW_A2 + (size_t)d * 65536, 64, 1024, nullptr, smem);
  }
  convT(tidv, bidv, p.in[22] + (size_t)l * 160 * 1024, wb + OW_G2, 160, 1024, nullptr, smem, 192);
}

DEV void phase_norm(int tidv, int bidv, const float* xlat, const float* xctx, const float* g, const float* mod, int shOff, int scOff, bf16* H, int nrows) {
  int wave = tidv >> 6, lane = tidv & 63;
  for (int row = bidv * NW + wave; row < nrows; row += gridDim.x * NW) {
    const float* x = row < ML ? xlat + (size_t)row * 2048 : xctx + (size_t)(row - ML) * 2048;
    int b = row < ML ? (row >> 12) : 4;
    const float* sh = mod + b * 12288 + shOff;
    const float* sc = mod + b * 12288 + scOff;
    float4 v[8];
    float ss = 0.f;
#pragma unroll
    for (int i = 0; i < 8; i++) {
      v[i] = *(const float4*)(x + i * 256 + lane * 4);
      ss += v[i].x * v[i].x + v[i].y * v[i].y + v[i].z * v[i].z + v[i].w * v[i].w;
    }
    ss = wsum(ss);
    float rinv = rsqrtf(ss * (1.f / 2048.f) + 1e-6f);
#pragma unroll
    for (int i = 0; i < 8; i++) {
      int c = i * 256 + lane * 4;
      float4 g4 = *(const float4*)(g + c), s4 = *(const float4*)(sc + c), h4 = *(const float4*)(sh + c);
      float y0 = v[i].x * rinv * g4.x * (1.f + s4.x) + h4.x;
      float y1 = v[i].y * rinv * g4.y * (1.f + s4.y) + h4.y;
      float y2 = v[i].z * rinv * g4.z * (1.f + s4.z) + h4.z;
      float y3 = v[i].w * rinv * g4.w * (1.f + s4.w) + h4.w;
      uint2 o;
      o.x = pack2(y0, y1);
      o.y = pack2(y2, y3);
      *(uint2*)(H + (size_t)row * 2048 + c) = o;
    }
  }
}

constexpr int LDT = 72;
constexpr int GA_BYTES = 256 * LDT * 2;
constexpr int GSTAGE = 512 * LDT * 2;
constexpr int SM_RINV = 2 * GSTAGE;
constexpr int SM_ITEM = SM_RINV + 1024;
constexpr int LDS_BYTES = SM_ITEM + 16;
DEV float sumsq8(uint4 r) {
  float s = 0.f, x;
  x = bf2f((bf16)(r.x & 0xffff)); s += x * x; x = bf2f((bf16)(r.x >> 16)); s += x * x;
  x = bf2f((bf16)(r.y & 0xffff)); s += x * x; x = bf2f((bf16)(r.y >> 16)); s += x * x;
  x = bf2f((bf16)(r.z & 0xffff)); s += x * x; x = bf2f((bf16)(r.z >> 16)); s += x * x;
  x = bf2f((bf16)(r.w & 0xffff)); s += x * x; x = bf2f((bf16)(r.w >> 16)); s += x * x;
  return s;
}

template <bool ROWNORM>
DEV void gemm_mainloop(int tidv, int bidv, const bf16* __restrict__ A, int lda, bool amap, const bf16* __restrict__ Bt, int K, int N, int m0, int n0,
                       char* smem, f32x4 (&acc)[8][4]) {
  float* srinv = (float*)(smem + SM_RINV);
  const int tid = tidv, lane = tid & 63, wave = tid >> 6;
  const int wm = wave >> 2, wn = wave & 3;
  const int lr = tid >> 3, kc = tid & 7;
  const char* abase = (const char*)(A + (size_t)m0 * lda);
  const char* bbase = (const char*)(Bt + (size_t)n0 * K);
  const uint32_t voa = (uint32_t)(lr * lda + kc * 8) * 2u;
  const uint32_t astep = (uint32_t)(64 * lda) * 2u;
  int nr0 = n0 + lr; if (nr0 > N - 1) nr0 = N - 1;
  int nr1 = n0 + lr + 64; if (nr1 > N - 1) nr1 = N - 1;
  int nr2 = n0 + lr + 128; if (nr2 > N - 1) nr2 = N - 1;
  int nr3 = n0 + lr + 192; if (nr3 > N - 1) nr3 = N - 1;
  const uint32_t vob0 = (uint32_t)((nr0 - n0) * K + kc * 8) * 2u;
  const uint32_t vob1 = (uint32_t)((nr1 - n0) * K + kc * 8) * 2u;
  const uint32_t vob2 = (uint32_t)((nr2 - n0) * K + kc * 8) * 2u;
  const uint32_t vob3 = (uint32_t)((nr3 - n0) * K + kc * 8) * 2u;
  const uint32_t lds_st = (uint32_t)(lr * LDT + kc * 8) * 2u;
  const int nk = K >> 6;
  uint4 xa0, xa1, xa2, xa3, xb0, xb1, xb2, xb3;
  float ss0 = 0.f, ss1 = 0.f, ss2 = 0.f, ss3 = 0.f;
#define G_LOAD(KT)                                                         \
  {                                                                        \
    const int k0_ = (KT) << 6;                                             \
    const int ka_ = amap ? ((k0_ >> 7) * 192 + (k0_ & 127)) : k0_;         \
    xa0 = *(const uint4*)(abase + (size_t)ka_ * 2 + voa);                  \
    xa1 = *(const uint4*)(abase + (size_t)ka_ * 2 + astep + voa);          \
    xa2 = *(const uint4*)(abase + (size_t)ka_ * 2 + 2 * astep + voa);      \
    xa3 = *(const uint4*)(abase + (size_t)ka_ * 2 + 3 * astep + voa);      \
    xb0 = *(const uint4*)(bbase + (size_t)k0_ * 2 + vob0);                 \
    xb1 = *(const uint4*)(bbase + (size_t)k0_ * 2 + vob1);                 \
    xb2 = *(const uint4*)(bbase + (size_t)k0_ * 2 + vob2);                 \
    xb3 = *(const uint4*)(bbase + (size_t)k0_ * 2 + vob3);                 \
  }
#define G_STORE(SN)                                                  \
  *(uint4*)((SN) + lds_st) = xa0;                                    \
  *(uint4*)((SN) + 1 * (64 * LDT * 2) + lds_st) = xa1;               \
  *(uint4*)((SN) + 2 * (64 * LDT * 2) + lds_st) = xa2;               \
  *(uint4*)((SN) + 3 * (64 * LDT * 2) + lds_st) = xa3;               \
  *(uint4*)((SN) + GA_BYTES + lds_st) = xb0;                         \
  *(uint4*)((SN) + GA_BYTES + 1 * (64 * LDT * 2) + lds_st) = xb1;    \
  *(uint4*)((SN) + GA_BYTES + 2 * (64 * LDT * 2) + lds_st) = xb2;    \
  *(uint4*)((SN) + GA_BYTES + 3 * (64 * LDT * 2) + lds_st) = xb3;    \
  if (ROWNORM) { ss0 += sumsq8(xa0); ss1 += sumsq8(xa1); ss2 += sumsq8(xa2); ss3 += sumsq8(xa3); }
  const uint32_t fa = (uint32_t)((wm * 128 + (lane & 15)) * LDT + (lane >> 4) * 8) * 2u;
  const uint32_t fb = (uint32_t)GA_BYTES + (uint32_t)((wn * 64 + (lane & 15)) * LDT + (lane >> 4) * 8) * 2u;
  const int nkm = nk - 1;
  G_LOAD(0)
  __syncthreads();
  G_STORE(smem)
  G_LOAD((1 < nkm ? 1 : nkm))
  __syncthreads();
  for (int kt = 0; kt < nk; kt++) {
    const char* st = smem + (kt & 1) * GSTAGE;
#pragma unroll
    for (int ks = 0; ks < 2; ks++) {
      bf16x8 af[8], bfr[4];
#pragma unroll
      for (int i = 0; i < 8; i++) af[i] = *(const bf16x8*)(st + fa + i * (16 * LDT * 2) + ks * 64);
#pragma unroll
      for (int j = 0; j < 4; j++) bfr[j] = *(const bf16x8*)(st + fb + j * (16 * LDT * 2) + ks * 64);
#pragma unroll
      for (int i = 0; i < 8; i++)
#pragma unroll
        for (int j = 0; j < 4; j++) acc[i][j] = __builtin_amdgcn_mfma_f32_16x16x32_bf16(bfr[j], af[i], acc[i][j], 0, 0, 0);
      __builtin_amdgcn_sched_barrier(0);
    }
    if (kt + 1 < nk) {
      char* sn = smem + ((kt + 1) & 1) * GSTAGE;
      G_STORE(sn)
    }
    G_LOAD((kt + 2 < nkm ? kt + 2 : nkm))
    __syncthreads();
  }
  if (ROWNORM) {
    float v;
    v = ss0; v += __shfl_xor(v, 1); v += __shfl_xor(v, 2); v += __shfl_xor(v, 4); if (kc == 0) srinv[lr] = rsqrtf(v / (float)K + 1e-6f);
    v = ss1; v += __shfl_xor(v, 1); v += __shfl_xor(v, 2); v += __shfl_xor(v, 4); if (kc == 0) srinv[lr + 64] = rsqrtf(v / (float)K + 1e-6f);
    v = ss2; v += __shfl_xor(v, 1); v += __shfl_xor(v, 2); v += __shfl_xor(v, 4); if (kc == 0) srinv[lr + 128] = rsqrtf(v / (float)K + 1e-6f);
    v = ss3; v += __shfl_xor(v, 1); v += __shfl_xor(v, 2); v += __shfl_xor(v, 4); if (kc == 0) srinv[lr + 192] = rsqrtf(v / (float)K + 1e-6f);
    __syncthreads();
  }
#undef G_LOAD
#undef G_STORE
}

DEV void zero_acc(f32x4 (&acc)[8][4]) {
#pragma unroll
  for (int i = 0; i < 8; i++)
#pragma unroll
    for (int j = 0; j < 4; j++) acc[i][j] = f32x4{0.f, 0.f, 0.f, 0.f};
}

template <class F>
DEV void epi_loop(int tidv, int bidv, f32x4 (&acc)[8][4], int m0, int n0, int N, F f) {
  const int lane = tidv & 63, wave = tidv >> 6;
  const int wm = wave >> 2, wn = wave & 3;
#pragma unroll
  for (int i = 0; i < 8; i++) {
    const int lrow = wm * 128 + i * 16 + (lane & 15);
#pragma unroll
    for (int j = 0; j < 4; j++) {
      int col = n0 + wn * 64 + j * 16 + (lane >> 4) * 4;
      if (col < N) f(m0 + lrow, lrow, col, acc[i][j]);
    }
    __builtin_amdgcn_sched_barrier(0);
  }
}

DEV uint2 pack4(f32x4 v) {
  uint2 o;
  o.x = pack2(v[0], v[1]);
  o.y = pack2(v[2], v[3]);
  return o;
}
DEV f32x4 unpack4(uint2 u) {
  f32x4 v;
  v[0] = bf2f((bf16)(u.x & 0xffff)); v[1] = bf2f((bf16)(u.x >> 16));
  v[2] = bf2f((bf16)(u.y & 0xffff)); v[3] = bf2f((bf16)(u.y >> 16));
  return v;
}

enum { G_IN = 0, G_UQ, G_UKV, G_W2, G_A2, G_G2, G_GLU, G_OUT, G_M1, G_M2, G_MG0, G_MG1, G_MG2 };

template <int MODE>
DEV void run_gemm(int tidv, int bidv, const Params& p, int l, char* smem, const bf16* A, int lda, const bf16* Bt, int K, int N, int M, int aux,
                  const float* xin_lat, const float* xin_ctx, float* xout_lat, float* xout_ctx) {
  const int nt = (N + 255) >> 8, mt = M >> 8;
  char* ws = p.ws;
  bf16* Z = (bf16*)(ws + B_ZB);
  const float* srinv = (const float*)(smem + SM_RINV);
  const float* mod = (const float*)(ws + B_MOD) + (size_t)l * 5 * 12288;
  for (int tile = bidv; tile < nt * mt; tile += gridDim.x) {
    int m0 = (tile / nt) << 8, n0 = (tile % nt) << 8;
    f32x4 acc[8][4];
    zero_acc(acc);
    gemm_mainloop<(MODE == G_UQ || MODE == G_UKV)>(tidv, bidv, A, lda, MODE == G_MG0, Bt, K, N, m0, n0, smem, acc);
    epi_loop(tidv, bidv, acc, m0, n0, N, [&](int row, int lrow, int col, f32x4 v) {
      if constexpr (MODE == G_IN) {
        f32x4 o = v;
        if (col >= C_GATE || (col >= C_GD && col < C_U)) {
#pragma unroll
          for (int r = 0; r < 4; r++) o[r] = sigmoidf_(v[r]);
        } else if (col >= C_WD && col < C_AD) {
#pragma unroll
          for (int r = 0; r < 4; r++) o[r] = tanhf(v[r]);
        }
        *(uint2*)(Z + (size_t)row * NIN + col) = pack4(o);
      } else if constexpr (MODE == G_UQ) {
        float ri = srinv[lrow];
        *(uint2*)((bf16*)(ws + B_QB) + (size_t)row * 1536 + col) = pack4(v * ri);
      } else if constexpr (MODE == G_UKV) {
        float ri = srinv[lrow];
        f32x4 o = v * ri;
        int h = col >> 8, c = col & 255;
        if (c < 128) {
          *(uint2*)((bf16*)(ws + B_KN) + (size_t)row * 1024 + h * 128 + c) = pack4(o);
        } else {
          int b, kp;
          if (row < ML) { b = row >> 12; kp = row & 4095; } else { int r2 = row - ML; b = r2 >> 8; kp = 4096 + (r2 & 255); }
          bf16* vt = (bf16*)(ws + B_VT) + ((size_t)((b * 8 + h) * 128 + (c - 128))) * NKEY + kp;
#pragma unroll
          for (int r = 0; r < 4; r++) vt[(size_t)r * NKEY] = f2bf(o[r]);
        }
      } else if constexpr (MODE == G_W2) {
        float4 w0 = *(const float4*)(p.in[18] + (l * 2 + aux) * 1024 + col);
        f32x4 o;
        o[0] = 0.60653066f * sigmoidf_(w0.x + v[0]);
        o[1] = 0.60653066f * sigmoidf_(w0.y + v[1]);
        o[2] = 0.60653066f * sigmoidf_(w0.z + v[2]);
        o[3] = 0.60653066f * sigmoidf_(w0.w + v[3]);
        *(uint2*)((bf16*)(ws + B_HB + (size_t)aux * SZ1K) + (size_t)row * 1024 + col) = pack4(o);
      } else if constexpr (MODE == G_A2) {
        float4 a0 = *(const float4*)(p.in[20] + (l * 2 + aux) * 1024 + col);
        f32x4 o;
        o[0] = sigmoidf_(a0.x + v[0]);
        o[1] = sigmoidf_(a0.y + v[1]);
        o[2] = sigmoidf_(a0.z + v[2]);
        o[3] = sigmoidf_(a0.w + v[3]);
        *(uint2*)((bf16*)(ws + (aux ? B_AB : B_AF)) + (size_t)row * 1024 + col) = pack4(o);
      } else if constexpr (MODE == G_G2) {
        *(uint2*)((bf16*)(ws + B_GB) + (size_t)row * 1024 + col) = pack4(v);
      } else if constexpr (MODE == G_GLU) {
        f32x4 zz = unpack4(*(const uint2*)((const bf16*)(ws + B_SY) + (size_t)row * 1024 + col));
        float4 gb = *(const float4*)(p.in[37] + l * 1024 + col);
        f32x4 o;
        o[0] = zz[0] * sigmoidf_(v[0] + gb.x);
        o[1] = zz[1] * sigmoidf_(v[1] + gb.y);
        o[2] = zz[2] * sigmoidf_(v[2] + gb.z);
        o[3] = zz[3] * sigmoidf_(v[3] + gb.w);
        *(uint2*)(Z + (size_t)row * NIN + col) = pack4(o);
      } else if constexpr (MODE == G_OUT) {
        int b = row < ML ? (row >> 12) : 4;
        float4 g = *(const float4*)(mod + b * 12288 + 4096 + col);
        const float* xi = row < ML ? xin_lat + (size_t)row * 2048 : xin_ctx + (size_t)(row - ML) * 2048;
        float* xo = row < ML ? xout_lat + (size_t)row * 2048 : xout_ctx + (size_t)(row - ML) * 2048;
        float4 x = *(const float4*)(xi + col);
        x.x += g.x * v[0]; x.y += g.y * v[1]; x.z += g.z * v[2]; x.w += g.w * v[3];
        *(float4*)(xo + col) = x;
      } else if constexpr (MODE == G_M1) {
        f32x4 o;
#pragma unroll
        for (int r = 0; r < 4; r++) { float t = fmaxf(v[r], 0.f); o[r] = t * t; }
        *(uint2*)(Z + (size_t)row * DFF + col) = pack4(o);
      } else if constexpr (MODE == G_MG0 || MODE == G_MG1 || MODE == G_MG2) {
        constexpr int nb = MODE - G_MG0;
        bf16* MG = (bf16*)(ws + B_HB);
        f32x4 g = unpack4(*(const uint2*)(Z + (size_t)row * NIN + C_GATE + nb * 2048 + col));
        f32x4 o = g * v;
        if constexpr (nb > 0) o += unpack4(*(const uint2*)(MG + (size_t)row * 2048 + col));
        *(uint2*)(MG + (size_t)row * 2048 + col) = pack4(o);
      } else if constexpr (MODE == G_M2) {
        int b = row < ML ? (row >> 12) : 4;
        float4 g = *(const float4*)(mod + b * 12288 + 10240 + col);
        float* xo = row < ML ? xout_lat + (size_t)row * 2048 : xout_ctx + (size_t)(row - ML) * 2048;
        float4 x = *(const float4*)(xo + col);
        x.x += g.x * v[0]; x.y += g.y * v[1]; x.z += g.z * v[2]; x.w += g.w * v[3];
        *(float4*)(xo + col) = x;
      }
    });
  }
}

DEV void phase_mla_post(int tidv, int bidv, const Params& p, int l) {
  char* ws = p.ws;
  const float* qng = p.in[13] + l * 128;
  const float* qrg = p.in[14] + l * 64;
  const float* kng = p.in[15] + l * 128;
  const float* krg = p.in[16] + l * 64;
  bf16* QB = (bf16*)(ws + B_QB);
  bf16* KN = (bf16*)(ws + B_KN);
  bf16* KR = (bf16*)(ws + B_KR);
  const bf16* Z = (const bf16*)(ws + B_ZB);
  const int wave = tidv >> 6, lane = tidv & 63;
  const float QS = 1.4426950408889634f * 0.07216878364870322f;
  const int idx = lane & 31;
  const float inv = powf(10000.f, -(float)(idx & 15) / 16.f);
  const float gq0 = qng[2 * lane], gq1 = qng[2 * lane + 1], gk0 = kng[2 * lane], gk1 = kng[2 * lane + 1];
  const float gqr = qrg[lane], gkr = krg[lane];
  for (int row = bidv * NW + wave; row < MT; row += gridDim.x * NW) {
    bool lat = row < ML;
    int t = row & 4095;
    float pos = (idx < 16) ? (float)(t >> 6) : (float)(t & 63);
    float ang = pos * inv;
    float cs = 1.f, sn = 0.f;
    if (lat) { cs = cosf(ang); sn = sinf(ang); }
#pragma unroll 1
    for (int h = 0; h < 8; h++) {
      bf16* q = QB + (size_t)row * 1536 + h * 192;
      uint32_t u = *(const uint32_t*)(q + 2 * lane);
      float x0 = bf2f((bf16)(u & 0xffff)), x1 = bf2f((bf16)(u >> 16));
      float ss = wsum(x0 * x0 + x1 * x1);
      float rinv = rsqrtf(ss * (1.f / 128.f) + 1e-6f) * QS;
      *(uint32_t*)(q + 2 * lane) = pack2(x0 * rinv * gq0, x1 * rinv * gq1);
      float xr = bf2f(q[128 + lane]);
      float ss2 = wsum(xr * xr);
      float y = xr * rsqrtf(ss2 * (1.f / 64.f) + 1e-6f) * gqr;
      float yp = __shfl_xor(y, 32);
      float o = lane < 32 ? (y * cs - yp * sn) : (yp * sn + y * cs);
      q[128 + lane] = f2bf(o * QS);
      bf16* k = KN + (size_t)row * 1024 + h * 128;
      uint32_t uk = *(const uint32_t*)(k + 2 * lane);
      float k0 = bf2f((bf16)(uk & 0xffff)), k1 = bf2f((bf16)(uk >> 16));
      float ssk = wsum(k0 * k0 + k1 * k1);
      float rk = rsqrtf(ssk * (1.f / 128.f) + 1e-6f);
      *(uint32_t*)(k + 2 * lane) = pack2(k0 * rk * gk0, k1 * rk * gk1);
    }
    {
      float xr = bf2f(Z[(size_t)row * NIN + C_KR + lane]);
      float ss2 = wsum(xr * xr);
      float y = xr * rsqrtf(ss2 * (1.f / 64.f) + 1e-6f) * gkr;
      float yp = __shfl_xor(y, 32);
      float o = lane < 32 ? (y * cs - yp * sn) : (yp * sn + y * cs);
      KR[(size_t)row * 64 + lane] = f2bf(o);
    }
  }
}

DEV void step_row(int s, int d, int b, int& row, int& tau, int& len) {
  if (s < 256) { tau = d ? 255 - s : s; len = 256; row = ML + b * 256 + tau; }
  else { int q = s - 256; tau = d ? 4095 - q : q; len = 4096; row = b * 4096 + tau; }
}

struct RwPre { bf16 r0, r1, r2, k0, k1, k2, v0, v1, v2, a, e; };

DEV void rwkv_fetch(RwPre& q, const bf16* Z, const bf16* AD, const bf16* ED, int s, int d, int b, int ch) {
  int row, tau, len;
  step_row(s, d, b, row, tau, len);
  const bf16* z = Z + (size_t)row * NIN + C_R + ch;
  q.r1 = z[0]; q.k1 = z[1024]; q.v1 = z[2048];
  q.r0 = 0; q.k0 = 0; q.v0 = 0; q.r2 = 0; q.k2 = 0; q.v2 = 0;
  if (tau > 0) { const bf16* zm = z - NIN; q.r0 = zm[0]; q.k0 = zm[1024]; q.v0 = zm[2048]; }
  if (tau < len - 1) { const bf16* zp = z + NIN; q.r2 = zp[0]; q.k2 = zp[1024]; q.v2 = zp[2048]; }
  q.a = AD[(size_t)row * 1024 + ch];
  q.e = ED[(size_t)row * 1024 + ch];
}

typedef float f2v __attribute__((ext_vector_type(2)));
DEV float dpp_hmirror(float v) {
  int i = __float_as_int(v);
  return __int_as_float(__builtin_amdgcn_update_dpp(i, i, 0x141, 0xF, 0xF, false));
}
DEV f2v lo2(float4 v) { return f2v{v.x, v.y}; }
DEV f2v hi2(float4 v) { return f2v{v.z, v.w}; }

DEV void rwkv_scan(int tidv, int bidv, const Params& p, int l, int chain, char* smem, int dry) {
  char* ws = p.ws;
  float* op = (float*)smem;
  float* vb = op + 16 * 320;
  float* yb = vb + 16 * 64;
  const int tid = tidv, wave = tid >> 6, lane = tid & 63;
  const int d = chain & 1, h = (chain >> 1) & 15, b = chain >> 5;
  const int ch = h * 64 + lane;
  const float* cw = p.in[17] + (size_t)l * 3 * 3072;
  const float cr0 = cw[ch], cr1 = cw[3072 + ch], cr2 = cw[6144 + ch];
  const float ck0 = cw[1024 + ch], ck1 = cw[3072 + 1024 + ch], ck2 = cw[6144 + 1024 + ch];
  const float cv0 = cw[2048 + ch], cv1 = cw[3072 + 2048 + ch], cv2 = cw[6144 + 2048 + ch];
  const float kkc = p.in[23][l * 1024 + ch], kac = p.in[24][l * 1024 + ch];
  const bf16* Z = (const bf16*)(ws + B_ZB);
  bf16* ED = (bf16*)(ws + B_HB + (size_t)d * SZ1K);
  const bf16* AD = (const bf16*)(ws + (d ? B_AB : B_AF));
  f2v S0 = {0.f, 0.f}, S1 = {0.f, 0.f}, S2 = {0.f, 0.f}, S3 = {0.f, 0.f};
  const int ri = lane >> 3, jo = lane & 7, irow = wave * 8 + ri;
  RwPre pre[2];
#pragma unroll
  for (int si = 0; si < 2; si++) rwkv_fetch(pre[si], Z, AD, ED, wave * 2 + si, d, b, ch);
  for (int chunk = 0; chunk < 272; chunk++) {
#pragma unroll
    for (int si = 0; si < 2; si++) {
      int t = wave * 2 + si;
      const RwPre& q = pre[si];
      float rr = cr0 * bf2f(q.r0) + cr1 * bf2f(q.r1) + cr2 * bf2f(q.r2);
      float kk_ = ck0 * bf2f(q.k0) + ck1 * bf2f(q.k1) + ck2 * bf2f(q.k2);
      float vv = cv0 * bf2f(q.v0) + cv1 * bf2f(q.v1) + cv2 * bf2f(q.v2);
      float kkv = kk_ * kkc;
      float ssq = wsum(kkv * kkv);
      float kn = kkv * rsqrtf(ssq + 1e-12f);
      float a = bf2f(q.a);
      float w = __expf(-bf2f(q.e));
      float krep = kk_ * (1.f + (a - 1.f) * kac);
      float* o = op + t * 320;
      o[lane] = w;
      o[64 + lane] = kn * a;
      o[128 + lane] = krep;
      o[192 + lane] = -kn;
      o[256 + lane] = rr;
      vb[t * 64 + lane] = vv;
    }
    __syncthreads();
    if (chunk + 1 < 272) {
#pragma unroll
      for (int si = 0; si < 2; si++) rwkv_fetch(pre[si], Z, AD, ED, (chunk + 1) * 16 + wave * 2 + si, d, b, ch);
    }
    {
      const float4* o4 = (const float4*)(op + jo * 8);
      float4 n0 = o4[48], n1 = o4[49];
#pragma unroll 4
      for (int t = 0; t < 16; t++) {
        const float4* ot = o4 + t * 80;
        const float4 w0 = ot[0], w1 = ot[1];
        const float4 a0 = ot[16], a1 = ot[17];
        const float4 k0 = ot[32], k1 = ot[33];
        const float4 r0 = ot[64], r1 = ot[65];
        const float vi = vb[t * 64 + irow];
        const int tn = t < 15 ? t + 1 : 15;
        const float4* on = o4 + tn * 80;
        const float4 m0 = on[48], m1 = on[49];
        f2v sv = S0 * lo2(n0) + S1 * hi2(n0) + (S2 * lo2(n1) + S3 * hi2(n1));
        float sa = sv.x + sv.y;
        sa += dpp_xor1(sa);
        sa += dpp_xor2(sa);
        sa += dpp_hmirror(sa);
        const f2v sa2 = {sa, sa}, vi2 = {vi, vi};
        S0 = S0 * lo2(w0) + sa2 * lo2(a0) + vi2 * lo2(k0);
        S1 = S1 * hi2(w0) + sa2 * hi2(a0) + vi2 * hi2(k0);
        S2 = S2 * lo2(w1) + sa2 * lo2(a1) + vi2 * lo2(k1);
        S3 = S3 * hi2(w1) + sa2 * hi2(a1) + vi2 * hi2(k1);
        f2v yv = S0 * lo2(r0) + S1 * hi2(r0) + (S2 * lo2(r1) + S3 * hi2(r1));
        float y = yv.x + yv.y;
        y += dpp_xor1(y);
        y += dpp_xor2(y);
        y += dpp_hmirror(y);
        if (jo == 0) yb[t * 64 + irow] = y;
        n0 = m0; n1 = m1;
      }
    }
    __syncthreads();
#pragma unroll
    for (int it = 0; it < 2; it++) {
      int idx = it * NT + tid;
      int t = idx >> 6, i = idx & 63;
      int row, tau, len;
      step_row(chunk * 16 + t, d, b, row, tau, len);
      size_t off = (size_t)row * 1024 + h * 64 + i;
      bf16* yd = dry ? (bf16*)(ws + B_END) + (off & 0x3fffff) : ED + off;
      *yd = f2bf(yb[t * 64 + i]);
    }
  }
}

DEV void s5_scan(int tidv, int bidv, const Params& p, int l, int chain, char* smemw, int dry) {
  char* ws = p.ws;
  const int lane = tidv & 63;
  const int d = chain & 1, g = (chain >> 1) & 63, b = chain >> 7;
  float* ub = (float*)smemw;
  float* hb = ub + 256;
  const size_t pg = (size_t)(l * 2 + d) * 64 + g;
  const float lre = p.in[28][pg * 64 + lane], lim = p.in[29][pg * 64 + lane];
  const float dt = expf(p.in[30][pg]);
  const float mag = expf(lre * dt);
  const float are = mag * cosf(lim * dt), aim = mag * sinf(lim * dt);
  const float den = lre * lre + lim * lim;
  const float qre = ((are - 1.f) * lre + aim * lim) / den;
  const float qim = (aim * lre - (are - 1.f) * lim) / den;
  float bbre[16], bbim[16];
  {
    const float* br = p.in[31] + (pg * 64 + lane) * 16;
    const float* bi = p.in[32] + (pg * 64 + lane) * 16;
#pragma unroll
    for (int i = 0; i < 16; i++) {
      float x = br[i], y = bi[i];
      bbre[i] = qre * x - qim * y;
      bbim[i] = qre * y + qim * x;
    }
  }
  bf16x8 cfr[4];
  {
    const int i = lane & 15, quad = lane >> 4;
    const float* cre = p.in[33] + (pg * 16 + i) * 64;
    const float* cim = p.in[34] + (pg * 16 + i) * 64;
#pragma unroll
    for (int ks = 0; ks < 4; ks++)
#pragma unroll
      for (int j = 0; j < 8; j++) {
        int k = ks * 32 + quad * 8 + j;
        float c = ks < 2 ? cre[k] : -cim[k - 64];
        cfr[ks][j] = (short)f2bf(c);
      }
  }
  float hre = 0.f, him = 0.f;
  const bf16* Z = (const bf16*)(ws + B_ZB);
  const int tt = lane >> 2, i0 = (lane & 3) * 4;
  uint2 unext;
  {
    int row, tau, len;
    step_row(tt, d, b, row, tau, len);
    unext = *(const uint2*)(Z + (size_t)row * NIN + C_U + g * 16 + i0);
  }
  for (int chunk = 0; chunk < 272; chunk++) {
    {
      uint2 u = unext;
      float4 f;
      f.x = bf2f((bf16)(u.x & 0xffff)); f.y = bf2f((bf16)(u.x >> 16));
      f.z = bf2f((bf16)(u.y & 0xffff)); f.w = bf2f((bf16)(u.y >> 16));
      *(float4*)(ub + tt * 16 + i0) = f;
    }
    __syncthreads();
    if (chunk + 1 < 272) {
      int row, tau, len;
      step_row((chunk + 1) * 16 + tt, d, b, row, tau, len);
      unext = *(const uint2*)(Z + (size_t)row * NIN + C_U + g * 16 + i0);
    }
#pragma unroll 2
    for (int t = 0; t < 16; t++) {
      const float* u = ub + t * 16;
      float br0 = 0.f, bi0 = 0.f;
#pragma unroll
      for (int i = 0; i < 16; i++) { float uv = u[i]; br0 += bbre[i] * uv; bi0 += bbim[i] * uv; }
      float nr = are * hre - aim * him + br0;
      float ni = are * him + aim * hre + bi0;
      hre = nr; him = ni;
      hb[t * 132 + lane] = hre;
      hb[t * 132 + 64 + lane] = him;
    }
    __syncthreads();
    {
      f32x4 yacc = {0.f, 0.f, 0.f, 0.f};
      const float* hr = hb + (lane & 15) * 132 + (lane >> 4) * 8;
#pragma unroll
      for (int ks = 0; ks < 4; ks++) {
        float4 x0 = *(const float4*)(hr + ks * 32), x1 = *(const float4*)(hr + ks * 32 + 4);
        union { bf16x8 v; uint32_t u[4]; } af;
        af.u[0] = pack2(x0.x, x0.y); af.u[1] = pack2(x0.z, x0.w);
        af.u[2] = pack2(x1.x, x1.y); af.u[3] = pack2(x1.z, x1.w);
        yacc = __builtin_amdgcn_mfma_f32_16x16x32_bf16(af.v, cfr[ks], yacc, 0, 0, 0);
      }
      const int ii = lane & 15;
#pragma unroll
      for (int r = 0; r < 4; r++) {
        int row, tau, len;
        step_row(chunk * 16 + (lane >> 4) * 4 + r, d, b, row, tau, len);
        bf16* dst = d == 0 ? (bf16*)(ws + B_SY) + (size_t)row * 1024 + g * 16 + ii : (bf16*)(ws + B_ZB) + (size_t)row * NIN + g * 16 + ii;
        if (dry) dst = (bf16*)(ws + B_END) + ((((size_t)row * 1024 + g * 16 + ii)) & 0x3fffff);
        *dst = f2bf(yacc[r]);
      }
    }
    __syncthreads();
  }
}

DEV int perm23(int r) { return (r & 0x13) | ((r & 4) << 1) | ((r & 8) >> 1); }

DEV void attn_item(int tidv, int bidv, const Params& p, int item, bool ctxq, char* smem, int dry) {
  char* ws = p.ws;
  bf16* sK = (bf16*)smem;
  bf16* sV = sK + 64 * 200;
  const int tid = tidv, wave = tid >> 6, lane = tid & 63;
  const int r = lane & 31, hf = lane >> 5;
  int b, hd, qt;
  if (!ctxq) { b = item >> 7; hd = (item >> 4) & 7; qt = item & 15; }
  else { b = item >> 3; hd = item & 7; qt = 0; }
  const int qrow0 = ctxq ? ML + b * 256 : b * 4096 + qt * 256;
  const int kt0 = ctxq ? 64 : 0, kt1 = 68;
  bf16* QB = (bf16*)(ws + B_QB);
  const bf16* KN = (const bf16*)(ws + B_KN);
  const bf16* KR = (const bf16*)(ws + B_KR);
  const bf16* VT = (const bf16*)(ws + B_VT);
  bf16x8 qf[12];
  {
    const bf16* qp = QB + (size_t)(qrow0 + wave * 32 + r) * 1536 + hd * 192 + hf * 8;
#pragma unroll
    for (int kk = 0; kk < 12; kk++) qf[kk] = *(const bf16x8*)(qp + kk * 16);
  }
  f32x16 oacc[4];
#pragma unroll
  for (int i = 0; i < 4; i++)
#pragma unroll
    for (int e = 0; e < 16; e++) oacc[i][e] = 0.f;
  float mrun = -1e30f, lrun = 0.f;
  const int pr = perm23(r);
  for (int kt = kt0; kt < kt1; kt++) {
    __syncthreads();
    const int key0 = kt * 64;
    const int rowbase = key0 < 4096 ? b * 4096 + key0 : ML + b * 256 + (key0 - 4096);
    {
      const char* bk = (const char*)(KN + (size_t)rowbase * 1024 + hd * 128);
      const char* br = (const char*)(KR + (size_t)rowbase * 64);
      const char* bv = (const char*)(VT + ((size_t)((b * 8 + hd) * 128)) * NKEY + key0);
      const uint32_t vo_n = (uint32_t)((tid >> 4) * 2048 + (tid & 15) * 16);
      const uint32_t lo_n = (uint32_t)((tid >> 4) * 400 + (tid & 15) * 16);
      const uint32_t vo_r = (uint32_t)((tid >> 3) * 128 + (tid & 7) * 16);
      const uint32_t lo_r = (uint32_t)((tid >> 3) * 400 + 256 + (tid & 7) * 16);
      const uint32_t vo_v = (uint32_t)((tid >> 3) * (NKEY * 2) + (tid & 7) * 16);
      const uint32_t lo_v = (uint32_t)((tid >> 3) * 144 + (tid & 7) * 16);
      uint4 t0 = *(const uint4*)(bk + vo_n);
      uint4 t1 = *(const uint4*)(bk + 32 * 2048 + vo_n);
      uint4 t4 = *(const uint4*)(br + vo_r);
      uint4 u0 = *(const uint4*)(bv + vo_v);
      uint4 u1 = *(const uint4*)(bv + (size_t)64 * NKEY * 2 + vo_v);
      *(uint4*)((char*)sK + lo_n) = t0;
      *(uint4*)((char*)sK + 32 * 400 + lo_n) = t1;
      *(uint4*)((char*)sK + lo_r) = t4;
      *(uint4*)((char*)sV + lo_v) = u0;
      *(uint4*)((char*)sV + 64 * 144 + lo_v) = u1;
    }
    __syncthreads();
    f32x16 sacc[2];
#pragma unroll
    for (int m = 0; m < 2; m++) {
#pragma unroll
      for (int e = 0; e < 16; e++) sacc[m][e] = 0.f;
      const bf16* kp = sK + (m * 32 + pr) * 200 + hf * 8;
#pragma unroll
      for (int kk = 0; kk < 12; kk++) {
        bf16x8 kf = *(const bf16x8*)(kp + kk * 16);
        sacc[m] = __builtin_amdgcn_mfma_f32_32x32x16_bf16(kf, qf[kk], sacc[m], 0, 0, 0);
        if ((kk & 3) == 3) __builtin_amdgcn_sched_barrier(0);
      }
      __builtin_amdgcn_sched_barrier(0);
    }
    float tmax = sacc[0][0];
#pragma unroll
    for (int e = 1; e < 16; e++) tmax = fmaxf(tmax, sacc[0][e]);
#pragma unroll
    for (int e = 0; e < 16; e++) tmax = fmaxf(tmax, sacc[1][e]);
    tmax = fmaxf(tmax, __shfl_xor(tmax, 32));
    float mnew = fmaxf(mrun, tmax);
    float alpha = __builtin_amdgcn_exp2f(mrun - mnew);
    mrun = mnew;
    float psum = 0.f;
#pragma unroll
    for (int m = 0; m < 2; m++)
#pragma unroll
      for (int e = 0; e < 16; e++) { float pv = __builtin_amdgcn_exp2f(sacc[m][e] - mnew); sacc[m][e] = pv; psum += pv; }
    lrun = lrun * alpha + psum;
#pragma unroll
    for (int i = 0; i < 4; i++)
#pragma unroll
      for (int e = 0; e < 16; e++) oacc[i][e] *= alpha;
#pragma unroll
    for (int s = 0; s < 4; s++) {
      const int m = s >> 1, s2 = s & 1;
      bf16x8 pf;
#pragma unroll
      for (int j = 0; j < 8; j++) pf[j] = (short)f2bf(sacc[m][8 * s2 + j]);
#pragma unroll
      for (int i = 0; i < 4; i++) {
        bf16x8 vf = *(const bf16x8*)(sV + (i * 32 + r) * 72 + m * 32 + s2 * 16 + hf * 8);
        oacc[i] = __builtin_amdgcn_mfma_f32_32x32x16_bf16(vf, pf, oacc[i], 0, 0, 0);
      }
      __builtin_amdgcn_sched_barrier(0);
    }
  }
  lrun += __shfl_xor(lrun, 32);
  const float inv = 1.f / lrun;
  bf16* op = QB + (size_t)(qrow0 + wave * 32 + r) * 1536 + hd * 192;
  if (dry) op = (bf16*)(ws + B_END) + ((((size_t)(qrow0 + wave * 32 + r) * 1536 + hd * 192)) & 0x3ffff8);
#pragma unroll
  for (int i = 0; i < 4; i++)
#pragma unroll
    for (int g = 0; g < 4; g++) {
      uint2 o;
      o.x = pack2(oacc[i][4 * g] * inv, oacc[i][4 * g + 1] * inv);
      o.y = pack2(oacc[i][4 * g + 2] * inv, oacc[i][4 * g + 3] * inv);
      *(uint2*)(op + 32 * i + 8 * g + 4 * hf) = o;
    }
}

DEV void phase_mixers(int tidv, int bidv, const Params& p, int l, char* smem, int dry) {
  int* s_item = (int*)(smem + SM_ITEM);
#ifdef PROBE_PARTS
  const int parts = dry ? PROBE_PARTS : 7;
#else
  const int parts = 7;
#endif
  for (int task = bidv; task < 192; task += gridDim.x) {
    if (task < 128 && !(parts & 1)) continue;
    if (task >= 128 && !(parts & 2)) continue;
    if (task < 128) rwkv_scan(tidv, bidv, p, l, task, smem, dry);
    else s5_scan(tidv, bidv, p, l, (task - 128) * 8 + (tidv >> 6), smem + (tidv >> 6) * 9472, dry);
  }
  const int nlat = 512, ntot = (parts & 4) ? ((l == 0) ? 544 : 512) : 0;
  int* cnt = (int*)(p.ws + B_CNT) + l + 2 * dry;
#if !defined(MIX_ONLY) || MIX_ONLY == 2
  while (true) {
    __syncthreads();
    if (tidv == 0) *s_item = atomicAdd(cnt, 1);
    __syncthreads();
    int item = *s_item;
    if (item >= ntot) break;
    if (item < nlat) attn_item(tidv, bidv, p, item, false, smem, dry);
    else attn_item(tidv, bidv, p, item - nlat, true, smem, dry);
  }
#endif
}

DEV float gelu_tanh(float x) {
  float u = 0.7978845608028654f * (x + 0.044715f * x * x * x);
  return 0.5f * x * (1.f + tanhf(u));
}

DEV void phase_post(int tidv, int bidv, const Params& p, int l, int M) {
  char* ws = p.ws;
  const bf16* Z = (const bf16*)(ws + B_ZB);
  const int wave = tidv >> 6, lane = tidv & 63;
  const float* cw = p.in[17] + (size_t)l * 3 * 3072;
  const bf16* YF = (const bf16*)(ws + B_HB);
  const bf16* YB = (const bf16*)(ws + B_HB + SZ1K);
  const bf16* AF = (const bf16*)(ws + B_AF);
  const bf16* AB = (const bf16*)(ws + B_AB);
  bf16* GB = (bf16*)(ws + B_GB);
  const int nitem = M * 16;
  for (int it = bidv * NW + wave; it < nitem; it += gridDim.x * NW) {
    int row = it >> 4, h = it & 15;
    int ch = h * 64 + lane;
    int tau, len;
    if (row < ML) { tau = row & 4095; len = 4096; } else { tau = (row - ML) & 255; len = 256; }
    size_t o = (size_t)row * 1024 + ch;
    float y = bf2f(YF[o]) + bf2f(YB[o]);
    float mu = wsum(y) * (1.f / 64.f);
    float dv = y - mu;
    float var = wsum(dv * dv) * (1.f / 64.f);
    float yn = dv * rsqrtf(var + 64e-5f) * p.in[26][l * 1024 + ch] + p.in[27][l * 1024 + ch];
    const bf16* z = Z + (size_t)row * NIN + C_R + ch;
    float r1 = bf2f(z[0]), k1 = bf2f(z[1024]), v1 = bf2f(z[2048]);
    float r0 = 0.f, k0 = 0.f, v0 = 0.f, r2 = 0.f, k2 = 0.f, v2 = 0.f;
    if (tau > 0) { const bf16* zm = z - NIN; r0 = bf2f(zm[0]); k0 = bf2f(zm[1024]); v0 = bf2f(zm[2048]); }
    if (tau < len - 1) { const bf16* zp = z + NIN; r2 = bf2f(zp[0]); k2 = bf2f(zp[1024]); v2 = bf2f(zp[2048]); }
    float rr = cw[ch] * r0 + cw[3072 + ch] * r1 + cw[6144 + ch] * r2;
    float kk = cw[1024 + ch] * k0 + cw[3072 + 1024 + ch] * k1 + cw[6144 + 1024 + ch] * k2;
    float vv = cw[2048 + ch] * v0 + cw[3072 + 2048 + ch] * v1 + cw[6144 + 2048 + ch] * v2;
    float am = 0.5f * (bf2f(AF[o]) + bf2f(AB[o]));
    float kbon = kk * (1.f + (am - 1.f) * p.in[24][l * 1024 + ch]);
    float s = wsum(rr * kbon * p.in[25][l * 1024 + ch]);
    float outv = (yn + s * vv) * bf2f(GB[o]);
    GB[o] = f2bf(outv);
  }
  bf16* SY = (bf16*)(ws + B_SY);
  const float* dsk = p.in[35] + l * 1024;
  const int n4 = M * 256;
  for (int i = bidv * NT + tidv; i < n4; i += gridDim.x * NT) {
    int row = i >> 8, c = (i & 255) * 4;
    uint2 a = *(const uint2*)(SY + (size_t)row * 1024 + c);
    uint2 bq = *(const uint2*)(Z + (size_t)row * NIN + c);
    uint2 u = *(const uint2*)(Z + (size_t)row * NIN + C_U + c);
    float4 dd = *(const float4*)(dsk + c);
    float y0 = bf2f((bf16)(a.x & 0xffff)) + bf2f((bf16)(bq.x & 0xffff)) + dd.x * bf2f((bf16)(u.x & 0xffff));
    float y1 = bf2f((bf16)(a.x >> 16)) + bf2f((bf16)(bq.x >> 16)) + dd.y * bf2f((bf16)(u.x >> 16));
    float y2 = bf2f((bf16)(a.y & 0xffff)) + bf2f((bf16)(bq.y & 0xffff)) + dd.z * bf2f((bf16)(u.y & 0xffff));
    float y3 = bf2f((bf16)(a.y >> 16)) + bf2f((bf16)(bq.y >> 16)) + dd.w * bf2f((bf16)(u.y >> 16));
    uint2 o;
    o.x = pack2(gelu_tanh(y0), gelu_tanh(y1));
    o.y = pack2(gelu_tanh(y2), gelu_tanh(y3));
    *(uint2*)(SY + (size_t)row * 1024 + c) = o;
  }
}

constexpr int NPH = 25;

DEV void run_phase(int tidv, int bidv, const Params& p, int ph, char* smem, int dry) {
  char* ws = p.ws;
#ifndef ONLY_S
  if (ph == 0) {
    if (bidv == 0 && tidv < 4) ((int*)(ws + B_CNT))[tidv] = 0;
    phase_mod(tidv, bidv, p, smem);
    phase_convw(tidv, bidv, p, 0, smem);
    return;
  }
#endif
  const int l = (ph - 1) / 12, s = (ph - 1) % 12;
#ifdef ONLY_S
  if (s != ONLY_S) return;
#endif
  const bf16* wb = (const bf16*)(ws + B_WB);
  const float* mod = (const float*)(ws + B_MOD) + (size_t)l * 5 * 12288;
  float* XC = (float*)(ws + B_XC);
  const float* xin_lat = l == 0 ? p.in[0] : p.out;
  const float* xin_ctx = l == 0 ? p.in[2] : XC;
  bf16* HB = (bf16*)(ws + B_HB);
  bf16* Z = (bf16*)(ws + B_ZB);
  bf16* H2 = (bf16*)(ws + B_KN);
  const int Mpost = l == 0 ? MT : ML;
  switch (s) {
    case 0:
      if (l == 1) phase_convw(tidv, bidv, p, 1, smem);
      phase_norm(tidv, bidv, xin_lat, xin_ctx, p.in[6] + l * 2048, mod, 0, 2048, HB, MT);
      break;
    case 1:
      run_gemm<G_IN>(tidv, bidv, p, l, smem, HB, 2048, wb + OW_IN, 2048, NIN, MT, 0, nullptr, nullptr, nullptr, nullptr);
      break;
    case 2:
      run_gemm<G_UKV>(tidv, bidv, p, l, smem, Z + C_CKV, NIN, wb + OW_UKV, 512, 2048, MT, 0, nullptr, nullptr, nullptr, nullptr);
      run_gemm<G_UQ>(tidv, bidv, p, l, smem, Z + C_CQ, NIN, wb + OW_UQ, 512, 1536, MT, 0, nullptr, nullptr, nullptr, nullptr);
      run_gemm<G_G2>(tidv, bidv, p, l, smem, Z + C_GD, NIN, wb + OW_G2, 192, 1024, MT, 0, nullptr, nullptr, nullptr, nullptr);
      for (int d = 0; d < 2; d++) {
        run_gemm<G_W2>(tidv, bidv, p, l, smem, Z + C_WD + 64 * d, NIN, wb + OW_W2 + (size_t)d * 65536, 64, 1024, MT, d, nullptr, nullptr, nullptr, nullptr);
        run_gemm<G_A2>(tidv, bidv, p, l, smem, Z + C_AD + 64 * d, NIN, wb + OW_A2 + (size_t)d * 65536, 64, 1024, MT, d, nullptr, nullptr, nullptr, nullptr);
      }
      break;
    case 3: phase_mla_post(tidv, bidv, p, l); break;
    case 4: phase_mixers(tidv, bidv, p, l, smem, dry); break;
    case 5: phase_post(tidv, bidv, p, l, Mpost); break;
    case 6:
      run_gemm<G_GLU>(tidv, bidv, p, l, smem, (const bf16*)(ws + B_SY), 1024, wb + OW_GLU, 1024, 1024, Mpost, 0, nullptr, nullptr, nullptr, nullptr);
      break;
    case 7:
      run_gemm<G_MG0>(tidv, bidv, p, l, smem, (const bf16*)(ws + B_QB), 1536, wb + OW_BR, 1024, 2048, Mpost, 0, nullptr, nullptr, nullptr, nullptr);
      run_gemm<G_MG1>(tidv, bidv, p, l, smem, (const bf16*)(ws + B_GB), 1024, wb + OW_BR + (size_t)2048 * 1024, 1024, 2048, Mpost, 0, nullptr, nullptr, nullptr, nullptr);
      run_gemm<G_MG2>(tidv, bidv, p, l, smem, Z, NIN, wb + OW_BR + (size_t)2 * 2048 * 1024, 1024, 2048, Mpost, 0, nullptr, nullptr, nullptr, nullptr);
      break;
    case 8:
      run_gemm<G_OUT>(tidv, bidv, p, l, smem, HB, 2048, wb + OW_OUT, 2048, 2048, Mpost, 0, xin_lat, xin_ctx, p.out, XC);
      break;
    case 9:
      phase_norm(tidv, bidv, p.out, XC, p.in[7] + l * 2048, mod, 6144, 8192, H2, Mpost);
      break;
    case 10:
      run_gemm<G_M1>(tidv, bidv, p, l, smem, H2, 2048, wb + OW_M1, 2048, 8192, Mpost, 0, nullptr, nullptr, nullptr, nullptr);
      break;
    case 11:
      run_gemm<G_M2>(tidv, bidv, p, l, smem, Z, 8192, wb + OW_M2, 8192, 2048, Mpost, 0, nullptr, nullptr, p.out, XC);
      break;
  }
}

__global__ void __launch_bounds__(NT) fwd_megakernel(Params p, int ph0, int ph1, int dryflag) {
  extern __shared__ __attribute__((aligned(16))) char smem[];
  for (int ph = ph0; ph < ph1; ph++) {
    int tidv = threadIdx.x, bidv = blockIdx.x;
    asm volatile("" : "+v"(tidv));
    asm volatile("" : "+s"(bidv));
#ifdef PROBE_MASK
    if (dryflag && ((ph == 0 && (PROBE_MASK & 0x1000)) || (ph > 0 && ((PROBE_MASK >> ((ph - 1) % 12)) & 1)))) {
      run_phase(tidv, bidv, p, ph, smem, dryflag);
      cg::this_grid().sync();
    }
#endif
    run_phase(tidv, bidv, p, ph, smem, 0);
    if (ph + 1 < ph1) cg::this_grid().sync();
  }
}

extern "C" void kernel_launch(void* const* d_in, const int* in_sizes, int n_in, void* d_out, int out_size, void* d_ws, size_t ws_size,
                              hipStream_t stream) {
  static int grid_blocks = 0;
  if (!grid_blocks) {
    int dev = 0, cus = 0, per_cu = 0;
    (void)hipGetDevice(&dev);
    (void)hipDeviceGetAttribute(&cus, hipDeviceAttributeMultiprocessorCount, dev);
    if (hipFuncSetAttribute((const void*)fwd_megakernel, hipFuncAttributeMaxDynamicSharedMemorySize, LDS_BYTES) != hipSuccess) {
      fprintf(stderr, "hipFuncSetAttribute(%d B dynamic LDS) failed\n", LDS_BYTES);
      return;
    }
    if (hipOccupancyMaxActiveBlocksPerMultiprocessor(&per_cu, (const void*)fwd_megakernel, NT, LDS_BYTES) != hipSuccess || per_cu < 1) {
      fprintf(stderr, "occupancy query failed / kernel not resident\n");
      return;
    }
    grid_blocks = cus;
  }
  Params p{};
  for (int i = 0; i < 42; i++) p.in[i] = (const float*)d_in[i];
  p.out = (float*)d_out;
  p.ws = (char*)d_ws;
  if (ws_size < B_END + (8u << 20)) { fprintf(stderr, "workspace too small\n"); return; }
  int ph0 = 0, ph1 = NPH;
  int dryflag = 1;
  void* args[] = {&p, &ph0, &ph1, &dryflag};
  hipError_t e = hipLaunchCooperativeKernel((void*)fwd_megakernel, dim3(grid_blocks), dim3(NT), args, LDS_BYTES, stream);
  if (e != hipSuccess) fprintf(stderr, "cooperative launch failed: %s (grid %d)\n", hipGetErrorString(e), grid_blocks);
}
```

```cpp
#include <hip/hip_runtime.h>
#include <hip/hip_cooperative_groups.h>
#include <stdint.h>
#include <cstdio>
namespace cg = cooperative_groups;

#ifndef MULTI_LAUNCH
#define MULTI_LAUNCH 0
#endif

typedef unsigned short bf16;
using bf16x8 = __attribute__((ext_vector_type(8))) short;
using f32x4 = __attribute__((ext_vector_type(4))) float;
using f32x16 = __attribute__((ext_vector_type(16))) float;

#define DEV __device__ __forceinline__
constexpr int NT = 512, NW = 8;

constexpr int DM = 2048, ML = 16384, MC = 1024, MT = 17408, NIN = 11744, DFF = 8192, NKEY = 4352;
constexpr int C_CQ = 0, C_CKV = 512, C_KR = 1024, C_R = 1088, C_WD = 4160, C_AD = 4288, C_GD = 4416, C_U = 4576, C_GATE = 5600;

constexpr size_t OW_IN = 0;
constexpr size_t OW_UQ = OW_IN + (size_t)NIN * 2048;
constexpr size_t OW_UKV = OW_UQ + 1536 * 512;
constexpr size_t OW_W2 = OW_UKV + 2048 * 512;
constexpr size_t OW_A2 = OW_W2 + 2 * 1024 * 64;
constexpr size_t OW_G2 = OW_A2 + 2 * 1024 * 64;
constexpr size_t OW_GLU = OW_G2 + 1024 * 192;
constexpr size_t OW_BR = OW_GLU + 1024 * 1024;
constexpr size_t OW_OUT = OW_BR + (size_t)3 * 2048 * 1024;
constexpr size_t OW_M1 = OW_OUT + (size_t)2048 * 2048;
constexpr size_t OW_M2 = OW_M1 + (size_t)8192 * 2048;
constexpr size_t OW_END = OW_M2 + (size_t)8192 * 2048;

constexpr size_t SZ1K = (size_t)MT * 1024 * 2;
constexpr size_t B_WB = 0;
constexpr size_t B_HB = B_WB + OW_END * 2;
constexpr size_t B_ZB = B_HB + (size_t)MT * 2048 * 2;
constexpr size_t B_QB = B_ZB + (size_t)MT * NIN * 2;
constexpr size_t B_KN = B_QB + (size_t)MT * 1536 * 2;
constexpr size_t B_VT = B_KN + SZ1K;
constexpr size_t B_KR = B_VT + SZ1K;
constexpr size_t B_AF = B_KR + (size_t)MT * 64 * 2;
constexpr size_t B_AB = B_AF + SZ1K;
constexpr size_t B_GB = B_AB + SZ1K;
constexpr size_t B_SY = B_GB + SZ1K;
constexpr size_t B_XC = B_SY + SZ1K;
constexpr size_t B_MOD = B_XC + (size_t)MC * 2048 * 4;
constexpr size_t B_CNT = B_MOD + (size_t)2 * 5 * 12288 * 4;
constexpr size_t B_FLG = B_CNT + 256;
constexpr size_t B_END = B_FLG + 4096;

struct Params {
  const float* in[42];
  float* out;
  char* ws;
};

typedef __attribute__((ext_vector_type(2))) __bf16 hbf2;
DEV bf16 f2bf(float f) {
  __bf16 h = (__bf16)f;
  return *(unsigned short*)&h;
}
DEV float bf2f(bf16 h) { return __uint_as_float(((uint32_t)h) << 16); }
DEV uint32_t pack2(float a, float b) {
  hbf2 v;
  v[0] = (__bf16)a;
  v[1] = (__bf16)b;
  return *(uint32_t*)&v;
}
DEV float wsum(float v) {
#pragma unroll
  for (int o = 32; o > 0; o >>= 1) v += __shfl_xor(v, o);
  return v;
}
DEV float dpp_xor1(float v) {
  int i = __float_as_int(v);
  return __int_as_float(__builtin_amdgcn_update_dpp(i, i, 0xB1, 0xF, 0xF, false));
}
DEV float dpp_xor2(float v) {
  int i = __float_as_int(v);
  return __int_as_float(__builtin_amdgcn_update_dpp(i, i, 0x4E, 0xF, 0xF, false));
}
DEV float sigmoidf_(float x) { return __builtin_amdgcn_rcpf(1.f + __expf(-x)); }

DEV void phase_mod(int tidv, int bidv, const Params& p, char* smem) {
  float* s_in = (float*)smem;
  float* red = s_in + 5 * 2048;
  float* mod = (float*)(p.ws + B_MOD);
  for (int i = tidv; i < 5 * 2048; i += NT) {
    int r = i >> 11, k = i & 2047;
    float v = r < 4 ? p.in[1][r * 2048 + k] : p.in[3][k];
    s_in[i] = v / (1.f + expf(-v));
  }
  __syncthreads();
  int kg = tidv >> 6, c = tidv & 63;
  for (int task = bidv; task < 2 * 192; task += gridDim.x) {
    int l = task / 192, n = (task % 192) * 64 + c;
    const float* w = p.in[4] + (size_t)l * 2048 * 12288 + n;
    float a0 = 0, a1 = 0, a2 = 0, a3 = 0, a4 = 0;
    int kb = kg * 256;
#pragma unroll 8
    for (int k = 0; k < 256; k++) {
      float wv = w[(size_t)(kb + k) * 12288];
      a0 += s_in[kb + k] * wv;
      a1 += s_in[2048 + kb + k] * wv;
      a2 += s_in[4096 + kb + k] * wv;
      a3 += s_in[6144 + kb + k] * wv;
      a4 += s_in[8192 + kb + k] * wv;
    }
    red[(kg * 5 + 0) * 64 + c] = a0;
    red[(kg * 5 + 1) * 64 + c] = a1;
    red[(kg * 5 + 2) * 64 + c] = a2;
    red[(kg * 5 + 3) * 64 + c] = a3;
    red[(kg * 5 + 4) * 64 + c] = a4;
    __syncthreads();
    if (kg == 0) {
      float bias = p.in[5][l * 12288 + n];
#pragma unroll
      for (int r = 0; r < 5; r++) {
        float v = 0.f;
#pragma unroll
        for (int g = 0; g < 8; g++) v += red[(g * 5 + r) * 64 + c];
        mod[(size_t)(l * 5 + r) * 12288 + n] = v + bias;
      }
    }
    __syncthreads();
  }
}

DEV void convT(int tidv, int bidv, const float* __restrict__ src, bf16* __restrict__ dst, int K, int N, const float* __restrict__ gain, char* smem, int dK = 0) {
  if (dK == 0) dK = K;
  float* t = (float*)smem;
  int tk = (K + 63) >> 6, tn = (N + 63) >> 6;
  for (int tile = bidv; tile < tk * tn; tile += gridDim.x) {
    int k0 = (tile / tn) * 64, n0 = (tile % tn) * 64;
    __syncthreads();
#pragma unroll 4
    for (int i = 0; i < 8; i++) {
      int kk = i * 8 + (tidv >> 6), nn = tidv & 63;
      float v = 0.f;
      if (k0 + kk < K && n0 + nn < N) {
        v = src[(size_t)(k0 + kk) * N + n0 + nn];
        if (gain) v *= gain[k0 + kk];
      }
      t[kk * 65 + nn] = v;
    }
    __syncthreads();
    {
      int c = tidv;
      int nn = c >> 3, kc = c & 7;
      if (n0 + nn < N && k0 + kc * 8 < dK) {
        uint4 o;
        o.x = pack2(t[(kc * 8 + 0) * 65 + nn], t[(kc * 8 + 1) * 65 + nn]);
        o.y = pack2(t[(kc * 8 + 2) * 65 + nn], t[(kc * 8 + 3) * 65 + nn]);
        o.z = pack2(t[(kc * 8 + 4) * 65 + nn], t[(kc * 8 + 5) * 65 + nn]);
        o.w = pack2(t[(kc * 8 + 6) * 65 + nn], t[(kc * 8 + 7) * 65 + nn]);
        *(uint4*)(dst + (size_t)(n0 + nn) * dK + k0 + kc * 8) = o;
      }
    }
  }
}

DEV void phase_convw(int tidv, int bidv, const Params& p, int l, char* smem) {
  bf16* wb = (bf16*)(p.ws + B_WB);
  convT(tidv, bidv, p.in[8] + (size_t)l * 2048 * NIN, wb + OW_IN, 2048, NIN, nullptr, smem);
  convT(tidv, bidv, p.in[40] + (size_t)l * 2048 * 8192, wb + OW_M1, 2048, 8192, nullptr, smem);
  convT(tidv, bidv, p.in[41] + (size_t)l * 8192 * 2048, wb + OW_M2, 8192, 2048, nullptr, smem);
  for (int n = 0; n < 3; n++)
    convT(tidv, bidv, p.in[38] + (size_t)(l * 3 + n) * 1024 * 2048, wb + OW_BR + (size_t)n * 2048 * 1024, 1024, 2048, nullptr, smem);
  convT(tidv, bidv, p.in[39] + (size_t)l * 2048 * 2048, wb + OW_OUT, 2048, 2048, nullptr, smem);
  convT(tidv, bidv, p.in[11] + (size_t)l * 512 * 1536, wb + OW_UQ, 512, 1536, p.in[9] + l * 512, smem);
  convT(tidv, bidv, p.in[12] + (size_t)l * 512 * 2048, wb + OW_UKV, 512, 2048, p.in[10] + l * 512, smem);
  convT(tidv, bidv, p.in[36] + (size_t)l * 1024 * 1024, wb + OW_GLU, 1024, 1024, nullptr, smem);
  for (int d = 0; d < 2; d++) {
    convT(tidv, bidv, p.in[19] + (size_t)(l * 2 + d) * 64 * 1024, wb + OW_W2 + (size_t)d * 65536, 64, 1024, nullptr, smem);
    convT(tidv, bidv, p.in[21] + (size_t)(l * 2 + d) * 64 * 1024, wb + OW_A2 + (size_t)d * 65536, 64, 1024, nullptr, smem);
  }
  convT(tidv, bidv, p.in[22] + (size_t)l * 160 * 1024, wb + OW_G2, 160, 1024, nullptr, smem, 192);
}

DEV void phase_norm(int tidv, int bidv, const float* xlat, const float* xctx, const float* g, const float* mod, int shOff, int scOff, bf16* H, int nrows) {
  int wave = tidv >> 6, lane = tidv & 63;
  for (int row = bidv * NW + wave; row < nrows; row += gridDim.x * NW) {
    const float* x = row < ML ? xlat + (size_t)row * 2048 : xctx + (size_t)(row - ML) * 2048;
    int b = row < ML ? (row >> 12) : 4;
    const float* sh = mod + b * 12288 + shOff;
    const float* sc = mod + b * 12288 + scOff;
    float4 v[8];
    float ss = 0.f;
#pragma unroll
    for (int i = 0; i < 8; i++) {
      v[i] = *(const float4*)(x + i * 256 + lane * 4);
      ss += v[i].x * v[i].x + v[i].y * v[i].y + v[i].z * v[i].z + v[i].w * v[i].w;
    }
    ss = wsum(ss);
    float rinv = rsqrtf(ss * (1.f / 2048.f) + 1e-6f);
#pragma unroll
    for (int i = 0; i < 8; i++) {
      int c = i * 256 + lane * 4;
      float4 g4 = *(const float4*)(g + c), s4 = *(const float4*)(sc + c), h4 = *(const float4*)(sh + c);
      float y0 = v[i].x * rinv * g4.x * (1.f + s4.x) + h4.x;
      float y1 = v[i].y * rinv * g4.y * (1.f + s4.y) + h4.y;
      float y2 = v[i].z * rinv * g4.z * (1.f + s4.z) + h4.z;
      float y3 = v[i].w * rinv * g4.w * (1.f + s4.w) + h4.w;
      uint2 o;
      o.x = pack2(y0, y1);
      o.y = pack2(y2, y3);
      *(uint2*)(H + (size_t)row * 2048 + c) = o;
    }
  }
}

constexpr int LDT = 72;
constexpr int GA_BYTES = 256 * LDT * 2;
constexpr int GSTAGE = 512 * LDT * 2;
constexpr int SM_RINV = 2 * GSTAGE;
constexpr int SM_ITEM = SM_RINV + 1024;
constexpr int LDS_BYTES = SM_ITEM + 16;
DEV float sumsq8(uint4 r) {
  float s = 0.f, x;
  x = bf2f((bf16)(r.x & 0xffff)); s += x * x; x = bf2f((bf16)(r.x >> 16)); s += x * x;
  x = bf2f((bf16)(r.y & 0xffff)); s += x * x; x = bf2f((bf16)(r.y >> 16)); s += x * x;
  x = bf2f((bf16)(r.z & 0xffff)); s += x * x; x = bf2f((bf16)(r.z >> 16)); s += x * x;
  x = bf2f((bf16)(r.w & 0xffff)); s += x * x; x = bf2f((bf16)(r.w >> 16)); s += x * x;
  return s;
}

template <bool ROWNORM>
DEV void gemm_mainloop(int tidv, int bidv, const bf16* __restrict__ A, int lda, bool amap, const bf16* __restrict__ Bt, int K, int N, int m0, int n0,
                       char* smem, f32x16 (&acc)[4][2]) {
  float* srinv = (float*)(smem + SM_RINV);
  const int tid = tidv, lane = tid & 63, wave = tid >> 6;
  const int wm = wave >> 2, wn = wave & 3;
  const int lr = tid >> 3, kc = tid & 7;
  const char* abase = (const char*)(A + (size_t)m0 * lda);
  const char* bbase = (const char*)(Bt + (size_t)n0 * K);
  const uint32_t voa = (uint32_t)(lr * lda + kc * 8) * 2u;
  const uint32_t astep = (uint32_t)(64 * lda) * 2u;
  const uint32_t vob0 = (uint32_t)(lr * K + kc * 8) * 2u;
  const uint32_t bstep = (uint32_t)(64 * K) * 2u;
  const uint32_t lds_st = (uint32_t)(lr * LDT + kc * 8) * 2u;
  const int nk = K >> 6;
  uint4 xa0, xa1, xa2, xa3, xb0, xb1, xb2, xb3;
#define G_LOAD(KT)                                                         \
  {                                                                        \
    const int k0_ = (KT) << 6;                                             \
    const int ka_ = amap ? ((k0_ >> 7) * 192 + (k0_ & 127)) : k0_;         \
    xa0 = *(const uint4*)(abase + (size_t)ka_ * 2 + voa);                  \
    xa1 = *(const uint4*)(abase + (size_t)ka_ * 2 + astep + voa);          \
    xa2 = *(const uint4*)(abase + (size_t)ka_ * 2 + 2 * astep + voa);      \
    xa3 = *(const uint4*)(abase + (size_t)ka_ * 2 + 3 * astep + voa);      \
    xb0 = *(const uint4*)(bbase + (size_t)k0_ * 2 + vob0);                 \
    xb1 = *(const uint4*)(bbase + (size_t)k0_ * 2 + bstep + vob0);         \
    xb2 = *(const uint4*)(bbase + (size_t)k0_ * 2 + 2 * bstep + vob0);     \
    xb3 = *(const uint4*)(bbase + (size_t)k0_ * 2 + 3 * bstep + vob0);     \
  }
#define G_STORE(SN)                                                  \
  *(uint4*)((SN) + lds_st) = xa0;                                    \
  *(uint4*)((SN) + 1 * (64 * LDT * 2) + lds_st) = xa1;               \
  *(uint4*)((SN) + 2 * (64 * LDT * 2) + lds_st) = xa2;               \
  *(uint4*)((SN) + 3 * (64 * LDT * 2) + lds_st) = xa3;               \
  *(uint4*)((SN) + GA_BYTES + lds_st) = xb0;                         \
  *(uint4*)((SN) + GA_BYTES + 1 * (64 * LDT * 2) + lds_st) = xb1;    \
  *(uint4*)((SN) + GA_BYTES + 2 * (64 * LDT * 2) + lds_st) = xb2;    \
  *(uint4*)((SN) + GA_BYTES + 3 * (64 * LDT * 2) + lds_st) = xb3;
  const uint32_t fa = (uint32_t)((wm * 128 + (lane & 31)) * LDT + (lane >> 5) * 8) * 2u;
  const uint32_t fb = (uint32_t)GA_BYTES + (uint32_t)((wn * 64 + (lane & 31)) * LDT + (lane >> 5) * 8) * 2u;
  const int nkm = nk - 1;
  if (ROWNORM) {
    __syncthreads();
#pragma unroll 1
    for (int i = 0; i < 4; i++) {
      float ss = 0.f;
      for (int kk = 0; kk < nk; kk++) ss += sumsq8(*(const uint4*)(abase + (size_t)kk * 128 + i * astep + voa));
      ss += __shfl_xor(ss, 1); ss += __shfl_xor(ss, 2); ss += __shfl_xor(ss, 4);
      if (kc == 0) srinv[lr + 64 * i] = rsqrtf(ss / (float)K + 1e-6f);
    }
  }
  G_LOAD(0)
  __syncthreads();
  G_STORE(smem)
  G_LOAD((1 < nkm ? 1 : nkm))
  __syncthreads();
#define G_FRAG(P, ST, KS)                                                            \
  P##a0 = *(const bf16x8*)((ST) + fa + 0 * (32 * LDT * 2) + (KS) * 32);                \
  P##a1 = *(const bf16x8*)((ST) + fa + 1 * (32 * LDT * 2) + (KS) * 32);                \
  P##a2 = *(const bf16x8*)((ST) + fa + 2 * (32 * LDT * 2) + (KS) * 32);                \
  P##a3 = *(const bf16x8*)((ST) + fa + 3 * (32 * LDT * 2) + (KS) * 32);                \
  P##b0 = *(const bf16x8*)((ST) + fb + 0 * (32 * LDT * 2) + (KS) * 32);                \
  P##b1 = *(const bf16x8*)((ST) + fb + 1 * (32 * LDT * 2) + (KS) * 32);
#define G_MMA(P)                                                                              \
  acc[0][0] = __builtin_amdgcn_mfma_f32_32x32x16_bf16(P##b0, P##a0, acc[0][0], 0, 0, 0);      \
  acc[0][1] = __builtin_amdgcn_mfma_f32_32x32x16_bf16(P##b1, P##a0, acc[0][1], 0, 0, 0);      \
  acc[1][0] = __builtin_amdgcn_mfma_f32_32x32x16_bf16(P##b0, P##a1, acc[1][0], 0, 0, 0);      \
  acc[1][1] = __builtin_amdgcn_mfma_f32_32x32x16_bf16(P##b1, P##a1, acc[1][1], 0, 0, 0);      \
  acc[2][0] = __builtin_amdgcn_mfma_f32_32x32x16_bf16(P##b0, P##a2, acc[2][0], 0, 0, 0);      \
  acc[2][1] = __builtin_amdgcn_mfma_f32_32x32x16_bf16(P##b1, P##a2, acc[2][1], 0, 0, 0);      \
  acc[3][0] = __builtin_amdgcn_mfma_f32_32x32x16_bf16(P##b0, P##a3, acc[3][0], 0, 0, 0);      \
  acc[3][1] = __builtin_amdgcn_mfma_f32_32x32x16_bf16(P##b1, P##a3, acc[3][1], 0, 0, 0);
  bf16x8 pa0, pa1, pa2, pa3, pb0, pb1, qa0, qa1, qa2, qa3, qb0, qb1;
#pragma unroll 1
  for (int kt = 0; kt < nk; kt++) {
    const char* st = smem + (kt & 1) * GSTAGE;
    char* sn = smem + ((kt + 1) & 1) * GSTAGE;
    if (!ROWNORM) {
      G_FRAG(p, st, 0)
      G_FRAG(q, st, 1)
      __builtin_amdgcn_sched_barrier(0);
      G_MMA(p)
      __builtin_amdgcn_sched_barrier(0);
      G_FRAG(p, st, 2)
      __builtin_amdgcn_sched_barrier(0);
      G_MMA(q)
      __builtin_amdgcn_sched_barrier(0);
      G_FRAG(q, st, 3)
      if (kt + 1 < nk) { G_STORE(sn) }
      G_LOAD((kt + 2 < nkm ? kt + 2 : nkm))
      __builtin_amdgcn_sched_barrier(0);
      G_MMA(p)
      __builtin_amdgcn_sched_barrier(0);
      G_MMA(q)
    } else {
      G_FRAG(p, st, 0)
      __builtin_amdgcn_sched_barrier(0);
      G_MMA(p)
      __builtin_amdgcn_sched_barrier(0);
      G_FRAG(p, st, 1)
      __builtin_amdgcn_sched_barrier(0);
      G_MMA(p)
      __builtin_amdgcn_sched_barrier(0);
      G_FRAG(p, st, 2)
      if (kt + 1 < nk) { G_STORE(sn) }
      G_LOAD((kt + 2 < nkm ? kt + 2 : nkm))
      __builtin_amdgcn_sched_barrier(0);
      G_MMA(p)
      __builtin_amdgcn_sched_barrier(0);
      G_FRAG(p, st, 3)
      __builtin_amdgcn_sched_barrier(0);
      G_MMA(p)
    }
    __syncthreads();
  }
#undef G_FRAG
#undef G_MMA
#undef G_LOAD
#undef G_STORE
}

DEV void zero_acc(f32x16 (&acc)[4][2]) {
#pragma unroll
  for (int i = 0; i < 4; i++)
#pragma unroll
    for (int j = 0; j < 2; j++)
#pragma unroll
      for (int e = 0; e < 16; e++) acc[i][j][e] = 0.f;
}

template <class F>
DEV void epi_loop(int tidv, int bidv, f32x16 (&acc)[4][2], int m0, int n0, int N, F f) {
  const int lane = tidv & 63, wave = tidv >> 6;
  const int wm = wave >> 2, wn = wave & 3;
#pragma unroll
  for (int i = 0; i < 4; i++) {
    const int lrow = wm * 128 + i * 32 + (lane & 31);
#pragma unroll
    for (int j = 0; j < 2; j++) {
#pragma unroll
      for (int g = 0; g < 4; g++) {
        int col = n0 + wn * 64 + j * 32 + 8 * g + 4 * (lane >> 5);
        f32x4 v = {acc[i][j][4 * g], acc[i][j][4 * g + 1], acc[i][j][4 * g + 2], acc[i][j][4 * g + 3]};
        if (col < N) f(m0 + lrow, lrow, col, v);
      }
    }
    __builtin_amdgcn_sched_barrier(0);
  }
}

DEV uint2 pack4(f32x4 v) {
  uint2 o;
  o.x = pack2(v[0], v[1]);
  o.y = pack2(v[2], v[3]);
  return o;
}
DEV f32x4 unpack4(uint2 u) {
  f32x4 v;
  v[0] = bf2f((bf16)(u.x & 0xffff)); v[1] = bf2f((bf16)(u.x >> 16));
  v[2] = bf2f((bf16)(u.y & 0xffff)); v[3] = bf2f((bf16)(u.y >> 16));
  return v;
}

enum { G_IN = 0, G_UQ, G_UKV, G_W2, G_A2, G_G2, G_GLU, G_OUT, G_M1, G_M2, G_MG0, G_MG1, G_MG2 };

template <int MODE>
DEV void run_gemm(int tidv, int bidv, const Params& p, int l, char* smem, const bf16* A, int lda, const bf16* Bt, int K, int N, int M, int aux,
                  const float* xin_lat, const float* xin_ctx, float* xout_lat, float* xout_ctx) {
  const int nt = (N + 255) >> 8, mt = M >> 8;
  char* ws = p.ws;
  bf16* Z = (bf16*)(ws + B_ZB);
  const float* srinv = (const float*)(smem + SM_RINV);
  const float* mod = (const float*)(ws + B_MOD) + (size_t)l * 5 * 12288;
  for (int tile = bidv; tile < nt * mt; tile += gridDim.x) {
    int m0 = (tile / nt) << 8, n0 = (tile % nt) << 8;
    f32x16 acc[4][2];
    zero_acc(acc);
    gemm_mainloop<(MODE == G_UQ || MODE == G_UKV)>(tidv, bidv, A, lda, MODE == G_MG0, Bt, K, N, m0, n0, smem, acc);
    epi_loop(tidv, bidv, acc, m0, n0, N, [&](int row, int lrow, int col, f32x4 v) {
      if constexpr (MODE == G_IN) {
        f32x4 o = v;
        if (col >= C_GATE || (col >= C_GD && col < C_U)) {
#pragma unroll
          for (int r = 0; r < 4; r++) o[r] = sigmoidf_(v[r]);
        } else if (col >= C_WD && col < C_AD) {
#pragma unroll
          for (int r = 0; r < 4; r++) o[r] = tanhf(v[r]);
        }
        *(uint2*)(smem + ((size_t)lrow * 264 + (col - n0)) * 2) = pack4(o);
      } else if constexpr (MODE == G_UQ) {
        float ri = srinv[lrow];
        *(uint2*)((bf16*)(ws + B_QB) + (size_t)row * 1536 + col) = pack4(v * ri);
      } else if constexpr (MODE == G_UKV) {
        float ri = srinv[lrow];
        f32x4 o = v * ri;
        int h = col >> 8, c = col & 255;
        if (c < 128) {
          *(uint2*)((bf16*)(ws + B_KN) + (size_t)row * 1024 + h * 128 + c) = pack4(o);
        } else {
          int b, kp;
          if (row < ML) { b = row >> 12; kp = row & 4095; } else { int r2 = row - ML; b = r2 >> 8; kp = 4096 + (r2 & 255); }
          bf16* vt = (bf16*)(ws + B_VT) + ((size_t)((b * 8 + h) * 128 + (c - 128))) * NKEY + kp;
#pragma unroll
          for (int r = 0; r < 4; r++) vt[(size_t)r * NKEY] = f2bf(o[r]);
        }
      } else if constexpr (MODE == G_W2) {
        float4 w0 = *(const float4*)(p.in[18] + (l * 2 + aux) * 1024 + col);
        f32x4 o;
        o[0] = 0.60653066f * sigmoidf_(w0.x + v[0]);
        o[1] = 0.60653066f * sigmoidf_(w0.y + v[1]);
        o[2] = 0.60653066f * sigmoidf_(w0.z + v[2]);
        o[3] = 0.60653066f * sigmoidf_(w0.w + v[3]);
        *(uint2*)((bf16*)(ws + B_HB + (size_t)aux * SZ1K) + (size_t)row * 1024 + col) = pack4(o);
      } else if constexpr (MODE == G_A2) {
        float4 a0 = *(const float4*)(p.in[20] + (l * 2 + aux) * 1024 + col);
        f32x4 o;
        o[0] = sigmoidf_(a0.x + v[0]);
        o[1] = sigmoidf_(a0.y + v[1]);
        o[2] = sigmoidf_(a0.z + v[2]);
        o[3] = sigmoidf_(a0.w + v[3]);
        *(uint2*)((bf16*)(ws + (aux ? B_AB : B_AF)) + (size_t)row * 1024 + col) = pack4(o);
      } else if constexpr (MODE == G_G2) {
        *(uint2*)((bf16*)(ws + B_GB) + (size_t)row * 1024 + col) = pack4(v);
      } else if constexpr (MODE == G_GLU) {
        f32x4 zz = unpack4(*(const uint2*)((const bf16*)(ws + B_SY) + (size_t)row * 1024 + col));
        float4 gb = *(const float4*)(p.in[37] + l * 1024 + col);
        f32x4 o;
        o[0] = zz[0] * sigmoidf_(v[0] + gb.x);
        o[1] = zz[1] * sigmoidf_(v[1] + gb.y);
        o[2] = zz[2] * sigmoidf_(v[2] + gb.z);
        o[3] = zz[3] * sigmoidf_(v[3] + gb.w);
        *(uint2*)(smem + ((size_t)lrow * 264 + (col - n0)) * 2) = pack4(o);
      } else if constexpr (MODE == G_OUT) {
        int b = row < ML ? (row >> 12) : 4;
        float4 g = *(const float4*)(mod + b * 12288 + 4096 + col);
        const float* xi = row < ML ? xin_lat + (size_t)row * 2048 : xin_ctx + (size_t)(row - ML) * 2048;
        float* xo = row < ML ? xout_lat + (size_t)row * 2048 : xout_ctx + (size_t)(row - ML) * 2048;
        float4 x = *(const float4*)(xi + col);
        x.x += g.x * v[0]; x.y += g.y * v[1]; x.z += g.z * v[2]; x.w += g.w * v[3];
        *(float4*)(xo + col) = x;
      } else if constexpr (MODE == G_M1) {
        f32x4 o;
#pragma unroll
        for (int r = 0; r < 4; r++) { float t = fmaxf(v[r], 0.f); o[r] = t * t; }
        *(uint2*)(smem + ((size_t)lrow * 264 + (col - n0)) * 2) = pack4(o);
      } else if constexpr (MODE == G_MG0 || MODE == G_MG1 || MODE == G_MG2) {
        constexpr int nb = MODE - G_MG0;
        bf16* MG = (bf16*)(ws + B_HB);
        f32x4 g = unpack4(*(const uint2*)(Z + (size_t)row * NIN + C_GATE + nb * 2048 + col));
        f32x4 o = g * v;
        if constexpr (nb > 0) o += unpack4(*(const uint2*)(MG + (size_t)row * 2048 + col));
        *(uint2*)(MG + (size_t)row * 2048 + col) = pack4(o);
      } else if constexpr (MODE == G_M2) {
        int b = row < ML ? (row >> 12) : 4;
        float4 g = *(const float4*)(mod + b * 12288 + 10240 + col);
        float* xo = row < ML ? xout_lat + (size_t)row * 2048 : xout_ctx + (size_t)(row - ML) * 2048;
        float4 x = *(const float4*)(xo + col);
        x.x += g.x * v[0]; x.y += g.y * v[1]; x.z += g.z * v[2]; x.w += g.w * v[3];
        *(float4*)(xo + col) = x;
      }
    });
    if constexpr (MODE == G_IN || MODE == G_GLU || MODE == G_M1) {
      bf16* dst;
      int ld;
      if constexpr (MODE == G_IN || MODE == G_GLU) { dst = Z; ld = NIN; }
      else { dst = Z; ld = DFF; }
      __syncthreads();
#pragma unroll 4
      for (int it = 0; it < 16; it++) {
        int c = it * NT + tidv;
        int r = c >> 5, ch = c & 31;
        int col = n0 + ch * 8;
        if (col < N) *(uint4*)(dst + (size_t)(m0 + r) * ld + col) = *(const uint4*)(smem + ((size_t)r * 264 + ch * 8) * 2);
      }
    }
  }
}

DEV void phase_mla_post(int tidv, int bidv, const Params& p, int l) {
  char* ws = p.ws;
  const float* qng = p.in[13] + l * 128;
  const float* qrg = p.in[14] + l * 64;
  const float* kng = p.in[15] + l * 128;
  const float* krg = p.in[16] + l * 64;
  bf16* QB = (bf16*)(ws + B_QB);
  bf16* KN = (bf16*)(ws + B_KN);
  bf16* KR = (bf16*)(ws + B_KR);
  const bf16* Z = (const bf16*)(ws + B_ZB);
  const int wave = tidv >> 6, lane = tidv & 63;
  const float QS = 1.4426950408889634f * 0.07216878364870322f;
  const int idx = lane & 31;
  const float inv = powf(10000.f, -(float)(idx & 15) / 16.f);
  const float gq0 = qng[2 * lane], gq1 = qng[2 * lane + 1], gk0 = kng[2 * lane], gk1 = kng[2 * lane + 1];
  const float gqr = qrg[lane], gkr = krg[lane];
  for (int row = bidv * NW + wave; row < MT; row += gridDim.x * NW) {
    bool lat = row < ML;
    int t = row & 4095;
    float pos = (idx < 16) ? (float)(t >> 6) : (float)(t & 63);
    float ang = pos * inv;
    float cs = 1.f, sn = 0.f;
    if (lat) { cs = cosf(ang); sn = sinf(ang); }
#pragma unroll 1
    for (int h = 0; h < 8; h++) {
      bf16* q = QB + (size_t)row * 1536 + h * 192;
      uint32_t u = *(const uint32_t*)(q + 2 * lane);
      float x0 = bf2f((bf16)(u & 0xffff)), x1 = bf2f((bf16)(u >> 16));
      float ss = wsum(x0 * x0 + x1 * x1);
      float rinv = rsqrtf(ss * (1.f / 128.f) + 1e-6f) * QS;
      *(uint32_t*)(q + 2 * lane) = pack2(x0 * rinv * gq0, x1 * rinv * gq1);
      float xr = bf2f(q[128 + lane]);
      float ss2 = wsum(xr * xr);
      float y = xr * rsqrtf(ss2 * (1.f / 64.f) + 1e-6f) * gqr;
      float yp = __shfl_xor(y, 32);
      float o = lane < 32 ? (y * cs - yp * sn) : (yp * sn + y * cs);
      q[128 + lane] = f2bf(o * QS);
      bf16* k = KN + (size_t)row * 1024 + h * 128;
      uint32_t uk = *(const uint32_t*)(k + 2 * lane);
      float k0 = bf2f((bf16)(uk & 0xffff)), k1 = bf2f((bf16)(uk >> 16));
      float ssk = wsum(k0 * k0 + k1 * k1);
      float rk = rsqrtf(ssk * (1.f / 128.f) + 1e-6f);
      *(uint32_t*)(k + 2 * lane) = pack2(k0 * rk * gk0, k1 * rk * gk1);
    }
    {
      float xr = bf2f(Z[(size_t)row * NIN + C_KR + lane]);
      float ss2 = wsum(xr * xr);
      float y = xr * rsqrtf(ss2 * (1.f / 64.f) + 1e-6f) * gkr;
      float yp = __shfl_xor(y, 32);
      float o = lane < 32 ? (y * cs - yp * sn) : (yp * sn + y * cs);
      KR[(size_t)row * 64 + lane] = f2bf(o);
    }
  }
}

DEV void step_row(int s, int d, int b, int& row, int& tau, int& len) {
  if (s < 256) { tau = d ? 255 - s : s; len = 256; row = ML + b * 256 + tau; }
  else { int q = s - 256; tau = d ? 4095 - q : q; len = 4096; row = b * 4096 + tau; }
}

struct RwPre { bf16 r0, r1, r2, k0, k1, k2, v0, v1, v2, a, e; };

DEV void rwkv_fetch(RwPre& q, const bf16* Z, const bf16* AD, const bf16* ED, int s, int d, int b, int ch) {
  int row, tau, len;
  step_row(s, d, b, row, tau, len);
  const bf16* z = Z + (size_t)row * NIN + C_R + ch;
  q.r1 = z[0]; q.k1 = z[1024]; q.v1 = z[2048];
  q.r0 = 0; q.k0 = 0; q.v0 = 0; q.r2 = 0; q.k2 = 0; q.v2 = 0;
  if (tau > 0) { const bf16* zm = z - NIN; q.r0 = zm[0]; q.k0 = zm[1024]; q.v0 = zm[2048]; }
  if (tau < len - 1) { const bf16* zp = z + NIN; q.r2 = zp[0]; q.k2 = zp[1024]; q.v2 = zp[2048]; }
  q.a = AD[(size_t)row * 1024 + ch];
  q.e = ED[(size_t)row * 1024 + ch];
}

typedef float f2v __attribute__((ext_vector_type(2)));
DEV float dpp_hmirror(float v) {
  int i = __float_as_int(v);
  return __int_as_float(__builtin_amdgcn_update_dpp(i, i, 0x141, 0xF, 0xF, false));
}
DEV f2v lo2(float4 v) { return f2v{v.x, v.y}; }
DEV f2v hi2(float4 v) { return f2v{v.z, v.w}; }

DEV void rwkv_scan(int tidv, int bidv, const Params& p, int l, int chain, char* smem, int dry) {
  char* ws = p.ws;
  float* op = (float*)smem;
  float* vb = op + 16 * 320;
  float* yb = vb + 16 * 64;
  const int tid = tidv, wave = tid >> 6, lane = tid & 63;
  const int d = chain & 1, h = (chain >> 1) & 15, b = chain >> 5;
  const int ch = h * 64 + lane;
  const float* cw = p.in[17] + (size_t)l * 3 * 3072;
  const float cr0 = cw[ch], cr1 = cw[3072 + ch], cr2 = cw[6144 + ch];
  const float ck0 = cw[1024 + ch], ck1 = cw[3072 + 1024 + ch], ck2 = cw[6144 + 1024 + ch];
  const float cv0 = cw[2048 + ch], cv1 = cw[3072 + 2048 + ch], cv2 = cw[6144 + 2048 + ch];
  const float kkc = p.in[23][l * 1024 + ch], kac = p.in[24][l * 1024 + ch];
  const bf16* Z = (const bf16*)(ws + B_ZB);
  bf16* ED = (bf16*)(ws + B_HB + (size_t)d * SZ1K);
  const bf16* AD = (const bf16*)(ws + (d ? B_AB : B_AF));
  f2v S0 = {0.f, 0.f}, S1 = {0.f, 0.f}, S2 = {0.f, 0.f}, S3 = {0.f, 0.f};
  const int ri = lane >> 3, jo = lane & 7, irow = wave * 8 + ri;
  RwPre pre[2];
#pragma unroll
  for (int si = 0; si < 2; si++) rwkv_fetch(pre[si], Z, AD, ED, wave * 2 + si, d, b, ch);
  for (int chunk = 0; chunk < 272; chunk++) {
#pragma unroll
    for (int si = 0; si < 2; si++) {
      int t = wave * 2 + si;
      const RwPre& q = pre[si];
      float rr = cr0 * bf2f(q.r0) + cr1 * bf2f(q.r1) + cr2 * bf2f(q.r2);
      float kk_ = ck0 * bf2f(q.k0) + ck1 * bf2f(q.k1) + ck2 * bf2f(q.k2);
      float vv = cv0 * bf2f(q.v0) + cv1 * bf2f(q.v1) + cv2 * bf2f(q.v2);
      float kkv = kk_ * kkc;
      float ssq = wsum(kkv * kkv);
      float kn = kkv * rsqrtf(ssq + 1e-12f);
      float a = bf2f(q.a);
      float w = __expf(-bf2f(q.e));
      float krep = kk_ * (1.f + (a - 1.f) * kac);
      float* o = op + t * 320;
      o[lane] = w;
      o[64 + lane] = kn * a;
      o[128 + lane] = krep;
      o[192 + lane] = -kn;
      o[256 + lane] = rr;
      vb[t * 64 + lane] = vv;
    }
    __syncthreads();
    if (chunk + 1 < 272) {
#pragma unroll
      for (int si = 0; si < 2; si++) rwkv_fetch(pre[si], Z, AD, ED, (chunk + 1) * 16 + wave * 2 + si, d, b, ch);
    }
    {
      const float4* o4 = (const float4*)(op + jo * 8);
      float4 n0 = o4[48], n1 = o4[49];
#pragma unroll 4
      for (int t = 0; t < 16; t++) {
        const float4* ot = o4 + t * 80;
        const float4 w0 = ot[0], w1 = ot[1];
        const float4 a0 = ot[16], a1 = ot[17];
        const float4 k0 = ot[32], k1 = ot[33];
        const float4 r0 = ot[64], r1 = ot[65];
        const float vi = vb[t * 64 + irow];
        const int tn = t < 15 ? t + 1 : 15;
        const float4* on = o4 + tn * 80;
        const float4 m0 = on[48], m1 = on[49];
        f2v sv = S0 * lo2(n0) + S1 * hi2(n0) + (S2 * lo2(n1) + S3 * hi2(n1));
        float sa = sv.x + sv.y;
        sa += dpp_xor1(sa);
        sa += dpp_xor2(sa);
        sa += dpp_hmirror(sa);
        const f2v sa2 = {sa, sa}, vi2 = {vi, vi};
        S0 = S0 * lo2(w0) + sa2 * lo2(a0) + vi2 * lo2(k0);
        S1 = S1 * hi2(w0) + sa2 * hi2(a0) + vi2 * hi2(k0);
        S2 = S2 * lo2(w1) + sa2 * lo2(a1) + vi2 * lo2(k1);
        S3 = S3 * hi2(w1) + sa2 * hi2(a1) + vi2 * hi2(k1);
        f2v yv = S0 * lo2(r0) + S1 * hi2(r0) + (S2 * lo2(r1) + S3 * hi2(r1));
        float y = yv.x + yv.y;
        y += dpp_xor1(y);
        y += dpp_xor2(y);
        y += dpp_hmirror(y);
        if (jo == 0) yb[t * 64 + irow] = y;
        n0 = m0; n1 = m1;
      }
    }
    __syncthreads();
#pragma unroll
    for (int it = 0; it < 2; it++) {
      int idx = it * NT + tid;
      int t = idx >> 6, i = idx & 63;
      int row, tau, len;
      step_row(chunk * 16 + t, d, b, row, tau, len);
      size_t off = (size_t)row * 1024 + h * 64 + i;
      bf16* yd = dry ? (bf16*)(ws + B_END) + (off & 0x3fffff) : ED + off;
      *yd = f2bf(yb[t * 64 + i]);
    }
  }
}

DEV void s5_scan(int tidv, int bidv, const Params& p, int l, int chain, char* smemw, int dry) {
  char* ws = p.ws;
  const int lane = tidv & 63;
  const int d = chain & 1, g = (chain >> 1) & 63, b = chain >> 7;
  float* ub = (float*)smemw;
  float* hb = ub + 256;
  const size_t pg = (size_t)(l * 2 + d) * 64 + g;
  const float lre = p.in[28][pg * 64 + lane], lim = p.in[29][pg * 64 + lane];
  const float dt = expf(p.in[30][pg]);
  const float mag = expf(lre * dt);
  const float are = mag * cosf(lim * dt), aim = mag * sinf(lim * dt);
  const float den = lre * lre + lim * lim;
  const float qre = ((are - 1.f) * lre + aim * lim) / den;
  const float qim = (aim * lre - (are - 1.f) * lim) / den;
  float bbre[16], bbim[16];
  {
    const float* br = p.in[31] + (pg * 64 + lane) * 16;
    const float* bi = p.in[32] + (pg * 64 + lane) * 16;
#pragma unroll
    for (int i = 0; i < 16; i++) {
      float x = br[i], y = bi[i];
      bbre[i] = qre * x - qim * y;
      bbim[i] = qre * y + qim * x;
    }
  }
  bf16x8 cfr[4];
  {
    const int i = lane & 15, quad = lane >> 4;
    const float* cre = p.in[33] + (pg * 16 + i) * 64;
    const float* cim = p.in[34] + (pg * 16 + i) * 64;
#pragma unroll
    for (int ks = 0; ks < 4; ks++)
#pragma unroll
      for (int j = 0; j < 8; j++) {
        int k = ks * 32 + quad * 8 + j;
        float c = ks < 2 ? cre[k] : -cim[k - 64];
        cfr[ks][j] = (short)f2bf(c);
      }
  }
  float hre = 0.f, him = 0.f;
  const bf16* Z = (const bf16*)(ws + B_ZB);
  const int tt = lane >> 2, i0 = (lane & 3) * 4;
  uint2 unext;
  {
    int row, tau, len;
    step_row(tt, d, b, row, tau, len);
    unext = *(const uint2*)(Z + (size_t)row * NIN + C_U + g * 16 + i0);
  }
  for (int chunk = 0; chunk < 272; chunk++) {
    {
      uint2 u = unext;
      float4 f;
      f.x = bf2f((bf16)(u.x & 0xffff)); f.y = bf2f((bf16)(u.x >> 16));
      f.z = bf2f((bf16)(u.y & 0xffff)); f.w = bf2f((bf16)(u.y >> 16));
      *(float4*)(ub + tt * 16 + i0) = f;
    }
    __syncthreads();
    if (chunk + 1 < 272) {
      int row, tau, len;
      step_row((chunk + 1) * 16 + tt, d, b, row, tau, len);
      unext = *(const uint2*)(Z + (size_t)row * NIN + C_U + g * 16 + i0);
    }
#pragma unroll 2
    for (int t = 0; t < 16; t++) {
      const float* u = ub + t * 16;
      float br0 = 0.f, bi0 = 0.f;
#pragma unroll
      for (int i = 0; i < 16; i++) { float uv = u[i]; br0 += bbre[i] * uv; bi0 += bbim[i] * uv; }
      float nr = are * hre - aim * him + br0;
      float ni = are * him + aim * hre + bi0;
      hre = nr; him = ni;
      hb[t * 132 + lane] = hre;
      hb[t * 132 + 64 + lane] = him;
    }
    __syncthreads();
    {
      f32x4 yacc = {0.f, 0.f, 0.f, 0.f};
      const float* hr = hb + (lane & 15) * 132 + (lane >> 4) * 8;
#pragma unroll
      for (int ks = 0; ks < 4; ks++) {
        float4 x0 = *(const float4*)(hr + ks * 32), x1 = *(const float4*)(hr + ks * 32 + 4);
        union { bf16x8 v; uint32_t u[4]; } af;
        af.u[0] = pack2(x0.x, x0.y); af.u[1] = pack2(x0.z, x0.w);
        af.u[2] = pack2(x1.x, x1.y); af.u[3] = pack2(x1.z, x1.w);
        yacc = __builtin_amdgcn_mfma_f32_16x16x32_bf16(af.v, cfr[ks], yacc, 0, 0, 0);
      }
      const int ii = lane & 15;
#pragma unroll
      for (int r = 0; r < 4; r++) {
        int row, tau, len;
        step_row(chunk * 16 + (lane >> 4) * 4 + r, d, b, row, tau, len);
        bf16* dst = d == 0 ? (bf16*)(ws + B_SY) + (size_t)row * 1024 + g * 16 + ii : (bf16*)(ws + B_ZB) + (size_t)row * NIN + g * 16 + ii;
        if (dry) dst = (bf16*)(ws + B_END) + ((((size_t)row * 1024 + g * 16 + ii)) & 0x3fffff);
        *dst = f2bf(yacc[r]);
      }
    }
    __syncthreads();
  }
}

DEV int perm23(int r) { return (r & 0x13) | ((r & 4) << 1) | ((r & 8) >> 1); }

DEV void attn_item(int tidv, int bidv, const Params& p, int item, bool ctxq, char* smem, int dry) {
  char* ws = p.ws;
  bf16* sK = (bf16*)smem;
  bf16* sV = sK + 64 * 200;
  const int tid = tidv, wave = tid >> 6, lane = tid & 63;
  const int r = lane & 31, hf = lane >> 5;
  int b, hd, qt;
  if (!ctxq) { b = item >> 7; hd = (item >> 4) & 7; qt = item & 15; }
  else { b = item >> 3; hd = item & 7; qt = 0; }
  const int qrow0 = ctxq ? ML + b * 256 : b * 4096 + qt * 256;
  const int kt0 = ctxq ? 64 : 0, kt1 = 68;
  bf16* QB = (bf16*)(ws + B_QB);
  const bf16* KN = (const bf16*)(ws + B_KN);
  const bf16* KR = (const bf16*)(ws + B_KR);
  const bf16* VT = (const bf16*)(ws + B_VT);
  bf16x8 qf[12];
  {
    const bf16* qp = QB + (size_t)(qrow0 + wave * 32 + r) * 1536 + hd * 192 + hf * 8;
#pragma unroll
    for (int kk = 0; kk < 12; kk++) qf[kk] = *(const bf16x8*)(qp + kk * 16);
  }
  f32x16 oacc[4];
#pragma unroll
  for (int i = 0; i < 4; i++)
#pragma unroll
    for (int e = 0; e < 16; e++) oacc[i][e] = 0.f;
  float mrun = -1e30f, lrun = 0.f;
  const int pr = perm23(r);
  for (int kt = kt0; kt < kt1; kt++) {
    __syncthreads();
    const int key0 = kt * 64;
    const int rowbase = key0 < 4096 ? b * 4096 + key0 : ML + b * 256 + (key0 - 4096);
    {
      const char* bk = (const char*)(KN + (size_t)rowbase * 1024 + hd * 128);
      const char* br = (const char*)(KR + (size_t)rowbase * 64);
      const char* bv = (const char*)(VT + ((size_t)((b * 8 + hd) * 128)) * NKEY + key0);
      const uint32_t vo_n = (uint32_t)((tid >> 4) * 2048 + (tid & 15) * 16);
      const uint32_t lo_n = (uint32_t)((tid >> 4) * 400 + (tid & 15) * 16);
      const uint32_t vo_r = (uint32_t)((tid >> 3) * 128 + (tid & 7) * 16);
      const uint32_t lo_r = (uint32_t)((tid >> 3) * 400 + 256 + (tid & 7) * 16);
      const uint32_t vo_v = (uint32_t)((tid >> 3) * (NKEY * 2) + (tid & 7) * 16);
      const uint32_t lo_v = (uint32_t)((tid >> 3) * 144 + (tid & 7) * 16);
      uint4 t0 = *(const uint4*)(bk + vo_n);
      uint4 t1 = *(const uint4*)(bk + 32 * 2048 + vo_n);
      uint4 t4 = *(const uint4*)(br + vo_r);
      uint4 u0 = *(const uint4*)(bv + vo_v);
      uint4 u1 = *(const uint4*)(bv + (size_t)64 * NKEY * 2 + vo_v);
      *(uint4*)((char*)sK + lo_n) = t0;
      *(uint4*)((char*)sK + 32 * 400 + lo_n) = t1;
      *(uint4*)((char*)sK + lo_r) = t4;
      *(uint4*)((char*)sV + lo_v) = u0;
      *(uint4*)((char*)sV + 64 * 144 + lo_v) = u1;
    }
    __syncthreads();
    f32x16 sacc[2];
#pragma unroll
    for (int m = 0; m < 2; m++) {
#pragma unroll
      for (int e = 0; e < 16; e++) sacc[m][e] = 0.f;
      const bf16* kp = sK + (m * 32 + pr) * 200 + hf * 8;
#pragma unroll
      for (int kk = 0; kk < 12; kk++) {
        bf16x8 kf = *(const bf16x8*)(kp + kk * 16);
        sacc[m] = __builtin_amdgcn_mfma_f32_32x32x16_bf16(kf, qf[kk], sacc[m], 0, 0, 0);
        if ((kk & 3) == 3) __builtin_amdgcn_sched_barrier(0);
      }
      __builtin_amdgcn_sched_barrier(0);
    }
    float tmax = sacc[0][0];
#pragma unroll
    for (int e = 1; e < 16; e++) tmax = fmaxf(tmax, sacc[0][e]);
#pragma unroll
    for (int e = 0; e < 16; e++) tmax = fmaxf(tmax, sacc[1][e]);
    tmax = fmaxf(tmax, __shfl_xor(tmax, 32));
    float mnew = fmaxf(mrun, tmax);
    float alpha = __builtin_amdgcn_exp2f(mrun - mnew);
    mrun = mnew;
    float psum = 0.f;
#pragma unroll
    for (int m = 0; m < 2; m++)
#pragma unroll
      for (int e = 0; e < 16; e++) { float pv = __builtin_amdgcn_exp2f(sacc[m][e] - mnew); sacc[m][e] = pv; psum += pv; }
    lrun = lrun * alpha + psum;
#pragma unroll
    for (int i = 0; i < 4; i++)
#pragma unroll
      for (int e = 0; e < 16; e++) oacc[i][e] *= alpha;
#pragma unroll
    for (int s = 0; s < 4; s++) {
      const int m = s >> 1, s2 = s & 1;
      bf16x8 pf;
#pragma unroll
      for (int j = 0; j < 8; j++) pf[j] = (short)f2bf(sacc[m][8 * s2 + j]);
#pragma unroll
      for (int i = 0; i < 4; i++) {
        bf16x8 vf = *(const bf16x8*)(sV + (i * 32 + r) * 72 + m * 32 + s2 * 16 + hf * 8);
        oacc[i] = __builtin_amdgcn_mfma_f32_32x32x16_bf16(vf, pf, oacc[i], 0, 0, 0);
      }
      __builtin_amdgcn_sched_barrier(0);
    }
  }
  lrun += __shfl_xor(lrun, 32);
  const float inv = 1.f / lrun;
  bf16* op = QB + (size_t)(qrow0 + wave * 32 + r) * 1536 + hd * 192;
  if (dry) op = (bf16*)(ws + B_END) + ((((size_t)(qrow0 + wave * 32 + r) * 1536 + hd * 192)) & 0x3ffff8);
#pragma unroll
  for (int i = 0; i < 4; i++)
#pragma unroll
    for (int g = 0; g < 4; g++) {
      uint2 o;
      o.x = pack2(oacc[i][4 * g] * inv, oacc[i][4 * g + 1] * inv);
      o.y = pack2(oacc[i][4 * g + 2] * inv, oacc[i][4 * g + 3] * inv);
      *(uint2*)(op + 32 * i + 8 * g + 4 * hf) = o;
    }
}

DEV void phase_mixers(int tidv, int bidv, const Params& p, int l, char* smem, int dry) {
  int* s_item = (int*)(smem + SM_ITEM);
#ifdef PROBE_PARTS
  const int parts = dry ? PROBE_PARTS : 7;
#else
  const int parts = 7;
#endif
  for (int task = bidv; task < 192; task += gridDim.x) {
    if (task < 128 && !(parts & 1)) continue;
    if (task >= 128 && !(parts & 2)) continue;
    if (task < 128) rwkv_scan(tidv, bidv, p, l, task, smem, dry);
    else s5_scan(tidv, bidv, p, l, (task - 128) * 8 + (tidv >> 6), smem + (tidv >> 6) * 9472, dry);
  }
  const int nlat = 512, ntot = (parts & 4) ? ((l == 0) ? 544 : 512) : 0;
  int* cnt = (int*)(p.ws + B_CNT) + l + 2 * dry;
#if !defined(MIX_ONLY) || MIX_ONLY == 2
  while (true) {
    __syncthreads();
    if (tidv == 0) *s_item = atomicAdd(cnt, 1);
    __syncthreads();
    int item = *s_item;
    if (item >= ntot) break;
    if (item < nlat) attn_item(tidv, bidv, p, item, false, smem, dry);
    else attn_item(tidv, bidv, p, item - nlat, true, smem, dry);
  }
#endif
}

DEV float gelu_tanh(float x) {
  float u = 0.7978845608028654f * (x + 0.044715f * x * x * x);
  return 0.5f * x * (1.f + tanhf(u));
}

DEV void phase_post(int tidv, int bidv, const Params& p, int l, int M) {
  char* ws = p.ws;
  const bf16* Z = (const bf16*)(ws + B_ZB);
  const int wave = tidv >> 6, lane = tidv & 63;
  const float* cw = p.in[17] + (size_t)l * 3 * 3072;
  const bf16* YF = (const bf16*)(ws + B_HB);
  const bf16* YB = (const bf16*)(ws + B_HB + SZ1K);
  const bf16* AF = (const bf16*)(ws + B_AF);
  const bf16* AB = (const bf16*)(ws + B_AB);
  bf16* GB = (bf16*)(ws + B_GB);
  const int nitem = M * 16;
  for (int it = bidv * NW + wave; it < nitem; it += gridDim.x * NW) {
    int row = it >> 4, h = it & 15;
    int ch = h * 64 + lane;
    int tau, len;
    if (row < ML) { tau = row & 4095; len = 4096; } else { tau = (row - ML) & 255; len = 256; }
    size_t o = (size_t)row * 1024 + ch;
    float y = bf2f(YF[o]) + bf2f(YB[o]);
    float mu = wsum(y) * (1.f / 64.f);
    float dv = y - mu;
    float var = wsum(dv * dv) * (1.f / 64.f);
    float yn = dv * rsqrtf(var + 64e-5f) * p.in[26][l * 1024 + ch] + p.in[27][l * 1024 + ch];
    const bf16* z = Z + (size_t)row * NIN + C_R + ch;
    float r1 = bf2f(z[0]), k1 = bf2f(z[1024]), v1 = bf2f(z[2048]);
    float r0 = 0.f, k0 = 0.f, v0 = 0.f, r2 = 0.f, k2 = 0.f, v2 = 0.f;
    if (tau > 0) { const bf16* zm = z - NIN; r0 = bf2f(zm[0]); k0 = bf2f(zm[1024]); v0 = bf2f(zm[2048]); }
    if (tau < len - 1) { const bf16* zp = z + NIN; r2 = bf2f(zp[0]); k2 = bf2f(zp[1024]); v2 = bf2f(zp[2048]); }
    float rr = cw[ch] * r0 + cw[3072 + ch] * r1 + cw[6144 + ch] * r2;
    float kk = cw[1024 + ch] * k0 + cw[3072 + 1024 + ch] * k1 + cw[6144 + 1024 + ch] * k2;
    float vv = cw[2048 + ch] * v0 + cw[3072 + 2048 + ch] * v1 + cw[6144 + 2048 + ch] * v2;
    float am = 0.5f * (bf2f(AF[o]) + bf2f(AB[o]));
    float kbon = kk * (1.f + (am - 1.f) * p.in[24][l * 1024 + ch]);
    float s = wsum(rr * kbon * p.in[25][l * 1024 + ch]);
    float outv = (yn + s * vv) * bf2f(GB[o]);
    GB[o] = f2bf(outv);
  }
  bf16* SY = (bf16*)(ws + B_SY);
  const float* dsk = p.in[35] + l * 1024;
  const int n4 = M * 256;
  for (int i = bidv * NT + tidv; i < n4; i += gridDim.x * NT) {
    int row = i >> 8, c = (i & 255) * 4;
    uint2 a = *(const uint2*)(SY + (size_t)row * 1024 + c);
    uint2 bq = *(const uint2*)(Z + (size_t)row * NIN + c);
    uint2 u = *(const uint2*)(Z + (size_t)row * NIN + C_U + c);
    float4 dd = *(const float4*)(dsk + c);
    float y0 = bf2f((bf16)(a.x & 0xffff)) + bf2f((bf16)(bq.x & 0xffff)) + dd.x * bf2f((bf16)(u.x & 0xffff));
    float y1 = bf2f((bf16)(a.x >> 16)) + bf2f((bf16)(bq.x >> 16)) + dd.y * bf2f((bf16)(u.x >> 16));
    float y2 = bf2f((bf16)(a.y & 0xffff)) + bf2f((bf16)(bq.y & 0xffff)) + dd.z * bf2f((bf16)(u.y & 0xffff));
    float y3 = bf2f((bf16)(a.y >> 16)) + bf2f((bf16)(bq.y >> 16)) + dd.w * bf2f((bf16)(u.y >> 16));
    uint2 o;
    o.x = pack2(gelu_tanh(y0), gelu_tanh(y1));
    o.y = pack2(gelu_tanh(y2), gelu_tanh(y3));
    *(uint2*)(SY + (size_t)row * 1024 + c) = o;
  }
}

constexpr int NPH = 25;

DEV void run_phase(int tidv, int bidv, const Params& p, int ph, char* smem, int dry) {
  char* ws = p.ws;
#ifndef ONLY_S
  if (ph == 0) {
    if (bidv == 0 && tidv < 4) ((int*)(ws + B_CNT))[tidv] = 0;
    phase_mod(tidv, bidv, p, smem);
    phase_convw(tidv, bidv, p, 0, smem);
    return;
  }
#endif
  const int l = (ph - 1) / 12, s = (ph - 1) % 12;
#ifdef ONLY_S
  if (s != ONLY_S) return;
#endif
  const bf16* wb = (const bf16*)(ws + B_WB);
  const float* mod = (const float*)(ws + B_MOD) + (size_t)l * 5 * 12288;
  float* XC = (float*)(ws + B_XC);
  const float* xin_lat = l == 0 ? p.in[0] : p.out;
  const float* xin_ctx = l == 0 ? p.in[2] : XC;
  bf16* HB = (bf16*)(ws + B_HB);
  bf16* Z = (bf16*)(ws + B_ZB);
  bf16* H2 = (bf16*)(ws + B_KN);
  const int Mpost = l == 0 ? MT : ML;
  switch (s) {
    case 0:
      if (l == 1) phase_convw(tidv, bidv, p, 1, smem);
      phase_norm(tidv, bidv, xin_lat, xin_ctx, p.in[6] + l * 2048, mod, 0, 2048, HB, MT);
      break;
    case 1:
      run_gemm<G_IN>(tidv, bidv, p, l, smem, HB, 2048, wb + OW_IN, 2048, NIN, MT, 0, nullptr, nullptr, nullptr, nullptr);
      break;
    case 2:
#if !defined(PH2_ONLY) || PH2_ONLY == 0
      run_gemm<G_UKV>(tidv, bidv, p, l, smem, Z + C_CKV, NIN, wb + OW_UKV, 512, 2048, MT, 0, nullptr, nullptr, nullptr, nullptr);
#endif
#if !defined(PH2_ONLY) || PH2_ONLY == 1
      run_gemm<G_UQ>(tidv, bidv, p, l, smem, Z + C_CQ, NIN, wb + OW_UQ, 512, 1536, MT, 0, nullptr, nullptr, nullptr, nullptr);
#endif
#if !defined(PH2_ONLY) || PH2_ONLY == 2
      run_gemm<G_G2>(tidv, bidv, p, l, smem, Z + C_GD, NIN, wb + OW_G2, 192, 1024, MT, 0, nullptr, nullptr, nullptr, nullptr);
#endif
#if !defined(PH2_ONLY) || PH2_ONLY == 3
      for (int d = 0; d < 2; d++) {
        run_gemm<G_W2>(tidv, bidv, p, l, smem, Z + C_WD + 64 * d, NIN, wb + OW_W2 + (size_t)d * 65536, 64, 1024, MT, d, nullptr, nullptr, nullptr, nullptr);
        run_gemm<G_A2>(tidv, bidv, p, l, smem, Z + C_AD + 64 * d, NIN, wb + OW_A2 + (size_t)d * 65536, 64, 1024, MT, d, nullptr, nullptr, nullptr, nullptr);
      }
#endif
      break;
    case 3: phase_mla_post(tidv, bidv, p, l); break;
    case 4: phase_mixers(tidv, bidv, p, l, smem, dry); break;
    case 5: phase_post(tidv, bidv, p, l, Mpost); break;
    case 6:
      run_gemm<G_GLU>(tidv, bidv, p, l, smem, (const bf16*)(ws + B_SY), 1024, wb + OW_GLU, 1024, 1024, Mpost, 0, nullptr, nullptr, nullptr, nullptr);
      break;
    case 7:
      run_gemm<G_MG0>(tidv, bidv, p, l, smem, (const bf16*)(ws + B_QB), 1536, wb + OW_BR, 1024, 2048, Mpost, 0, nullptr, nullptr, nullptr, nullptr);
      run_gemm<G_MG1>(tidv, bidv, p, l, smem, (const bf16*)(ws + B_GB), 1024, wb + OW_BR + (size_t)2048 * 1024, 1024, 2048, Mpost, 0, nullptr, nullptr, nullptr, nullptr);
      run_gemm<G_MG2>(tidv, bidv, p, l, smem, Z, NIN, wb + OW_BR + (size_t)2 * 2048 * 1024, 1024, 2048, Mpost, 0, nullptr, nullptr, nullptr, nullptr);
      break;
    case 8:
      run_gemm<G_OUT>(tidv, bidv, p, l, smem, HB, 2048, wb + OW_OUT, 2048, 2048, Mpost, 0, xin_lat, xin_ctx, p.out, XC);
      break;
    case 9:
      phase_norm(tidv, bidv, p.out, XC, p.in[7] + l * 2048, mod, 6144, 8192, H2, Mpost);
      break;
    case 10:
      run_gemm<G_M1>(tidv, bidv, p, l, smem, H2, 2048, wb + OW_M1, 2048, 8192, Mpost, 0, nullptr, nullptr, nullptr, nullptr);
      break;
    case 11:
      run_gemm<G_M2>(tidv, bidv, p, l, smem, Z, 8192, wb + OW_M2, 8192, 2048, Mpost, 0, nullptr, nullptr, p.out, XC);
      break;
  }
}

__global__ void __launch_bounds__(NT) fwd_megakernel(Params p, int ph0, int ph1, int dryflag) {
  extern __shared__ __attribute__((aligned(16))) char smem[];
  for (int ph = ph0; ph < ph1; ph++) {
    int tidv = threadIdx.x, bidv = blockIdx.x;
    asm volatile("" : "+v"(tidv));
    asm volatile("" : "+s"(bidv));
#ifdef PROBE_MASK
    if (dryflag && ((ph == 0 && (PROBE_MASK & 0x1000)) || (ph > 0 && ((PROBE_MASK >> ((ph - 1) % 12)) & 1)))) {
      run_phase(tidv, bidv, p, ph, smem, dryflag);
      cg::this_grid().sync();
    }
#endif
    run_phase(tidv, bidv, p, ph, smem, 0);
    if (ph + 1 < ph1) cg::this_grid().sync();
  }
}

extern "C" void kernel_launch(void* const* d_in, const int* in_sizes, int n_in, void* d_out, int out_size, void* d_ws, size_t ws_size,
                              hipStream_t stream) {
  static int grid_blocks = 0;
  if (!grid_blocks) {
    int dev = 0, cus = 0, per_cu = 0;
    (void)hipGetDevice(&dev);
    (void)hipDeviceGetAttribute(&cus, hipDeviceAttributeMultiprocessorCount, dev);
    if (hipFuncSetAttribute((const void*)fwd_megakernel, hipFuncAttributeMaxDynamicSharedMemorySize, LDS_BYTES) != hipSuccess) {
      fprintf(stderr, "hipFuncSetAttribute(%d B dynamic LDS) failed\n", LDS_BYTES);
      return;
    }
    if (hipOccupancyMaxActiveBlocksPerMultiprocessor(&per_cu, (const void*)fwd_megakernel, NT, LDS_BYTES) != hipSuccess || per_cu < 1) {
      fprintf(stderr, "occupancy query failed / kernel not resident\n");
      return;
    }
    grid_blocks = cus;
  }
  Params p{};
  for (int i = 0; i < 42; i++) p.in[i] = (const float*)d_in[i];
  p.out = (float*)d_out;
  p.ws = (char*)d_ws;
  if (ws_size < B_END + (8u << 20)) { fprintf(stderr, "workspace too small\n"); return; }
  int ph0 = 0, ph1 = NPH;
  int dryflag = 1;
  void* args[] = {&p, &ph0, &ph1, &dryflag};
  hipError_t e = hipLaunchCooperativeKernel((void*)fwd_megakernel, dim3(grid_blocks), dim3(NT), args, LDS_BYTES, stream);
  if (e != hipSuccess) fprintf(stderr, "cooperative launch failed: %s (grid %d)\n", hipGetErrorString(e), grid_blocks);
}
```

```cpp
#include <hip/hip_runtime.h>
#include <hip/hip_cooperative_groups.h>
#include <stdint.h>
#include <cstdio>
namespace cg = cooperative_groups;

#ifndef MULTI_LAUNCH
#define MULTI_LAUNCH 0
#endif

typedef unsigned short bf16;
using bf16x8 = __attribute__((ext_vector_type(8))) short;
using f32x4 = __attribute__((ext_vector_type(4))) float;
using f32x16 = __attribute__((ext_vector_type(16))) float;

#define DEV __device__ __forceinline__
constexpr int NT = 512, NW = 8;

constexpr int DM = 2048, ML = 16384, MC = 1024, MT = 17408, NIN = 11744, DFF = 8192, NKEY = 4352;
constexpr int C_CQ = 0, C_CKV = 512, C_KR = 1024, C_R = 1088, C_WD = 4160, C_AD = 4288, C_GD = 4416, C_U = 4576, C_GATE = 5600;

constexpr size_t OW_IN = 0;
constexpr size_t OW_UQ = OW_IN + (size_t)NIN * 2048;
constexpr size_t OW_UKV = OW_UQ + 1536 * 512;
constexpr size_t OW_W2 = OW_UKV + 2048 * 512;
constexpr size_t OW_A2 = OW_W2 + 2 * 1024 * 64;
constexpr size_t OW_G2 = OW_A2 + 2 * 1024 * 64;
constexpr size_t OW_GLU = OW_G2 + 1024 * 192;
constexpr size_t OW_BR = OW_GLU + 1024 * 1024;
constexpr size_t OW_OUT = OW_BR + (size_t)3 * 2048 * 1024;
constexpr size_t OW_M1 = OW_OUT + (size_t)2048 * 2048;
constexpr size_t OW_M2 = OW_M1 + (size_t)8192 * 2048;
constexpr size_t OW_END = OW_M2 + (size_t)8192 * 2048;

constexpr size_t SZ1K = (size_t)MT * 1024 * 2;
constexpr size_t B_WB = 0;
constexpr size_t B_HB = B_WB + OW_END * 2;
constexpr size_t B_ZB = B_HB + (size_t)MT * 2048 * 2;
constexpr size_t B_QB = B_ZB + (size_t)MT * NIN * 2;
constexpr size_t B_KN = B_QB + (size_t)MT * 1536 * 2;
constexpr size_t B_VT = B_KN + SZ1K;
constexpr size_t B_KR = B_VT + SZ1K;
constexpr size_t B_AF = B_KR + (size_t)MT * 64 * 2;
constexpr size_t B_AB = B_AF + SZ1K;
constexpr size_t B_GB = B_AB + SZ1K;
constexpr size_t B_SY = B_GB + SZ1K;
constexpr size_t B_XC = B_SY + SZ1K;
constexpr size_t B_MOD = B_XC + (size_t)MC * 2048 * 4;
constexpr size_t B_CNT = B_MOD + (size_t)2 * 5 * 12288 * 4;
constexpr size_t B_FLG = B_CNT + 256;
constexpr size_t B_END = B_FLG + 4096;

struct Params {
  const float* in[42];
  float* out;
  char* ws;
};

typedef __attribute__((ext_vector_type(2))) __bf16 hbf2;
DEV bf16 f2bf(float f) {
  __bf16 h = (__bf16)f;
  return *(unsigned short*)&h;
}
DEV float bf2f(bf16 h) { return __uint_as_float(((uint32_t)h) << 16); }
DEV uint32_t pack2(float a, float b) {
  hbf2 v;
  v[0] = (__bf16)a;
  v[1] = (__bf16)b;
  return *(uint32_t*)&v;
}
DEV float wsum(float v) {
#pragma unroll
  for (int o = 32; o > 0; o >>= 1) v += __shfl_xor(v, o);
  return v;
}
DEV float dpp_xor1(float v) {
  int i = __float_as_int(v);
  return __int_as_float(__builtin_amdgcn_update_dpp(i, i, 0xB1, 0xF, 0xF, false));
}
DEV float dpp_xor2(float v) {
  int i = __float_as_int(v);
  return __int_as_float(__builtin_amdgcn_update_dpp(i, i, 0x4E, 0xF, 0xF, false));
}
DEV float sigmoidf_(float x) { return __builtin_amdgcn_rcpf(1.f + __expf(-x)); }

DEV void phase_mod(int tidv, int bidv, const Params& p, char* smem) {
  float* s_in = (float*)smem;
  float* red = s_in + 5 * 2048;
  float* mod = (float*)(p.ws + B_MOD);
  for (int i = tidv; i < 5 * 2048; i += NT) {
    int r = i >> 11, k = i & 2047;
    float v = r < 4 ? p.in[1][r * 2048 + k] : p.in[3][k];
    s_in[i] = v / (1.f + expf(-v));
  }
  __syncthreads();
  int kg = tidv >> 6, c = tidv & 63;
  for (int task = bidv; task < 2 * 192; task += gridDim.x) {
    int l = task / 192, n = (task % 192) * 64 + c;
    const float* w = p.in[4] + (size_t)l * 2048 * 12288 + n;
    float a0 = 0, a1 = 0, a2 = 0, a3 = 0, a4 = 0;
    int kb = kg * 256;
#pragma unroll 8
    for (int k = 0; k < 256; k++) {
      float wv = w[(size_t)(kb + k) * 12288];
      a0 += s_in[kb + k] * wv;
      a1 += s_in[2048 + kb + k] * wv;
      a2 += s_in[4096 + kb + k] * wv;
      a3 += s_in[6144 + kb + k] * wv;
      a4 += s_in[8192 + kb + k] * wv;
    }
    red[(kg * 5 + 0) * 64 + c] = a0;
    red[(kg * 5 + 1) * 64 + c] = a1;
    red[(kg * 5 + 2) * 64 + c] = a2;
    red[(kg * 5 + 3) * 64 + c] = a3;
    red[(kg * 5 + 4) * 64 + c] = a4;
    __syncthreads();
    if (kg == 0) {
      float bias = p.in[5][l * 12288 + n];
#pragma unroll
      for (int r = 0; r < 5; r++) {
        float v = 0.f;
#pragma unroll
        for (int g = 0; g < 8; g++) v += red[(g * 5 + r) * 64 + c];
        mod[(size_t)(l * 5 + r) * 12288 + n] = v + bias;
      }
    }
    __syncthreads();
  }
}

DEV void convT(int tidv, int bidv, const float* __restrict__ src, bf16* __restrict__ dst, int K, int N, const float* __restrict__ gain, char* smem, int dK = 0) {
  if (dK == 0) dK = K;
  float* t = (float*)smem;
  int tk = (K + 63) >> 6, tn = (N + 63) >> 6;
  for (int tile = bidv; tile < tk * tn; tile += gridDim.x) {
    int k0 = (tile / tn) * 64, n0 = (tile % tn) * 64;
    __syncthreads();
#pragma unroll 4
    for (int i = 0; i < 8; i++) {
      int kk = i * 8 + (tidv >> 6), nn = tidv & 63;
      float v = 0.f;
      if (k0 + kk < K && n0 + nn < N) {
        v = src[(size_t)(k0 + kk) * N + n0 + nn];
        if (gain) v *= gain[k0 + kk];
      }
      t[kk * 65 + nn] = v;
    }
    __syncthreads();
    {
      int c = tidv;
      int nn = c >> 3, kc = c & 7;
      if (n0 + nn < N && k0 + kc * 8 < dK) {
        uint4 o;
        o.x = pack2(t[(kc * 8 + 0) * 65 + nn], t[(kc * 8 + 1) * 65 + nn]);
        o.y = pack2(t[(kc * 8 + 2) * 65 + nn], t[(kc * 8 + 3) * 65 + nn]);
        o.z = pack2(t[(kc * 8 + 4) * 65 + nn], t[(kc * 8 + 5) * 65 + nn]);
        o.w = pack2(t[(kc * 8 + 6) * 65 + nn], t[(kc * 8 + 7) * 65 + nn]);
        *(uint4*)(dst + (size_t)(n0 + nn) * dK + k0 + kc * 8) = o;
      }
    }
  }
}

DEV void phase_convw(int tidv, int bidv, const Params& p, int l, char* smem) {
  bf16* wb = (bf16*)(p.ws + B_WB);
  convT(tidv, bidv, p.in[8] + (size_t)l * 2048 * NIN, wb + OW_IN, 2048, NIN, nullptr, smem);
  convT(tidv, bidv, p.in[40] + (size_t)l * 2048 * 8192, wb + OW_M1, 2048, 8192, nullptr, smem);
  convT(tidv, bidv, p.in[41] + (size_t)l * 8192 * 2048, wb + OW_M2, 8192, 2048, nullptr, smem);
  for (int n = 0; n < 3; n++)
    convT(tidv, bidv, p.in[38] + (size_t)(l * 3 + n) * 1024 * 2048, wb + OW_BR + (size_t)n * 2048 * 1024, 1024, 2048, nullptr, smem);
  convT(tidv, bidv, p.in[39] + (size_t)l * 2048 * 2048, wb + OW_OUT, 2048, 2048, nullptr, smem);
  convT(tidv, bidv, p.in[11] + (size_t)l * 512 * 1536, wb + OW_UQ, 512, 1536, p.in[9] + l * 512, smem);
  convT(tidv, bidv, p.in[12] + (size_t)l * 512 * 2048, wb + OW_UKV, 512, 2048, p.in[10] + l * 512, smem);
  convT(tidv, bidv, p.in[36] + (size_t)l * 1024 * 1024, wb + OW_GLU, 1024, 1024, nullptr, smem);
  for (int d = 0; d < 2; d++) {
    convT(tidv, bidv, p.in[19] + (size_t)(l * 2 + d) * 64 * 1024, wb + OW_W2 + (size_t)d * 65536, 64, 1024, nullptr, smem);
    convT(tidv, bidv, p.in[21] + (size_t)(l * 2 + d) * 64 * 1024, wb + OW_A2 + (size_t)d * 65536, 64, 1024, nullptr, smem);
  }
  convT(tidv, bidv, p.in[22] + (size_t)l * 160 * 1024, wb + OW_G2, 160, 1024, nullptr, smem, 192);
}

DEV void phase_norm(int tidv, int bidv, const float* xlat, const float* xctx, const float* g, const float* mod, int shOff, int scOff, bf16* H, int nrows) {
  int wave = tidv >> 6, lane = tidv & 63;
  for (int row = bidv * NW + wave; row < nrows; row += gridDim.x * NW) {
    const float* x = row < ML ? xlat + (size_t)row * 2048 : xctx + (size_t)(row - ML) * 2048;
    int b = row < ML ? (row >> 12) : 4;
    const float* sh = mod + b * 12288 + shOff;
    const float* sc = mod + b * 12288 + scOff;
    float4 v[8];
    float ss = 0.f;
#pragma unroll
    for (int i = 0; i < 8; i++) {
      v[i] = *(const float4*)(x + i * 256 + lane * 4);
      ss += v[i].x * v[i].x + v[i].y * v[i].y + v[i].z * v[i].z + v[i].w * v[i].w;
    }
    ss = wsum(ss);
    float rinv = rsqrtf(ss * (1.f / 2048.f) + 1e-6f);
#pragma unroll
    for (int i = 0; i < 8; i++) {
      int c = i * 256 + lane * 4;
      float4 g4 = *(const float4*)(g + c), s4 = *(const float4*)(sc + c), h4 = *(const float4*)(sh + c);
      float y0 = v[i].x * rinv * g4.x * (1.f + s4.x) + h4.x;
      float y1 = v[i].y * rinv * g4.y * (1.f + s4.y) + h4.y;
      float y2 = v[i].z * rinv * g4.z * (1.f + s4.z) + h4.z;
      float y3 = v[i].w * rinv * g4.w * (1.f + s4.w) + h4.w;
      uint2 o;
      o.x = pack2(y0, y1);
      o.y = pack2(y2, y3);
      *(uint2*)(H + (size_t)row * 2048 + c) = o;
    }
  }
}

constexpr int LDT = 72;
constexpr int GA_BYTES = 256 * LDT * 2;
constexpr int GSTAGE = 512 * LDT * 2;
constexpr int SM_RINV = 2 * GSTAGE;
constexpr int SM_ITEM = SM_RINV + 1024;
constexpr int LDS_BYTES = SM_ITEM + 16;
DEV float sumsq8(uint4 r) {
  float s = 0.f, x;
  x = bf2f((bf16)(r.x & 0xffff)); s += x * x; x = bf2f((bf16)(r.x >> 16)); s += x * x;
  x = bf2f((bf16)(r.y & 0xffff)); s += x * x; x = bf2f((bf16)(r.y >> 16)); s += x * x;
  x = bf2f((bf16)(r.z & 0xffff)); s += x * x; x = bf2f((bf16)(r.z >> 16)); s += x * x;
  x = bf2f((bf16)(r.w & 0xffff)); s += x * x; x = bf2f((bf16)(r.w >> 16)); s += x * x;
  return s;
}

template <bool ROWNORM>
DEV void gemm_mainloop(int tidv, int bidv, const bf16* __restrict__ A, int lda, bool amap, const bf16* __restrict__ Bt, int K, int N, int m0, int n0,
                       char* smem, f32x16 (&acc)[4][2]) {
  float* srinv = (float*)(smem + SM_RINV);
  const int tid = tidv, lane = tid & 63, wave = tid >> 6;
  const int wm = wave >> 2, wn = wave & 3;
  const int lr = tid >> 3, kc = tid & 7;
  const char* abase = (const char*)(A + (size_t)m0 * lda);
  const char* bbase = (const char*)(Bt + (size_t)n0 * K);
  const uint32_t voa = (uint32_t)(lr * lda + kc * 8) * 2u;
  const uint32_t astep = (uint32_t)(64 * lda) * 2u;
  const uint32_t vob0 = (uint32_t)(lr * K + kc * 8) * 2u;
  const uint32_t bstep = (uint32_t)(64 * K) * 2u;
  const uint32_t lds_st = (uint32_t)(lr * LDT + kc * 8) * 2u;
  const int nk = K >> 6;
  uint4 xa0, xa1, xa2, xa3, xb0, xb1, xb2, xb3;
#define G_LOAD(KT)                                                         \
  {                                                                        \
    const int k0_ = (KT) << 6;                                             \
    const int ka_ = amap ? ((k0_ >> 7) * 192 + (k0_ & 127)) : k0_;         \
    xa0 = *(const uint4*)(abase + (size_t)ka_ * 2 + voa);                  \
    xa1 = *(const uint4*)(abase + (size_t)ka_ * 2 + astep + voa);          \
    xa2 = *(const uint4*)(abase + (size_t)ka_ * 2 + 2 * astep + voa);      \
    xa3 = *(const uint4*)(abase + (size_t)ka_ * 2 + 3 * astep + voa);      \
    xb0 = *(const uint4*)(bbase + (size_t)k0_ * 2 + vob0);                 \
    xb1 = *(const uint4*)(bbase + (size_t)k0_ * 2 + bstep + vob0);         \
    xb2 = *(const uint4*)(bbase + (size_t)k0_ * 2 + 2 * bstep + vob0);     \
    xb3 = *(const uint4*)(bbase + (size_t)k0_ * 2 + 3 * bstep + vob0);     \
  }
#define G_STORE(SN)                                                  \
  *(uint4*)((SN) + lds_st) = xa0;                                    \
  *(uint4*)((SN) + 1 * (64 * LDT * 2) + lds_st) = xa1;               \
  *(uint4*)((SN) + 2 * (64 * LDT * 2) + lds_st) = xa2;               \
  *(uint4*)((SN) + 3 * (64 * LDT * 2) + lds_st) = xa3;               \
  *(uint4*)((SN) + GA_BYTES + lds_st) = xb0;                         \
  *(uint4*)((SN) + GA_BYTES + 1 * (64 * LDT * 2) + lds_st) = xb1;    \
  *(uint4*)((SN) + GA_BYTES + 2 * (64 * LDT * 2) + lds_st) = xb2;    \
  *(uint4*)((SN) + GA_BYTES + 3 * (64 * LDT * 2) + lds_st) = xb3;
  const uint32_t fa = (uint32_t)((wm * 128 + (lane & 31)) * LDT + (lane >> 5) * 8) * 2u;
  const uint32_t fb = (uint32_t)GA_BYTES + (uint32_t)((wn * 64 + (lane & 31)) * LDT + (lane >> 5) * 8) * 2u;
  const int nkm = nk - 1;
  if (ROWNORM) {
    __syncthreads();
#pragma unroll 1
    for (int i = 0; i < 4; i++) {
      float ss = 0.f;
      for (int kk = 0; kk < nk; kk++) ss += sumsq8(*(const uint4*)(abase + (size_t)kk * 128 + i * astep + voa));
      ss += __shfl_xor(ss, 1); ss += __shfl_xor(ss, 2); ss += __shfl_xor(ss, 4);
      if (kc == 0) srinv[lr + 64 * i] = rsqrtf(ss / (float)K + 1e-6f);
    }
  }
  G_LOAD(0)
  __syncthreads();
  G_STORE(smem)
  G_LOAD((1 < nkm ? 1 : nkm))
  __syncthreads();
#define G_FRAG(P, ST, KS)                                                            \
  P##a0 = *(const bf16x8*)((ST) + fa + 0 * (32 * LDT * 2) + (KS) * 32);                \
  P##a1 = *(const bf16x8*)((ST) + fa + 1 * (32 * LDT * 2) + (KS) * 32);                \
  P##a2 = *(const bf16x8*)((ST) + fa + 2 * (32 * LDT * 2) + (KS) * 32);                \
  P##a3 = *(const bf16x8*)((ST) + fa + 3 * (32 * LDT * 2) + (KS) * 32);                \
  P##b0 = *(const bf16x8*)((ST) + fb + 0 * (32 * LDT * 2) + (KS) * 32);                \
  P##b1 = *(const bf16x8*)((ST) + fb + 1 * (32 * LDT * 2) + (KS) * 32);
#define G_MMA(P)                                                                              \
  acc[0][0] = __builtin_amdgcn_mfma_f32_32x32x16_bf16(P##b0, P##a0, acc[0][0], 0, 0, 0);      \
  acc[0][1] = __builtin_amdgcn_mfma_f32_32x32x16_bf16(P##b1, P##a0, acc[0][1], 0, 0, 0);      \
  acc[1][0] = __builtin_amdgcn_mfma_f32_32x32x16_bf16(P##b0, P##a1, acc[1][0], 0, 0, 0);      \
  acc[1][1] = __builtin_amdgcn_mfma_f32_32x32x16_bf16(P##b1, P##a1, acc[1][1], 0, 0, 0);      \
  acc[2][0] = __builtin_amdgcn_mfma_f32_32x32x16_bf16(P##b0, P##a2, acc[2][0], 0, 0, 0);      \
  acc[2][1] = __builtin_amdgcn_mfma_f32_32x32x16_bf16(P##b1, P##a2, acc[2][1], 0, 0, 0);      \
  acc[3][0] = __builtin_amdgcn_mfma_f32_32x32x16_bf16(P##b0, P##a3, acc[3][0], 0, 0, 0);      \
  acc[3][1] = __builtin_amdgcn_mfma_f32_32x32x16_bf16(P##b1, P##a3, acc[3][1], 0, 0, 0);
  bf16x8 pa0, pa1, pa2, pa3, pb0, pb1, qa0, qa1, qa2, qa3, qb0, qb1;
#pragma unroll 1
  for (int kt = 0; kt < nk; kt++) {
    const char* st = smem + (kt & 1) * GSTAGE;
    char* sn = smem + ((kt + 1) & 1) * GSTAGE;
    if (!ROWNORM) {
      G_FRAG(p, st, 0)
      G_FRAG(q, st, 1)
      __builtin_amdgcn_sched_barrier(0);
      G_MMA(p)
      __builtin_amdgcn_sched_barrier(0);
      G_FRAG(p, st, 2)
      __builtin_amdgcn_sched_barrier(0);
      G_MMA(q)
      __builtin_amdgcn_sched_barrier(0);
      G_FRAG(q, st, 3)
      if (kt + 1 < nk) { G_STORE(sn) }
      G_LOAD((kt + 2 < nkm ? kt + 2 : nkm))
      __builtin_amdgcn_sched_barrier(0);
      G_MMA(p)
      __builtin_amdgcn_sched_barrier(0);
      G_MMA(q)
    } else {
      G_FRAG(p, st, 0)
      __builtin_amdgcn_sched_barrier(0);
      G_MMA(p)
      __builtin_amdgcn_sched_barrier(0);
      G_FRAG(p, st, 1)
      __builtin_amdgcn_sched_barrier(0);
      G_MMA(p)
      __builtin_amdgcn_sched_barrier(0);
      G_FRAG(p, st, 2)
      if (kt + 1 < nk) { G_STORE(sn) }
      G_LOAD((kt + 2 < nkm ? kt + 2 : nkm))
      __builtin_amdgcn_sched_barrier(0);
      G_MMA(p)
      __builtin_amdgcn_sched_barrier(0);
      G_FRAG(p, st, 3)
      __builtin_amdgcn_sched_barrier(0);
      G_MMA(p)
    }
    __syncthreads();
  }
#undef G_FRAG
#undef G_MMA
#undef G_LOAD
#undef G_STORE
}

DEV void zero_acc(f32x16 (&acc)[4][2]) {
#pragma unroll
  for (int i = 0; i < 4; i++)
#pragma unroll
    for (int j = 0; j < 2; j++)
#pragma unroll
      for (int e = 0; e < 16; e++) acc[i][j][e] = 0.f;
}

template <class F>
DEV void epi_loop(int tidv, int bidv, f32x16 (&acc)[4][2], int m0, int n0, int N, F f) {
  const int lane = tidv & 63, wave = tidv >> 6;
  const int wm = wave >> 2, wn = wave & 3;
#pragma unroll
  for (int i = 0; i < 4; i++) {
    const int lrow = wm * 128 + i * 32 + (lane & 31);
#pragma unroll
    for (int j = 0; j < 2; j++) {
#pragma unroll
      for (int g = 0; g < 4; g++) {
        int col = n0 + wn * 64 + j * 32 + 8 * g + 4 * (lane >> 5);
        f32x4 v = {acc[i][j][4 * g], acc[i][j][4 * g + 1], acc[i][j][4 * g + 2], acc[i][j][4 * g + 3]};
        if (col < N) f(m0 + lrow, lrow, col, v);
      }
    }
    __builtin_amdgcn_sched_barrier(0);
  }
}

DEV uint2 pack4(f32x4 v) {
  uint2 o;
  o.x = pack2(v[0], v[1]);
  o.y = pack2(v[2], v[3]);
  return o;
}
DEV f32x4 unpack4(uint2 u) {
  f32x4 v;
  v[0] = bf2f((bf16)(u.x & 0xffff)); v[1] = bf2f((bf16)(u.x >> 16));
  v[2] = bf2f((bf16)(u.y & 0xffff)); v[3] = bf2f((bf16)(u.y >> 16));
  return v;
}

enum { G_IN = 0, G_UQ, G_UKV, G_W2, G_A2, G_G2, G_GLU, G_OUT, G_M1, G_M2, G_MG0, G_MG1, G_MG2 };

template <int MODE>
DEV void run_gemm(int tidv, int bidv, const Params& p, int l, char* smem, const bf16* A, int lda, const bf16* Bt, int K, int N, int M, int aux,
                  const float* xin_lat, const float* xin_ctx, float* xout_lat, float* xout_ctx) {
  const int nt = (N + 255) >> 8, mt = M >> 8;
  char* ws = p.ws;
  bf16* Z = (bf16*)(ws + B_ZB);
  const float* srinv = (const float*)(smem + SM_RINV);
  const float* mod = (const float*)(ws + B_MOD) + (size_t)l * 5 * 12288;
  for (int tile = bidv; tile < nt * mt; tile += gridDim.x) {
    int m0 = (tile / nt) << 8, n0 = (tile % nt) << 8;
    f32x16 acc[4][2];
    zero_acc(acc);
    gemm_mainloop<(MODE == G_UQ || MODE == G_UKV)>(tidv, bidv, A, lda, MODE == G_MG0, Bt, K, N, m0, n0, smem, acc);
    epi_loop(tidv, bidv, acc, m0, n0, N, [&](int row, int lrow, int col, f32x4 v) {
      if constexpr (MODE == G_IN) {
        f32x4 o = v;
        if (col >= C_GATE || (col >= C_GD && col < C_U)) {
#pragma unroll
          for (int r = 0; r < 4; r++) o[r] = sigmoidf_(v[r]);
        } else if (col >= C_WD && col < C_AD) {
#pragma unroll
          for (int r = 0; r < 4; r++) o[r] = tanhf(v[r]);
        }
        *(uint2*)(smem + ((size_t)lrow * 264 + (col - n0)) * 2) = pack4(o);
      } else if constexpr (MODE == G_UQ) {
        float ri = srinv[lrow];
        *(uint2*)((bf16*)(ws + B_QB) + (size_t)row * 1536 + col) = pack4(v * ri);
      } else if constexpr (MODE == G_UKV) {
        float ri = srinv[lrow];
        f32x4 o = v * ri;
        int h = col >> 8, c = col & 255;
        if (c < 128) {
          *(uint2*)((bf16*)(ws + B_KN) + (size_t)row * 1024 + h * 128 + c) = pack4(o);
        } else {
          int b, kp;
          if (row < ML) { b = row >> 12; kp = row & 4095; } else { int r2 = row - ML; b = r2 >> 8; kp = 4096 + (r2 & 255); }
          bf16* vt = (bf16*)(ws + B_VT) + ((size_t)((b * 8 + h) * 128 + (c - 128))) * NKEY + kp;
#pragma unroll
          for (int r = 0; r < 4; r++) vt[(size_t)r * NKEY] = f2bf(o[r]);
        }
      } else if constexpr (MODE == G_W2) {
        float4 w0 = *(const float4*)(p.in[18] + (l * 2 + aux) * 1024 + col);
        f32x4 o;
        o[0] = 0.60653066f * sigmoidf_(w0.x + v[0]);
        o[1] = 0.60653066f * sigmoidf_(w0.y + v[1]);
        o[2] = 0.60653066f * sigmoidf_(w0.z + v[2]);
        o[3] = 0.60653066f * sigmoidf_(w0.w + v[3]);
        *(uint2*)((bf16*)(ws + B_HB + (size_t)aux * SZ1K) + (size_t)row * 1024 + col) = pack4(o);
      } else if constexpr (MODE == G_A2) {
        float4 a0 = *(const float4*)(p.in[20] + (l * 2 + aux) * 1024 + col);
        f32x4 o;
        o[0] = sigmoidf_(a0.x + v[0]);
        o[1] = sigmoidf_(a0.y + v[1]);
        o[2] = sigmoidf_(a0.z + v[2]);
        o[3] = sigmoidf_(a0.w + v[3]);
        *(uint2*)((bf16*)(ws + (aux ? B_AB : B_AF)) + (size_t)row * 1024 + col) = pack4(o);
      } else if constexpr (MODE == G_G2) {
        *(uint2*)((bf16*)(ws + B_GB) + (size_t)row * 1024 + col) = pack4(v);
      } else if constexpr (MODE == G_GLU) {
        f32x4 zz = unpack4(*(const uint2*)((const bf16*)(ws + B_SY) + (size_t)row * 1024 + col));
        float4 gb = *(const float4*)(p.in[37] + l * 1024 + col);
        f32x4 o;
        o[0] = zz[0] * sigmoidf_(v[0] + gb.x);
        o[1] = zz[1] * sigmoidf_(v[1] + gb.y);
        o[2] = zz[2] * sigmoidf_(v[2] + gb.z);
        o[3] = zz[3] * sigmoidf_(v[3] + gb.w);
        *(uint2*)(smem + ((size_t)lrow * 264 + (col - n0)) * 2) = pack4(o);
      } else if constexpr (MODE == G_OUT) {
        int b = row < ML ? (row >> 12) : 4;
        float4 g = *(const float4*)(mod + b * 12288 + 4096 + col);
        const float* xi = row < ML ? xin_lat + (size_t)row * 2048 : xin_ctx + (size_t)(row - ML) * 2048;
        float* xo = row < ML ? xout_lat + (size_t)row * 2048 : xout_ctx + (size_t)(row - ML) * 2048;
        float4 x = *(const float4*)(xi + col);
        x.x += g.x * v[0]; x.y += g.y * v[1]; x.z += g.z * v[2]; x.w += g.w * v[3];
        *(float4*)(xo + col) = x;
      } else if constexpr (MODE == G_M1) {
        f32x4 o;
#pragma unroll
        for (int r = 0; r < 4; r++) { float t = fmaxf(v[r], 0.f); o[r] = t * t; }
        *(uint2*)(smem + ((size_t)lrow * 264 + (col - n0)) * 2) = pack4(o);
      } else if constexpr (MODE == G_MG0 || MODE == G_MG1 || MODE == G_MG2) {
        *(uint2*)(smem + ((size_t)lrow * 264 + (col - n0)) * 2) = pack4(v);
      } else if constexpr (MODE == G_M2) {
        int b = row < ML ? (row >> 12) : 4;
        float4 g = *(const float4*)(mod + b * 12288 + 10240 + col);
        float* xo = row < ML ? xout_lat + (size_t)row * 2048 : xout_ctx + (size_t)(row - ML) * 2048;
        float4 x = *(const float4*)(xo + col);
        x.x += g.x * v[0]; x.y += g.y * v[1]; x.z += g.z * v[2]; x.w += g.w * v[3];
        *(float4*)(xo + col) = x;
      }
    });
    if constexpr (MODE == G_MG0 || MODE == G_MG1 || MODE == G_MG2) {
      constexpr int nb = MODE - G_MG0;
      bf16* MG = (bf16*)(ws + B_HB);
      __syncthreads();
#pragma unroll 2
      for (int it = 0; it < 16; it++) {
        int c = it * NT + tidv;
        int r = c >> 5, ch = c & 31;
        int col = n0 + ch * 8;
        uint4 pv = *(const uint4*)(smem + ((size_t)r * 264 + ch * 8) * 2);
        uint4 gv = *(const uint4*)(Z + (size_t)(m0 + r) * NIN + C_GATE + nb * 2048 + col);
        f32x4 p0 = unpack4(uint2{pv.x, pv.y}), p1 = unpack4(uint2{pv.z, pv.w});
        f32x4 g0 = unpack4(uint2{gv.x, gv.y}), g1 = unpack4(uint2{gv.z, gv.w});
        f32x4 o0 = g0 * p0, o1 = g1 * p1;
        if constexpr (nb > 0) {
          uint4 qv = *(const uint4*)(MG + (size_t)(m0 + r) * 2048 + col);
          o0 += unpack4(uint2{qv.x, qv.y});
          o1 += unpack4(uint2{qv.z, qv.w});
        }
        uint2 a = pack4(o0), b = pack4(o1);
        *(uint4*)(MG + (size_t)(m0 + r) * 2048 + col) = uint4{a.x, a.y, b.x, b.y};
      }
    }
    if constexpr (MODE == G_IN || MODE == G_GLU || MODE == G_M1) {
      bf16* dst;
      int ld;
      if constexpr (MODE == G_IN || MODE == G_GLU) { dst = Z; ld = NIN; }
      else { dst = Z; ld = DFF; }
      __syncthreads();
#pragma unroll 4
      for (int it = 0; it < 16; it++) {
        int c = it * NT + tidv;
        int r = c >> 5, ch = c & 31;
        int col = n0 + ch * 8;
        if (col < N) *(uint4*)(dst + (size_t)(m0 + r) * ld + col) = *(const uint4*)(smem + ((size_t)r * 264 + ch * 8) * 2);
      }
    }
  }
}

DEV void phase_mla_post(int tidv, int bidv, const Params& p, int l) {
  char* ws = p.ws;
  const float* qng = p.in[13] + l * 128;
  const float* qrg = p.in[14] + l * 64;
  const float* kng = p.in[15] + l * 128;
  const float* krg = p.in[16] + l * 64;
  bf16* QB = (bf16*)(ws + B_QB);
  bf16* KN = (bf16*)(ws + B_KN);
  bf16* KR = (bf16*)(ws + B_KR);
  const bf16* Z = (const bf16*)(ws + B_ZB);
  const int wave = tidv >> 6, lane = tidv & 63;
  const float QS = 1.4426950408889634f * 0.07216878364870322f;
  const int idx = lane & 31;
  const float inv = powf(10000.f, -(float)(idx & 15) / 16.f);
  const float gq0 = qng[2 * lane], gq1 = qng[2 * lane + 1], gk0 = kng[2 * lane], gk1 = kng[2 * lane + 1];
  const float gqr = qrg[lane], gkr = krg[lane];
  for (int row = bidv * NW + wave; row < MT; row += gridDim.x * NW) {
    bool lat = row < ML;
    int t = row & 4095;
    float pos = (idx < 16) ? (float)(t >> 6) : (float)(t & 63);
    float ang = pos * inv;
    float cs = 1.f, sn = 0.f;
    if (lat) { cs = cosf(ang); sn = sinf(ang); }
#pragma unroll 1
    for (int h = 0; h < 8; h++) {
      bf16* q = QB + (size_t)row * 1536 + h * 192;
      uint32_t u = *(const uint32_t*)(q + 2 * lane);
      float x0 = bf2f((bf16)(u & 0xffff)), x1 = bf2f((bf16)(u >> 16));
      float ss = wsum(x0 * x0 + x1 * x1);
      float rinv = rsqrtf(ss * (1.f / 128.f) + 1e-6f) * QS;
      *(uint32_t*)(q + 2 * lane) = pack2(x0 * rinv * gq0, x1 * rinv * gq1);
      float xr = bf2f(q[128 + lane]);
      float ss2 = wsum(xr * xr);
      float y = xr * rsqrtf(ss2 * (1.f / 64.f) + 1e-6f) * gqr;
      float yp = __shfl_xor(y, 32);
      float o = lane < 32 ? (y * cs - yp * sn) : (yp * sn + y * cs);
      q[128 + lane] = f2bf(o * QS);
      bf16* k = KN + (size_t)row * 1024 + h * 128;
      uint32_t uk = *(const uint32_t*)(k + 2 * lane);
      float k0 = bf2f((bf16)(uk & 0xffff)), k1 = bf2f((bf16)(uk >> 16));
      float ssk = wsum(k0 * k0 + k1 * k1);
      float rk = rsqrtf(ssk * (1.f / 128.f) + 1e-6f);
      *(uint32_t*)(k + 2 * lane) = pack2(k0 * rk * gk0, k1 * rk * gk1);
    }
    {
      float xr = bf2f(Z[(size_t)row * NIN + C_KR + lane]);
      float ss2 = wsum(xr * xr);
      float y = xr * rsqrtf(ss2 * (1.f / 64.f) + 1e-6f) * gkr;
      float yp = __shfl_xor(y, 32);
      float o = lane < 32 ? (y * cs - yp * sn) : (yp * sn + y * cs);
      KR[(size_t)row * 64 + lane] = f2bf(o);
    }
  }
}

DEV void step_row(int s, int d, int b, int& row, int& tau, int& len) {
  if (s < 256) { tau = d ? 255 - s : s; len = 256; row = ML + b * 256 + tau; }
  else { int q = s - 256; tau = d ? 4095 - q : q; len = 4096; row = b * 4096 + tau; }
}

struct RwPre { bf16 r0, r1, r2, k0, k1, k2, v0, v1, v2, a, e; };

DEV void rwkv_fetch(RwPre& q, const bf16* Z, const bf16* AD, const bf16* ED, int s, int d, int b, int ch) {
  int row, tau, len;
  step_row(s, d, b, row, tau, len);
  const bf16* z = Z + (size_t)row * NIN + C_R + ch;
  q.r1 = z[0]; q.k1 = z[1024]; q.v1 = z[2048];
  q.r0 = 0; q.k0 = 0; q.v0 = 0; q.r2 = 0; q.k2 = 0; q.v2 = 0;
  if (tau > 0) { const bf16* zm = z - NIN; q.r0 = zm[0]; q.k0 = zm[1024]; q.v0 = zm[2048]; }
  if (tau < len - 1) { const bf16* zp = z + NIN; q.r2 = zp[0]; q.k2 = zp[1024]; q.v2 = zp[2048]; }
  q.a = AD[(size_t)row * 1024 + ch];
  q.e = ED[(size_t)row * 1024 + ch];
}

typedef float f2v __attribute__((ext_vector_type(2)));
DEV float dpp_hmirror(float v) {
  int i = __float_as_int(v);
  return __int_as_float(__builtin_amdgcn_update_dpp(i, i, 0x141, 0xF, 0xF, false));
}
DEV f2v lo2(float4 v) { return f2v{v.x, v.y}; }
DEV f2v hi2(float4 v) { return f2v{v.z, v.w}; }

DEV void rwkv_scan(int tidv, int bidv, const Params& p, int l, int chain, char* smem, int dry) {
  char* ws = p.ws;
  float* op = (float*)smem;
  float* vb = op + 16 * 320;
  float* yb = vb + 16 * 64;
  const int tid = tidv, wave = tid >> 6, lane = tid & 63;
  const int d = chain & 1, h = (chain >> 1) & 15, b = chain >> 5;
  const int ch = h * 64 + lane;
  const float* cw = p.in[17] + (size_t)l * 3 * 3072;
  const float cr0 = cw[ch], cr1 = cw[3072 + ch], cr2 = cw[6144 + ch];
  const float ck0 = cw[1024 + ch], ck1 = cw[3072 + 1024 + ch], ck2 = cw[6144 + 1024 + ch];
  const float cv0 = cw[2048 + ch], cv1 = cw[3072 + 2048 + ch], cv2 = cw[6144 + 2048 + ch];
  const float kkc = p.in[23][l * 1024 + ch], kac = p.in[24][l * 1024 + ch];
  const bf16* Z = (const bf16*)(ws + B_ZB);
  bf16* ED = (bf16*)(ws + B_HB + (size_t)d * SZ1K);
  const bf16* AD = (const bf16*)(ws + (d ? B_AB : B_AF));
  f2v S0 = {0.f, 0.f}, S1 = {0.f, 0.f}, S2 = {0.f, 0.f}, S3 = {0.f, 0.f};
  const int ri = lane >> 3, jo = lane & 7, irow = wave * 8 + ri;
  RwPre pre[2];
#pragma unroll
  for (int si = 0; si < 2; si++) rwkv_fetch(pre[si], Z, AD, ED, wave * 2 + si, d, b, ch);
  for (int chunk = 0; chunk < 272; chunk++) {
#pragma unroll
    for (int si = 0; si < 2; si++) {
      int t = wave * 2 + si;
      const RwPre& q = pre[si];
      float rr = cr0 * bf2f(q.r0) + cr1 * bf2f(q.r1) + cr2 * bf2f(q.r2);
      float kk_ = ck0 * bf2f(q.k0) + ck1 * bf2f(q.k1) + ck2 * bf2f(q.k2);
      float vv = cv0 * bf2f(q.v0) + cv1 * bf2f(q.v1) + cv2 * bf2f(q.v2);
      float kkv = kk_ * kkc;
      float ssq = wsum(kkv * kkv);
      float kn = kkv * rsqrtf(ssq + 1e-12f);
      float a = bf2f(q.a);
      float w = __expf(-bf2f(q.e));
      float krep = kk_ * (1.f + (a - 1.f) * kac);
      float* o = op + t * 320;
      o[lane] = w;
      o[64 + lane] = kn * a;
      o[128 + lane] = krep;
      o[192 + lane] = -kn;
      o[256 + lane] = rr;
      vb[t * 64 + lane] = vv;
    }
    __syncthreads();
    if (chunk + 1 < 272) {
#pragma unroll
      for (int si = 0; si < 2; si++) rwkv_fetch(pre[si], Z, AD, ED, (chunk + 1) * 16 + wave * 2 + si, d, b, ch);
    }
    {
      const float4* o4 = (const float4*)(op + jo * 8);
      float4 n0 = o4[48], n1 = o4[49];
#pragma unroll 4
      for (int t = 0; t < 16; t++) {
        const float4* ot = o4 + t * 80;
        const float4 w0 = ot[0], w1 = ot[1];
        const float4 a0 = ot[16], a1 = ot[17];
        const float4 k0 = ot[32], k1 = ot[33];
        const float4 r0 = ot[64], r1 = ot[65];
        const float vi = vb[t * 64 + irow];
        const int tn = t < 15 ? t + 1 : 15;
        const float4* on = o4 + tn * 80;
        const float4 m0 = on[48], m1 = on[49];
        f2v sv = S0 * lo2(n0) + S1 * hi2(n0) + (S2 * lo2(n1) + S3 * hi2(n1));
        float sa = sv.x + sv.y;
        sa += dpp_xor1(sa);
        sa += dpp_xor2(sa);
        sa += dpp_hmirror(sa);
        const f2v sa2 = {sa, sa}, vi2 = {vi, vi};
        S0 = S0 * lo2(w0) + sa2 * lo2(a0) + vi2 * lo2(k0);
        S1 = S1 * hi2(w0) + sa2 * hi2(a0) + vi2 * hi2(k0);
        S2 = S2 * lo2(w1) + sa2 * lo2(a1) + vi2 * lo2(k1);
        S3 = S3 * hi2(w1) + sa2 * hi2(a1) + vi2 * hi2(k1);
        f2v yv = S0 * lo2(r0) + S1 * hi2(r0) + (S2 * lo2(r1) + S3 * hi2(r1));
        float y = yv.x + yv.y;
        y += dpp_xor1(y);
        y += dpp_xor2(y);
        y += dpp_hmirror(y);
        if (jo == 0) yb[t * 64 + irow] = y;
        n0 = m0; n1 = m1;
      }
    }
    __syncthreads();
#pragma unroll
    for (int it = 0; it < 2; it++) {
      int idx = it * NT + tid;
      int t = idx >> 6, i = idx & 63;
      int row, tau, len;
      step_row(chunk * 16 + t, d, b, row, tau, len);
      size_t off = (size_t)row * 1024 + h * 64 + i;
      bf16* yd = dry ? (bf16*)(ws + B_END) + (off & 0x3fffff) : ED + off;
      *yd = f2bf(yb[t * 64 + i]);
    }
  }
}

DEV void s5_scan(int tidv, int bidv, const Params& p, int l, int chain, char* smemw, int dry) {
  char* ws = p.ws;
  const int lane = tidv & 63;
  const int d = chain & 1, g = (chain >> 1) & 63, b = chain >> 7;
  float* ub = (float*)smemw;
  float* hb = ub + 256;
  const size_t pg = (size_t)(l * 2 + d) * 64 + g;
  const float lre = p.in[28][pg * 64 + lane], lim = p.in[29][pg * 64 + lane];
  const float dt = expf(p.in[30][pg]);
  const float mag = expf(lre * dt);
  const float are = mag * cosf(lim * dt), aim = mag * sinf(lim * dt);
  const float den = lre * lre + lim * lim;
  const float qre = ((are - 1.f) * lre + aim * lim) / den;
  const float qim = (aim * lre - (are - 1.f) * lim) / den;
  float bbre[16], bbim[16];
  {
    const float* br = p.in[31] + (pg * 64 + lane) * 16;
    const float* bi = p.in[32] + (pg * 64 + lane) * 16;
#pragma unroll
    for (int i = 0; i < 16; i++) {
      float x = br[i], y = bi[i];
      bbre[i] = qre * x - qim * y;
      bbim[i] = qre * y + qim * x;
    }
  }
  bf16x8 cfr[4];
  {
    const int i = lane & 15, quad = lane >> 4;
    const float* cre = p.in[33] + (pg * 16 + i) * 64;
    const float* cim = p.in[34] + (pg * 16 + i) * 64;
#pragma unroll
    for (int ks = 0; ks < 4; ks++)
#pragma unroll
      for (int j = 0; j < 8; j++) {
        int k = ks * 32 + quad * 8 + j;
        float c = ks < 2 ? cre[k] : -cim[k - 64];
        cfr[ks][j] = (short)f2bf(c);
      }
  }
  float hre = 0.f, him = 0.f;
  const bf16* Z = (const bf16*)(ws + B_ZB);
  const int tt = lane >> 2, i0 = (lane & 3) * 4;
  uint2 unext;
  {
    int row, tau, len;
    step_row(tt, d, b, row, tau, len);
    unext = *(const uint2*)(Z + (size_t)row * NIN + C_U + g * 16 + i0);
  }
  for (int chunk = 0; chunk < 272; chunk++) {
    {
      uint2 u = unext;
      float4 f;
      f.x = bf2f((bf16)(u.x & 0xffff)); f.y = bf2f((bf16)(u.x >> 16));
      f.z = bf2f((bf16)(u.y & 0xffff)); f.w = bf2f((bf16)(u.y >> 16));
      *(float4*)(ub + tt * 16 + i0) = f;
    }
    __syncthreads();
    if (chunk + 1 < 272) {
      int row, tau, len;
      step_row((chunk + 1) * 16 + tt, d, b, row, tau, len);
      unext = *(const uint2*)(Z + (size_t)row * NIN + C_U + g * 16 + i0);
    }
#pragma unroll 2
    for (int t = 0; t < 16; t++) {
      const float* u = ub + t * 16;
      float br0 = 0.f, bi0 = 0.f;
#pragma unroll
      for (int i = 0; i < 16; i++) { float uv = u[i]; br0 += bbre[i] * uv; bi0 += bbim[i] * uv; }
      float nr = are * hre - aim * him + br0;
      float ni = are * him + aim * hre + bi0;
      hre = nr; him = ni;
      hb[t * 132 + lane] = hre;
      hb[t * 132 + 64 + lane] = him;
    }
    __syncthreads();
    {
      f32x4 yacc = {0.f, 0.f, 0.f, 0.f};
      const float* hr = hb + (lane & 15) * 132 + (lane >> 4) * 8;
#pragma unroll
      for (int ks = 0; ks < 4; ks++) {
        float4 x0 = *(const float4*)(hr + ks * 32), x1 = *(const float4*)(hr + ks * 32 + 4);
        union { bf16x8 v; uint32_t u[4]; } af;
        af.u[0] = pack2(x0.x, x0.y); af.u[1] = pack2(x0.z, x0.w);
        af.u[2] = pack2(x1.x, x1.y); af.u[3] = pack2(x1.z, x1.w);
        yacc = __builtin_amdgcn_mfma_f32_16x16x32_bf16(af.v, cfr[ks], yacc, 0, 0, 0);
      }
      const int ii = lane & 15;
#pragma unroll
      for (int r = 0; r < 4; r++) {
        int row, tau, len;
        step_row(chunk * 16 + (lane >> 4) * 4 + r, d, b, row, tau, len);
        bf16* dst = d == 0 ? (bf16*)(ws + B_SY) + (size_t)row * 1024 + g * 16 + ii : (bf16*)(ws + B_ZB) + (size_t)row * NIN + g * 16 + ii;
        if (dry) dst = (bf16*)(ws + B_END) + ((((size_t)row * 1024 + g * 16 + ii)) & 0x3fffff);
        *dst = f2bf(yacc[r]);
      }
    }
    __syncthreads();
  }
}

DEV int perm23(int r) { return (r & 0x13) | ((r & 4) << 1) | ((r & 8) >> 1); }

DEV void attn_item(int tidv, int bidv, const Params& p, int item, bool ctxq, char* smem, int dry) {
  char* ws = p.ws;
  bf16* sK = (bf16*)smem;
  bf16* sV = sK + 64 * 200;
  const int tid = tidv, wave = tid >> 6, lane = tid & 63;
  const int r = lane & 31, hf = lane >> 5;
  int b, hd, qt;
  if (!ctxq) { b = item >> 7; hd = (item >> 4) & 7; qt = item & 15; }
  else { b = item >> 3; hd = item & 7; qt = 0; }
  const int qrow0 = ctxq ? ML + b * 256 : b * 4096 + qt * 256;
  const int kt0 = ctxq ? 64 : 0, kt1 = 68;
  bf16* QB = (bf16*)(ws + B_QB);
  const bf16* KN = (const bf16*)(ws + B_KN);
  const bf16* KR = (const bf16*)(ws + B_KR);
  const bf16* VT = (const bf16*)(ws + B_VT);
  bf16x8 qf[12];
  {
    const bf16* qp = QB + (size_t)(qrow0 + wave * 32 + r) * 1536 + hd * 192 + hf * 8;
#pragma unroll
    for (int kk = 0; kk < 12; kk++) qf[kk] = *(const bf16x8*)(qp + kk * 16);
  }
  f32x16 oacc[4];
#pragma unroll
  for (int i = 0; i < 4; i++)
#pragma unroll
    for (int e = 0; e < 16; e++) oacc[i][e] = 0.f;
  float mrun = -1e30f, lrun = 0.f;
  const int pr = perm23(r);
  for (int kt = kt0; kt < kt1; kt++) {
    __syncthreads();
    const int key0 = kt * 64;
    const int rowbase = key0 < 4096 ? b * 4096 + key0 : ML + b * 256 + (key0 - 4096);
    {
      const char* bk = (const char*)(KN + (size_t)rowbase * 1024 + hd * 128);
      const char* br = (const char*)(KR + (size_t)rowbase * 64);
      const char* bv = (const char*)(VT + ((size_t)((b * 8 + hd) * 128)) * NKEY + key0);
      const uint32_t vo_n = (uint32_t)((tid >> 4) * 2048 + (tid & 15) * 16);
      const uint32_t lo_n = (uint32_t)((tid >> 4) * 400 + (tid & 15) * 16);
      const uint32_t vo_r = (uint32_t)((tid >> 3) * 128 + (tid & 7) * 16);
      const uint32_t lo_r = (uint32_t)((tid >> 3) * 400 + 256 + (tid & 7) * 16);
      const uint32_t vo_v = (uint32_t)((tid >> 3) * (NKEY * 2) + (tid & 7) * 16);
      const uint32_t lo_v = (uint32_t)((tid >> 3) * 144 + (tid & 7) * 16);
      uint4 t0 = *(const uint4*)(bk + vo_n);
      uint4 t1 = *(const uint4*)(bk + 32 * 2048 + vo_n);
      uint4 t4 = *(const uint4*)(br + vo_r);
      uint4 u0 = *(const uint4*)(bv + vo_v);
      uint4 u1 = *(const uint4*)(bv + (size_t)64 * NKEY * 2 + vo_v);
      *(uint4*)((char*)sK + lo_n) = t0;
      *(uint4*)((char*)sK + 32 * 400 + lo_n) = t1;
      *(uint4*)((char*)sK + lo_r) = t4;
      *(uint4*)((char*)sV + lo_v) = u0;
      *(uint4*)((char*)sV + 64 * 144 + lo_v) = u1;
    }
    __syncthreads();
    f32x16 sacc[2];
#pragma unroll
    for (int m = 0; m < 2; m++) {
#pragma unroll
      for (int e = 0; e < 16; e++) sacc[m][e] = 0.f;
      const bf16* kp = sK + (m * 32 + pr) * 200 + hf * 8;
#pragma unroll
      for (int kk = 0; kk < 12; kk++) {
        bf16x8 kf = *(const bf16x8*)(kp + kk * 16);
        sacc[m] = __builtin_amdgcn_mfma_f32_32x32x16_bf16(kf, qf[kk], sacc[m], 0, 0, 0);
        if ((kk & 3) == 3) __builtin_amdgcn_sched_barrier(0);
      }
      __builtin_amdgcn_sched_barrier(0);
    }
    float tmax = sacc[0][0];
#pragma unroll
    for (int e = 1; e < 16; e++) tmax = fmaxf(tmax, sacc[0][e]);
#pragma unroll
    for (int e = 0; e < 16; e++) tmax = fmaxf(tmax, sacc[1][e]);
    tmax = fmaxf(tmax, __shfl_xor(tmax, 32));
    float mnew = fmaxf(mrun, tmax);
    float alpha = __builtin_amdgcn_exp2f(mrun - mnew);
    mrun = mnew;
    float psum = 0.f;
#pragma unroll
    for (int m = 0; m < 2; m++)
#pragma unroll
      for (int e = 0; e < 16; e++) { float pv = __builtin_amdgcn_exp2f(sacc[m][e] - mnew); sacc[m][e] = pv; psum += pv; }
    lrun = lrun * alpha + psum;
#pragma unroll
    for (int i = 0; i < 4; i++)
#pragma unroll
      for (int e = 0; e < 16; e++) oacc[i][e] *= alpha;
#pragma unroll
    for (int s = 0; s < 4; s++) {
      const int m = s >> 1, s2 = s & 1;
      bf16x8 pf;
#pragma unroll
      for (int j = 0; j < 8; j++) pf[j] = (short)f2bf(sacc[m][8 * s2 + j]);
#pragma unroll
      for (int i = 0; i < 4; i++) {
        bf16x8 vf = *(const bf16x8*)(sV + (i * 32 + r) * 72 + m * 32 + s2 * 16 + hf * 8);
        oacc[i] = __builtin_amdgcn_mfma_f32_32x32x16_bf16(vf, pf, oacc[i], 0, 0, 0);
      }
      __builtin_amdgcn_sched_barrier(0);
    }
  }
  lrun += __shfl_xor(lrun, 32);
  const float inv = 1.f / lrun;
  bf16* op = QB + (size_t)(qrow0 + wave * 32 + r) * 1536 + hd * 192;
  if (dry) op = (bf16*)(ws + B_END) + ((((size_t)(qrow0 + wave * 32 + r) * 1536 + hd * 192)) & 0x3ffff8);
#pragma unroll
  for (int i = 0; i < 4; i++)
#pragma unroll
    for (int g = 0; g < 4; g++) {
      uint2 o;
      o.x = pack2(oacc[i][4 * g] * inv, oacc[i][4 * g + 1] * inv);
      o.y = pack2(oacc[i][4 * g + 2] * inv, oacc[i][4 * g + 3] * inv);
      *(uint2*)(op + 32 * i + 8 * g + 4 * hf) = o;
    }
}

DEV void phase_mixers(int tidv, int bidv, const Params& p, int l, char* smem, int dry) {
  int* s_item = (int*)(smem + SM_ITEM);
#ifdef PROBE_PARTS
  const int parts = dry ? PROBE_PARTS : 7;
#else
  const int parts = 7;
#endif
  for (int task = bidv; task < 192; task += gridDim.x) {
    if (task < 128 && !(parts & 1)) continue;
    if (task >= 128 && !(parts & 2)) continue;
    if (task < 128) rwkv_scan(tidv, bidv, p, l, task, smem, dry);
    else s5_scan(tidv, bidv, p, l, (task - 128) * 8 + (tidv >> 6), smem + (tidv >> 6) * 9472, dry);
  }
  const int nlat = 512, ntot = (parts & 4) ? ((l == 0) ? 544 : 512) : 0;
  int* cnt = (int*)(p.ws + B_CNT) + l + 2 * dry;
#if !defined(MIX_ONLY) || MIX_ONLY == 2
  while (true) {
    __syncthreads();
    if (tidv == 0) *s_item = atomicAdd(cnt, 1);
    __syncthreads();
    int item = *s_item;
    if (item >= ntot) break;
    if (item < nlat) attn_item(tidv, bidv, p, item, false, smem, dry);
    else attn_item(tidv, bidv, p, item - nlat, true, smem, dry);
  }
#endif
}

DEV float gelu_tanh(float x) {
  float u = 0.7978845608028654f * (x + 0.044715f * x * x * x);
  return 0.5f * x * (1.f + tanhf(u));
}

DEV void phase_post(int tidv, int bidv, const Params& p, int l, int M) {
  char* ws = p.ws;
  const bf16* Z = (const bf16*)(ws + B_ZB);
  const int wave = tidv >> 6, lane = tidv & 63;
  const float* cw = p.in[17] + (size_t)l * 3 * 3072;
  const bf16* YF = (const bf16*)(ws + B_HB);
  const bf16* YB = (const bf16*)(ws + B_HB + SZ1K);
  const bf16* AF = (const bf16*)(ws + B_AF);
  const bf16* AB = (const bf16*)(ws + B_AB);
  bf16* GB = (bf16*)(ws + B_GB);
  const int nitem = M * 16;
  for (int it = bidv * NW + wave; it < nitem; it += gridDim.x * NW) {
    int row = it >> 4, h = it & 15;
    int ch = h * 64 + lane;
    int tau, len;
    if (row < ML) { tau = row & 4095; len = 4096; } else { tau = (row - ML) & 255; len = 256; }
    size_t o = (size_t)row * 1024 + ch;
    float y = bf2f(YF[o]) + bf2f(YB[o]);
    float mu = wsum(y) * (1.f / 64.f);
    float dv = y - mu;
    float var = wsum(dv * dv) * (1.f / 64.f);
    float yn = dv * rsqrtf(var + 64e-5f) * p.in[26][l * 1024 + ch] + p.in[27][l * 1024 + ch];
    const bf16* z = Z + (size_t)row * NIN + C_R + ch;
    float r1 = bf2f(z[0]), k1 = bf2f(z[1024]), v1 = bf2f(z[2048]);
    float r0 = 0.f, k0 = 0.f, v0 = 0.f, r2 = 0.f, k2 = 0.f, v2 = 0.f;
    if (tau > 0) { const bf16* zm = z - NIN; r0 = bf2f(zm[0]); k0 = bf2f(zm[1024]); v0 = bf2f(zm[2048]); }
    if (tau < len - 1) { const bf16* zp = z + NIN; r2 = bf2f(zp[0]); k2 = bf2f(zp[1024]); v2 = bf2f(zp[2048]); }
    float rr = cw[ch] * r0 + cw[3072 + ch] * r1 + cw[6144 + ch] * r2;
    float kk = cw[1024 + ch] * k0 + cw[3072 + 1024 + ch] * k1 + cw[6144 + 1024 + ch] * k2;
    float vv = cw[2048 + ch] * v0 + cw[3072 + 2048 + ch] * v1 + cw[6144 + 2048 + ch] * v2;
    float am = 0.5f * (bf2f(AF[o]) + bf2f(AB[o]));
    float kbon = kk * (1.f + (am - 1.f) * p.in[24][l * 1024 + ch]);
    float s = wsum(rr * kbon * p.in[25][l * 1024 + ch]);
    float outv = (yn + s * vv) * bf2f(GB[o]);
    GB[o] = f2bf(outv);
  }
  bf16* SY = (bf16*)(ws + B_SY);
  const float* dsk = p.in[35] + l * 1024;
  const int n4 = M * 256;
  for (int i = bidv * NT + tidv; i < n4; i += gridDim.x * NT) {
    int row = i >> 8, c = (i & 255) * 4;
    uint2 a = *(const uint2*)(SY + (size_t)row * 1024 + c);
    uint2 bq = *(const uint2*)(Z + (size_t)row * NIN + c);
    uint2 u = *(const uint2*)(Z + (size_t)row * NIN + C_U + c);
    float4 dd = *(const float4*)(dsk + c);
    float y0 = bf2f((bf16)(a.x & 0xffff)) + bf2f((bf16)(bq.x & 0xffff)) + dd.x * bf2f((bf16)(u.x & 0xffff));
    float y1 = bf2f((bf16)(a.x >> 16)) + bf2f((bf16)(bq.x >> 16)) + dd.y * bf2f((bf16)(u.x >> 16));
    float y2 = bf2f((bf16)(a.y & 0xffff)) + bf2f((bf16)(bq.y & 0xffff)) + dd.z * bf2f((bf16)(u.y & 0xffff));
    float y3 = bf2f((bf16)(a.y >> 16)) + bf2f((bf16)(bq.y >> 16)) + dd.w * bf2f((bf16)(u.y >> 16));
    uint2 o;
    o.x = pack2(gelu_tanh(y0), gelu_tanh(y1));
    o.y = pack2(gelu_tanh(y2), gelu_tanh(y3));
    *(uint2*)(SY + (size_t)row * 1024 + c) = o;
  }
}

constexpr int NPH = 25;

DEV void run_phase(int tidv, int bidv, const Params& p, int ph, char* smem, int dry) {
  char* ws = p.ws;
#ifndef ONLY_S
  if (ph == 0) {
    if (bidv == 0 && tidv < 4) ((int*)(ws + B_CNT))[tidv] = 0;
    phase_mod(tidv, bidv, p, smem);
    phase_convw(tidv, bidv, p, 0, smem);
    return;
  }
#endif
  const int l = (ph - 1) / 12, s = (ph - 1) % 12;
#ifdef ONLY_S
  if (s != ONLY_S) return;
#endif
  const bf16* wb = (const bf16*)(ws + B_WB);
  const float* mod = (const float*)(ws + B_MOD) + (size_t)l * 5 * 12288;
  float* XC = (float*)(ws + B_XC);
  const float* xin_lat = l == 0 ? p.in[0] : p.out;
  const float* xin_ctx = l == 0 ? p.in[2] : XC;
  bf16* HB = (bf16*)(ws + B_HB);
  bf16* Z = (bf16*)(ws + B_ZB);
  bf16* H2 = (bf16*)(ws + B_KN);
  const int Mpost = l == 0 ? MT : ML;
  switch (s) {
    case 0:
      if (l == 1) phase_convw(tidv, bidv, p, 1, smem);
      phase_norm(tidv, bidv, xin_lat, xin_ctx, p.in[6] + l * 2048, mod, 0, 2048, HB, MT);
      break;
    case 1:
      run_gemm<G_IN>(tidv, bidv, p, l, smem, HB, 2048, wb + OW_IN, 2048, NIN, MT, 0, nullptr, nullptr, nullptr, nullptr);
      break;
    case 2:
#if !defined(PH2_ONLY) || PH2_ONLY == 0
      run_gemm<G_UKV>(tidv, bidv, p, l, smem, Z + C_CKV, NIN, wb + OW_UKV, 512, 2048, MT, 0, nullptr, nullptr, nullptr, nullptr);
#endif
#if !defined(PH2_ONLY) || PH2_ONLY == 1
      run_gemm<G_UQ>(tidv, bidv, p, l, smem, Z + C_CQ, NIN, wb + OW_UQ, 512, 1536, MT, 0, nullptr, nullptr, nullptr, nullptr);
#endif
#if !defined(PH2_ONLY) || PH2_ONLY == 2
      run_gemm<G_G2>(tidv, bidv, p, l, smem, Z + C_GD, NIN, wb + OW_G2, 192, 1024, MT, 0, nullptr, nullptr, nullptr, nullptr);
#endif
#if !defined(PH2_ONLY) || PH2_ONLY == 3
      for (int d = 0; d < 2; d++) {
        run_gemm<G_W2>(tidv, bidv, p, l, smem, Z + C_WD + 64 * d, NIN, wb + OW_W2 + (size_t)d * 65536, 64, 1024, MT, d, nullptr, nullptr, nullptr, nullptr);
        run_gemm<G_A2>(tidv, bidv, p, l, smem, Z + C_AD + 64 * d, NIN, wb + OW_A2 + (size_t)d * 65536, 64, 1024, MT, d, nullptr, nullptr, nullptr, nullptr);
      }
#endif
      break;
    case 3: phase_mla_post(tidv, bidv, p, l); break;
    case 4: phase_mixers(tidv, bidv, p, l, smem, dry); break;
    case 5: phase_post(tidv, bidv, p, l, Mpost); break;
    case 6:
      run_gemm<G_GLU>(tidv, bidv, p, l, smem, (const bf16*)(ws + B_SY), 1024, wb + OW_GLU, 1024, 1024, Mpost, 0, nullptr, nullptr, nullptr, nullptr);
      break;
    case 7:
      run_gemm<G_MG0>(tidv, bidv, p, l, smem, (const bf16*)(ws + B_QB), 1536, wb + OW_BR, 1024, 2048, Mpost, 0, nullptr, nullptr, nullptr, nullptr);
      run_gemm<G_MG1>(tidv, bidv, p, l, smem, (const bf16*)(ws + B_GB), 1024, wb + OW_BR + (size_t)2048 * 1024, 1024, 2048, Mpost, 0, nullptr, nullptr, nullptr, nullptr);
      run_gemm<G_MG2>(tidv, bidv, p, l, smem, Z, NIN, wb + OW_BR + (size_t)2 * 2048 * 1024, 1024, 2048, Mpost, 0, nullptr, nullptr, nullptr, nullptr);
      break;
    case 8:
      run_gemm<G_OUT>(tidv, bidv, p, l, smem, HB, 2048, wb + OW_OUT, 2048, 2048, Mpost, 0, xin_lat, xin_ctx, p.out, XC);
      break;
    case 9:
      phase_norm(tidv, bidv, p.out, XC, p.in[7] + l * 2048, mod, 6144, 8192, H2, Mpost);
      break;
    case 10:
      run_gemm<G_M1>(tidv, bidv, p, l, smem, H2, 2048, wb + OW_M1, 2048, 8192, Mpost, 0, nullptr, nullptr, nullptr, nullptr);
      break;
    case 11:
      run_gemm<G_M2>(tidv, bidv, p, l, smem, Z, 8192, wb + OW_M2, 8192, 2048, Mpost, 0, nullptr, nullptr, p.out, XC);
      break;
  }
}

__global__ void __launch_bounds__(NT) fwd_megakernel(Params p, int ph0, int ph1, int dryflag) {
  extern __shared__ __attribute__((aligned(16))) char smem[];
  for (int ph = ph0; ph < ph1; ph++) {
    int tidv = threadIdx.x, bidv = blockIdx.x;
    asm volatile("" : "+v"(tidv));
    asm volatile("" : "+s"(bidv));
#ifdef PROBE_MASK
    if (dryflag && ((ph == 0 && (PROBE_MASK & 0x1000)) || (ph > 0 && ((PROBE_MASK >> ((ph - 1) % 12)) & 1)))) {
      run_phase(tidv, bidv, p, ph, smem, dryflag);
      cg::this_grid().sync();
    }
#endif
    run_phase(tidv, bidv, p, ph, smem, 0);
    if (ph + 1 < ph1) cg::this_grid().sync();
  }
}

extern "C" void kernel_launch(void* const* d_in, const int* in_sizes, int n_in, void* d_out, int out_size, void* d_ws, size_t ws_size,
                              hipStream_t stream) {
  static int grid_blocks = 0;
  if (!grid_blocks) {
    int dev = 0, cus = 0, per_cu = 0;
    (void)hipGetDevice(&dev);
    (void)hipDeviceGetAttribute(&cus, hipDeviceAttributeMultiprocessorCount, dev);
    if (hipFuncSetAttribute((const void*)fwd_megakernel, hipFuncAttributeMaxDynamicSharedMemorySize, LDS_BYTES) != hipSuccess) {
      fprintf(stderr, "hipFuncSetAttribute(%d B dynamic LDS) failed\n", LDS_BYTES);
      return;
    }
    if (hipOccupancyMaxActiveBlocksPerMultiprocessor(&per_cu, (const void*)fwd_megakernel, NT, LDS_BYTES) != hipSuccess || per_cu < 1) {
      fprintf(stderr, "occupancy query failed / kernel not resident\n");
      return;
    }
    grid_blocks = cus;
  }
  Params p{};
  for (int i = 0; i < 42; i++) p.in[i] = (const float*)d_in[i];
  p.out = (float*)d_out;
  p.ws = (char*)d_ws;
  if (ws_size < B_END + (8u << 20)) { fprintf(stderr, "workspace too small\n"); return; }
  int ph0 = 0, ph1 = NPH;
  int dryflag = 1;
  void* args[] = {&p, &ph0, &ph1, &dryflag};
  hipError_t e = hipLaunchCooperativeKernel((void*)fwd_megakernel, dim3(grid_blocks), dim3(NT), args, LDS_BYTES, stream);
  if (e != hipSuccess) fprintf(stderr, "cooperative launch failed: %s (grid %d)\n", hipGetErrorString(e), grid_blocks);
}
```

```cpp
#include <hip/hip_runtime.h>
#include <hip/hip_cooperative_groups.h>
#include <stdint.h>
#include <cstdio>
namespace cg = cooperative_groups;

#ifndef MULTI_LAUNCH
#define MULTI_LAUNCH 0
#endif

typedef unsigned short bf16;
using bf16x8 = __attribute__((ext_vector_type(8))) short;
using f32x4 = __attribute__((ext_vector_type(4))) float;
using f32x16 = __attribute__((ext_vector_type(16))) float;

#define DEV __device__ __forceinline__
constexpr int NT = 512, NW = 8;

constexpr int DM = 2048, ML = 16384, MC = 1024, MT = 17408, NIN = 11744, DFF = 8192, NKEY = 4352;
constexpr int C_CQ = 0, C_CKV = 512, C_KR = 1024, C_R = 1088, C_WD = 4160, C_AD = 4288, C_GD = 4416, C_U = 4576, C_GATE = 5600;

constexpr size_t OW_IN = 0;
constexpr size_t OW_UQ = OW_IN + (size_t)NIN * 2048;
constexpr size_t OW_UKV = OW_UQ + 1536 * 512;
constexpr size_t OW_W2 = OW_UKV + 2048 * 512;
constexpr size_t OW_A2 = OW_W2 + 2 * 1024 * 64;
constexpr size_t OW_G2 = OW_A2 + 2 * 1024 * 64;
constexpr size_t OW_GLU = OW_G2 + 1024 * 192;
constexpr size_t OW_BR = OW_GLU + 1024 * 1024;
constexpr size_t OW_OUT = OW_BR + (size_t)3 * 2048 * 1024;
constexpr size_t OW_M1 = OW_OUT + (size_t)2048 * 2048;
constexpr size_t OW_M2 = OW_M1 + (size_t)8192 * 2048;
constexpr size_t OW_END = OW_M2 + (size_t)8192 * 2048;

constexpr size_t SZ1K = (size_t)MT * 1024 * 2;
constexpr size_t B_WB = 0;
constexpr size_t B_HB = B_WB + OW_END * 2;
constexpr size_t B_ZB = B_HB + (size_t)MT * 2048 * 2;
constexpr size_t B_QB = B_ZB + (size_t)MT * NIN * 2;
constexpr size_t B_KN = B_QB + (size_t)MT * 1536 * 2;
constexpr size_t B_VT = B_KN + SZ1K;
constexpr size_t B_KR = B_VT + SZ1K;
constexpr size_t B_AF = B_KR + (size_t)MT * 64 * 2;
constexpr size_t B_AB = B_AF + SZ1K;
constexpr size_t B_GB = B_AB + SZ1K;
constexpr size_t B_SY = B_GB + SZ1K;
constexpr size_t B_XC = B_SY + SZ1K;
constexpr size_t B_MOD = B_XC + (size_t)MC * 2048 * 4;
constexpr size_t B_CNT = B_MOD + (size_t)2 * 5 * 12288 * 4;
constexpr size_t B_FLG = B_CNT + 256;
constexpr size_t B_END = B_FLG + 4096;

struct Params {
  const float* in[42];
  float* out;
  char* ws;
};

typedef __attribute__((ext_vector_type(2))) __bf16 hbf2;
DEV bf16 f2bf(float f) {
  __bf16 h = (__bf16)f;
  return *(unsigned short*)&h;
}
DEV float bf2f(bf16 h) { return __uint_as_float(((uint32_t)h) << 16); }
DEV uint32_t pack2(float a, float b) {
  hbf2 v;
  v[0] = (__bf16)a;
  v[1] = (__bf16)b;
  return *(uint32_t*)&v;
}
DEV float wsum(float v) {
#pragma unroll
  for (int o = 32; o > 0; o >>= 1) v += __shfl_xor(v, o);
  return v;
}
DEV float dpp_xor1(float v) {
  int i = __float_as_int(v);
  return __int_as_float(__builtin_amdgcn_update_dpp(i, i, 0xB1, 0xF, 0xF, false));
}
DEV float dpp_xor2(float v) {
  int i = __float_as_int(v);
  return __int_as_float(__builtin_amdgcn_update_dpp(i, i, 0x4E, 0xF, 0xF, false));
}
DEV float sigmoidf_(float x) { return __builtin_amdgcn_rcpf(1.f + __expf(-x)); }

DEV void phase_mod(int tidv, int bidv, const Params& p, char* smem) {
  float* s_in = (float*)smem;
  float* red = s_in + 5 * 2048;
  float* mod = (float*)(p.ws + B_MOD);
  for (int i = tidv; i < 5 * 2048; i += NT) {
    int r = i >> 11, k = i & 2047;
    float v = r < 4 ? p.in[1][r * 2048 + k] : p.in[3][k];
    s_in[i] = v / (1.f + expf(-v));
  }
  __syncthreads();
  int kg = tidv >> 6, c = tidv & 63;
  for (int task = bidv; task < 2 * 192; task += gridDim.x) {
    int l = task / 192, n = (task % 192) * 64 + c;
    const float* w = p.in[4] + (size_t)l * 2048 * 12288 + n;
    float a0 = 0, a1 = 0, a2 = 0, a3 = 0, a4 = 0;
    int kb = kg * 256;
#pragma unroll 8
    for (int k = 0; k < 256; k++) {
      float wv = w[(size_t)(kb + k) * 12288];
      a0 += s_in[kb + k] * wv;
      a1 += s_in[2048 + kb + k] * wv;
      a2 += s_in[4096 + kb + k] * wv;
      a3 += s_in[6144 + kb + k] * wv;
      a4 += s_in[8192 + kb + k] * wv;
    }
    red[(kg * 5 + 0) * 64 + c] = a0;
    red[(kg * 5 + 1) * 64 + c] = a1;
    red[(kg * 5 + 2) * 64 + c] = a2;
    red[(kg * 5 + 3) * 64 + c] = a3;
    red[(kg * 5 + 4) * 64 + c] = a4;
    __syncthreads();
    if (kg == 0) {
      float bias = p.in[5][l * 12288 + n];
#pragma unroll
      for (int r = 0; r < 5; r++) {
        float v = 0.f;
#pragma unroll
        for (int g = 0; g < 8; g++) v += red[(g * 5 + r) * 64 + c];
        mod[(size_t)(l * 5 + r) * 12288 + n] = v + bias;
      }
    }
    __syncthreads();
  }
}

DEV void convT(int tidv, int bidv, const float* __restrict__ src, bf16* __restrict__ dst, int K, int N, const float* __restrict__ gain, char* smem, int dK = 0) {
  if (dK == 0) dK = K;
  float* t = (float*)smem;
  int tk = (K + 63) >> 6, tn = (N + 63) >> 6;
  for (int tile = bidv; tile < tk * tn; tile += gridDim.x) {
    int k0 = (tile / tn) * 64, n0 = (tile % tn) * 64;
    __syncthreads();
#pragma unroll 4
    for (int i = 0; i < 8; i++) {
      int kk = i * 8 + (tidv >> 6), nn = tidv & 63;
      float v = 0.f;
      if (k0 + kk < K && n0 + nn < N) {
        v = src[(size_t)(k0 + kk) * N + n0 + nn];
        if (gain) v *= gain[k0 + kk];
      }
      t[kk * 65 + nn] = v;
    }
    __syncthreads();
    {
      int c = tidv;
      int nn = c >> 3, kc = c & 7;
      if (n0 + nn < N && k0 + kc * 8 < dK) {
        uint4 o;
        o.x = pack2(t[(kc * 8 + 0) * 65 + nn], t[(kc * 8 + 1) * 65 + nn]);
        o.y = pack2(t[(kc * 8 + 2) * 65 + nn], t[(kc * 8 + 3) * 65 + nn]);
        o.z = pack2(t[(kc * 8 + 4) * 65 + nn], t[(kc * 8 + 5) * 65 + nn]);
        o.w = pack2(t[(kc * 8 + 6) * 65 + nn], t[(kc * 8 + 7) * 65 + nn]);
        *(uint4*)(dst + (size_t)(n0 + nn) * dK + k0 + kc * 8) = o;
      }
    }
  }
}

DEV void phase_convw(int tidv, int bidv, const Params& p, int l, char* smem) {
  bf16* wb = (bf16*)(p.ws + B_WB);
  convT(tidv, bidv, p.in[8] + (size_t)l * 2048 * NIN, wb + OW_IN, 2048, NIN, nullptr, smem);
  convT(tidv, bidv, p.in[40] + (size_t)l * 2048 * 8192, wb + OW_M1, 2048, 8192, nullptr, smem);
  convT(tidv, bidv, p.in[41] + (size_t)l * 8192 * 2048, wb + OW_M2, 8192, 2048, nullptr, smem);
  for (int n = 0; n < 3; n++)
    convT(tidv, bidv, p.in[38] + (size_t)(l * 3 + n) * 1024 * 2048, wb + OW_BR + (size_t)n * 2048 * 1024, 1024, 2048, nullptr, smem);
  convT(tidv, bidv, p.in[39] + (size_t)l * 2048 * 2048, wb + OW_OUT, 2048, 2048, nullptr, smem);
  convT(tidv, bidv, p.in[11] + (size_t)l * 512 * 1536, wb + OW_UQ, 512, 1536, p.in[9] + l * 512, smem);
  convT(tidv, bidv, p.in[12] + (size_t)l * 512 * 2048, wb + OW_UKV, 512, 2048, p.in[10] + l * 512, smem);
  convT(tidv, bidv, p.in[36] + (size_t)l * 1024 * 1024, wb + OW_GLU, 1024, 1024, nullptr, smem);
  for (int d = 0; d < 2; d++) {
    convT(tidv, bidv, p.in[19] + (size_t)(l * 2 + d) * 64 * 1024, wb + OW_W2 + (size_t)d * 65536, 64, 1024, nullptr, smem);
    convT(tidv, bidv, p.in[21] + (size_t)(l * 2 + d) * 64 * 1024, wb + OW_A2 + (size_t)d * 65536, 64, 1024, nullptr, smem);
  }
  convT(tidv, bidv, p.in[22] + (size_t)l * 160 * 1024, wb + OW_G2, 160, 1024, nullptr, smem, 192);
}

DEV void phase_norm(int tidv, int bidv, const float* xlat, const float* xctx, const float* g, const float* mod, int shOff, int scOff, bf16* H, int nrows) {
  int wave = tidv >> 6, lane = tidv & 63;
  for (int row = bidv * NW + wave; row < nrows; row += gridDim.x * NW) {
    const float* x = row < ML ? xlat + (size_t)row * 2048 : xctx + (size_t)(row - ML) * 2048;
    int b = row < ML ? (row >> 12) : 4;
    const float* sh = mod + b * 12288 + shOff;
    const float* sc = mod + b * 12288 + scOff;
    float4 v[8];
    float ss = 0.f;
#pragma unroll
    for (int i = 0; i < 8; i++) {
      v[i] = *(const float4*)(x + i * 256 + lane * 4);
      ss += v[i].x * v[i].x + v[i].y * v[i].y + v[i].z * v[i].z + v[i].w * v[i].w;
    }
    ss = wsum(ss);
    float rinv = rsqrtf(ss * (1.f / 2048.f) + 1e-6f);
#pragma unroll
    for (int i = 0; i < 8; i++) {
      int c = i * 256 + lane * 4;
      float4 g4 = *(const float4*)(g + c), s4 = *(const float4*)(sc + c), h4 = *(const float4*)(sh + c);
      float y0 = v[i].x * rinv * g4.x * (1.f + s4.x) + h4.x;
      float y1 = v[i].y * rinv * g4.y * (1.f + s4.y) + h4.y;
      float y2 = v[i].z * rinv * g4.z * (1.f + s4.z) + h4.z;
      float y3 = v[i].w * rinv * g4.w * (1.f + s4.w) + h4.w;
      uint2 o;
      o.x = pack2(y0, y1);
      o.y = pack2(y2, y3);
      *(uint2*)(H + (size_t)row * 2048 + c) = o;
    }
  }
}

constexpr int LDT = 72;
constexpr int GA_BYTES = 256 * LDT * 2;
constexpr int GSTAGE = 512 * LDT * 2;
constexpr int SM_RINV = 2 * GSTAGE;
constexpr int SM_ITEM = SM_RINV + 1024;
constexpr int LDS_BYTES = SM_ITEM + 16;
DEV float sumsq8(uint4 r) {
  float s = 0.f, x;
  x = bf2f((bf16)(r.x & 0xffff)); s += x * x; x = bf2f((bf16)(r.x >> 16)); s += x * x;
  x = bf2f((bf16)(r.y & 0xffff)); s += x * x; x = bf2f((bf16)(r.y >> 16)); s += x * x;
  x = bf2f((bf16)(r.z & 0xffff)); s += x * x; x = bf2f((bf16)(r.z >> 16)); s += x * x;
  x = bf2f((bf16)(r.w & 0xffff)); s += x * x; x = bf2f((bf16)(r.w >> 16)); s += x * x;
  return s;
}

template <bool ROWNORM>
DEV void gemm_mainloop(int tidv, int bidv, const bf16* __restrict__ A, int lda, bool amap, const bf16* __restrict__ Bt, int K, int N, int m0, int n0,
                       char* smem, f32x16 (&acc)[4][2]) {
  float* srinv = (float*)(smem + SM_RINV);
  const int tid = tidv, lane = tid & 63, wave = tid >> 6;
  const int wm = wave >> 2, wn = wave & 3;
  const int lr = tid >> 3, kc = tid & 7;
  const char* abase = (const char*)(A + (size_t)m0 * lda);
  const char* bbase = (const char*)(Bt + (size_t)n0 * K);
  const uint32_t voa = (uint32_t)(lr * lda + kc * 8) * 2u;
  const uint32_t astep = (uint32_t)(64 * lda) * 2u;
  const uint32_t vob0 = (uint32_t)(lr * K + kc * 8) * 2u;
  const uint32_t bstep = (uint32_t)(64 * K) * 2u;
  const uint32_t lds_st = (uint32_t)(lr * LDT + kc * 8) * 2u;
  const int nk = K >> 6;
  uint4 xa0, xa1, xa2, xa3, xb0, xb1, xb2, xb3;
#define G_LOAD(KT)                                                         \
  {                                                                        \
    const int k0_ = (KT) << 6;                                             \
    const int ka_ = amap ? ((k0_ >> 7) * 192 + (k0_ & 127)) : k0_;         \
    xa0 = *(const uint4*)(abase + (size_t)ka_ * 2 + voa);                  \
    xa1 = *(const uint4*)(abase + (size_t)ka_ * 2 + astep + voa);          \
    xa2 = *(const uint4*)(abase + (size_t)ka_ * 2 + 2 * astep + voa);      \
    xa3 = *(const uint4*)(abase + (size_t)ka_ * 2 + 3 * astep + voa);      \
    xb0 = *(const uint4*)(bbase + (size_t)k0_ * 2 + vob0);                 \
    xb1 = *(const uint4*)(bbase + (size_t)k0_ * 2 + bstep + vob0);         \
    xb2 = *(const uint4*)(bbase + (size_t)k0_ * 2 + 2 * bstep + vob0);     \
    xb3 = *(const uint4*)(bbase + (size_t)k0_ * 2 + 3 * bstep + vob0);     \
  }
#define G_STORE(SN)                                                  \
  *(uint4*)((SN) + lds_st) = xa0;                                    \
  *(uint4*)((SN) + 1 * (64 * LDT * 2) + lds_st) = xa1;               \
  *(uint4*)((SN) + 2 * (64 * LDT * 2) + lds_st) = xa2;               \
  *(uint4*)((SN) + 3 * (64 * LDT * 2) + lds_st) = xa3;               \
  *(uint4*)((SN) + GA_BYTES + lds_st) = xb0;                         \
  *(uint4*)((SN) + GA_BYTES + 1 * (64 * LDT * 2) + lds_st) = xb1;    \
  *(uint4*)((SN) + GA_BYTES + 2 * (64 * LDT * 2) + lds_st) = xb2;    \
  *(uint4*)((SN) + GA_BYTES + 3 * (64 * LDT * 2) + lds_st) = xb3;
  const uint32_t fa = (uint32_t)((wm * 128 + (lane & 31)) * LDT + (lane >> 5) * 8) * 2u;
  const uint32_t fb = (uint32_t)GA_BYTES + (uint32_t)((wn * 64 + (lane & 31)) * LDT + (lane >> 5) * 8) * 2u;
  const int nkm = nk - 1;
  if (ROWNORM) {
    __syncthreads();
#pragma unroll 1
    for (int i = 0; i < 4; i++) {
      float ss = 0.f;
      for (int kk = 0; kk < nk; kk++) ss += sumsq8(*(const uint4*)(abase + (size_t)kk * 128 + i * astep + voa));
      ss += __shfl_xor(ss, 1); ss += __shfl_xor(ss, 2); ss += __shfl_xor(ss, 4);
      if (kc == 0) srinv[lr + 64 * i] = rsqrtf(ss / (float)K + 1e-6f);
    }
  }
  G_LOAD(0)
  __syncthreads();
  G_STORE(smem)
  G_LOAD((1 < nkm ? 1 : nkm))
  __syncthreads();
#define G_FRAG(P, ST, KS)                                                            \
  P##a0 = *(const bf16x8*)((ST) + fa + 0 * (32 * LDT * 2) + (KS) * 32);                \
  P##a1 = *(const bf16x8*)((ST) + fa + 1 * (32 * LDT * 2) + (KS) * 32);                \
  P##a2 = *(const bf16x8*)((ST) + fa + 2 * (32 * LDT * 2) + (KS) * 32);                \
  P##a3 = *(const bf16x8*)((ST) + fa + 3 * (32 * LDT * 2) + (KS) * 32);                \
  P##b0 = *(const bf16x8*)((ST) + fb + 0 * (32 * LDT * 2) + (KS) * 32);                \
  P##b1 = *(const bf16x8*)((ST) + fb + 1 * (32 * LDT * 2) + (KS) * 32);
#define G_MMA(P)                                                                              \
  acc[0][0] = __builtin_amdgcn_mfma_f32_32x32x16_bf16(P##b0, P##a0, acc[0][0], 0, 0, 0);      \
  acc[0][1] = __builtin_amdgcn_mfma_f32_32x32x16_bf16(P##b1, P##a0, acc[0][1], 0, 0, 0);      \
  acc[1][0] = __builtin_amdgcn_mfma_f32_32x32x16_bf16(P##b0, P##a1, acc[1][0], 0, 0, 0);      \
  acc[1][1] = __builtin_amdgcn_mfma_f32_32x32x16_bf16(P##b1, P##a1, acc[1][1], 0, 0, 0);      \
  acc[2][0] = __builtin_amdgcn_mfma_f32_32x32x16_bf16(P##b0, P##a2, acc[2][0], 0, 0, 0);      \
  acc[2][1] = __builtin_amdgcn_mfma_f32_32x32x16_bf16(P##b1, P##a2, acc[2][1], 0, 0, 0);      \
  acc[3][0] = __builtin_amdgcn_mfma_f32_32x32x16_bf16(P##b0, P##a3, acc[3][0], 0, 0, 0);      \
  acc[3][1] = __builtin_amdgcn_mfma_f32_32x32x16_bf16(P##b1, P##a3, acc[3][1], 0, 0, 0);
  bf16x8 pa0, pa1, pa2, pa3, pb0, pb1, qa0, qa1, qa2, qa3, qb0, qb1;
#pragma unroll 1
  for (int kt = 0; kt < nk; kt++) {
    const char* st = smem + (kt & 1) * GSTAGE;
    char* sn = smem + ((kt + 1) & 1) * GSTAGE;
    if (!ROWNORM) {
      G_FRAG(p, st, 0)
      G_FRAG(q, st, 1)
      __builtin_amdgcn_sched_barrier(0);
      G_MMA(p)
      __builtin_amdgcn_sched_barrier(0);
      G_FRAG(p, st, 2)
      __builtin_amdgcn_sched_barrier(0);
      G_MMA(q)
      __builtin_amdgcn_sched_barrier(0);
      G_FRAG(q, st, 3)
      if (kt + 1 < nk) { G_STORE(sn) }
      G_LOAD((kt + 2 < nkm ? kt + 2 : nkm))
      __builtin_amdgcn_sched_barrier(0);
      G_MMA(p)
      __builtin_amdgcn_sched_barrier(0);
      G_MMA(q)
    } else {
      G_FRAG(p, st, 0)
      __builtin_amdgcn_sched_barrier(0);
      G_MMA(p)
      __builtin_amdgcn_sched_barrier(0);
      G_FRAG(p, st, 1)
      __builtin_amdgcn_sched_barrier(0);
      G_MMA(p)
      __builtin_amdgcn_sched_barrier(0);
      G_FRAG(p, st, 2)
      if (kt + 1 < nk) { G_STORE(sn) }
      G_LOAD((kt + 2 < nkm ? kt + 2 : nkm))
      __builtin_amdgcn_sched_barrier(0);
      G_MMA(p)
      __builtin_amdgcn_sched_barrier(0);
      G_FRAG(p, st, 3)
      __builtin_amdgcn_sched_barrier(0);
      G_MMA(p)
    }
    __syncthreads();
  }
#undef G_FRAG
#undef G_MMA
#undef G_LOAD
#undef G_STORE
}

DEV void zero_acc(f32x16 (&acc)[4][2]) {
#pragma unroll
  for (int i = 0; i < 4; i++)
#pragma unroll
    for (int j = 0; j < 2; j++)
#pragma unroll
      for (int e = 0; e < 16; e++) acc[i][j][e] = 0.f;
}

template <class F>
DEV void epi_loop(int tidv, int bidv, f32x16 (&acc)[4][2], int m0, int n0, int N, F f) {
  const int lane = tidv & 63, wave = tidv >> 6;
  const int wm = wave >> 2, wn = wave & 3;
#pragma unroll
  for (int i = 0; i < 4; i++) {
    const int lrow = wm * 128 + i * 32 + (lane & 31);
#pragma unroll
    for (int j = 0; j < 2; j++) {
#pragma unroll
      for (int g = 0; g < 4; g++) {
        int col = n0 + wn * 64 + j * 32 + 8 * g + 4 * (lane >> 5);
        f32x4 v = {acc[i][j][4 * g], acc[i][j][4 * g + 1], acc[i][j][4 * g + 2], acc[i][j][4 * g + 3]};
        if (col < N) f(m0 + lrow, lrow, col, v);
      }
    }
    __builtin_amdgcn_sched_barrier(0);
  }
}

DEV uint2 pack4(f32x4 v) {
  uint2 o;
  o.x = pack2(v[0], v[1]);
  o.y = pack2(v[2], v[3]);
  return o;
}
DEV f32x4 unpack4(uint2 u) {
  f32x4 v;
  v[0] = bf2f((bf16)(u.x & 0xffff)); v[1] = bf2f((bf16)(u.x >> 16));
  v[2] = bf2f((bf16)(u.y & 0xffff)); v[3] = bf2f((bf16)(u.y >> 16));
  return v;
}

enum { G_IN = 0, G_UQ, G_UKV, G_W2, G_A2, G_G2, G_GLU, G_OUT, G_M1, G_M2, G_MG0, G_MG1, G_MG2 };

template <int MODE>
DEV void run_gemm(int tidv, int bidv, const Params& p, int l, char* smem, const bf16* A, int lda, const bf16* Bt, int K, int N, int M, int aux,
                  const float* xin_lat, const float* xin_ctx, float* xout_lat, float* xout_ctx) {
  const int nt = (N + 255) >> 8, mt = M >> 8;
  char* ws = p.ws;
  bf16* Z = (bf16*)(ws + B_ZB);
  const float* srinv = (const float*)(smem + SM_RINV);
  const float* mod = (const float*)(ws + B_MOD) + (size_t)l * 5 * 12288;
  for (int tile = bidv; tile < nt * mt; tile += gridDim.x) {
    int m0 = (tile / nt) << 8, n0 = (tile % nt) << 8;
    f32x16 acc[4][2];
    zero_acc(acc);
    gemm_mainloop<(MODE == G_UQ || MODE == G_UKV)>(tidv, bidv, A, lda, MODE == G_MG0, Bt, K, N, m0, n0, smem, acc);
    if constexpr (MODE != G_OUT && MODE != G_M2)
    epi_loop(tidv, bidv, acc, m0, n0, N, [&](int row, int lrow, int col, f32x4 v) {
      if constexpr (MODE == G_IN) {
        f32x4 o = v;
        if (col >= C_GATE || (col >= C_GD && col < C_U)) {
#pragma unroll
          for (int r = 0; r < 4; r++) o[r] = sigmoidf_(v[r]);
        } else if (col >= C_WD && col < C_AD) {
#pragma unroll
          for (int r = 0; r < 4; r++) o[r] = tanhf(v[r]);
        }
        *(uint2*)(smem + ((size_t)lrow * 264 + (col - n0)) * 2) = pack4(o);
      } else if constexpr (MODE == G_UQ) {
        float ri = srinv[lrow];
        *(uint2*)((bf16*)(ws + B_QB) + (size_t)row * 1536 + col) = pack4(v * ri);
      } else if constexpr (MODE == G_UKV) {
        float ri = srinv[lrow];
        f32x4 o = v * ri;
        int h = col >> 8, c = col & 255;
        if (c < 128) {
          *(uint2*)((bf16*)(ws + B_KN) + (size_t)row * 1024 + h * 128 + c) = pack4(o);
        } else {
          int b, kp;
          if (row < ML) { b = row >> 12; kp = row & 4095; } else { int r2 = row - ML; b = r2 >> 8; kp = 4096 + (r2 & 255); }
          bf16* vt = (bf16*)(ws + B_VT) + ((size_t)((b * 8 + h) * 128 + (c - 128))) * NKEY + kp;
#pragma unroll
          for (int r = 0; r < 4; r++) vt[(size_t)r * NKEY] = f2bf(o[r]);
        }
      } else if constexpr (MODE == G_W2) {
        float4 w0 = *(const float4*)(p.in[18] + (l * 2 + aux) * 1024 + col);
        f32x4 o;
        o[0] = 0.60653066f * sigmoidf_(w0.x + v[0]);
        o[1] = 0.60653066f * sigmoidf_(w0.y + v[1]);
        o[2] = 0.60653066f * sigmoidf_(w0.z + v[2]);
        o[3] = 0.60653066f * sigmoidf_(w0.w + v[3]);
        *(uint2*)((bf16*)(ws + B_HB + (size_t)aux * SZ1K) + (size_t)row * 1024 + col) = pack4(o);
      } else if constexpr (MODE == G_A2) {
        float4 a0 = *(const float4*)(p.in[20] + (l * 2 + aux) * 1024 + col);
        f32x4 o;
        o[0] = sigmoidf_(a0.x + v[0]);
        o[1] = sigmoidf_(a0.y + v[1]);
        o[2] = sigmoidf_(a0.z + v[2]);
        o[3] = sigmoidf_(a0.w + v[3]);
        *(uint2*)((bf16*)(ws + (aux ? B_AB : B_AF)) + (size_t)row * 1024 + col) = pack4(o);
      } else if constexpr (MODE == G_G2) {
        *(uint2*)((bf16*)(ws + B_GB) + (size_t)row * 1024 + col) = pack4(v);
      } else if constexpr (MODE == G_GLU) {
        f32x4 zz = unpack4(*(const uint2*)((const bf16*)(ws + B_SY) + (size_t)row * 1024 + col));
        float4 gb = *(const float4*)(p.in[37] + l * 1024 + col);
        f32x4 o;
        o[0] = zz[0] * sigmoidf_(v[0] + gb.x);
        o[1] = zz[1] * sigmoidf_(v[1] + gb.y);
        o[2] = zz[2] * sigmoidf_(v[2] + gb.z);
        o[3] = zz[3] * sigmoidf_(v[3] + gb.w);
        *(uint2*)(smem + ((size_t)lrow * 264 + (col - n0)) * 2) = pack4(o);
      } else if constexpr (MODE == G_OUT || MODE == G_M2) {
      } else if constexpr (MODE == G_M1) {
        f32x4 o;
#pragma unroll
        for (int r = 0; r < 4; r++) { float t = fmaxf(v[r], 0.f); o[r] = t * t; }
        *(uint2*)(smem + ((size_t)lrow * 264 + (col - n0)) * 2) = pack4(o);
      } else if constexpr (MODE == G_MG0 || MODE == G_MG1 || MODE == G_MG2) {
        *(uint2*)(smem + ((size_t)lrow * 264 + (col - n0)) * 2) = pack4(v);
      }
    });
    if constexpr (MODE == G_OUT || MODE == G_M2) {
      float* tilef = (float*)smem;
      constexpr int GOFF = (MODE == G_OUT) ? 4096 : 10240;
      const int wn_ = (tidv >> 6) & 3;
#pragma unroll 1
      for (int half = 0; half < 2; half++) {
        if ((wn_ >> 1) == half) {
          epi_loop(tidv, bidv, acc, m0, n0, N, [&](int row, int lrow, int col, f32x4 v) {
            *(f32x4*)(tilef + (size_t)lrow * 132 + (col - n0 - half * 128)) = v;
          });
        }
        __syncthreads();
#pragma unroll 2
        for (int it = 0; it < 16; it++) {
          int c = it * NT + tidv;
          int r = c >> 5, ch = c & 31;
          int row = m0 + r, col = n0 + half * 128 + ch * 4;
          int b = row < ML ? (row >> 12) : 4;
          float4 g = *(const float4*)(mod + b * 12288 + GOFF + col);
          const float* xi;
          if constexpr (MODE == G_OUT) xi = row < ML ? xin_lat + (size_t)row * 2048 : xin_ctx + (size_t)(row - ML) * 2048;
          else xi = row < ML ? xout_lat + (size_t)row * 2048 : xout_ctx + (size_t)(row - ML) * 2048;
          float* xo = row < ML ? xout_lat + (size_t)row * 2048 : xout_ctx + (size_t)(row - ML) * 2048;
          float4 x = *(const float4*)(xi + col);
          f32x4 v = *(const f32x4*)(tilef + (size_t)r * 132 + ch * 4);
          x.x += g.x * v[0]; x.y += g.y * v[1]; x.z += g.z * v[2]; x.w += g.w * v[3];
          *(float4*)(xo + col) = x;
        }
        __syncthreads();
      }
    }
    if constexpr (MODE == G_MG0 || MODE == G_MG1 || MODE == G_MG2) {
      constexpr int nb = MODE - G_MG0;
      bf16* MG = (bf16*)(ws + B_HB);
      __syncthreads();
#pragma unroll 2
      for (int it = 0; it < 16; it++) {
        int c = it * NT + tidv;
        int r = c >> 5, ch = c & 31;
        int col = n0 + ch * 8;
        uint4 pv = *(const uint4*)(smem + ((size_t)r * 264 + ch * 8) * 2);
        uint4 gv = *(const uint4*)(Z + (size_t)(m0 + r) * NIN + C_GATE + nb * 2048 + col);
        f32x4 p0 = unpack4(uint2{pv.x, pv.y}), p1 = unpack4(uint2{pv.z, pv.w});
        f32x4 g0 = unpack4(uint2{gv.x, gv.y}), g1 = unpack4(uint2{gv.z, gv.w});
        f32x4 o0 = g0 * p0, o1 = g1 * p1;
        if constexpr (nb > 0) {
          uint4 qv = *(const uint4*)(MG + (size_t)(m0 + r) * 2048 + col);
          o0 += unpack4(uint2{qv.x, qv.y});
          o1 += unpack4(uint2{qv.z, qv.w});
        }
        uint2 a = pack4(o0), b = pack4(o1);
        *(uint4*)(MG + (size_t)(m0 + r) * 2048 + col) = uint4{a.x, a.y, b.x, b.y};
      }
    }
    if constexpr (MODE == G_IN || MODE == G_GLU || MODE == G_M1) {
      bf16* dst;
      int ld;
      if constexpr (MODE == G_IN || MODE == G_GLU) { dst = Z; ld = NIN; }
      else { dst = Z; ld = DFF; }
      __syncthreads();
#pragma unroll 4
      for (int it = 0; it < 16; it++) {
        int c = it * NT + tidv;
        int r = c >> 5, ch = c & 31;
        int col = n0 + ch * 8;
        if (col < N) *(uint4*)(dst + (size_t)(m0 + r) * ld + col) = *(const uint4*)(smem + ((size_t)r * 264 + ch * 8) * 2);
      }
    }
  }
}

DEV void phase_mla_post(int tidv, int bidv, const Params& p, int l) {
  char* ws = p.ws;
  const float* qng = p.in[13] + l * 128;
  const float* qrg = p.in[14] + l * 64;
  const float* kng = p.in[15] + l * 128;
  const float* krg = p.in[16] + l * 64;
  bf16* QB = (bf16*)(ws + B_QB);
  bf16* KN = (bf16*)(ws + B_KN);
  bf16* KR = (bf16*)(ws + B_KR);
  const bf16* Z = (const bf16*)(ws + B_ZB);
  const int wave = tidv >> 6, lane = tidv & 63;
  const float QS = 1.4426950408889634f * 0.07216878364870322f;
  const int idx = lane & 31;
  const float inv = powf(10000.f, -(float)(idx & 15) / 16.f);
  const float gq0 = qng[2 * lane], gq1 = qng[2 * lane + 1], gk0 = kng[2 * lane], gk1 = kng[2 * lane + 1];
  const float gqr = qrg[lane], gkr = krg[lane];
  for (int row = bidv * NW + wave; row < MT; row += gridDim.x * NW) {
    bool lat = row < ML;
    int t = row & 4095;
    float pos = (idx < 16) ? (float)(t >> 6) : (float)(t & 63);
    float ang = pos * inv;
    float cs = 1.f, sn = 0.f;
    if (lat) { cs = cosf(ang); sn = sinf(ang); }
#pragma unroll 1
    for (int h = 0; h < 8; h++) {
      bf16* q = QB + (size_t)row * 1536 + h * 192;
      uint32_t u = *(const uint32_t*)(q + 2 * lane);
      float x0 = bf2f((bf16)(u & 0xffff)), x1 = bf2f((bf16)(u >> 16));
      float ss = wsum(x0 * x0 + x1 * x1);
      float rinv = rsqrtf(ss * (1.f / 128.f) + 1e-6f) * QS;
      *(uint32_t*)(q + 2 * lane) = pack2(x0 * rinv * gq0, x1 * rinv * gq1);
      float xr = bf2f(q[128 + lane]);
      float ss2 = wsum(xr * xr);
      float y = xr * rsqrtf(ss2 * (1.f / 64.f) + 1e-6f) * gqr;
      float yp = __shfl_xor(y, 32);
      float o = lane < 32 ? (y * cs - yp * sn) : (yp * sn + y * cs);
      q[128 + lane] = f2bf(o * QS);
      bf16* k = KN + (size_t)row * 1024 + h * 128;
      uint32_t uk = *(const uint32_t*)(k + 2 * lane);
      float k0 = bf2f((bf16)(uk & 0xffff)), k1 = bf2f((bf16)(uk >> 16));
      float ssk = wsum(k0 * k0 + k1 * k1);
      float rk = rsqrtf(ssk * (1.f / 128.f) + 1e-6f);
      *(uint32_t*)(k + 2 * lane) = pack2(k0 * rk * gk0, k1 * rk * gk1);
    }
    {
      float xr = bf2f(Z[(size_t)row * NIN + C_KR + lane]);
      float ss2 = wsum(xr * xr);
      float y = xr * rsqrtf(ss2 * (1.f / 64.f) + 1e-6f) * gkr;
      float yp = __shfl_xor(y, 32);
      float o = lane < 32 ? (y * cs - yp * sn) : (yp * sn + y * cs);
      KR[(size_t)row * 64 + lane] = f2bf(o);
    }
  }
}

DEV void step_row(int s, int d, int b, int& row, int& tau, int& len) {
  if (s < 256) { tau = d ? 255 - s : s; len = 256; row = ML + b * 256 + tau; }
  else { int q = s - 256; tau = d ? 4095 - q : q; len = 4096; row = b * 4096 + tau; }
}

struct RwPre { bf16 r0, r1, r2, k0, k1, k2, v0, v1, v2, a, e; };

DEV void rwkv_fetch(RwPre& q, const bf16* Z, const bf16* AD, const bf16* ED, int s, int d, int b, int ch) {
  int row, tau, len;
  step_row(s, d, b, row, tau, len);
  const bf16* z = Z + (size_t)row * NIN + C_R + ch;
  q.r1 = z[0]; q.k1 = z[1024]; q.v1 = z[2048];
  q.r0 = 0; q.k0 = 0; q.v0 = 0; q.r2 = 0; q.k2 = 0; q.v2 = 0;
  if (tau > 0) { const bf16* zm = z - NIN; q.r0 = zm[0]; q.k0 = zm[1024]; q.v0 = zm[2048]; }
  if (tau < len - 1) { const bf16* zp = z + NIN; q.r2 = zp[0]; q.k2 = zp[1024]; q.v2 = zp[2048]; }
  q.a = AD[(size_t)row * 1024 + ch];
  q.e = ED[(size_t)row * 1024 + ch];
}

typedef float f2v __attribute__((ext_vector_type(2)));
DEV float dpp_hmirror(float v) {
  int i = __float_as_int(v);
  return __int_as_float(__builtin_amdgcn_update_dpp(i, i, 0x141, 0xF, 0xF, false));
}
DEV f2v lo2(float4 v) { return f2v{v.x, v.y}; }
DEV f2v hi2(float4 v) { return f2v{v.z, v.w}; }

DEV void rwkv_scan(int tidv, int bidv, const Params& p, int l, int chain, char* smem, int dry) {
  char* ws = p.ws;
  float* op = (float*)smem;
  float* vb = op + 16 * 320;
  float* yb = vb + 16 * 64;
  const int tid = tidv, wave = tid >> 6, lane = tid & 63;
  const int d = chain & 1, h = (chain >> 1) & 15, b = chain >> 5;
  const int ch = h * 64 + lane;
  const float* cw = p.in[17] + (size_t)l * 3 * 3072;
  const float cr0 = cw[ch], cr1 = cw[3072 + ch], cr2 = cw[6144 + ch];
  const float ck0 = cw[1024 + ch], ck1 = cw[3072 + 1024 + ch], ck2 = cw[6144 + 1024 + ch];
  const float cv0 = cw[2048 + ch], cv1 = cw[3072 + 2048 + ch], cv2 = cw[6144 + 2048 + ch];
  const float kkc = p.in[23][l * 1024 + ch], kac = p.in[24][l * 1024 + ch];
  const bf16* Z = (const bf16*)(ws + B_ZB);
  bf16* ED = (bf16*)(ws + B_HB + (size_t)d * SZ1K);
  const bf16* AD = (const bf16*)(ws + (d ? B_AB : B_AF));
  f2v S0 = {0.f, 0.f}, S1 = {0.f, 0.f}, S2 = {0.f, 0.f}, S3 = {0.f, 0.f};
  const int ri = lane >> 3, jo = lane & 7, irow = wave * 8 + ri;
  RwPre pre[2];
#pragma unroll
  for (int si = 0; si < 2; si++) rwkv_fetch(pre[si], Z, AD, ED, wave * 2 + si, d, b, ch);
  for (int chunk = 0; chunk < 272; chunk++) {
#pragma unroll
    for (int si = 0; si < 2; si++) {
      int t = wave * 2 + si;
      const RwPre& q = pre[si];
      float rr = cr0 * bf2f(q.r0) + cr1 * bf2f(q.r1) + cr2 * bf2f(q.r2);
      float kk_ = ck0 * bf2f(q.k0) + ck1 * bf2f(q.k1) + ck2 * bf2f(q.k2);
      float vv = cv0 * bf2f(q.v0) + cv1 * bf2f(q.v1) + cv2 * bf2f(q.v2);
      float kkv = kk_ * kkc;
      float ssq = wsum(kkv * kkv);
      float kn = kkv * rsqrtf(ssq + 1e-12f);
      float a = bf2f(q.a);
      float w = __expf(-bf2f(q.e));
      float krep = kk_ * (1.f + (a - 1.f) * kac);
      float* o = op + t * 320;
      o[lane] = w;
      o[64 + lane] = kn * a;
      o[128 + lane] = krep;
      o[192 + lane] = -kn;
      o[256 + lane] = rr;
      vb[t * 64 + lane] = vv;
    }
    __syncthreads();
    if (chunk + 1 < 272) {
#pragma unroll
      for (int si = 0; si < 2; si++) rwkv_fetch(pre[si], Z, AD, ED, (chunk + 1) * 16 + wave * 2 + si, d, b, ch);
    }
    {
      const float4* o4 = (const float4*)(op + jo * 8);
      float4 n0 = o4[48], n1 = o4[49];
#pragma unroll 4
      for (int t = 0; t < 16; t++) {
        const float4* ot = o4 + t * 80;
        const float4 w0 = ot[0], w1 = ot[1];
        const float4 a0 = ot[16], a1 = ot[17];
        const float4 k0 = ot[32], k1 = ot[33];
        const float4 r0 = ot[64], r1 = ot[65];
        const float vi = vb[t * 64 + irow];
        const int tn = t < 15 ? t + 1 : 15;
        const float4* on = o4 + tn * 80;
        const float4 m0 = on[48], m1 = on[49];
        f2v sv = S0 * lo2(n0) + S1 * hi2(n0) + (S2 * lo2(n1) + S3 * hi2(n1));
        float sa = sv.x + sv.y;
        sa += dpp_xor1(sa);
        sa += dpp_xor2(sa);
        sa += dpp_hmirror(sa);
        const f2v sa2 = {sa, sa}, vi2 = {vi, vi};
        S0 = S0 * lo2(w0) + sa2 * lo2(a0) + vi2 * lo2(k0);
        S1 = S1 * hi2(w0) + sa2 * hi2(a0) + vi2 * hi2(k0);
        S2 = S2 * lo2(w1) + sa2 * lo2(a1) + vi2 * lo2(k1);
        S3 = S3 * hi2(w1) + sa2 * hi2(a1) + vi2 * hi2(k1);
        f2v yv = S0 * lo2(r0) + S1 * hi2(r0) + (S2 * lo2(r1) + S3 * hi2(r1));
        float y = yv.x + yv.y;
        y += dpp_xor1(y);
        y += dpp_xor2(y);
        y += dpp_hmirror(y);
        if (jo == 0) yb[t * 64 + irow] = y;
        n0 = m0; n1 = m1;
      }
    }
    __syncthreads();
#pragma unroll
    for (int it = 0; it < 2; it++) {
      int idx = it * NT + tid;
      int t = idx >> 6, i = idx & 63;
      int row, tau, len;
      step_row(chunk * 16 + t, d, b, row, tau, len);
      size_t off = (size_t)row * 1024 + h * 64 + i;
      bf16* yd = dry ? (bf16*)(ws + B_END) + (off & 0x3fffff) : ED + off;
      *yd = f2bf(yb[t * 64 + i]);
    }
  }
}

DEV void s5_scan(int tidv, int bidv, const Params& p, int l, int chain, char* smemw, int dry) {
  char* ws = p.ws;
  const int lane = tidv & 63;
  const int d = chain & 1, g = (chain >> 1) & 63, b = chain >> 7;
  float* ub = (float*)smemw;
  float* hb = ub + 256;
  const size_t pg = (size_t)(l * 2 + d) * 64 + g;
  const float lre = p.in[28][pg * 64 + lane], lim = p.in[29][pg * 64 + lane];
  const float dt = expf(p.in[30][pg]);
  const float mag = expf(lre * dt);
  const float are = mag * cosf(lim * dt), aim = mag * sinf(lim * dt);
  const float den = lre * lre + lim * lim;
  const float qre = ((are - 1.f) * lre + aim * lim) / den;
  const float qim = (aim * lre - (are - 1.f) * lim) / den;
  float bbre[16], bbim[16];
  {
    const float* br = p.in[31] + (pg * 64 + lane) * 16;
    const float* bi = p.in[32] + (pg * 64 + lane) * 16;
#pragma unroll
    for (int i = 0; i < 16; i++) {
      float x = br[i], y = bi[i];
      bbre[i] = qre * x - qim * y;
      bbim[i] = qre * y + qim * x;
    }
  }
  bf16x8 cfr[4];
  {
    const int i = lane & 15, quad = lane >> 4;
    const float* cre = p.in[33] + (pg * 16 + i) * 64;
    const float* cim = p.in[34] + (pg * 16 + i) * 64;
#pragma unroll
    for (int ks = 0; ks < 4; ks++)
#pragma unroll
      for (int j = 0; j < 8; j++) {
        int k = ks * 32 + quad * 8 + j;
        float c = ks < 2 ? cre[k] : -cim[k - 64];
        cfr[ks][j] = (short)f2bf(c);
      }
  }
  float hre = 0.f, him = 0.f;
  const bf16* Z = (const bf16*)(ws + B_ZB);
  const int tt = lane >> 2, i0 = (lane & 3) * 4;
  uint2 unext;
  {
    int row, tau, len;
    step_row(tt, d, b, row, tau, len);
    unext = *(const uint2*)(Z + (size_t)row * NIN + C_U + g * 16 + i0);
  }
  for (int chunk = 0; chunk < 272; chunk++) {
    {
      uint2 u = unext;
      float4 f;
      f.x = bf2f((bf16)(u.x & 0xffff)); f.y = bf2f((bf16)(u.x >> 16));
      f.z = bf2f((bf16)(u.y & 0xffff)); f.w = bf2f((bf16)(u.y >> 16));
      *(float4*)(ub + tt * 16 + i0) = f;
    }
    __syncthreads();
    if (chunk + 1 < 272) {
      int row, tau, len;
      step_row((chunk + 1) * 16 + tt, d, b, row, tau, len);
      unext = *(const uint2*)(Z + (size_t)row * NIN + C_U + g * 16 + i0);
    }
#pragma unroll 2
    for (int t = 0; t < 16; t++) {
      const float* u = ub + t * 16;
      float br0 = 0.f, bi0 = 0.f;
#pragma unroll
      for (int i = 0; i < 16; i++) { float uv = u[i]; br0 += bbre[i] * uv; bi0 += bbim[i] * uv; }
      float nr = are * hre - aim * him + br0;
      float ni = are * him + aim * hre + bi0;
      hre = nr; him = ni;
      hb[t * 132 + lane] = hre;
      hb[t * 132 + 64 + lane] = him;
    }
    __syncthreads();
    {
      f32x4 yacc = {0.f, 0.f, 0.f, 0.f};
      const float* hr = hb + (lane & 15) * 132 + (lane >> 4) * 8;
#pragma unroll
      for (int ks = 0; ks < 4; ks++) {
        float4 x0 = *(const float4*)(hr + ks * 32), x1 = *(const float4*)(hr + ks * 32 + 4);
        union { bf16x8 v; uint32_t u[4]; } af;
        af.u[0] = pack2(x0.x, x0.y); af.u[1] = pack2(x0.z, x0.w);
        af.u[2] = pack2(x1.x, x1.y); af.u[3] = pack2(x1.z, x1.w);
        yacc = __builtin_amdgcn_mfma_f32_16x16x32_bf16(af.v, cfr[ks], yacc, 0, 0, 0);
      }
      const int ii = lane & 15;
#pragma unroll
      for (int r = 0; r < 4; r++) {
        int row, tau, len;
        step_row(chunk * 16 + (lane >> 4) * 4 + r, d, b, row, tau, len);
        bf16* dst = d == 0 ? (bf16*)(ws + B_SY) + (size_t)row * 1024 + g * 16 + ii : (bf16*)(ws + B_ZB) + (size_t)row * NIN + g * 16 + ii;
        if (dry) dst = (bf16*)(ws + B_END) + ((((size_t)row * 1024 + g * 16 + ii)) & 0x3fffff);
        *dst = f2bf(yacc[r]);
      }
    }
    __syncthreads();
  }
}

DEV int perm23(int r) { return (r & 0x13) | ((r & 4) << 1) | ((r & 8) >> 1); }

DEV void attn_item(int tidv, int bidv, const Params& p, int item, bool ctxq, char* smem, int dry) {
  char* ws = p.ws;
  bf16* sK = (bf16*)smem;
  bf16* sV = sK + 64 * 200;
  const int tid = tidv, wave = tid >> 6, lane = tid & 63;
  const int r = lane & 31, hf = lane >> 5;
  int b, hd, qt;
  if (!ctxq) { b = item >> 7; hd = (item >> 4) & 7; qt = item & 15; }
  else { b = item >> 3; hd = item & 7; qt = 0; }
  const int qrow0 = ctxq ? ML + b * 256 : b * 4096 + qt * 256;
  const int kt0 = ctxq ? 64 : 0, kt1 = 68;
  bf16* QB = (bf16*)(ws + B_QB);
  const bf16* KN = (const bf16*)(ws + B_KN);
  const bf16* KR = (const bf16*)(ws + B_KR);
  const bf16* VT = (const bf16*)(ws + B_VT);
  bf16x8 qf[12];
  {
    const bf16* qp = QB + (size_t)(qrow0 + wave * 32 + r) * 1536 + hd * 192 + hf * 8;
#pragma unroll
    for (int kk = 0; kk < 12; kk++) qf[kk] = *(const bf16x8*)(qp + kk * 16);
  }
  f32x16 oacc[4];
#pragma unroll
  for (int i = 0; i < 4; i++)
#pragma unroll
    for (int e = 0; e < 16; e++) oacc[i][e] = 0.f;
  float mrun = -1e30f, lrun = 0.f;
  const int pr = perm23(r);
  for (int kt = kt0; kt < kt1; kt++) {
    __syncthreads();
    const int key0 = kt * 64;
    const int rowbase = key0 < 4096 ? b * 4096 + key0 : ML + b * 256 + (key0 - 4096);
    {
      const char* bk = (const char*)(KN + (size_t)rowbase * 1024 + hd * 128);
      const char* br = (const char*)(KR + (size_t)rowbase * 64);
      const char* bv = (const char*)(VT + ((size_t)((b * 8 + hd) * 128)) * NKEY + key0);
      const uint32_t vo_n = (uint32_t)((tid >> 4) * 2048 + (tid & 15) * 16);
      const uint32_t lo_n = (uint32_t)((tid >> 4) * 400 + (tid & 15) * 16);
      const uint32_t vo_r = (uint32_t)((tid >> 3) * 128 + (tid & 7) * 16);
      const uint32_t lo_r = (uint32_t)((tid >> 3) * 400 + 256 + (tid & 7) * 16);
      const uint32_t vo_v = (uint32_t)((tid >> 3) * (NKEY * 2) + (tid & 7) * 16);
      const uint32_t lo_v = (uint32_t)((tid >> 3) * 144 + (tid & 7) * 16);
      uint4 t0 = *(const uint4*)(bk + vo_n);
      uint4 t1 = *(const uint4*)(bk + 32 * 2048 + vo_n);
      uint4 t4 = *(const uint4*)(br + vo_r);
      uint4 u0 = *(const uint4*)(bv + vo_v);
      uint4 u1 = *(const uint4*)(bv + (size_t)64 * NKEY * 2 + vo_v);
      *(uint4*)((char*)sK + lo_n) = t0;
      *(uint4*)((char*)sK + 32 * 400 + lo_n) = t1;
      *(uint4*)((char*)sK + lo_r) = t4;
      *(uint4*)((char*)sV + lo_v) = u0;
      *(uint4*)((char*)sV + 64 * 144 + lo_v) = u1;
    }
    __syncthreads();
    f32x16 sacc[2];
#pragma unroll
    for (int m = 0; m < 2; m++) {
#pragma unroll
      for (int e = 0; e < 16; e++) sacc[m][e] = 0.f;
      const bf16* kp = sK + (m * 32 + pr) * 200 + hf * 8;
#pragma unroll
      for (int kk = 0; kk < 12; kk++) {
        bf16x8 kf = *(const bf16x8*)(kp + kk * 16);
        sacc[m] = __builtin_amdgcn_mfma_f32_32x32x16_bf16(kf, qf[kk], sacc[m], 0, 0, 0);
        if ((kk & 3) == 3) __builtin_amdgcn_sched_barrier(0);
      }
      __builtin_amdgcn_sched_barrier(0);
    }
    float tmax = sacc[0][0];
#pragma unroll
    for (int e = 1; e < 16; e++) tmax = fmaxf(tmax, sacc[0][e]);
#pragma unroll
    for (int e = 0; e < 16; e++) tmax = fmaxf(tmax, sacc[1][e]);
    tmax = fmaxf(tmax, __shfl_xor(tmax, 32));
    float mnew = fmaxf(mrun, tmax);
    float alpha = __builtin_amdgcn_exp2f(mrun - mnew);
    mrun = mnew;
    float psum = 0.f;
#pragma unroll
    for (int m = 0; m < 2; m++)
#pragma unroll
      for (int e = 0; e < 16; e++) { float pv = __builtin_amdgcn_exp2f(sacc[m][e] - mnew); sacc[m][e] = pv; psum += pv; }
    lrun = lrun * alpha + psum;
#pragma unroll
    for (int i = 0; i < 4; i++)
#pragma unroll
      for (int e = 0; e < 16; e++) oacc[i][e] *= alpha;
#pragma unroll
    for (int s = 0; s < 4; s++) {
      const int m = s >> 1, s2 = s & 1;
      bf16x8 pf;
#pragma unroll
      for (int j = 0; j < 8; j++) pf[j] = (short)f2bf(sacc[m][8 * s2 + j]);
#pragma unroll
      for (int i = 0; i < 4; i++) {
        bf16x8 vf = *(const bf16x8*)(sV + (i * 32 + r) * 72 + m * 32 + s2 * 16 + hf * 8);
        oacc[i] = __builtin_amdgcn_mfma_f32_32x32x16_bf16(vf, pf, oacc[i], 0, 0, 0);
      }
      __builtin_amdgcn_sched_barrier(0);
    }
  }
  lrun += __shfl_xor(lrun, 32);
  const float inv = 1.f / lrun;
  bf16* op = QB + (size_t)(qrow0 + wave * 32 + r) * 1536 + hd * 192;
  if (dry) op = (bf16*)(ws + B_END) + ((((size_t)(qrow0 + wave * 32 + r) * 1536 + hd * 192)) & 0x3ffff8);
#pragma unroll
  for (int i = 0; i < 4; i++)
#pragma unroll
    for (int g = 0; g < 4; g++) {
      uint2 o;
      o.x = pack2(oacc[i][4 * g] * inv, oacc[i][4 * g + 1] * inv);
      o.y = pack2(oacc[i][4 * g + 2] * inv, oacc[i][4 * g + 3] * inv);
      *(uint2*)(op + 32 * i + 8 * g + 4 * hf) = o;
    }
}

DEV void phase_mixers(int tidv, int bidv, const Params& p, int l, char* smem, int dry) {
  int* s_item = (int*)(smem + SM_ITEM);
#ifdef PROBE_PARTS
  const int parts = dry ? PROBE_PARTS : 7;
#else
  const int parts = 7;
#endif
  for (int task = bidv; task < 192; task += gridDim.x) {
    if (task < 128 && !(parts & 1)) continue;
    if (task >= 128 && !(parts & 2)) continue;
    if (task < 128) rwkv_scan(tidv, bidv, p, l, task, smem, dry);
    else s5_scan(tidv, bidv, p, l, (task - 128) * 8 + (tidv >> 6), smem + (tidv >> 6) * 9472, dry);
  }
  const int nlat = 512, ntot = (parts & 4) ? ((l == 0) ? 544 : 512) : 0;
  int* cnt = (int*)(p.ws + B_CNT) + l + 2 * dry;
#if !defined(MIX_ONLY) || MIX_ONLY == 2
  while (true) {
    __syncthreads();
    if (tidv == 0) *s_item = atomicAdd(cnt, 1);
    __syncthreads();
    int item = *s_item;
    if (item >= ntot) break;
    if (item < nlat) attn_item(tidv, bidv, p, item, false, smem, dry);
    else attn_item(tidv, bidv, p, item - nlat, true, smem, dry);
  }
#endif
}

DEV float gelu_tanh(float x) {
  float u = 0.7978845608028654f * (x + 0.044715f * x * x * x);
  return 0.5f * x * (1.f + tanhf(u));
}

DEV void phase_post(int tidv, int bidv, const Params& p, int l, int M) {
  char* ws = p.ws;
  const bf16* Z = (const bf16*)(ws + B_ZB);
  const int wave = tidv >> 6, lane = tidv & 63;
  const float* cw = p.in[17] + (size_t)l * 3 * 3072;
  const bf16* YF = (const bf16*)(ws + B_HB);
  const bf16* YB = (const bf16*)(ws + B_HB + SZ1K);
  const bf16* AF = (const bf16*)(ws + B_AF);
  const bf16* AB = (const bf16*)(ws + B_AB);
  bf16* GB = (bf16*)(ws + B_GB);
  const int nitem = M * 16;
  for (int it = bidv * NW + wave; it < nitem; it += gridDim.x * NW) {
    int row = it >> 4, h = it & 15;
    int ch = h * 64 + lane;
    int tau, len;
    if (row < ML) { tau = row & 4095; len = 4096; } else { tau = (row - ML) & 255; len = 256; }
    size_t o = (size_t)row * 1024 + ch;
    float y = bf2f(YF[o]) + bf2f(YB[o]);
    float mu = wsum(y) * (1.f / 64.f);
    float dv = y - mu;
    float var = wsum(dv * dv) * (1.f / 64.f);
    float yn = dv * rsqrtf(var + 64e-5f) * p.in[26][l * 1024 + ch] + p.in[27][l * 1024 + ch];
    const bf16* z = Z + (size_t)row * NIN + C_R + ch;
    float r1 = bf2f(z[0]), k1 = bf2f(z[1024]), v1 = bf2f(z[2048]);
    float r0 = 0.f, k0 = 0.f, v0 = 0.f, r2 = 0.f, k2 = 0.f, v2 = 0.f;
    if (tau > 0) { const bf16* zm = z - NIN; r0 = bf2f(zm[0]); k0 = bf2f(zm[1024]); v0 = bf2f(zm[2048]); }
    if (tau < len - 1) { const bf16* zp = z + NIN; r2 = bf2f(zp[0]); k2 = bf2f(zp[1024]); v2 = bf2f(zp[2048]); }
    float rr = cw[ch] * r0 + cw[3072 + ch] * r1 + cw[6144 + ch] * r2;
    float kk = cw[1024 + ch] * k0 + cw[3072 + 1024 + ch] * k1 + cw[6144 + 1024 + ch] * k2;
    float vv = cw[2048 + ch] * v0 + cw[3072 + 2048 + ch] * v1 + cw[6144 + 2048 + ch] * v2;
    float am = 0.5f * (bf2f(AF[o]) + bf2f(AB[o]));
    float kbon = kk * (1.f + (am - 1.f) * p.in[24][l * 1024 + ch]);
    float s = wsum(rr * kbon * p.in[25][l * 1024 + ch]);
    float outv = (yn + s * vv) * bf2f(GB[o]);
    GB[o] = f2bf(outv);
  }
  bf16* SY = (bf16*)(ws + B_SY);
  const float* dsk = p.in[35] + l * 1024;
  const int n4 = M * 256;
  for (int i = bidv * NT + tidv; i < n4; i += gridDim.x * NT) {
    int row = i >> 8, c = (i & 255) * 4;
    uint2 a = *(const uint2*)(SY + (size_t)row * 1024 + c);
    uint2 bq = *(const uint2*)(Z + (size_t)row * NIN + c);
    uint2 u = *(const uint2*)(Z + (size_t)row * NIN + C_U + c);
    float4 dd = *(const float4*)(dsk + c);
    float y0 = bf2f((bf16)(a.x & 0xffff)) + bf2f((bf16)(bq.x & 0xffff)) + dd.x * bf2f((bf16)(u.x & 0xffff));
    float y1 = bf2f((bf16)(a.x >> 16)) + bf2f((bf16)(bq.x >> 16)) + dd.y * bf2f((bf16)(u.x >> 16));
    float y2 = bf2f((bf16)(a.y & 0xffff)) + bf2f((bf16)(bq.y & 0xffff)) + dd.z * bf2f((bf16)(u.y & 0xffff));
    float y3 = bf2f((bf16)(a.y >> 16)) + bf2f((bf16)(bq.y >> 16)) + dd.w * bf2f((bf16)(u.y >> 16));
    uint2 o;
    o.x = pack2(gelu_tanh(y0), gelu_tanh(y1));
    o.y = pack2(gelu_tanh(y2), gelu_tanh(y3));
    *(uint2*)(SY + (size_t)row * 1024 + c) = o;
  }
}

constexpr int NPH = 25;

DEV void run_phase(int tidv, int bidv, const Params& p, int ph, char* smem, int dry) {
  char* ws = p.ws;
#ifndef ONLY_S
  if (ph == 0) {
    if (bidv == 0 && tidv < 4) ((int*)(ws + B_CNT))[tidv] = 0;
    phase_mod(tidv, bidv, p, smem);
    phase_convw(tidv, bidv, p, 0, smem);
    return;
  }
#endif
  const int l = (ph - 1) / 12, s = (ph - 1) % 12;
#ifdef ONLY_S
  if (s != ONLY_S) return;
#endif
  const bf16* wb = (const bf16*)(ws + B_WB);
  const float* mod = (const float*)(ws + B_MOD) + (size_t)l * 5 * 12288;
  float* XC = (float*)(ws + B_XC);
  const float* xin_lat = l == 0 ? p.in[0] : p.out;
  const float* xin_ctx = l == 0 ? p.in[2] : XC;
  bf16* HB = (bf16*)(ws + B_HB);
  bf16* Z = (bf16*)(ws + B_ZB);
  bf16* H2 = (bf16*)(ws + B_KN);
  const int Mpost = l == 0 ? MT : ML;
  switch (s) {
    case 0:
      if (l == 1) phase_convw(tidv, bidv, p, 1, smem);
      phase_norm(tidv, bidv, xin_lat, xin_ctx, p.in[6] + l * 2048, mod, 0, 2048, HB, MT);
      break;
    case 1:
      run_gemm<G_IN>(tidv, bidv, p, l, smem, HB, 2048, wb + OW_IN, 2048, NIN, MT, 0, nullptr, nullptr, nullptr, nullptr);
      break;
    case 2:
#if !defined(PH2_ONLY) || PH2_ONLY == 0
      run_gemm<G_UKV>(tidv, bidv, p, l, smem, Z + C_CKV, NIN, wb + OW_UKV, 512, 2048, MT, 0, nullptr, nullptr, nullptr, nullptr);
#endif
#if !defined(PH2_ONLY) || PH2_ONLY == 1
      run_gemm<G_UQ>(tidv, bidv, p, l, smem, Z + C_CQ, NIN, wb + OW_UQ, 512, 1536, MT, 0, nullptr, nullptr, nullptr, nullptr);
#endif
#if !defined(PH2_ONLY) || PH2_ONLY == 2
      run_gemm<G_G2>(tidv, bidv, p, l, smem, Z + C_GD, NIN, wb + OW_G2, 192, 1024, MT, 0, nullptr, nullptr, nullptr, nullptr);
#endif
#if !defined(PH2_ONLY) || PH2_ONLY == 3
      for (int d = 0; d < 2; d++) {
        run_gemm<G_W2>(tidv, bidv, p, l, smem, Z + C_WD + 64 * d, NIN, wb + OW_W2 + (size_t)d * 65536, 64, 1024, MT, d, nullptr, nullptr, nullptr, nullptr);
        run_gemm<G_A2>(tidv, bidv, p, l, smem, Z + C_AD + 64 * d, NIN, wb + OW_A2 + (size_t)d * 65536, 64, 1024, MT, d, nullptr, nullptr, nullptr, nullptr);
      }
#endif
      break;
    case 3: phase_mla_post(tidv, bidv, p, l); break;
    case 4: phase_mixers(tidv, bidv, p, l, smem, dry); break;
    case 5: phase_post(tidv, bidv, p, l, Mpost); break;
    case 6:
      run_gemm<G_GLU>(tidv, bidv, p, l, smem, (const bf16*)(ws + B_SY), 1024, wb + OW_GLU, 1024, 1024, Mpost, 0, nullptr, nullptr, nullptr, nullptr);
      break;
    case 7:
      run_gemm<G_MG0>(tidv, bidv, p, l, smem, (const bf16*)(ws + B_QB), 1536, wb + OW_BR, 1024, 2048, Mpost, 0, nullptr, nullptr, nullptr, nullptr);
      run_gemm<G_MG1>(tidv, bidv, p, l, smem, (const bf16*)(ws + B_GB), 1024, wb + OW_BR + (size_t)2048 * 1024, 1024, 2048, Mpost, 0, nullptr, nullptr, nullptr, nullptr);
      run_gemm<G_MG2>(tidv, bidv, p, l, smem, Z, NIN, wb + OW_BR + (size_t)2 * 2048 * 1024, 1024, 2048, Mpost, 0, nullptr, nullptr, nullptr, nullptr);
      break;
    case 8:
      run_gemm<G_OUT>(tidv, bidv, p, l, smem, HB, 2048, wb + OW_OUT, 2048, 2048, Mpost, 0, xin_lat, xin_ctx, p.out, XC);
      break;
    case 9:
      phase_norm(tidv, bidv, p.out, XC, p.in[7] + l * 2048, mod, 6144, 8192, H2, Mpost);
      break;
    case 10:
      run_gemm<G_M1>(tidv, bidv, p, l, smem, H2, 2048, wb + OW_M1, 2048, 8192, Mpost, 0, nullptr, nullptr, nullptr, nullptr);
      break;
    case 11:
      run_gemm<G_M2>(tidv, bidv, p, l, smem, Z, 8192, wb + OW_M2, 8192, 2048, Mpost, 0, nullptr, nullptr, p.out, XC);
      break;
  }
}

__global__ void __launch_bounds__(NT) fwd_megakernel(Params p, int ph0, int ph1, int dryflag) {
  extern __shared__ __attribute__((aligned(16))) char smem[];
  for (int ph = ph0; ph < ph1; ph++) {
    int tidv = threadIdx.x, bidv = blockIdx.x;
    asm volatile("" : "+v"(tidv));
    asm volatile("" : "+s"(bidv));
#ifdef PROBE_MASK
    if (dryflag && ((ph == 0 && (PROBE_MASK & 0x1000)) || (ph > 0 && ((PROBE_MASK >> ((ph - 1) % 12)) & 1)))) {
      run_phase(tidv, bidv, p, ph, smem, dryflag);
      cg::this_grid().sync();
    }
#endif
    run_phase(tidv, bidv, p, ph, smem, 0);
    if (ph + 1 < ph1) cg::this_grid().sync();
  }
}

extern "C" void kernel_launch(void* const* d_in, const int* in_sizes, int n_in, void* d_out, int out_size, void* d_ws, size_t ws_size,
                              hipStream_t stream) {
  static int grid_blocks = 0;
  if (!grid_blocks) {
    int dev = 0, cus = 0, per_cu = 0;
    (void)hipGetDevice(&dev);
    (void)hipDeviceGetAttribute(&cus, hipDeviceAttributeMultiprocessorCount, dev);
    if (hipFuncSetAttribute((const void*)fwd_megakernel, hipFuncAttributeMaxDynamicSharedMemorySize, LDS_BYTES) != hipSuccess) {
      fprintf(stderr, "hipFuncSetAttribute(%d B dynamic LDS) failed\n", LDS_BYTES);
      return;
    }
    if (hipOccupancyMaxActiveBlocksPerMultiprocessor(&per_cu, (const void*)fwd_megakernel, NT, LDS_BYTES) != hipSuccess || per_cu < 1) {
      fprintf(stderr, "occupancy query failed / kernel not resident\n");
      return;
    }
    grid_blocks = cus;
  }
  Params p{};
  for (int i = 0; i < 42; i++) p.in[i] = (const float*)d_in[i];
  p.out = (float*)d_out;
  p.ws = (char*)d_ws;
  if (ws_size < B_END + (8u << 20)) { fprintf(stderr, "workspace too small\n"); return; }
  int ph0 = 0, ph1 = NPH;
  int dryflag = 1;
  void* args[] = {&p, &ph0, &ph1, &dryflag};
  hipError_t e = hipLaunchCooperativeKernel((void*)fwd_megakernel, dim3(grid_blocks), dim3(NT), args, LDS_BYTES, stream);
  if (e != hipSuccess) fprintf(stderr, "cooperative launch failed: %s (grid %d)\n", hipGetErrorString(e), grid_blocks);
}
```

```cpp
#include <hip/hip_runtime.h>
#include <hip/hip_cooperative_groups.h>
#include <stdint.h>
#include <cstdio>
namespace cg = cooperative_groups;

#ifndef MULTI_LAUNCH
#define MULTI_LAUNCH 0
#endif

typedef unsigned short bf16;
using bf16x8 = __attribute__((ext_vector_type(8))) short;
using f32x4 = __attribute__((ext_vector_type(4))) float;
using f32x16 = __attribute__((ext_vector_type(16))) float;

#define DEV __device__ __forceinline__
constexpr int NT = 512, NW = 8;

constexpr int DM = 2048, ML = 16384, MC = 1024, MT = 17408, NIN = 11744, DFF = 8192, NKEY = 4352;
constexpr int C_CQ = 0, C_CKV = 512, C_KR = 1024, C_R = 1088, C_WD = 4160, C_AD = 4288, C_GD = 4416, C_U = 4576, C_GATE = 5600;

constexpr size_t OW_IN = 0;
constexpr size_t OW_UQ = OW_IN + (size_t)NIN * 2048;
constexpr size_t OW_UKV = OW_UQ + 1536 * 512;
constexpr size_t OW_W2 = OW_UKV + 2048 * 512;
constexpr size_t OW_A2 = OW_W2 + 2 * 1024 * 64;
constexpr size_t OW_G2 = OW_A2 + 2 * 1024 * 64;
constexpr size_t OW_GLU = OW_G2 + 1024 * 192;
constexpr size_t OW_BR = OW_GLU + 1024 * 1024;
constexpr size_t OW_OUT = OW_BR + (size_t)3 * 2048 * 1024;
constexpr size_t OW_M1 = OW_OUT + (size_t)2048 * 2048;
constexpr size_t OW_M2 = OW_M1 + (size_t)8192 * 2048;
constexpr size_t OW_END = OW_M2 + (size_t)8192 * 2048;

constexpr size_t SZ1K = (size_t)MT * 1024 * 2;
constexpr size_t B_WB = 0;
constexpr size_t B_HB = B_WB + OW_END * 2;
constexpr size_t B_ZB = B_HB + (size_t)MT * 2048 * 2;
constexpr size_t B_QB = B_ZB + (size_t)MT * NIN * 2;
constexpr size_t B_KN = B_QB + (size_t)MT * 1536 * 2;
constexpr size_t B_VT = B_KN + SZ1K;
constexpr size_t B_KR = B_VT + SZ1K;
constexpr size_t B_AF = B_KR + (size_t)MT * 64 * 2;
constexpr size_t B_AB = B_AF + SZ1K;
constexpr size_t B_GB = B_AB + SZ1K;
constexpr size_t B_SY = B_GB + SZ1K;
constexpr size_t B_XC = B_SY + SZ1K;
constexpr size_t B_MOD = B_XC + (size_t)MC * 2048 * 4;
constexpr size_t B_CNT = B_MOD + (size_t)2 * 5 * 12288 * 4;
constexpr size_t B_FLG = B_CNT + 256;
constexpr size_t B_END = B_FLG + 4096;

struct Params {
  const float* in[42];
  float* out;
  char* ws;
};

typedef __attribute__((ext_vector_type(2))) __bf16 hbf2;
DEV bf16 f2bf(float f) {
  __bf16 h = (__bf16)f;
  return *(unsigned short*)&h;
}
DEV float bf2f(bf16 h) { return __uint_as_float(((uint32_t)h) << 16); }
DEV uint32_t pack2(float a, float b) {
  hbf2 v;
  v[0] = (__bf16)a;
  v[1] = (__bf16)b;
  return *(uint32_t*)&v;
}
DEV float wsum(float v) {
#pragma unroll
  for (int o = 32; o > 0; o >>= 1) v += __shfl_xor(v, o);
  return v;
}
DEV float dpp_xor1(float v) {
  int i = __float_as_int(v);
  return __int_as_float(__builtin_amdgcn_update_dpp(0, i, 0xB1, 0xF, 0xF, true));
}
DEV float dpp_xor2(float v) {
  int i = __float_as_int(v);
  return __int_as_float(__builtin_amdgcn_update_dpp(0, i, 0x4E, 0xF, 0xF, true));
}
DEV float sigmoidf_(float x) { return __builtin_amdgcn_rcpf(1.f + __expf(-x)); }

DEV void phase_mod(int tidv, int bidv, const Params& p, char* smem) {
  float* s_in = (float*)smem;
  float* red = s_in + 5 * 2048;
  float* mod = (float*)(p.ws + B_MOD);
  for (int i = tidv; i < 5 * 2048; i += NT) {
    int r = i >> 11, k = i & 2047;
    float v = r < 4 ? p.in[1][r * 2048 + k] : p.in[3][k];
    s_in[i] = v / (1.f + expf(-v));
  }
  __syncthreads();
  int kg = tidv >> 6, c = tidv & 63;
  for (int task = bidv; task < 2 * 192; task += gridDim.x) {
    int l = task / 192, n = (task % 192) * 64 + c;
    const float* w = p.in[4] + (size_t)l * 2048 * 12288 + n;
    float a0 = 0, a1 = 0, a2 = 0, a3 = 0, a4 = 0;
    int kb = kg * 256;
#pragma unroll 8
    for (int k = 0; k < 256; k++) {
      float wv = w[(size_t)(kb + k) * 12288];
      a0 += s_in[kb + k] * wv;
      a1 += s_in[2048 + kb + k] * wv;
      a2 += s_in[4096 + kb + k] * wv;
      a3 += s_in[6144 + kb + k] * wv;
      a4 += s_in[8192 + kb + k] * wv;
    }
    red[(kg * 5 + 0) * 64 + c] = a0;
    red[(kg * 5 + 1) * 64 + c] = a1;
    red[(kg * 5 + 2) * 64 + c] = a2;
    red[(kg * 5 + 3) * 64 + c] = a3;
    red[(kg * 5 + 4) * 64 + c] = a4;
    __syncthreads();
    if (kg == 0) {
      float bias = p.in[5][l * 12288 + n];
#pragma unroll
      for (int r = 0; r < 5; r++) {
        float v = 0.f;
#pragma unroll
        for (int g = 0; g < 8; g++) v += red[(g * 5 + r) * 64 + c];
        mod[(size_t)(l * 5 + r) * 12288 + n] = v + bias;
      }
    }
    __syncthreads();
  }
}

DEV void convT(int tidv, int bidv, const float* __restrict__ src, bf16* __restrict__ dst, int K, int N, const float* __restrict__ gain, char* smem, int dK = 0) {
  if (dK == 0) dK = K;
  float* t = (float*)smem;
  int tk = (K + 63) >> 6, tn = (N + 63) >> 6;
  for (int tile = bidv; tile < tk * tn; tile += gridDim.x) {
    int k0 = (tile / tn) * 64, n0 = (tile % tn) * 64;
    __syncthreads();
#pragma unroll 4
    for (int i = 0; i < 8; i++) {
      int kk = i * 8 + (tidv >> 6), nn = tidv & 63;
      float v = 0.f;
      if (k0 + kk < K && n0 + nn < N) {
        v = src[(size_t)(k0 + kk) * N + n0 + nn];
        if (gain) v *= gain[k0 + kk];
      }
      t[kk * 65 + nn] = v;
    }
    __syncthreads();
    {
      int c = tidv;
      int nn = c >> 3, kc = c & 7;
      if (n0 + nn < N && k0 + kc * 8 < dK) {
        uint4 o;
        o.x = pack2(t[(kc * 8 + 0) * 65 + nn], t[(kc * 8 + 1) * 65 + nn]);
        o.y = pack2(t[(kc * 8 + 2) * 65 + nn], t[(kc * 8 + 3) * 65 + nn]);
        o.z = pack2(t[(kc * 8 + 4) * 65 + nn], t[(kc * 8 + 5) * 65 + nn]);
        o.w = pack2(t[(kc * 8 + 6) * 65 + nn], t[(kc * 8 + 7) * 65 + nn]);
        *(uint4*)(dst + (size_t)(n0 + nn) * dK + k0 + kc * 8) = o;
      }
    }
  }
}

DEV void phase_convw(int tidv, int bidv, const Params& p, int l, char* smem) {
  bf16* wb = (bf16*)(p.ws + B_WB);
  convT(tidv, bidv, p.in[8] + (size_t)l * 2048 * NIN, wb + OW_IN, 2048, NIN, nullptr, smem);
  convT(tidv, bidv, p.in[40] + (size_t)l * 2048 * 8192, wb + OW_M1, 2048, 8192, nullptr, smem);
  convT(tidv, bidv, p.in[41] + (size_t)l * 8192 * 2048, wb + OW_M2, 8192, 2048, nullptr, smem);
  for (int n = 0; n < 3; n++)
    convT(tidv, bidv, p.in[38] + (size_t)(l * 3 + n) * 1024 * 2048, wb + OW_BR + (size_t)n * 2048 * 1024, 1024, 2048, nullptr, smem);
  convT(tidv, bidv, p.in[39] + (size_t)l * 2048 * 2048, wb + OW_OUT, 2048, 2048, nullptr, smem);
  convT(tidv, bidv, p.in[11] + (size_t)l * 512 * 1536, wb + OW_UQ, 512, 1536, p.in[9] + l * 512, smem);
  convT(tidv, bidv, p.in[12] + (size_t)l * 512 * 2048, wb + OW_UKV, 512, 2048, p.in[10] + l * 512, smem);
  convT(tidv, bidv, p.in[36] + (size_t)l * 1024 * 1024, wb + OW_GLU, 1024, 1024, nullptr, smem);
  for (int d = 0; d < 2; d++) {
    convT(tidv, bidv, p.in[19] + (size_t)(l * 2 + d) * 64 * 1024, wb + OW_W2 + (size_t)d * 65536, 64, 1024, nullptr, smem);
    convT(tidv, bidv, p.in[21] + (size_t)(l * 2 + d) * 64 * 1024, wb + OW_A2 + (size_t)d * 65536, 64, 1024, nullptr, smem);
  }
  convT(tidv, bidv, p.in[22] + (size_t)l * 160 * 1024, wb + OW_G2, 160, 1024, nullptr, smem, 192);
}

DEV void phase_norm(int tidv, int bidv, const float* xlat, const float* xctx, const float* g, const float* mod, int shOff, int scOff, bf16* H, int nrows) {
  int wave = tidv >> 6, lane = tidv & 63;
  for (int row = bidv * NW + wave; row < nrows; row += gridDim.x * NW) {
    const float* x = row < ML ? xlat + (size_t)row * 2048 : xctx + (size_t)(row - ML) * 2048;
    int b = row < ML ? (row >> 12) : 4;
    const float* sh = mod + b * 12288 + shOff;
    const float* sc = mod + b * 12288 + scOff;
    float4 v[8];
    float ss = 0.f;
#pragma unroll
    for (int i = 0; i < 8; i++) {
      v[i] = *(const float4*)(x + i * 256 + lane * 4);
      ss += v[i].x * v[i].x + v[i].y * v[i].y + v[i].z * v[i].z + v[i].w * v[i].w;
    }
    ss = wsum(ss);
    float rinv = rsqrtf(ss * (1.f / 2048.f) + 1e-6f);
#pragma unroll
    for (int i = 0; i < 8; i++) {
      int c = i * 256 + lane * 4;
      float4 g4 = *(const float4*)(g + c), s4 = *(const float4*)(sc + c), h4 = *(const float4*)(sh + c);
      float y0 = v[i].x * rinv * g4.x * (1.f + s4.x) + h4.x;
      float y1 = v[i].y * rinv * g4.y * (1.f + s4.y) + h4.y;
      float y2 = v[i].z * rinv * g4.z * (1.f + s4.z) + h4.z;
      float y3 = v[i].w * rinv * g4.w * (1.f + s4.w) + h4.w;
      uint2 o;
      o.x = pack2(y0, y1);
      o.y = pack2(y2, y3);
      *(uint2*)(H + (size_t)row * 2048 + c) = o;
    }
  }
}

constexpr int LDT = 72;
constexpr int GA_BYTES = 256 * LDT * 2;
constexpr int GSTAGE = 512 * LDT * 2;
constexpr int SM_RINV = 2 * GSTAGE;
constexpr int SM_ITEM = SM_RINV + 1024;
constexpr int LDS_BYTES = SM_ITEM + 16;
DEV float sumsq8(uint4 r) {
  float s = 0.f, x;
  x = bf2f((bf16)(r.x & 0xffff)); s += x * x; x = bf2f((bf16)(r.x >> 16)); s += x * x;
  x = bf2f((bf16)(r.y & 0xffff)); s += x * x; x = bf2f((bf16)(r.y >> 16)); s += x * x;
  x = bf2f((bf16)(r.z & 0xffff)); s += x * x; x = bf2f((bf16)(r.z >> 16)); s += x * x;
  x = bf2f((bf16)(r.w & 0xffff)); s += x * x; x = bf2f((bf16)(r.w >> 16)); s += x * x;
  return s;
}

template <bool ROWNORM>
DEV void gemm_mainloop(int tidv, int bidv, const bf16* __restrict__ A, int lda, bool amap, const bf16* __restrict__ Bt, int K, int N, int m0, int n0,
                       char* smem, f32x16 (&acc)[4][2]) {
  float* srinv = (float*)(smem + SM_RINV);
  const int tid = tidv, lane = tid & 63, wave = tid >> 6;
  const int wm = wave >> 2, wn = wave & 3;
  const int lr = tid >> 3, kc = tid & 7;
  const char* abase = (const char*)(A + (size_t)m0 * lda);
  const char* bbase = (const char*)(Bt + (size_t)n0 * K);
  const uint32_t voa = (uint32_t)(lr * lda + kc * 8) * 2u;
  const uint32_t astep = (uint32_t)(64 * lda) * 2u;
  const uint32_t vob0 = (uint32_t)(lr * K + kc * 8) * 2u;
  const uint32_t bstep = (uint32_t)(64 * K) * 2u;
  const uint32_t lds_st = (uint32_t)(lr * LDT + kc * 8) * 2u;
  const int nk = K >> 6;
  uint4 xa0, xa1, xa2, xa3, xb0, xb1, xb2, xb3;
#define G_LOAD(KT)                                                         \
  {                                                                        \
    const int k0_ = (KT) << 6;                                             \
    const int ka_ = amap ? ((k0_ >> 7) * 192 + (k0_ & 127)) : k0_;         \
    xa0 = *(const uint4*)(abase + (size_t)ka_ * 2 + voa);                  \
    xa1 = *(const uint4*)(abase + (size_t)ka_ * 2 + astep + voa);          \
    xa2 = *(const uint4*)(abase + (size_t)ka_ * 2 + 2 * astep + voa);      \
    xa3 = *(const uint4*)(abase + (size_t)ka_ * 2 + 3 * astep + voa);      \
    xb0 = *(const uint4*)(bbase + (size_t)k0_ * 2 + vob0);                 \
    xb1 = *(const uint4*)(bbase + (size_t)k0_ * 2 + bstep + vob0);         \
    xb2 = *(const uint4*)(bbase + (size_t)k0_ * 2 + 2 * bstep + vob0);     \
    xb3 = *(const uint4*)(bbase + (size_t)k0_ * 2 + 3 * bstep + vob0);     \
  }
#define G_STORE(SN)                                                  \
  *(uint4*)((SN) + lds_st) = xa0;                                    \
  *(uint4*)((SN) + 1 * (64 * LDT * 2) + lds_st) = xa1;               \
  *(uint4*)((SN) + 2 * (64 * LDT * 2) + lds_st) = xa2;               \
  *(uint4*)((SN) + 3 * (64 * LDT * 2) + lds_st) = xa3;               \
  *(uint4*)((SN) + GA_BYTES + lds_st) = xb0;                         \
  *(uint4*)((SN) + GA_BYTES + 1 * (64 * LDT * 2) + lds_st) = xb1;    \
  *(uint4*)((SN) + GA_BYTES + 2 * (64 * LDT * 2) + lds_st) = xb2;    \
  *(uint4*)((SN) + GA_BYTES + 3 * (64 * LDT * 2) + lds_st) = xb3;
  const uint32_t fa = (uint32_t)((wm * 128 + (lane & 31)) * LDT + (lane >> 5) * 8) * 2u;
  const uint32_t fb = (uint32_t)GA_BYTES + (uint32_t)((wn * 64 + (lane & 31)) * LDT + (lane >> 5) * 8) * 2u;
  const int nkm = nk - 1;
  if (ROWNORM) {
    __syncthreads();
#pragma unroll 1
    for (int i = 0; i < 4; i++) {
      float ss = 0.f;
      for (int kk = 0; kk < nk; kk++) ss += sumsq8(*(const uint4*)(abase + (size_t)kk * 128 + i * astep + voa));
      ss += __shfl_xor(ss, 1); ss += __shfl_xor(ss, 2); ss += __shfl_xor(ss, 4);
      if (kc == 0) srinv[lr + 64 * i] = rsqrtf(ss / (float)K + 1e-6f);
    }
  }
  G_LOAD(0)
  __syncthreads();
  G_STORE(smem)
  G_LOAD((1 < nkm ? 1 : nkm))
  __syncthreads();
#define G_FRAG(P, ST, KS)                                                            \
  P##a0 = *(const bf16x8*)((ST) + fa + 0 * (32 * LDT * 2) + (KS) * 32);                \
  P##a1 = *(const bf16x8*)((ST) + fa + 1 * (32 * LDT * 2) + (KS) * 32);                \
  P##a2 = *(const bf16x8*)((ST) + fa + 2 * (32 * LDT * 2) + (KS) * 32);                \
  P##a3 = *(const bf16x8*)((ST) + fa + 3 * (32 * LDT * 2) + (KS) * 32);                \
  P##b0 = *(const bf16x8*)((ST) + fb + 0 * (32 * LDT * 2) + (KS) * 32);                \
  P##b1 = *(const bf16x8*)((ST) + fb + 1 * (32 * LDT * 2) + (KS) * 32);
#define G_MMA(P)                                                                              \
  acc[0][0] = __builtin_amdgcn_mfma_f32_32x32x16_bf16(P##b0, P##a0, acc[0][0], 0, 0, 0);      \
  acc[0][1] = __builtin_amdgcn_mfma_f32_32x32x16_bf16(P##b1, P##a0, acc[0][1], 0, 0, 0);      \
  acc[1][0] = __builtin_amdgcn_mfma_f32_32x32x16_bf16(P##b0, P##a1, acc[1][0], 0, 0, 0);      \
  acc[1][1] = __builtin_amdgcn_mfma_f32_32x32x16_bf16(P##b1, P##a1, acc[1][1], 0, 0, 0);      \
  acc[2][0] = __builtin_amdgcn_mfma_f32_32x32x16_bf16(P##b0, P##a2, acc[2][0], 0, 0, 0);      \
  acc[2][1] = __builtin_amdgcn_mfma_f32_32x32x16_bf16(P##b1, P##a2, acc[2][1], 0, 0, 0);      \
  acc[3][0] = __builtin_amdgcn_mfma_f32_32x32x16_bf16(P##b0, P##a3, acc[3][0], 0, 0, 0);      \
  acc[3][1] = __builtin_amdgcn_mfma_f32_32x32x16_bf16(P##b1, P##a3, acc[3][1], 0, 0, 0);
  bf16x8 pa0, pa1, pa2, pa3, pb0, pb1, qa0, qa1, qa2, qa3, qb0, qb1;
#pragma unroll 1
  for (int kt = 0; kt < nk; kt++) {
    const char* st = smem + (kt & 1) * GSTAGE;
    char* sn = smem + ((kt + 1) & 1) * GSTAGE;
    if (!ROWNORM) {
      G_FRAG(p, st, 0)
      G_FRAG(q, st, 1)
      __builtin_amdgcn_sched_barrier(0);
      G_MMA(p)
      __builtin_amdgcn_sched_barrier(0);
      G_FRAG(p, st, 2)
      __builtin_amdgcn_sched_barrier(0);
      G_MMA(q)
      __builtin_amdgcn_sched_barrier(0);
      G_FRAG(q, st, 3)
      if (kt + 1 < nk) { G_STORE(sn) }
      G_LOAD((kt + 2 < nkm ? kt + 2 : nkm))
      __builtin_amdgcn_sched_barrier(0);
      G_MMA(p)
      __builtin_amdgcn_sched_barrier(0);
      G_MMA(q)
    } else {
      G_FRAG(p, st, 0)
      __builtin_amdgcn_sched_barrier(0);
      G_MMA(p)
      __builtin_amdgcn_sched_barrier(0);
      G_FRAG(p, st, 1)
      __builtin_amdgcn_sched_barrier(0);
      G_MMA(p)
      __builtin_amdgcn_sched_barrier(0);
      G_FRAG(p, st, 2)
      if (kt + 1 < nk) { G_STORE(sn) }
      G_LOAD((kt + 2 < nkm ? kt + 2 : nkm))
      __builtin_amdgcn_sched_barrier(0);
      G_MMA(p)
      __builtin_amdgcn_sched_barrier(0);
      G_FRAG(p, st, 3)
      __builtin_amdgcn_sched_barrier(0);
      G_MMA(p)
    }
    __syncthreads();
  }
#undef G_FRAG
#undef G_MMA
#undef G_LOAD
#undef G_STORE
}

DEV void zero_acc(f32x16 (&acc)[4][2]) {
#pragma unroll
  for (int i = 0; i < 4; i++)
#pragma unroll
    for (int j = 0; j < 2; j++)
#pragma unroll
      for (int e = 0; e < 16; e++) acc[i][j][e] = 0.f;
}

template <class F>
DEV void epi_loop(int tidv, int bidv, f32x16 (&acc)[4][2], int m0, int n0, int N, F f) {
  const int lane = tidv & 63, wave = tidv >> 6;
  const int wm = wave >> 2, wn = wave & 3;
#pragma unroll
  for (int i = 0; i < 4; i++) {
    const int lrow = wm * 128 + i * 32 + (lane & 31);
#pragma unroll
    for (int j = 0; j < 2; j++) {
#pragma unroll
      for (int g = 0; g < 4; g++) {
        int col = n0 + wn * 64 + j * 32 + 8 * g + 4 * (lane >> 5);
        f32x4 v = {acc[i][j][4 * g], acc[i][j][4 * g + 1], acc[i][j][4 * g + 2], acc[i][j][4 * g + 3]};
        if (col < N) f(m0 + lrow, lrow, col, v);
      }
    }
    __builtin_amdgcn_sched_barrier(0);
  }
}

DEV uint2 pack4(f32x4 v) {
  uint2 o;
  o.x = pack2(v[0], v[1]);
  o.y = pack2(v[2], v[3]);
  return o;
}
DEV f32x4 unpack4(uint2 u) {
  f32x4 v;
  v[0] = bf2f((bf16)(u.x & 0xffff)); v[1] = bf2f((bf16)(u.x >> 16));
  v[2] = bf2f((bf16)(u.y & 0xffff)); v[3] = bf2f((bf16)(u.y >> 16));
  return v;
}

enum { G_IN = 0, G_UQ, G_UKV, G_W2, G_A2, G_G2, G_GLU, G_OUT, G_M1, G_M2, G_MG0, G_MG1, G_MG2 };

template <int MODE>
DEV void run_gemm(int tidv, int bidv, const Params& p, int l, char* smem, const bf16* A, int lda, const bf16* Bt, int K, int N, int M, int aux,
                  const float* xin_lat, const float* xin_ctx, float* xout_lat, float* xout_ctx) {
  const int nt = (N + 255) >> 8, mt = M >> 8;
  char* ws = p.ws;
  bf16* Z = (bf16*)(ws + B_ZB);
  const float* srinv = (const float*)(smem + SM_RINV);
  const float* mod = (const float*)(ws + B_MOD) + (size_t)l * 5 * 12288;
  for (int tile = bidv; tile < nt * mt; tile += gridDim.x) {
    int m0 = (tile / nt) << 8, n0 = (tile % nt) << 8;
    f32x16 acc[4][2];
    zero_acc(acc);
    gemm_mainloop<(MODE == G_UQ || MODE == G_UKV)>(tidv, bidv, A, lda, MODE == G_MG0, Bt, K, N, m0, n0, smem, acc);
    if constexpr (MODE != G_OUT && MODE != G_M2)
    epi_loop(tidv, bidv, acc, m0, n0, N, [&](int row, int lrow, int col, f32x4 v) {
      if constexpr (MODE == G_IN) {
        f32x4 o = v;
        if (col >= C_GATE || (col >= C_GD && col < C_U)) {
#pragma unroll
          for (int r = 0; r < 4; r++) o[r] = sigmoidf_(v[r]);
        } else if (col >= C_WD && col < C_AD) {
#pragma unroll
          for (int r = 0; r < 4; r++) o[r] = tanhf(v[r]);
        }
        *(uint2*)(smem + ((size_t)lrow * 264 + (col - n0)) * 2) = pack4(o);
      } else if constexpr (MODE == G_UQ) {
        float ri = srinv[lrow];
        *(uint2*)((bf16*)(ws + B_QB) + (size_t)row * 1536 + col) = pack4(v * ri);
      } else if constexpr (MODE == G_UKV) {
        float ri = srinv[lrow];
        f32x4 o = v * ri;
        int h = col >> 8, c = col & 255;
        if (c < 128) {
          *(uint2*)((bf16*)(ws + B_KN) + (size_t)row * 1024 + h * 128 + c) = pack4(o);
        } else {
          int b, kp;
          if (row < ML) { b = row >> 12; kp = row & 4095; } else { int r2 = row - ML; b = r2 >> 8; kp = 4096 + (r2 & 255); }
          bf16* vt = (bf16*)(ws + B_VT) + ((size_t)((b * 8 + h) * 128 + (c - 128))) * NKEY + kp;
#pragma unroll
          for (int r = 0; r < 4; r++) vt[(size_t)r * NKEY] = f2bf(o[r]);
        }
      } else if constexpr (MODE == G_W2) {
        float4 w0 = *(const float4*)(p.in[18] + (l * 2 + aux) * 1024 + col);
        f32x4 o;
        o[0] = 0.60653066f * sigmoidf_(w0.x + v[0]);
        o[1] = 0.60653066f * sigmoidf_(w0.y + v[1]);
        o[2] = 0.60653066f * sigmoidf_(w0.z + v[2]);
        o[3] = 0.60653066f * sigmoidf_(w0.w + v[3]);
        *(uint2*)((bf16*)(ws + B_HB + (size_t)aux * SZ1K) + (size_t)row * 1024 + col) = pack4(o);
      } else if constexpr (MODE == G_A2) {
        float4 a0 = *(const float4*)(p.in[20] + (l * 2 + aux) * 1024 + col);
        f32x4 o;
        o[0] = sigmoidf_(a0.x + v[0]);
        o[1] = sigmoidf_(a0.y + v[1]);
        o[2] = sigmoidf_(a0.z + v[2]);
        o[3] = sigmoidf_(a0.w + v[3]);
        *(uint2*)((bf16*)(ws + (aux ? B_AB : B_AF)) + (size_t)row * 1024 + col) = pack4(o);
      } else if constexpr (MODE == G_G2) {
        *(uint2*)((bf16*)(ws + B_GB) + (size_t)row * 1024 + col) = pack4(v);
      } else if constexpr (MODE == G_GLU) {
        f32x4 zz = unpack4(*(const uint2*)((const bf16*)(ws + B_SY) + (size_t)row * 1024 + col));
        float4 gb = *(const float4*)(p.in[37] + l * 1024 + col);
        f32x4 o;
        o[0] = zz[0] * sigmoidf_(v[0] + gb.x);
        o[1] = zz[1] * sigmoidf_(v[1] + gb.y);
        o[2] = zz[2] * sigmoidf_(v[2] + gb.z);
        o[3] = zz[3] * sigmoidf_(v[3] + gb.w);
        *(uint2*)(smem + ((size_t)lrow * 264 + (col - n0)) * 2) = pack4(o);
      } else if constexpr (MODE == G_OUT || MODE == G_M2) {
      } else if constexpr (MODE == G_M1) {
        f32x4 o;
#pragma unroll
        for (int r = 0; r < 4; r++) { float t = fmaxf(v[r], 0.f); o[r] = t * t; }
        *(uint2*)(smem + ((size_t)lrow * 264 + (col - n0)) * 2) = pack4(o);
      } else if constexpr (MODE == G_MG0 || MODE == G_MG1 || MODE == G_MG2) {
        *(uint2*)(smem + ((size_t)lrow * 264 + (col - n0)) * 2) = pack4(v);
      }
    });
    if constexpr (MODE == G_OUT || MODE == G_M2) {
      float* tilef = (float*)smem;
      constexpr int GOFF = (MODE == G_OUT) ? 4096 : 10240;
      const int wn_ = (tidv >> 6) & 3;
#pragma unroll 1
      for (int half = 0; half < 2; half++) {
        if ((wn_ >> 1) == half) {
          epi_loop(tidv, bidv, acc, m0, n0, N, [&](int row, int lrow, int col, f32x4 v) {
            *(f32x4*)(tilef + (size_t)lrow * 132 + (col - n0 - half * 128)) = v;
          });
        }
        __syncthreads();
#pragma unroll 2
        for (int it = 0; it < 16; it++) {
          int c = it * NT + tidv;
          int r = c >> 5, ch = c & 31;
          int row = m0 + r, col = n0 + half * 128 + ch * 4;
          int b = row < ML ? (row >> 12) : 4;
          float4 g = *(const float4*)(mod + b * 12288 + GOFF + col);
          const float* xi;
          if constexpr (MODE == G_OUT) xi = row < ML ? xin_lat + (size_t)row * 2048 : xin_ctx + (size_t)(row - ML) * 2048;
          else xi = row < ML ? xout_lat + (size_t)row * 2048 : xout_ctx + (size_t)(row - ML) * 2048;
          float* xo = row < ML ? xout_lat + (size_t)row * 2048 : xout_ctx + (size_t)(row - ML) * 2048;
          float4 x = *(const float4*)(xi + col);
          f32x4 v = *(const f32x4*)(tilef + (size_t)r * 132 + ch * 4);
          x.x += g.x * v[0]; x.y += g.y * v[1]; x.z += g.z * v[2]; x.w += g.w * v[3];
          *(float4*)(xo + col) = x;
        }
        __syncthreads();
      }
    }
    if constexpr (MODE == G_MG0 || MODE == G_MG1 || MODE == G_MG2) {
      constexpr int nb = MODE - G_MG0;
      bf16* MG = (bf16*)(ws + B_HB);
      __syncthreads();
#pragma unroll 2
      for (int it = 0; it < 16; it++) {
        int c = it * NT + tidv;
        int r = c >> 5, ch = c & 31;
        int col = n0 + ch * 8;
        uint4 pv = *(const uint4*)(smem + ((size_t)r * 264 + ch * 8) * 2);
        uint4 gv = *(const uint4*)(Z + (size_t)(m0 + r) * NIN + C_GATE + nb * 2048 + col);
        f32x4 p0 = unpack4(uint2{pv.x, pv.y}), p1 = unpack4(uint2{pv.z, pv.w});
        f32x4 g0 = unpack4(uint2{gv.x, gv.y}), g1 = unpack4(uint2{gv.z, gv.w});
        f32x4 o0 = g0 * p0, o1 = g1 * p1;
        if constexpr (nb > 0) {
          uint4 qv = *(const uint4*)(MG + (size_t)(m0 + r) * 2048 + col);
          o0 += unpack4(uint2{qv.x, qv.y});
          o1 += unpack4(uint2{qv.z, qv.w});
        }
        uint2 a = pack4(o0), b = pack4(o1);
        *(uint4*)(MG + (size_t)(m0 + r) * 2048 + col) = uint4{a.x, a.y, b.x, b.y};
      }
    }
    if constexpr (MODE == G_IN || MODE == G_GLU || MODE == G_M1) {
      bf16* dst;
      int ld;
      if constexpr (MODE == G_IN || MODE == G_GLU) { dst = Z; ld = NIN; }
      else { dst = Z; ld = DFF; }
      __syncthreads();
#pragma unroll 4
      for (int it = 0; it < 16; it++) {
        int c = it * NT + tidv;
        int r = c >> 5, ch = c & 31;
        int col = n0 + ch * 8;
        if (col < N) *(uint4*)(dst + (size_t)(m0 + r) * ld + col) = *(const uint4*)(smem + ((size_t)r * 264 + ch * 8) * 2);
      }
    }
  }
}

DEV void phase_mla_post(int tidv, int bidv, const Params& p, int l) {
  char* ws = p.ws;
  const float* qng = p.in[13] + l * 128;
  const float* qrg = p.in[14] + l * 64;
  const float* kng = p.in[15] + l * 128;
  const float* krg = p.in[16] + l * 64;
  bf16* QB = (bf16*)(ws + B_QB);
  bf16* KN = (bf16*)(ws + B_KN);
  bf16* KR = (bf16*)(ws + B_KR);
  const bf16* Z = (const bf16*)(ws + B_ZB);
  const int wave = tidv >> 6, lane = tidv & 63;
  const float QS = 1.4426950408889634f * 0.07216878364870322f;
  const int idx = lane & 31;
  const float inv = powf(10000.f, -(float)(idx & 15) / 16.f);
  const float gq0 = qng[2 * lane], gq1 = qng[2 * lane + 1], gk0 = kng[2 * lane], gk1 = kng[2 * lane + 1];
  const float gqr = qrg[lane], gkr = krg[lane];
  for (int row = bidv * NW + wave; row < MT; row += gridDim.x * NW) {
    bool lat = row < ML;
    int t = row & 4095;
    float pos = (idx < 16) ? (float)(t >> 6) : (float)(t & 63);
    float ang = pos * inv;
    float cs = 1.f, sn = 0.f;
    if (lat) { cs = cosf(ang); sn = sinf(ang); }
#pragma unroll 1
    for (int h = 0; h < 8; h++) {
      bf16* q = QB + (size_t)row * 1536 + h * 192;
      uint32_t u = *(const uint32_t*)(q + 2 * lane);
      float x0 = bf2f((bf16)(u & 0xffff)), x1 = bf2f((bf16)(u >> 16));
      float ss = wsum(x0 * x0 + x1 * x1);
      float rinv = rsqrtf(ss * (1.f / 128.f) + 1e-6f) * QS;
      *(uint32_t*)(q + 2 * lane) = pack2(x0 * rinv * gq0, x1 * rinv * gq1);
      float xr = bf2f(q[128 + lane]);
      float ss2 = wsum(xr * xr);
      float y = xr * rsqrtf(ss2 * (1.f / 64.f) + 1e-6f) * gqr;
      float yp = __shfl_xor(y, 32);
      float o = lane < 32 ? (y * cs - yp * sn) : (yp * sn + y * cs);
      q[128 + lane] = f2bf(o * QS);
      bf16* k = KN + (size_t)row * 1024 + h * 128;
      uint32_t uk = *(const uint32_t*)(k + 2 * lane);
      float k0 = bf2f((bf16)(uk & 0xffff)), k1 = bf2f((bf16)(uk >> 16));
      float ssk = wsum(k0 * k0 + k1 * k1);
      float rk = rsqrtf(ssk * (1.f / 128.f) + 1e-6f);
      *(uint32_t*)(k + 2 * lane) = pack2(k0 * rk * gk0, k1 * rk * gk1);
    }
    {
      float xr = bf2f(Z[(size_t)row * NIN + C_KR + lane]);
      float ss2 = wsum(xr * xr);
      float y = xr * rsqrtf(ss2 * (1.f / 64.f) + 1e-6f) * gkr;
      float yp = __shfl_xor(y, 32);
      float o = lane < 32 ? (y * cs - yp * sn) : (yp * sn + y * cs);
      KR[(size_t)row * 64 + lane] = f2bf(o);
    }
  }
}

DEV void step_row(int s, int d, int b, int& row, int& tau, int& len) {
  if (s < 256) { tau = d ? 255 - s : s; len = 256; row = ML + b * 256 + tau; }
  else { int q = s - 256; tau = d ? 4095 - q : q; len = 4096; row = b * 4096 + tau; }
}

struct RwPre { bf16 r0, r1, r2, k0, k1, k2, v0, v1, v2, a, e; };

DEV void rwkv_fetch(RwPre& q, const bf16* Z, const bf16* AD, const bf16* ED, int s, int d, int b, int ch) {
  int row, tau, len;
  step_row(s, d, b, row, tau, len);
  const bf16* z = Z + (size_t)row * NIN + C_R + ch;
  q.r1 = z[0]; q.k1 = z[1024]; q.v1 = z[2048];
  q.r0 = 0; q.k0 = 0; q.v0 = 0; q.r2 = 0; q.k2 = 0; q.v2 = 0;
  if (tau > 0) { const bf16* zm = z - NIN; q.r0 = zm[0]; q.k0 = zm[1024]; q.v0 = zm[2048]; }
  if (tau < len - 1) { const bf16* zp = z + NIN; q.r2 = zp[0]; q.k2 = zp[1024]; q.v2 = zp[2048]; }
  q.a = AD[(size_t)row * 1024 + ch];
  q.e = ED[(size_t)row * 1024 + ch];
}

typedef float f2v __attribute__((ext_vector_type(2)));
DEV float dpp_hmirror(float v) {
  int i = __float_as_int(v);
  return __int_as_float(__builtin_amdgcn_update_dpp(0, i, 0x141, 0xF, 0xF, true));
}
DEV f2v lo2(float4 v) { return f2v{v.x, v.y}; }
DEV f2v hi2(float4 v) { return f2v{v.z, v.w}; }

DEV void rwkv_scan(int tidv, int bidv, const Params& p, int l, int chain, char* smem, int dry) {
  char* ws = p.ws;
  float* op = (float*)smem;
  float* vb = op + 16 * 320;
  float* yb = vb + 16 * 64;
  const int tid = tidv, wave = tid >> 6, lane = tid & 63;
  const int d = chain & 1, h = (chain >> 1) & 15, b = chain >> 5;
  const int ch = h * 64 + lane;
  const float* cw = p.in[17] + (size_t)l * 3 * 3072;
  const float cr0 = cw[ch], cr1 = cw[3072 + ch], cr2 = cw[6144 + ch];
  const float ck0 = cw[1024 + ch], ck1 = cw[3072 + 1024 + ch], ck2 = cw[6144 + 1024 + ch];
  const float cv0 = cw[2048 + ch], cv1 = cw[3072 + 2048 + ch], cv2 = cw[6144 + 2048 + ch];
  const float kkc = p.in[23][l * 1024 + ch], kac = p.in[24][l * 1024 + ch];
  const bf16* Z = (const bf16*)(ws + B_ZB);
  bf16* ED = (bf16*)(ws + B_HB + (size_t)d * SZ1K);
  const bf16* AD = (const bf16*)(ws + (d ? B_AB : B_AF));
  f2v S0 = {0.f, 0.f}, S1 = {0.f, 0.f}, S2 = {0.f, 0.f}, S3 = {0.f, 0.f};
  const int ri = lane >> 3, jo = lane & 7, irow = wave * 8 + ri;
  RwPre pre[2];
#pragma unroll
  for (int si = 0; si < 2; si++) rwkv_fetch(pre[si], Z, AD, ED, wave * 2 + si, d, b, ch);
  for (int chunk = 0; chunk < 272; chunk++) {
#pragma unroll
    for (int si = 0; si < 2; si++) {
      int t = wave * 2 + si;
      const RwPre& q = pre[si];
      float rr = cr0 * bf2f(q.r0) + cr1 * bf2f(q.r1) + cr2 * bf2f(q.r2);
      float kk_ = ck0 * bf2f(q.k0) + ck1 * bf2f(q.k1) + ck2 * bf2f(q.k2);
      float vv = cv0 * bf2f(q.v0) + cv1 * bf2f(q.v1) + cv2 * bf2f(q.v2);
      float kkv = kk_ * kkc;
      float ssq = wsum(kkv * kkv);
      float kn = kkv * rsqrtf(ssq + 1e-12f);
      float a = bf2f(q.a);
      float w = __expf(-bf2f(q.e));
      float krep = kk_ * (1.f + (a - 1.f) * kac);
      float* o = op + t * 320;
      o[lane] = w;
      o[64 + lane] = kn * a;
      o[128 + lane] = krep;
      o[192 + lane] = -kn;
      o[256 + lane] = rr;
      vb[t * 64 + lane] = vv;
    }
    __syncthreads();
    if (chunk + 1 < 272) {
#pragma unroll
      for (int si = 0; si < 2; si++) rwkv_fetch(pre[si], Z, AD, ED, (chunk + 1) * 16 + wave * 2 + si, d, b, ch);
    }
    {
      const float4* o4 = (const float4*)(op + jo * 8);
      float4 n0 = o4[48], n1 = o4[49];
#pragma unroll 4
      for (int t = 0; t < 16; t++) {
        const float4* ot = o4 + t * 80;
        const float4 w0 = ot[0], w1 = ot[1];
        const float4 a0 = ot[16], a1 = ot[17];
        const float4 k0 = ot[32], k1 = ot[33];
        const float4 r0 = ot[64], r1 = ot[65];
        const float vi = vb[t * 64 + irow];
        const int tn = t < 15 ? t + 1 : 15;
        const float4* on = o4 + tn * 80;
        const float4 m0 = on[48], m1 = on[49];
        f2v sv = S0 * lo2(n0) + S1 * hi2(n0) + (S2 * lo2(n1) + S3 * hi2(n1));
        float sa = sv.x + sv.y;
        sa += dpp_xor1(sa);
        sa += dpp_xor2(sa);
        sa += dpp_hmirror(sa);
        const f2v sa2 = {sa, sa}, vi2 = {vi, vi};
        S0 = S0 * lo2(w0) + sa2 * lo2(a0) + vi2 * lo2(k0);
        S1 = S1 * hi2(w0) + sa2 * hi2(a0) + vi2 * hi2(k0);
        S2 = S2 * lo2(w1) + sa2 * lo2(a1) + vi2 * lo2(k1);
        S3 = S3 * hi2(w1) + sa2 * hi2(a1) + vi2 * hi2(k1);
        f2v yv = S0 * lo2(r0) + S1 * hi2(r0) + (S2 * lo2(r1) + S3 * hi2(r1));
        yb[(t * 64 + irow) * 8 + jo] = yv.x + yv.y;
        n0 = m0; n1 = m1;
      }
    }
    __syncthreads();
#pragma unroll
    for (int it = 0; it < 2; it++) {
      int idx = it * NT + tid;
      int t = idx >> 6, i = idx & 63;
      int row, tau, len;
      step_row(chunk * 16 + t, d, b, row, tau, len);
      size_t off = (size_t)row * 1024 + h * 64 + i;
      bf16* yd = dry ? (bf16*)(ws + B_END) + (off & 0x3fffff) : ED + off;
      const float4 ya = *(const float4*)(yb + (t * 64 + i) * 8), yc = *(const float4*)(yb + (t * 64 + i) * 8 + 4);
      *yd = f2bf(((ya.x + ya.y) + (ya.z + ya.w)) + ((yc.x + yc.y) + (yc.z + yc.w)));
    }
  }
}

DEV void s5_scan(int tidv, int bidv, const Params& p, int l, int chain, char* smemw, int dry) {
  char* ws = p.ws;
  const int lane = tidv & 63;
  const int d = chain & 1, g = (chain >> 1) & 63, b = chain >> 7;
  float* ub = (float*)smemw;
  float* hb = ub + 256;
  const size_t pg = (size_t)(l * 2 + d) * 64 + g;
  const float lre = p.in[28][pg * 64 + lane], lim = p.in[29][pg * 64 + lane];
  const float dt = expf(p.in[30][pg]);
  const float mag = expf(lre * dt);
  const float are = mag * cosf(lim * dt), aim = mag * sinf(lim * dt);
  const float den = lre * lre + lim * lim;
  const float qre = ((are - 1.f) * lre + aim * lim) / den;
  const float qim = (aim * lre - (are - 1.f) * lim) / den;
  float bbre[16], bbim[16];
  {
    const float* br = p.in[31] + (pg * 64 + lane) * 16;
    const float* bi = p.in[32] + (pg * 64 + lane) * 16;
#pragma unroll
    for (int i = 0; i < 16; i++) {
      float x = br[i], y = bi[i];
      bbre[i] = qre * x - qim * y;
      bbim[i] = qre * y + qim * x;
    }
  }
  bf16x8 cfr[4];
  {
    const int i = lane & 15, quad = lane >> 4;
    const float* cre = p.in[33] + (pg * 16 + i) * 64;
    const float* cim = p.in[34] + (pg * 16 + i) * 64;
#pragma unroll
    for (int ks = 0; ks < 4; ks++)
#pragma unroll
      for (int j = 0; j < 8; j++) {
        int k = ks * 32 + quad * 8 + j;
        float c = ks < 2 ? cre[k] : -cim[k - 64];
        cfr[ks][j] = (short)f2bf(c);
      }
  }
  float hre = 0.f, him = 0.f;
  const bf16* Z = (const bf16*)(ws + B_ZB);
  const int tt = lane >> 2, i0 = (lane & 3) * 4;
  uint2 unext;
  {
    int row, tau, len;
    step_row(tt, d, b, row, tau, len);
    unext = *(const uint2*)(Z + (size_t)row * NIN + C_U + g * 16 + i0);
  }
  for (int chunk = 0; chunk < 272; chunk++) {
    {
      uint2 u = unext;
      float4 f;
      f.x = bf2f((bf16)(u.x & 0xffff)); f.y = bf2f((bf16)(u.x >> 16));
      f.z = bf2f((bf16)(u.y & 0xffff)); f.w = bf2f((bf16)(u.y >> 16));
      *(float4*)(ub + tt * 16 + i0) = f;
    }
    __syncthreads();
    if (chunk + 1 < 272) {
      int row, tau, len;
      step_row((chunk + 1) * 16 + tt, d, b, row, tau, len);
      unext = *(const uint2*)(Z + (size_t)row * NIN + C_U + g * 16 + i0);
    }
#pragma unroll 2
    for (int t = 0; t < 16; t++) {
      const float* u = ub + t * 16;
      float br0 = 0.f, bi0 = 0.f;
#pragma unroll
      for (int i = 0; i < 16; i++) { float uv = u[i]; br0 += bbre[i] * uv; bi0 += bbim[i] * uv; }
      float nr = are * hre - aim * him + br0;
      float ni = are * him + aim * hre + bi0;
      hre = nr; him = ni;
      hb[t * 132 + lane] = hre;
      hb[t * 132 + 64 + lane] = him;
    }
    __syncthreads();
    {
      f32x4 yacc = {0.f, 0.f, 0.f, 0.f};
      const float* hr = hb + (lane & 15) * 132 + (lane >> 4) * 8;
#pragma unroll
      for (int ks = 0; ks < 4; ks++) {
        float4 x0 = *(const float4*)(hr + ks * 32), x1 = *(const float4*)(hr + ks * 32 + 4);
        union { bf16x8 v; uint32_t u[4]; } af;
        af.u[0] = pack2(x0.x, x0.y); af.u[1] = pack2(x0.z, x0.w);
        af.u[2] = pack2(x1.x, x1.y); af.u[3] = pack2(x1.z, x1.w);
        yacc = __builtin_amdgcn_mfma_f32_16x16x32_bf16(af.v, cfr[ks], yacc, 0, 0, 0);
      }
      const int ii = lane & 15;
#pragma unroll
      for (int r = 0; r < 4; r++) {
        int row, tau, len;
        step_row(chunk * 16 + (lane >> 4) * 4 + r, d, b, row, tau, len);
        bf16* dst = d == 0 ? (bf16*)(ws + B_SY) + (size_t)row * 1024 + g * 16 + ii : (bf16*)(ws + B_ZB) + (size_t)row * NIN + g * 16 + ii;
        if (dry) dst = (bf16*)(ws + B_END) + ((((size_t)row * 1024 + g * 16 + ii)) & 0x3fffff);
        *dst = f2bf(yacc[r]);
      }
    }
    __syncthreads();
  }
}

DEV int perm23(int r) { return (r & 0x13) | ((r & 4) << 1) | ((r & 8) >> 1); }

DEV void attn_item(int tidv, int bidv, const Params& p, int item, bool ctxq, char* smem, int dry) {
  char* ws = p.ws;
  bf16* sK = (bf16*)smem;
  bf16* sV = sK + 64 * 200;
  const int tid = tidv, wave = tid >> 6, lane = tid & 63;
  const int r = lane & 31, hf = lane >> 5;
  int b, hd, qt;
  if (!ctxq) { b = item >> 7; hd = (item >> 4) & 7; qt = item & 15; }
  else { b = item >> 3; hd = item & 7; qt = 0; }
  const int qrow0 = ctxq ? ML + b * 256 : b * 4096 + qt * 256;
  const int kt0 = ctxq ? 64 : 0, kt1 = 68;
  bf16* QB = (bf16*)(ws + B_QB);
  const bf16* KN = (const bf16*)(ws + B_KN);
  const bf16* KR = (const bf16*)(ws + B_KR);
  const bf16* VT = (const bf16*)(ws + B_VT);
  bf16x8 qf[12];
  {
    const bf16* qp = QB + (size_t)(qrow0 + wave * 32 + r) * 1536 + hd * 192 + hf * 8;
#pragma unroll
    for (int kk = 0; kk < 12; kk++) qf[kk] = *(const bf16x8*)(qp + kk * 16);
  }
  f32x16 oacc[4];
#pragma unroll
  for (int i = 0; i < 4; i++)
#pragma unroll
    for (int e = 0; e < 16; e++) oacc[i][e] = 0.f;
  float mrun = -1e30f, lrun = 0.f;
  const int pr = perm23(r);
  for (int kt = kt0; kt < kt1; kt++) {
    __syncthreads();
    const int key0 = kt * 64;
    const int rowbase = key0 < 4096 ? b * 4096 + key0 : ML + b * 256 + (key0 - 4096);
    {
      const char* bk = (const char*)(KN + (size_t)rowbase * 1024 + hd * 128);
      const char* br = (const char*)(KR + (size_t)rowbase * 64);
      const char* bv = (const char*)(VT + ((size_t)((b * 8 + hd) * 128)) * NKEY + key0);
      const uint32_t vo_n = (uint32_t)((tid >> 4) * 2048 + (tid & 15) * 16);
      const uint32_t lo_n = (uint32_t)((tid >> 4) * 400 + (tid & 15) * 16);
      const uint32_t vo_r = (uint32_t)((tid >> 3) * 128 + (tid & 7) * 16);
      const uint32_t lo_r = (uint32_t)((tid >> 3) * 400 + 256 + (tid & 7) * 16);
      const uint32_t vo_v = (uint32_t)((tid >> 3) * (NKEY * 2) + (tid & 7) * 16);
      const uint32_t lo_v = (uint32_t)((tid >> 3) * 144 + (tid & 7) * 16);
      uint4 t0 = *(const uint4*)(bk + vo_n);
      uint4 t1 = *(const uint4*)(bk + 32 * 2048 + vo_n);
      uint4 t4 = *(const uint4*)(br + vo_r);
      uint4 u0 = *(const uint4*)(bv + vo_v);
      uint4 u1 = *(const uint4*)(bv + (size_t)64 * NKEY * 2 + vo_v);
      *(uint4*)((char*)sK + lo_n) = t0;
      *(uint4*)((char*)sK + 32 * 400 + lo_n) = t1;
      *(uint4*)((char*)sK + lo_r) = t4;
      *(uint4*)((char*)sV + lo_v) = u0;
      *(uint4*)((char*)sV + 64 * 144 + lo_v) = u1;
    }
    __syncthreads();
    f32x16 sacc[2];
#pragma unroll
    for (int m = 0; m < 2; m++) {
#pragma unroll
      for (int e = 0; e < 16; e++) sacc[m][e] = 0.f;
      const bf16* kp = sK + (m * 32 + pr) * 200 + hf * 8;
#pragma unroll
      for (int kk = 0; kk < 12; kk++) {
        bf16x8 kf = *(const bf16x8*)(kp + kk * 16);
        sacc[m] = __builtin_amdgcn_mfma_f32_32x32x16_bf16(kf, qf[kk], sacc[m], 0, 0, 0);
        if ((kk & 3) == 3) __builtin_amdgcn_sched_barrier(0);
      }
      __builtin_amdgcn_sched_barrier(0);
    }
    float tmax = sacc[0][0];
#pragma unroll
    for (int e = 1; e < 16; e++) tmax = fmaxf(tmax, sacc[0][e]);
#pragma unroll
    for (int e = 0; e < 16; e++) tmax = fmaxf(tmax, sacc[1][e]);
    tmax = fmaxf(tmax, __shfl_xor(tmax, 32));
    float mnew = fmaxf(mrun, tmax);
    float alpha = __builtin_amdgcn_exp2f(mrun - mnew);
    mrun = mnew;
    float psum = 0.f;
#pragma unroll
    for (int m = 0; m < 2; m++)
#pragma unroll
      for (int e = 0; e < 16; e++) { float pv = __builtin_amdgcn_exp2f(sacc[m][e] - mnew); sacc[m][e] = pv; psum += pv; }
    lrun = lrun * alpha + psum;
#pragma unroll
    for (int i = 0; i < 4; i++)
#pragma unroll
      for (int e = 0; e < 16; e++) oacc[i][e] *= alpha;
#pragma unroll
    for (int s = 0; s < 4; s++) {
      const int m = s >> 1, s2 = s & 1;
      bf16x8 pf;
#pragma unroll
      for (int j = 0; j < 8; j++) pf[j] = (short)f2bf(sacc[m][8 * s2 + j]);
#pragma unroll
      for (int i = 0; i < 4; i++) {
        bf16x8 vf = *(const bf16x8*)(sV + (i * 32 + r) * 72 + m * 32 + s2 * 16 + hf * 8);
        oacc[i] = __builtin_amdgcn_mfma_f32_32x32x16_bf16(vf, pf, oacc[i], 0, 0, 0);
      }
      __builtin_amdgcn_sched_barrier(0);
    }
  }
  lrun += __shfl_xor(lrun, 32);
  const float inv = 1.f / lrun;
  bf16* op = QB + (size_t)(qrow0 + wave * 32 + r) * 1536 + hd * 192;
  if (dry) op = (bf16*)(ws + B_END) + ((((size_t)(qrow0 + wave * 32 + r) * 1536 + hd * 192)) & 0x3ffff8);
#pragma unroll
  for (int i = 0; i < 4; i++)
#pragma unroll
    for (int g = 0; g < 4; g++) {
      uint2 o;
      o.x = pack2(oacc[i][4 * g] * inv, oacc[i][4 * g + 1] * inv);
      o.y = pack2(oacc[i][4 * g + 2] * inv, oacc[i][4 * g + 3] * inv);
      *(uint2*)(op + 32 * i + 8 * g + 4 * hf) = o;
    }
}

DEV void phase_mixers(int tidv, int bidv, const Params& p, int l, char* smem, int dry) {
  int* s_item = (int*)(smem + SM_ITEM);
#ifdef PROBE_PARTS
  const int parts = dry ? PROBE_PARTS : 7;
#else
  const int parts = 7;
#endif
  for (int task = bidv; task < 192; task += gridDim.x) {
    if (task < 128 && !(parts & 1)) continue;
    if (task >= 128 && !(parts & 2)) continue;
    if (task < 128) rwkv_scan(tidv, bidv, p, l, task, smem, dry);
    else s5_scan(tidv, bidv, p, l, (task - 128) * 8 + (tidv >> 6), smem + (tidv >> 6) * 9472, dry);
  }
  const int nlat = 512, ntot = (parts & 4) ? ((l == 0) ? 544 : 512) : 0;
  int* cnt = (int*)(p.ws + B_CNT) + l + 2 * dry;
#if !defined(MIX_ONLY) || MIX_ONLY == 2
  while (true) {
    __syncthreads();
    if (tidv == 0) *s_item = atomicAdd(cnt, 1);
    __syncthreads();
    int item = *s_item;
    if (item >= ntot) break;
    if (item < nlat) attn_item(tidv, bidv, p, item, false, smem, dry);
    else attn_item(tidv, bidv, p, item - nlat, true, smem, dry);
  }
#endif
}

DEV float gelu_tanh(float x) {
  float u = 0.7978845608028654f * (x + 0.044715f * x * x * x);
  return 0.5f * x * (1.f + tanhf(u));
}

DEV void phase_post(int tidv, int bidv, const Params& p, int l, int M) {
  char* ws = p.ws;
  const bf16* Z = (const bf16*)(ws + B_ZB);
  const int wave = tidv >> 6, lane = tidv & 63;
  const float* cw = p.in[17] + (size_t)l * 3 * 3072;
  const bf16* YF = (const bf16*)(ws + B_HB);
  const bf16* YB = (const bf16*)(ws + B_HB + SZ1K);
  const bf16* AF = (const bf16*)(ws + B_AF);
  const bf16* AB = (const bf16*)(ws + B_AB);
  bf16* GB = (bf16*)(ws + B_GB);
  const int nitem = M * 16;
  for (int it = bidv * NW + wave; it < nitem; it += gridDim.x * NW) {
    int row = it >> 4, h = it & 15;
    int ch = h * 64 + lane;
    int tau, len;
    if (row < ML) { tau = row & 4095; len = 4096; } else { tau = (row - ML) & 255; len = 256; }
    size_t o = (size_t)row * 1024 + ch;
    float y = bf2f(YF[o]) + bf2f(YB[o]);
    float mu = wsum(y) * (1.f / 64.f);
    float dv = y - mu;
    float var = wsum(dv * dv) * (1.f / 64.f);
    float yn = dv * rsqrtf(var + 64e-5f) * p.in[26][l * 1024 + ch] + p.in[27][l * 1024 + ch];
    const bf16* z = Z + (size_t)row * NIN + C_R + ch;
    float r1 = bf2f(z[0]), k1 = bf2f(z[1024]), v1 = bf2f(z[2048]);
    float r0 = 0.f, k0 = 0.f, v0 = 0.f, r2 = 0.f, k2 = 0.f, v2 = 0.f;
    if (tau > 0) { const bf16* zm = z - NIN; r0 = bf2f(zm[0]); k0 = bf2f(zm[1024]); v0 = bf2f(zm[2048]); }
    if (tau < len - 1) { const bf16* zp = z + NIN; r2 = bf2f(zp[0]); k2 = bf2f(zp[1024]); v2 = bf2f(zp[2048]); }
    float rr = cw[ch] * r0 + cw[3072 + ch] * r1 + cw[6144 + ch] * r2;
    float kk = cw[1024 + ch] * k0 + cw[3072 + 1024 + ch] * k1 + cw[6144 + 1024 + ch] * k2;
    float vv = cw[2048 + ch] * v0 + cw[3072 + 2048 + ch] * v1 + cw[6144 + 2048 + ch] * v2;
    float am = 0.5f * (bf2f(AF[o]) + bf2f(AB[o]));
    float kbon = kk * (1.f + (am - 1.f) * p.in[24][l * 1024 + ch]);
    float s = wsum(rr * kbon * p.in[25][l * 1024 + ch]);
    float outv = (yn + s * vv) * bf2f(GB[o]);
    GB[o] = f2bf(outv);
  }
  bf16* SY = (bf16*)(ws + B_SY);
  const float* dsk = p.in[35] + l * 1024;
  const int n4 = M * 256;
  for (int i = bidv * NT + tidv; i < n4; i += gridDim.x * NT) {
    int row = i >> 8, c = (i & 255) * 4;
    uint2 a = *(const uint2*)(SY + (size_t)row * 1024 + c);
    uint2 bq = *(const uint2*)(Z + (size_t)row * NIN + c);
    uint2 u = *(const uint2*)(Z + (size_t)row * NIN + C_U + c);
    float4 dd = *(const float4*)(dsk + c);
    float y0 = bf2f((bf16)(a.x & 0xffff)) + bf2f((bf16)(bq.x & 0xffff)) + dd.x * bf2f((bf16)(u.x & 0xffff));
    float y1 = bf2f((bf16)(a.x >> 16)) + bf2f((bf16)(bq.x >> 16)) + dd.y * bf2f((bf16)(u.x >> 16));
    float y2 = bf2f((bf16)(a.y & 0xffff)) + bf2f((bf16)(bq.y & 0xffff)) + dd.z * bf2f((bf16)(u.y & 0xffff));
    float y3 = bf2f((bf16)(a.y >> 16)) + bf2f((bf16)(bq.y >> 16)) + dd.w * bf2f((bf16)(u.y >> 16));
    uint2 o;
    o.x = pack2(gelu_tanh(y0), gelu_tanh(y1));
    o.y = pack2(gelu_tanh(y2), gelu_tanh(y3));
    *(uint2*)(SY + (size_t)row * 1024 + c) = o;
  }
}

constexpr int NPH = 25;

DEV void run_phase(int tidv, int bidv, const Params& p, int ph, char* smem, int dry) {
  char* ws = p.ws;
#ifndef ONLY_S
  if (ph == 0) {
    if (bidv == 0 && tidv < 4) ((int*)(ws + B_CNT))[tidv] = 0;
    phase_mod(tidv, bidv, p, smem);
    phase_convw(tidv, bidv, p, 0, smem);
    return;
  }
#endif
  const int l = (ph - 1) / 12, s = (ph - 1) % 12;
#ifdef ONLY_S
  if (s != ONLY_S) return;
#endif
  const bf16* wb = (const bf16*)(ws + B_WB);
  const float* mod = (const float*)(ws + B_MOD) + (size_t)l * 5 * 12288;
  float* XC = (float*)(ws + B_XC);
  const float* xin_lat = l == 0 ? p.in[0] : p.out;
  const float* xin_ctx = l == 0 ? p.in[2] : XC;
  bf16* HB = (bf16*)(ws + B_HB);
  bf16* Z = (bf16*)(ws + B_ZB);
  bf16* H2 = (bf16*)(ws + B_KN);
  const int Mpost = l == 0 ? MT : ML;
  switch (s) {
    case 0:
      if (l == 1) phase_convw(tidv, bidv, p, 1, smem);
      phase_norm(tidv, bidv, xin_lat, xin_ctx, p.in[6] + l * 2048, mod, 0, 2048, HB, MT);
      break;
    case 1:
      run_gemm<G_IN>(tidv, bidv, p, l, smem, HB, 2048, wb + OW_IN, 2048, NIN, MT, 0, nullptr, nullptr, nullptr, nullptr);
      break;
    case 2:
#if !defined(PH2_ONLY) || PH2_ONLY == 0
      run_gemm<G_UKV>(tidv, bidv, p, l, smem, Z + C_CKV, NIN, wb + OW_UKV, 512, 2048, MT, 0, nullptr, nullptr, nullptr, nullptr);
#endif
#if !defined(PH2_ONLY) || PH2_ONLY == 1
      run_gemm<G_UQ>(tidv, bidv, p, l, smem, Z + C_CQ, NIN, wb + OW_UQ, 512, 1536, MT, 0, nullptr, nullptr, nullptr, nullptr);
#endif
#if !defined(PH2_ONLY) || PH2_ONLY == 2
      run_gemm<G_G2>(tidv, bidv, p, l, smem, Z + C_GD, NIN, wb + OW_G2, 192, 1024, MT, 0, nullptr, nullptr, nullptr, nullptr);
#endif
#if !defined(PH2_ONLY) || PH2_ONLY == 3
      for (int d = 0; d < 2; d++) {
        run_gemm<G_W2>(tidv, bidv, p, l, smem, Z + C_WD + 64 * d, NIN, wb + OW_W2 + (size_t)d * 65536, 64, 1024, MT, d, nullptr, nullptr, nullptr, nullptr);
        run_gemm<G_A2>(tidv, bidv, p, l, smem, Z + C_AD + 64 * d, NIN, wb + OW_A2 + (size_t)d * 65536, 64, 1024, MT, d, nullptr, nullptr, nullptr, nullptr);
      }
#endif
      break;
    case 3: phase_mla_post(tidv, bidv, p, l); break;
    case 4: phase_mixers(tidv, bidv, p, l, smem, dry); break;
    case 5: phase_post(tidv, bidv, p, l, Mpost); break;
    case 6:
      run_gemm<G_GLU>(tidv, bidv, p, l, smem, (const bf16*)(ws + B_SY), 1024, wb + OW_GLU, 1024, 1024, Mpost, 0, nullptr, nullptr, nullptr, nullptr);
      break;
    case 7:
      run_gemm<G_MG0>(tidv, bidv, p, l, smem, (const bf16*)(ws + B_QB), 1536, wb + OW_BR, 1024, 2048, Mpost, 0, nullptr, nullptr, nullptr, nullptr);
      run_gemm<G_MG1>(tidv, bidv, p, l, smem, (const bf16*)(ws + B_GB), 1024, wb + OW_BR + (size_t)2048 * 1024, 1024, 2048, Mpost, 0, nullptr, nullptr, nullptr, nullptr);
      run_gemm<G_MG2>(tidv, bidv, p, l, smem, Z, NIN, wb + OW_BR + (size_t)2 * 2048 * 1024, 1024, 2048, Mpost, 0, nullptr, nullptr, nullptr, nullptr);
      break;
    case 8:
      run_gemm<G_OUT>(tidv, bidv, p, l, smem, HB, 2048, wb + OW_OUT, 2048, 2048, Mpost, 0, xin_lat, xin_ctx, p.out, XC);
      break;
    case 9:
      phase_norm(tidv, bidv, p.out, XC, p.in[7] + l * 2048, mod, 6144, 8192, H2, Mpost);
      break;
    case 10:
      run_gemm<G_M1>(tidv, bidv, p, l, smem, H2, 2048, wb + OW_M1, 2048, 8192, Mpost, 0, nullptr, nullptr, nullptr, nullptr);
      break;
    case 11:
      run_gemm<G_M2>(tidv, bidv, p, l, smem, Z, 8192, wb + OW_M2, 8192, 2048, Mpost, 0, nullptr, nullptr, p.out, XC);
      break;
  }
}

__global__ void __launch_bounds__(NT) fwd_megakernel(Params p, int ph0, int ph1, int dryflag) {
  extern __shared__ __attribute__((aligned(16))) char smem[];
  for (int ph = ph0; ph < ph1; ph++) {
    int tidv = threadIdx.x, bidv = blockIdx.x;
    asm volatile("" : "+v"(tidv));
    asm volatile("" : "+s"(bidv));
#ifdef PROBE_MASK
    if (dryflag && ((ph == 0 && (PROBE_MASK & 0x1000)) || (ph > 0 && ((PROBE_MASK >> ((ph - 1) % 12)) & 1)))) {
      run_phase(tidv, bidv, p, ph, smem, dryflag);
      cg::this_grid().sync();
    }
#endif
    run_phase(tidv, bidv, p, ph, smem, 0);
    if (ph + 1 < ph1) cg::this_grid().sync();
  }
}

extern "C" void kernel_launch(void* const* d_in, const int* in_sizes, int n_in, void* d_out, int out_size, void* d_ws, size_t ws_size,
                              hipStream_t stream) {
  static int grid_blocks = 0;
  if (!grid_blocks) {
    int dev = 0, cus = 0, per_cu = 0;
    (void)hipGetDevice(&dev);
    (void)hipDeviceGetAttribute(&cus, hipDeviceAttributeMultiprocessorCount, dev);
    if (hipFuncSetAttribute((const void*)fwd_megakernel, hipFuncAttributeMaxDynamicSharedMemorySize, LDS_BYTES) != hipSuccess) {
      fprintf(stderr, "hipFuncSetAttribute(%d B dynamic LDS) failed\n", LDS_BYTES);
      return;
    }
    if (hipOccupancyMaxActiveBlocksPerMultiprocessor(&per_cu, (const void*)fwd_megakernel, NT, LDS_BYTES) != hipSuccess || per_cu < 1) {
      fprintf(stderr, "occupancy query failed / kernel not resident\n");
      return;
    }
    grid_blocks = cus;
  }
  Params p{};
  for (int i = 0; i < 42; i++) p.in[i] = (const float*)d_in[i];
  p.out = (float*)d_out;
  p.ws = (char*)d_ws;
  if (ws_size < B_END + (8u << 20)) { fprintf(stderr, "workspace too small\n"); return; }
  int ph0 = 0, ph1 = NPH;
  int dryflag = 1;
  void* args[] = {&p, &ph0, &ph1, &dryflag};
  hipError_t e = hipLaunchCooperativeKernel((void*)fwd_megakernel, dim3(grid_blocks), dim3(NT), args, LDS_BYTES, stream);
  if (e != hipSuccess) fprintf(stderr, "cooperative launch failed: %s (grid %d)\n", hipGetErrorString(e), grid_blocks);
}
```

```cpp
#include <hip/hip_runtime.h>
#include <hip/hip_cooperative_groups.h>
#include <stdint.h>
#include <cstdio>
namespace cg = cooperative_groups;

#ifndef MULTI_LAUNCH
#define MULTI_LAUNCH 0
#endif

typedef unsigned short bf16;
using bf16x8 = __attribute__((ext_vector_type(8))) short;
using f32x4 = __attribute__((ext_vector_type(4))) float;
using f32x16 = __attribute__((ext_vector_type(16))) float;

#define DEV __device__ __forceinline__
constexpr int NT = 512, NW = 8;

constexpr int DM = 2048, ML = 16384, MC = 1024, MT = 17408, NIN = 11744, DFF = 8192, NKEY = 4352;
constexpr int C_CQ = 0, C_CKV = 512, C_KR = 1024, C_R = 1088, C_WD = 4160, C_AD = 4288, C_GD = 4416, C_U = 4576, C_GATE = 5600;

constexpr size_t OW_IN = 0;
constexpr size_t OW_UQ = OW_IN + (size_t)NIN * 2048;
constexpr size_t OW_UKV = OW_UQ + 1536 * 512;
constexpr size_t OW_W2 = OW_UKV + 2048 * 512;
constexpr size_t OW_A2 = OW_W2 + 2 * 1024 * 64;
constexpr size_t OW_G2 = OW_A2 + 2 * 1024 * 64;
constexpr size_t OW_GLU = OW_G2 + 1024 * 192;
constexpr size_t OW_BR = OW_GLU + 1024 * 1024;
constexpr size_t OW_OUT = OW_BR + (size_t)3 * 2048 * 1024;
constexpr size_t OW_M1 = OW_OUT + (size_t)2048 * 2048;
constexpr size_t OW_M2 = OW_M1 + (size_t)8192 * 2048;
constexpr size_t OW_END = OW_M2 + (size_t)8192 * 2048;

constexpr size_t SZ1K = (size_t)MT * 1024 * 2;
constexpr size_t B_WB = 0;
constexpr size_t B_HB = B_WB + OW_END * 2;
constexpr size_t B_ZB = B_HB + (size_t)MT * 2048 * 2;
constexpr size_t B_QB = B_ZB + (size_t)MT * NIN * 2;
constexpr size_t B_KN = B_QB + (size_t)MT * 1536 * 2;
constexpr size_t B_VT = B_KN + SZ1K;
constexpr size_t B_KR = B_VT + SZ1K;
constexpr size_t B_AF = B_KR + (size_t)MT * 64 * 2;
constexpr size_t B_AB = B_AF + SZ1K;
constexpr size_t B_GB = B_AB + SZ1K;
constexpr size_t B_SY = B_GB + SZ1K;
constexpr size_t B_XC = B_SY + SZ1K;
constexpr size_t B_MOD = B_XC + (size_t)MC * 2048 * 4;
constexpr size_t B_CNT = B_MOD + (size_t)2 * 5 * 12288 * 4;
constexpr size_t B_FLG = B_CNT + 256;
constexpr size_t B_END = B_FLG + 4096;

struct Params {
  const float* in[42];
  float* out;
  char* ws;
};

typedef __attribute__((ext_vector_type(2))) __bf16 hbf2;
DEV bf16 f2bf(float f) {
  __bf16 h = (__bf16)f;
  return *(unsigned short*)&h;
}
DEV float bf2f(bf16 h) { return __uint_as_float(((uint32_t)h) << 16); }
DEV uint32_t pack2(float a, float b) {
  hbf2 v;
  v[0] = (__bf16)a;
  v[1] = (__bf16)b;
  return *(uint32_t*)&v;
}
DEV float wsum(float v) {
#pragma unroll
  for (int o = 32; o > 0; o >>= 1) v += __shfl_xor(v, o);
  return v;
}
DEV float dpp_xor1(float v) {
  int i = __float_as_int(v);
  return __int_as_float(__builtin_amdgcn_update_dpp(0, i, 0xB1, 0xF, 0xF, true));
}
DEV float dpp_xor2(float v) {
  int i = __float_as_int(v);
  return __int_as_float(__builtin_amdgcn_update_dpp(0, i, 0x4E, 0xF, 0xF, true));
}
DEV float dpp_rmirror(float v) {
  int i = __float_as_int(v);
  return __int_as_float(__builtin_amdgcn_update_dpp(0, i, 0x140, 0xF, 0xF, true));
}
DEV float sigmoidf_(float x) { return __builtin_amdgcn_rcpf(1.f + __expf(-x)); }

DEV void phase_mod(int tidv, int bidv, const Params& p, char* smem) {
  float* s_in = (float*)smem;
  float* red = s_in + 5 * 2048;
  float* mod = (float*)(p.ws + B_MOD);
  for (int i = tidv; i < 5 * 2048; i += NT) {
    int r = i >> 11, k = i & 2047;
    float v = r < 4 ? p.in[1][r * 2048 + k] : p.in[3][k];
    s_in[i] = v / (1.f + expf(-v));
  }
  __syncthreads();
  int kg = tidv >> 6, c = tidv & 63;
  for (int task = bidv; task < 2 * 192; task += gridDim.x) {
    int l = task / 192, n = (task % 192) * 64 + c;
    const float* w = p.in[4] + (size_t)l * 2048 * 12288 + n;
    float a0 = 0, a1 = 0, a2 = 0, a3 = 0, a4 = 0;
    int kb = kg * 256;
#pragma unroll 8
    for (int k = 0; k < 256; k++) {
      float wv = w[(size_t)(kb + k) * 12288];
      a0 += s_in[kb + k] * wv;
      a1 += s_in[2048 + kb + k] * wv;
      a2 += s_in[4096 + kb + k] * wv;
      a3 += s_in[6144 + kb + k] * wv;
      a4 += s_in[8192 + kb + k] * wv;
    }
    red[(kg * 5 + 0) * 64 + c] = a0;
    red[(kg * 5 + 1) * 64 + c] = a1;
    red[(kg * 5 + 2) * 64 + c] = a2;
    red[(kg * 5 + 3) * 64 + c] = a3;
    red[(kg * 5 + 4) * 64 + c] = a4;
    __syncthreads();
    if (kg == 0) {
      float bias = p.in[5][l * 12288 + n];
#pragma unroll
      for (int r = 0; r < 5; r++) {
        float v = 0.f;
#pragma unroll
        for (int g = 0; g < 8; g++) v += red[(g * 5 + r) * 64 + c];
        mod[(size_t)(l * 5 + r) * 12288 + n] = v + bias;
      }
    }
    __syncthreads();
  }
}

DEV void convT(int tidv, int bidv, const float* __restrict__ src, bf16* __restrict__ dst, int K, int N, const float* __restrict__ gain, char* smem, int dK = 0) {
  if (dK == 0) dK = K;
  float* t = (float*)smem;
  int tk = (K + 63) >> 6, tn = (N + 63) >> 6;
  for (int tile = bidv; tile < tk * tn; tile += gridDim.x) {
    int k0 = (tile / tn) * 64, n0 = (tile % tn) * 64;
    __syncthreads();
#pragma unroll 4
    for (int i = 0; i < 8; i++) {
      int kk = i * 8 + (tidv >> 6), nn = tidv & 63;
      float v = 0.f;
      if (k0 + kk < K && n0 + nn < N) {
        v = src[(size_t)(k0 + kk) * N + n0 + nn];
        if (gain) v *= gain[k0 + kk];
      }
      t[kk * 65 + nn] = v;
    }
    __syncthreads();
    {
      int c = tidv;
      int nn = c >> 3, kc = c & 7;
      if (n0 + nn < N && k0 + kc * 8 < dK) {
        uint4 o;
        o.x = pack2(t[(kc * 8 + 0) * 65 + nn], t[(kc * 8 + 1) * 65 + nn]);
        o.y = pack2(t[(kc * 8 + 2) * 65 + nn], t[(kc * 8 + 3) * 65 + nn]);
        o.z = pack2(t[(kc * 8 + 4) * 65 + nn], t[(kc * 8 + 5) * 65 + nn]);
        o.w = pack2(t[(kc * 8 + 6) * 65 + nn], t[(kc * 8 + 7) * 65 + nn]);
        *(uint4*)(dst + (size_t)(n0 + nn) * dK + k0 + kc * 8) = o;
      }
    }
  }
}

DEV void phase_convw(int tidv, int bidv, const Params& p, int l, char* smem) {
  bf16* wb = (bf16*)(p.ws + B_WB);
  convT(tidv, bidv, p.in[8] + (size_t)l * 2048 * NIN, wb + OW_IN, 2048, NIN, nullptr, smem);
  convT(tidv, bidv, p.in[40] + (size_t)l * 2048 * 8192, wb + OW_M1, 2048, 8192, nullptr, smem);
  convT(tidv, bidv, p.in[41] + (size_t)l * 8192 * 2048, wb + OW_M2, 8192, 2048, nullptr, smem);
  for (int n = 0; n < 3; n++)
    convT(tidv, bidv, p.in[38] + (size_t)(l * 3 + n) * 1024 * 2048, wb + OW_BR + (size_t)n * 2048 * 1024, 1024, 2048, nullptr, smem);
  convT(tidv, bidv, p.in[39] + (size_t)l * 2048 * 2048, wb + OW_OUT, 2048, 2048, nullptr, smem);
  convT(tidv, bidv, p.in[11] + (size_t)l * 512 * 1536, wb + OW_UQ, 512, 1536, p.in[9] + l * 512, smem);
  convT(tidv, bidv, p.in[12] + (size_t)l * 512 * 2048, wb + OW_UKV, 512, 2048, p.in[10] + l * 512, smem);
  convT(tidv, bidv, p.in[36] + (size_t)l * 1024 * 1024, wb + OW_GLU, 1024, 1024, nullptr, smem);
  for (int d = 0; d < 2; d++) {
    convT(tidv, bidv, p.in[19] + (size_t)(l * 2 + d) * 64 * 1024, wb + OW_W2 + (size_t)d * 65536, 64, 1024, nullptr, smem);
    convT(tidv, bidv, p.in[21] + (size_t)(l * 2 + d) * 64 * 1024, wb + OW_A2 + (size_t)d * 65536, 64, 1024, nullptr, smem);
  }
  convT(tidv, bidv, p.in[22] + (size_t)l * 160 * 1024, wb + OW_G2, 160, 1024, nullptr, smem, 192);
}

DEV void phase_norm(int tidv, int bidv, const float* xlat, const float* xctx, const float* g, const float* mod, int shOff, int scOff, bf16* H, int nrows) {
  int wave = tidv >> 6, lane = tidv & 63;
  for (int row = bidv * NW + wave; row < nrows; row += gridDim.x * NW) {
    const float* x = row < ML ? xlat + (size_t)row * 2048 : xctx + (size_t)(row - ML) * 2048;
    int b = row < ML ? (row >> 12) : 4;
    const float* sh = mod + b * 12288 + shOff;
    const float* sc = mod + b * 12288 + scOff;
    float4 v[8];
    float ss = 0.f;
#pragma unroll
    for (int i = 0; i < 8; i++) {
      v[i] = *(const float4*)(x + i * 256 + lane * 4);
      ss += v[i].x * v[i].x + v[i].y * v[i].y + v[i].z * v[i].z + v[i].w * v[i].w;
    }
    ss = wsum(ss);
    float rinv = rsqrtf(ss * (1.f / 2048.f) + 1e-6f);
#pragma unroll
    for (int i = 0; i < 8; i++) {
      int c = i * 256 + lane * 4;
      float4 g4 = *(const float4*)(g + c), s4 = *(const float4*)(sc + c), h4 = *(const float4*)(sh + c);
      float y0 = v[i].x * rinv * g4.x * (1.f + s4.x) + h4.x;
      float y1 = v[i].y * rinv * g4.y * (1.f + s4.y) + h4.y;
      float y2 = v[i].z * rinv * g4.z * (1.f + s4.z) + h4.z;
      float y3 = v[i].w * rinv * g4.w * (1.f + s4.w) + h4.w;
      uint2 o;
      o.x = pack2(y0, y1);
      o.y = pack2(y2, y3);
      *(uint2*)(H + (size_t)row * 2048 + c) = o;
    }
  }
}

constexpr int LDT = 72;
constexpr int GA_BYTES = 256 * LDT * 2;
constexpr int GSTAGE = 512 * LDT * 2;
constexpr int SM_RINV = 2 * GSTAGE;
constexpr int SM_ITEM = SM_RINV + 1024;
constexpr int LDS_BYTES = SM_ITEM + 16;
DEV float sumsq8(uint4 r) {
  float s = 0.f, x;
  x = bf2f((bf16)(r.x & 0xffff)); s += x * x; x = bf2f((bf16)(r.x >> 16)); s += x * x;
  x = bf2f((bf16)(r.y & 0xffff)); s += x * x; x = bf2f((bf16)(r.y >> 16)); s += x * x;
  x = bf2f((bf16)(r.z & 0xffff)); s += x * x; x = bf2f((bf16)(r.z >> 16)); s += x * x;
  x = bf2f((bf16)(r.w & 0xffff)); s += x * x; x = bf2f((bf16)(r.w >> 16)); s += x * x;
  return s;
}

template <bool ROWNORM>
DEV void gemm_mainloop(int tidv, int bidv, const bf16* __restrict__ A, int lda, bool amap, const bf16* __restrict__ Bt, int K, int N, int m0, int n0,
                       char* smem, f32x16 (&acc)[4][2]) {
  float* srinv = (float*)(smem + SM_RINV);
  const int tid = tidv, lane = tid & 63, wave = tid >> 6;
  const int wm = wave >> 2, wn = wave & 3;
  const int lr = tid >> 3, kc = tid & 7;
  const char* abase = (const char*)(A + (size_t)m0 * lda);
  const char* bbase = (const char*)(Bt + (size_t)n0 * K);
  const uint32_t voa = (uint32_t)(lr * lda + kc * 8) * 2u;
  const uint32_t astep = (uint32_t)(64 * lda) * 2u;
  const uint32_t vob0 = (uint32_t)(lr * K + kc * 8) * 2u;
  const uint32_t bstep = (uint32_t)(64 * K) * 2u;
  const uint32_t lds_st = (uint32_t)(lr * LDT + kc * 8) * 2u;
  const int nk = K >> 6;
  uint4 xa0, xa1, xa2, xa3, xb0, xb1, xb2, xb3;
#define G_LOAD(KT)                                                         \
  {                                                                        \
    const int k0_ = (KT) << 6;                                             \
    const int ka_ = amap ? ((k0_ >> 7) * 192 + (k0_ & 127)) : k0_;         \
    xa0 = *(const uint4*)(abase + (size_t)ka_ * 2 + voa);                  \
    xa1 = *(const uint4*)(abase + (size_t)ka_ * 2 + astep + voa);          \
    xa2 = *(const uint4*)(abase + (size_t)ka_ * 2 + 2 * astep + voa);      \
    xa3 = *(const uint4*)(abase + (size_t)ka_ * 2 + 3 * astep + voa);      \
    xb0 = *(const uint4*)(bbase + (size_t)k0_ * 2 + vob0);                 \
    xb1 = *(const uint4*)(bbase + (size_t)k0_ * 2 + bstep + vob0);         \
    xb2 = *(const uint4*)(bbase + (size_t)k0_ * 2 + 2 * bstep + vob0);     \
    xb3 = *(const uint4*)(bbase + (size_t)k0_ * 2 + 3 * bstep + vob0);     \
  }
#define G_STORE(SN)                                                  \
  *(uint4*)((SN) + lds_st) = xa0;                                    \
  *(uint4*)((SN) + 1 * (64 * LDT * 2) + lds_st) = xa1;               \
  *(uint4*)((SN) + 2 * (64 * LDT * 2) + lds_st) = xa2;               \
  *(uint4*)((SN) + 3 * (64 * LDT * 2) + lds_st) = xa3;               \
  *(uint4*)((SN) + GA_BYTES + lds_st) = xb0;                         \
  *(uint4*)((SN) + GA_BYTES + 1 * (64 * LDT * 2) + lds_st) = xb1;    \
  *(uint4*)((SN) + GA_BYTES + 2 * (64 * LDT * 2) + lds_st) = xb2;    \
  *(uint4*)((SN) + GA_BYTES + 3 * (64 * LDT * 2) + lds_st) = xb3;
  const uint32_t fa = (uint32_t)((wm * 128 + (lane & 31)) * LDT + (lane >> 5) * 8) * 2u;
  const uint32_t fb = (uint32_t)GA_BYTES + (uint32_t)((wn * 64 + (lane & 31)) * LDT + (lane >> 5) * 8) * 2u;
  const int nkm = nk - 1;
  if (ROWNORM) {
    __syncthreads();
#pragma unroll 1
    for (int i = 0; i < 4; i++) {
      float ss = 0.f;
      for (int kk = 0; kk < nk; kk++) ss += sumsq8(*(const uint4*)(abase + (size_t)kk * 128 + i * astep + voa));
      ss += __shfl_xor(ss, 1); ss += __shfl_xor(ss, 2); ss += __shfl_xor(ss, 4);
      if (kc == 0) srinv[lr + 64 * i] = rsqrtf(ss / (float)K + 1e-6f);
    }
  }
  G_LOAD(0)
  __syncthreads();
  G_STORE(smem)
  G_LOAD((1 < nkm ? 1 : nkm))
  __syncthreads();
#define G_FRAG(P, ST, KS)                                                            \
  P##a0 = *(const bf16x8*)((ST) + fa + 0 * (32 * LDT * 2) + (KS) * 32);                \
  P##a1 = *(const bf16x8*)((ST) + fa + 1 * (32 * LDT * 2) + (KS) * 32);                \
  P##a2 = *(const bf16x8*)((ST) + fa + 2 * (32 * LDT * 2) + (KS) * 32);                \
  P##a3 = *(const bf16x8*)((ST) + fa + 3 * (32 * LDT * 2) + (KS) * 32);                \
  P##b0 = *(const bf16x8*)((ST) + fb + 0 * (32 * LDT * 2) + (KS) * 32);                \
  P##b1 = *(const bf16x8*)((ST) + fb + 1 * (32 * LDT * 2) + (KS) * 32);
#define G_MMA(P)                                                                              \
  acc[0][0] = __builtin_amdgcn_mfma_f32_32x32x16_bf16(P##b0, P##a0, acc[0][0], 0, 0, 0);      \
  acc[0][1] = __builtin_amdgcn_mfma_f32_32x32x16_bf16(P##b1, P##a0, acc[0][1], 0, 0, 0);      \
  acc[1][0] = __builtin_amdgcn_mfma_f32_32x32x16_bf16(P##b0, P##a1, acc[1][0], 0, 0, 0);      \
  acc[1][1] = __builtin_amdgcn_mfma_f32_32x32x16_bf16(P##b1, P##a1, acc[1][1], 0, 0, 0);      \
  acc[2][0] = __builtin_amdgcn_mfma_f32_32x32x16_bf16(P##b0, P##a2, acc[2][0], 0, 0, 0);      \
  acc[2][1] = __builtin_amdgcn_mfma_f32_32x32x16_bf16(P##b1, P##a2, acc[2][1], 0, 0, 0);      \
  acc[3][0] = __builtin_amdgcn_mfma_f32_32x32x16_bf16(P##b0, P##a3, acc[3][0], 0, 0, 0);      \
  acc[3][1] = __builtin_amdgcn_mfma_f32_32x32x16_bf16(P##b1, P##a3, acc[3][1], 0, 0, 0);
  bf16x8 pa0, pa1, pa2, pa3, pb0, pb1, qa0, qa1, qa2, qa3, qb0, qb1;
#pragma unroll 1
  for (int kt = 0; kt < nk; kt++) {
    const char* st = smem + (kt & 1) * GSTAGE;
    char* sn = smem + ((kt + 1) & 1) * GSTAGE;
    if (!ROWNORM) {
      G_FRAG(p, st, 0)
      G_FRAG(q, st, 1)
      __builtin_amdgcn_sched_barrier(0);
      G_MMA(p)
      __builtin_amdgcn_sched_barrier(0);
      G_FRAG(p, st, 2)
      __builtin_amdgcn_sched_barrier(0);
      G_MMA(q)
      __builtin_amdgcn_sched_barrier(0);
      G_FRAG(q, st, 3)
      if (kt + 1 < nk) { G_STORE(sn) }
      G_LOAD((kt + 2 < nkm ? kt + 2 : nkm))
      __builtin_amdgcn_sched_barrier(0);
      G_MMA(p)
      __builtin_amdgcn_sched_barrier(0);
      G_MMA(q)
    } else {
      G_FRAG(p, st, 0)
      __builtin_amdgcn_sched_barrier(0);
      G_MMA(p)
      __builtin_amdgcn_sched_barrier(0);
      G_FRAG(p, st, 1)
      __builtin_amdgcn_sched_barrier(0);
      G_MMA(p)
      __builtin_amdgcn_sched_barrier(0);
      G_FRAG(p, st, 2)
      if (kt + 1 < nk) { G_STORE(sn) }
      G_LOAD((kt + 2 < nkm ? kt + 2 : nkm))
      __builtin_amdgcn_sched_barrier(0);
      G_MMA(p)
      __builtin_amdgcn_sched_barrier(0);
      G_FRAG(p, st, 3)
      __builtin_amdgcn_sched_barrier(0);
      G_MMA(p)
    }
    __syncthreads();
  }
#undef G_FRAG
#undef G_MMA
#undef G_LOAD
#undef G_STORE
}

DEV void zero_acc(f32x16 (&acc)[4][2]) {
#pragma unroll
  for (int i = 0; i < 4; i++)
#pragma unroll
    for (int j = 0; j < 2; j++)
#pragma unroll
      for (int e = 0; e < 16; e++) acc[i][j][e] = 0.f;
}

template <class F>
DEV void epi_loop(int tidv, int bidv, f32x16 (&acc)[4][2], int m0, int n0, int N, F f) {
  const int lane = tidv & 63, wave = tidv >> 6;
  const int wm = wave >> 2, wn = wave & 3;
#pragma unroll
  for (int i = 0; i < 4; i++) {
    const int lrow = wm * 128 + i * 32 + (lane & 31);
#pragma unroll
    for (int j = 0; j < 2; j++) {
#pragma unroll
      for (int g = 0; g < 4; g++) {
        int col = n0 + wn * 64 + j * 32 + 8 * g + 4 * (lane >> 5);
        f32x4 v = {acc[i][j][4 * g], acc[i][j][4 * g + 1], acc[i][j][4 * g + 2], acc[i][j][4 * g + 3]};
        if (col < N) f(m0 + lrow, lrow, col, v);
      }
    }
    __builtin_amdgcn_sched_barrier(0);
  }
}

DEV uint2 pack4(f32x4 v) {
  uint2 o;
  o.x = pack2(v[0], v[1]);
  o.y = pack2(v[2], v[3]);
  return o;
}
DEV f32x4 unpack4(uint2 u) {
  f32x4 v;
  v[0] = bf2f((bf16)(u.x & 0xffff)); v[1] = bf2f((bf16)(u.x >> 16));
  v[2] = bf2f((bf16)(u.y & 0xffff)); v[3] = bf2f((bf16)(u.y >> 16));
  return v;
}

enum { G_IN = 0, G_UQ, G_UKV, G_W2, G_A2, G_G2, G_GLU, G_OUT, G_M1, G_M2, G_MG0, G_MG1, G_MG2 };

template <int MODE>
DEV void run_gemm(int tidv, int bidv, const Params& p, int l, char* smem, const bf16* A, int lda, const bf16* Bt, int K, int N, int M, int aux,
                  const float* xin_lat, const float* xin_ctx, float* xout_lat, float* xout_ctx) {
  const int nt = (N + 255) >> 8, mt = M >> 8;
  char* ws = p.ws;
  bf16* Z = (bf16*)(ws + B_ZB);
  const float* srinv = (const float*)(smem + SM_RINV);
  const float* mod = (const float*)(ws + B_MOD) + (size_t)l * 5 * 12288;
  for (int tile = bidv; tile < nt * mt; tile += gridDim.x) {
    int m0 = (tile / nt) << 8, n0 = (tile % nt) << 8;
    f32x16 acc[4][2];
    zero_acc(acc);
    gemm_mainloop<(MODE == G_UQ || MODE == G_UKV)>(tidv, bidv, A, lda, MODE == G_MG0, Bt, K, N, m0, n0, smem, acc);
    if constexpr (MODE != G_OUT && MODE != G_M2)
    epi_loop(tidv, bidv, acc, m0, n0, N, [&](int row, int lrow, int col, f32x4 v) {
      if constexpr (MODE == G_IN) {
        f32x4 o = v;
        if (col >= C_GATE || (col >= C_GD && col < C_U)) {
#pragma unroll
          for (int r = 0; r < 4; r++) o[r] = sigmoidf_(v[r]);
        } else if (col >= C_WD && col < C_AD) {
#pragma unroll
          for (int r = 0; r < 4; r++) o[r] = tanhf(v[r]);
        }
        *(uint2*)(smem + ((size_t)lrow * 264 + (col - n0)) * 2) = pack4(o);
      } else if constexpr (MODE == G_UQ) {
        float ri = srinv[lrow];
        *(uint2*)((bf16*)(ws + B_QB) + (size_t)row * 1536 + col) = pack4(v * ri);
      } else if constexpr (MODE == G_UKV) {
        float ri = srinv[lrow];
        f32x4 o = v * ri;
        int h = col >> 8, c = col & 255;
        if (c < 128) {
          *(uint2*)((bf16*)(ws + B_KN) + (size_t)row * 1024 + h * 128 + c) = pack4(o);
        } else {
          int b, kp;
          if (row < ML) { b = row >> 12; kp = row & 4095; } else { int r2 = row - ML; b = r2 >> 8; kp = 4096 + (r2 & 255); }
          bf16* vt = (bf16*)(ws + B_VT) + ((size_t)((b * 8 + h) * 128 + (c - 128))) * NKEY + kp;
#pragma unroll
          for (int r = 0; r < 4; r++) vt[(size_t)r * NKEY] = f2bf(o[r]);
        }
      } else if constexpr (MODE == G_W2) {
        float4 w0 = *(const float4*)(p.in[18] + (l * 2 + aux) * 1024 + col);
        f32x4 o;
        o[0] = 0.60653066f * sigmoidf_(w0.x + v[0]);
        o[1] = 0.60653066f * sigmoidf_(w0.y + v[1]);
        o[2] = 0.60653066f * sigmoidf_(w0.z + v[2]);
        o[3] = 0.60653066f * sigmoidf_(w0.w + v[3]);
        *(uint2*)((bf16*)(ws + B_HB + (size_t)aux * SZ1K) + (size_t)row * 1024 + col) = pack4(o);
      } else if constexpr (MODE == G_A2) {
        float4 a0 = *(const float4*)(p.in[20] + (l * 2 + aux) * 1024 + col);
        f32x4 o;
        o[0] = sigmoidf_(a0.x + v[0]);
        o[1] = sigmoidf_(a0.y + v[1]);
        o[2] = sigmoidf_(a0.z + v[2]);
        o[3] = sigmoidf_(a0.w + v[3]);
        *(uint2*)((bf16*)(ws + (aux ? B_AB : B_AF)) + (size_t)row * 1024 + col) = pack4(o);
      } else if constexpr (MODE == G_G2) {
        *(uint2*)((bf16*)(ws + B_GB) + (size_t)row * 1024 + col) = pack4(v);
      } else if constexpr (MODE == G_GLU) {
        f32x4 zz = unpack4(*(const uint2*)((const bf16*)(ws + B_SY) + (size_t)row * 1024 + col));
        float4 gb = *(const float4*)(p.in[37] + l * 1024 + col);
        f32x4 o;
        o[0] = zz[0] * sigmoidf_(v[0] + gb.x);
        o[1] = zz[1] * sigmoidf_(v[1] + gb.y);
        o[2] = zz[2] * sigmoidf_(v[2] + gb.z);
        o[3] = zz[3] * sigmoidf_(v[3] + gb.w);
        *(uint2*)(smem + ((size_t)lrow * 264 + (col - n0)) * 2) = pack4(o);
      } else if constexpr (MODE == G_OUT || MODE == G_M2) {
      } else if constexpr (MODE == G_M1) {
        f32x4 o;
#pragma unroll
        for (int r = 0; r < 4; r++) { float t = fmaxf(v[r], 0.f); o[r] = t * t; }
        *(uint2*)(smem + ((size_t)lrow * 264 + (col - n0)) * 2) = pack4(o);
      } else if constexpr (MODE == G_MG0 || MODE == G_MG1 || MODE == G_MG2) {
        *(uint2*)(smem + ((size_t)lrow * 264 + (col - n0)) * 2) = pack4(v);
      }
    });
    if constexpr (MODE == G_OUT || MODE == G_M2) {
      float* tilef = (float*)smem;
      constexpr int GOFF = (MODE == G_OUT) ? 4096 : 10240;
      const int wn_ = (tidv >> 6) & 3;
#pragma unroll 1
      for (int half = 0; half < 2; half++) {
        if ((wn_ >> 1) == half) {
          epi_loop(tidv, bidv, acc, m0, n0, N, [&](int row, int lrow, int col, f32x4 v) {
            *(f32x4*)(tilef + (size_t)lrow * 132 + (col - n0 - half * 128)) = v;
          });
        }
        __syncthreads();
#pragma unroll 2
        for (int it = 0; it < 16; it++) {
          int c = it * NT + tidv;
          int r = c >> 5, ch = c & 31;
          int row = m0 + r, col = n0 + half * 128 + ch * 4;
          int b = row < ML ? (row >> 12) : 4;
          float4 g = *(const float4*)(mod + b * 12288 + GOFF + col);
          const float* xi;
          if constexpr (MODE == G_OUT) xi = row < ML ? xin_lat + (size_t)row * 2048 : xin_ctx + (size_t)(row - ML) * 2048;
          else xi = row < ML ? xout_lat + (size_t)row * 2048 : xout_ctx + (size_t)(row - ML) * 2048;
          float* xo = row < ML ? xout_lat + (size_t)row * 2048 : xout_ctx + (size_t)(row - ML) * 2048;
          float4 x = *(const float4*)(xi + col);
          f32x4 v = *(const f32x4*)(tilef + (size_t)r * 132 + ch * 4);
          x.x += g.x * v[0]; x.y += g.y * v[1]; x.z += g.z * v[2]; x.w += g.w * v[3];
          *(float4*)(xo + col) = x;
        }
        __syncthreads();
      }
    }
    if constexpr (MODE == G_MG0 || MODE == G_MG1 || MODE == G_MG2) {
      constexpr int nb = MODE - G_MG0;
      bf16* MG = (bf16*)(ws + B_HB);
      __syncthreads();
#pragma unroll 2
      for (int it = 0; it < 16; it++) {
        int c = it * NT + tidv;
        int r = c >> 5, ch = c & 31;
        int col = n0 + ch * 8;
        uint4 pv = *(const uint4*)(smem + ((size_t)r * 264 + ch * 8) * 2);
        uint4 gv = *(const uint4*)(Z + (size_t)(m0 + r) * NIN + C_GATE + nb * 2048 + col);
        f32x4 p0 = unpack4(uint2{pv.x, pv.y}), p1 = unpack4(uint2{pv.z, pv.w});
        f32x4 g0 = unpack4(uint2{gv.x, gv.y}), g1 = unpack4(uint2{gv.z, gv.w});
        f32x4 o0 = g0 * p0, o1 = g1 * p1;
        if constexpr (nb > 0) {
          uint4 qv = *(const uint4*)(MG + (size_t)(m0 + r) * 2048 + col);
          o0 += unpack4(uint2{qv.x, qv.y});
          o1 += unpack4(uint2{qv.z, qv.w});
        }
        uint2 a = pack4(o0), b = pack4(o1);
        *(uint4*)(MG + (size_t)(m0 + r) * 2048 + col) = uint4{a.x, a.y, b.x, b.y};
      }
    }
    if constexpr (MODE == G_IN || MODE == G_GLU || MODE == G_M1) {
      bf16* dst;
      int ld;
      if constexpr (MODE == G_IN || MODE == G_GLU) { dst = Z; ld = NIN; }
      else { dst = Z; ld = DFF; }
      __syncthreads();
#pragma unroll 4
      for (int it = 0; it < 16; it++) {
        int c = it * NT + tidv;
        int r = c >> 5, ch = c & 31;
        int col = n0 + ch * 8;
        if (col < N) *(uint4*)(dst + (size_t)(m0 + r) * ld + col) = *(const uint4*)(smem + ((size_t)r * 264 + ch * 8) * 2);
      }
    }
  }
}

DEV void phase_mla_post(int tidv, int bidv, const Params& p, int l) {
  char* ws = p.ws;
  const float* qng = p.in[13] + l * 128;
  const float* qrg = p.in[14] + l * 64;
  const float* kng = p.in[15] + l * 128;
  const float* krg = p.in[16] + l * 64;
  bf16* QB = (bf16*)(ws + B_QB);
  bf16* KN = (bf16*)(ws + B_KN);
  bf16* KR = (bf16*)(ws + B_KR);
  const bf16* Z = (const bf16*)(ws + B_ZB);
  const int wave = tidv >> 6, lane = tidv & 63;
  const float QS = 1.4426950408889634f * 0.07216878364870322f;
  const int idx = lane & 31;
  const float inv = powf(10000.f, -(float)(idx & 15) / 16.f);
  const float gq0 = qng[2 * lane], gq1 = qng[2 * lane + 1], gk0 = kng[2 * lane], gk1 = kng[2 * lane + 1];
  const float gqr = qrg[lane], gkr = krg[lane];
  for (int row = bidv * NW + wave; row < MT; row += gridDim.x * NW) {
    bool lat = row < ML;
    int t = row & 4095;
    float pos = (idx < 16) ? (float)(t >> 6) : (float)(t & 63);
    float ang = pos * inv;
    float cs = 1.f, sn = 0.f;
    if (lat) { cs = cosf(ang); sn = sinf(ang); }
#pragma unroll 1
    for (int h = 0; h < 8; h++) {
      bf16* q = QB + (size_t)row * 1536 + h * 192;
      uint32_t u = *(const uint32_t*)(q + 2 * lane);
      float x0 = bf2f((bf16)(u & 0xffff)), x1 = bf2f((bf16)(u >> 16));
      float ss = wsum(x0 * x0 + x1 * x1);
      float rinv = rsqrtf(ss * (1.f / 128.f) + 1e-6f) * QS;
      *(uint32_t*)(q + 2 * lane) = pack2(x0 * rinv * gq0, x1 * rinv * gq1);
      float xr = bf2f(q[128 + lane]);
      float ss2 = wsum(xr * xr);
      float y = xr * rsqrtf(ss2 * (1.f / 64.f) + 1e-6f) * gqr;
      float yp = __shfl_xor(y, 32);
      float o = lane < 32 ? (y * cs - yp * sn) : (yp * sn + y * cs);
      q[128 + lane] = f2bf(o * QS);
      bf16* k = KN + (size_t)row * 1024 + h * 128;
      uint32_t uk = *(const uint32_t*)(k + 2 * lane);
      float k0 = bf2f((bf16)(uk & 0xffff)), k1 = bf2f((bf16)(uk >> 16));
      float ssk = wsum(k0 * k0 + k1 * k1);
      float rk = rsqrtf(ssk * (1.f / 128.f) + 1e-6f);
      *(uint32_t*)(k + 2 * lane) = pack2(k0 * rk * gk0, k1 * rk * gk1);
    }
    {
      float xr = bf2f(Z[(size_t)row * NIN + C_KR + lane]);
      float ss2 = wsum(xr * xr);
      float y = xr * rsqrtf(ss2 * (1.f / 64.f) + 1e-6f) * gkr;
      float yp = __shfl_xor(y, 32);
      float o = lane < 32 ? (y * cs - yp * sn) : (yp * sn + y * cs);
      KR[(size_t)row * 64 + lane] = f2bf(o);
    }
  }
}

DEV void step_row(int s, int d, int b, int& row, int& tau, int& len) {
  if (s < 256) { tau = d ? 255 - s : s; len = 256; row = ML + b * 256 + tau; }
  else { int q = s - 256; tau = d ? 4095 - q : q; len = 4096; row = b * 4096 + tau; }
}

struct RwPre { bf16 r0, r1, r2, k0, k1, k2, v0, v1, v2, a, e; };

DEV void rwkv_fetch(RwPre& q, const bf16* Z, const bf16* AD, const bf16* ED, int s, int d, int b, int ch) {
  int row, tau, len;
  step_row(s, d, b, row, tau, len);
  const bf16* z = Z + (size_t)row * NIN + C_R + ch;
  q.r1 = z[0]; q.k1 = z[1024]; q.v1 = z[2048];
  q.r0 = 0; q.k0 = 0; q.v0 = 0; q.r2 = 0; q.k2 = 0; q.v2 = 0;
  if (tau > 0) { const bf16* zm = z - NIN; q.r0 = zm[0]; q.k0 = zm[1024]; q.v0 = zm[2048]; }
  if (tau < len - 1) { const bf16* zp = z + NIN; q.r2 = zp[0]; q.k2 = zp[1024]; q.v2 = zp[2048]; }
  q.a = AD[(size_t)row * 1024 + ch];
  q.e = ED[(size_t)row * 1024 + ch];
}

typedef float f2v __attribute__((ext_vector_type(2)));
DEV float dpp_hmirror(float v) {
  int i = __float_as_int(v);
  return __int_as_float(__builtin_amdgcn_update_dpp(0, i, 0x141, 0xF, 0xF, true));
}
DEV f2v lo2(float4 v) { return f2v{v.x, v.y}; }
DEV f2v hi2(float4 v) { return f2v{v.z, v.w}; }

DEV void rwkv_scan(int tidv, int bidv, const Params& p, int l, int chain, char* smem, int dry) {
  char* ws = p.ws;
  float* op = (float*)smem;
  float* vb = op + 16 * 320;
  float* yb = vb + 16 * 64;
  const int tid = tidv, wave = tid >> 6, lane = tid & 63;
  const int d = chain & 1, h = (chain >> 1) & 15, b = chain >> 5;
  const int ch = h * 64 + lane;
  const float* cw = p.in[17] + (size_t)l * 3 * 3072;
  const float cr0 = cw[ch], cr1 = cw[3072 + ch], cr2 = cw[6144 + ch];
  const float ck0 = cw[1024 + ch], ck1 = cw[3072 + 1024 + ch], ck2 = cw[6144 + 1024 + ch];
  const float cv0 = cw[2048 + ch], cv1 = cw[3072 + 2048 + ch], cv2 = cw[6144 + 2048 + ch];
  const float kkc = p.in[23][l * 1024 + ch], kac = p.in[24][l * 1024 + ch];
  const bf16* Z = (const bf16*)(ws + B_ZB);
  bf16* ED = (bf16*)(ws + B_HB + (size_t)d * SZ1K);
  const bf16* AD = (const bf16*)(ws + (d ? B_AB : B_AF));
  f2v A0 = {0.f, 0.f}, A1 = {0.f, 0.f}, B0 = {0.f, 0.f}, B1 = {0.f, 0.f};
  const int ri = lane >> 4, jo = lane & 15, rA = wave * 8 + ri, rB = rA + 4;
  RwPre pre[2];
#pragma unroll
  for (int si = 0; si < 2; si++) rwkv_fetch(pre[si], Z, AD, ED, wave * 2 + si, d, b, ch);
  for (int chunk = 0; chunk < 272; chunk++) {
#pragma unroll
    for (int si = 0; si < 2; si++) {
      int t = wave * 2 + si;
      const RwPre& q = pre[si];
      float rr = cr0 * bf2f(q.r0) + cr1 * bf2f(q.r1) + cr2 * bf2f(q.r2);
      float kk_ = ck0 * bf2f(q.k0) + ck1 * bf2f(q.k1) + ck2 * bf2f(q.k2);
      float vv = cv0 * bf2f(q.v0) + cv1 * bf2f(q.v1) + cv2 * bf2f(q.v2);
      float kkv = kk_ * kkc;
      float ssq = wsum(kkv * kkv);
      float kn = kkv * rsqrtf(ssq + 1e-12f);
      float a = bf2f(q.a);
      float w = __expf(-bf2f(q.e));
      float krep = kk_ * (1.f + (a - 1.f) * kac);
      float* o = op + t * 320;
      o[lane] = w;
      o[64 + lane] = kn * a;
      o[128 + lane] = krep;
      o[192 + lane] = -kn;
      o[256 + lane] = rr;
      vb[t * 64 + lane] = vv;
    }
    __syncthreads();
    if (chunk + 1 < 272) {
#pragma unroll
      for (int si = 0; si < 2; si++) rwkv_fetch(pre[si], Z, AD, ED, (chunk + 1) * 16 + wave * 2 + si, d, b, ch);
    }
    {
      const float4* o4 = (const float4*)op + jo;
      float4 nn = o4[48];
#pragma unroll 4
      for (int t = 0; t < 16; t++) {
        const float4* ot = o4 + t * 80;
        const float4 w = ot[0], a = ot[16], k = ot[32], r = ot[64];
        const float viA = vb[t * 64 + rA], viB = vb[t * 64 + rB];
        const int tn = t < 15 ? t + 1 : 15;
        const float4 mm = o4[tn * 80 + 48];
        f2v svA = A0 * lo2(nn) + A1 * hi2(nn);
        f2v svB = B0 * lo2(nn) + B1 * hi2(nn);
        float saA = svA.x + svA.y, saB = svB.x + svB.y;
        saA += dpp_xor1(saA); saB += dpp_xor1(saB);
        saA += dpp_xor2(saA); saB += dpp_xor2(saB);
        saA += dpp_hmirror(saA); saB += dpp_hmirror(saB);
        saA += dpp_rmirror(saA); saB += dpp_rmirror(saB);
        const f2v sA2 = {saA, saA}, vA2 = {viA, viA}, sB2 = {saB, saB}, vB2 = {viB, viB};
        A0 = A0 * lo2(w) + sA2 * lo2(a) + vA2 * lo2(k);
        B0 = B0 * lo2(w) + sB2 * lo2(a) + vB2 * lo2(k);
        A1 = A1 * hi2(w) + sA2 * hi2(a) + vA2 * hi2(k);
        B1 = B1 * hi2(w) + sB2 * hi2(a) + vB2 * hi2(k);
        f2v yvA = A0 * lo2(r) + A1 * hi2(r);
        f2v yvB = B0 * lo2(r) + B1 * hi2(r);
        yb[(t * 64 + rA) * 16 + jo] = yvA.x + yvA.y;
        yb[(t * 64 + rB) * 16 + jo] = yvB.x + yvB.y;
        nn = mm;
      }
    }
    __syncthreads();
#pragma unroll
    for (int it = 0; it < 2; it++) {
      int idx = it * NT + tid;
      int t = idx >> 6, i = idx & 63;
      int row, tau, len;
      step_row(chunk * 16 + t, d, b, row, tau, len);
      size_t off = (size_t)row * 1024 + h * 64 + i;
      bf16* yd = dry ? (bf16*)(ws + B_END) + (off & 0x3fffff) : ED + off;
      const float4* yp = (const float4*)(yb + (t * 64 + i) * 16);
      const float4 ya = yp[0], yc = yp[1], ye = yp[2], yg = yp[3];
      *yd = f2bf((((ya.x + ya.y) + (ya.z + ya.w)) + ((yc.x + yc.y) + (yc.z + yc.w))) + (((ye.x + ye.y) + (ye.z + ye.w)) + ((yg.x + yg.y) + (yg.z + yg.w))));
    }
  }
}

DEV void s5_scan(int tidv, int bidv, const Params& p, int l, int chain, char* smemw, int dry) {
  char* ws = p.ws;
  const int lane = tidv & 63;
  const int d = chain & 1, g = (chain >> 1) & 63, b = chain >> 7;
  float* ub = (float*)smemw;
  float* hb = ub + 256;
  const size_t pg = (size_t)(l * 2 + d) * 64 + g;
  const float lre = p.in[28][pg * 64 + lane], lim = p.in[29][pg * 64 + lane];
  const float dt = expf(p.in[30][pg]);
  const float mag = expf(lre * dt);
  const float are = mag * cosf(lim * dt), aim = mag * sinf(lim * dt);
  const float den = lre * lre + lim * lim;
  const float qre = ((are - 1.f) * lre + aim * lim) / den;
  const float qim = (aim * lre - (are - 1.f) * lim) / den;
  float bbre[16], bbim[16];
  {
    const float* br = p.in[31] + (pg * 64 + lane) * 16;
    const float* bi = p.in[32] + (pg * 64 + lane) * 16;
#pragma unroll
    for (int i = 0; i < 16; i++) {
      float x = br[i], y = bi[i];
      bbre[i] = qre * x - qim * y;
      bbim[i] = qre * y + qim * x;
    }
  }
  bf16x8 cfr[4];
  {
    const int i = lane & 15, quad = lane >> 4;
    const float* cre = p.in[33] + (pg * 16 + i) * 64;
    const float* cim = p.in[34] + (pg * 16 + i) * 64;
#pragma unroll
    for (int ks = 0; ks < 4; ks++)
#pragma unroll
      for (int j = 0; j < 8; j++) {
        int k = ks * 32 + quad * 8 + j;
        float c = ks < 2 ? cre[k] : -cim[k - 64];
        cfr[ks][j] = (short)f2bf(c);
      }
  }
  float hre = 0.f, him = 0.f;
  const bf16* Z = (const bf16*)(ws + B_ZB);
  const int tt = lane >> 2, i0 = (lane & 3) * 4;
  uint2 unext;
  {
    int row, tau, len;
    step_row(tt, d, b, row, tau, len);
    unext = *(const uint2*)(Z + (size_t)row * NIN + C_U + g * 16 + i0);
  }
  for (int chunk = 0; chunk < 272; chunk++) {
    {
      uint2 u = unext;
      float4 f;
      f.x = bf2f((bf16)(u.x & 0xffff)); f.y = bf2f((bf16)(u.x >> 16));
      f.z = bf2f((bf16)(u.y & 0xffff)); f.w = bf2f((bf16)(u.y >> 16));
      *(float4*)(ub + tt * 16 + i0) = f;
    }
    __syncthreads();
    if (chunk + 1 < 272) {
      int row, tau, len;
      step_row((chunk + 1) * 16 + tt, d, b, row, tau, len);
      unext = *(const uint2*)(Z + (size_t)row * NIN + C_U + g * 16 + i0);
    }
#pragma unroll 2
    for (int t = 0; t < 16; t++) {
      const float* u = ub + t * 16;
      float br0 = 0.f, bi0 = 0.f;
#pragma unroll
      for (int i = 0; i < 16; i++) { float uv = u[i]; br0 += bbre[i] * uv; bi0 += bbim[i] * uv; }
      float nr = are * hre - aim * him + br0;
      float ni = are * him + aim * hre + bi0;
      hre = nr; him = ni;
      hb[t * 132 + lane] = hre;
      hb[t * 132 + 64 + lane] = him;
    }
    __syncthreads();
    {
      f32x4 yacc = {0.f, 0.f, 0.f, 0.f};
      const float* hr = hb + (lane & 15) * 132 + (lane >> 4) * 8;
#pragma unroll
      for (int ks = 0; ks < 4; ks++) {
        float4 x0 = *(const float4*)(hr + ks * 32), x1 = *(const float4*)(hr + ks * 32 + 4);
        union { bf16x8 v; uint32_t u[4]; } af;
        af.u[0] = pack2(x0.x, x0.y); af.u[1] = pack2(x0.z, x0.w);
        af.u[2] = pack2(x1.x, x1.y); af.u[3] = pack2(x1.z, x1.w);
        yacc = __builtin_amdgcn_mfma_f32_16x16x32_bf16(af.v, cfr[ks], yacc, 0, 0, 0);
      }
      const int ii = lane & 15;
#pragma unroll
      for (int r = 0; r < 4; r++) {
        int row, tau, len;
        step_row(chunk * 16 + (lane >> 4) * 4 + r, d, b, row, tau, len);
        bf16* dst = d == 0 ? (bf16*)(ws + B_SY) + (size_t)row * 1024 + g * 16 + ii : (bf16*)(ws + B_ZB) + (size_t)row * NIN + g * 16 + ii;
        if (dry) dst = (bf16*)(ws + B_END) + ((((size_t)row * 1024 + g * 16 + ii)) & 0x3fffff);
        *dst = f2bf(yacc[r]);
      }
    }
    __syncthreads();
  }
}

DEV int perm23(int r) { return (r & 0x13) | ((r & 4) << 1) | ((r & 8) >> 1); }

DEV void attn_item(int tidv, int bidv, const Params& p, int item, bool ctxq, char* smem, int dry) {
  char* ws = p.ws;
  bf16* sK = (bf16*)smem;
  bf16* sV = sK + 64 * 200;
  const int tid = tidv, wave = tid >> 6, lane = tid & 63;
  const int r = lane & 31, hf = lane >> 5;
  int b, hd, qt;
  if (!ctxq) { b = item >> 7; hd = (item >> 4) & 7; qt = item & 15; }
  else { b = item >> 3; hd = item & 7; qt = 0; }
  const int qrow0 = ctxq ? ML + b * 256 : b * 4096 + qt * 256;
  const int kt0 = ctxq ? 64 : 0, kt1 = 68;
  bf16* QB = (bf16*)(ws + B_QB);
  const bf16* KN = (const bf16*)(ws + B_KN);
  const bf16* KR = (const bf16*)(ws + B_KR);
  const bf16* VT = (const bf16*)(ws + B_VT);
  bf16x8 qf[12];
  {
    const bf16* qp = QB + (size_t)(qrow0 + wave * 32 + r) * 1536 + hd * 192 + hf * 8;
#pragma unroll
    for (int kk = 0; kk < 12; kk++) qf[kk] = *(const bf16x8*)(qp + kk * 16);
  }
  f32x16 oacc[4];
#pragma unroll
  for (int i = 0; i < 4; i++)
#pragma unroll
    for (int e = 0; e < 16; e++) oacc[i][e] = 0.f;
  float mrun = -1e30f, lrun = 0.f;
  const int pr = perm23(r);
  const uint32_t vo_n = (uint32_t)((tid >> 4) * 2048 + (tid & 15) * 16);
  const uint32_t lo_n = (uint32_t)((tid >> 4) * 400 + (tid & 15) * 16);
  const uint32_t vo_r = (uint32_t)((tid >> 3) * 128 + (tid & 7) * 16);
  const uint32_t lo_r = (uint32_t)((tid >> 3) * 400 + 256 + (tid & 7) * 16);
  const uint32_t vo_v = (uint32_t)((tid >> 3) * (NKEY * 2) + (tid & 7) * 16);
  const uint32_t lo_v = (uint32_t)((tid >> 3) * 144 + (tid & 7) * 16);
  uint4 t0, t1, t4, u0, u1;
#define ATT_LOAD(KT)                                                                                   \
  {                                                                                                    \
    const int key0_ = (KT) * 64;                                                                       \
    const int rowbase_ = key0_ < 4096 ? b * 4096 + key0_ : ML + b * 256 + (key0_ - 4096);               \
    const char* bk = (const char*)(KN + (size_t)rowbase_ * 1024 + hd * 128);                           \
    const char* br = (const char*)(KR + (size_t)rowbase_ * 64);                                        \
    const char* bv = (const char*)(VT + ((size_t)((b * 8 + hd) * 128)) * NKEY + key0_);                \
    t0 = *(const uint4*)(bk + vo_n);                                                                   \
    t1 = *(const uint4*)(bk + 32 * 2048 + vo_n);                                                       \
    t4 = *(const uint4*)(br + vo_r);                                                                   \
    u0 = *(const uint4*)(bv + vo_v);                                                                   \
    u1 = *(const uint4*)(bv + (size_t)64 * NKEY * 2 + vo_v);                                           \
  }
  ATT_LOAD(kt0)
  for (int kt = kt0; kt < kt1; kt++) {
    __syncthreads();
    *(uint4*)((char*)sK + lo_n) = t0;
    *(uint4*)((char*)sK + 32 * 400 + lo_n) = t1;
    *(uint4*)((char*)sK + lo_r) = t4;
    *(uint4*)((char*)sV + lo_v) = u0;
    *(uint4*)((char*)sV + 64 * 144 + lo_v) = u1;
    __syncthreads();
    ATT_LOAD((kt + 1 < kt1 ? kt + 1 : kt1 - 1))
    f32x16 sacc[2];
#pragma unroll
    for (int m = 0; m < 2; m++) {
#pragma unroll
      for (int e = 0; e < 16; e++) sacc[m][e] = 0.f;
      const bf16* kp = sK + (m * 32 + pr) * 200 + hf * 8;
#pragma unroll
      for (int kk = 0; kk < 12; kk++) {
        bf16x8 kf = *(const bf16x8*)(kp + kk * 16);
        sacc[m] = __builtin_amdgcn_mfma_f32_32x32x16_bf16(kf, qf[kk], sacc[m], 0, 0, 0);
        if ((kk & 3) == 3) __builtin_amdgcn_sched_barrier(0);
      }
      __builtin_amdgcn_sched_barrier(0);
    }
    float tmax = sacc[0][0];
#pragma unroll
    for (int e = 1; e < 16; e++) tmax = fmaxf(tmax, sacc[0][e]);
#pragma unroll
    for (int e = 0; e < 16; e++) tmax = fmaxf(tmax, sacc[1][e]);
    tmax = fmaxf(tmax, __shfl_xor(tmax, 32));
    float mnew = fmaxf(mrun, tmax);
    float alpha = __builtin_amdgcn_exp2f(mrun - mnew);
    mrun = mnew;
    float psum = 0.f;
#pragma unroll
    for (int m = 0; m < 2; m++)
#pragma unroll
      for (int e = 0; e < 16; e++) { float pv = __builtin_amdgcn_exp2f(sacc[m][e] - mnew); sacc[m][e] = pv; psum += pv; }
    lrun = lrun * alpha + psum;
#pragma unroll
    for (int i = 0; i < 4; i++)
#pragma unroll
      for (int e = 0; e < 16; e++) oacc[i][e] *= alpha;
#pragma unroll
    for (int s = 0; s < 4; s++) {
      const int m = s >> 1, s2 = s & 1;
      bf16x8 pf;
#pragma unroll
      for (int j = 0; j < 8; j++) pf[j] = (short)f2bf(sacc[m][8 * s2 + j]);
#pragma unroll
      for (int i = 0; i < 4; i++) {
        bf16x8 vf = *(const bf16x8*)(sV + (i * 32 + r) * 72 + m * 32 + s2 * 16 + hf * 8);
        oacc[i] = __builtin_amdgcn_mfma_f32_32x32x16_bf16(vf, pf, oacc[i], 0, 0, 0);
      }
      __builtin_amdgcn_sched_barrier(0);
    }
  }
#undef ATT_LOAD
  lrun += __shfl_xor(lrun, 32);
  const float inv = 1.f / lrun;
  bf16* op = QB + (size_t)(qrow0 + wave * 32 + r) * 1536 + hd * 192;
  if (dry) op = (bf16*)(ws + B_END) + ((((size_t)(qrow0 + wave * 32 + r) * 1536 + hd * 192)) & 0x3ffff8);
#pragma unroll
  for (int i = 0; i < 4; i++)
#pragma unroll
    for (int g = 0; g < 4; g++) {
      uint2 o;
      o.x = pack2(oacc[i][4 * g] * inv, oacc[i][4 * g + 1] * inv);
      o.y = pack2(oacc[i][4 * g + 2] * inv, oacc[i][4 * g + 3] * inv);
      *(uint2*)(op + 32 * i + 8 * g + 4 * hf) = o;
    }
}

DEV void phase_mixers(int tidv, int bidv, const Params& p, int l, char* smem, int dry) {
  int* s_item = (int*)(smem + SM_ITEM);
#ifdef PROBE_PARTS
  const int parts = dry ? PROBE_PARTS : 7;
#else
  const int parts = 7;
#endif
  for (int task = bidv; task < 192; task += gridDim.x) {
    if (task < 128 && !(parts & 1)) continue;
    if (task >= 128 && !(parts & 2)) continue;
    if (task < 128) rwkv_scan(tidv, bidv, p, l, task, smem, dry);
    else s5_scan(tidv, bidv, p, l, (task - 128) * 8 + (tidv >> 6), smem + (tidv >> 6) * 9472, dry);
  }
  const int nlat = 512, ntot = (parts & 4) ? ((l == 0) ? 544 : 512) : 0;
  int* cnt = (int*)(p.ws + B_CNT) + l + 2 * dry;
#if !defined(MIX_ONLY) || MIX_ONLY == 2
  while (true) {
    __syncthreads();
    if (tidv == 0) *s_item = atomicAdd(cnt, 1);
    __syncthreads();
    int item = *s_item;
    if (item >= ntot) break;
    if (item < nlat) attn_item(tidv, bidv, p, item, false, smem, dry);
    else attn_item(tidv, bidv, p, item - nlat, true, smem, dry);
  }
#endif
}

DEV float gelu_tanh(float x) {
  float u = 0.7978845608028654f * (x + 0.044715f * x * x * x);
  return 0.5f * x * (1.f + tanhf(u));
}

DEV void phase_post(int tidv, int bidv, const Params& p, int l, int M) {
  char* ws = p.ws;
  const bf16* Z = (const bf16*)(ws + B_ZB);
  const int wave = tidv >> 6, lane = tidv & 63;
  const float* cw = p.in[17] + (size_t)l * 3 * 3072;
  const bf16* YF = (const bf16*)(ws + B_HB);
  const bf16* YB = (const bf16*)(ws + B_HB + SZ1K);
  const bf16* AF = (const bf16*)(ws + B_AF);
  const bf16* AB = (const bf16*)(ws + B_AB);
  bf16* GB = (bf16*)(ws + B_GB);
  const int nitem = M * 16;
  for (int it = bidv * NW + wave; it < nitem; it += gridDim.x * NW) {
    int row = it >> 4, h = it & 15;
    int ch = h * 64 + lane;
    int tau, len;
    if (row < ML) { tau = row & 4095; len = 4096; } else { tau = (row - ML) & 255; len = 256; }
    size_t o = (size_t)row * 1024 + ch;
    float y = bf2f(YF[o]) + bf2f(YB[o]);
    float mu = wsum(y) * (1.f / 64.f);
    float dv = y - mu;
    float var = wsum(dv * dv) * (1.f / 64.f);
    float yn = dv * rsqrtf(var + 64e-5f) * p.in[26][l * 1024 + ch] + p.in[27][l * 1024 + ch];
    const bf16* z = Z + (size_t)row * NIN + C_R + ch;
    float r1 = bf2f(z[0]), k1 = bf2f(z[1024]), v1 = bf2f(z[2048]);
    float r0 = 0.f, k0 = 0.f, v0 = 0.f, r2 = 0.f, k2 = 0.f, v2 = 0.f;
    if (tau > 0) { const bf16* zm = z - NIN; r0 = bf2f(zm[0]); k0 = bf2f(zm[1024]); v0 = bf2f(zm[2048]); }
    if (tau < len - 1) { const bf16* zp = z + NIN; r2 = bf2f(zp[0]); k2 = bf2f(zp[1024]); v2 = bf2f(zp[2048]); }
    float rr = cw[ch] * r0 + cw[3072 + ch] * r1 + cw[6144 + ch] * r2;
    float kk = cw[1024 + ch] * k0 + cw[3072 + 1024 + ch] * k1 + cw[6144 + 1024 + ch] * k2;
    float vv = cw[2048 + ch] * v0 + cw[3072 + 2048 + ch] * v1 + cw[6144 + 2048 + ch] * v2;
    float am = 0.5f * (bf2f(AF[o]) + bf2f(AB[o]));
    float kbon = kk * (1.f + (am - 1.f) * p.in[24][l * 1024 + ch]);
    float s = wsum(rr * kbon * p.in[25][l * 1024 + ch]);
    float outv = (yn + s * vv) * bf2f(GB[o]);
    GB[o] = f2bf(outv);
  }
  bf16* SY = (bf16*)(ws + B_SY);
  const float* dsk = p.in[35] + l * 1024;
  const int n4 = M * 256;
  for (int i = bidv * NT + tidv; i < n4; i += gridDim.x * NT) {
    int row = i >> 8, c = (i & 255) * 4;
    uint2 a = *(const uint2*)(SY + (size_t)row * 1024 + c);
    uint2 bq = *(const uint2*)(Z + (size_t)row * NIN + c);
    uint2 u = *(const uint2*)(Z + (size_t)row * NIN + C_U + c);
    float4 dd = *(const float4*)(dsk + c);
    float y0 = bf2f((bf16)(a.x & 0xffff)) + bf2f((bf16)(bq.x & 0xffff)) + dd.x * bf2f((bf16)(u.x & 0xffff));
    float y1 = bf2f((bf16)(a.x >> 16)) + bf2f((bf16)(bq.x >> 16)) + dd.y * bf2f((bf16)(u.x >> 16));
    float y2 = bf2f((bf16)(a.y & 0xffff)) + bf2f((bf16)(bq.y & 0xffff)) + dd.z * bf2f((bf16)(u.y & 0xffff));
    float y3 = bf2f((bf16)(a.y >> 16)) + bf2f((bf16)(bq.y >> 16)) + dd.w * bf2f((bf16)(u.y >> 16));
    uint2 o;
    o.x = pack2(gelu_tanh(y0), gelu_tanh(y1));
    o.y = pack2(gelu_tanh(y2), gelu_tanh(y3));
    *(uint2*)(SY + (size_t)row * 1024 + c) = o;
  }
}

constexpr int NPH = 25;

DEV void run_phase(int tidv, int bidv, const Params& p, int ph, char* smem, int dry) {
  char* ws = p.ws;
#ifndef ONLY_S
  if (ph == 0) {
    if (bidv == 0 && tidv < 4) ((int*)(ws + B_CNT))[tidv] = 0;
    phase_mod(tidv, bidv, p, smem);
    phase_convw(tidv, bidv, p, 0, smem);
    return;
  }
#endif
  const int l = (ph - 1) / 12, s = (ph - 1) % 12;
#ifdef ONLY_S
  if (s != ONLY_S) return;
#endif
  const bf16* wb = (const bf16*)(ws + B_WB);
  const float* mod = (const float*)(ws + B_MOD) + (size_t)l * 5 * 12288;
  float* XC = (float*)(ws + B_XC);
  const float* xin_lat = l == 0 ? p.in[0] : p.out;
  const float* xin_ctx = l == 0 ? p.in[2] : XC;
  bf16* HB = (bf16*)(ws + B_HB);
  bf16* Z = (bf16*)(ws + B_ZB);
  bf16* H2 = (bf16*)(ws + B_KN);
  const int Mpost = l == 0 ? MT : ML;
  switch (s) {
    case 0:
      if (l == 1) phase_convw(tidv, bidv, p, 1, smem);
      phase_norm(tidv, bidv, xin_lat, xin_ctx, p.in[6] + l * 2048, mod, 0, 2048, HB, MT);
      break;
    case 1:
      run_gemm<G_IN>(tidv, bidv, p, l, smem, HB, 2048, wb + OW_IN, 2048, NIN, MT, 0, nullptr, nullptr, nullptr, nullptr);
      break;
    case 2:
#if !defined(PH2_ONLY) || PH2_ONLY == 0
      run_gemm<G_UKV>(tidv, bidv, p, l, smem, Z + C_CKV, NIN, wb + OW_UKV, 512, 2048, MT, 0, nullptr, nullptr, nullptr, nullptr);
#endif
#if !defined(PH2_ONLY) || PH2_ONLY == 1
      run_gemm<G_UQ>(tidv, bidv, p, l, smem, Z + C_CQ, NIN, wb + OW_UQ, 512, 1536, MT, 0, nullptr, nullptr, nullptr, nullptr);
#endif
#if !defined(PH2_ONLY) || PH2_ONLY == 2
      run_gemm<G_G2>(tidv, bidv, p, l, smem, Z + C_GD, NIN, wb + OW_G2, 192, 1024, MT, 0, nullptr, nullptr, nullptr, nullptr);
#endif
#if !defined(PH2_ONLY) || PH2_ONLY == 3
      for (int d = 0; d < 2; d++) {
        run_gemm<G_W2>(tidv, bidv, p, l, smem, Z + C_WD + 64 * d, NIN, wb + OW_W2 + (size_t)d * 65536, 64, 1024, MT, d, nullptr, nullptr, nullptr, nullptr);
        run_gemm<G_A2>(tidv, bidv, p, l, smem, Z + C_AD + 64 * d, NIN, wb + OW_A2 + (size_t)d * 65536, 64, 1024, MT, d, nullptr, nullptr, nullptr, nullptr);
      }
#endif
      break;
    case 3: phase_mla_post(tidv, bidv, p, l); break;
    case 4: phase_mixers(tidv, bidv, p, l, smem, dry); break;
    case 5: phase_post(tidv, bidv, p, l, Mpost); break;
    case 6:
      run_gemm<G_GLU>(tidv, bidv, p, l, smem, (const bf16*)(ws + B_SY), 1024, wb + OW_GLU, 1024, 1024, Mpost, 0, nullptr, nullptr, nullptr, nullptr);
      break;
    case 7:
      run_gemm<G_MG0>(tidv, bidv, p, l, smem, (const bf16*)(ws + B_QB), 1536, wb + OW_BR, 1024, 2048, Mpost, 0, nullptr, nullptr, nullptr, nullptr);
      run_gemm<G_MG1>(tidv, bidv, p, l, smem, (const bf16*)(ws + B_GB), 1024, wb + OW_BR + (size_t)2048 * 1024, 1024, 2048, Mpost, 0, nullptr, nullptr, nullptr, nullptr);
      run_gemm<G_MG2>(tidv, bidv, p, l, smem, Z, NIN, wb + OW_BR + (size_t)2 * 2048 * 1024, 1024, 2048, Mpost, 0, nullptr, nullptr, nullptr, nullptr);
      break;
    case 8:
      run_gemm<G_OUT>(tidv, bidv, p, l, smem, HB, 2048, wb + OW_OUT, 2048, 2048, Mpost, 0, xin_lat, xin_ctx, p.out, XC);
      break;
    case 9:
      phase_norm(tidv, bidv, p.out, XC, p.in[7] + l * 2048, mod, 6144, 8192, H2, Mpost);
      break;
    case 10:
      run_gemm<G_M1>(tidv, bidv, p, l, smem, H2, 2048, wb + OW_M1, 2048, 8192, Mpost, 0, nullptr, nullptr, nullptr, nullptr);
      break;
    case 11:
      run_gemm<G_M2>(tidv, bidv, p, l, smem, Z, 8192, wb + OW_M2, 8192, 2048, Mpost, 0, nullptr, nullptr, p.out, XC);
      break;
  }
}

__global__ void __launch_bounds__(NT) fwd_megakernel(Params p, int ph0, int ph1, int dryflag) {
  extern __shared__ __attribute__((aligned(16))) char smem[];
  for (int ph = ph0; ph < ph1; ph++) {
    int tidv = threadIdx.x, bidv = blockIdx.x;
    asm volatile("" : "+v"(tidv));
    asm volatile("" : "+s"(bidv));
#ifdef PROBE_MASK
    if (dryflag && ((ph == 0 && (PROBE_MASK & 0x1000)) || (ph > 0 && ((PROBE_MASK >> ((ph - 1) % 12)) & 1)))) {
      run_phase(tidv, bidv, p, ph, smem, dryflag);
      cg::this_grid().sync();
    }
#endif
    run_phase(tidv, bidv, p, ph, smem, 0);
    if (ph + 1 < ph1) cg::this_grid().sync();
  }
}

extern "C" void kernel_launch(void* const* d_in, const int* in_sizes, int n_in, void* d_out, int out_size, void* d_ws, size_t ws_size,
                              hipStream_t stream) {
  static int grid_blocks = 0;
  if (!grid_blocks) {
    int dev = 0, cus = 0, per_cu = 0;
    (void)hipGetDevice(&dev);
    (void)hipDeviceGetAttribute(&cus, hipDeviceAttributeMultiprocessorCount, dev);
    if (hipFuncSetAttribute((const void*)fwd_megakernel, hipFuncAttributeMaxDynamicSharedMemorySize, LDS_BYTES) != hipSuccess) {
      fprintf(stderr, "hipFuncSetAttribute(%d B dynamic LDS) failed\n", LDS_BYTES);
      return;
    }
    if (hipOccupancyMaxActiveBlocksPerMultiprocessor(&per_cu, (const void*)fwd_megakernel, NT, LDS_BYTES) != hipSuccess || per_cu < 1) {
      fprintf(stderr, "occupancy query failed / kernel not resident\n");
      return;
    }
    grid_blocks = cus;
  }
  Params p{};
  for (int i = 0; i < 42; i++) p.in[i] = (const float*)d_in[i];
  p.out = (float*)d_out;
  p.ws = (char*)d_ws;
  if (ws_size < B_END + (8u << 20)) { fprintf(stderr, "workspace too small\n"); return; }
  int ph0 = 0, ph1 = NPH;
  int dryflag = 1;
  void* args[] = {&p, &ph0, &ph1, &dryflag};
  hipError_t e = hipLaunchCooperativeKernel((void*)fwd_megakernel, dim3(grid_blocks), dim3(NT), args, LDS_BYTES, stream);
  if (e != hipSuccess) fprintf(stderr, "cooperative launch failed: %s (grid %d)\n", hipGetErrorString(e), grid_blocks);
}
```

```cpp
#include <hip/hip_runtime.h>
#include <hip/hip_cooperative_groups.h>
#include <stdint.h>
#include <cstdio>
namespace cg = cooperative_groups;

#ifndef MULTI_LAUNCH
#define MULTI_LAUNCH 0
#endif

typedef unsigned short bf16;
using bf16x8 = __attribute__((ext_vector_type(8))) short;
using f32x4 = __attribute__((ext_vector_type(4))) float;
using f32x16 = __attribute__((ext_vector_type(16))) float;

#define DEV __device__ __forceinline__
constexpr int NT = 512, NW = 8;

constexpr int DM = 2048, ML = 16384, MC = 1024, MT = 17408, NIN = 11744, DFF = 8192, NKEY = 4352;
constexpr int C_CQ = 0, C_CKV = 512, C_KR = 1024, C_R = 1088, C_WD = 4160, C_AD = 4288, C_GD = 4416, C_U = 4576, C_GATE = 5600;

constexpr size_t OW_IN = 0;
constexpr size_t OW_UQ = OW_IN + (size_t)NIN * 2048;
constexpr size_t OW_UKV = OW_UQ + 1536 * 512;
constexpr size_t OW_W2 = OW_UKV + 2048 * 512;
constexpr size_t OW_A2 = OW_W2 + 2 * 1024 * 64;
constexpr size_t OW_G2 = OW_A2 + 2 * 1024 * 64;
constexpr size_t OW_GLU = OW_G2 + 1024 * 192;
constexpr size_t OW_BR = OW_GLU + 1024 * 1024;
constexpr size_t OW_OUT = OW_BR + (size_t)3 * 2048 * 1024;
constexpr size_t OW_M1 = OW_OUT + (size_t)2048 * 2048;
constexpr size_t OW_M2 = OW_M1 + (size_t)8192 * 2048;
constexpr size_t OW_END = OW_M2 + (size_t)8192 * 2048;

constexpr size_t SZ1K = (size_t)MT * 1024 * 2;
constexpr size_t B_WB = 0;
constexpr size_t B_HB = B_WB + OW_END * 2;
constexpr size_t B_ZB = B_HB + (size_t)MT * 2048 * 2;
constexpr size_t B_QB = B_ZB + (size_t)MT * NIN * 2;
constexpr size_t B_KN = B_QB + (size_t)MT * 1536 * 2;
constexpr size_t B_VT = B_KN + SZ1K;
constexpr size_t B_KR = B_VT + SZ1K;
constexpr size_t B_AF = B_KR + (size_t)MT * 64 * 2;
constexpr size_t B_AB = B_AF + SZ1K;
constexpr size_t B_GB = B_AB + SZ1K;
constexpr size_t B_SY = B_GB + SZ1K;
constexpr size_t B_XC = B_SY + SZ1K;
constexpr size_t B_MOD = B_XC + (size_t)MC * 2048 * 4;
constexpr size_t B_CNT = B_MOD + (size_t)2 * 5 * 12288 * 4;
constexpr size_t B_FLG = B_CNT + 256;
constexpr size_t B_END = B_FLG + 4096;

struct Params {
  const float* in[42];
  float* out;
  char* ws;
};

typedef __attribute__((ext_vector_type(2))) __bf16 hbf2;
DEV bf16 f2bf(float f) {
  __bf16 h = (__bf16)f;
  return *(unsigned short*)&h;
}
DEV float bf2f(bf16 h) { return __uint_as_float(((uint32_t)h) << 16); }
DEV uint32_t pack2(float a, float b) {
  hbf2 v;
  v[0] = (__bf16)a;
  v[1] = (__bf16)b;
  return *(uint32_t*)&v;
}
DEV float wsum(float v) {
#pragma unroll
  for (int o = 32; o > 0; o >>= 1) v += __shfl_xor(v, o);
  return v;
}
DEV float dpp_xor1(float v) {
  int i = __float_as_int(v);
  return __int_as_float(__builtin_amdgcn_update_dpp(0, i, 0xB1, 0xF, 0xF, true));
}
DEV float dpp_xor2(float v) {
  int i = __float_as_int(v);
  return __int_as_float(__builtin_amdgcn_update_dpp(0, i, 0x4E, 0xF, 0xF, true));
}
DEV float dpp_rmirror(float v) {
  int i = __float_as_int(v);
  return __int_as_float(__builtin_amdgcn_update_dpp(0, i, 0x140, 0xF, 0xF, true));
}
DEV float dpp_hmirror0(float v) {
  int i = __float_as_int(v);
  return __int_as_float(__builtin_amdgcn_update_dpp(0, i, 0x141, 0xF, 0xF, true));
}
DEV float wsum_fast(float v) {
  v += dpp_xor1(v);
  v += dpp_xor2(v);
  v += dpp_hmirror0(v);
  v += dpp_rmirror(v);
  v += __shfl_xor(v, 16);
  v += __shfl_xor(v, 32);
  return v;
}
DEV float sigmoidf_(float x) { return __builtin_amdgcn_rcpf(1.f + __expf(-x)); }

DEV void phase_mod(int tidv, int bidv, const Params& p, char* smem) {
  float* s_in = (float*)smem;
  float* red = s_in + 5 * 2048;
  float* mod = (float*)(p.ws + B_MOD);
  for (int i = tidv; i < 5 * 2048; i += NT) {
    int r = i >> 11, k = i & 2047;
    float v = r < 4 ? p.in[1][r * 2048 + k] : p.in[3][k];
    s_in[i] = v / (1.f + expf(-v));
  }
  __syncthreads();
  int kg = tidv >> 6, c = tidv & 63;
  for (int task = bidv; task < 2 * 192; task += gridDim.x) {
    int l = task / 192, n = (task % 192) * 64 + c;
    const float* w = p.in[4] + (size_t)l * 2048 * 12288 + n;
    float a0 = 0, a1 = 0, a2 = 0, a3 = 0, a4 = 0;
    int kb = kg * 256;
#pragma unroll 8
    for (int k = 0; k < 256; k++) {
      float wv = w[(size_t)(kb + k) * 12288];
      a0 += s_in[kb + k] * wv;
      a1 += s_in[2048 + kb + k] * wv;
      a2 += s_in[4096 + kb + k] * wv;
      a3 += s_in[6144 + kb + k] * wv;
      a4 += s_in[8192 + kb + k] * wv;
    }
    red[(kg * 5 + 0) * 64 + c] = a0;
    red[(kg * 5 + 1) * 64 + c] = a1;
    red[(kg * 5 + 2) * 64 + c] = a2;
    red[(kg * 5 + 3) * 64 + c] = a3;
    red[(kg * 5 + 4) * 64 + c] = a4;
    __syncthreads();
    if (kg == 0) {
      float bias = p.in[5][l * 12288 + n];
#pragma unroll
      for (int r = 0; r < 5; r++) {
        float v = 0.f;
#pragma unroll
        for (int g = 0; g < 8; g++) v += red[(g * 5 + r) * 64 + c];
        mod[(size_t)(l * 5 + r) * 12288 + n] = v + bias;
      }
    }
    __syncthreads();
  }
}

DEV void convT(int tidv, int bidv, const float* __restrict__ src, bf16* __restrict__ dst, int K, int N, const float* __restrict__ gain, char* smem, int dK = 0) {
  if (dK == 0) dK = K;
  float* t = (float*)smem;
  int tk = (K + 63) >> 6, tn = (N + 63) >> 6;
  for (int tile = bidv; tile < tk * tn; tile += gridDim.x) {
    int k0 = (tile / tn) * 64, n0 = (tile % tn) * 64;
    __syncthreads();
#pragma unroll 4
    for (int i = 0; i < 8; i++) {
      int kk = i * 8 + (tidv >> 6), nn = tidv & 63;
      float v = 0.f;
      if (k0 + kk < K && n0 + nn < N) {
        v = src[(size_t)(k0 + kk) * N + n0 + nn];
        if (gain) v *= gain[k0 + kk];
      }
      t[kk * 65 + nn] = v;
    }
    __syncthreads();
    {
      int c = tidv;
      int nn = c >> 3, kc = c & 7;
      if (n0 + nn < N && k0 + kc * 8 < dK) {
        uint4 o;
        o.x = pack2(t[(kc * 8 + 0) * 65 + nn], t[(kc * 8 + 1) * 65 + nn]);
        o.y = pack2(t[(kc * 8 + 2) * 65 + nn], t[(kc * 8 + 3) * 65 + nn]);
        o.z = pack2(t[(kc * 8 + 4) * 65 + nn], t[(kc * 8 + 5) * 65 + nn]);
        o.w = pack2(t[(kc * 8 + 6) * 65 + nn], t[(kc * 8 + 7) * 65 + nn]);
        *(uint4*)(dst + (size_t)(n0 + nn) * dK + k0 + kc * 8) = o;
      }
    }
  }
}

DEV void phase_convw(int tidv, int bidv, const Params& p, int l, char* smem) {
  bf16* wb = (bf16*)(p.ws + B_WB);
  convT(tidv, bidv, p.in[8] + (size_t)l * 2048 * NIN, wb + OW_IN, 2048, NIN, nullptr, smem);
  convT(tidv, bidv, p.in[40] + (size_t)l * 2048 * 8192, wb + OW_M1, 2048, 8192, nullptr, smem);
  convT(tidv, bidv, p.in[41] + (size_t)l * 8192 * 2048, wb + OW_M2, 8192, 2048, nullptr, smem);
  for (int n = 0; n < 3; n++)
    convT(tidv, bidv, p.in[38] + (size_t)(l * 3 + n) * 1024 * 2048, wb + OW_BR + (size_t)n * 2048 * 1024, 1024, 2048, nullptr, smem);
  convT(tidv, bidv, p.in[39] + (size_t)l * 2048 * 2048, wb + OW_OUT, 2048, 2048, nullptr, smem);
  convT(tidv, bidv, p.in[11] + (size_t)l * 512 * 1536, wb + OW_UQ, 512, 1536, p.in[9] + l * 512, smem);
  convT(tidv, bidv, p.in[12] + (size_t)l * 512 * 2048, wb + OW_UKV, 512, 2048, p.in[10] + l * 512, smem);
  convT(tidv, bidv, p.in[36] + (size_t)l * 1024 * 1024, wb + OW_GLU, 1024, 1024, nullptr, smem);
  for (int d = 0; d < 2; d++) {
    convT(tidv, bidv, p.in[19] + (size_t)(l * 2 + d) * 64 * 1024, wb + OW_W2 + (size_t)d * 65536, 64, 1024, nullptr, smem);
    convT(tidv, bidv, p.in[21] + (size_t)(l * 2 + d) * 64 * 1024, wb + OW_A2 + (size_t)d * 65536, 64, 1024, nullptr, smem);
  }
  convT(tidv, bidv, p.in[22] + (size_t)l * 160 * 1024, wb + OW_G2, 160, 1024, nullptr, smem, 192);
}

DEV void phase_norm(int tidv, int bidv, const float* xlat, const float* xctx, const float* g, const float* mod, int shOff, int scOff, bf16* H, int nrows) {
  int wave = tidv >> 6, lane = tidv & 63;
  for (int row = bidv * NW + wave; row < nrows; row += gridDim.x * NW) {
    const float* x = row < ML ? xlat + (size_t)row * 2048 : xctx + (size_t)(row - ML) * 2048;
    int b = row < ML ? (row >> 12) : 4;
    const float* sh = mod + b * 12288 + shOff;
    const float* sc = mod + b * 12288 + scOff;
    float4 v[8];
    float ss = 0.f;
#pragma unroll
    for (int i = 0; i < 8; i++) {
      v[i] = *(const float4*)(x + i * 256 + lane * 4);
      ss += v[i].x * v[i].x + v[i].y * v[i].y + v[i].z * v[i].z + v[i].w * v[i].w;
    }
    ss = wsum(ss);
    float rinv = rsqrtf(ss * (1.f / 2048.f) + 1e-6f);
#pragma unroll
    for (int i = 0; i < 8; i++) {
      int c = i * 256 + lane * 4;
      float4 g4 = *(const float4*)(g + c), s4 = *(const float4*)(sc + c), h4 = *(const float4*)(sh + c);
      float y0 = v[i].x * rinv * g4.x * (1.f + s4.x) + h4.x;
      float y1 = v[i].y * rinv * g4.y * (1.f + s4.y) + h4.y;
      float y2 = v[i].z * rinv * g4.z * (1.f + s4.z) + h4.z;
      float y3 = v[i].w * rinv * g4.w * (1.f + s4.w) + h4.w;
      uint2 o;
      o.x = pack2(y0, y1);
      o.y = pack2(y2, y3);
      *(uint2*)(H + (size_t)row * 2048 + c) = o;
    }
  }
}

constexpr int LDT = 72;
constexpr int GA_BYTES = 256 * LDT * 2;
constexpr int GSTAGE = 512 * LDT * 2;
constexpr int SM_RINV = 2 * GSTAGE;
constexpr int SM_ITEM = SM_RINV + 1024;
constexpr int LDS_BYTES = SM_ITEM + 16;
DEV float sumsq8(uint4 r) {
  float s = 0.f, x;
  x = bf2f((bf16)(r.x & 0xffff)); s += x * x; x = bf2f((bf16)(r.x >> 16)); s += x * x;
  x = bf2f((bf16)(r.y & 0xffff)); s += x * x; x = bf2f((bf16)(r.y >> 16)); s += x * x;
  x = bf2f((bf16)(r.z & 0xffff)); s += x * x; x = bf2f((bf16)(r.z >> 16)); s += x * x;
  x = bf2f((bf16)(r.w & 0xffff)); s += x * x; x = bf2f((bf16)(r.w >> 16)); s += x * x;
  return s;
}

template <bool ROWNORM>
DEV void gemm_mainloop(int tidv, int bidv, const bf16* __restrict__ A, int lda, bool amap, const bf16* __restrict__ Bt, int K, int N, int m0, int n0,
                       char* smem, f32x16 (&acc)[4][2]) {
  float* srinv = (float*)(smem + SM_RINV);
  const int tid = tidv, lane = tid & 63, wave = tid >> 6;
  const int wm = wave >> 2, wn = wave & 3;
  const int lr = tid >> 3, kc = tid & 7;
  const char* abase = (const char*)(A + (size_t)m0 * lda);
  const char* bbase = (const char*)(Bt + (size_t)n0 * K);
  const uint32_t voa = (uint32_t)(lr * lda + kc * 8) * 2u;
  const uint32_t astep = (uint32_t)(64 * lda) * 2u;
  const uint32_t vob0 = (uint32_t)(lr * K + kc * 8) * 2u;
  const uint32_t bstep = (uint32_t)(64 * K) * 2u;
  const uint32_t lds_st = (uint32_t)(lr * LDT + kc * 8) * 2u;
  const int nk = K >> 6;
  uint4 xa0, xa1, xa2, xa3, xb0, xb1, xb2, xb3;
#define G_LOAD(KT)                                                         \
  {                                                                        \
    const int k0_ = (KT) << 6;                                             \
    const int ka_ = amap ? ((k0_ >> 7) * 192 + (k0_ & 127)) : k0_;         \
    xa0 = *(const uint4*)(abase + (size_t)ka_ * 2 + voa);                  \
    xa1 = *(const uint4*)(abase + (size_t)ka_ * 2 + astep + voa);          \
    xa2 = *(const uint4*)(abase + (size_t)ka_ * 2 + 2 * astep + voa);      \
    xa3 = *(const uint4*)(abase + (size_t)ka_ * 2 + 3 * astep + voa);      \
    xb0 = *(const uint4*)(bbase + (size_t)k0_ * 2 + vob0);                 \
    xb1 = *(const uint4*)(bbase + (size_t)k0_ * 2 + bstep + vob0);         \
    xb2 = *(const uint4*)(bbase + (size_t)k0_ * 2 + 2 * bstep + vob0);     \
    xb3 = *(const uint4*)(bbase + (size_t)k0_ * 2 + 3 * bstep + vob0);     \
  }
#define G_STORE(SN)                                                  \
  *(uint4*)((SN) + lds_st) = xa0;                                    \
  *(uint4*)((SN) + 1 * (64 * LDT * 2) + lds_st) = xa1;               \
  *(uint4*)((SN) + 2 * (64 * LDT * 2) + lds_st) = xa2;               \
  *(uint4*)((SN) + 3 * (64 * LDT * 2) + lds_st) = xa3;               \
  *(uint4*)((SN) + GA_BYTES + lds_st) = xb0;                         \
  *(uint4*)((SN) + GA_BYTES + 1 * (64 * LDT * 2) + lds_st) = xb1;    \
  *(uint4*)((SN) + GA_BYTES + 2 * (64 * LDT * 2) + lds_st) = xb2;    \
  *(uint4*)((SN) + GA_BYTES + 3 * (64 * LDT * 2) + lds_st) = xb3;
  const uint32_t fa = (uint32_t)((wm * 128 + (lane & 31)) * LDT + (lane >> 5) * 8) * 2u;
  const uint32_t fb = (uint32_t)GA_BYTES + (uint32_t)((wn * 64 + (lane & 31)) * LDT + (lane >> 5) * 8) * 2u;
  const int nkm = nk - 1;
  if (ROWNORM) {
    __syncthreads();
#pragma unroll 1
    for (int i = 0; i < 4; i++) {
      float ss = 0.f;
      for (int kk = 0; kk < nk; kk++) ss += sumsq8(*(const uint4*)(abase + (size_t)kk * 128 + i * astep + voa));
      ss += __shfl_xor(ss, 1); ss += __shfl_xor(ss, 2); ss += __shfl_xor(ss, 4);
      if (kc == 0) srinv[lr + 64 * i] = rsqrtf(ss / (float)K + 1e-6f);
    }
  }
  G_LOAD(0)
  __syncthreads();
  G_STORE(smem)
  G_LOAD((1 < nkm ? 1 : nkm))
  __syncthreads();
#define G_FRAG(P, ST, KS)                                                            \
  P##a0 = *(const bf16x8*)((ST) + fa + 0 * (32 * LDT * 2) + (KS) * 32);                \
  P##a1 = *(const bf16x8*)((ST) + fa + 1 * (32 * LDT * 2) + (KS) * 32);                \
  P##a2 = *(const bf16x8*)((ST) + fa + 2 * (32 * LDT * 2) + (KS) * 32);                \
  P##a3 = *(const bf16x8*)((ST) + fa + 3 * (32 * LDT * 2) + (KS) * 32);                \
  P##b0 = *(const bf16x8*)((ST) + fb + 0 * (32 * LDT * 2) + (KS) * 32);                \
  P##b1 = *(const bf16x8*)((ST) + fb + 1 * (32 * LDT * 2) + (KS) * 32);
#define G_MMA(P)                                                                              \
  acc[0][0] = __builtin_amdgcn_mfma_f32_32x32x16_bf16(P##b0, P##a0, acc[0][0], 0, 0, 0);      \
  acc[0][1] = __builtin_amdgcn_mfma_f32_32x32x16_bf16(P##b1, P##a0, acc[0][1], 0, 0, 0);      \
  acc[1][0] = __builtin_amdgcn_mfma_f32_32x32x16_bf16(P##b0, P##a1, acc[1][0], 0, 0, 0);      \
  acc[1][1] = __builtin_amdgcn_mfma_f32_32x32x16_bf16(P##b1, P##a1, acc[1][1], 0, 0, 0);      \
  acc[2][0] = __builtin_amdgcn_mfma_f32_32x32x16_bf16(P##b0, P##a2, acc[2][0], 0, 0, 0);      \
  acc[2][1] = __builtin_amdgcn_mfma_f32_32x32x16_bf16(P##b1, P##a2, acc[2][1], 0, 0, 0);      \
  acc[3][0] = __builtin_amdgcn_mfma_f32_32x32x16_bf16(P##b0, P##a3, acc[3][0], 0, 0, 0);      \
  acc[3][1] = __builtin_amdgcn_mfma_f32_32x32x16_bf16(P##b1, P##a3, acc[3][1], 0, 0, 0);
  bf16x8 pa0, pa1, pa2, pa3, pb0, pb1, qa0, qa1, qa2, qa3, qb0, qb1;
#pragma unroll 1
  for (int kt = 0; kt < nk; kt++) {
    const char* st = smem + (kt & 1) * GSTAGE;
    char* sn = smem + ((kt + 1) & 1) * GSTAGE;
    if (!ROWNORM) {
      G_FRAG(p, st, 0)
      G_FRAG(q, st, 1)
      __builtin_amdgcn_sched_barrier(0);
      G_MMA(p)
      __builtin_amdgcn_sched_barrier(0);
      G_FRAG(p, st, 2)
      __builtin_amdgcn_sched_barrier(0);
      G_MMA(q)
      __builtin_amdgcn_sched_barrier(0);
      G_FRAG(q, st, 3)
      if (kt + 1 < nk) { G_STORE(sn) }
      G_LOAD((kt + 2 < nkm ? kt + 2 : nkm))
      __builtin_amdgcn_sched_barrier(0);
      G_MMA(p)
      __builtin_amdgcn_sched_barrier(0);
      G_MMA(q)
    } else {
      G_FRAG(p, st, 0)
      __builtin_amdgcn_sched_barrier(0);
      G_MMA(p)
      __builtin_amdgcn_sched_barrier(0);
      G_FRAG(p, st, 1)
      __builtin_amdgcn_sched_barrier(0);
      G_MMA(p)
      __builtin_amdgcn_sched_barrier(0);
      G_FRAG(p, st, 2)
      if (kt + 1 < nk) { G_STORE(sn) }
      G_LOAD((kt + 2 < nkm ? kt + 2 : nkm))
      __builtin_amdgcn_sched_barrier(0);
      G_MMA(p)
      __builtin_amdgcn_sched_barrier(0);
      G_FRAG(p, st, 3)
      __builtin_amdgcn_sched_barrier(0);
      G_MMA(p)
    }
    __syncthreads();
  }
#undef G_FRAG
#undef G_MMA
#undef G_LOAD
#undef G_STORE
}

DEV void zero_acc(f32x16 (&acc)[4][2]) {
#pragma unroll
  for (int i = 0; i < 4; i++)
#pragma unroll
    for (int j = 0; j < 2; j++)
#pragma unroll
      for (int e = 0; e < 16; e++) acc[i][j][e] = 0.f;
}

template <class F>
DEV void epi_loop(int tidv, int bidv, f32x16 (&acc)[4][2], int m0, int n0, int N, F f) {
  const int lane = tidv & 63, wave = tidv >> 6;
  const int wm = wave >> 2, wn = wave & 3;
#pragma unroll
  for (int i = 0; i < 4; i++) {
    const int lrow = wm * 128 + i * 32 + (lane & 31);
#pragma unroll
    for (int j = 0; j < 2; j++) {
#pragma unroll
      for (int g = 0; g < 4; g++) {
        int col = n0 + wn * 64 + j * 32 + 8 * g + 4 * (lane >> 5);
        f32x4 v = {acc[i][j][4 * g], acc[i][j][4 * g + 1], acc[i][j][4 * g + 2], acc[i][j][4 * g + 3]};
        if (col < N) f(m0 + lrow, lrow, col, v);
      }
    }
    __builtin_amdgcn_sched_barrier(0);
  }
}

DEV uint2 pack4(f32x4 v) {
  uint2 o;
  o.x = pack2(v[0], v[1]);
  o.y = pack2(v[2], v[3]);
  return o;
}
DEV f32x4 unpack4(uint2 u) {
  f32x4 v;
  v[0] = bf2f((bf16)(u.x & 0xffff)); v[1] = bf2f((bf16)(u.x >> 16));
  v[2] = bf2f((bf16)(u.y & 0xffff)); v[3] = bf2f((bf16)(u.y >> 16));
  return v;
}

enum { G_IN = 0, G_UQ, G_UKV, G_W2, G_A2, G_G2, G_GLU, G_OUT, G_M1, G_M2, G_MG0, G_MG1, G_MG2 };

template <int MODE>
DEV void run_gemm(int tidv, int bidv, const Params& p, int l, char* smem, const bf16* A, int lda, const bf16* Bt, int K, int N, int M, int aux,
                  const float* xin_lat, const float* xin_ctx, float* xout_lat, float* xout_ctx) {
  const int nt = (N + 255) >> 8, mt = M >> 8;
  char* ws = p.ws;
  bf16* Z = (bf16*)(ws + B_ZB);
  const float* srinv = (const float*)(smem + SM_RINV);
  const float* mod = (const float*)(ws + B_MOD) + (size_t)l * 5 * 12288;
  for (int tile = bidv; tile < nt * mt; tile += gridDim.x) {
    int m0 = (tile / nt) << 8, n0 = (tile % nt) << 8;
    f32x16 acc[4][2];
    zero_acc(acc);
    gemm_mainloop<(MODE == G_UQ || MODE == G_UKV)>(tidv, bidv, A, lda, MODE == G_MG0, Bt, K, N, m0, n0, smem, acc);
    if constexpr (MODE != G_OUT && MODE != G_M2)
    epi_loop(tidv, bidv, acc, m0, n0, N, [&](int row, int lrow, int col, f32x4 v) {
      if constexpr (MODE == G_IN) {
        f32x4 o = v;
        if (col >= C_GATE || (col >= C_GD && col < C_U)) {
#pragma unroll
          for (int r = 0; r < 4; r++) o[r] = sigmoidf_(v[r]);
        } else if (col >= C_WD && col < C_AD) {
#pragma unroll
          for (int r = 0; r < 4; r++) o[r] = tanhf(v[r]);
        }
        *(uint2*)(smem + ((size_t)lrow * 264 + (col - n0)) * 2) = pack4(o);
      } else if constexpr (MODE == G_UQ) {
        float ri = srinv[lrow];
        *(uint2*)((bf16*)(ws + B_QB) + (size_t)row * 1536 + col) = pack4(v * ri);
      } else if constexpr (MODE == G_UKV) {
        float ri = srinv[lrow];
        f32x4 o = v * ri;
        int h = col >> 8, c = col & 255;
        if (c < 128) {
          *(uint2*)((bf16*)(ws + B_KN) + (size_t)row * 1024 + h * 128 + c) = pack4(o);
        } else {
          int b, kp;
          if (row < ML) { b = row >> 12; kp = row & 4095; } else { int r2 = row - ML; b = r2 >> 8; kp = 4096 + (r2 & 255); }
          bf16* vt = (bf16*)(ws + B_VT) + ((size_t)((b * 8 + h) * 128 + (c - 128))) * NKEY + kp;
#pragma unroll
          for (int r = 0; r < 4; r++) vt[(size_t)r * NKEY] = f2bf(o[r]);
        }
      } else if constexpr (MODE == G_W2) {
        float4 w0 = *(const float4*)(p.in[18] + (l * 2 + aux) * 1024 + col);
        f32x4 o;
        o[0] = 0.60653066f * sigmoidf_(w0.x + v[0]);
        o[1] = 0.60653066f * sigmoidf_(w0.y + v[1]);
        o[2] = 0.60653066f * sigmoidf_(w0.z + v[2]);
        o[3] = 0.60653066f * sigmoidf_(w0.w + v[3]);
        *(uint2*)((bf16*)(ws + B_HB + (size_t)aux * SZ1K) + (size_t)row * 1024 + col) = pack4(o);
      } else if constexpr (MODE == G_A2) {
        float4 a0 = *(const float4*)(p.in[20] + (l * 2 + aux) * 1024 + col);
        f32x4 o;
        o[0] = sigmoidf_(a0.x + v[0]);
        o[1] = sigmoidf_(a0.y + v[1]);
        o[2] = sigmoidf_(a0.z + v[2]);
        o[3] = sigmoidf_(a0.w + v[3]);
        *(uint2*)((bf16*)(ws + (aux ? B_AB : B_AF)) + (size_t)row * 1024 + col) = pack4(o);
      } else if constexpr (MODE == G_G2) {
        *(uint2*)((bf16*)(ws + B_GB) + (size_t)row * 1024 + col) = pack4(v);
      } else if constexpr (MODE == G_GLU) {
        f32x4 zz = unpack4(*(const uint2*)((const bf16*)(ws + B_SY) + (size_t)row * 1024 + col));
        float4 gb = *(const float4*)(p.in[37] + l * 1024 + col);
        f32x4 o;
        o[0] = zz[0] * sigmoidf_(v[0] + gb.x);
        o[1] = zz[1] * sigmoidf_(v[1] + gb.y);
        o[2] = zz[2] * sigmoidf_(v[2] + gb.z);
        o[3] = zz[3] * sigmoidf_(v[3] + gb.w);
        *(uint2*)(smem + ((size_t)lrow * 264 + (col - n0)) * 2) = pack4(o);
      } else if constexpr (MODE == G_OUT || MODE == G_M2) {
      } else if constexpr (MODE == G_M1) {
        f32x4 o;
#pragma unroll
        for (int r = 0; r < 4; r++) { float t = fmaxf(v[r], 0.f); o[r] = t * t; }
        *(uint2*)(smem + ((size_t)lrow * 264 + (col - n0)) * 2) = pack4(o);
      } else if constexpr (MODE == G_MG0 || MODE == G_MG1 || MODE == G_MG2) {
        *(uint2*)(smem + ((size_t)lrow * 264 + (col - n0)) * 2) = pack4(v);
      }
    });
    if constexpr (MODE == G_OUT || MODE == G_M2) {
      float* tilef = (float*)smem;
      constexpr int GOFF = (MODE == G_OUT) ? 4096 : 10240;
      const int wn_ = (tidv >> 6) & 3;
#pragma unroll 1
      for (int half = 0; half < 2; half++) {
        if ((wn_ >> 1) == half) {
          epi_loop(tidv, bidv, acc, m0, n0, N, [&](int row, int lrow, int col, f32x4 v) {
            *(f32x4*)(tilef + (size_t)lrow * 132 + (col - n0 - half * 128)) = v;
          });
        }
        __syncthreads();
#pragma unroll 2
        for (int it = 0; it < 16; it++) {
          int c = it * NT + tidv;
          int r = c >> 5, ch = c & 31;
          int row = m0 + r, col = n0 + half * 128 + ch * 4;
          int b = row < ML ? (row >> 12) : 4;
          float4 g = *(const float4*)(mod + b * 12288 + GOFF + col);
          const float* xi;
          if constexpr (MODE == G_OUT) xi = row < ML ? xin_lat + (size_t)row * 2048 : xin_ctx + (size_t)(row - ML) * 2048;
          else xi = row < ML ? xout_lat + (size_t)row * 2048 : xout_ctx + (size_t)(row - ML) * 2048;
          float* xo = row < ML ? xout_lat + (size_t)row * 2048 : xout_ctx + (size_t)(row - ML) * 2048;
          float4 x = *(const float4*)(xi + col);
          f32x4 v = *(const f32x4*)(tilef + (size_t)r * 132 + ch * 4);
          x.x += g.x * v[0]; x.y += g.y * v[1]; x.z += g.z * v[2]; x.w += g.w * v[3];
          *(float4*)(xo + col) = x;
        }
        __syncthreads();
      }
    }
    if constexpr (MODE == G_MG0 || MODE == G_MG1 || MODE == G_MG2) {
      constexpr int nb = MODE - G_MG0;
      bf16* MG = (bf16*)(ws + B_HB);
      __syncthreads();
#pragma unroll 2
      for (int it = 0; it < 16; it++) {
        int c = it * NT + tidv;
        int r = c >> 5, ch = c & 31;
        int col = n0 + ch * 8;
        uint4 pv = *(const uint4*)(smem + ((size_t)r * 264 + ch * 8) * 2);
        uint4 gv = *(const uint4*)(Z + (size_t)(m0 + r) * NIN + C_GATE + nb * 2048 + col);
        f32x4 p0 = unpack4(uint2{pv.x, pv.y}), p1 = unpack4(uint2{pv.z, pv.w});
        f32x4 g0 = unpack4(uint2{gv.x, gv.y}), g1 = unpack4(uint2{gv.z, gv.w});
        f32x4 o0 = g0 * p0, o1 = g1 * p1;
        if constexpr (nb > 0) {
          uint4 qv = *(const uint4*)(MG + (size_t)(m0 + r) * 2048 + col);
          o0 += unpack4(uint2{qv.x, qv.y});
          o1 += unpack4(uint2{qv.z, qv.w});
        }
        uint2 a = pack4(o0), b = pack4(o1);
        *(uint4*)(MG + (size_t)(m0 + r) * 2048 + col) = uint4{a.x, a.y, b.x, b.y};
      }
    }
    if constexpr (MODE == G_IN || MODE == G_GLU || MODE == G_M1) {
      bf16* dst;
      int ld;
      if constexpr (MODE == G_IN || MODE == G_GLU) { dst = Z; ld = NIN; }
      else { dst = Z; ld = DFF; }
      __syncthreads();
#pragma unroll 4
      for (int it = 0; it < 16; it++) {
        int c = it * NT + tidv;
        int r = c >> 5, ch = c & 31;
        int col = n0 + ch * 8;
        if (col < N) *(uint4*)(dst + (size_t)(m0 + r) * ld + col) = *(const uint4*)(smem + ((size_t)r * 264 + ch * 8) * 2);
      }
    }
  }
}

DEV void phase_mla_post(int tidv, int bidv, const Params& p, int l) {
  char* ws = p.ws;
  const float* qng = p.in[13] + l * 128;
  const float* qrg = p.in[14] + l * 64;
  const float* kng = p.in[15] + l * 128;
  const float* krg = p.in[16] + l * 64;
  bf16* QB = (bf16*)(ws + B_QB);
  bf16* KN = (bf16*)(ws + B_KN);
  bf16* KR = (bf16*)(ws + B_KR);
  const bf16* Z = (const bf16*)(ws + B_ZB);
  const int wave = tidv >> 6, lane = tidv & 63;
  const float QS = 1.4426950408889634f * 0.07216878364870322f;
  const int idx = lane & 31;
  const float inv = powf(10000.f, -(float)(idx & 15) / 16.f);
  const float gq0 = qng[2 * lane], gq1 = qng[2 * lane + 1], gk0 = kng[2 * lane], gk1 = kng[2 * lane + 1];
  const float gqr = qrg[lane], gkr = krg[lane];
  for (int row = bidv * NW + wave; row < MT; row += gridDim.x * NW) {
    bool lat = row < ML;
    int t = row & 4095;
    float pos = (idx < 16) ? (float)(t >> 6) : (float)(t & 63);
    float ang = pos * inv;
    float cs = 1.f, sn = 0.f;
    if (lat) { cs = cosf(ang); sn = sinf(ang); }
#pragma unroll 1
    for (int h = 0; h < 8; h++) {
      bf16* q = QB + (size_t)row * 1536 + h * 192;
      uint32_t u = *(const uint32_t*)(q + 2 * lane);
      float x0 = bf2f((bf16)(u & 0xffff)), x1 = bf2f((bf16)(u >> 16));
      float ss = wsum(x0 * x0 + x1 * x1);
      float rinv = rsqrtf(ss * (1.f / 128.f) + 1e-6f) * QS;
      *(uint32_t*)(q + 2 * lane) = pack2(x0 * rinv * gq0, x1 * rinv * gq1);
      float xr = bf2f(q[128 + lane]);
      float ss2 = wsum(xr * xr);
      float y = xr * rsqrtf(ss2 * (1.f / 64.f) + 1e-6f) * gqr;
      float yp = __shfl_xor(y, 32);
      float o = lane < 32 ? (y * cs - yp * sn) : (yp * sn + y * cs);
      q[128 + lane] = f2bf(o * QS);
      bf16* k = KN + (size_t)row * 1024 + h * 128;
      uint32_t uk = *(const uint32_t*)(k + 2 * lane);
      float k0 = bf2f((bf16)(uk & 0xffff)), k1 = bf2f((bf16)(uk >> 16));
      float ssk = wsum(k0 * k0 + k1 * k1);
      float rk = rsqrtf(ssk * (1.f / 128.f) + 1e-6f);
      *(uint32_t*)(k + 2 * lane) = pack2(k0 * rk * gk0, k1 * rk * gk1);
    }
    {
      float xr = bf2f(Z[(size_t)row * NIN + C_KR + lane]);
      float ss2 = wsum(xr * xr);
      float y = xr * rsqrtf(ss2 * (1.f / 64.f) + 1e-6f) * gkr;
      float yp = __shfl_xor(y, 32);
      float o = lane < 32 ? (y * cs - yp * sn) : (yp * sn + y * cs);
      KR[(size_t)row * 64 + lane] = f2bf(o);
    }
  }
}

DEV void step_row(int s, int d, int b, int& row, int& tau, int& len) {
  if (s < 256) { tau = d ? 255 - s : s; len = 256; row = ML + b * 256 + tau; }
  else { int q = s - 256; tau = d ? 4095 - q : q; len = 4096; row = b * 4096 + tau; }
}

struct RwPre { bf16 r0, r1, r2, k0, k1, k2, v0, v1, v2, a, e; };

DEV void rwkv_fetch(RwPre& q, const bf16* Z, const bf16* AD, const bf16* ED, int s, int d, int b, int ch) {
  int row, tau, len;
  step_row(s, d, b, row, tau, len);
  const bf16* z = Z + (size_t)row * NIN + C_R + ch;
  q.r1 = z[0]; q.k1 = z[1024]; q.v1 = z[2048];
  q.r0 = 0; q.k0 = 0; q.v0 = 0; q.r2 = 0; q.k2 = 0; q.v2 = 0;
  if (tau > 0) { const bf16* zm = z - NIN; q.r0 = zm[0]; q.k0 = zm[1024]; q.v0 = zm[2048]; }
  if (tau < len - 1) { const bf16* zp = z + NIN; q.r2 = zp[0]; q.k2 = zp[1024]; q.v2 = zp[2048]; }
  q.a = AD[(size_t)row * 1024 + ch];
  q.e = ED[(size_t)row * 1024 + ch];
}

typedef float f2v __attribute__((ext_vector_type(2)));
DEV float dpp_hmirror(float v) {
  int i = __float_as_int(v);
  return __int_as_float(__builtin_amdgcn_update_dpp(0, i, 0x141, 0xF, 0xF, true));
}
DEV f2v lo2(float4 v) { return f2v{v.x, v.y}; }
DEV f2v hi2(float4 v) { return f2v{v.z, v.w}; }

DEV void rwkv_scan(int tidv, int bidv, const Params& p, int l, int chain, char* smem, int dry) {
  char* ws = p.ws;
  float* op = (float*)smem;
  float* vb = op + 16 * 320;
  float* yb = vb + 16 * 64;
  const int tid = tidv, wave = tid >> 6, lane = tid & 63;
  const int d = chain & 1, h = (chain >> 1) & 15, b = chain >> 5;
  const int ch = h * 64 + lane;
  const float* cw = p.in[17] + (size_t)l * 3 * 3072;
  const float cr0 = cw[ch], cr1 = cw[3072 + ch], cr2 = cw[6144 + ch];
  const float ck0 = cw[1024 + ch], ck1 = cw[3072 + 1024 + ch], ck2 = cw[6144 + 1024 + ch];
  const float cv0 = cw[2048 + ch], cv1 = cw[3072 + 2048 + ch], cv2 = cw[6144 + 2048 + ch];
  const float kkc = p.in[23][l * 1024 + ch], kac = p.in[24][l * 1024 + ch];
  const bf16* Z = (const bf16*)(ws + B_ZB);
  bf16* ED = (bf16*)(ws + B_HB + (size_t)d * SZ1K);
  const bf16* AD = (const bf16*)(ws + (d ? B_AB : B_AF));
  f2v A0 = {0.f, 0.f}, A1 = {0.f, 0.f}, B0 = {0.f, 0.f}, B1 = {0.f, 0.f};
  const int ri = lane >> 4, jo = lane & 15, rA = wave * 8 + ri, rB = rA + 4;
  RwPre pre[2];
#pragma unroll
  for (int si = 0; si < 2; si++) rwkv_fetch(pre[si], Z, AD, ED, wave * 2 + si, d, b, ch);
  for (int chunk = 0; chunk < 272; chunk++) {
#pragma unroll
    for (int si = 0; si < 2; si++) {
      int t = wave * 2 + si;
      const RwPre& q = pre[si];
      float rr = cr0 * bf2f(q.r0) + cr1 * bf2f(q.r1) + cr2 * bf2f(q.r2);
      float kk_ = ck0 * bf2f(q.k0) + ck1 * bf2f(q.k1) + ck2 * bf2f(q.k2);
      float vv = cv0 * bf2f(q.v0) + cv1 * bf2f(q.v1) + cv2 * bf2f(q.v2);
      float kkv = kk_ * kkc;
      float ssq = wsum_fast(kkv * kkv);
      float kn = kkv * rsqrtf(ssq + 1e-12f);
      float a = bf2f(q.a);
      float w = __expf(-bf2f(q.e));
      float krep = kk_ * (1.f + (a - 1.f) * kac);
      float* o = op + t * 320;
      o[lane] = w;
      o[64 + lane] = kn * a;
      o[128 + lane] = krep;
      o[192 + lane] = -kn;
      o[256 + lane] = rr;
      vb[t * 64 + lane] = vv;
    }
    __syncthreads();
    if (chunk + 1 < 272) {
#pragma unroll
      for (int si = 0; si < 2; si++) rwkv_fetch(pre[si], Z, AD, ED, (chunk + 1) * 16 + wave * 2 + si, d, b, ch);
    }
    {
      const float4* o4 = (const float4*)op + jo;
      float4 nn = o4[48];
#pragma unroll 4
      for (int t = 0; t < 16; t++) {
        const float4* ot = o4 + t * 80;
        const float4 w = ot[0], a = ot[16], k = ot[32], r = ot[64];
        const float viA = vb[t * 64 + rA], viB = vb[t * 64 + rB];
        const int tn = t < 15 ? t + 1 : 15;
        const float4 mm = o4[tn * 80 + 48];
        f2v svA = A0 * lo2(nn) + A1 * hi2(nn);
        f2v svB = B0 * lo2(nn) + B1 * hi2(nn);
        float saA = svA.x + svA.y, saB = svB.x + svB.y;
        saA += dpp_xor1(saA); saB += dpp_xor1(saB);
        saA += dpp_xor2(saA); saB += dpp_xor2(saB);
        saA += dpp_hmirror(saA); saB += dpp_hmirror(saB);
        saA += dpp_rmirror(saA); saB += dpp_rmirror(saB);
        const f2v sA2 = {saA, saA}, vA2 = {viA, viA}, sB2 = {saB, saB}, vB2 = {viB, viB};
        A0 = A0 * lo2(w) + sA2 * lo2(a) + vA2 * lo2(k);
        B0 = B0 * lo2(w) + sB2 * lo2(a) + vB2 * lo2(k);
        A1 = A1 * hi2(w) + sA2 * hi2(a) + vA2 * hi2(k);
        B1 = B1 * hi2(w) + sB2 * hi2(a) + vB2 * hi2(k);
        f2v yvA = A0 * lo2(r) + A1 * hi2(r);
        f2v yvB = B0 * lo2(r) + B1 * hi2(r);
        yb[(t * 64 + rA) * 16 + jo] = yvA.x + yvA.y;
        yb[(t * 64 + rB) * 16 + jo] = yvB.x + yvB.y;
        nn = mm;
      }
    }
    __syncthreads();
#pragma unroll
    for (int it = 0; it < 2; it++) {
      int idx = it * NT + tid;
      int t = idx >> 6, i = idx & 63;
      int row, tau, len;
      step_row(chunk * 16 + t, d, b, row, tau, len);
      size_t off = (size_t)row * 1024 + h * 64 + i;
      bf16* yd = dry ? (bf16*)(ws + B_END) + (off & 0x3fffff) : ED + off;
      const float4* yp = (const float4*)(yb + (t * 64 + i) * 16);
      const float4 ya = yp[0], yc = yp[1], ye = yp[2], yg = yp[3];
      *yd = f2bf((((ya.x + ya.y) + (ya.z + ya.w)) + ((yc.x + yc.y) + (yc.z + yc.w))) + (((ye.x + ye.y) + (ye.z + ye.w)) + ((yg.x + yg.y) + (yg.z + yg.w))));
    }
  }
}

DEV void s5_scan(int tidv, int bidv, const Params& p, int l, int chain, char* smemw, int dry) {
  char* ws = p.ws;
  const int lane = tidv & 63;
  const int d = chain & 1, g = (chain >> 1) & 63, b = chain >> 7;
  float* ub = (float*)smemw;
  float* hb = ub + 256;
  const size_t pg = (size_t)(l * 2 + d) * 64 + g;
  const float lre = p.in[28][pg * 64 + lane], lim = p.in[29][pg * 64 + lane];
  const float dt = expf(p.in[30][pg]);
  const float mag = expf(lre * dt);
  const float are = mag * cosf(lim * dt), aim = mag * sinf(lim * dt);
  const float den = lre * lre + lim * lim;
  const float qre = ((are - 1.f) * lre + aim * lim) / den;
  const float qim = (aim * lre - (are - 1.f) * lim) / den;
  float bbre[16], bbim[16];
  {
    const float* br = p.in[31] + (pg * 64 + lane) * 16;
    const float* bi = p.in[32] + (pg * 64 + lane) * 16;
#pragma unroll
    for (int i = 0; i < 16; i++) {
      float x = br[i], y = bi[i];
      bbre[i] = qre * x - qim * y;
      bbim[i] = qre * y + qim * x;
    }
  }
  bf16x8 cfr[4];
  {
    const int i = lane & 15, quad = lane >> 4;
    const float* cre = p.in[33] + (pg * 16 + i) * 64;
    const float* cim = p.in[34] + (pg * 16 + i) * 64;
#pragma unroll
    for (int ks = 0; ks < 4; ks++)
#pragma unroll
      for (int j = 0; j < 8; j++) {
        int k = ks * 32 + quad * 8 + j;
        float c = ks < 2 ? cre[k] : -cim[k - 64];
        cfr[ks][j] = (short)f2bf(c);
      }
  }
  float hre = 0.f, him = 0.f;
  const bf16* Z = (const bf16*)(ws + B_ZB);
  const int tt = lane >> 2, i0 = (lane & 3) * 4;
  uint2 unext;
  {
    int row, tau, len;
    step_row(tt, d, b, row, tau, len);
    unext = *(const uint2*)(Z + (size_t)row * NIN + C_U + g * 16 + i0);
  }
  for (int chunk = 0; chunk < 272; chunk++) {
    {
      uint2 u = unext;
      float4 f;
      f.x = bf2f((bf16)(u.x & 0xffff)); f.y = bf2f((bf16)(u.x >> 16));
      f.z = bf2f((bf16)(u.y & 0xffff)); f.w = bf2f((bf16)(u.y >> 16));
      *(float4*)(ub + tt * 16 + i0) = f;
    }
    __syncthreads();
    if (chunk + 1 < 272) {
      int row, tau, len;
      step_row((chunk + 1) * 16 + tt, d, b, row, tau, len);
      unext = *(const uint2*)(Z + (size_t)row * NIN + C_U + g * 16 + i0);
    }
#pragma unroll 2
    for (int t = 0; t < 16; t++) {
      const float* u = ub + t * 16;
      float br0 = 0.f, bi0 = 0.f;
#pragma unroll
      for (int i = 0; i < 16; i++) { float uv = u[i]; br0 += bbre[i] * uv; bi0 += bbim[i] * uv; }
      float nr = are * hre - aim * him + br0;
      float ni = are * him + aim * hre + bi0;
      hre = nr; him = ni;
      hb[t * 132 + lane] = hre;
      hb[t * 132 + 64 + lane] = him;
    }
    __syncthreads();
    {
      f32x4 yacc = {0.f, 0.f, 0.f, 0.f};
      const float* hr = hb + (lane & 15) * 132 + (lane >> 4) * 8;
#pragma unroll
      for (int ks = 0; ks < 4; ks++) {
        float4 x0 = *(const float4*)(hr + ks * 32), x1 = *(const float4*)(hr + ks * 32 + 4);
        union { bf16x8 v; uint32_t u[4]; } af;
        af.u[0] = pack2(x0.x, x0.y); af.u[1] = pack2(x0.z, x0.w);
        af.u[2] = pack2(x1.x, x1.y); af.u[3] = pack2(x1.z, x1.w);
        yacc = __builtin_amdgcn_mfma_f32_16x16x32_bf16(af.v, cfr[ks], yacc, 0, 0, 0);
      }
      const int ii = lane & 15;
#pragma unroll
      for (int r = 0; r < 4; r++) {
        int row, tau, len;
        step_row(chunk * 16 + (lane >> 4) * 4 + r, d, b, row, tau, len);
        bf16* dst = d == 0 ? (bf16*)(ws + B_SY) + (size_t)row * 1024 + g * 16 + ii : (bf16*)(ws + B_ZB) + (size_t)row * NIN + g * 16 + ii;
        if (dry) dst = (bf16*)(ws + B_END) + ((((size_t)row * 1024 + g * 16 + ii)) & 0x3fffff);
        *dst = f2bf(yacc[r]);
      }
    }
    __syncthreads();
  }
}

DEV int perm23(int r) { return (r & 0x13) | ((r & 4) << 1) | ((r & 8) >> 1); }

DEV void attn_item(int tidv, int bidv, const Params& p, int item, bool ctxq, char* smem, int dry) {
  char* ws = p.ws;
  bf16* sK = (bf16*)smem;
  bf16* sV = sK + 64 * 200;
  const int tid = tidv, wave = tid >> 6, lane = tid & 63;
  const int r = lane & 31, hf = lane >> 5;
  int b, hd, qt;
  if (!ctxq) { b = item >> 7; hd = (item >> 4) & 7; qt = item & 15; }
  else { b = item >> 3; hd = item & 7; qt = 0; }
  const int qrow0 = ctxq ? ML + b * 256 : b * 4096 + qt * 256;
  const int kt0 = ctxq ? 64 : 0, kt1 = 68;
  bf16* QB = (bf16*)(ws + B_QB);
  const bf16* KN = (const bf16*)(ws + B_KN);
  const bf16* KR = (const bf16*)(ws + B_KR);
  const bf16* VT = (const bf16*)(ws + B_VT);
  bf16x8 qf[12];
  {
    const bf16* qp = QB + (size_t)(qrow0 + wave * 32 + r) * 1536 + hd * 192 + hf * 8;
#pragma unroll
    for (int kk = 0; kk < 12; kk++) qf[kk] = *(const bf16x8*)(qp + kk * 16);
  }
  f32x16 oacc[4];
#pragma unroll
  for (int i = 0; i < 4; i++)
#pragma unroll
    for (int e = 0; e < 16; e++) oacc[i][e] = 0.f;
  float mrun = -1e30f, lrun = 0.f;
  const int pr = perm23(r);
  const uint32_t vo_n = (uint32_t)((tid >> 4) * 2048 + (tid & 15) * 16);
  const uint32_t lo_n = (uint32_t)((tid >> 4) * 400 + (tid & 15) * 16);
  const uint32_t vo_r = (uint32_t)((tid >> 3) * 128 + (tid & 7) * 16);
  const uint32_t lo_r = (uint32_t)((tid >> 3) * 400 + 256 + (tid & 7) * 16);
  const uint32_t vo_v = (uint32_t)((tid >> 3) * (NKEY * 2) + (tid & 7) * 16);
  const uint32_t lo_v = (uint32_t)((tid >> 3) * 144 + (tid & 7) * 16);
  uint4 t0, t1, t4, u0, u1;
#define ATT_LOAD(KT)                                                                                   \
  {                                                                                                    \
    const int key0_ = (KT) * 64;                                                                       \
    const int rowbase_ = key0_ < 4096 ? b * 4096 + key0_ : ML + b * 256 + (key0_ - 4096);               \
    const char* bk = (const char*)(KN + (size_t)rowbase_ * 1024 + hd * 128);                           \
    const char* br = (const char*)(KR + (size_t)rowbase_ * 64);                                        \
    const char* bv = (const char*)(VT + ((size_t)((b * 8 + hd) * 128)) * NKEY + key0_);                \
    t0 = *(const uint4*)(bk + vo_n);                                                                   \
    t1 = *(const uint4*)(bk + 32 * 2048 + vo_n);                                                       \
    t4 = *(const uint4*)(br + vo_r);                                                                   \
    u0 = *(const uint4*)(bv + vo_v);                                                                   \
    u1 = *(const uint4*)(bv + (size_t)64 * NKEY * 2 + vo_v);                                           \
  }
  ATT_LOAD(kt0)
  for (int kt = kt0; kt < kt1; kt++) {
    __syncthreads();
    *(uint4*)((char*)sK + lo_n) = t0;
    *(uint4*)((char*)sK + 32 * 400 + lo_n) = t1;
    *(uint4*)((char*)sK + lo_r) = t4;
    *(uint4*)((char*)sV + lo_v) = u0;
    *(uint4*)((char*)sV + 64 * 144 + lo_v) = u1;
    __syncthreads();
    ATT_LOAD((kt + 1 < kt1 ? kt + 1 : kt1 - 1))
    f32x16 sacc[2];
#pragma unroll
    for (int m = 0; m < 2; m++) {
#pragma unroll
      for (int e = 0; e < 16; e++) sacc[m][e] = 0.f;
      const bf16* kp = sK + (m * 32 + pr) * 200 + hf * 8;
#pragma unroll
      for (int kk = 0; kk < 12; kk++) {
        bf16x8 kf = *(const bf16x8*)(kp + kk * 16);
        sacc[m] = __builtin_amdgcn_mfma_f32_32x32x16_bf16(kf, qf[kk], sacc[m], 0, 0, 0);
        if ((kk & 3) == 3) __builtin_amdgcn_sched_barrier(0);
      }
      __builtin_amdgcn_sched_barrier(0);
    }
    float tmax = sacc[0][0];
#pragma unroll
    for (int e = 1; e < 16; e++) tmax = fmaxf(tmax, sacc[0][e]);
#pragma unroll
    for (int e = 0; e < 16; e++) tmax = fmaxf(tmax, sacc[1][e]);
    tmax = fmaxf(tmax, __shfl_xor(tmax, 32));
    float mnew = fmaxf(mrun, tmax);
    float alpha = __builtin_amdgcn_exp2f(mrun - mnew);
    mrun = mnew;
    float psum = 0.f;
#pragma unroll
    for (int m = 0; m < 2; m++)
#pragma unroll
      for (int e = 0; e < 16; e++) { float pv = __builtin_amdgcn_exp2f(sacc[m][e] - mnew); sacc[m][e] = pv; psum += pv; }
    lrun = lrun * alpha + psum;
#pragma unroll
    for (int i = 0; i < 4; i++)
#pragma unroll
      for (int e = 0; e < 16; e++) oacc[i][e] *= alpha;
#pragma unroll
    for (int s = 0; s < 4; s++) {
      const int m = s >> 1, s2 = s & 1;
      bf16x8 pf;
#pragma unroll
      for (int j = 0; j < 8; j++) pf[j] = (short)f2bf(sacc[m][8 * s2 + j]);
#pragma unroll
      for (int i = 0; i < 4; i++) {
        bf16x8 vf = *(const bf16x8*)(sV + (i * 32 + r) * 72 + m * 32 + s2 * 16 + hf * 8);
        oacc[i] = __builtin_amdgcn_mfma_f32_32x32x16_bf16(vf, pf, oacc[i], 0, 0, 0);
      }
      __builtin_amdgcn_sched_barrier(0);
    }
  }
#undef ATT_LOAD
  lrun += __shfl_xor(lrun, 32);
  const float inv = 1.f / lrun;
  bf16* op = QB + (size_t)(qrow0 + wave * 32 + r) * 1536 + hd * 192;
  if (dry) op = (bf16*)(ws + B_END) + ((((size_t)(qrow0 + wave * 32 + r) * 1536 + hd * 192)) & 0x3ffff8);
#pragma unroll
  for (int i = 0; i < 4; i++)
#pragma unroll
    for (int g = 0; g < 4; g++) {
      uint2 o;
      o.x = pack2(oacc[i][4 * g] * inv, oacc[i][4 * g + 1] * inv);
      o.y = pack2(oacc[i][4 * g + 2] * inv, oacc[i][4 * g + 3] * inv);
      *(uint2*)(op + 32 * i + 8 * g + 4 * hf) = o;
    }
}

DEV void phase_mixers(int tidv, int bidv, const Params& p, int l, char* smem, int dry) {
  int* s_item = (int*)(smem + SM_ITEM);
#ifdef PROBE_PARTS
  const int parts = dry ? PROBE_PARTS : 7;
#else
  const int parts = 7;
#endif
  for (int task = bidv; task < 192; task += gridDim.x) {
    if (task < 128 && !(parts & 1)) continue;
    if (task >= 128 && !(parts & 2)) continue;
    if (task < 128) rwkv_scan(tidv, bidv, p, l, task, smem, dry);
    else s5_scan(tidv, bidv, p, l, (task - 128) * 8 + (tidv >> 6), smem + (tidv >> 6) * 9472, dry);
  }
  const int nlat = 512, ntot = (parts & 4) ? ((l == 0) ? 544 : 512) : 0;
  int* cnt = (int*)(p.ws + B_CNT) + l + 2 * dry;
#if !defined(MIX_ONLY) || MIX_ONLY == 2
  while (true) {
    __syncthreads();
    if (tidv == 0) *s_item = atomicAdd(cnt, 1);
    __syncthreads();
    int item = *s_item;
    if (item >= ntot) break;
    if (item < nlat) attn_item(tidv, bidv, p, item, false, smem, dry);
    else attn_item(tidv, bidv, p, item - nlat, true, smem, dry);
  }
#endif
}

DEV float gelu_tanh(float x) {
  float u = 0.7978845608028654f * (x + 0.044715f * x * x * x);
  return 0.5f * x * (1.f + tanhf(u));
}

DEV void phase_post(int tidv, int bidv, const Params& p, int l, int M) {
  char* ws = p.ws;
  const bf16* Z = (const bf16*)(ws + B_ZB);
  const int wave = tidv >> 6, lane = tidv & 63;
  const float* cw = p.in[17] + (size_t)l * 3 * 3072;
  const bf16* YF = (const bf16*)(ws + B_HB);
  const bf16* YB = (const bf16*)(ws + B_HB + SZ1K);
  const bf16* AF = (const bf16*)(ws + B_AF);
  const bf16* AB = (const bf16*)(ws + B_AB);
  bf16* GB = (bf16*)(ws + B_GB);
  const int nitem = M * 16;
  for (int it = bidv * NW + wave; it < nitem; it += gridDim.x * NW) {
    int row = it >> 4, h = it & 15;
    int ch = h * 64 + lane;
    int tau, len;
    if (row < ML) { tau = row & 4095; len = 4096; } else { tau = (row - ML) & 255; len = 256; }
    size_t o = (size_t)row * 1024 + ch;
    float y = bf2f(YF[o]) + bf2f(YB[o]);
    float mu = wsum(y) * (1.f / 64.f);
    float dv = y - mu;
    float var = wsum(dv * dv) * (1.f / 64.f);
    float yn = dv * rsqrtf(var + 64e-5f) * p.in[26][l * 1024 + ch] + p.in[27][l * 1024 + ch];
    const bf16* z = Z + (size_t)row * NIN + C_R + ch;
    float r1 = bf2f(z[0]), k1 = bf2f(z[1024]), v1 = bf2f(z[2048]);
    float r0 = 0.f, k0 = 0.f, v0 = 0.f, r2 = 0.f, k2 = 0.f, v2 = 0.f;
    if (tau > 0) { const bf16* zm = z - NIN; r0 = bf2f(zm[0]); k0 = bf2f(zm[1024]); v0 = bf2f(zm[2048]); }
    if (tau < len - 1) { const bf16* zp = z + NIN; r2 = bf2f(zp[0]); k2 = bf2f(zp[1024]); v2 = bf2f(zp[2048]); }
    float rr = cw[ch] * r0 + cw[3072 + ch] * r1 + cw[6144 + ch] * r2;
    float kk = cw[1024 + ch] * k0 + cw[3072 + 1024 + ch] * k1 + cw[6144 + 1024 + ch] * k2;
    float vv = cw[2048 + ch] * v0 + cw[3072 + 2048 + ch] * v1 + cw[6144 + 2048 + ch] * v2;
    float am = 0.5f * (bf2f(AF[o]) + bf2f(AB[o]));
    float kbon = kk * (1.f + (am - 1.f) * p.in[24][l * 1024 + ch]);
    float s = wsum(rr * kbon * p.in[25][l * 1024 + ch]);
    float outv = (yn + s * vv) * bf2f(GB[o]);
    GB[o] = f2bf(outv);
  }
  bf16* SY = (bf16*)(ws + B_SY);
  const float* dsk = p.in[35] + l * 1024;
  const int n4 = M * 256;
  for (int i = bidv * NT + tidv; i < n4; i += gridDim.x * NT) {
    int row = i >> 8, c = (i & 255) * 4;
    uint2 a = *(const uint2*)(SY + (size_t)row * 1024 + c);
    uint2 bq = *(const uint2*)(Z + (size_t)row * NIN + c);
    uint2 u = *(const uint2*)(Z + (size_t)row * NIN + C_U + c);
    float4 dd = *(const float4*)(dsk + c);
    float y0 = bf2f((bf16)(a.x & 0xffff)) + bf2f((bf16)(bq.x & 0xffff)) + dd.x * bf2f((bf16)(u.x & 0xffff));
    float y1 = bf2f((bf16)(a.x >> 16)) + bf2f((bf16)(bq.x >> 16)) + dd.y * bf2f((bf16)(u.x >> 16));
    float y2 = bf2f((bf16)(a.y & 0xffff)) + bf2f((bf16)(bq.y & 0xffff)) + dd.z * bf2f((bf16)(u.y & 0xffff));
    float y3 = bf2f((bf16)(a.y >> 16)) + bf2f((bf16)(bq.y >> 16)) + dd.w * bf2f((bf16)(u.y >> 16));
    uint2 o;
    o.x = pack2(gelu_tanh(y0), gelu_tanh(y1));
    o.y = pack2(gelu_tanh(y2), gelu_tanh(y3));
    *(uint2*)(SY + (size_t)row * 1024 + c) = o;
  }
}

constexpr int NPH = 25;

DEV void run_phase(int tidv, int bidv, const Params& p, int ph, char* smem, int dry) {
  char* ws = p.ws;
#ifndef ONLY_S
  if (ph == 0) {
    if (bidv == 0 && tidv < 4) ((int*)(ws + B_CNT))[tidv] = 0;
    phase_mod(tidv, bidv, p, smem);
    phase_convw(tidv, bidv, p, 0, smem);
    return;
  }
#endif
  const int l = (ph - 1) / 12, s = (ph - 1) % 12;
#ifdef ONLY_S
  if (s != ONLY_S) return;
#endif
  const bf16* wb = (const bf16*)(ws + B_WB);
  const float* mod = (const float*)(ws + B_MOD) + (size_t)l * 5 * 12288;
  float* XC = (float*)(ws + B_XC);
  const float* xin_lat = l == 0 ? p.in[0] : p.out;
  const float* xin_ctx = l == 0 ? p.in[2] : XC;
  bf16* HB = (bf16*)(ws + B_HB);
  bf16* Z = (bf16*)(ws + B_ZB);
  bf16* H2 = (bf16*)(ws + B_KN);
  const int Mpost = l == 0 ? MT : ML;
  switch (s) {
    case 0:
      if (l == 1) phase_convw(tidv, bidv, p, 1, smem);
      phase_norm(tidv, bidv, xin_lat, xin_ctx, p.in[6] + l * 2048, mod, 0, 2048, HB, MT);
      break;
    case 1:
      run_gemm<G_IN>(tidv, bidv, p, l, smem, HB, 2048, wb + OW_IN, 2048, NIN, MT, 0, nullptr, nullptr, nullptr, nullptr);
      break;
    case 2:
#if !defined(PH2_ONLY) || PH2_ONLY == 0
      run_gemm<G_UKV>(tidv, bidv, p, l, smem, Z + C_CKV, NIN, wb + OW_UKV, 512, 2048, MT, 0, nullptr, nullptr, nullptr, nullptr);
#endif
#if !defined(PH2_ONLY) || PH2_ONLY == 1
      run_gemm<G_UQ>(tidv, bidv, p, l, smem, Z + C_CQ, NIN, wb + OW_UQ, 512, 1536, MT, 0, nullptr, nullptr, nullptr, nullptr);
#endif
#if !defined(PH2_ONLY) || PH2_ONLY == 2
      run_gemm<G_G2>(tidv, bidv, p, l, smem, Z + C_GD, NIN, wb + OW_G2, 192, 1024, MT, 0, nullptr, nullptr, nullptr, nullptr);
#endif
#if !defined(PH2_ONLY) || PH2_ONLY == 3
      for (int d = 0; d < 2; d++) {
        run_gemm<G_W2>(tidv, bidv, p, l, smem, Z + C_WD + 64 * d, NIN, wb + OW_W2 + (size_t)d * 65536, 64, 1024, MT, d, nullptr, nullptr, nullptr, nullptr);
        run_gemm<G_A2>(tidv, bidv, p, l, smem, Z + C_AD + 64 * d, NIN, wb + OW_A2 + (size_t)d * 65536, 64, 1024, MT, d, nullptr, nullptr, nullptr, nullptr);
      }
#endif
      break;
    case 3: phase_mla_post(tidv, bidv, p, l); break;
    case 4: phase_mixers(tidv, bidv, p, l, smem, dry); break;
    case 5: phase_post(tidv, bidv, p, l, Mpost); break;
    case 6:
      run_gemm<G_GLU>(tidv, bidv, p, l, smem, (const bf16*)(ws + B_SY), 1024, wb + OW_GLU, 1024, 1024, Mpost, 0, nullptr, nullptr, nullptr, nullptr);
      break;
    case 7:
      run_gemm<G_MG0>(tidv, bidv, p, l, smem, (const bf16*)(ws + B_QB), 1536, wb + OW_BR, 1024, 2048, Mpost, 0, nullptr, nullptr, nullptr, nullptr);
      run_gemm<G_MG1>(tidv, bidv, p, l, smem, (const bf16*)(ws + B_GB), 1024, wb + OW_BR + (size_t)2048 * 1024, 1024, 2048, Mpost, 0, nullptr, nullptr, nullptr, nullptr);
      run_gemm<G_MG2>(tidv, bidv, p, l, smem, Z, NIN, wb + OW_BR + (size_t)2 * 2048 * 1024, 1024, 2048, Mpost, 0, nullptr, nullptr, nullptr, nullptr);
      break;
    case 8:
      run_gemm<G_OUT>(tidv, bidv, p, l, smem, HB, 2048, wb + OW_OUT, 2048, 2048, Mpost, 0, xin_lat, xin_ctx, p.out, XC);
      break;
    case 9:
      phase_norm(tidv, bidv, p.out, XC, p.in[7] + l * 2048, mod, 6144, 8192, H2, Mpost);
      break;
    case 10:
      run_gemm<G_M1>(tidv, bidv, p, l, smem, H2, 2048, wb + OW_M1, 2048, 8192, Mpost, 0, nullptr, nullptr, nullptr, nullptr);
      break;
    case 11:
      run_gemm<G_M2>(tidv, bidv, p, l, smem, Z, 8192, wb + OW_M2, 8192, 2048, Mpost, 0, nullptr, nullptr, p.out, XC);
      break;
  }
}

DEV void grid_barrier(unsigned* cnt, unsigned target) {
  asm volatile("s_waitcnt vmcnt(0)" ::: "memory");
  __syncthreads();
  if (threadIdx.x == 0) {
    __builtin_amdgcn_fence(__ATOMIC_RELEASE, "agent");
    asm volatile("s_waitcnt vmcnt(0)" ::: "memory");
    __hip_atomic_fetch_add(cnt, 1u, __ATOMIC_RELAXED, __HIP_MEMORY_SCOPE_AGENT);
    unsigned spins = 0;
    while (__hip_atomic_load(cnt, __ATOMIC_RELAXED, __HIP_MEMORY_SCOPE_AGENT) < target) {
      __builtin_amdgcn_s_sleep(1);
      if (++spins > (1u << 21)) break;
    }
    __builtin_amdgcn_fence(__ATOMIC_ACQUIRE, "agent");
    asm volatile("s_waitcnt vmcnt(0)" ::: "memory");
  }
  __syncthreads();
}

__global__ void __launch_bounds__(NT) fwd_megakernel(Params p, int ph0, int ph1, int dryflag) {
  extern __shared__ __attribute__((aligned(16))) char smem[];
  for (int ph = ph0; ph < ph1; ph++) {
    int tidv = threadIdx.x, bidv = blockIdx.x;
    asm volatile("" : "+v"(tidv));
    asm volatile("" : "+s"(bidv));
#ifdef PROBE_MASK
    if (dryflag && ((ph == 0 && (PROBE_MASK & 0x1000)) || (ph > 0 && ((PROBE_MASK >> ((ph - 1) % 12)) & 1)))) {
      run_phase(tidv, bidv, p, ph, smem, dryflag);
      cg::this_grid().sync();
    }
#endif
    run_phase(tidv, bidv, p, ph, smem, 0);
    if (ph + 1 < ph1) {
      if (ph == ph0) cg::this_grid().sync();
      else grid_barrier((unsigned*)(p.ws + B_FLG), (unsigned)(ph - ph0) * gridDim.x);
    }
  }
}

extern "C" void kernel_launch(void* const* d_in, const int* in_sizes, int n_in, void* d_out, int out_size, void* d_ws, size_t ws_size,
                              hipStream_t stream) {
  static int grid_blocks = 0;
  if (!grid_blocks) {
    int dev = 0, cus = 0, per_cu = 0;
    (void)hipGetDevice(&dev);
    (void)hipDeviceGetAttribute(&cus, hipDeviceAttributeMultiprocessorCount, dev);
    if (hipFuncSetAttribute((const void*)fwd_megakernel, hipFuncAttributeMaxDynamicSharedMemorySize, LDS_BYTES) != hipSuccess) {
      fprintf(stderr, "hipFuncSetAttribute(%d B dynamic LDS) failed\n", LDS_BYTES);
      return;
    }
    if (hipOccupancyMaxActiveBlocksPerMultiprocessor(&per_cu, (const void*)fwd_megakernel, NT, LDS_BYTES) != hipSuccess || per_cu < 1) {
      fprintf(stderr, "occupancy query failed / kernel not resident\n");
      return;
    }
    grid_blocks = cus;
  }
  Params p{};
  for (int i = 0; i < 42; i++) p.in[i] = (const float*)d_in[i];
  p.out = (float*)d_out;
  p.ws = (char*)d_ws;
  if (ws_size < B_END + (8u << 20)) { fprintf(stderr, "workspace too small\n"); return; }
  int ph0 = 0, ph1 = NPH;
  int dryflag = 1;
  void* args[] = {&p, &ph0, &ph1, &dryflag};
  (void)hipMemsetAsync((char*)d_ws + B_FLG, 0, 4096, stream);
  hipError_t e = hipLaunchCooperativeKernel((void*)fwd_megakernel, dim3(grid_blocks), dim3(NT), args, LDS_BYTES, stream);
  if (e != hipSuccess) fprintf(stderr, "cooperative launch failed: %s (grid %d)\n", hipGetErrorString(e), grid_blocks);
}
```

```cpp
#include <hip/hip_runtime.h>
#include <hip/hip_cooperative_groups.h>
#include <stdint.h>
#include <cstdio>
namespace cg = cooperative_groups;

#ifndef MULTI_LAUNCH
#define MULTI_LAUNCH 0
#endif

typedef unsigned short bf16;
using bf16x8 = __attribute__((ext_vector_type(8))) short;
using f32x4 = __attribute__((ext_vector_type(4))) float;
using f32x16 = __attribute__((ext_vector_type(16))) float;

#define DEV __device__ __forceinline__
constexpr int NT = 512, NW = 8;

constexpr int DM = 2048, ML = 16384, MC = 1024, MT = 17408, NIN = 11744, DFF = 8192, NKEY = 4352;
constexpr int C_CQ = 0, C_CKV = 512, C_KR = 1024, C_R = 1088, C_WD = 4160, C_AD = 4288, C_GD = 4416, C_U = 4576, C_GATE = 5600;

constexpr size_t OW_IN = 0;
constexpr size_t OW_UQ = OW_IN + (size_t)NIN * 2048;
constexpr size_t OW_UKV = OW_UQ + 1536 * 512;
constexpr size_t OW_W2 = OW_UKV + 2048 * 512;
constexpr size_t OW_A2 = OW_W2 + 2 * 1024 * 64;
constexpr size_t OW_G2 = OW_A2 + 2 * 1024 * 64;
constexpr size_t OW_GLU = OW_G2 + 1024 * 192;
constexpr size_t OW_BR = OW_GLU + 1024 * 1024;
constexpr size_t OW_OUT = OW_BR + (size_t)3 * 2048 * 1024;
constexpr size_t OW_M1 = OW_OUT + (size_t)2048 * 2048;
constexpr size_t OW_M2 = OW_M1 + (size_t)8192 * 2048;
constexpr size_t OW_END = OW_M2 + (size_t)8192 * 2048;

constexpr size_t SZ1K = (size_t)MT * 1024 * 2;
constexpr size_t B_WB = 0;
constexpr size_t B_HB = B_WB + OW_END * 2;
constexpr size_t B_ZB = B_HB + (size_t)MT * 2048 * 2;
constexpr size_t B_QB = B_ZB + (size_t)MT * NIN * 2;
constexpr size_t B_KN = B_QB + (size_t)MT * 1536 * 2;
constexpr size_t B_VT = B_KN + SZ1K;
constexpr size_t B_KR = B_VT + SZ1K;
constexpr size_t B_AF = B_KR + (size_t)MT * 64 * 2;
constexpr size_t B_AB = B_AF + SZ1K;
constexpr size_t B_GB = B_AB + SZ1K;
constexpr size_t B_SY = B_GB + SZ1K;
constexpr size_t B_XC = B_SY + SZ1K;
constexpr size_t B_MOD = B_XC + (size_t)MC * 2048 * 4;
constexpr size_t B_CNT = B_MOD + (size_t)2 * 5 * 12288 * 4;
constexpr size_t B_FLG = B_CNT + 256;
constexpr size_t B_END = B_FLG + 4096;

struct Params {
  const float* in[42];
  float* out;
  char* ws;
};

typedef __attribute__((ext_vector_type(2))) __bf16 hbf2;
DEV bf16 f2bf(float f) {
  __bf16 h = (__bf16)f;
  return *(unsigned short*)&h;
}
DEV float bf2f(bf16 h) { return __uint_as_float(((uint32_t)h) << 16); }
DEV uint32_t pack2(float a, float b) {
  hbf2 v;
  v[0] = (__bf16)a;
  v[1] = (__bf16)b;
  return *(uint32_t*)&v;
}
DEV float wsum(float v) {
#pragma unroll
  for (int o = 32; o > 0; o >>= 1) v += __shfl_xor(v, o);
  return v;
}
DEV float dpp_xor1(float v) {
  int i = __float_as_int(v);
  return __int_as_float(__builtin_amdgcn_update_dpp(0, i, 0xB1, 0xF, 0xF, true));
}
DEV float dpp_xor2(float v) {
  int i = __float_as_int(v);
  return __int_as_float(__builtin_amdgcn_update_dpp(0, i, 0x4E, 0xF, 0xF, true));
}
DEV float dpp_rmirror(float v) {
  int i = __float_as_int(v);
  return __int_as_float(__builtin_amdgcn_update_dpp(0, i, 0x140, 0xF, 0xF, true));
}
DEV float dpp_hmirror0(float v) {
  int i = __float_as_int(v);
  return __int_as_float(__builtin_amdgcn_update_dpp(0, i, 0x141, 0xF, 0xF, true));
}
DEV float wsum_fast(float v) {
  v += dpp_xor1(v);
  v += dpp_xor2(v);
  v += dpp_hmirror0(v);
  v += dpp_rmirror(v);
  v += __shfl_xor(v, 16);
  v += __shfl_xor(v, 32);
  return v;
}
DEV float sigmoidf_(float x) { return __builtin_amdgcn_rcpf(1.f + __expf(-x)); }

DEV void phase_mod(int tidv, int bidv, const Params& p, char* smem) {
  float* s_in = (float*)smem;
  float* red = s_in + 5 * 2048;
  float* mod = (float*)(p.ws + B_MOD);
  for (int i = tidv; i < 5 * 2048; i += NT) {
    int r = i >> 11, k = i & 2047;
    float v = r < 4 ? p.in[1][r * 2048 + k] : p.in[3][k];
    s_in[i] = v / (1.f + expf(-v));
  }
  __syncthreads();
  int kg = tidv >> 6, c = tidv & 63;
  for (int task = bidv; task < 2 * 192; task += gridDim.x) {
    int l = task / 192, n = (task % 192) * 64 + c;
    const float* w = p.in[4] + (size_t)l * 2048 * 12288 + n;
    float a0 = 0, a1 = 0, a2 = 0, a3 = 0, a4 = 0;
    int kb = kg * 256;
#pragma unroll 8
    for (int k = 0; k < 256; k++) {
      float wv = w[(size_t)(kb + k) * 12288];
      a0 += s_in[kb + k] * wv;
      a1 += s_in[2048 + kb + k] * wv;
      a2 += s_in[4096 + kb + k] * wv;
      a3 += s_in[6144 + kb + k] * wv;
      a4 += s_in[8192 + kb + k] * wv;
    }
    red[(kg * 5 + 0) * 64 + c] = a0;
    red[(kg * 5 + 1) * 64 + c] = a1;
    red[(kg * 5 + 2) * 64 + c] = a2;
    red[(kg * 5 + 3) * 64 + c] = a3;
    red[(kg * 5 + 4) * 64 + c] = a4;
    __syncthreads();
    if (kg == 0) {
      float bias = p.in[5][l * 12288 + n];
#pragma unroll
      for (int r = 0; r < 5; r++) {
        float v = 0.f;
#pragma unroll
        for (int g = 0; g < 8; g++) v += red[(g * 5 + r) * 64 + c];
        mod[(size_t)(l * 5 + r) * 12288 + n] = v + bias;
      }
    }
    __syncthreads();
  }
}

DEV void convT(int tidv, int bidv, const float* __restrict__ src, bf16* __restrict__ dst, int K, int N, const float* __restrict__ gain, char* smem, int dK = 0) {
  if (dK == 0) dK = K;
  float* t = (float*)smem;
  const int tk = (K + 63) >> 6, tn = (N + 63) >> 6, ntile = tk * tn;
  const int kk = tidv >> 4, n4 = (tidv & 15) * 4;
  float4 c0 = {0.f, 0.f, 0.f, 0.f}, c1 = {0.f, 0.f, 0.f, 0.f};
#define CV_LOAD(TILE)                                                                      \
  {                                                                                        \
    const int k0_ = ((TILE) / tn) * 64, n0_ = ((TILE) % tn) * 64;                          \
    c0 = float4{0.f, 0.f, 0.f, 0.f}; c1 = c0;                                              \
    if (n0_ + n4 < N) {                                                                    \
      if (k0_ + kk < K) { c0 = *(const float4*)(src + (size_t)(k0_ + kk) * N + n0_ + n4);  \
        if (gain) { float g = gain[k0_ + kk]; c0.x *= g; c0.y *= g; c0.z *= g; c0.w *= g; } }          \
      if (k0_ + kk + 32 < K) { c1 = *(const float4*)(src + (size_t)(k0_ + kk + 32) * N + n0_ + n4);    \
        if (gain) { float g = gain[k0_ + kk + 32]; c1.x *= g; c1.y *= g; c1.z *= g; c1.w *= g; } }     \
    }                                                                                      \
  }
  if (bidv < ntile) CV_LOAD(bidv)
  for (int tile = bidv; tile < ntile; tile += gridDim.x) {
    int k0 = (tile / tn) * 64, n0 = (tile % tn) * 64;
    __syncthreads();
    t[kk * 65 + n4 + 0] = c0.x; t[kk * 65 + n4 + 1] = c0.y; t[kk * 65 + n4 + 2] = c0.z; t[kk * 65 + n4 + 3] = c0.w;
    t[(kk + 32) * 65 + n4 + 0] = c1.x; t[(kk + 32) * 65 + n4 + 1] = c1.y; t[(kk + 32) * 65 + n4 + 2] = c1.z; t[(kk + 32) * 65 + n4 + 3] = c1.w;
    __syncthreads();
    if (tile + (int)gridDim.x < ntile) CV_LOAD(tile + (int)gridDim.x)
    {
      int c = tidv;
      int nn = c >> 3, kc = c & 7;
      if (n0 + nn < N && k0 + kc * 8 < dK) {
        uint4 o;
        o.x = pack2(t[(kc * 8 + 0) * 65 + nn], t[(kc * 8 + 1) * 65 + nn]);
        o.y = pack2(t[(kc * 8 + 2) * 65 + nn], t[(kc * 8 + 3) * 65 + nn]);
        o.z = pack2(t[(kc * 8 + 4) * 65 + nn], t[(kc * 8 + 5) * 65 + nn]);
        o.w = pack2(t[(kc * 8 + 6) * 65 + nn], t[(kc * 8 + 7) * 65 + nn]);
        *(uint4*)(dst + (size_t)(n0 + nn) * dK + k0 + kc * 8) = o;
      }
    }
  }
#undef CV_LOAD
}

DEV void phase_convw(int tidv, int bidv, const Params& p, int l, char* smem) {
  bf16* wb = (bf16*)(p.ws + B_WB);
  convT(tidv, bidv, p.in[8] + (size_t)l * 2048 * NIN, wb + OW_IN, 2048, NIN, nullptr, smem);
  convT(tidv, bidv, p.in[40] + (size_t)l * 2048 * 8192, wb + OW_M1, 2048, 8192, nullptr, smem);
  convT(tidv, bidv, p.in[41] + (size_t)l * 8192 * 2048, wb + OW_M2, 8192, 2048, nullptr, smem);
  for (int n = 0; n < 3; n++)
    convT(tidv, bidv, p.in[38] + (size_t)(l * 3 + n) * 1024 * 2048, wb + OW_BR + (size_t)n * 2048 * 1024, 1024, 2048, nullptr, smem);
  convT(tidv, bidv, p.in[39] + (size_t)l * 2048 * 2048, wb + OW_OUT, 2048, 2048, nullptr, smem);
  convT(tidv, bidv, p.in[11] + (size_t)l * 512 * 1536, wb + OW_UQ, 512, 1536, p.in[9] + l * 512, smem);
  convT(tidv, bidv, p.in[12] + (size_t)l * 512 * 2048, wb + OW_UKV, 512, 2048, p.in[10] + l * 512, smem);
  convT(tidv, bidv, p.in[36] + (size_t)l * 1024 * 1024, wb + OW_GLU, 1024, 1024, nullptr, smem);
  for (int d = 0; d < 2; d++) {
    convT(tidv, bidv, p.in[19] + (size_t)(l * 2 + d) * 64 * 1024, wb + OW_W2 + (size_t)d * 65536, 64, 1024, nullptr, smem);
    convT(tidv, bidv, p.in[21] + (size_t)(l * 2 + d) * 64 * 1024, wb + OW_A2 + (size_t)d * 65536, 64, 1024, nullptr, smem);
  }
  convT(tidv, bidv, p.in[22] + (size_t)l * 160 * 1024, wb + OW_G2, 160, 1024, nullptr, smem, 192);
}

DEV void phase_norm(int tidv, int bidv, const float* xlat, const float* xctx, const float* g, const float* mod, int shOff, int scOff, bf16* H, int nrows) {
  int wave = tidv >> 6, lane = tidv & 63;
  for (int row = bidv * NW + wave; row < nrows; row += gridDim.x * NW) {
    const float* x = row < ML ? xlat + (size_t)row * 2048 : xctx + (size_t)(row - ML) * 2048;
    int b = row < ML ? (row >> 12) : 4;
    const float* sh = mod + b * 12288 + shOff;
    const float* sc = mod + b * 12288 + scOff;
    float4 v[8];
    float ss = 0.f;
#pragma unroll
    for (int i = 0; i < 8; i++) {
      v[i] = *(const float4*)(x + i * 256 + lane * 4);
      ss += v[i].x * v[i].x + v[i].y * v[i].y + v[i].z * v[i].z + v[i].w * v[i].w;
    }
    ss = wsum(ss);
    float rinv = rsqrtf(ss * (1.f / 2048.f) + 1e-6f);
#pragma unroll
    for (int i = 0; i < 8; i++) {
      int c = i * 256 + lane * 4;
      float4 g4 = *(const float4*)(g + c), s4 = *(const float4*)(sc + c), h4 = *(const float4*)(sh + c);
      float y0 = v[i].x * rinv * g4.x * (1.f + s4.x) + h4.x;
      float y1 = v[i].y * rinv * g4.y * (1.f + s4.y) + h4.y;
      float y2 = v[i].z * rinv * g4.z * (1.f + s4.z) + h4.z;
      float y3 = v[i].w * rinv * g4.w * (1.f + s4.w) + h4.w;
      uint2 o;
      o.x = pack2(y0, y1);
      o.y = pack2(y2, y3);
      *(uint2*)(H + (size_t)row * 2048 + c) = o;
    }
  }
}

constexpr int LDT = 72;
constexpr int GA_BYTES = 256 * LDT * 2;
constexpr int GSTAGE = 512 * LDT * 2;
constexpr int SM_RINV = 2 * GSTAGE;
constexpr int SM_ITEM = SM_RINV + 1024;
constexpr int LDS_BYTES = SM_ITEM + 16;
DEV float sumsq8(uint4 r) {
  float s = 0.f, x;
  x = bf2f((bf16)(r.x & 0xffff)); s += x * x; x = bf2f((bf16)(r.x >> 16)); s += x * x;
  x = bf2f((bf16)(r.y & 0xffff)); s += x * x; x = bf2f((bf16)(r.y >> 16)); s += x * x;
  x = bf2f((bf16)(r.z & 0xffff)); s += x * x; x = bf2f((bf16)(r.z >> 16)); s += x * x;
  x = bf2f((bf16)(r.w & 0xffff)); s += x * x; x = bf2f((bf16)(r.w >> 16)); s += x * x;
  return s;
}

template <bool ROWNORM>
DEV void gemm_mainloop(int tidv, int bidv, const bf16* __restrict__ A, int lda, bool amap, const bf16* __restrict__ Bt, int K, int N, int m0, int n0,
                       char* smem, f32x16 (&acc)[4][2]) {
  float* srinv = (float*)(smem + SM_RINV);
  const int tid = tidv, lane = tid & 63, wave = tid >> 6;
  const int wm = wave >> 2, wn = wave & 3;
  const int lr = tid >> 3, kc = tid & 7;
  const char* abase = (const char*)(A + (size_t)m0 * lda);
  const char* bbase = (const char*)(Bt + (size_t)n0 * K);
  const uint32_t voa = (uint32_t)(lr * lda + kc * 8) * 2u;
  const uint32_t astep = (uint32_t)(64 * lda) * 2u;
  const uint32_t vob0 = (uint32_t)(lr * K + kc * 8) * 2u;
  const uint32_t bstep = (uint32_t)(64 * K) * 2u;
  const uint32_t lds_st = (uint32_t)(lr * LDT + kc * 8) * 2u;
  const int nk = K >> 6;
  uint4 xa0, xa1, xa2, xa3, xb0, xb1, xb2, xb3;
#define G_LOAD(KT)                                                         \
  {                                                                        \
    const int k0_ = (KT) << 6;                                             \
    const int ka_ = amap ? ((k0_ >> 7) * 192 + (k0_ & 127)) : k0_;         \
    xa0 = *(const uint4*)(abase + (size_t)ka_ * 2 + voa);                  \
    xa1 = *(const uint4*)(abase + (size_t)ka_ * 2 + astep + voa);          \
    xa2 = *(const uint4*)(abase + (size_t)ka_ * 2 + 2 * astep + voa);      \
    xa3 = *(const uint4*)(abase + (size_t)ka_ * 2 + 3 * astep + voa);      \
    xb0 = *(const uint4*)(bbase + (size_t)k0_ * 2 + vob0);                 \
    xb1 = *(const uint4*)(bbase + (size_t)k0_ * 2 + bstep + vob0);         \
    xb2 = *(const uint4*)(bbase + (size_t)k0_ * 2 + 2 * bstep + vob0);     \
    xb3 = *(const uint4*)(bbase + (size_t)k0_ * 2 + 3 * bstep + vob0);     \
  }
#define G_STORE(SN)                                                  \
  *(uint4*)((SN) + lds_st) = xa0;                                    \
  *(uint4*)((SN) + 1 * (64 * LDT * 2) + lds_st) = xa1;               \
  *(uint4*)((SN) + 2 * (64 * LDT * 2) + lds_st) = xa2;               \
  *(uint4*)((SN) + 3 * (64 * LDT * 2) + lds_st) = xa3;               \
  *(uint4*)((SN) + GA_BYTES + lds_st) = xb0;                         \
  *(uint4*)((SN) + GA_BYTES + 1 * (64 * LDT * 2) + lds_st) = xb1;    \
  *(uint4*)((SN) + GA_BYTES + 2 * (64 * LDT * 2) + lds_st) = xb2;    \
  *(uint4*)((SN) + GA_BYTES + 3 * (64 * LDT * 2) + lds_st) = xb3;
  const uint32_t fa = (uint32_t)((wm * 128 + (lane & 31)) * LDT + (lane >> 5) * 8) * 2u;
  const uint32_t fb = (uint32_t)GA_BYTES + (uint32_t)((wn * 64 + (lane & 31)) * LDT + (lane >> 5) * 8) * 2u;
  const int nkm = nk - 1;
  if (ROWNORM) {
    __syncthreads();
#pragma unroll 1
    for (int i = 0; i < 4; i++) {
      float ss = 0.f;
      for (int kk = 0; kk < nk; kk++) ss += sumsq8(*(const uint4*)(abase + (size_t)kk * 128 + i * astep + voa));
      ss += __shfl_xor(ss, 1); ss += __shfl_xor(ss, 2); ss += __shfl_xor(ss, 4);
      if (kc == 0) srinv[lr + 64 * i] = rsqrtf(ss / (float)K + 1e-6f);
    }
  }
  G_LOAD(0)
  __syncthreads();
  G_STORE(smem)
  G_LOAD((1 < nkm ? 1 : nkm))
  __syncthreads();
#define G_FRAG(P, ST, KS)                                                            \
  P##a0 = *(const bf16x8*)((ST) + fa + 0 * (32 * LDT * 2) + (KS) * 32);                \
  P##a1 = *(const bf16x8*)((ST) + fa + 1 * (32 * LDT * 2) + (KS) * 32);                \
  P##a2 = *(const bf16x8*)((ST) + fa + 2 * (32 * LDT * 2) + (KS) * 32);                \
  P##a3 = *(const bf16x8*)((ST) + fa + 3 * (32 * LDT * 2) + (KS) * 32);                \
  P##b0 = *(const bf16x8*)((ST) + fb + 0 * (32 * LDT * 2) + (KS) * 32);                \
  P##b1 = *(const bf16x8*)((ST) + fb + 1 * (32 * LDT * 2) + (KS) * 32);
#define G_MMA(P)                                                                              \
  acc[0][0] = __builtin_amdgcn_mfma_f32_32x32x16_bf16(P##b0, P##a0, acc[0][0], 0, 0, 0);      \
  acc[0][1] = __builtin_amdgcn_mfma_f32_32x32x16_bf16(P##b1, P##a0, acc[0][1], 0, 0, 0);      \
  acc[1][0] = __builtin_amdgcn_mfma_f32_32x32x16_bf16(P##b0, P##a1, acc[1][0], 0, 0, 0);      \
  acc[1][1] = __builtin_amdgcn_mfma_f32_32x32x16_bf16(P##b1, P##a1, acc[1][1], 0, 0, 0);      \
  acc[2][0] = __builtin_amdgcn_mfma_f32_32x32x16_bf16(P##b0, P##a2, acc[2][0], 0, 0, 0);      \
  acc[2][1] = __builtin_amdgcn_mfma_f32_32x32x16_bf16(P##b1, P##a2, acc[2][1], 0, 0, 0);      \
  acc[3][0] = __builtin_amdgcn_mfma_f32_32x32x16_bf16(P##b0, P##a3, acc[3][0], 0, 0, 0);      \
  acc[3][1] = __builtin_amdgcn_mfma_f32_32x32x16_bf16(P##b1, P##a3, acc[3][1], 0, 0, 0);
  bf16x8 pa0, pa1, pa2, pa3, pb0, pb1, qa0, qa1, qa2, qa3, qb0, qb1;
#pragma unroll 1
  for (int kt = 0; kt < nk; kt++) {
    const char* st = smem + (kt & 1) * GSTAGE;
    char* sn = smem + ((kt + 1) & 1) * GSTAGE;
    if (!ROWNORM) {
      G_FRAG(p, st, 0)
      G_FRAG(q, st, 1)
      __builtin_amdgcn_sched_barrier(0);
      G_MMA(p)
      __builtin_amdgcn_sched_barrier(0);
      G_FRAG(p, st, 2)
      __builtin_amdgcn_sched_barrier(0);
      G_MMA(q)
      __builtin_amdgcn_sched_barrier(0);
      G_FRAG(q, st, 3)
      if (kt + 1 < nk) { G_STORE(sn) }
      G_LOAD((kt + 2 < nkm ? kt + 2 : nkm))
      __builtin_amdgcn_sched_barrier(0);
      G_MMA(p)
      __builtin_amdgcn_sched_barrier(0);
      G_MMA(q)
    } else {
      G_FRAG(p, st, 0)
      __builtin_amdgcn_sched_barrier(0);
      G_MMA(p)
      __builtin_amdgcn_sched_barrier(0);
      G_FRAG(p, st, 1)
      __builtin_amdgcn_sched_barrier(0);
      G_MMA(p)
      __builtin_amdgcn_sched_barrier(0);
      G_FRAG(p, st, 2)
      if (kt + 1 < nk) { G_STORE(sn) }
      G_LOAD((kt + 2 < nkm ? kt + 2 : nkm))
      __builtin_amdgcn_sched_barrier(0);
      G_MMA(p)
      __builtin_amdgcn_sched_barrier(0);
      G_FRAG(p, st, 3)
      __builtin_amdgcn_sched_barrier(0);
      G_MMA(p)
    }
    __syncthreads();
  }
#undef G_FRAG
#undef G_MMA
#undef G_LOAD
#undef G_STORE
}

DEV void zero_acc(f32x16 (&acc)[4][2]) {
#pragma unroll
  for (int i = 0; i < 4; i++)
#pragma unroll
    for (int j = 0; j < 2; j++)
#pragma unroll
      for (int e = 0; e < 16; e++) acc[i][j][e] = 0.f;
}

template <class F>
DEV void epi_loop(int tidv, int bidv, f32x16 (&acc)[4][2], int m0, int n0, int N, F f) {
  const int lane = tidv & 63, wave = tidv >> 6;
  const int wm = wave >> 2, wn = wave & 3;
#pragma unroll
  for (int i = 0; i < 4; i++) {
    const int lrow = wm * 128 + i * 32 + (lane & 31);
#pragma unroll
    for (int j = 0; j < 2; j++) {
#pragma unroll
      for (int g = 0; g < 4; g++) {
        int col = n0 + wn * 64 + j * 32 + 8 * g + 4 * (lane >> 5);
        f32x4 v = {acc[i][j][4 * g], acc[i][j][4 * g + 1], acc[i][j][4 * g + 2], acc[i][j][4 * g + 3]};
        if (col < N) f(m0 + lrow, lrow, col, v);
      }
    }
    __builtin_amdgcn_sched_barrier(0);
  }
}

DEV uint2 pack4(f32x4 v) {
  uint2 o;
  o.x = pack2(v[0], v[1]);
  o.y = pack2(v[2], v[3]);
  return o;
}
DEV f32x4 unpack4(uint2 u) {
  f32x4 v;
  v[0] = bf2f((bf16)(u.x & 0xffff)); v[1] = bf2f((bf16)(u.x >> 16));
  v[2] = bf2f((bf16)(u.y & 0xffff)); v[3] = bf2f((bf16)(u.y >> 16));
  return v;
}

enum { G_IN = 0, G_UQ, G_UKV, G_W2, G_A2, G_G2, G_GLU, G_OUT, G_M1, G_M2, G_MG0, G_MG1, G_MG2 };

template <int MODE>
DEV void run_gemm(int tidv, int bidv, const Params& p, int l, char* smem, const bf16* A, int lda, const bf16* Bt, int K, int N, int M, int aux,
                  const float* xin_lat, const float* xin_ctx, float* xout_lat, float* xout_ctx) {
  const int nt = (N + 255) >> 8, mt = M >> 8;
  char* ws = p.ws;
  bf16* Z = (bf16*)(ws + B_ZB);
  const float* srinv = (const float*)(smem + SM_RINV);
  const float* mod = (const float*)(ws + B_MOD) + (size_t)l * 5 * 12288;
  for (int tile = bidv; tile < nt * mt; tile += gridDim.x) {
    int m0 = (tile / nt) << 8, n0 = (tile % nt) << 8;
    f32x16 acc[4][2];
    zero_acc(acc);
    gemm_mainloop<(MODE == G_UQ || MODE == G_UKV)>(tidv, bidv, A, lda, MODE == G_MG0, Bt, K, N, m0, n0, smem, acc);
    if constexpr (MODE != G_OUT && MODE != G_M2)
    epi_loop(tidv, bidv, acc, m0, n0, N, [&](int row, int lrow, int col, f32x4 v) {
      if constexpr (MODE == G_IN) {
        f32x4 o = v;
        if (col >= C_GATE || (col >= C_GD && col < C_U)) {
#pragma unroll
          for (int r = 0; r < 4; r++) o[r] = sigmoidf_(v[r]);
        } else if (col >= C_WD && col < C_AD) {
#pragma unroll
          for (int r = 0; r < 4; r++) o[r] = tanhf(v[r]);
        }
        *(uint2*)(smem + ((size_t)lrow * 264 + (col - n0)) * 2) = pack4(o);
      } else if constexpr (MODE == G_UQ) {
        float ri = srinv[lrow];
        *(uint2*)((bf16*)(ws + B_QB) + (size_t)row * 1536 + col) = pack4(v * ri);
      } else if constexpr (MODE == G_UKV) {
        float ri = srinv[lrow];
        f32x4 o = v * ri;
        int h = col >> 8, c = col & 255;
        if (c < 128) {
          *(uint2*)((bf16*)(ws + B_KN) + (size_t)row * 1024 + h * 128 + c) = pack4(o);
        } else {
          int b, kp;
          if (row < ML) { b = row >> 12; kp = row & 4095; } else { int r2 = row - ML; b = r2 >> 8; kp = 4096 + (r2 & 255); }
          bf16* vt = (bf16*)(ws + B_VT) + ((size_t)((b * 8 + h) * 128 + (c - 128))) * NKEY + kp;
#pragma unroll
          for (int r = 0; r < 4; r++) vt[(size_t)r * NKEY] = f2bf(o[r]);
        }
      } else if constexpr (MODE == G_W2) {
        float4 w0 = *(const float4*)(p.in[18] + (l * 2 + aux) * 1024 + col);
        f32x4 o;
        o[0] = 0.60653066f * sigmoidf_(w0.x + v[0]);
        o[1] = 0.60653066f * sigmoidf_(w0.y + v[1]);
        o[2] = 0.60653066f * sigmoidf_(w0.z + v[2]);
        o[3] = 0.60653066f * sigmoidf_(w0.w + v[3]);
        *(uint2*)((bf16*)(ws + B_HB + (size_t)aux * SZ1K) + (size_t)row * 1024 + col) = pack4(o);
      } else if constexpr (MODE == G_A2) {
        float4 a0 = *(const float4*)(p.in[20] + (l * 2 + aux) * 1024 + col);
        f32x4 o;
        o[0] = sigmoidf_(a0.x + v[0]);
        o[1] = sigmoidf_(a0.y + v[1]);
        o[2] = sigmoidf_(a0.z + v[2]);
        o[3] = sigmoidf_(a0.w + v[3]);
        *(uint2*)((bf16*)(ws + (aux ? B_AB : B_AF)) + (size_t)row * 1024 + col) = pack4(o);
      } else if constexpr (MODE == G_G2) {
        *(uint2*)((bf16*)(ws + B_GB) + (size_t)row * 1024 + col) = pack4(v);
      } else if constexpr (MODE == G_GLU) {
        f32x4 zz = unpack4(*(const uint2*)((const bf16*)(ws + B_SY) + (size_t)row * 1024 + col));
        float4 gb = *(const float4*)(p.in[37] + l * 1024 + col);
        f32x4 o;
        o[0] = zz[0] * sigmoidf_(v[0] + gb.x);
        o[1] = zz[1] * sigmoidf_(v[1] + gb.y);
        o[2] = zz[2] * sigmoidf_(v[2] + gb.z);
        o[3] = zz[3] * sigmoidf_(v[3] + gb.w);
        *(uint2*)(smem + ((size_t)lrow * 264 + (col - n0)) * 2) = pack4(o);
      } else if constexpr (MODE == G_OUT || MODE == G_M2) {
      } else if constexpr (MODE == G_M1) {
        f32x4 o;
#pragma unroll
        for (int r = 0; r < 4; r++) { float t = fmaxf(v[r], 0.f); o[r] = t * t; }
        *(uint2*)(smem + ((size_t)lrow * 264 + (col - n0)) * 2) = pack4(o);
      } else if constexpr (MODE == G_MG0 || MODE == G_MG1 || MODE == G_MG2) {
        *(uint2*)(smem + ((size_t)lrow * 264 + (col - n0)) * 2) = pack4(v);
      }
    });
    if constexpr (MODE == G_OUT || MODE == G_M2) {
      float* tilef = (float*)smem;
      constexpr int GOFF = (MODE == G_OUT) ? 4096 : 10240;
      const int wn_ = (tidv >> 6) & 3;
#pragma unroll 1
      for (int half = 0; half < 2; half++) {
        if ((wn_ >> 1) == half) {
          epi_loop(tidv, bidv, acc, m0, n0, N, [&](int row, int lrow, int col, f32x4 v) {
            *(f32x4*)(tilef + (size_t)lrow * 132 + (col - n0 - half * 128)) = v;
          });
        }
        __syncthreads();
#pragma unroll 2
        for (int it = 0; it < 16; it++) {
          int c = it * NT + tidv;
          int r = c >> 5, ch = c & 31;
          int row = m0 + r, col = n0 + half * 128 + ch * 4;
          int b = row < ML ? (row >> 12) : 4;
          float4 g = *(const float4*)(mod + b * 12288 + GOFF + col);
          const float* xi;
          if constexpr (MODE == G_OUT) xi = row < ML ? xin_lat + (size_t)row * 2048 : xin_ctx + (size_t)(row - ML) * 2048;
          else xi = row < ML ? xout_lat + (size_t)row * 2048 : xout_ctx + (size_t)(row - ML) * 2048;
          float* xo = row < ML ? xout_lat + (size_t)row * 2048 : xout_ctx + (size_t)(row - ML) * 2048;
          float4 x = *(const float4*)(xi + col);
          f32x4 v = *(const f32x4*)(tilef + (size_t)r * 132 + ch * 4);
          x.x += g.x * v[0]; x.y += g.y * v[1]; x.z += g.z * v[2]; x.w += g.w * v[3];
          *(float4*)(xo + col) = x;
        }
        __syncthreads();
      }
    }
    if constexpr (MODE == G_MG0 || MODE == G_MG1 || MODE == G_MG2) {
      constexpr int nb = MODE - G_MG0;
      bf16* MG = (bf16*)(ws + B_HB);
      __syncthreads();
#pragma unroll 2
      for (int it = 0; it < 16; it++) {
        int c = it * NT + tidv;
        int r = c >> 5, ch = c & 31;
        int col = n0 + ch * 8;
        uint4 pv = *(const uint4*)(smem + ((size_t)r * 264 + ch * 8) * 2);
        uint4 gv = *(const uint4*)(Z + (size_t)(m0 + r) * NIN + C_GATE + nb * 2048 + col);
        f32x4 p0 = unpack4(uint2{pv.x, pv.y}), p1 = unpack4(uint2{pv.z, pv.w});
        f32x4 g0 = unpack4(uint2{gv.x, gv.y}), g1 = unpack4(uint2{gv.z, gv.w});
        f32x4 o0 = g0 * p0, o1 = g1 * p1;
        if constexpr (nb > 0) {
          uint4 qv = *(const uint4*)(MG + (size_t)(m0 + r) * 2048 + col);
          o0 += unpack4(uint2{qv.x, qv.y});
          o1 += unpack4(uint2{qv.z, qv.w});
        }
        uint2 a = pack4(o0), b = pack4(o1);
        *(uint4*)(MG + (size_t)(m0 + r) * 2048 + col) = uint4{a.x, a.y, b.x, b.y};
      }
    }
    if constexpr (MODE == G_IN || MODE == G_GLU || MODE == G_M1) {
      bf16* dst;
      int ld;
      if constexpr (MODE == G_IN || MODE == G_GLU) { dst = Z; ld = NIN; }
      else { dst = Z; ld = DFF; }
      __syncthreads();
#pragma unroll 4
      for (int it = 0; it < 16; it++) {
        int c = it * NT + tidv;
        int r = c >> 5, ch = c & 31;
        int col = n0 + ch * 8;
        if (col < N) *(uint4*)(dst + (size_t)(m0 + r) * ld + col) = *(const uint4*)(smem + ((size_t)r * 264 + ch * 8) * 2);
      }
    }
  }
}

DEV void phase_mla_post(int tidv, int bidv, const Params& p, int l) {
  char* ws = p.ws;
  const float* qng = p.in[13] + l * 128;
  const float* qrg = p.in[14] + l * 64;
  const float* kng = p.in[15] + l * 128;
  const float* krg = p.in[16] + l * 64;
  bf16* QB = (bf16*)(ws + B_QB);
  bf16* KN = (bf16*)(ws + B_KN);
  bf16* KR = (bf16*)(ws + B_KR);
  const bf16* Z = (const bf16*)(ws + B_ZB);
  const int wave = tidv >> 6, lane = tidv & 63;
  const float QS = 1.4426950408889634f * 0.07216878364870322f;
  const int idx = lane & 31;
  const float inv = powf(10000.f, -(float)(idx & 15) / 16.f);
  const float gq0 = qng[2 * lane], gq1 = qng[2 * lane + 1], gk0 = kng[2 * lane], gk1 = kng[2 * lane + 1];
  const float gqr = qrg[lane], gkr = krg[lane];
  for (int row = bidv * NW + wave; row < MT; row += gridDim.x * NW) {
    bool lat = row < ML;
    int t = row & 4095;
    float pos = (idx < 16) ? (float)(t >> 6) : (float)(t & 63);
    float ang = pos * inv;
    float cs = 1.f, sn = 0.f;
    if (lat) { cs = cosf(ang); sn = sinf(ang); }
#pragma unroll 1
    for (int h = 0; h < 8; h++) {
      bf16* q = QB + (size_t)row * 1536 + h * 192;
      uint32_t u = *(const uint32_t*)(q + 2 * lane);
      float x0 = bf2f((bf16)(u & 0xffff)), x1 = bf2f((bf16)(u >> 16));
      float ss = wsum(x0 * x0 + x1 * x1);
      float rinv = rsqrtf(ss * (1.f / 128.f) + 1e-6f) * QS;
      *(uint32_t*)(q + 2 * lane) = pack2(x0 * rinv * gq0, x1 * rinv * gq1);
      float xr = bf2f(q[128 + lane]);
      float ss2 = wsum(xr * xr);
      float y = xr * rsqrtf(ss2 * (1.f / 64.f) + 1e-6f) * gqr;
      float yp = __shfl_xor(y, 32);
      float o = lane < 32 ? (y * cs - yp * sn) : (yp * sn + y * cs);
      q[128 + lane] = f2bf(o * QS);
      bf16* k = KN + (size_t)row * 1024 + h * 128;
      uint32_t uk = *(const uint32_t*)(k + 2 * lane);
      float k0 = bf2f((bf16)(uk & 0xffff)), k1 = bf2f((bf16)(uk >> 16));
      float ssk = wsum(k0 * k0 + k1 * k1);
      float rk = rsqrtf(ssk * (1.f / 128.f) + 1e-6f);
      *(uint32_t*)(k + 2 * lane) = pack2(k0 * rk * gk0, k1 * rk * gk1);
    }
    {
      float xr = bf2f(Z[(size_t)row * NIN + C_KR + lane]);
      float ss2 = wsum(xr * xr);
      float y = xr * rsqrtf(ss2 * (1.f / 64.f) + 1e-6f) * gkr;
      float yp = __shfl_xor(y, 32);
      float o = lane < 32 ? (y * cs - yp * sn) : (yp * sn + y * cs);
      KR[(size_t)row * 64 + lane] = f2bf(o);
    }
  }
}

DEV void step_row(int s, int d, int b, int& row, int& tau, int& len) {
  if (s < 256) { tau = d ? 255 - s : s; len = 256; row = ML + b * 256 + tau; }
  else { int q = s - 256; tau = d ? 4095 - q : q; len = 4096; row = b * 4096 + tau; }
}

struct RwPre { bf16 r0, r1, r2, k0, k1, k2, v0, v1, v2, a, e; };

DEV void rwkv_fetch(RwPre& q, const bf16* Z, const bf16* AD, const bf16* ED, int s, int d, int b, int ch) {
  int row, tau, len;
  step_row(s, d, b, row, tau, len);
  const bf16* z = Z + (size_t)row * NIN + C_R + ch;
  q.r1 = z[0]; q.k1 = z[1024]; q.v1 = z[2048];
  q.r0 = 0; q.k0 = 0; q.v0 = 0; q.r2 = 0; q.k2 = 0; q.v2 = 0;
  if (tau > 0) { const bf16* zm = z - NIN; q.r0 = zm[0]; q.k0 = zm[1024]; q.v0 = zm[2048]; }
  if (tau < len - 1) { const bf16* zp = z + NIN; q.r2 = zp[0]; q.k2 = zp[1024]; q.v2 = zp[2048]; }
  q.a = AD[(size_t)row * 1024 + ch];
  q.e = ED[(size_t)row * 1024 + ch];
}

typedef float f2v __attribute__((ext_vector_type(2)));
DEV float dpp_hmirror(float v) {
  int i = __float_as_int(v);
  return __int_as_float(__builtin_amdgcn_update_dpp(0, i, 0x141, 0xF, 0xF, true));
}
DEV f2v lo2(float4 v) { return f2v{v.x, v.y}; }
DEV f2v hi2(float4 v) { return f2v{v.z, v.w}; }

DEV void rwkv_scan(int tidv, int bidv, const Params& p, int l, int chain, char* smem, int dry) {
  char* ws = p.ws;
  float* op = (float*)smem;
  float* vb = op + 16 * 320;
  float* yb = vb + 16 * 64;
  const int tid = tidv, wave = tid >> 6, lane = tid & 63;
  const int d = chain & 1, h = (chain >> 1) & 15, b = chain >> 5;
  const int ch = h * 64 + lane;
  const float* cw = p.in[17] + (size_t)l * 3 * 3072;
  const float cr0 = cw[ch], cr1 = cw[3072 + ch], cr2 = cw[6144 + ch];
  const float ck0 = cw[1024 + ch], ck1 = cw[3072 + 1024 + ch], ck2 = cw[6144 + 1024 + ch];
  const float cv0 = cw[2048 + ch], cv1 = cw[3072 + 2048 + ch], cv2 = cw[6144 + 2048 + ch];
  const float kkc = p.in[23][l * 1024 + ch], kac = p.in[24][l * 1024 + ch];
  const bf16* Z = (const bf16*)(ws + B_ZB);
  bf16* ED = (bf16*)(ws + B_HB + (size_t)d * SZ1K);
  const bf16* AD = (const bf16*)(ws + (d ? B_AB : B_AF));
  f2v A0 = {0.f, 0.f}, A1 = {0.f, 0.f}, B0 = {0.f, 0.f}, B1 = {0.f, 0.f};
  const int ri = lane >> 4, jo = lane & 15, rA = wave * 8 + ri, rB = rA + 4;
  RwPre pre[2];
#pragma unroll
  for (int si = 0; si < 2; si++) rwkv_fetch(pre[si], Z, AD, ED, wave * 2 + si, d, b, ch);
  for (int chunk = 0; chunk < 272; chunk++) {
#pragma unroll
    for (int si = 0; si < 2; si++) {
      int t = wave * 2 + si;
      const RwPre& q = pre[si];
      float rr = cr0 * bf2f(q.r0) + cr1 * bf2f(q.r1) + cr2 * bf2f(q.r2);
      float kk_ = ck0 * bf2f(q.k0) + ck1 * bf2f(q.k1) + ck2 * bf2f(q.k2);
      float vv = cv0 * bf2f(q.v0) + cv1 * bf2f(q.v1) + cv2 * bf2f(q.v2);
      float kkv = kk_ * kkc;
      float ssq = wsum_fast(kkv * kkv);
      float kn = kkv * rsqrtf(ssq + 1e-12f);
      float a = bf2f(q.a);
      float w = __expf(-bf2f(q.e));
      float krep = kk_ * (1.f + (a - 1.f) * kac);
      float* o = op + t * 320;
      o[lane] = w;
      o[64 + lane] = kn * a;
      o[128 + lane] = krep;
      o[192 + lane] = -kn;
      o[256 + lane] = rr;
      vb[t * 64 + lane] = vv;
    }
    __syncthreads();
    if (chunk + 1 < 272) {
#pragma unroll
      for (int si = 0; si < 2; si++) rwkv_fetch(pre[si], Z, AD, ED, (chunk + 1) * 16 + wave * 2 + si, d, b, ch);
    }
    {
      const float4* o4 = (const float4*)op + jo;
      float4 nn = o4[48];
#pragma unroll 4
      for (int t = 0; t < 16; t++) {
        const float4* ot = o4 + t * 80;
        const float4 w = ot[0], a = ot[16], k = ot[32], r = ot[64];
        const float viA = vb[t * 64 + rA], viB = vb[t * 64 + rB];
        const int tn = t < 15 ? t + 1 : 15;
        const float4 mm = o4[tn * 80 + 48];
        f2v svA = A0 * lo2(nn) + A1 * hi2(nn);
        f2v svB = B0 * lo2(nn) + B1 * hi2(nn);
        float saA = svA.x + svA.y, saB = svB.x + svB.y;
        saA += dpp_xor1(saA); saB += dpp_xor1(saB);
        saA += dpp_xor2(saA); saB += dpp_xor2(saB);
        saA += dpp_hmirror(saA); saB += dpp_hmirror(saB);
        saA += dpp_rmirror(saA); saB += dpp_rmirror(saB);
        const f2v sA2 = {saA, saA}, vA2 = {viA, viA}, sB2 = {saB, saB}, vB2 = {viB, viB};
        A0 = A0 * lo2(w) + sA2 * lo2(a) + vA2 * lo2(k);
        B0 = B0 * lo2(w) + sB2 * lo2(a) + vB2 * lo2(k);
        A1 = A1 * hi2(w) + sA2 * hi2(a) + vA2 * hi2(k);
        B1 = B1 * hi2(w) + sB2 * hi2(a) + vB2 * hi2(k);
        f2v yvA = A0 * lo2(r) + A1 * hi2(r);
        f2v yvB = B0 * lo2(r) + B1 * hi2(r);
        yb[(t * 64 + rA) * 16 + jo] = yvA.x + yvA.y;
        yb[(t * 64 + rB) * 16 + jo] = yvB.x + yvB.y;
        nn = mm;
      }
    }
    __syncthreads();
#pragma unroll
    for (int it = 0; it < 2; it++) {
      int idx = it * NT + tid;
      int t = idx >> 6, i = idx & 63;
      int row, tau, len;
      step_row(chunk * 16 + t, d, b, row, tau, len);
      size_t off = (size_t)row * 1024 + h * 64 + i;
      bf16* yd = dry ? (bf16*)(ws + B_END) + (off & 0x3fffff) : ED + off;
      const float4* yp = (const float4*)(yb + (t * 64 + i) * 16);
      const float4 ya = yp[0], yc = yp[1], ye = yp[2], yg = yp[3];
      *yd = f2bf((((ya.x + ya.y) + (ya.z + ya.w)) + ((yc.x + yc.y) + (yc.z + yc.w))) + (((ye.x + ye.y) + (ye.z + ye.w)) + ((yg.x + yg.y) + (yg.z + yg.w))));
    }
  }
}

DEV void s5_scan(int tidv, int bidv, const Params& p, int l, int chain, char* smemw, int dry) {
  char* ws = p.ws;
  const int lane = tidv & 63;
  const int d = chain & 1, g = (chain >> 1) & 63, b = chain >> 7;
  float* ub = (float*)smemw;
  float* hb = ub + 256;
  const size_t pg = (size_t)(l * 2 + d) * 64 + g;
  const float lre = p.in[28][pg * 64 + lane], lim = p.in[29][pg * 64 + lane];
  const float dt = expf(p.in[30][pg]);
  const float mag = expf(lre * dt);
  const float are = mag * cosf(lim * dt), aim = mag * sinf(lim * dt);
  const float den = lre * lre + lim * lim;
  const float qre = ((are - 1.f) * lre + aim * lim) / den;
  const float qim = (aim * lre - (are - 1.f) * lim) / den;
  float bbre[16], bbim[16];
  {
    const float* br = p.in[31] + (pg * 64 + lane) * 16;
    const float* bi = p.in[32] + (pg * 64 + lane) * 16;
#pragma unroll
    for (int i = 0; i < 16; i++) {
      float x = br[i], y = bi[i];
      bbre[i] = qre * x - qim * y;
      bbim[i] = qre * y + qim * x;
    }
  }
  bf16x8 cfr[4];
  {
    const int i = lane & 15, quad = lane >> 4;
    const float* cre = p.in[33] + (pg * 16 + i) * 64;
    const float* cim = p.in[34] + (pg * 16 + i) * 64;
#pragma unroll
    for (int ks = 0; ks < 4; ks++)
#pragma unroll
      for (int j = 0; j < 8; j++) {
        int k = ks * 32 + quad * 8 + j;
        float c = ks < 2 ? cre[k] : -cim[k - 64];
        cfr[ks][j] = (short)f2bf(c);
      }
  }
  float hre = 0.f, him = 0.f;
  const bf16* Z = (const bf16*)(ws + B_ZB);
  const int tt = lane >> 2, i0 = (lane & 3) * 4;
  uint2 unext;
  {
    int row, tau, len;
    step_row(tt, d, b, row, tau, len);
    unext = *(const uint2*)(Z + (size_t)row * NIN + C_U + g * 16 + i0);
  }
  for (int chunk = 0; chunk < 272; chunk++) {
    {
      uint2 u = unext;
      float4 f;
      f.x = bf2f((bf16)(u.x & 0xffff)); f.y = bf2f((bf16)(u.x >> 16));
      f.z = bf2f((bf16)(u.y & 0xffff)); f.w = bf2f((bf16)(u.y >> 16));
      *(float4*)(ub + tt * 16 + i0) = f;
    }
    __syncthreads();
    if (chunk + 1 < 272) {
      int row, tau, len;
      step_row((chunk + 1) * 16 + tt, d, b, row, tau, len);
      unext = *(const uint2*)(Z + (size_t)row * NIN + C_U + g * 16 + i0);
    }
#pragma unroll 2
    for (int t = 0; t < 16; t++) {
      const float* u = ub + t * 16;
      float br0 = 0.f, bi0 = 0.f;
#pragma unroll
      for (int i = 0; i < 16; i++) { float uv = u[i]; br0 += bbre[i] * uv; bi0 += bbim[i] * uv; }
      float nr = are * hre - aim * him + br0;
      float ni = are * him + aim * hre + bi0;
      hre = nr; him = ni;
      hb[t * 132 + lane] = hre;
      hb[t * 132 + 64 + lane] = him;
    }
    __syncthreads();
    {
      f32x4 yacc = {0.f, 0.f, 0.f, 0.f};
      const float* hr = hb + (lane & 15) * 132 + (lane >> 4) * 8;
#pragma unroll
      for (int ks = 0; ks < 4; ks++) {
        float4 x0 = *(const float4*)(hr + ks * 32), x1 = *(const float4*)(hr + ks * 32 + 4);
        union { bf16x8 v; uint32_t u[4]; } af;
        af.u[0] = pack2(x0.x, x0.y); af.u[1] = pack2(x0.z, x0.w);
        af.u[2] = pack2(x1.x, x1.y); af.u[3] = pack2(x1.z, x1.w);
        yacc = __builtin_amdgcn_mfma_f32_16x16x32_bf16(af.v, cfr[ks], yacc, 0, 0, 0);
      }
      const int ii = lane & 15;
#pragma unroll
      for (int r = 0; r < 4; r++) {
        int row, tau, len;
        step_row(chunk * 16 + (lane >> 4) * 4 + r, d, b, row, tau, len);
        bf16* dst = d == 0 ? (bf16*)(ws + B_SY) + (size_t)row * 1024 + g * 16 + ii : (bf16*)(ws + B_ZB) + (size_t)row * NIN + g * 16 + ii;
        if (dry) dst = (bf16*)(ws + B_END) + ((((size_t)row * 1024 + g * 16 + ii)) & 0x3fffff);
        *dst = f2bf(yacc[r]);
      }
    }
    __syncthreads();
  }
}

DEV int perm23(int r) { return (r & 0x13) | ((r & 4) << 1) | ((r & 8) >> 1); }

DEV void attn_item(int tidv, int bidv, const Params& p, int item, bool ctxq, char* smem, int dry) {
  char* ws = p.ws;
  bf16* sK = (bf16*)smem;
  bf16* sV = sK + 64 * 200;
  const int tid = tidv, wave = tid >> 6, lane = tid & 63;
  const int r = lane & 31, hf = lane >> 5;
  int b, hd, qt;
  if (!ctxq) { b = item >> 7; hd = (item >> 4) & 7; qt = item & 15; }
  else { b = item >> 3; hd = item & 7; qt = 0; }
  const int qrow0 = ctxq ? ML + b * 256 : b * 4096 + qt * 256;
  const int kt0 = ctxq ? 64 : 0, kt1 = 68;
  bf16* QB = (bf16*)(ws + B_QB);
  const bf16* KN = (const bf16*)(ws + B_KN);
  const bf16* KR = (const bf16*)(ws + B_KR);
  const bf16* VT = (const bf16*)(ws + B_VT);
  bf16x8 qf[12];
  {
    const bf16* qp = QB + (size_t)(qrow0 + wave * 32 + r) * 1536 + hd * 192 + hf * 8;
#pragma unroll
    for (int kk = 0; kk < 12; kk++) qf[kk] = *(const bf16x8*)(qp + kk * 16);
  }
  f32x16 oacc[4];
#pragma unroll
  for (int i = 0; i < 4; i++)
#pragma unroll
    for (int e = 0; e < 16; e++) oacc[i][e] = 0.f;
  float mrun = -1e30f, lrun = 0.f;
  const int pr = perm23(r);
  const uint32_t vo_n = (uint32_t)((tid >> 4) * 2048 + (tid & 15) * 16);
  const uint32_t lo_n = (uint32_t)((tid >> 4) * 400 + (tid & 15) * 16);
  const uint32_t vo_r = (uint32_t)((tid >> 3) * 128 + (tid & 7) * 16);
  const uint32_t lo_r = (uint32_t)((tid >> 3) * 400 + 256 + (tid & 7) * 16);
  const uint32_t vo_v = (uint32_t)((tid >> 3) * (NKEY * 2) + (tid & 7) * 16);
  const uint32_t lo_v = (uint32_t)((tid >> 3) * 144 + (tid & 7) * 16);
  uint4 t0, t1, t4, u0, u1;
#define ATT_LOAD(KT)                                                                                   \
  {                                                                                                    \
    const int key0_ = (KT) * 64;                                                                       \
    const int rowbase_ = key0_ < 4096 ? b * 4096 + key0_ : ML + b * 256 + (key0_ - 4096);               \
    const char* bk = (const char*)(KN + (size_t)rowbase_ * 1024 + hd * 128);                           \
    const char* br = (const char*)(KR + (size_t)rowbase_ * 64);                                        \
    const char* bv = (const char*)(VT + ((size_t)((b * 8 + hd) * 128)) * NKEY + key0_);                \
    t0 = *(const uint4*)(bk + vo_n);                                                                   \
    t1 = *(const uint4*)(bk + 32 * 2048 + vo_n);                                                       \
    t4 = *(const uint4*)(br + vo_r);                                                                   \
    u0 = *(const uint4*)(bv + vo_v);                                                                   \
    u1 = *(const uint4*)(bv + (size_t)64 * NKEY * 2 + vo_v);                                           \
  }
  ATT_LOAD(kt0)
  for (int kt = kt0; kt < kt1; kt++) {
    __syncthreads();
    *(uint4*)((char*)sK + lo_n) = t0;
    *(uint4*)((char*)sK + 32 * 400 + lo_n) = t1;
    *(uint4*)((char*)sK + lo_r) = t4;
    *(uint4*)((char*)sV + lo_v) = u0;
    *(uint4*)((char*)sV + 64 * 144 + lo_v) = u1;
    __syncthreads();
    ATT_LOAD((kt + 1 < kt1 ? kt + 1 : kt1 - 1))
    f32x16 sacc[2];
#pragma unroll
    for (int m = 0; m < 2; m++) {
#pragma unroll
      for (int e = 0; e < 16; e++) sacc[m][e] = 0.f;
      const bf16* kp = sK + (m * 32 + pr) * 200 + hf * 8;
#pragma unroll
      for (int kk = 0; kk < 12; kk++) {
        bf16x8 kf = *(const bf16x8*)(kp + kk * 16);
        sacc[m] = __builtin_amdgcn_mfma_f32_32x32x16_bf16(kf, qf[kk], sacc[m], 0, 0, 0);
        if ((kk & 3) == 3) __builtin_amdgcn_sched_barrier(0);
      }
      __builtin_amdgcn_sched_barrier(0);
    }
    float tmax = sacc[0][0];
#pragma unroll
    for (int e = 1; e < 16; e++) tmax = fmaxf(tmax, sacc[0][e]);
#pragma unroll
    for (int e = 0; e < 16; e++) tmax = fmaxf(tmax, sacc[1][e]);
    tmax = fmaxf(tmax, __shfl_xor(tmax, 32));
    float mnew = fmaxf(mrun, tmax);
    float alpha = __builtin_amdgcn_exp2f(mrun - mnew);
    mrun = mnew;
    float psum = 0.f;
#pragma unroll
    for (int m = 0; m < 2; m++)
#pragma unroll
      for (int e = 0; e < 16; e++) { float pv = __builtin_amdgcn_exp2f(sacc[m][e] - mnew); sacc[m][e] = pv; psum += pv; }
    lrun = lrun * alpha + psum;
#pragma unroll
    for (int i = 0; i < 4; i++)
#pragma unroll
      for (int e = 0; e < 16; e++) oacc[i][e] *= alpha;
#pragma unroll
    for (int s = 0; s < 4; s++) {
      const int m = s >> 1, s2 = s & 1;
      bf16x8 pf;
#pragma unroll
      for (int j = 0; j < 8; j++) pf[j] = (short)f2bf(sacc[m][8 * s2 + j]);
#pragma unroll
      for (int i = 0; i < 4; i++) {
        bf16x8 vf = *(const bf16x8*)(sV + (i * 32 + r) * 72 + m * 32 + s2 * 16 + hf * 8);
        oacc[i] = __builtin_amdgcn_mfma_f32_32x32x16_bf16(vf, pf, oacc[i], 0, 0, 0);
      }
      __builtin_amdgcn_sched_barrier(0);
    }
  }
#undef ATT_LOAD
  lrun += __shfl_xor(lrun, 32);
  const float inv = 1.f / lrun;
  bf16* op = QB + (size_t)(qrow0 + wave * 32 + r) * 1536 + hd * 192;
  if (dry) op = (bf16*)(ws + B_END) + ((((size_t)(qrow0 + wave * 32 + r) * 1536 + hd * 192)) & 0x3ffff8);
#pragma unroll
  for (int i = 0; i < 4; i++)
#pragma unroll
    for (int g = 0; g < 4; g++) {
      uint2 o;
      o.x = pack2(oacc[i][4 * g] * inv, oacc[i][4 * g + 1] * inv);
      o.y = pack2(oacc[i][4 * g + 2] * inv, oacc[i][4 * g + 3] * inv);
      *(uint2*)(op + 32 * i + 8 * g + 4 * hf) = o;
    }
}

DEV void phase_mixers(int tidv, int bidv, const Params& p, int l, char* smem, int dry) {
  int* s_item = (int*)(smem + SM_ITEM);
#ifdef PROBE_PARTS
  const int parts = dry ? PROBE_PARTS : 7;
#else
  const int parts = 7;
#endif
  for (int task = bidv; task < 192; task += gridDim.x) {
    if (task < 128 && !(parts & 1)) continue;
    if (task >= 128 && !(parts & 2)) continue;
    if (task < 128) rwkv_scan(tidv, bidv, p, l, task, smem, dry);
    else s5_scan(tidv, bidv, p, l, (task - 128) * 8 + (tidv >> 6), smem + (tidv >> 6) * 9472, dry);
  }
  const int nlat = 512, ntot = (parts & 4) ? ((l == 0) ? 544 : 512) : 0;
  int* cnt = (int*)(p.ws + B_CNT) + l + 2 * dry;
#if !defined(MIX_ONLY) || MIX_ONLY == 2
  while (true) {
    __syncthreads();
    if (tidv == 0) *s_item = atomicAdd(cnt, 1);
    __syncthreads();
    int item = *s_item;
    if (item >= ntot) break;
    if (item < nlat) attn_item(tidv, bidv, p, item, false, smem, dry);
    else attn_item(tidv, bidv, p, item - nlat, true, smem, dry);
  }
#endif
}

DEV float gelu_tanh(float x) {
  float u = 0.7978845608028654f * (x + 0.044715f * x * x * x);
  return 0.5f * x * (1.f + tanhf(u));
}

DEV void phase_post(int tidv, int bidv, const Params& p, int l, int M) {
  char* ws = p.ws;
  const bf16* Z = (const bf16*)(ws + B_ZB);
  const int wave = tidv >> 6, lane = tidv & 63;
  const float* cw = p.in[17] + (size_t)l * 3 * 3072;
  const bf16* YF = (const bf16*)(ws + B_HB);
  const bf16* YB = (const bf16*)(ws + B_HB + SZ1K);
  const bf16* AF = (const bf16*)(ws + B_AF);
  const bf16* AB = (const bf16*)(ws + B_AB);
  bf16* GB = (bf16*)(ws + B_GB);
  const int nitem = M * 16;
  for (int it = bidv * NW + wave; it < nitem; it += gridDim.x * NW) {
    int row = it >> 4, h = it & 15;
    int ch = h * 64 + lane;
    int tau, len;
    if (row < ML) { tau = row & 4095; len = 4096; } else { tau = (row - ML) & 255; len = 256; }
    size_t o = (size_t)row * 1024 + ch;
    float y = bf2f(YF[o]) + bf2f(YB[o]);
    float mu = wsum(y) * (1.f / 64.f);
    float dv = y - mu;
    float var = wsum(dv * dv) * (1.f / 64.f);
    float yn = dv * rsqrtf(var + 64e-5f) * p.in[26][l * 1024 + ch] + p.in[27][l * 1024 + ch];
    const bf16* z = Z + (size_t)row * NIN + C_R + ch;
    float r1 = bf2f(z[0]), k1 = bf2f(z[1024]), v1 = bf2f(z[2048]);
    float r0 = 0.f, k0 = 0.f, v0 = 0.f, r2 = 0.f, k2 = 0.f, v2 = 0.f;
    if (tau > 0) { const bf16* zm = z - NIN; r0 = bf2f(zm[0]); k0 = bf2f(zm[1024]); v0 = bf2f(zm[2048]); }
    if (tau < len - 1) { const bf16* zp = z + NIN; r2 = bf2f(zp[0]); k2 = bf2f(zp[1024]); v2 = bf2f(zp[2048]); }
    float rr = cw[ch] * r0 + cw[3072 + ch] * r1 + cw[6144 + ch] * r2;
    float kk = cw[1024 + ch] * k0 + cw[3072 + 1024 + ch] * k1 + cw[6144 + 1024 + ch] * k2;
    float vv = cw[2048 + ch] * v0 + cw[3072 + 2048 + ch] * v1 + cw[6144 + 2048 + ch] * v2;
    float am = 0.5f * (bf2f(AF[o]) + bf2f(AB[o]));
    float kbon = kk * (1.f + (am - 1.f) * p.in[24][l * 1024 + ch]);
    float s = wsum(rr * kbon * p.in[25][l * 1024 + ch]);
    float outv = (yn + s * vv) * bf2f(GB[o]);
    GB[o] = f2bf(outv);
  }
  bf16* SY = (bf16*)(ws + B_SY);
  const float* dsk = p.in[35] + l * 1024;
  const int n4 = M * 256;
  for (int i = bidv * NT + tidv; i < n4; i += gridDim.x * NT) {
    int row = i >> 8, c = (i & 255) * 4;
    uint2 a = *(const uint2*)(SY + (size_t)row * 1024 + c);
    uint2 bq = *(const uint2*)(Z + (size_t)row * NIN + c);
    uint2 u = *(const uint2*)(Z + (size_t)row * NIN + C_U + c);
    float4 dd = *(const float4*)(dsk + c);
    float y0 = bf2f((bf16)(a.x & 0xffff)) + bf2f((bf16)(bq.x & 0xffff)) + dd.x * bf2f((bf16)(u.x & 0xffff));
    float y1 = bf2f((bf16)(a.x >> 16)) + bf2f((bf16)(bq.x >> 16)) + dd.y * bf2f((bf16)(u.x >> 16));
    float y2 = bf2f((bf16)(a.y & 0xffff)) + bf2f((bf16)(bq.y & 0xffff)) + dd.z * bf2f((bf16)(u.y & 0xffff));
    float y3 = bf2f((bf16)(a.y >> 16)) + bf2f((bf16)(bq.y >> 16)) + dd.w * bf2f((bf16)(u.y >> 16));
    uint2 o;
    o.x = pack2(gelu_tanh(y0), gelu_tanh(y1));
    o.y = pack2(gelu_tanh(y2), gelu_tanh(y3));
    *(uint2*)(SY + (size_t)row * 1024 + c) = o;
  }
}

constexpr int NPH = 25;

DEV void run_phase(int tidv, int bidv, const Params& p, int ph, char* smem, int dry) {
  char* ws = p.ws;
#ifndef ONLY_S
  if (ph == 0) {
    if (bidv == 0 && tidv < 4) ((int*)(ws + B_CNT))[tidv] = 0;
    phase_mod(tidv, bidv, p, smem);
    phase_convw(tidv, bidv, p, 0, smem);
    return;
  }
#endif
  const int l = (ph - 1) / 12, s = (ph - 1) % 12;
#ifdef ONLY_S
  if (s != ONLY_S) return;
#endif
  const bf16* wb = (const bf16*)(ws + B_WB);
  const float* mod = (const float*)(ws + B_MOD) + (size_t)l * 5 * 12288;
  float* XC = (float*)(ws + B_XC);
  const float* xin_lat = l == 0 ? p.in[0] : p.out;
  const float* xin_ctx = l == 0 ? p.in[2] : XC;
  bf16* HB = (bf16*)(ws + B_HB);
  bf16* Z = (bf16*)(ws + B_ZB);
  bf16* H2 = (bf16*)(ws + B_KN);
  const int Mpost = l == 0 ? MT : ML;
  switch (s) {
    case 0:
      if (l == 1) phase_convw(tidv, bidv, p, 1, smem);
      phase_norm(tidv, bidv, xin_lat, xin_ctx, p.in[6] + l * 2048, mod, 0, 2048, HB, MT);
      break;
    case 1:
      run_gemm<G_IN>(tidv, bidv, p, l, smem, HB, 2048, wb + OW_IN, 2048, NIN, MT, 0, nullptr, nullptr, nullptr, nullptr);
      break;
    case 2:
#if !defined(PH2_ONLY) || PH2_ONLY == 0
      run_gemm<G_UKV>(tidv, bidv, p, l, smem, Z + C_CKV, NIN, wb + OW_UKV, 512, 2048, MT, 0, nullptr, nullptr, nullptr, nullptr);
#endif
#if !defined(PH2_ONLY) || PH2_ONLY == 1
      run_gemm<G_UQ>(tidv, bidv, p, l, smem, Z + C_CQ, NIN, wb + OW_UQ, 512, 1536, MT, 0, nullptr, nullptr, nullptr, nullptr);
#endif
#if !defined(PH2_ONLY) || PH2_ONLY == 2
      run_gemm<G_G2>(tidv, bidv, p, l, smem, Z + C_GD, NIN, wb + OW_G2, 192, 1024, MT, 0, nullptr, nullptr, nullptr, nullptr);
#endif
#if !defined(PH2_ONLY) || PH2_ONLY == 3
      for (int d = 0; d < 2; d++) {
        run_gemm<G_W2>(tidv, bidv, p, l, smem, Z + C_WD + 64 * d, NIN, wb + OW_W2 + (size_t)d * 65536, 64, 1024, MT, d, nullptr, nullptr, nullptr, nullptr);
        run_gemm<G_A2>(tidv, bidv, p, l, smem, Z + C_AD + 64 * d, NIN, wb + OW_A2 + (size_t)d * 65536, 64, 1024, MT, d, nullptr, nullptr, nullptr, nullptr);
      }
#endif
      break;
    case 3: phase_mla_post(tidv, bidv, p, l); break;
    case 4: phase_mixers(tidv, bidv, p, l, smem, dry); break;
    case 5: phase_post(tidv, bidv, p, l, Mpost); break;
    case 6:
      run_gemm<G_GLU>(tidv, bidv, p, l, smem, (const bf16*)(ws + B_SY), 1024, wb + OW_GLU, 1024, 1024, Mpost, 0, nullptr, nullptr, nullptr, nullptr);
      break;
    case 7:
      run_gemm<G_MG0>(tidv, bidv, p, l, smem, (const bf16*)(ws + B_QB), 1536, wb + OW_BR, 1024, 2048, Mpost, 0, nullptr, nullptr, nullptr, nullptr);
      run_gemm<G_MG1>(tidv, bidv, p, l, smem, (const bf16*)(ws + B_GB), 1024, wb + OW_BR + (size_t)2048 * 1024, 1024, 2048, Mpost, 0, nullptr, nullptr, nullptr, nullptr);
      run_gemm<G_MG2>(tidv, bidv, p, l, smem, Z, NIN, wb + OW_BR + (size_t)2 * 2048 * 1024, 1024, 2048, Mpost, 0, nullptr, nullptr, nullptr, nullptr);
      break;
    case 8:
      run_gemm<G_OUT>(tidv, bidv, p, l, smem, HB, 2048, wb + OW_OUT, 2048, 2048, Mpost, 0, xin_lat, xin_ctx, p.out, XC);
      break;
    case 9:
      phase_norm(tidv, bidv, p.out, XC, p.in[7] + l * 2048, mod, 6144, 8192, H2, Mpost);
      break;
    case 10:
      run_gemm<G_M1>(tidv, bidv, p, l, smem, H2, 2048, wb + OW_M1, 2048, 8192, Mpost, 0, nullptr, nullptr, nullptr, nullptr);
      break;
    case 11:
      run_gemm<G_M2>(tidv, bidv, p, l, smem, Z, 8192, wb + OW_M2, 8192, 2048, Mpost, 0, nullptr, nullptr, p.out, XC);
      break;
  }
}

DEV void grid_barrier(unsigned* cnt, unsigned target) {
  asm volatile("s_waitcnt vmcnt(0)" ::: "memory");
  __syncthreads();
  if (threadIdx.x == 0) {
    __builtin_amdgcn_fence(__ATOMIC_RELEASE, "agent");
    asm volatile("s_waitcnt vmcnt(0)" ::: "memory");
    __hip_atomic_fetch_add(cnt, 1u, __ATOMIC_RELAXED, __HIP_MEMORY_SCOPE_AGENT);
    unsigned spins = 0;
    while (__hip_atomic_load(cnt, __ATOMIC_RELAXED, __HIP_MEMORY_SCOPE_AGENT) < target) {
      __builtin_amdgcn_s_sleep(1);
      if (++spins > (1u << 21)) break;
    }
    __builtin_amdgcn_fence(__ATOMIC_ACQUIRE, "agent");
    asm volatile("s_waitcnt vmcnt(0)" ::: "memory");
  }
  __syncthreads();
}

__global__ void __launch_bounds__(NT) fwd_megakernel(Params p, int ph0, int ph1, int dryflag) {
  extern __shared__ __attribute__((aligned(16))) char smem[];
  for (int ph = ph0; ph < ph1; ph++) {
    int tidv = threadIdx.x, bidv = blockIdx.x;
    asm volatile("" : "+v"(tidv));
    asm volatile("" : "+s"(bidv));
#ifdef PROBE_MASK
    if (dryflag && ((ph == 0 && (PROBE_MASK & 0x1000)) || (ph > 0 && ((PROBE_MASK >> ((ph - 1) % 12)) & 1)))) {
      run_phase(tidv, bidv, p, ph, smem, dryflag);
      cg::this_grid().sync();
    }
#endif
    run_phase(tidv, bidv, p, ph, smem, 0);
    if (ph + 1 < ph1) {
      if (ph == ph0) cg::this_grid().sync();
      else grid_barrier((unsigned*)(p.ws + B_FLG), (unsigned)(ph - ph0) * gridDim.x);
    }
  }
}

extern "C" void kernel_launch(void* const* d_in, const int* in_sizes, int n_in, void* d_out, int out_size, void* d_ws, size_t ws_size,
                              hipStream_t stream) {
  static int grid_blocks = 0;
  if (!grid_blocks) {
    int dev = 0, cus = 0, per_cu = 0;
    (void)hipGetDevice(&dev);
    (void)hipDeviceGetAttribute(&cus, hipDeviceAttributeMultiprocessorCount, dev);
    if (hipFuncSetAttribute((const void*)fwd_megakernel, hipFuncAttributeMaxDynamicSharedMemorySize, LDS_BYTES) != hipSuccess) {
      fprintf(stderr, "hipFuncSetAttribute(%d B dynamic LDS) failed\n", LDS_BYTES);
      return;
    }
    if (hipOccupancyMaxActiveBlocksPerMultiprocessor(&per_cu, (const void*)fwd_megakernel, NT, LDS_BYTES) != hipSuccess || per_cu < 1) {
      fprintf(stderr, "occupancy query failed / kernel not resident\n");
      return;
    }
    grid_blocks = cus;
  }
  Params p{};
  for (int i = 0; i < 42; i++) p.in[i] = (const float*)d_in[i];
  p.out = (float*)d_out;
  p.ws = (char*)d_ws;
  if (ws_size < B_END + (8u << 20)) { fprintf(stderr, "workspace too small\n"); return; }
  int ph0 = 0, ph1 = NPH;
  int dryflag = 1;
  void* args[] = {&p, &ph0, &ph1, &dryflag};
  (void)hipMemsetAsync((char*)d_ws + B_FLG, 0, 4096, stream);
  hipError_t e = hipLaunchCooperativeKernel((void*)fwd_megakernel, dim3(grid_blocks), dim3(NT), args, LDS_BYTES, stream);
  if (e != hipSuccess) fprintf(stderr, "cooperative launch failed: %s (grid %d)\n", hipGetErrorString(e), grid_blocks);
}
```

```cpp
#include <hip/hip_runtime.h>
#include <hip/hip_cooperative_groups.h>
#include <stdint.h>
#include <cstdio>
namespace cg = cooperative_groups;

#ifndef MULTI_LAUNCH
#define MULTI_LAUNCH 0
#endif

typedef unsigned short bf16;
using bf16x8 = __attribute__((ext_vector_type(8))) short;
using f32x4 = __attribute__((ext_vector_type(4))) float;
using f32x16 = __attribute__((ext_vector_type(16))) float;

#define DEV __device__ __forceinline__
constexpr int NT = 512, NW = 8;

constexpr int DM = 2048, ML = 16384, MC = 1024, MT = 17408, NIN = 11744, DFF = 8192, NKEY = 4352;
constexpr int C_CQ = 0, C_CKV = 512, C_KR = 1024, C_R = 1088, C_WD = 4160, C_AD = 4288, C_GD = 4416, C_U = 4576, C_GATE = 5600;

constexpr size_t OW_IN = 0;
constexpr size_t OW_UQ = OW_IN + (size_t)NIN * 2048;
constexpr size_t OW_UKV = OW_UQ + 1536 * 512;
constexpr size_t OW_W2 = OW_UKV + 2048 * 512;
constexpr size_t OW_A2 = OW_W2 + 2 * 1024 * 64;
constexpr size_t OW_G2 = OW_A2 + 2 * 1024 * 64;
constexpr size_t OW_GLU = OW_G2 + 1024 * 192;
constexpr size_t OW_BR = OW_GLU + 1024 * 1024;
constexpr size_t OW_OUT = OW_BR + (size_t)3 * 2048 * 1024;
constexpr size_t OW_M1 = OW_OUT + (size_t)2048 * 2048;
constexpr size_t OW_M2 = OW_M1 + (size_t)8192 * 2048;
constexpr size_t OW_END = OW_M2 + (size_t)8192 * 2048;

constexpr size_t SZ1K = (size_t)MT * 1024 * 2;
constexpr size_t B_WB = 0;
constexpr size_t B_HB = B_WB + OW_END * 2;
constexpr size_t B_ZB = B_HB + (size_t)MT * 2048 * 2;
constexpr size_t B_QB = B_ZB + (size_t)MT * NIN * 2;
constexpr size_t B_KN = B_QB + (size_t)MT * 1536 * 2;
constexpr size_t B_VT = B_KN + SZ1K;
constexpr size_t B_KR = B_VT + SZ1K;
constexpr size_t B_AF = B_KR + (size_t)MT * 64 * 2;
constexpr size_t B_AB = B_AF + SZ1K;
constexpr size_t B_GB = B_AB + SZ1K;
constexpr size_t B_SY = B_GB + SZ1K;
constexpr size_t B_XC = B_SY + SZ1K;
constexpr size_t B_MOD = B_XC + (size_t)MC * 2048 * 4;
constexpr size_t B_CNT = B_MOD + (size_t)2 * 5 * 12288 * 4;
constexpr size_t B_FLG = B_CNT + 256;
constexpr size_t B_END = B_FLG + 4096;

struct Params {
  const float* in[42];
  float* out;
  char* ws;
};

typedef __attribute__((ext_vector_type(2))) __bf16 hbf2;
DEV bf16 f2bf(float f) {
  __bf16 h = (__bf16)f;
  return *(unsigned short*)&h;
}
DEV float bf2f(bf16 h) { return __uint_as_float(((uint32_t)h) << 16); }
DEV uint32_t pack2(float a, float b) {
  hbf2 v;
  v[0] = (__bf16)a;
  v[1] = (__bf16)b;
  return *(uint32_t*)&v;
}
DEV float wsum(float v) {
#pragma unroll
  for (int o = 32; o > 0; o >>= 1) v += __shfl_xor(v, o);
  return v;
}
DEV float dpp_xor1(float v) {
  int i = __float_as_int(v);
  return __int_as_float(__builtin_amdgcn_update_dpp(0, i, 0xB1, 0xF, 0xF, true));
}
DEV float dpp_xor2(float v) {
  int i = __float_as_int(v);
  return __int_as_float(__builtin_amdgcn_update_dpp(0, i, 0x4E, 0xF, 0xF, true));
}
DEV float dpp_rmirror(float v) {
  int i = __float_as_int(v);
  return __int_as_float(__builtin_amdgcn_update_dpp(0, i, 0x140, 0xF, 0xF, true));
}
DEV float dpp_hmirror0(float v) {
  int i = __float_as_int(v);
  return __int_as_float(__builtin_amdgcn_update_dpp(0, i, 0x141, 0xF, 0xF, true));
}
DEV float wsum_fast(float v) {
  v += dpp_xor1(v);
  v += dpp_xor2(v);
  v += dpp_hmirror0(v);
  v += dpp_rmirror(v);
  v += __shfl_xor(v, 16);
  v += __shfl_xor(v, 32);
  return v;
}
DEV float sigmoidf_(float x) { return __builtin_amdgcn_rcpf(1.f + __expf(-x)); }

DEV void phase_mod(int tidv, int bidv, const Params& p, char* smem) {
  float* s_in = (float*)smem;
  float* red = s_in + 5 * 2048;
  float* mod = (float*)(p.ws + B_MOD);
  for (int i = tidv; i < 5 * 2048; i += NT) {
    int r = i >> 11, k = i & 2047;
    float v = r < 4 ? p.in[1][r * 2048 + k] : p.in[3][k];
    s_in[i] = v / (1.f + expf(-v));
  }
  __syncthreads();
  int kg = tidv >> 6, c = tidv & 63;
  for (int task = bidv; task < 2 * 192; task += gridDim.x) {
    int l = task / 192, n = (task % 192) * 64 + c;
    const float* w = p.in[4] + (size_t)l * 2048 * 12288 + n;
    float a0 = 0, a1 = 0, a2 = 0, a3 = 0, a4 = 0;
    int kb = kg * 256;
#pragma unroll 8
    for (int k = 0; k < 256; k++) {
      float wv = w[(size_t)(kb + k) * 12288];
      a0 += s_in[kb + k] * wv;
      a1 += s_in[2048 + kb + k] * wv;
      a2 += s_in[4096 + kb + k] * wv;
      a3 += s_in[6144 + kb + k] * wv;
      a4 += s_in[8192 + kb + k] * wv;
    }
    red[(kg * 5 + 0) * 64 + c] = a0;
    red[(kg * 5 + 1) * 64 + c] = a1;
    red[(kg * 5 + 2) * 64 + c] = a2;
    red[(kg * 5 + 3) * 64 + c] = a3;
    red[(kg * 5 + 4) * 64 + c] = a4;
    __syncthreads();
    if (kg == 0) {
      float bias = p.in[5][l * 12288 + n];
#pragma unroll
      for (int r = 0; r < 5; r++) {
        float v = 0.f;
#pragma unroll
        for (int g = 0; g < 8; g++) v += red[(g * 5 + r) * 64 + c];
        mod[(size_t)(l * 5 + r) * 12288 + n] = v + bias;
      }
    }
    __syncthreads();
  }
}

DEV void convT(int tidv, int bidv, const float* __restrict__ src, bf16* __restrict__ dst, int K, int N, const float* __restrict__ gain, char* smem, int dK = 0) {
  if (dK == 0) dK = K;
  float* t = (float*)smem;
  const int tk = (K + 63) >> 6, tn = (N + 63) >> 6, ntile = tk * tn;
  const int kk = tidv >> 4, n4 = (tidv & 15) * 4;
  float4 c0 = {0.f, 0.f, 0.f, 0.f}, c1 = {0.f, 0.f, 0.f, 0.f};
#define CV_LOAD(TILE)                                                                      \
  {                                                                                        \
    const int k0_ = ((TILE) / tn) * 64, n0_ = ((TILE) % tn) * 64;                          \
    c0 = float4{0.f, 0.f, 0.f, 0.f}; c1 = c0;                                              \
    if (n0_ + n4 < N) {                                                                    \
      if (k0_ + kk < K) { c0 = *(const float4*)(src + (size_t)(k0_ + kk) * N + n0_ + n4);  \
        if (gain) { float g = gain[k0_ + kk]; c0.x *= g; c0.y *= g; c0.z *= g; c0.w *= g; } }          \
      if (k0_ + kk + 32 < K) { c1 = *(const float4*)(src + (size_t)(k0_ + kk + 32) * N + n0_ + n4);    \
        if (gain) { float g = gain[k0_ + kk + 32]; c1.x *= g; c1.y *= g; c1.z *= g; c1.w *= g; } }     \
    }                                                                                      \
  }
  if (bidv < ntile) CV_LOAD(bidv)
  for (int tile = bidv; tile < ntile; tile += gridDim.x) {
    int k0 = (tile / tn) * 64, n0 = (tile % tn) * 64;
    __syncthreads();
    t[kk * 65 + n4 + 0] = c0.x; t[kk * 65 + n4 + 1] = c0.y; t[kk * 65 + n4 + 2] = c0.z; t[kk * 65 + n4 + 3] = c0.w;
    t[(kk + 32) * 65 + n4 + 0] = c1.x; t[(kk + 32) * 65 + n4 + 1] = c1.y; t[(kk + 32) * 65 + n4 + 2] = c1.z; t[(kk + 32) * 65 + n4 + 3] = c1.w;
    __syncthreads();
    if (tile + (int)gridDim.x < ntile) CV_LOAD(tile + (int)gridDim.x)
    {
      int c = tidv;
      int nn = c >> 3, kc = c & 7;
      if (n0 + nn < N && k0 + kc * 8 < dK) {
        uint4 o;
        o.x = pack2(t[(kc * 8 + 0) * 65 + nn], t[(kc * 8 + 1) * 65 + nn]);
        o.y = pack2(t[(kc * 8 + 2) * 65 + nn], t[(kc * 8 + 3) * 65 + nn]);
        o.z = pack2(t[(kc * 8 + 4) * 65 + nn], t[(kc * 8 + 5) * 65 + nn]);
        o.w = pack2(t[(kc * 8 + 6) * 65 + nn], t[(kc * 8 + 7) * 65 + nn]);
        *(uint4*)(dst + (size_t)(n0 + nn) * dK + k0 + kc * 8) = o;
      }
    }
  }
#undef CV_LOAD
}

DEV void phase_convw(int tidv, int bidv, const Params& p, int l, char* smem) {
  bf16* wb = (bf16*)(p.ws + B_WB);
  convT(tidv, bidv, p.in[8] + (size_t)l * 2048 * NIN, wb + OW_IN, 2048, NIN, nullptr, smem);
  convT(tidv, bidv, p.in[40] + (size_t)l * 2048 * 8192, wb + OW_M1, 2048, 8192, nullptr, smem);
  convT(tidv, bidv, p.in[41] + (size_t)l * 8192 * 2048, wb + OW_M2, 8192, 2048, nullptr, smem);
  for (int n = 0; n < 3; n++)
    convT(tidv, bidv, p.in[38] + (size_t)(l * 3 + n) * 1024 * 2048, wb + OW_BR + (size_t)n * 2048 * 1024, 1024, 2048, nullptr, smem);
  convT(tidv, bidv, p.in[39] + (size_t)l * 2048 * 2048, wb + OW_OUT, 2048, 2048, nullptr, smem);
  convT(tidv, bidv, p.in[11] + (size_t)l * 512 * 1536, wb + OW_UQ, 512, 1536, p.in[9] + l * 512, smem);
  convT(tidv, bidv, p.in[12] + (size_t)l * 512 * 2048, wb + OW_UKV, 512, 2048, p.in[10] + l * 512, smem);
  convT(tidv, bidv, p.in[36] + (size_t)l * 1024 * 1024, wb + OW_GLU, 1024, 1024, nullptr, smem);
  for (int d = 0; d < 2; d++) {
    convT(tidv, bidv, p.in[19] + (size_t)(l * 2 + d) * 64 * 1024, wb + OW_W2 + (size_t)d * 65536, 64, 1024, nullptr, smem);
    convT(tidv, bidv, p.in[21] + (size_t)(l * 2 + d) * 64 * 1024, wb + OW_A2 + (size_t)d * 65536, 64, 1024, nullptr, smem);
  }
  convT(tidv, bidv, p.in[22] + (size_t)l * 160 * 1024, wb + OW_G2, 160, 1024, nullptr, smem, 192);
}

DEV void phase_norm(int tidv, int bidv, const float* xlat, const float* xctx, const float* g, const float* mod, int shOff, int scOff, bf16* H, int nrows) {
  int wave = tidv >> 6, lane = tidv & 63;
  for (int row = bidv * NW + wave; row < nrows; row += gridDim.x * NW) {
    const float* x = row < ML ? xlat + (size_t)row * 2048 : xctx + (size_t)(row - ML) * 2048;
    int b = row < ML ? (row >> 12) : 4;
    const float* sh = mod + b * 12288 + shOff;
    const float* sc = mod + b * 12288 + scOff;
    float4 v[8];
    float ss = 0.f;
#pragma unroll
    for (int i = 0; i < 8; i++) {
      v[i] = *(const float4*)(x + i * 256 + lane * 4);
      ss += v[i].x * v[i].x + v[i].y * v[i].y + v[i].z * v[i].z + v[i].w * v[i].w;
    }
    ss = wsum_fast(ss);
    float rinv = rsqrtf(ss * (1.f / 2048.f) + 1e-6f);
#pragma unroll
    for (int i = 0; i < 8; i++) {
      int c = i * 256 + lane * 4;
      float4 g4 = *(const float4*)(g + c), s4 = *(const float4*)(sc + c), h4 = *(const float4*)(sh + c);
      float y0 = v[i].x * rinv * g4.x * (1.f + s4.x) + h4.x;
      float y1 = v[i].y * rinv * g4.y * (1.f + s4.y) + h4.y;
      float y2 = v[i].z * rinv * g4.z * (1.f + s4.z) + h4.z;
      float y3 = v[i].w * rinv * g4.w * (1.f + s4.w) + h4.w;
      uint2 o;
      o.x = pack2(y0, y1);
      o.y = pack2(y2, y3);
      *(uint2*)(H + (size_t)row * 2048 + c) = o;
    }
  }
}

constexpr int LDT = 72;
constexpr int GA_BYTES = 256 * LDT * 2;
constexpr int GSTAGE = 512 * LDT * 2;
constexpr int SM_RINV = 2 * GSTAGE;
constexpr int SM_ITEM = SM_RINV + 1024;
constexpr int LDS_BYTES = SM_ITEM + 16;
DEV float sumsq8(uint4 r) {
  float s = 0.f, x;
  x = bf2f((bf16)(r.x & 0xffff)); s += x * x; x = bf2f((bf16)(r.x >> 16)); s += x * x;
  x = bf2f((bf16)(r.y & 0xffff)); s += x * x; x = bf2f((bf16)(r.y >> 16)); s += x * x;
  x = bf2f((bf16)(r.z & 0xffff)); s += x * x; x = bf2f((bf16)(r.z >> 16)); s += x * x;
  x = bf2f((bf16)(r.w & 0xffff)); s += x * x; x = bf2f((bf16)(r.w >> 16)); s += x * x;
  return s;
}

template <bool ROWNORM>
DEV void gemm_mainloop(int tidv, int bidv, const bf16* __restrict__ A, int lda, bool amap, const bf16* __restrict__ Bt, int K, int N, int m0, int n0,
                       char* smem, f32x16 (&acc)[4][2]) {
  float* srinv = (float*)(smem + SM_RINV);
  const int tid = tidv, lane = tid & 63, wave = tid >> 6;
  const int wm = wave >> 2, wn = wave & 3;
  const int lr = tid >> 3, kc = tid & 7;
  const char* abase = (const char*)(A + (size_t)m0 * lda);
  const char* bbase = (const char*)(Bt + (size_t)n0 * K);
  const uint32_t voa = (uint32_t)(lr * lda + kc * 8) * 2u;
  const uint32_t astep = (uint32_t)(64 * lda) * 2u;
  const uint32_t vob0 = (uint32_t)(lr * K + kc * 8) * 2u;
  const uint32_t bstep = (uint32_t)(64 * K) * 2u;
  const uint32_t lds_st = (uint32_t)(lr * LDT + kc * 8) * 2u;
  const int nk = K >> 6;
  uint4 xa0, xa1, xa2, xa3, xb0, xb1, xb2, xb3;
#define G_LOAD(KT)                                                         \
  {                                                                        \
    const int k0_ = (KT) << 6;                                             \
    const int ka_ = amap ? ((k0_ >> 7) * 192 + (k0_ & 127)) : k0_;         \
    xa0 = *(const uint4*)(abase + (size_t)ka_ * 2 + voa);                  \
    xa1 = *(const uint4*)(abase + (size_t)ka_ * 2 + astep + voa);          \
    xa2 = *(const uint4*)(abase + (size_t)ka_ * 2 + 2 * astep + voa);      \
    xa3 = *(const uint4*)(abase + (size_t)ka_ * 2 + 3 * astep + voa);      \
    xb0 = *(const uint4*)(bbase + (size_t)k0_ * 2 + vob0);                 \
    xb1 = *(const uint4*)(bbase + (size_t)k0_ * 2 + bstep + vob0);         \
    xb2 = *(const uint4*)(bbase + (size_t)k0_ * 2 + 2 * bstep + vob0);     \
    xb3 = *(const uint4*)(bbase + (size_t)k0_ * 2 + 3 * bstep + vob0);     \
  }
#define G_STORE(SN)                                                  \
  *(uint4*)((SN) + lds_st) = xa0;                                    \
  *(uint4*)((SN) + 1 * (64 * LDT * 2) + lds_st) = xa1;               \
  *(uint4*)((SN) + 2 * (64 * LDT * 2) + lds_st) = xa2;               \
  *(uint4*)((SN) + 3 * (64 * LDT * 2) + lds_st) = xa3;               \
  *(uint4*)((SN) + GA_BYTES + lds_st) = xb0;                         \
  *(uint4*)((SN) + GA_BYTES + 1 * (64 * LDT * 2) + lds_st) = xb1;    \
  *(uint4*)((SN) + GA_BYTES + 2 * (64 * LDT * 2) + lds_st) = xb2;    \
  *(uint4*)((SN) + GA_BYTES + 3 * (64 * LDT * 2) + lds_st) = xb3;
  const uint32_t fa = (uint32_t)((wm * 128 + (lane & 31)) * LDT + (lane >> 5) * 8) * 2u;
  const uint32_t fb = (uint32_t)GA_BYTES + (uint32_t)((wn * 64 + (lane & 31)) * LDT + (lane >> 5) * 8) * 2u;
  const int nkm = nk - 1;
  if (ROWNORM) {
    __syncthreads();
#pragma unroll 1
    for (int i = 0; i < 4; i++) {
      float ss = 0.f;
      for (int kk = 0; kk < nk; kk++) ss += sumsq8(*(const uint4*)(abase + (size_t)kk * 128 + i * astep + voa));
      ss += __shfl_xor(ss, 1); ss += __shfl_xor(ss, 2); ss += __shfl_xor(ss, 4);
      if (kc == 0) srinv[lr + 64 * i] = rsqrtf(ss / (float)K + 1e-6f);
    }
  }
  G_LOAD(0)
  __syncthreads();
  G_STORE(smem)
  G_LOAD((1 < nkm ? 1 : nkm))
  __syncthreads();
#define G_FRAG(P, ST, KS)                                                            \
  P##a0 = *(const bf16x8*)((ST) + fa + 0 * (32 * LDT * 2) + (KS) * 32);                \
  P##a1 = *(const bf16x8*)((ST) + fa + 1 * (32 * LDT * 2) + (KS) * 32);                \
  P##a2 = *(const bf16x8*)((ST) + fa + 2 * (32 * LDT * 2) + (KS) * 32);                \
  P##a3 = *(const bf16x8*)((ST) + fa + 3 * (32 * LDT * 2) + (KS) * 32);                \
  P##b0 = *(const bf16x8*)((ST) + fb + 0 * (32 * LDT * 2) + (KS) * 32);                \
  P##b1 = *(const bf16x8*)((ST) + fb + 1 * (32 * LDT * 2) + (KS) * 32);
#define G_MMA(P)                                                                              \
  acc[0][0] = __builtin_amdgcn_mfma_f32_32x32x16_bf16(P##b0, P##a0, acc[0][0], 0, 0, 0);      \
  acc[0][1] = __builtin_amdgcn_mfma_f32_32x32x16_bf16(P##b1, P##a0, acc[0][1], 0, 0, 0);      \
  acc[1][0] = __builtin_amdgcn_mfma_f32_32x32x16_bf16(P##b0, P##a1, acc[1][0], 0, 0, 0);      \
  acc[1][1] = __builtin_amdgcn_mfma_f32_32x32x16_bf16(P##b1, P##a1, acc[1][1], 0, 0, 0);      \
  acc[2][0] = __builtin_amdgcn_mfma_f32_32x32x16_bf16(P##b0, P##a2, acc[2][0], 0, 0, 0);      \
  acc[2][1] = __builtin_amdgcn_mfma_f32_32x32x16_bf16(P##b1, P##a2, acc[2][1], 0, 0, 0);      \
  acc[3][0] = __builtin_amdgcn_mfma_f32_32x32x16_bf16(P##b0, P##a3, acc[3][0], 0, 0, 0);      \
  acc[3][1] = __builtin_amdgcn_mfma_f32_32x32x16_bf16(P##b1, P##a3, acc[3][1], 0, 0, 0);
  bf16x8 pa0, pa1, pa2, pa3, pb0, pb1, qa0, qa1, qa2, qa3, qb0, qb1;
#pragma unroll 1
  for (int kt = 0; kt < nk; kt++) {
    const char* st = smem + (kt & 1) * GSTAGE;
    char* sn = smem + ((kt + 1) & 1) * GSTAGE;
    if (!ROWNORM) {
      G_FRAG(p, st, 0)
      G_FRAG(q, st, 1)
      __builtin_amdgcn_sched_barrier(0);
      G_MMA(p)
      __builtin_amdgcn_sched_barrier(0);
      G_FRAG(p, st, 2)
      __builtin_amdgcn_sched_barrier(0);
      G_MMA(q)
      __builtin_amdgcn_sched_barrier(0);
      G_FRAG(q, st, 3)
      if (kt + 1 < nk) { G_STORE(sn) }
      G_LOAD((kt + 2 < nkm ? kt + 2 : nkm))
      __builtin_amdgcn_sched_barrier(0);
      G_MMA(p)
      __builtin_amdgcn_sched_barrier(0);
      G_MMA(q)
    } else {
      G_FRAG(p, st, 0)
      __builtin_amdgcn_sched_barrier(0);
      G_MMA(p)
      __builtin_amdgcn_sched_barrier(0);
      G_FRAG(p, st, 1)
      __builtin_amdgcn_sched_barrier(0);
      G_MMA(p)
      __builtin_amdgcn_sched_barrier(0);
      G_FRAG(p, st, 2)
      if (kt + 1 < nk) { G_STORE(sn) }
      G_LOAD((kt + 2 < nkm ? kt + 2 : nkm))
      __builtin_amdgcn_sched_barrier(0);
      G_MMA(p)
      __builtin_amdgcn_sched_barrier(0);
      G_FRAG(p, st, 3)
      __builtin_amdgcn_sched_barrier(0);
      G_MMA(p)
    }
    __syncthreads();
  }
#undef G_FRAG
#undef G_MMA
#undef G_LOAD
#undef G_STORE
}

DEV void zero_acc(f32x16 (&acc)[4][2]) {
#pragma unroll
  for (int i = 0; i < 4; i++)
#pragma unroll
    for (int j = 0; j < 2; j++)
#pragma unroll
      for (int e = 0; e < 16; e++) acc[i][j][e] = 0.f;
}

template <class F>
DEV void epi_loop(int tidv, int bidv, f32x16 (&acc)[4][2], int m0, int n0, int N, F f) {
  const int lane = tidv & 63, wave = tidv >> 6;
  const int wm = wave >> 2, wn = wave & 3;
#pragma unroll
  for (int i = 0; i < 4; i++) {
    const int lrow = wm * 128 + i * 32 + (lane & 31);
#pragma unroll
    for (int j = 0; j < 2; j++) {
#pragma unroll
      for (int g = 0; g < 4; g++) {
        int col = n0 + wn * 64 + j * 32 + 8 * g + 4 * (lane >> 5);
        f32x4 v = {acc[i][j][4 * g], acc[i][j][4 * g + 1], acc[i][j][4 * g + 2], acc[i][j][4 * g + 3]};
        if (col < N) f(m0 + lrow, lrow, col, v);
      }
    }
    __builtin_amdgcn_sched_barrier(0);
  }
}

DEV uint2 pack4(f32x4 v) {
  uint2 o;
  o.x = pack2(v[0], v[1]);
  o.y = pack2(v[2], v[3]);
  return o;
}
DEV f32x4 unpack4(uint2 u) {
  f32x4 v;
  v[0] = bf2f((bf16)(u.x & 0xffff)); v[1] = bf2f((bf16)(u.x >> 16));
  v[2] = bf2f((bf16)(u.y & 0xffff)); v[3] = bf2f((bf16)(u.y >> 16));
  return v;
}

enum { G_IN = 0, G_UQ, G_UKV, G_W2, G_A2, G_G2, G_GLU, G_OUT, G_M1, G_M2, G_MG0, G_MG1, G_MG2 };

template <int MODE>
DEV void run_gemm(int tidv, int bidv, const Params& p, int l, char* smem, const bf16* A, int lda, const bf16* Bt, int K, int N, int M, int aux,
                  const float* xin_lat, const float* xin_ctx, float* xout_lat, float* xout_ctx) {
  const int nt = (N + 255) >> 8, mt = M >> 8;
  char* ws = p.ws;
  bf16* Z = (bf16*)(ws + B_ZB);
  const float* srinv = (const float*)(smem + SM_RINV);
  const float* mod = (const float*)(ws + B_MOD) + (size_t)l * 5 * 12288;
  for (int tile = bidv; tile < nt * mt; tile += gridDim.x) {
    int m0 = (tile / nt) << 8, n0 = (tile % nt) << 8;
    f32x16 acc[4][2];
    zero_acc(acc);
    gemm_mainloop<(MODE == G_UQ || MODE == G_UKV)>(tidv, bidv, A, lda, MODE == G_MG0, Bt, K, N, m0, n0, smem, acc);
    if constexpr (MODE != G_OUT && MODE != G_M2)
    epi_loop(tidv, bidv, acc, m0, n0, N, [&](int row, int lrow, int col, f32x4 v) {
      if constexpr (MODE == G_IN) {
        f32x4 o = v;
        if (col >= C_GATE || (col >= C_GD && col < C_U)) {
#pragma unroll
          for (int r = 0; r < 4; r++) o[r] = sigmoidf_(v[r]);
        } else if (col >= C_WD && col < C_AD) {
#pragma unroll
          for (int r = 0; r < 4; r++) o[r] = tanhf(v[r]);
        }
        *(uint2*)(smem + ((size_t)lrow * 264 + (col - n0)) * 2) = pack4(o);
      } else if constexpr (MODE == G_UQ) {
        float ri = srinv[lrow];
        *(uint2*)((bf16*)(ws + B_QB) + (size_t)row * 1536 + col) = pack4(v * ri);
      } else if constexpr (MODE == G_UKV) {
        float ri = srinv[lrow];
        f32x4 o = v * ri;
        int h = col >> 8, c = col & 255;
        if (c < 128) {
          *(uint2*)((bf16*)(ws + B_KN) + (size_t)row * 1024 + h * 128 + c) = pack4(o);
        } else {
          int b, kp;
          if (row < ML) { b = row >> 12; kp = row & 4095; } else { int r2 = row - ML; b = r2 >> 8; kp = 4096 + (r2 & 255); }
          bf16* vt = (bf16*)(ws + B_VT) + ((size_t)((b * 8 + h) * 128 + (c - 128))) * NKEY + kp;
#pragma unroll
          for (int r = 0; r < 4; r++) vt[(size_t)r * NKEY] = f2bf(o[r]);
        }
      } else if constexpr (MODE == G_W2) {
        float4 w0 = *(const float4*)(p.in[18] + (l * 2 + aux) * 1024 + col);
        f32x4 o;
        o[0] = 0.60653066f * sigmoidf_(w0.x + v[0]);
        o[1] = 0.60653066f * sigmoidf_(w0.y + v[1]);
        o[2] = 0.60653066f * sigmoidf_(w0.z + v[2]);
        o[3] = 0.60653066f * sigmoidf_(w0.w + v[3]);
        *(uint2*)((bf16*)(ws + B_HB + (size_t)aux * SZ1K) + (size_t)row * 1024 + col) = pack4(o);
      } else if constexpr (MODE == G_A2) {
        float4 a0 = *(const float4*)(p.in[20] + (l * 2 + aux) * 1024 + col);
        f32x4 o;
        o[0] = sigmoidf_(a0.x + v[0]);
        o[1] = sigmoidf_(a0.y + v[1]);
        o[2] = sigmoidf_(a0.z + v[2]);
        o[3] = sigmoidf_(a0.w + v[3]);
        *(uint2*)((bf16*)(ws + (aux ? B_AB : B_AF)) + (size_t)row * 1024 + col) = pack4(o);
      } else if constexpr (MODE == G_G2) {
        *(uint2*)((bf16*)(ws + B_GB) + (size_t)row * 1024 + col) = pack4(v);
      } else if constexpr (MODE == G_GLU) {
        f32x4 zz = unpack4(*(const uint2*)((const bf16*)(ws + B_SY) + (size_t)row * 1024 + col));
        float4 gb = *(const float4*)(p.in[37] + l * 1024 + col);
        f32x4 o;
        o[0] = zz[0] * sigmoidf_(v[0] + gb.x);
        o[1] = zz[1] * sigmoidf_(v[1] + gb.y);
        o[2] = zz[2] * sigmoidf_(v[2] + gb.z);
        o[3] = zz[3] * sigmoidf_(v[3] + gb.w);
        *(uint2*)(smem + ((size_t)lrow * 264 + (col - n0)) * 2) = pack4(o);
      } else if constexpr (MODE == G_OUT || MODE == G_M2) {
      } else if constexpr (MODE == G_M1) {
        f32x4 o;
#pragma unroll
        for (int r = 0; r < 4; r++) { float t = fmaxf(v[r], 0.f); o[r] = t * t; }
        *(uint2*)(smem + ((size_t)lrow * 264 + (col - n0)) * 2) = pack4(o);
      } else if constexpr (MODE == G_MG0 || MODE == G_MG1 || MODE == G_MG2) {
        *(uint2*)(smem + ((size_t)lrow * 264 + (col - n0)) * 2) = pack4(v);
      }
    });
    if constexpr (MODE == G_OUT || MODE == G_M2) {
      float* tilef = (float*)smem;
      constexpr int GOFF = (MODE == G_OUT) ? 4096 : 10240;
      const int wn_ = (tidv >> 6) & 3;
#pragma unroll 1
      for (int half = 0; half < 2; half++) {
        if ((wn_ >> 1) == half) {
          epi_loop(tidv, bidv, acc, m0, n0, N, [&](int row, int lrow, int col, f32x4 v) {
            *(f32x4*)(tilef + (size_t)lrow * 132 + (col - n0 - half * 128)) = v;
          });
        }
        __syncthreads();
#pragma unroll 2
        for (int it = 0; it < 16; it++) {
          int c = it * NT + tidv;
          int r = c >> 5, ch = c & 31;
          int row = m0 + r, col = n0 + half * 128 + ch * 4;
          int b = row < ML ? (row >> 12) : 4;
          float4 g = *(const float4*)(mod + b * 12288 + GOFF + col);
          const float* xi;
          if constexpr (MODE == G_OUT) xi = row < ML ? xin_lat + (size_t)row * 2048 : xin_ctx + (size_t)(row - ML) * 2048;
          else xi = row < ML ? xout_lat + (size_t)row * 2048 : xout_ctx + (size_t)(row - ML) * 2048;
          float* xo = row < ML ? xout_lat + (size_t)row * 2048 : xout_ctx + (size_t)(row - ML) * 2048;
          float4 x = *(const float4*)(xi + col);
          f32x4 v = *(const f32x4*)(tilef + (size_t)r * 132 + ch * 4);
          x.x += g.x * v[0]; x.y += g.y * v[1]; x.z += g.z * v[2]; x.w += g.w * v[3];
          *(float4*)(xo + col) = x;
        }
        __syncthreads();
      }
    }
    if constexpr (MODE == G_MG0 || MODE == G_MG1 || MODE == G_MG2) {
      constexpr int nb = MODE - G_MG0;
      bf16* MG = (bf16*)(ws + B_HB);
      __syncthreads();
#pragma unroll 2
      for (int it = 0; it < 16; it++) {
        int c = it * NT + tidv;
        int r = c >> 5, ch = c & 31;
        int col = n0 + ch * 8;
        uint4 pv = *(const uint4*)(smem + ((size_t)r * 264 + ch * 8) * 2);
        uint4 gv = *(const uint4*)(Z + (size_t)(m0 + r) * NIN + C_GATE + nb * 2048 + col);
        f32x4 p0 = unpack4(uint2{pv.x, pv.y}), p1 = unpack4(uint2{pv.z, pv.w});
        f32x4 g0 = unpack4(uint2{gv.x, gv.y}), g1 = unpack4(uint2{gv.z, gv.w});
        f32x4 o0 = g0 * p0, o1 = g1 * p1;
        if constexpr (nb > 0) {
          uint4 qv = *(const uint4*)(MG + (size_t)(m0 + r) * 2048 + col);
          o0 += unpack4(uint2{qv.x, qv.y});
          o1 += unpack4(uint2{qv.z, qv.w});
        }
        uint2 a = pack4(o0), b = pack4(o1);
        *(uint4*)(MG + (size_t)(m0 + r) * 2048 + col) = uint4{a.x, a.y, b.x, b.y};
      }
    }
    if constexpr (MODE == G_IN || MODE == G_GLU || MODE == G_M1) {
      bf16* dst;
      int ld;
      if constexpr (MODE == G_IN || MODE == G_GLU) { dst = Z; ld = NIN; }
      else { dst = Z; ld = DFF; }
      __syncthreads();
#pragma unroll 4
      for (int it = 0; it < 16; it++) {
        int c = it * NT + tidv;
        int r = c >> 5, ch = c & 31;
        int col = n0 + ch * 8;
        if (col < N) *(uint4*)(dst + (size_t)(m0 + r) * ld + col) = *(const uint4*)(smem + ((size_t)r * 264 + ch * 8) * 2);
      }
    }
  }
}

DEV void phase_mla_post(int tidv, int bidv, const Params& p, int l) {
  char* ws = p.ws;
  const float* qng = p.in[13] + l * 128;
  const float* qrg = p.in[14] + l * 64;
  const float* kng = p.in[15] + l * 128;
  const float* krg = p.in[16] + l * 64;
  bf16* QB = (bf16*)(ws + B_QB);
  bf16* KN = (bf16*)(ws + B_KN);
  bf16* KR = (bf16*)(ws + B_KR);
  const bf16* Z = (const bf16*)(ws + B_ZB);
  const int wave = tidv >> 6, lane = tidv & 63;
  const float QS = 1.4426950408889634f * 0.07216878364870322f;
  const int idx = lane & 31;
  const float inv = powf(10000.f, -(float)(idx & 15) / 16.f);
  const float gq0 = qng[2 * lane], gq1 = qng[2 * lane + 1], gk0 = kng[2 * lane], gk1 = kng[2 * lane + 1];
  const float gqr = qrg[lane], gkr = krg[lane];
  for (int row = bidv * NW + wave; row < MT; row += gridDim.x * NW) {
    bool lat = row < ML;
    int t = row & 4095;
    float pos = (idx < 16) ? (float)(t >> 6) : (float)(t & 63);
    float ang = pos * inv;
    float cs = 1.f, sn = 0.f;
    if (lat) { cs = cosf(ang); sn = sinf(ang); }
#pragma unroll 1
    for (int h = 0; h < 8; h++) {
      bf16* q = QB + (size_t)row * 1536 + h * 192;
      uint32_t u = *(const uint32_t*)(q + 2 * lane);
      float x0 = bf2f((bf16)(u & 0xffff)), x1 = bf2f((bf16)(u >> 16));
      float ss = wsum_fast(x0 * x0 + x1 * x1);
      float rinv = rsqrtf(ss * (1.f / 128.f) + 1e-6f) * QS;
      *(uint32_t*)(q + 2 * lane) = pack2(x0 * rinv * gq0, x1 * rinv * gq1);
      float xr = bf2f(q[128 + lane]);
      float ss2 = wsum_fast(xr * xr);
      float y = xr * rsqrtf(ss2 * (1.f / 64.f) + 1e-6f) * gqr;
      float yp = __shfl_xor(y, 32);
      float o = lane < 32 ? (y * cs - yp * sn) : (yp * sn + y * cs);
      q[128 + lane] = f2bf(o * QS);
      bf16* k = KN + (size_t)row * 1024 + h * 128;
      uint32_t uk = *(const uint32_t*)(k + 2 * lane);
      float k0 = bf2f((bf16)(uk & 0xffff)), k1 = bf2f((bf16)(uk >> 16));
      float ssk = wsum_fast(k0 * k0 + k1 * k1);
      float rk = rsqrtf(ssk * (1.f / 128.f) + 1e-6f);
      *(uint32_t*)(k + 2 * lane) = pack2(k0 * rk * gk0, k1 * rk * gk1);
    }
    {
      float xr = bf2f(Z[(size_t)row * NIN + C_KR + lane]);
      float ss2 = wsum_fast(xr * xr);
      float y = xr * rsqrtf(ss2 * (1.f / 64.f) + 1e-6f) * gkr;
      float yp = __shfl_xor(y, 32);
      float o = lane < 32 ? (y * cs - yp * sn) : (yp * sn + y * cs);
      KR[(size_t)row * 64 + lane] = f2bf(o);
    }
  }
}

DEV void step_row(int s, int d, int b, int& row, int& tau, int& len) {
  if (s < 256) { tau = d ? 255 - s : s; len = 256; row = ML + b * 256 + tau; }
  else { int q = s - 256; tau = d ? 4095 - q : q; len = 4096; row = b * 4096 + tau; }
}

struct RwPre { bf16 r0, r1, r2, k0, k1, k2, v0, v1, v2, a, e; };

DEV void rwkv_fetch(RwPre& q, const bf16* Z, const bf16* AD, const bf16* ED, int s, int d, int b, int ch) {
  int row, tau, len;
  step_row(s, d, b, row, tau, len);
  const bf16* z = Z + (size_t)row * NIN + C_R + ch;
  q.r1 = z[0]; q.k1 = z[1024]; q.v1 = z[2048];
  q.r0 = 0; q.k0 = 0; q.v0 = 0; q.r2 = 0; q.k2 = 0; q.v2 = 0;
  if (tau > 0) { const bf16* zm = z - NIN; q.r0 = zm[0]; q.k0 = zm[1024]; q.v0 = zm[2048]; }
  if (tau < len - 1) { const bf16* zp = z + NIN; q.r2 = zp[0]; q.k2 = zp[1024]; q.v2 = zp[2048]; }
  q.a = AD[(size_t)row * 1024 + ch];
  q.e = ED[(size_t)row * 1024 + ch];
}

typedef float f2v __attribute__((ext_vector_type(2)));
DEV float dpp_hmirror(float v) {
  int i = __float_as_int(v);
  return __int_as_float(__builtin_amdgcn_update_dpp(0, i, 0x141, 0xF, 0xF, true));
}
DEV f2v lo2(float4 v) { return f2v{v.x, v.y}; }
DEV f2v hi2(float4 v) { return f2v{v.z, v.w}; }

DEV void rwkv_scan(int tidv, int bidv, const Params& p, int l, int chain, char* smem, int dry) {
  char* ws = p.ws;
  float* op = (float*)smem;
  float* vb = op + 16 * 320;
  float* yb = vb + 16 * 64;
  const int tid = tidv, wave = tid >> 6, lane = tid & 63;
  const int d = chain & 1, h = (chain >> 1) & 15, b = chain >> 5;
  const int ch = h * 64 + lane;
  const float* cw = p.in[17] + (size_t)l * 3 * 3072;
  const float cr0 = cw[ch], cr1 = cw[3072 + ch], cr2 = cw[6144 + ch];
  const float ck0 = cw[1024 + ch], ck1 = cw[3072 + 1024 + ch], ck2 = cw[6144 + 1024 + ch];
  const float cv0 = cw[2048 + ch], cv1 = cw[3072 + 2048 + ch], cv2 = cw[6144 + 2048 + ch];
  const float kkc = p.in[23][l * 1024 + ch], kac = p.in[24][l * 1024 + ch];
  const bf16* Z = (const bf16*)(ws + B_ZB);
  bf16* ED = (bf16*)(ws + B_HB + (size_t)d * SZ1K);
  const bf16* AD = (const bf16*)(ws + (d ? B_AB : B_AF));
  f2v A0 = {0.f, 0.f}, A1 = {0.f, 0.f}, B0 = {0.f, 0.f}, B1 = {0.f, 0.f};
  const int ri = lane >> 4, jo = lane & 15, rA = wave * 8 + ri, rB = rA + 4;
  RwPre pre[2];
#pragma unroll
  for (int si = 0; si < 2; si++) rwkv_fetch(pre[si], Z, AD, ED, wave * 2 + si, d, b, ch);
  for (int chunk = 0; chunk < 272; chunk++) {
#pragma unroll
    for (int si = 0; si < 2; si++) {
      int t = wave * 2 + si;
      const RwPre& q = pre[si];
      float rr = cr0 * bf2f(q.r0) + cr1 * bf2f(q.r1) + cr2 * bf2f(q.r2);
      float kk_ = ck0 * bf2f(q.k0) + ck1 * bf2f(q.k1) + ck2 * bf2f(q.k2);
      float vv = cv0 * bf2f(q.v0) + cv1 * bf2f(q.v1) + cv2 * bf2f(q.v2);
      float kkv = kk_ * kkc;
      float ssq = wsum_fast(kkv * kkv);
      float kn = kkv * rsqrtf(ssq + 1e-12f);
      float a = bf2f(q.a);
      float w = __expf(-bf2f(q.e));
      float krep = kk_ * (1.f + (a - 1.f) * kac);
      float* o = op + t * 320;
      o[lane] = w;
      o[64 + lane] = kn * a;
      o[128 + lane] = krep;
      o[192 + lane] = -kn;
      o[256 + lane] = rr;
      vb[t * 64 + lane] = vv;
    }
    __syncthreads();
    if (chunk + 1 < 272) {
#pragma unroll
      for (int si = 0; si < 2; si++) rwkv_fetch(pre[si], Z, AD, ED, (chunk + 1) * 16 + wave * 2 + si, d, b, ch);
    }
    {
      const float4* o4 = (const float4*)op + jo;
      float4 nn = o4[48];
#pragma unroll 4
      for (int t = 0; t < 16; t++) {
        const float4* ot = o4 + t * 80;
        const float4 w = ot[0], a = ot[16], k = ot[32], r = ot[64];
        const float viA = vb[t * 64 + rA], viB = vb[t * 64 + rB];
        const int tn = t < 15 ? t + 1 : 15;
        const float4 mm = o4[tn * 80 + 48];
        f2v svA = A0 * lo2(nn) + A1 * hi2(nn);
        f2v svB = B0 * lo2(nn) + B1 * hi2(nn);
        float saA = svA.x + svA.y, saB = svB.x + svB.y;
        saA += dpp_xor1(saA); saB += dpp_xor1(saB);
        saA += dpp_xor2(saA); saB += dpp_xor2(saB);
        saA += dpp_hmirror(saA); saB += dpp_hmirror(saB);
        saA += dpp_rmirror(saA); saB += dpp_rmirror(saB);
        const f2v sA2 = {saA, saA}, vA2 = {viA, viA}, sB2 = {saB, saB}, vB2 = {viB, viB};
        A0 = A0 * lo2(w) + sA2 * lo2(a) + vA2 * lo2(k);
        B0 = B0 * lo2(w) + sB2 * lo2(a) + vB2 * lo2(k);
        A1 = A1 * hi2(w) + sA2 * hi2(a) + vA2 * hi2(k);
        B1 = B1 * hi2(w) + sB2 * hi2(a) + vB2 * hi2(k);
        f2v yvA = A0 * lo2(r) + A1 * hi2(r);
        f2v yvB = B0 * lo2(r) + B1 * hi2(r);
        yb[(t * 64 + rA) * 16 + jo] = yvA.x + yvA.y;
        yb[(t * 64 + rB) * 16 + jo] = yvB.x + yvB.y;
        nn = mm;
      }
    }
    __syncthreads();
#pragma unroll
    for (int it = 0; it < 2; it++) {
      int idx = it * NT + tid;
      int t = idx >> 6, i = idx & 63;
      int row, tau, len;
      step_row(chunk * 16 + t, d, b, row, tau, len);
      size_t off = (size_t)row * 1024 + h * 64 + i;
      bf16* yd = dry ? (bf16*)(ws + B_END) + (off & 0x3fffff) : ED + off;
      const float4* yp = (const float4*)(yb + (t * 64 + i) * 16);
      const float4 ya = yp[0], yc = yp[1], ye = yp[2], yg = yp[3];
      *yd = f2bf((((ya.x + ya.y) + (ya.z + ya.w)) + ((yc.x + yc.y) + (yc.z + yc.w))) + (((ye.x + ye.y) + (ye.z + ye.w)) + ((yg.x + yg.y) + (yg.z + yg.w))));
    }
  }
}

DEV void s5_scan(int tidv, int bidv, const Params& p, int l, int chain, char* smemw, int dry) {
  char* ws = p.ws;
  const int lane = tidv & 63;
  const int d = chain & 1, g = (chain >> 1) & 63, b = chain >> 7;
  float* ub = (float*)smemw;
  float* hb = ub + 256;
  const size_t pg = (size_t)(l * 2 + d) * 64 + g;
  const float lre = p.in[28][pg * 64 + lane], lim = p.in[29][pg * 64 + lane];
  const float dt = expf(p.in[30][pg]);
  const float mag = expf(lre * dt);
  const float are = mag * cosf(lim * dt), aim = mag * sinf(lim * dt);
  const float den = lre * lre + lim * lim;
  const float qre = ((are - 1.f) * lre + aim * lim) / den;
  const float qim = (aim * lre - (are - 1.f) * lim) / den;
  float bbre[16], bbim[16];
  {
    const float* br = p.in[31] + (pg * 64 + lane) * 16;
    const float* bi = p.in[32] + (pg * 64 + lane) * 16;
#pragma unroll
    for (int i = 0; i < 16; i++) {
      float x = br[i], y = bi[i];
      bbre[i] = qre * x - qim * y;
      bbim[i] = qre * y + qim * x;
    }
  }
  bf16x8 cfr[4];
  {
    const int i = lane & 15, quad = lane >> 4;
    const float* cre = p.in[33] + (pg * 16 + i) * 64;
    const float* cim = p.in[34] + (pg * 16 + i) * 64;
#pragma unroll
    for (int ks = 0; ks < 4; ks++)
#pragma unroll
      for (int j = 0; j < 8; j++) {
        int k = ks * 32 + quad * 8 + j;
        float c = ks < 2 ? cre[k] : -cim[k - 64];
        cfr[ks][j] = (short)f2bf(c);
      }
  }
  float hre = 0.f, him = 0.f;
  const bf16* Z = (const bf16*)(ws + B_ZB);
  const int tt = lane >> 2, i0 = (lane & 3) * 4;
  uint2 unext;
  {
    int row, tau, len;
    step_row(tt, d, b, row, tau, len);
    unext = *(const uint2*)(Z + (size_t)row * NIN + C_U + g * 16 + i0);
  }
  for (int chunk = 0; chunk < 272; chunk++) {
    {
      uint2 u = unext;
      float4 f;
      f.x = bf2f((bf16)(u.x & 0xffff)); f.y = bf2f((bf16)(u.x >> 16));
      f.z = bf2f((bf16)(u.y & 0xffff)); f.w = bf2f((bf16)(u.y >> 16));
      *(float4*)(ub + tt * 16 + i0) = f;
    }
    __syncthreads();
    if (chunk + 1 < 272) {
      int row, tau, len;
      step_row((chunk + 1) * 16 + tt, d, b, row, tau, len);
      unext = *(const uint2*)(Z + (size_t)row * NIN + C_U + g * 16 + i0);
    }
#pragma unroll 2
    for (int t = 0; t < 16; t++) {
      const float* u = ub + t * 16;
      float br0 = 0.f, bi0 = 0.f;
#pragma unroll
      for (int i = 0; i < 16; i++) { float uv = u[i]; br0 += bbre[i] * uv; bi0 += bbim[i] * uv; }
      float nr = are * hre - aim * him + br0;
      float ni = are * him + aim * hre + bi0;
      hre = nr; him = ni;
      hb[t * 132 + lane] = hre;
      hb[t * 132 + 64 + lane] = him;
    }
    __syncthreads();
    {
      f32x4 yacc = {0.f, 0.f, 0.f, 0.f};
      const float* hr = hb + (lane & 15) * 132 + (lane >> 4) * 8;
#pragma unroll
      for (int ks = 0; ks < 4; ks++) {
        float4 x0 = *(const float4*)(hr + ks * 32), x1 = *(const float4*)(hr + ks * 32 + 4);
        union { bf16x8 v; uint32_t u[4]; } af;
        af.u[0] = pack2(x0.x, x0.y); af.u[1] = pack2(x0.z, x0.w);
        af.u[2] = pack2(x1.x, x1.y); af.u[3] = pack2(x1.z, x1.w);
        yacc = __builtin_amdgcn_mfma_f32_16x16x32_bf16(af.v, cfr[ks], yacc, 0, 0, 0);
      }
      const int ii = lane & 15;
#pragma unroll
      for (int r = 0; r < 4; r++) {
        int row, tau, len;
        step_row(chunk * 16 + (lane >> 4) * 4 + r, d, b, row, tau, len);
        bf16* dst = d == 0 ? (bf16*)(ws + B_SY) + (size_t)row * 1024 + g * 16 + ii : (bf16*)(ws + B_ZB) + (size_t)row * NIN + g * 16 + ii;
        if (dry) dst = (bf16*)(ws + B_END) + ((((size_t)row * 1024 + g * 16 + ii)) & 0x3fffff);
        *dst = f2bf(yacc[r]);
      }
    }
    __syncthreads();
  }
}

DEV int perm23(int r) { return (r & 0x13) | ((r & 4) << 1) | ((r & 8) >> 1); }

DEV void attn_item(int tidv, int bidv, const Params& p, int item, bool ctxq, char* smem, int dry) {
  char* ws = p.ws;
  bf16* sK = (bf16*)smem;
  bf16* sV = sK + 64 * 200;
  const int tid = tidv, wave = tid >> 6, lane = tid & 63;
  const int r = lane & 31, hf = lane >> 5;
  int b, hd, qt;
  if (!ctxq) { b = item >> 7; hd = (item >> 4) & 7; qt = item & 15; }
  else { b = item >> 3; hd = item & 7; qt = 0; }
  const int qrow0 = ctxq ? ML + b * 256 : b * 4096 + qt * 256;
  const int kt0 = ctxq ? 64 : 0, kt1 = 68;
  bf16* QB = (bf16*)(ws + B_QB);
  const bf16* KN = (const bf16*)(ws + B_KN);
  const bf16* KR = (const bf16*)(ws + B_KR);
  const bf16* VT = (const bf16*)(ws + B_VT);
  bf16x8 qf[12];
  {
    const bf16* qp = QB + (size_t)(qrow0 + wave * 32 + r) * 1536 + hd * 192 + hf * 8;
#pragma unroll
    for (int kk = 0; kk < 12; kk++) qf[kk] = *(const bf16x8*)(qp + kk * 16);
  }
  f32x16 oacc[4];
#pragma unroll
  for (int i = 0; i < 4; i++)
#pragma unroll
    for (int e = 0; e < 16; e++) oacc[i][e] = 0.f;
  float mrun = -1e30f, lrun = 0.f;
  const int pr = perm23(r);
  const uint32_t vo_n = (uint32_t)((tid >> 4) * 2048 + (tid & 15) * 16);
  const uint32_t lo_n = (uint32_t)((tid >> 4) * 400 + (tid & 15) * 16);
  const uint32_t vo_r = (uint32_t)((tid >> 3) * 128 + (tid & 7) * 16);
  const uint32_t lo_r = (uint32_t)((tid >> 3) * 400 + 256 + (tid & 7) * 16);
  const uint32_t vo_v = (uint32_t)((tid >> 3) * (NKEY * 2) + (tid & 7) * 16);
  const uint32_t lo_v = (uint32_t)((tid >> 3) * 144 + (tid & 7) * 16);
  uint4 t0, t1, t4, u0, u1;
#define ATT_LOAD(KT)                                                                                   \
  {                                                                                                    \
    const int key0_ = (KT) * 64;                                                                       \
    const int rowbase_ = key0_ < 4096 ? b * 4096 + key0_ : ML + b * 256 + (key0_ - 4096);               \
    const char* bk = (const char*)(KN + (size_t)rowbase_ * 1024 + hd * 128);                           \
    const char* br = (const char*)(KR + (size_t)rowbase_ * 64);                                        \
    const char* bv = (const char*)(VT + ((size_t)((b * 8 + hd) * 128)) * NKEY + key0_);                \
    t0 = *(const uint4*)(bk + vo_n);                                                                   \
    t1 = *(const uint4*)(bk + 32 * 2048 + vo_n);                                                       \
    t4 = *(const uint4*)(br + vo_r);                                                                   \
    u0 = *(const uint4*)(bv + vo_v);                                                                   \
    u1 = *(const uint4*)(bv + (size_t)64 * NKEY * 2 + vo_v);                                           \
  }
  ATT_LOAD(kt0)
  for (int kt = kt0; kt < kt1; kt++) {
    __syncthreads();
    *(uint4*)((char*)sK + lo_n) = t0;
    *(uint4*)((char*)sK + 32 * 400 + lo_n) = t1;
    *(uint4*)((char*)sK + lo_r) = t4;
    *(uint4*)((char*)sV + lo_v) = u0;
    *(uint4*)((char*)sV + 64 * 144 + lo_v) = u1;
    __syncthreads();
    ATT_LOAD((kt + 1 < kt1 ? kt + 1 : kt1 - 1))
    f32x16 sacc[2];
#pragma unroll
    for (int m = 0; m < 2; m++) {
#pragma unroll
      for (int e = 0; e < 16; e++) sacc[m][e] = 0.f;
      const bf16* kp = sK + (m * 32 + pr) * 200 + hf * 8;
#pragma unroll
      for (int kk = 0; kk < 12; kk++) {
        bf16x8 kf = *(const bf16x8*)(kp + kk * 16);
        sacc[m] = __builtin_amdgcn_mfma_f32_32x32x16_bf16(kf, qf[kk], sacc[m], 0, 0, 0);
        if ((kk & 3) == 3) __builtin_amdgcn_sched_barrier(0);
      }
      __builtin_amdgcn_sched_barrier(0);
    }
    float tmax = sacc[0][0];
#pragma unroll
    for (int e = 1; e < 16; e++) tmax = fmaxf(tmax, sacc[0][e]);
#pragma unroll
    for (int e = 0; e < 16; e++) tmax = fmaxf(tmax, sacc[1][e]);
    tmax = fmaxf(tmax, __shfl_xor(tmax, 32));
    float mnew = fmaxf(mrun, tmax);
    float alpha = __builtin_amdgcn_exp2f(mrun - mnew);
    mrun = mnew;
    float psum = 0.f;
#pragma unroll
    for (int m = 0; m < 2; m++)
#pragma unroll
      for (int e = 0; e < 16; e++) { float pv = __builtin_amdgcn_exp2f(sacc[m][e] - mnew); sacc[m][e] = pv; psum += pv; }
    lrun = lrun * alpha + psum;
#pragma unroll
    for (int i = 0; i < 4; i++)
#pragma unroll
      for (int e = 0; e < 16; e++) oacc[i][e] *= alpha;
#pragma unroll
    for (int s = 0; s < 4; s++) {
      const int m = s >> 1, s2 = s & 1;
      bf16x8 pf;
#pragma unroll
      for (int j = 0; j < 8; j++) pf[j] = (short)f2bf(sacc[m][8 * s2 + j]);
#pragma unroll
      for (int i = 0; i < 4; i++) {
        bf16x8 vf = *(const bf16x8*)(sV + (i * 32 + r) * 72 + m * 32 + s2 * 16 + hf * 8);
        oacc[i] = __builtin_amdgcn_mfma_f32_32x32x16_bf16(vf, pf, oacc[i], 0, 0, 0);
      }
      __builtin_amdgcn_sched_barrier(0);
    }
  }
#undef ATT_LOAD
  lrun += __shfl_xor(lrun, 32);
  const float inv = 1.f / lrun;
  bf16* op = QB + (size_t)(qrow0 + wave * 32 + r) * 1536 + hd * 192;
  if (dry) op = (bf16*)(ws + B_END) + ((((size_t)(qrow0 + wave * 32 + r) * 1536 + hd * 192)) & 0x3ffff8);
#pragma unroll
  for (int i = 0; i < 4; i++)
#pragma unroll
    for (int g = 0; g < 4; g++) {
      uint2 o;
      o.x = pack2(oacc[i][4 * g] * inv, oacc[i][4 * g + 1] * inv);
      o.y = pack2(oacc[i][4 * g + 2] * inv, oacc[i][4 * g + 3] * inv);
      *(uint2*)(op + 32 * i + 8 * g + 4 * hf) = o;
    }
}

DEV void phase_mixers(int tidv, int bidv, const Params& p, int l, char* smem, int dry) {
  int* s_item = (int*)(smem + SM_ITEM);
#ifdef PROBE_PARTS
  const int parts = dry ? PROBE_PARTS : 7;
#else
  const int parts = 7;
#endif
  for (int task = bidv; task < 192; task += gridDim.x) {
    if (task < 128 && !(parts & 1)) continue;
    if (task >= 128 && !(parts & 2)) continue;
    if (task < 128) rwkv_scan(tidv, bidv, p, l, task, smem, dry);
    else s5_scan(tidv, bidv, p, l, (task - 128) * 8 + (tidv >> 6), smem + (tidv >> 6) * 9472, dry);
  }
  const int nlat = 512, ntot = (parts & 4) ? ((l == 0) ? 544 : 512) : 0;
  int* cnt = (int*)(p.ws + B_CNT) + l + 2 * dry;
#if !defined(MIX_ONLY) || MIX_ONLY == 2
  while (true) {
    __syncthreads();
    if (tidv == 0) *s_item = atomicAdd(cnt, 1);
    __syncthreads();
    int item = *s_item;
    if (item >= ntot) break;
    if (item < nlat) attn_item(tidv, bidv, p, item, false, smem, dry);
    else attn_item(tidv, bidv, p, item - nlat, true, smem, dry);
  }
#endif
}

DEV float gelu_tanh(float x) {
  float u = 0.7978845608028654f * (x + 0.044715f * x * x * x);
  return 0.5f * x * (1.f + tanhf(u));
}

DEV void phase_post(int tidv, int bidv, const Params& p, int l, int M) {
  char* ws = p.ws;
  const bf16* Z = (const bf16*)(ws + B_ZB);
  const int wave = tidv >> 6, lane = tidv & 63;
  const float* cw = p.in[17] + (size_t)l * 3 * 3072;
  const bf16* YF = (const bf16*)(ws + B_HB);
  const bf16* YB = (const bf16*)(ws + B_HB + SZ1K);
  const bf16* AF = (const bf16*)(ws + B_AF);
  const bf16* AB = (const bf16*)(ws + B_AB);
  bf16* GB = (bf16*)(ws + B_GB);
  const int nitem = M * 16;
  for (int it = bidv * NW + wave; it < nitem; it += gridDim.x * NW) {
    int row = it >> 4, h = it & 15;
    int ch = h * 64 + lane;
    int tau, len;
    if (row < ML) { tau = row & 4095; len = 4096; } else { tau = (row - ML) & 255; len = 256; }
    size_t o = (size_t)row * 1024 + ch;
    float y = bf2f(YF[o]) + bf2f(YB[o]);
    float mu = wsum_fast(y) * (1.f / 64.f);
    float dv = y - mu;
    float var = wsum_fast(dv * dv) * (1.f / 64.f);
    float yn = dv * rsqrtf(var + 64e-5f) * p.in[26][l * 1024 + ch] + p.in[27][l * 1024 + ch];
    const bf16* z = Z + (size_t)row * NIN + C_R + ch;
    float r1 = bf2f(z[0]), k1 = bf2f(z[1024]), v1 = bf2f(z[2048]);
    float r0 = 0.f, k0 = 0.f, v0 = 0.f, r2 = 0.f, k2 = 0.f, v2 = 0.f;
    if (tau > 0) { const bf16* zm = z - NIN; r0 = bf2f(zm[0]); k0 = bf2f(zm[1024]); v0 = bf2f(zm[2048]); }
    if (tau < len - 1) { const bf16* zp = z + NIN; r2 = bf2f(zp[0]); k2 = bf2f(zp[1024]); v2 = bf2f(zp[2048]); }
    float rr = cw[ch] * r0 + cw[3072 + ch] * r1 + cw[6144 + ch] * r2;
    float kk = cw[1024 + ch] * k0 + cw[3072 + 1024 + ch] * k1 + cw[6144 + 1024 + ch] * k2;
    float vv = cw[2048 + ch] * v0 + cw[3072 + 2048 + ch] * v1 + cw[6144 + 2048 + ch] * v2;
    float am = 0.5f * (bf2f(AF[o]) + bf2f(AB[o]));
    float kbon = kk * (1.f + (am - 1.f) * p.in[24][l * 1024 + ch]);
    float s = wsum_fast(rr * kbon * p.in[25][l * 1024 + ch]);
    float outv = (yn + s * vv) * bf2f(GB[o]);
    GB[o] = f2bf(outv);
  }
  bf16* SY = (bf16*)(ws + B_SY);
  const float* dsk = p.in[35] + l * 1024;
  const int n4 = M * 256;
  for (int i = bidv * NT + tidv; i < n4; i += gridDim.x * NT) {
    int row = i >> 8, c = (i & 255) * 4;
    uint2 a = *(const uint2*)(SY + (size_t)row * 1024 + c);
    uint2 bq = *(const uint2*)(Z + (size_t)row * NIN + c);
    uint2 u = *(const uint2*)(Z + (size_t)row * NIN + C_U + c);
    float4 dd = *(const float4*)(dsk + c);
    float y0 = bf2f((bf16)(a.x & 0xffff)) + bf2f((bf16)(bq.x & 0xffff)) + dd.x * bf2f((bf16)(u.x & 0xffff));
    float y1 = bf2f((bf16)(a.x >> 16)) + bf2f((bf16)(bq.x >> 16)) + dd.y * bf2f((bf16)(u.x >> 16));
    float y2 = bf2f((bf16)(a.y & 0xffff)) + bf2f((bf16)(bq.y & 0xffff)) + dd.z * bf2f((bf16)(u.y & 0xffff));
    float y3 = bf2f((bf16)(a.y >> 16)) + bf2f((bf16)(bq.y >> 16)) + dd.w * bf2f((bf16)(u.y >> 16));
    uint2 o;
    o.x = pack2(gelu_tanh(y0), gelu_tanh(y1));
    o.y = pack2(gelu_tanh(y2), gelu_tanh(y3));
    *(uint2*)(SY + (size_t)row * 1024 + c) = o;
  }
}

constexpr int NPH = 25;

DEV void run_phase(int tidv, int bidv, const Params& p, int ph, char* smem, int dry) {
  char* ws = p.ws;
#ifndef ONLY_S
  if (ph == 0) {
    if (bidv == 0 && tidv < 4) ((int*)(ws + B_CNT))[tidv] = 0;
    phase_mod(tidv, bidv, p, smem);
    phase_convw(tidv, bidv, p, 0, smem);
    return;
  }
#endif
  const int l = (ph - 1) / 12, s = (ph - 1) % 12;
#ifdef ONLY_S
  if (s != ONLY_S) return;
#endif
  const bf16* wb = (const bf16*)(ws + B_WB);
  const float* mod = (const float*)(ws + B_MOD) + (size_t)l * 5 * 12288;
  float* XC = (float*)(ws + B_XC);
  const float* xin_lat = l == 0 ? p.in[0] : p.out;
  const float* xin_ctx = l == 0 ? p.in[2] : XC;
  bf16* HB = (bf16*)(ws + B_HB);
  bf16* Z = (bf16*)(ws + B_ZB);
  bf16* H2 = (bf16*)(ws + B_KN);
  const int Mpost = l == 0 ? MT : ML;
  switch (s) {
    case 0:
      if (l == 1) phase_convw(tidv, bidv, p, 1, smem);
      phase_norm(tidv, bidv, xin_lat, xin_ctx, p.in[6] + l * 2048, mod, 0, 2048, HB, MT);
      break;
    case 1:
      run_gemm<G_IN>(tidv, bidv, p, l, smem, HB, 2048, wb + OW_IN, 2048, NIN, MT, 0, nullptr, nullptr, nullptr, nullptr);
      break;
    case 2:
#if !defined(PH2_ONLY) || PH2_ONLY == 0
      run_gemm<G_UKV>(tidv, bidv, p, l, smem, Z + C_CKV, NIN, wb + OW_UKV, 512, 2048, MT, 0, nullptr, nullptr, nullptr, nullptr);
#endif
#if !defined(PH2_ONLY) || PH2_ONLY == 1
      run_gemm<G_UQ>(tidv, bidv, p, l, smem, Z + C_CQ, NIN, wb + OW_UQ, 512, 1536, MT, 0, nullptr, nullptr, nullptr, nullptr);
#endif
#if !defined(PH2_ONLY) || PH2_ONLY == 2
      run_gemm<G_G2>(tidv, bidv, p, l, smem, Z + C_GD, NIN, wb + OW_G2, 192, 1024, MT, 0, nullptr, nullptr, nullptr, nullptr);
#endif
#if !defined(PH2_ONLY) || PH2_ONLY == 3
      for (int d = 0; d < 2; d++) {
        run_gemm<G_W2>(tidv, bidv, p, l, smem, Z + C_WD + 64 * d, NIN, wb + OW_W2 + (size_t)d * 65536, 64, 1024, MT, d, nullptr, nullptr, nullptr, nullptr);
        run_gemm<G_A2>(tidv, bidv, p, l, smem, Z + C_AD + 64 * d, NIN, wb + OW_A2 + (size_t)d * 65536, 64, 1024, MT, d, nullptr, nullptr, nullptr, nullptr);
      }
#endif
      break;
    case 3: phase_mla_post(tidv, bidv, p, l); break;
    case 4: phase_mixers(tidv, bidv, p, l, smem, dry); break;
    case 5: phase_post(tidv, bidv, p, l, Mpost); break;
    case 6:
      run_gemm<G_GLU>(tidv, bidv, p, l, smem, (const bf16*)(ws + B_SY), 1024, wb + OW_GLU, 1024, 1024, Mpost, 0, nullptr, nullptr, nullptr, nullptr);
      break;
    case 7:
      run_gemm<G_MG0>(tidv, bidv, p, l, smem, (const bf16*)(ws + B_QB), 1536, wb + OW_BR, 1024, 2048, Mpost, 0, nullptr, nullptr, nullptr, nullptr);
      run_gemm<G_MG1>(tidv, bidv, p, l, smem, (const bf16*)(ws + B_GB), 1024, wb + OW_BR + (size_t)2048 * 1024, 1024, 2048, Mpost, 0, nullptr, nullptr, nullptr, nullptr);
      run_gemm<G_MG2>(tidv, bidv, p, l, smem, Z, NIN, wb + OW_BR + (size_t)2 * 2048 * 1024, 1024, 2048, Mpost, 0, nullptr, nullptr, nullptr, nullptr);
      break;
    case 8:
      run_gemm<G_OUT>(tidv, bidv, p, l, smem, HB, 2048, wb + OW_OUT, 2048, 2048, Mpost, 0, xin_lat, xin_ctx, p.out, XC);
      break;
    case 9:
      phase_norm(tidv, bidv, p.out, XC, p.in[7] + l * 2048, mod, 6144, 8192, H2, Mpost);
      break;
    case 10:
      run_gemm<G_M1>(tidv, bidv, p, l, smem, H2, 2048, wb + OW_M1, 2048, 8192, Mpost, 0, nullptr, nullptr, nullptr, nullptr);
      break;
    case 11:
      run_gemm<G_M2>(tidv, bidv, p, l, smem, Z, 8192, wb + OW_M2, 8192, 2048, Mpost, 0, nullptr, nullptr, p.out, XC);
      break;
  }
}

DEV void grid_barrier(unsigned* cnt, unsigned target) {
  asm volatile("s_waitcnt vmcnt(0)" ::: "memory");
  __syncthreads();
  if (threadIdx.x == 0) {
    __builtin_amdgcn_fence(__ATOMIC_RELEASE, "agent");
    asm volatile("s_waitcnt vmcnt(0)" ::: "memory");
    __hip_atomic_fetch_add(cnt, 1u, __ATOMIC_RELAXED, __HIP_MEMORY_SCOPE_AGENT);
    unsigned spins = 0;
    while (__hip_atomic_load(cnt, __ATOMIC_RELAXED, __HIP_MEMORY_SCOPE_AGENT) < target) {
      __builtin_amdgcn_s_sleep(1);
      if (++spins > (1u << 21)) break;
    }
    __builtin_amdgcn_fence(__ATOMIC_ACQUIRE, "agent");
    asm volatile("s_waitcnt vmcnt(0)" ::: "memory");
  }
  __syncthreads();
}

__global__ void __launch_bounds__(NT) fwd_megakernel(Params p, int ph0, int ph1, int dryflag) {
  extern __shared__ __attribute__((aligned(16))) char smem[];
  for (int ph = ph0; ph < ph1; ph++) {
    int tidv = threadIdx.x, bidv = blockIdx.x;
    asm volatile("" : "+v"(tidv));
    asm volatile("" : "+s"(bidv));
#ifdef PROBE_MASK
    if (dryflag && ((ph == 0 && (PROBE_MASK & 0x1000)) || (ph > 0 && ((PROBE_MASK >> ((ph - 1) % 12)) & 1)))) {
      run_phase(tidv, bidv, p, ph, smem, dryflag);
      cg::this_grid().sync();
    }
#endif
    run_phase(tidv, bidv, p, ph, smem, 0);
    if (ph + 1 < ph1) {
      if (ph == ph0) cg::this_grid().sync();
      else grid_barrier((unsigned*)(p.ws + B_FLG), (unsigned)(ph - ph0) * gridDim.x);
    }
  }
}

extern "C" void kernel_launch(void* const* d_in, const int* in_sizes, int n_in, void* d_out, int out_size, void* d_ws, size_t ws_size,
                              hipStream_t stream) {
  static int grid_blocks = 0;
  if (!grid_blocks) {
    int dev = 0, cus = 0, per_cu = 0;
    (void)hipGetDevice(&dev);
    (void)hipDeviceGetAttribute(&cus, hipDeviceAttributeMultiprocessorCount, dev);
    if (hipFuncSetAttribute((const void*)fwd_megakernel, hipFuncAttributeMaxDynamicSharedMemorySize, LDS_BYTES) != hipSuccess) {
      fprintf(stderr, "hipFuncSetAttribute(%d B dynamic LDS) failed\n", LDS_BYTES);
      return;
    }
    if (hipOccupancyMaxActiveBlocksPerMultiprocessor(&per_cu, (const void*)fwd_megakernel, NT, LDS_BYTES) != hipSuccess || per_cu < 1) {
      fprintf(stderr, "occupancy query failed / kernel not resident\n");
      return;
    }
    grid_blocks = cus;
  }
  Params p{};
  for (int i = 0; i < 42; i++) p.in[i] = (const float*)d_in[i];
  p.out = (float*)d_out;
  p.ws = (char*)d_ws;
  if (ws_size < B_END + (8u << 20)) { fprintf(stderr, "workspace too small\n"); return; }
  int ph0 = 0, ph1 = NPH;
  int dryflag = 1;
  void* args[] = {&p, &ph0, &ph1, &dryflag};
  (void)hipMemsetAsync((char*)d_ws + B_FLG, 0, 4096, stream);
  hipError_t e = hipLaunchCooperativeKernel((void*)fwd_megakernel, dim3(grid_blocks), dim3(NT), args, LDS_BYTES, stream);
  if (e != hipSuccess) fprintf(stderr, "cooperative launch failed: %s (grid %d)\n", hipGetErrorString(e), grid_blocks);
}
```

```cpp
#include <hip/hip_runtime.h>
#include <hip/hip_cooperative_groups.h>
#include <stdint.h>
#include <cstdio>
namespace cg = cooperative_groups;

#ifndef MULTI_LAUNCH
#define MULTI_LAUNCH 0
#endif

typedef unsigned short bf16;
using bf16x8 = __attribute__((ext_vector_type(8))) short;
using f32x4 = __attribute__((ext_vector_type(4))) float;
using f32x16 = __attribute__((ext_vector_type(16))) float;

#define DEV __device__ __forceinline__
constexpr int NT = 512, NW = 8;

constexpr int DM = 2048, ML = 16384, MC = 1024, MT = 17408, NIN = 11744, DFF = 8192, NKEY = 4352;
constexpr int C_CQ = 0, C_CKV = 512, C_KR = 1024, C_R = 1088, C_WD = 4160, C_AD = 4288, C_GD = 4416, C_U = 4576, C_GATE = 5600;

constexpr size_t OW_IN = 0;
constexpr size_t OW_UQ = OW_IN + (size_t)NIN * 2048;
constexpr size_t OW_UKV = OW_UQ + 1536 * 512;
constexpr size_t OW_W2 = OW_UKV + 2048 * 512;
constexpr size_t OW_A2 = OW_W2 + 2 * 1024 * 64;
constexpr size_t OW_G2 = OW_A2 + 2 * 1024 * 64;
constexpr size_t OW_GLU = OW_G2 + 1024 * 192;
constexpr size_t OW_BR = OW_GLU + 1024 * 1024;
constexpr size_t OW_OUT = OW_BR + (size_t)3 * 2048 * 1024;
constexpr size_t OW_M1 = OW_OUT + (size_t)2048 * 2048;
constexpr size_t OW_M2 = OW_M1 + (size_t)8192 * 2048;
constexpr size_t OW_END = OW_M2 + (size_t)8192 * 2048;

constexpr size_t SZ1K = (size_t)MT * 1024 * 2;
constexpr size_t B_WB = 0;
constexpr size_t B_HB = B_WB + OW_END * 2;
constexpr size_t B_ZB = B_HB + (size_t)MT * 2048 * 2;
constexpr size_t B_QB = B_ZB + (size_t)MT * NIN * 2;
constexpr size_t B_KN = B_QB + (size_t)MT * 1536 * 2;
constexpr size_t B_VT = B_KN + SZ1K;
constexpr size_t B_KR = B_VT + SZ1K;
constexpr size_t B_AF = B_KR + (size_t)MT * 64 * 2;
constexpr size_t B_AB = B_AF + SZ1K;
constexpr size_t B_GB = B_AB + SZ1K;
constexpr size_t B_SY = B_GB + SZ1K;
constexpr size_t B_XC = B_SY + SZ1K;
constexpr size_t B_MOD = B_XC + (size_t)MC * 2048 * 4;
constexpr size_t B_CNT = B_MOD + (size_t)2 * 5 * 12288 * 4;
constexpr size_t B_FLG = B_CNT + 256;
constexpr size_t B_END = B_FLG + 4096;

struct Params {
  const float* in[42];
  float* out;
  char* ws;
};

typedef __attribute__((ext_vector_type(2))) __bf16 hbf2;
DEV bf16 f2bf(float f) {
  __bf16 h = (__bf16)f;
  return *(unsigned short*)&h;
}
DEV float bf2f(bf16 h) { return __uint_as_float(((uint32_t)h) << 16); }
DEV uint32_t pack2(float a, float b) {
  hbf2 v;
  v[0] = (__bf16)a;
  v[1] = (__bf16)b;
  return *(uint32_t*)&v;
}
DEV float wsum(float v) {
#pragma unroll
  for (int o = 32; o > 0; o >>= 1) v += __shfl_xor(v, o);
  return v;
}
DEV float dpp_xor1(float v) {
  int i = __float_as_int(v);
  return __int_as_float(__builtin_amdgcn_update_dpp(0, i, 0xB1, 0xF, 0xF, true));
}
DEV float dpp_xor2(float v) {
  int i = __float_as_int(v);
  return __int_as_float(__builtin_amdgcn_update_dpp(0, i, 0x4E, 0xF, 0xF, true));
}
DEV float dpp_rmirror(float v) {
  int i = __float_as_int(v);
  return __int_as_float(__builtin_amdgcn_update_dpp(0, i, 0x140, 0xF, 0xF, true));
}
DEV float dpp_hmirror0(float v) {
  int i = __float_as_int(v);
  return __int_as_float(__builtin_amdgcn_update_dpp(0, i, 0x141, 0xF, 0xF, true));
}
DEV float wsum_fast(float v) {
  v += dpp_xor1(v);
  v += dpp_xor2(v);
  v += dpp_hmirror0(v);
  v += dpp_rmirror(v);
  v += __shfl_xor(v, 16);
  v += __shfl_xor(v, 32);
  return v;
}
DEV float sigmoidf_(float x) { return __builtin_amdgcn_rcpf(1.f + __expf(-x)); }

DEV void phase_mod(int tidv, int bidv, const Params& p, char* smem) {
  float* s_in = (float*)smem;
  float* red = s_in + 5 * 2048;
  float* mod = (float*)(p.ws + B_MOD);
  for (int i = tidv; i < 5 * 2048; i += NT) {
    int r = i >> 11, k = i & 2047;
    float v = r < 4 ? p.in[1][r * 2048 + k] : p.in[3][k];
    s_in[i] = v / (1.f + expf(-v));
  }
  __syncthreads();
  int kg = tidv >> 6, c = tidv & 63;
  for (int task = bidv; task < 2 * 192; task += gridDim.x) {
    int l = task / 192, n = (task % 192) * 64 + c;
    const float* w = p.in[4] + (size_t)l * 2048 * 12288 + n;
    float a0 = 0, a1 = 0, a2 = 0, a3 = 0, a4 = 0;
    int kb = kg * 256;
#pragma unroll 8
    for (int k = 0; k < 256; k++) {
      float wv = w[(size_t)(kb + k) * 12288];
      a0 += s_in[kb + k] * wv;
      a1 += s_in[2048 + kb + k] * wv;
      a2 += s_in[4096 + kb + k] * wv;
      a3 += s_in[6144 + kb + k] * wv;
      a4 += s_in[8192 + kb + k] * wv;
    }
    red[(kg * 5 + 0) * 64 + c] = a0;
    red[(kg * 5 + 1) * 64 + c] = a1;
    red[(kg * 5 + 2) * 64 + c] = a2;
    red[(kg * 5 + 3) * 64 + c] = a3;
    red[(kg * 5 + 4) * 64 + c] = a4;
    __syncthreads();
    if (kg == 0) {
      float bias = p.in[5][l * 12288 + n];
#pragma unroll
      for (int r = 0; r < 5; r++) {
        float v = 0.f;
#pragma unroll
        for (int g = 0; g < 8; g++) v += red[(g * 5 + r) * 64 + c];
        mod[(size_t)(l * 5 + r) * 12288 + n] = v + bias;
      }
    }
    __syncthreads();
  }
}

DEV void convT(int tidv, int bidv, const float* __restrict__ src, bf16* __restrict__ dst, int K, int N, const float* __restrict__ gain, char* smem, int dK = 0) {
  if (dK == 0) dK = K;
  float* t = (float*)smem;
  const int tk = (K + 63) >> 6, tn = (N + 63) >> 6, ntile = tk * tn;
  const int kk = tidv >> 4, n4 = (tidv & 15) * 4;
  float4 c0 = {0.f, 0.f, 0.f, 0.f}, c1 = {0.f, 0.f, 0.f, 0.f};
#define CV_LOAD(TILE)                                                                      \
  {                                                                                        \
    const int k0_ = ((TILE) / tn) * 64, n0_ = ((TILE) % tn) * 64;                          \
    c0 = float4{0.f, 0.f, 0.f, 0.f}; c1 = c0;                                              \
    if (n0_ + n4 < N) {                                                                    \
      if (k0_ + kk < K) { c0 = *(const float4*)(src + (size_t)(k0_ + kk) * N + n0_ + n4);  \
        if (gain) { float g = gain[k0_ + kk]; c0.x *= g; c0.y *= g; c0.z *= g; c0.w *= g; } }          \
      if (k0_ + kk + 32 < K) { c1 = *(const float4*)(src + (size_t)(k0_ + kk + 32) * N + n0_ + n4);    \
        if (gain) { float g = gain[k0_ + kk + 32]; c1.x *= g; c1.y *= g; c1.z *= g; c1.w *= g; } }     \
    }                                                                                      \
  }
  if (bidv < ntile) CV_LOAD(bidv)
  for (int tile = bidv; tile < ntile; tile += gridDim.x) {
    int k0 = (tile / tn) * 64, n0 = (tile % tn) * 64;
    __syncthreads();
    t[kk * 65 + n4 + 0] = c0.x; t[kk * 65 + n4 + 1] = c0.y; t[kk * 65 + n4 + 2] = c0.z; t[kk * 65 + n4 + 3] = c0.w;
    t[(kk + 32) * 65 + n4 + 0] = c1.x; t[(kk + 32) * 65 + n4 + 1] = c1.y; t[(kk + 32) * 65 + n4 + 2] = c1.z; t[(kk + 32) * 65 + n4 + 3] = c1.w;
    __syncthreads();
    if (tile + (int)gridDim.x < ntile) CV_LOAD(tile + (int)gridDim.x)
    {
      int c = tidv;
      int nn = c >> 3, kc = c & 7;
      if (n0 + nn < N && k0 + kc * 8 < dK) {
        uint4 o;
        o.x = pack2(t[(kc * 8 + 0) * 65 + nn], t[(kc * 8 + 1) * 65 + nn]);
        o.y = pack2(t[(kc * 8 + 2) * 65 + nn], t[(kc * 8 + 3) * 65 + nn]);
        o.z = pack2(t[(kc * 8 + 4) * 65 + nn], t[(kc * 8 + 5) * 65 + nn]);
        o.w = pack2(t[(kc * 8 + 6) * 65 + nn], t[(kc * 8 + 7) * 65 + nn]);
        *(uint4*)(dst + (size_t)(n0 + nn) * dK + k0 + kc * 8) = o;
      }
    }
  }
#undef CV_LOAD
}

DEV void phase_convw(int tidv, int bidv, const Params& p, int l, char* smem) {
  bf16* wb = (bf16*)(p.ws + B_WB);
  convT(tidv, bidv, p.in[8] + (size_t)l * 2048 * NIN, wb + OW_IN, 2048, NIN, nullptr, smem);
  convT(tidv, bidv, p.in[40] + (size_t)l * 2048 * 8192, wb + OW_M1, 2048, 8192, nullptr, smem);
  convT(tidv, bidv, p.in[41] + (size_t)l * 8192 * 2048, wb + OW_M2, 8192, 2048, nullptr, smem);
  for (int n = 0; n < 3; n++)
    convT(tidv, bidv, p.in[38] + (size_t)(l * 3 + n) * 1024 * 2048, wb + OW_BR + (size_t)n * 2048 * 1024, 1024, 2048, nullptr, smem);
  convT(tidv, bidv, p.in[39] + (size_t)l * 2048 * 2048, wb + OW_OUT, 2048, 2048, nullptr, smem);
  convT(tidv, bidv, p.in[11] + (size_t)l * 512 * 1536, wb + OW_UQ, 512, 1536, p.in[9] + l * 512, smem);
  convT(tidv, bidv, p.in[12] + (size_t)l * 512 * 2048, wb + OW_UKV, 512, 2048, p.in[10] + l * 512, smem);
  convT(tidv, bidv, p.in[36] + (size_t)l * 1024 * 1024, wb + OW_GLU, 1024, 1024, nullptr, smem);
  for (int d = 0; d < 2; d++) {
    convT(tidv, bidv, p.in[19] + (size_t)(l * 2 + d) * 64 * 1024, wb + OW_W2 + (size_t)d * 65536, 64, 1024, nullptr, smem);
    convT(tidv, bidv, p.in[21] + (size_t)(l * 2 + d) * 64 * 1024, wb + OW_A2 + (size_t)d * 65536, 64, 1024, nullptr, smem);
  }
  convT(tidv, bidv, p.in[22] + (size_t)l * 160 * 1024, wb + OW_G2, 160, 1024, nullptr, smem, 192);
}

DEV void phase_norm(int tidv, int bidv, const float* xlat, const float* xctx, const float* g, const float* mod, int shOff, int scOff, bf16* H, int nrows) {
  int wave = tidv >> 6, lane = tidv & 63;
  for (int row = bidv * NW + wave; row < nrows; row += gridDim.x * NW) {
    const float* x = row < ML ? xlat + (size_t)row * 2048 : xctx + (size_t)(row - ML) * 2048;
    int b = row < ML ? (row >> 12) : 4;
    const float* sh = mod + b * 12288 + shOff;
    const float* sc = mod + b * 12288 + scOff;
    float4 v[8];
    float ss = 0.f;
#pragma unroll
    for (int i = 0; i < 8; i++) {
      v[i] = *(const float4*)(x + i * 256 + lane * 4);
      ss += v[i].x * v[i].x + v[i].y * v[i].y + v[i].z * v[i].z + v[i].w * v[i].w;
    }
    ss = wsum_fast(ss);
    float rinv = rsqrtf(ss * (1.f / 2048.f) + 1e-6f);
#pragma unroll
    for (int i = 0; i < 8; i++) {
      int c = i * 256 + lane * 4;
      float4 g4 = *(const float4*)(g + c), s4 = *(const float4*)(sc + c), h4 = *(const float4*)(sh + c);
      float y0 = v[i].x * rinv * g4.x * (1.f + s4.x) + h4.x;
      float y1 = v[i].y * rinv * g4.y * (1.f + s4.y) + h4.y;
      float y2 = v[i].z * rinv * g4.z * (1.f + s4.z) + h4.z;
      float y3 = v[i].w * rinv * g4.w * (1.f + s4.w) + h4.w;
      uint2 o;
      o.x = pack2(y0, y1);
      o.y = pack2(y2, y3);
      *(uint2*)(H + (size_t)row * 2048 + c) = o;
    }
  }
}

constexpr int LDT = 72;
constexpr int GA_BYTES = 256 * LDT * 2;
constexpr int GSTAGE = 512 * LDT * 2;
constexpr int SM_RINV = 2 * GSTAGE;
constexpr int SM_ITEM = SM_RINV + 1024;
constexpr int LDS_BYTES = SM_ITEM + 16;
DEV float sumsq8(uint4 r) {
  float s = 0.f, x;
  x = bf2f((bf16)(r.x & 0xffff)); s += x * x; x = bf2f((bf16)(r.x >> 16)); s += x * x;
  x = bf2f((bf16)(r.y & 0xffff)); s += x * x; x = bf2f((bf16)(r.y >> 16)); s += x * x;
  x = bf2f((bf16)(r.z & 0xffff)); s += x * x; x = bf2f((bf16)(r.z >> 16)); s += x * x;
  x = bf2f((bf16)(r.w & 0xffff)); s += x * x; x = bf2f((bf16)(r.w >> 16)); s += x * x;
  return s;
}

template <bool ROWNORM>
DEV void gemm_mainloop(int tidv, int bidv, const bf16* __restrict__ A, int lda, bool amap, const bf16* __restrict__ Bt, int K, int N, int m0, int n0,
                       char* smem, f32x16 (&acc)[4][2]) {
  float* srinv = (float*)(smem + SM_RINV);
  const int tid = tidv, lane = tid & 63, wave = tid >> 6;
  const int wm = wave >> 2, wn = wave & 3;
  const int lr = tid >> 3, kc = tid & 7;
  const char* abase = (const char*)(A + (size_t)m0 * lda);
  const char* bbase = (const char*)(Bt + (size_t)n0 * K);
  const uint32_t voa = (uint32_t)(lr * lda + kc * 8) * 2u;
  const uint32_t astep = (uint32_t)(64 * lda) * 2u;
  const uint32_t vob0 = (uint32_t)(lr * K + kc * 8) * 2u;
  const uint32_t bstep = (uint32_t)(64 * K) * 2u;
  const uint32_t lds_st = (uint32_t)(lr * LDT + kc * 8) * 2u;
  const int nk = K >> 6;
  uint4 xa0, xa1, xa2, xa3, xb0, xb1, xb2, xb3;
#define G_LOAD(KT)                                                         \
  {                                                                        \
    const int k0_ = (KT) << 6;                                             \
    const int ka_ = amap ? ((k0_ >> 7) * 192 + (k0_ & 127)) : k0_;         \
    xa0 = *(const uint4*)(abase + (size_t)ka_ * 2 + voa);                  \
    xa1 = *(const uint4*)(abase + (size_t)ka_ * 2 + astep + voa);          \
    xa2 = *(const uint4*)(abase + (size_t)ka_ * 2 + 2 * astep + voa);      \
    xa3 = *(const uint4*)(abase + (size_t)ka_ * 2 + 3 * astep + voa);      \
    xb0 = *(const uint4*)(bbase + (size_t)k0_ * 2 + vob0);                 \
    xb1 = *(const uint4*)(bbase + (size_t)k0_ * 2 + bstep + vob0);         \
    xb2 = *(const uint4*)(bbase + (size_t)k0_ * 2 + 2 * bstep + vob0);     \
    xb3 = *(const uint4*)(bbase + (size_t)k0_ * 2 + 3 * bstep + vob0);     \
  }
#define G_STORE(SN)                                                  \
  *(uint4*)((SN) + lds_st) = xa0;                                    \
  *(uint4*)((SN) + 1 * (64 * LDT * 2) + lds_st) = xa1;               \
  *(uint4*)((SN) + 2 * (64 * LDT * 2) + lds_st) = xa2;               \
  *(uint4*)((SN) + 3 * (64 * LDT * 2) + lds_st) = xa3;               \
  *(uint4*)((SN) + GA_BYTES + lds_st) = xb0;                         \
  *(uint4*)((SN) + GA_BYTES + 1 * (64 * LDT * 2) + lds_st) = xb1;    \
  *(uint4*)((SN) + GA_BYTES + 2 * (64 * LDT * 2) + lds_st) = xb2;    \
  *(uint4*)((SN) + GA_BYTES + 3 * (64 * LDT * 2) + lds_st) = xb3;
  const uint32_t fa = (uint32_t)((wm * 128 + (lane & 31)) * LDT + (lane >> 5) * 8) * 2u;
  const uint32_t fb = (uint32_t)GA_BYTES + (uint32_t)((wn * 64 + (lane & 31)) * LDT + (lane >> 5) * 8) * 2u;
  const int nkm = nk - 1;
  if (ROWNORM) {
    __syncthreads();
#pragma unroll 1
    for (int i = 0; i < 4; i++) {
      float ss = 0.f;
      for (int kk = 0; kk < nk; kk++) ss += sumsq8(*(const uint4*)(abase + (size_t)kk * 128 + i * astep + voa));
      ss += __shfl_xor(ss, 1); ss += __shfl_xor(ss, 2); ss += __shfl_xor(ss, 4);
      if (kc == 0) srinv[lr + 64 * i] = rsqrtf(ss / (float)K + 1e-6f);
    }
  }
  G_LOAD(0)
  __syncthreads();
  G_STORE(smem)
  G_LOAD((1 < nkm ? 1 : nkm))
  __syncthreads();
#define G_FRAG(P, ST, KS)                                                            \
  P##a0 = *(const bf16x8*)((ST) + fa + 0 * (32 * LDT * 2) + (KS) * 32);                \
  P##a1 = *(const bf16x8*)((ST) + fa + 1 * (32 * LDT * 2) + (KS) * 32);                \
  P##a2 = *(const bf16x8*)((ST) + fa + 2 * (32 * LDT * 2) + (KS) * 32);                \
  P##a3 = *(const bf16x8*)((ST) + fa + 3 * (32 * LDT * 2) + (KS) * 32);                \
  P##b0 = *(const bf16x8*)((ST) + fb + 0 * (32 * LDT * 2) + (KS) * 32);                \
  P##b1 = *(const bf16x8*)((ST) + fb + 1 * (32 * LDT * 2) + (KS) * 32);
#define G_MMA(P)                                                                              \
  acc[0][0] = __builtin_amdgcn_mfma_f32_32x32x16_bf16(P##b0, P##a0, acc[0][0], 0, 0, 0);      \
  acc[0][1] = __builtin_amdgcn_mfma_f32_32x32x16_bf16(P##b1, P##a0, acc[0][1], 0, 0, 0);      \
  acc[1][0] = __builtin_amdgcn_mfma_f32_32x32x16_bf16(P##b0, P##a1, acc[1][0], 0, 0, 0);      \
  acc[1][1] = __builtin_amdgcn_mfma_f32_32x32x16_bf16(P##b1, P##a1, acc[1][1], 0, 0, 0);      \
  acc[2][0] = __builtin_amdgcn_mfma_f32_32x32x16_bf16(P##b0, P##a2, acc[2][0], 0, 0, 0);      \
  acc[2][1] = __builtin_amdgcn_mfma_f32_32x32x16_bf16(P##b1, P##a2, acc[2][1], 0, 0, 0);      \
  acc[3][0] = __builtin_amdgcn_mfma_f32_32x32x16_bf16(P##b0, P##a3, acc[3][0], 0, 0, 0);      \
  acc[3][1] = __builtin_amdgcn_mfma_f32_32x32x16_bf16(P##b1, P##a3, acc[3][1], 0, 0, 0);
  bf16x8 pa0, pa1, pa2, pa3, pb0, pb1, qa0, qa1, qa2, qa3, qb0, qb1;
#pragma unroll 1
  for (int kt = 0; kt < nk; kt++) {
    const char* st = smem + (kt & 1) * GSTAGE;
    char* sn = smem + ((kt + 1) & 1) * GSTAGE;
    if (!ROWNORM) {
      G_FRAG(p, st, 0)
      G_FRAG(q, st, 1)
      __builtin_amdgcn_sched_barrier(0);
      G_MMA(p)
      __builtin_amdgcn_sched_barrier(0);
      G_FRAG(p, st, 2)
      __builtin_amdgcn_sched_barrier(0);
      G_MMA(q)
      __builtin_amdgcn_sched_barrier(0);
      G_FRAG(q, st, 3)
      if (kt + 1 < nk) { G_STORE(sn) }
      G_LOAD((kt + 2 < nkm ? kt + 2 : nkm))
      __builtin_amdgcn_sched_barrier(0);
      G_MMA(p)
      __builtin_amdgcn_sched_barrier(0);
      G_MMA(q)
    } else {
      G_FRAG(p, st, 0)
      __builtin_amdgcn_sched_barrier(0);
      G_MMA(p)
      __builtin_amdgcn_sched_barrier(0);
      G_FRAG(p, st, 1)
      __builtin_amdgcn_sched_barrier(0);
      G_MMA(p)
      __builtin_amdgcn_sched_barrier(0);
      G_FRAG(p, st, 2)
      if (kt + 1 < nk) { G_STORE(sn) }
      G_LOAD((kt + 2 < nkm ? kt + 2 : nkm))
      __builtin_amdgcn_sched_barrier(0);
      G_MMA(p)
      __builtin_amdgcn_sched_barrier(0);
      G_FRAG(p, st, 3)
      __builtin_amdgcn_sched_barrier(0);
      G_MMA(p)
    }
    __syncthreads();
  }
#undef G_FRAG
#undef G_MMA
#undef G_LOAD
#undef G_STORE
}

DEV void zero_acc(f32x16 (&acc)[4][2]) {
#pragma unroll
  for (int i = 0; i < 4; i++)
#pragma unroll
    for (int j = 0; j < 2; j++)
#pragma unroll
      for (int e = 0; e < 16; e++) acc[i][j][e] = 0.f;
}

template <class F>
DEV void epi_loop(int tidv, int bidv, f32x16 (&acc)[4][2], int m0, int n0, int N, F f) {
  const int lane = tidv & 63, wave = tidv >> 6;
  const int wm = wave >> 2, wn = wave & 3;
#pragma unroll
  for (int i = 0; i < 4; i++) {
    const int lrow = wm * 128 + i * 32 + (lane & 31);
#pragma unroll
    for (int j = 0; j < 2; j++) {
#pragma unroll
      for (int g = 0; g < 4; g++) {
        int col = n0 + wn * 64 + j * 32 + 8 * g + 4 * (lane >> 5);
        f32x4 v = {acc[i][j][4 * g], acc[i][j][4 * g + 1], acc[i][j][4 * g + 2], acc[i][j][4 * g + 3]};
        if (col < N) f(m0 + lrow, lrow, col, v);
      }
    }
    __builtin_amdgcn_sched_barrier(0);
  }
}

DEV uint2 pack4(f32x4 v) {
  uint2 o;
  o.x = pack2(v[0], v[1]);
  o.y = pack2(v[2], v[3]);
  return o;
}
DEV f32x4 unpack4(uint2 u) {
  f32x4 v;
  v[0] = bf2f((bf16)(u.x & 0xffff)); v[1] = bf2f((bf16)(u.x >> 16));
  v[2] = bf2f((bf16)(u.y & 0xffff)); v[3] = bf2f((bf16)(u.y >> 16));
  return v;
}

enum { G_IN = 0, G_UQ, G_UKV, G_W2, G_A2, G_G2, G_GLU, G_OUT, G_M1, G_M2, G_MG0, G_MG1, G_MG2 };

template <int MODE>
DEV void run_gemm(int tidv, int bidv, const Params& p, int l, char* smem, const bf16* A, int lda, const bf16* Bt, int K, int N, int M, int aux,
                  const float* xin_lat, const float* xin_ctx, float* xout_lat, float* xout_ctx) {
  const int nt = (N + 255) >> 8, mt = M >> 8;
  char* ws = p.ws;
  bf16* Z = (bf16*)(ws + B_ZB);
  const float* srinv = (const float*)(smem + SM_RINV);
  const float* mod = (const float*)(ws + B_MOD) + (size_t)l * 5 * 12288;
  for (int tile = bidv; tile < nt * mt; tile += gridDim.x) {
    int m0 = (tile / nt) << 8, n0 = (tile % nt) << 8;
    f32x16 acc[4][2];
    zero_acc(acc);
    gemm_mainloop<(MODE == G_UQ || MODE == G_UKV)>(tidv, bidv, A, lda, MODE == G_MG0, Bt, K, N, m0, n0, smem, acc);
    if constexpr (MODE != G_OUT && MODE != G_M2)
    epi_loop(tidv, bidv, acc, m0, n0, N, [&](int row, int lrow, int col, f32x4 v) {
      if constexpr (MODE == G_IN) {
        f32x4 o = v;
        if (col >= C_GATE || (col >= C_GD && col < C_U)) {
#pragma unroll
          for (int r = 0; r < 4; r++) o[r] = sigmoidf_(v[r]);
        } else if (col >= C_WD && col < C_AD) {
#pragma unroll
          for (int r = 0; r < 4; r++) o[r] = tanhf(v[r]);
        }
        *(uint2*)(smem + ((size_t)lrow * 264 + (col - n0)) * 2) = pack4(o);
      } else if constexpr (MODE == G_UQ) {
        float ri = srinv[lrow];
        *(uint2*)((bf16*)(ws + B_QB) + (size_t)row * 1536 + col) = pack4(v * ri);
      } else if constexpr (MODE == G_UKV) {
        float ri = srinv[lrow];
        f32x4 o = v * ri;
        int h = col >> 8, c = col & 255;
        if (c < 128) {
          *(uint2*)((bf16*)(ws + B_KN) + (size_t)row * 1024 + h * 128 + c) = pack4(o);
        } else {
          int b, kp;
          if (row < ML) { b = row >> 12; kp = row & 4095; } else { int r2 = row - ML; b = r2 >> 8; kp = 4096 + (r2 & 255); }
          bf16* vt = (bf16*)(ws + B_VT) + ((size_t)((b * 8 + h) * 128 + (c - 128))) * NKEY + kp;
#pragma unroll
          for (int r = 0; r < 4; r++) vt[(size_t)r * NKEY] = f2bf(o[r]);
        }
      } else if constexpr (MODE == G_W2) {
        float4 w0 = *(const float4*)(p.in[18] + (l * 2 + aux) * 1024 + col);
        f32x4 o;
        o[0] = 0.60653066f * sigmoidf_(w0.x + v[0]);
        o[1] = 0.60653066f * sigmoidf_(w0.y + v[1]);
        o[2] = 0.60653066f * sigmoidf_(w0.z + v[2]);
        o[3] = 0.60653066f * sigmoidf_(w0.w + v[3]);
        *(uint2*)((bf16*)(ws + B_HB + (size_t)aux * SZ1K) + (size_t)row * 1024 + col) = pack4(o);
      } else if constexpr (MODE == G_A2) {
        float4 a0 = *(const float4*)(p.in[20] + (l * 2 + aux) * 1024 + col);
        f32x4 o;
        o[0] = sigmoidf_(a0.x + v[0]);
        o[1] = sigmoidf_(a0.y + v[1]);
        o[2] = sigmoidf_(a0.z + v[2]);
        o[3] = sigmoidf_(a0.w + v[3]);
        *(uint2*)((bf16*)(ws + (aux ? B_AB : B_AF)) + (size_t)row * 1024 + col) = pack4(o);
      } else if constexpr (MODE == G_G2) {
        *(uint2*)((bf16*)(ws + B_GB) + (size_t)row * 1024 + col) = pack4(v);
      } else if constexpr (MODE == G_GLU) {
        f32x4 zz = unpack4(*(const uint2*)((const bf16*)(ws + B_SY) + (size_t)row * 1024 + col));
        float4 gb = *(const float4*)(p.in[37] + l * 1024 + col);
        f32x4 o;
        o[0] = zz[0] * sigmoidf_(v[0] + gb.x);
        o[1] = zz[1] * sigmoidf_(v[1] + gb.y);
        o[2] = zz[2] * sigmoidf_(v[2] + gb.z);
        o[3] = zz[3] * sigmoidf_(v[3] + gb.w);
        *(uint2*)(smem + ((size_t)lrow * 264 + (col - n0)) * 2) = pack4(o);
      } else if constexpr (MODE == G_OUT || MODE == G_M2) {
      } else if constexpr (MODE == G_M1) {
        f32x4 o;
#pragma unroll
        for (int r = 0; r < 4; r++) { float t = fmaxf(v[r], 0.f); o[r] = t * t; }
        *(uint2*)(smem + ((size_t)lrow * 264 + (col - n0)) * 2) = pack4(o);
      } else if constexpr (MODE == G_MG0 || MODE == G_MG1 || MODE == G_MG2) {
        *(uint2*)(smem + ((size_t)lrow * 264 + (col - n0)) * 2) = pack4(v);
      }
    });
    if constexpr (MODE == G_OUT || MODE == G_M2) {
      float* tilef = (float*)smem;
      constexpr int GOFF = (MODE == G_OUT) ? 4096 : 10240;
      const int wn_ = (tidv >> 6) & 3;
#pragma unroll 1
      for (int half = 0; half < 2; half++) {
        if ((wn_ >> 1) == half) {
          epi_loop(tidv, bidv, acc, m0, n0, N, [&](int row, int lrow, int col, f32x4 v) {
            *(f32x4*)(tilef + (size_t)lrow * 132 + (col - n0 - half * 128)) = v;
          });
        }
        __syncthreads();
#pragma unroll 2
        for (int it = 0; it < 16; it++) {
          int c = it * NT + tidv;
          int r = c >> 5, ch = c & 31;
          int row = m0 + r, col = n0 + half * 128 + ch * 4;
          int b = row < ML ? (row >> 12) : 4;
          float4 g = *(const float4*)(mod + b * 12288 + GOFF + col);
          const float* xi;
          if constexpr (MODE == G_OUT) xi = row < ML ? xin_lat + (size_t)row * 2048 : xin_ctx + (size_t)(row - ML) * 2048;
          else xi = row < ML ? xout_lat + (size_t)row * 2048 : xout_ctx + (size_t)(row - ML) * 2048;
          float* xo = row < ML ? xout_lat + (size_t)row * 2048 : xout_ctx + (size_t)(row - ML) * 2048;
          float4 x = *(const float4*)(xi + col);
          f32x4 v = *(const f32x4*)(tilef + (size_t)r * 132 + ch * 4);
          x.x += g.x * v[0]; x.y += g.y * v[1]; x.z += g.z * v[2]; x.w += g.w * v[3];
          *(float4*)(xo + col) = x;
        }
        __syncthreads();
      }
    }
    if constexpr (MODE == G_MG0 || MODE == G_MG1 || MODE == G_MG2) {
      constexpr int nb = MODE - G_MG0;
      bf16* MG = (bf16*)(ws + B_HB);
      __syncthreads();
#pragma unroll 2
      for (int it = 0; it < 16; it++) {
        int c = it * NT + tidv;
        int r = c >> 5, ch = c & 31;
        int col = n0 + ch * 8;
        uint4 pv = *(const uint4*)(smem + ((size_t)r * 264 + ch * 8) * 2);
        uint4 gv = *(const uint4*)(Z + (size_t)(m0 + r) * NIN + C_GATE + nb * 2048 + col);
        f32x4 p0 = unpack4(uint2{pv.x, pv.y}), p1 = unpack4(uint2{pv.z, pv.w});
        f32x4 g0 = unpack4(uint2{gv.x, gv.y}), g1 = unpack4(uint2{gv.z, gv.w});
        f32x4 o0 = g0 * p0, o1 = g1 * p1;
        if constexpr (nb > 0) {
          uint4 qv = *(const uint4*)(MG + (size_t)(m0 + r) * 2048 + col);
          o0 += unpack4(uint2{qv.x, qv.y});
          o1 += unpack4(uint2{qv.z, qv.w});
        }
        uint2 a = pack4(o0), b = pack4(o1);
        *(uint4*)(MG + (size_t)(m0 + r) * 2048 + col) = uint4{a.x, a.y, b.x, b.y};
      }
    }
    if constexpr (MODE == G_IN || MODE == G_GLU || MODE == G_M1) {
      bf16* dst;
      int ld;
      if constexpr (MODE == G_IN || MODE == G_GLU) { dst = Z; ld = NIN; }
      else { dst = Z; ld = DFF; }
      __syncthreads();
#pragma unroll 4
      for (int it = 0; it < 16; it++) {
        int c = it * NT + tidv;
        int r = c >> 5, ch = c & 31;
        int col = n0 + ch * 8;
        if (col < N) *(uint4*)(dst + (size_t)(m0 + r) * ld + col) = *(const uint4*)(smem + ((size_t)r * 264 + ch * 8) * 2);
      }
    }
  }
}

DEV void phase_mla_post(int tidv, int bidv, const Params& p, int l) {
  char* ws = p.ws;
  const float* qng = p.in[13] + l * 128;
  const float* qrg = p.in[14] + l * 64;
  const float* kng = p.in[15] + l * 128;
  const float* krg = p.in[16] + l * 64;
  bf16* QB = (bf16*)(ws + B_QB);
  bf16* KN = (bf16*)(ws + B_KN);
  bf16* KR = (bf16*)(ws + B_KR);
  const bf16* Z = (const bf16*)(ws + B_ZB);
  const int wave = tidv >> 6, lane = tidv & 63;
  const float QS = 1.4426950408889634f * 0.07216878364870322f;
  const int idx = lane & 31;
  const float inv = powf(10000.f, -(float)(idx & 15) / 16.f);
  const float gq0 = qng[2 * lane], gq1 = qng[2 * lane + 1], gk0 = kng[2 * lane], gk1 = kng[2 * lane + 1];
  const float gqr = qrg[lane], gkr = krg[lane];
  for (int row = bidv * NW + wave; row < MT; row += gridDim.x * NW) {
    bool lat = row < ML;
    int t = row & 4095;
    float pos = (idx < 16) ? (float)(t >> 6) : (float)(t & 63);
    float ang = pos * inv;
    float cs = 1.f, sn = 0.f;
    if (lat) { cs = cosf(ang); sn = sinf(ang); }
#pragma unroll 1
    for (int h = 0; h < 8; h++) {
      bf16* q = QB + (size_t)row * 1536 + h * 192;
      uint32_t u = *(const uint32_t*)(q + 2 * lane);
      float x0 = bf2f((bf16)(u & 0xffff)), x1 = bf2f((bf16)(u >> 16));
      float ss = wsum_fast(x0 * x0 + x1 * x1);
      float rinv = rsqrtf(ss * (1.f / 128.f) + 1e-6f) * QS;
      *(uint32_t*)(q + 2 * lane) = pack2(x0 * rinv * gq0, x1 * rinv * gq1);
      float xr = bf2f(q[128 + lane]);
      float ss2 = wsum_fast(xr * xr);
      float y = xr * rsqrtf(ss2 * (1.f / 64.f) + 1e-6f) * gqr;
      float yp = __shfl_xor(y, 32);
      float o = lane < 32 ? (y * cs - yp * sn) : (yp * sn + y * cs);
      q[128 + lane] = f2bf(o * QS);
      bf16* k = KN + (size_t)row * 1024 + h * 128;
      uint32_t uk = *(const uint32_t*)(k + 2 * lane);
      float k0 = bf2f((bf16)(uk & 0xffff)), k1 = bf2f((bf16)(uk >> 16));
      float ssk = wsum_fast(k0 * k0 + k1 * k1);
      float rk = rsqrtf(ssk * (1.f / 128.f) + 1e-6f);
      *(uint32_t*)(k + 2 * lane) = pack2(k0 * rk * gk0, k1 * rk * gk1);
    }
    {
      float xr = bf2f(Z[(size_t)row * NIN + C_KR + lane]);
      float ss2 = wsum_fast(xr * xr);
      float y = xr * rsqrtf(ss2 * (1.f / 64.f) + 1e-6f) * gkr;
      float yp = __shfl_xor(y, 32);
      float o = lane < 32 ? (y * cs - yp * sn) : (yp * sn + y * cs);
      KR[(size_t)row * 64 + lane] = f2bf(o);
    }
  }
}

DEV void step_row(int s, int d, int b, int& row, int& tau, int& len) {
  if (s < 256) { tau = d ? 255 - s : s; len = 256; row = ML + b * 256 + tau; }
  else { int q = s - 256; tau = d ? 4095 - q : q; len = 4096; row = b * 4096 + tau; }
}

struct RwPre { bf16 r0, r1, r2, k0, k1, k2, v0, v1, v2, a, e; };

DEV void rwkv_fetch(RwPre& q, const bf16* Z, const bf16* AD, const bf16* ED, int s, int d, int b, int ch) {
  int row, tau, len;
  step_row(s, d, b, row, tau, len);
  const bf16* z = Z + (size_t)row * NIN + C_R + ch;
  q.r1 = z[0]; q.k1 = z[1024]; q.v1 = z[2048];
  q.r0 = 0; q.k0 = 0; q.v0 = 0; q.r2 = 0; q.k2 = 0; q.v2 = 0;
  if (tau > 0) { const bf16* zm = z - NIN; q.r0 = zm[0]; q.k0 = zm[1024]; q.v0 = zm[2048]; }
  if (tau < len - 1) { const bf16* zp = z + NIN; q.r2 = zp[0]; q.k2 = zp[1024]; q.v2 = zp[2048]; }
  q.a = AD[(size_t)row * 1024 + ch];
  q.e = ED[(size_t)row * 1024 + ch];
}

typedef float f2v __attribute__((ext_vector_type(2)));
DEV float dpp_hmirror(float v) {
  int i = __float_as_int(v);
  return __int_as_float(__builtin_amdgcn_update_dpp(0, i, 0x141, 0xF, 0xF, true));
}
DEV f2v lo2(float4 v) { return f2v{v.x, v.y}; }
DEV f2v hi2(float4 v) { return f2v{v.z, v.w}; }

DEV void rwkv_scan(int tidv, int bidv, const Params& p, int l, int chain, char* smem, int dry) {
  char* ws = p.ws;
  float* op = (float*)smem;
  float* vb = op + 16 * 320;
  float* yb = vb + 16 * 64;
  const int tid = tidv, wave = tid >> 6, lane = tid & 63;
  const int d = chain & 1, h = (chain >> 1) & 15, b = chain >> 5;
  const int ch = h * 64 + lane;
  const float* cw = p.in[17] + (size_t)l * 3 * 3072;
  const float cr0 = cw[ch], cr1 = cw[3072 + ch], cr2 = cw[6144 + ch];
  const float ck0 = cw[1024 + ch], ck1 = cw[3072 + 1024 + ch], ck2 = cw[6144 + 1024 + ch];
  const float cv0 = cw[2048 + ch], cv1 = cw[3072 + 2048 + ch], cv2 = cw[6144 + 2048 + ch];
  const float kkc = p.in[23][l * 1024 + ch], kac = p.in[24][l * 1024 + ch];
  const bf16* Z = (const bf16*)(ws + B_ZB);
  bf16* ED = (bf16*)(ws + B_HB + (size_t)d * SZ1K);
  const bf16* AD = (const bf16*)(ws + (d ? B_AB : B_AF));
  f2v A0 = {0.f, 0.f}, A1 = {0.f, 0.f}, B0 = {0.f, 0.f}, B1 = {0.f, 0.f};
  const int ri = lane >> 4, jo = lane & 15, rA = wave * 8 + ri, rB = rA + 4;
  RwPre pre[2];
#pragma unroll
  for (int si = 0; si < 2; si++) rwkv_fetch(pre[si], Z, AD, ED, wave * 2 + si, d, b, ch);
  for (int chunk = 0; chunk < 272; chunk++) {
#pragma unroll
    for (int si = 0; si < 2; si++) {
      int t = wave * 2 + si;
      const RwPre& q = pre[si];
      float rr = cr0 * bf2f(q.r0) + cr1 * bf2f(q.r1) + cr2 * bf2f(q.r2);
      float kk_ = ck0 * bf2f(q.k0) + ck1 * bf2f(q.k1) + ck2 * bf2f(q.k2);
      float vv = cv0 * bf2f(q.v0) + cv1 * bf2f(q.v1) + cv2 * bf2f(q.v2);
      float kkv = kk_ * kkc;
      float ssq = wsum_fast(kkv * kkv);
      float kn = kkv * rsqrtf(ssq + 1e-12f);
      float a = bf2f(q.a);
      float w = __expf(-bf2f(q.e));
      float krep = kk_ * (1.f + (a - 1.f) * kac);
      float* o = op + t * 320;
      o[lane] = w;
      o[64 + lane] = kn * a;
      o[128 + lane] = krep;
      o[192 + lane] = -kn;
      o[256 + lane] = rr;
      vb[t * 64 + lane] = vv;
    }
    __syncthreads();
    if (chunk + 1 < 272) {
#pragma unroll
      for (int si = 0; si < 2; si++) rwkv_fetch(pre[si], Z, AD, ED, (chunk + 1) * 16 + wave * 2 + si, d, b, ch);
    }
    {
      const float4* o4 = (const float4*)op + jo;
      float4 nn = o4[48];
#pragma unroll 4
      for (int t = 0; t < 16; t++) {
        const float4* ot = o4 + t * 80;
        const float4 w = ot[0], a = ot[16], k = ot[32], r = ot[64];
        const float viA = vb[t * 64 + rA], viB = vb[t * 64 + rB];
        const int tn = t < 15 ? t + 1 : 15;
        const float4 mm = o4[tn * 80 + 48];
        f2v svA = A0 * lo2(nn) + A1 * hi2(nn);
        f2v svB = B0 * lo2(nn) + B1 * hi2(nn);
        float saA = svA.x + svA.y, saB = svB.x + svB.y;
        saA += dpp_xor1(saA); saB += dpp_xor1(saB);
        saA += dpp_xor2(saA); saB += dpp_xor2(saB);
        saA += dpp_hmirror(saA); saB += dpp_hmirror(saB);
        saA += dpp_rmirror(saA); saB += dpp_rmirror(saB);
        const f2v sA2 = {saA, saA}, vA2 = {viA, viA}, sB2 = {saB, saB}, vB2 = {viB, viB};
        A0 = A0 * lo2(w) + sA2 * lo2(a) + vA2 * lo2(k);
        B0 = B0 * lo2(w) + sB2 * lo2(a) + vB2 * lo2(k);
        A1 = A1 * hi2(w) + sA2 * hi2(a) + vA2 * hi2(k);
        B1 = B1 * hi2(w) + sB2 * hi2(a) + vB2 * hi2(k);
        f2v yvA = A0 * lo2(r) + A1 * hi2(r);
        f2v yvB = B0 * lo2(r) + B1 * hi2(r);
        yb[(t * 64 + rA) * 16 + jo] = yvA.x + yvA.y;
        yb[(t * 64 + rB) * 16 + jo] = yvB.x + yvB.y;
        nn = mm;
      }
    }
    __syncthreads();
#pragma unroll
    for (int it = 0; it < 2; it++) {
      int idx = it * NT + tid;
      int t = idx >> 6, i = idx & 63;
      int row, tau, len;
      step_row(chunk * 16 + t, d, b, row, tau, len);
      size_t off = (size_t)row * 1024 + h * 64 + i;
      bf16* yd = dry ? (bf16*)(ws + B_END) + (off & 0x3fffff) : ED + off;
      const float4* yp = (const float4*)(yb + (t * 64 + i) * 16);
      const float4 ya = yp[0], yc = yp[1], ye = yp[2], yg = yp[3];
      *yd = f2bf((((ya.x + ya.y) + (ya.z + ya.w)) + ((yc.x + yc.y) + (yc.z + yc.w))) + (((ye.x + ye.y) + (ye.z + ye.w)) + ((yg.x + yg.y) + (yg.z + yg.w))));
    }
  }
}

DEV void s5_scan(int tidv, int bidv, const Params& p, int l, int chain, char* smemw, int dry) {
  char* ws = p.ws;
  const int lane = tidv & 63;
  const int d = chain & 1, g = (chain >> 1) & 63, b = chain >> 7;
  float* ub = (float*)smemw;
  float* hb = ub + 256;
  const size_t pg = (size_t)(l * 2 + d) * 64 + g;
  const float lre = p.in[28][pg * 64 + lane], lim = p.in[29][pg * 64 + lane];
  const float dt = expf(p.in[30][pg]);
  const float mag = expf(lre * dt);
  const float are = mag * cosf(lim * dt), aim = mag * sinf(lim * dt);
  const float den = lre * lre + lim * lim;
  const float qre = ((are - 1.f) * lre + aim * lim) / den;
  const float qim = (aim * lre - (are - 1.f) * lim) / den;
  float bbre[16], bbim[16];
  {
    const float* br = p.in[31] + (pg * 64 + lane) * 16;
    const float* bi = p.in[32] + (pg * 64 + lane) * 16;
#pragma unroll
    for (int i = 0; i < 16; i++) {
      float x = br[i], y = bi[i];
      bbre[i] = qre * x - qim * y;
      bbim[i] = qre * y + qim * x;
    }
  }
  bf16x8 cfr[4];
  {
    const int i = lane & 15, quad = lane >> 4;
    const float* cre = p.in[33] + (pg * 16 + i) * 64;
    const float* cim = p.in[34] + (pg * 16 + i) * 64;
#pragma unroll
    for (int ks = 0; ks < 4; ks++)
#pragma unroll
      for (int j = 0; j < 8; j++) {
        int k = ks * 32 + quad * 8 + j;
        float c = ks < 2 ? cre[k] : -cim[k - 64];
        cfr[ks][j] = (short)f2bf(c);
      }
  }
  float hre = 0.f, him = 0.f;
  const bf16* Z = (const bf16*)(ws + B_ZB);
  const int tt = lane >> 2, i0 = (lane & 3) * 4;
  uint2 unext;
  {
    int row, tau, len;
    step_row(tt, d, b, row, tau, len);
    unext = *(const uint2*)(Z + (size_t)row * NIN + C_U + g * 16 + i0);
  }
  for (int chunk = 0; chunk < 272; chunk++) {
    {
      uint2 u = unext;
      float4 f;
      f.x = bf2f((bf16)(u.x & 0xffff)); f.y = bf2f((bf16)(u.x >> 16));
      f.z = bf2f((bf16)(u.y & 0xffff)); f.w = bf2f((bf16)(u.y >> 16));
      *(float4*)(ub + tt * 16 + i0) = f;
    }
    __syncthreads();
    if (chunk + 1 < 272) {
      int row, tau, len;
      step_row((chunk + 1) * 16 + tt, d, b, row, tau, len);
      unext = *(const uint2*)(Z + (size_t)row * NIN + C_U + g * 16 + i0);
    }
#pragma unroll 2
    for (int t = 0; t < 16; t++) {
      const float* u = ub + t * 16;
      float br0 = 0.f, bi0 = 0.f;
#pragma unroll
      for (int i = 0; i < 16; i++) { float uv = u[i]; br0 += bbre[i] * uv; bi0 += bbim[i] * uv; }
      float nr = are * hre - aim * him + br0;
      float ni = are * him + aim * hre + bi0;
      hre = nr; him = ni;
      hb[t * 132 + lane] = hre;
      hb[t * 132 + 64 + lane] = him;
    }
    __syncthreads();
    {
      f32x4 yacc = {0.f, 0.f, 0.f, 0.f};
      const float* hr = hb + (lane & 15) * 132 + (lane >> 4) * 8;
#pragma unroll
      for (int ks = 0; ks < 4; ks++) {
        float4 x0 = *(const float4*)(hr + ks * 32), x1 = *(const float4*)(hr + ks * 32 + 4);
        union { bf16x8 v; uint32_t u[4]; } af;
        af.u[0] = pack2(x0.x, x0.y); af.u[1] = pack2(x0.z, x0.w);
        af.u[2] = pack2(x1.x, x1.y); af.u[3] = pack2(x1.z, x1.w);
        yacc = __builtin_amdgcn_mfma_f32_16x16x32_bf16(af.v, cfr[ks], yacc, 0, 0, 0);
      }
      const int ii = lane & 15;
#pragma unroll
      for (int r = 0; r < 4; r++) {
        int row, tau, len;
        step_row(chunk * 16 + (lane >> 4) * 4 + r, d, b, row, tau, len);
        bf16* dst = d == 0 ? (bf16*)(ws + B_SY) + (size_t)row * 1024 + g * 16 + ii : (bf16*)(ws + B_ZB) + (size_t)row * NIN + g * 16 + ii;
        if (dry) dst = (bf16*)(ws + B_END) + ((((size_t)row * 1024 + g * 16 + ii)) & 0x3fffff);
        *dst = f2bf(yacc[r]);
      }
    }
    __syncthreads();
  }
}

DEV int perm23(int r) { return (r & 0x13) | ((r & 4) << 1) | ((r & 8) >> 1); }

DEV void attn_item(int tidv, int bidv, const Params& p, int item, bool ctxq, char* smem, int dry) {
  char* ws = p.ws;
  bf16* sK = (bf16*)smem;
  bf16* sV = sK + 64 * 200;
  const int tid = tidv, wave = tid >> 6, lane = tid & 63;
  const int r = lane & 31, hf = lane >> 5;
  int b, hd, qt;
  if (!ctxq) { b = item >> 7; hd = (item >> 4) & 7; qt = item & 15; }
  else { b = item >> 3; hd = item & 7; qt = 0; }
  const int qrow0 = ctxq ? ML + b * 256 : b * 4096 + qt * 256;
  const int kt0 = ctxq ? 64 : 0, kt1 = 68;
  bf16* QB = (bf16*)(ws + B_QB);
  const bf16* KN = (const bf16*)(ws + B_KN);
  const bf16* KR = (const bf16*)(ws + B_KR);
  const bf16* VT = (const bf16*)(ws + B_VT);
  bf16x8 qf[12];
  {
    const bf16* qp = QB + (size_t)(qrow0 + wave * 32 + r) * 1536 + hd * 192 + hf * 8;
#pragma unroll
    for (int kk = 0; kk < 12; kk++) qf[kk] = *(const bf16x8*)(qp + kk * 16);
  }
  f32x16 oacc[4];
#pragma unroll
  for (int i = 0; i < 4; i++)
#pragma unroll
    for (int e = 0; e < 16; e++) oacc[i][e] = 0.f;
  float mrun = -1e30f, lrun = 0.f;
  const int pr = perm23(r);
  const uint32_t vo_n = (uint32_t)((tid >> 4) * 2048 + (tid & 15) * 16);
  const uint32_t lo_n = (uint32_t)((tid >> 4) * 400 + (tid & 15) * 16);
  const uint32_t vo_r = (uint32_t)((tid >> 3) * 128 + (tid & 7) * 16);
  const uint32_t lo_r = (uint32_t)((tid >> 3) * 400 + 256 + (tid & 7) * 16);
  const uint32_t vo_v = (uint32_t)((tid >> 3) * (NKEY * 2) + (tid & 7) * 16);
  const uint32_t lo_v = (uint32_t)((tid >> 3) * 144 + (tid & 7) * 16);
  uint4 t0, t1, t4, u0, u1;
#define ATT_LOAD(KT)                                                                                   \
  {                                                                                                    \
    const int key0_ = (KT) * 64;                                                                       \
    const int rowbase_ = key0_ < 4096 ? b * 4096 + key0_ : ML + b * 256 + (key0_ - 4096);               \
    const char* bk = (const char*)(KN + (size_t)rowbase_ * 1024 + hd * 128);                           \
    const char* br = (const char*)(KR + (size_t)rowbase_ * 64);                                        \
    const char* bv = (const char*)(VT + ((size_t)((b * 8 + hd) * 128)) * NKEY + key0_);                \
    t0 = *(const uint4*)(bk + vo_n);                                                                   \
    t1 = *(const uint4*)(bk + 32 * 2048 + vo_n);                                                       \
    t4 = *(const uint4*)(br + vo_r);                                                                   \
    u0 = *(const uint4*)(bv + vo_v);                                                                   \
    u1 = *(const uint4*)(bv + (size_t)64 * NKEY * 2 + vo_v);                                           \
  }
  ATT_LOAD(kt0)
  for (int kt = kt0; kt < kt1; kt++) {
    __syncthreads();
    *(uint4*)((char*)sK + lo_n) = t0;
    *(uint4*)((char*)sK + 32 * 400 + lo_n) = t1;
    *(uint4*)((char*)sK + lo_r) = t4;
    *(uint4*)((char*)sV + lo_v) = u0;
    *(uint4*)((char*)sV + 64 * 144 + lo_v) = u1;
    __syncthreads();
    ATT_LOAD((kt + 1 < kt1 ? kt + 1 : kt1 - 1))
    f32x16 sacc[2];
#pragma unroll
    for (int m = 0; m < 2; m++) {
#pragma unroll
      for (int e = 0; e < 16; e++) sacc[m][e] = 0.f;
      const bf16* kp = sK + (m * 32 + pr) * 200 + hf * 8;
#pragma unroll
      for (int kk = 0; kk < 12; kk++) {
        bf16x8 kf = *(const bf16x8*)(kp + kk * 16);
        sacc[m] = __builtin_amdgcn_mfma_f32_32x32x16_bf16(kf, qf[kk], sacc[m], 0, 0, 0);
        if ((kk & 3) == 3) __builtin_amdgcn_sched_barrier(0);
      }
      __builtin_amdgcn_sched_barrier(0);
    }
    float tmax = sacc[0][0];
#pragma unroll
    for (int e = 1; e < 16; e++) tmax = fmaxf(tmax, sacc[0][e]);
#pragma unroll
    for (int e = 0; e < 16; e++) tmax = fmaxf(tmax, sacc[1][e]);
    tmax = fmaxf(tmax, __shfl_xor(tmax, 32));
    float mnew = fmaxf(mrun, tmax);
    float alpha = __builtin_amdgcn_exp2f(mrun - mnew);
    mrun = mnew;
    float psum = 0.f;
#pragma unroll
    for (int m = 0; m < 2; m++)
#pragma unroll
      for (int e = 0; e < 16; e++) { float pv = __builtin_amdgcn_exp2f(sacc[m][e] - mnew); sacc[m][e] = pv; psum += pv; }
    lrun = lrun * alpha + psum;
#pragma unroll
    for (int i = 0; i < 4; i++)
#pragma unroll
      for (int e = 0; e < 16; e++) oacc[i][e] *= alpha;
#pragma unroll
    for (int s = 0; s < 4; s++) {
      const int m = s >> 1, s2 = s & 1;
      bf16x8 pf;
#pragma unroll
      for (int j = 0; j < 8; j++) pf[j] = (short)f2bf(sacc[m][8 * s2 + j]);
#pragma unroll
      for (int i = 0; i < 4; i++) {
        bf16x8 vf = *(const bf16x8*)(sV + (i * 32 + r) * 72 + m * 32 + s2 * 16 + hf * 8);
        oacc[i] = __builtin_amdgcn_mfma_f32_32x32x16_bf16(vf, pf, oacc[i], 0, 0, 0);
      }
      __builtin_amdgcn_sched_barrier(0);
    }
  }
#undef ATT_LOAD
  lrun += __shfl_xor(lrun, 32);
  const float inv = 1.f / lrun;
  bf16* op = QB + (size_t)(qrow0 + wave * 32 + r) * 1536 + hd * 192;
  if (dry) op = (bf16*)(ws + B_END) + ((((size_t)(qrow0 + wave * 32 + r) * 1536 + hd * 192)) & 0x3ffff8);
#pragma unroll
  for (int i = 0; i < 4; i++)
#pragma unroll
    for (int g = 0; g < 4; g++) {
      uint2 o;
      o.x = pack2(oacc[i][4 * g] * inv, oacc[i][4 * g + 1] * inv);
      o.y = pack2(oacc[i][4 * g + 2] * inv, oacc[i][4 * g + 3] * inv);
      *(uint2*)(op + 32 * i + 8 * g + 4 * hf) = o;
    }
}

DEV void phase_mixers(int tidv, int bidv, const Params& p, int l, char* smem, int dry) {
  int* s_item = (int*)(smem + SM_ITEM);
#ifdef PROBE_PARTS
  const int parts = dry ? PROBE_PARTS : 7;
#else
  const int parts = 7;
#endif
  for (int task = bidv; task < 192; task += gridDim.x) {
    if (task < 128 && !(parts & 1)) continue;
    if (task >= 128 && !(parts & 2)) continue;
    if (task < 128) rwkv_scan(tidv, bidv, p, l, task, smem, dry);
    else s5_scan(tidv, bidv, p, l, (task - 128) * 8 + (tidv >> 6), smem + (tidv >> 6) * 9472, dry);
  }
  const int nlat = 512, ntot = (parts & 4) ? ((l == 0) ? 544 : 512) : 0;
  int* cnt = (int*)(p.ws + B_CNT) + l + 2 * dry;
#if !defined(MIX_ONLY) || MIX_ONLY == 2
  while (true) {
    __syncthreads();
    if (tidv == 0) *s_item = atomicAdd(cnt, 1);
    __syncthreads();
    int item = *s_item;
    if (item >= ntot) break;
    if (item < nlat) attn_item(tidv, bidv, p, item, false, smem, dry);
    else attn_item(tidv, bidv, p, item - nlat, true, smem, dry);
  }
#endif
}

DEV float gelu_tanh(float x) {
  float u = 0.7978845608028654f * (x + 0.044715f * x * x * x);
  return 0.5f * x * (1.f + tanhf(u));
}

DEV void phase_post(int tidv, int bidv, const Params& p, int l, int M) {
  char* ws = p.ws;
  const bf16* Z = (const bf16*)(ws + B_ZB);
  const int wave = tidv >> 6, lane = tidv & 63;
  const float* cw = p.in[17] + (size_t)l * 3 * 3072;
  const bf16* YF = (const bf16*)(ws + B_HB);
  const bf16* YB = (const bf16*)(ws + B_HB + SZ1K);
  const bf16* AF = (const bf16*)(ws + B_AF);
  const bf16* AB = (const bf16*)(ws + B_AB);
  bf16* GB = (bf16*)(ws + B_GB);
  {
    const int gw = bidv * NW + wave, nwv = gridDim.x * NW;
    const int h = gw & 15, ch = h * 64 + lane;
    const float c_r0 = cw[ch], c_r1 = cw[3072 + ch], c_r2 = cw[6144 + ch];
    const float c_k0 = cw[1024 + ch], c_k1 = cw[3072 + 1024 + ch], c_k2 = cw[6144 + 1024 + ch];
    const float c_v0 = cw[2048 + ch], c_v1 = cw[3072 + 2048 + ch], c_v2 = cw[6144 + 2048 + ch];
    const float lng = p.in[26][l * 1024 + ch], lnb = p.in[27][l * 1024 + ch];
    const float kac = p.in[24][l * 1024 + ch], rkc = p.in[25][l * 1024 + ch];
    for (int row = gw >> 4; row < M; row += (nwv >> 4)) {
      int tau, len;
      if (row < ML) { tau = row & 4095; len = 4096; } else { tau = (row - ML) & 255; len = 256; }
      size_t o = (size_t)row * 1024 + ch;
      float y = bf2f(YF[o]) + bf2f(YB[o]);
      const bf16* z = Z + (size_t)row * NIN + C_R + ch;
      float r1 = bf2f(z[0]), k1 = bf2f(z[1024]), v1 = bf2f(z[2048]);
      float r0 = 0.f, k0 = 0.f, v0 = 0.f, r2 = 0.f, k2 = 0.f, v2 = 0.f;
      if (tau > 0) { const bf16* zm = z - NIN; r0 = bf2f(zm[0]); k0 = bf2f(zm[1024]); v0 = bf2f(zm[2048]); }
      if (tau < len - 1) { const bf16* zp = z + NIN; r2 = bf2f(zp[0]); k2 = bf2f(zp[1024]); v2 = bf2f(zp[2048]); }
      float am = 0.5f * (bf2f(AF[o]) + bf2f(AB[o]));
      float gate = bf2f(GB[o]);
      float mu = wsum_fast(y) * (1.f / 64.f);
      float dv = y - mu;
      float var = wsum_fast(dv * dv) * (1.f / 64.f);
      float yn = dv * rsqrtf(var + 64e-5f) * lng + lnb;
      float rr = c_r0 * r0 + c_r1 * r1 + c_r2 * r2;
      float kk = c_k0 * k0 + c_k1 * k1 + c_k2 * k2;
      float vv = c_v0 * v0 + c_v1 * v1 + c_v2 * v2;
      float kbon = kk * (1.f + (am - 1.f) * kac);
      float s = wsum_fast(rr * kbon * rkc);
      GB[o] = f2bf((yn + s * vv) * gate);
    }
  }
  bf16* SY = (bf16*)(ws + B_SY);
  const float* dsk = p.in[35] + l * 1024;
  const int n4 = M * 256;
  for (int i = bidv * NT + tidv; i < n4; i += gridDim.x * NT) {
    int row = i >> 8, c = (i & 255) * 4;
    uint2 a = *(const uint2*)(SY + (size_t)row * 1024 + c);
    uint2 bq = *(const uint2*)(Z + (size_t)row * NIN + c);
    uint2 u = *(const uint2*)(Z + (size_t)row * NIN + C_U + c);
    float4 dd = *(const float4*)(dsk + c);
    float y0 = bf2f((bf16)(a.x & 0xffff)) + bf2f((bf16)(bq.x & 0xffff)) + dd.x * bf2f((bf16)(u.x & 0xffff));
    float y1 = bf2f((bf16)(a.x >> 16)) + bf2f((bf16)(bq.x >> 16)) + dd.y * bf2f((bf16)(u.x >> 16));
    float y2 = bf2f((bf16)(a.y & 0xffff)) + bf2f((bf16)(bq.y & 0xffff)) + dd.z * bf2f((bf16)(u.y & 0xffff));
    float y3 = bf2f((bf16)(a.y >> 16)) + bf2f((bf16)(bq.y >> 16)) + dd.w * bf2f((bf16)(u.y >> 16));
    uint2 o;
    o.x = pack2(gelu_tanh(y0), gelu_tanh(y1));
    o.y = pack2(gelu_tanh(y2), gelu_tanh(y3));
    *(uint2*)(SY + (size_t)row * 1024 + c) = o;
  }
}

constexpr int NPH = 25;

DEV void run_phase(int tidv, int bidv, const Params& p, int ph, char* smem, int dry) {
  char* ws = p.ws;
#ifndef ONLY_S
  if (ph == 0) {
    if (bidv == 0 && tidv < 4) ((int*)(ws + B_CNT))[tidv] = 0;
    phase_mod(tidv, bidv, p, smem);
    phase_convw(tidv, bidv, p, 0, smem);
    return;
  }
#endif
  const int l = (ph - 1) / 12, s = (ph - 1) % 12;
#ifdef ONLY_S
  if (s != ONLY_S) return;
#endif
  const bf16* wb = (const bf16*)(ws + B_WB);
  const float* mod = (const float*)(ws + B_MOD) + (size_t)l * 5 * 12288;
  float* XC = (float*)(ws + B_XC);
  const float* xin_lat = l == 0 ? p.in[0] : p.out;
  const float* xin_ctx = l == 0 ? p.in[2] : XC;
  bf16* HB = (bf16*)(ws + B_HB);
  bf16* Z = (bf16*)(ws + B_ZB);
  bf16* H2 = (bf16*)(ws + B_KN);
  const int Mpost = l == 0 ? MT : ML;
  switch (s) {
    case 0:
      if (l == 1) phase_convw(tidv, bidv, p, 1, smem);
      phase_norm(tidv, bidv, xin_lat, xin_ctx, p.in[6] + l * 2048, mod, 0, 2048, HB, MT);
      break;
    case 1:
      run_gemm<G_IN>(tidv, bidv, p, l, smem, HB, 2048, wb + OW_IN, 2048, NIN, MT, 0, nullptr, nullptr, nullptr, nullptr);
      break;
    case 2:
#if !defined(PH2_ONLY) || PH2_ONLY == 0
      run_gemm<G_UKV>(tidv, bidv, p, l, smem, Z + C_CKV, NIN, wb + OW_UKV, 512, 2048, MT, 0, nullptr, nullptr, nullptr, nullptr);
#endif
#if !defined(PH2_ONLY) || PH2_ONLY == 1
      run_gemm<G_UQ>(tidv, bidv, p, l, smem, Z + C_CQ, NIN, wb + OW_UQ, 512, 1536, MT, 0, nullptr, nullptr, nullptr, nullptr);
#endif
#if !defined(PH2_ONLY) || PH2_ONLY == 2
      run_gemm<G_G2>(tidv, bidv, p, l, smem, Z + C_GD, NIN, wb + OW_G2, 192, 1024, MT, 0, nullptr, nullptr, nullptr, nullptr);
#endif
#if !defined(PH2_ONLY) || PH2_ONLY == 3
      for (int d = 0; d < 2; d++) {
        run_gemm<G_W2>(tidv, bidv, p, l, smem, Z + C_WD + 64 * d, NIN, wb + OW_W2 + (size_t)d * 65536, 64, 1024, MT, d, nullptr, nullptr, nullptr, nullptr);
        run_gemm<G_A2>(tidv, bidv, p, l, smem, Z + C_AD + 64 * d, NIN, wb + OW_A2 + (size_t)d * 65536, 64, 1024, MT, d, nullptr, nullptr, nullptr, nullptr);
      }
#endif
      break;
    case 3: phase_mla_post(tidv, bidv, p, l); break;
    case 4: phase_mixers(tidv, bidv, p, l, smem, dry); break;
    case 5: phase_post(tidv, bidv, p, l, Mpost); break;
    case 6:
      run_gemm<G_GLU>(tidv, bidv, p, l, smem, (const bf16*)(ws + B_SY), 1024, wb + OW_GLU, 1024, 1024, Mpost, 0, nullptr, nullptr, nullptr, nullptr);
      break;
    case 7:
      run_gemm<G_MG0>(tidv, bidv, p, l, smem, (const bf16*)(ws + B_QB), 1536, wb + OW_BR, 1024, 2048, Mpost, 0, nullptr, nullptr, nullptr, nullptr);
      run_gemm<G_MG1>(tidv, bidv, p, l, smem, (const bf16*)(ws + B_GB), 1024, wb + OW_BR + (size_t)2048 * 1024, 1024, 2048, Mpost, 0, nullptr, nullptr, nullptr, nullptr);
      run_gemm<G_MG2>(tidv, bidv, p, l, smem, Z, NIN, wb + OW_BR + (size_t)2 * 2048 * 1024, 1024, 2048, Mpost, 0, nullptr, nullptr, nullptr, nullptr);
      break;
    case 8:
      run_gemm<G_OUT>(tidv, bidv, p, l, smem, HB, 2048, wb + OW_OUT, 2048, 2048, Mpost, 0, xin_lat, xin_ctx, p.out, XC);
      break;
    case 9:
      phase_norm(tidv, bidv, p.out, XC, p.in[7] + l * 2048, mod, 6144, 8192, H2, Mpost);
      break;
    case 10:
      run_gemm<G_M1>(tidv, bidv, p, l, smem, H2, 2048, wb + OW_M1, 2048, 8192, Mpost, 0, nullptr, nullptr, nullptr, nullptr);
      break;
    case 11:
      run_gemm<G_M2>(tidv, bidv, p, l, smem, Z, 8192, wb + OW_M2, 8192, 2048, Mpost, 0, nullptr, nullptr, p.out, XC);
      break;
  }
}

DEV void grid_barrier(unsigned* cnt, unsigned target) {
  asm volatile("s_waitcnt vmcnt(0)" ::: "memory");
  __syncthreads();
  if (threadIdx.x == 0) {
    __builtin_amdgcn_fence(__ATOMIC_RELEASE, "agent");
    asm volatile("s_waitcnt vmcnt(0)" ::: "memory");
    __hip_atomic_fetch_add(cnt, 1u, __ATOMIC_RELAXED, __HIP_MEMORY_SCOPE_AGENT);
    unsigned spins = 0;
    while (__hip_atomic_load(cnt, __ATOMIC_RELAXED, __HIP_MEMORY_SCOPE_AGENT) < target) {
      __builtin_amdgcn_s_sleep(1);
      if (++spins > (1u << 21)) break;
    }
    __builtin_amdgcn_fence(__ATOMIC_ACQUIRE, "agent");
    asm volatile("s_waitcnt vmcnt(0)" ::: "memory");
  }
  __syncthreads();
}

__global__ void __launch_bounds__(NT) fwd_megakernel(Params p, int ph0, int ph1, int dryflag) {
  extern __shared__ __attribute__((aligned(16))) char smem[];
  for (int ph = ph0; ph < ph1; ph++) {
    int tidv = threadIdx.x, bidv = blockIdx.x;
    asm volatile("" : "+v"(tidv));
    asm volatile("" : "+s"(bidv));
#ifdef PROBE_MASK
    if (dryflag && ((ph == 0 && (PROBE_MASK & 0x1000)) || (ph > 0 && ((PROBE_MASK >> ((ph - 1) % 12)) & 1)))) {
      run_phase(tidv, bidv, p, ph, smem, dryflag);
      cg::this_grid().sync();
    }
#endif
    run_phase(tidv, bidv, p, ph, smem, 0);
    if (ph + 1 < ph1) {
      if (ph == ph0) cg::this_grid().sync();
      else grid_barrier((unsigned*)(p.ws + B_FLG), (unsigned)(ph - ph0) * gridDim.x);
    }
  }
}

extern "C" void kernel_launch(void* const* d_in, const int* in_sizes, int n_in, void* d_out, int out_size, void* d_ws, size_t ws_size,
                              hipStream_t stream) {
  static int grid_blocks = 0;
  if (!grid_blocks) {
    int dev = 0, cus = 0, per_cu = 0;
    (void)hipGetDevice(&dev);
    (void)hipDeviceGetAttribute(&cus, hipDeviceAttributeMultiprocessorCount, dev);
    if (hipFuncSetAttribute((const void*)fwd_megakernel, hipFuncAttributeMaxDynamicSharedMemorySize, LDS_BYTES) != hipSuccess) {
      fprintf(stderr, "hipFuncSetAttribute(%d B dynamic LDS) failed\n", LDS_BYTES);
      return;
    }
    if (hipOccupancyMaxActiveBlocksPerMultiprocessor(&per_cu, (const void*)fwd_megakernel, NT, LDS_BYTES) != hipSuccess || per_cu < 1) {
      fprintf(stderr, "occupancy query failed / kernel not resident\n");
      return;
    }
    grid_blocks = cus;
  }
  Params p{};
  for (int i = 0; i < 42; i++) p.in[i] = (const float*)d_in[i];
  p.out = (float*)d_out;
  p.ws = (char*)d_ws;
  if (ws_size < B_END + (8u << 20)) { fprintf(stderr, "workspace too small\n"); return; }
  int ph0 = 0, ph1 = NPH;
  int dryflag = 1;
  void* args[] = {&p, &ph0, &ph1, &dryflag};
  (void)hipMemsetAsync((char*)d_ws + B_FLG, 0, 4096, stream);
  hipError_t e = hipLaunchCooperativeKernel((void*)fwd_megakernel, dim3(grid_blocks), dim3(NT), args, LDS_BYTES, stream);
  if (e != hipSuccess) fprintf(stderr, "cooperative launch failed: %s (grid %d)\n", hipGetErrorString(e), grid_blocks);
}
```

```cpp
#include <hip/hip_runtime.h>
#include <hip/hip_cooperative_groups.h>
#include <stdint.h>
#include <cstdio>
namespace cg = cooperative_groups;

#ifndef MULTI_LAUNCH
#define MULTI_LAUNCH 0
#endif

typedef unsigned short bf16;
using bf16x8 = __attribute__((ext_vector_type(8))) short;
using f32x4 = __attribute__((ext_vector_type(4))) float;
using f32x16 = __attribute__((ext_vector_type(16))) float;

#define DEV __device__ __forceinline__
constexpr int NT = 512, NW = 8;

constexpr int DM = 2048, ML = 16384, MC = 1024, MT = 17408, NIN = 11744, DFF = 8192, NKEY = 4352;
constexpr int C_CQ = 0, C_CKV = 512, C_KR = 1024, C_R = 1088, C_WD = 4160, C_AD = 4288, C_GD = 4416, C_U = 4576, C_GATE = 5600;

constexpr size_t OW_IN = 0;
constexpr size_t OW_UQ = OW_IN + (size_t)NIN * 2048;
constexpr size_t OW_UKV = OW_UQ + 1536 * 512;
constexpr size_t OW_W2 = OW_UKV + 2048 * 512;
constexpr size_t OW_A2 = OW_W2 + 2 * 1024 * 64;
constexpr size_t OW_G2 = OW_A2 + 2 * 1024 * 64;
constexpr size_t OW_GLU = OW_G2 + 1024 * 192;
constexpr size_t OW_BR = OW_GLU + 1024 * 1024;
constexpr size_t OW_OUT = OW_BR + (size_t)3 * 2048 * 1024;
constexpr size_t OW_M1 = OW_OUT + (size_t)2048 * 2048;
constexpr size_t OW_M2 = OW_M1 + (size_t)8192 * 2048;
constexpr size_t OW_END = OW_M2 + (size_t)8192 * 2048;

constexpr size_t SZ1K = (size_t)MT * 1024 * 2;
constexpr size_t B_WB = 0;
constexpr size_t B_HB = B_WB + OW_END * 2;
constexpr size_t B_ZB = B_HB + (size_t)MT * 2048 * 2;
constexpr size_t B_QB = B_ZB + (size_t)MT * NIN * 2;
constexpr size_t B_KN = B_QB + (size_t)MT * 1536 * 2;
constexpr size_t B_VT = B_KN + SZ1K;
constexpr size_t B_KR = B_VT + SZ1K;
constexpr size_t B_AF = B_KR + (size_t)MT * 64 * 2;
constexpr size_t B_AB = B_AF + SZ1K;
constexpr size_t B_GB = B_AB + SZ1K;
constexpr size_t B_SY = B_GB + SZ1K;
constexpr size_t B_XC = B_SY + SZ1K;
constexpr size_t B_MOD = B_XC + (size_t)MC * 2048 * 4;
constexpr size_t B_CNT = B_MOD + (size_t)2 * 5 * 12288 * 4;
constexpr size_t B_FLG = B_CNT + 256;
constexpr size_t B_END = B_FLG + 4096;

struct Params {
  const float* in[42];
  float* out;
  char* ws;
};

typedef __attribute__((ext_vector_type(2))) __bf16 hbf2;
DEV bf16 f2bf(float f) {
  __bf16 h = (__bf16)f;
  return *(unsigned short*)&h;
}
DEV float bf2f(bf16 h) { return __uint_as_float(((uint32_t)h) << 16); }
DEV uint32_t pack2(float a, float b) {
  hbf2 v;
  v[0] = (__bf16)a;
  v[1] = (__bf16)b;
  return *(uint32_t*)&v;
}
DEV float wsum(float v) {
#pragma unroll
  for (int o = 32; o > 0; o >>= 1) v += __shfl_xor(v, o);
  return v;
}
DEV float dpp_xor1(float v) {
  int i = __float_as_int(v);
  return __int_as_float(__builtin_amdgcn_update_dpp(0, i, 0xB1, 0xF, 0xF, true));
}
DEV float dpp_xor2(float v) {
  int i = __float_as_int(v);
  return __int_as_float(__builtin_amdgcn_update_dpp(0, i, 0x4E, 0xF, 0xF, true));
}
DEV float dpp_rmirror(float v) {
  int i = __float_as_int(v);
  return __int_as_float(__builtin_amdgcn_update_dpp(0, i, 0x140, 0xF, 0xF, true));
}
DEV float dpp_hmirror0(float v) {
  int i = __float_as_int(v);
  return __int_as_float(__builtin_amdgcn_update_dpp(0, i, 0x141, 0xF, 0xF, true));
}
DEV float wsum_fast(float v) {
  v += dpp_xor1(v);
  v += dpp_xor2(v);
  v += dpp_hmirror0(v);
  v += dpp_rmirror(v);
  v += __shfl_xor(v, 16);
  v += __shfl_xor(v, 32);
  return v;
}
DEV float sigmoidf_(float x) { return __builtin_amdgcn_rcpf(1.f + __expf(-x)); }

DEV void phase_mod(int tidv, int bidv, const Params& p, char* smem) {
  float* s_in = (float*)smem;
  float* red = s_in + 5 * 2048;
  float* mod = (float*)(p.ws + B_MOD);
  for (int i = tidv; i < 5 * 2048; i += NT) {
    int r = i >> 11, k = i & 2047;
    float v = r < 4 ? p.in[1][r * 2048 + k] : p.in[3][k];
    s_in[i] = v / (1.f + expf(-v));
  }
  __syncthreads();
  int kg = tidv >> 6, c = tidv & 63;
  for (int task = bidv; task < 2 * 192; task += gridDim.x) {
    int l = task / 192, n = (task % 192) * 64 + c;
    const float* w = p.in[4] + (size_t)l * 2048 * 12288 + n;
    float a0 = 0, a1 = 0, a2 = 0, a3 = 0, a4 = 0;
    int kb = kg * 256;
#pragma unroll 8
    for (int k = 0; k < 256; k++) {
      float wv = w[(size_t)(kb + k) * 12288];
      a0 += s_in[kb + k] * wv;
      a1 += s_in[2048 + kb + k] * wv;
      a2 += s_in[4096 + kb + k] * wv;
      a3 += s_in[6144 + kb + k] * wv;
      a4 += s_in[8192 + kb + k] * wv;
    }
    red[(kg * 5 + 0) * 64 + c] = a0;
    red[(kg * 5 + 1) * 64 + c] = a1;
    red[(kg * 5 + 2) * 64 + c] = a2;
    red[(kg * 5 + 3) * 64 + c] = a3;
    red[(kg * 5 + 4) * 64 + c] = a4;
    __syncthreads();
    if (kg == 0) {
      float bias = p.in[5][l * 12288 + n];
#pragma unroll
      for (int r = 0; r < 5; r++) {
        float v = 0.f;
#pragma unroll
        for (int g = 0; g < 8; g++) v += red[(g * 5 + r) * 64 + c];
        mod[(size_t)(l * 5 + r) * 12288 + n] = v + bias;
      }
    }
    __syncthreads();
  }
}

DEV void convT(int tidv, int bidv, const float* __restrict__ src, bf16* __restrict__ dst, int K, int N, const float* __restrict__ gain, char* smem, int dK = 0) {
  if (dK == 0) dK = K;
  float* t = (float*)smem;
  const int tk = (K + 63) >> 6, tn = (N + 63) >> 6, ntile = tk * tn;
  const int kk = tidv >> 4, n4 = (tidv & 15) * 4;
  float4 c0 = {0.f, 0.f, 0.f, 0.f}, c1 = {0.f, 0.f, 0.f, 0.f};
#define CV_LOAD(TILE)                                                                      \
  {                                                                                        \
    const int k0_ = ((TILE) / tn) * 64, n0_ = ((TILE) % tn) * 64;                          \
    c0 = float4{0.f, 0.f, 0.f, 0.f}; c1 = c0;                                              \
    if (n0_ + n4 < N) {                                                                    \
      if (k0_ + kk < K) { c0 = *(const float4*)(src + (size_t)(k0_ + kk) * N + n0_ + n4);  \
        if (gain) { float g = gain[k0_ + kk]; c0.x *= g; c0.y *= g; c0.z *= g; c0.w *= g; } }          \
      if (k0_ + kk + 32 < K) { c1 = *(const float4*)(src + (size_t)(k0_ + kk + 32) * N + n0_ + n4);    \
        if (gain) { float g = gain[k0_ + kk + 32]; c1.x *= g; c1.y *= g; c1.z *= g; c1.w *= g; } }     \
    }                                                                                      \
  }
  if (bidv < ntile) CV_LOAD(bidv)
  for (int tile = bidv; tile < ntile; tile += gridDim.x) {
    int k0 = (tile / tn) * 64, n0 = (tile % tn) * 64;
    __syncthreads();
    t[kk * 65 + n4 + 0] = c0.x; t[kk * 65 + n4 + 1] = c0.y; t[kk * 65 + n4 + 2] = c0.z; t[kk * 65 + n4 + 3] = c0.w;
    t[(kk + 32) * 65 + n4 + 0] = c1.x; t[(kk + 32) * 65 + n4 + 1] = c1.y; t[(kk + 32) * 65 + n4 + 2] = c1.z; t[(kk + 32) * 65 + n4 + 3] = c1.w;
    __syncthreads();
    if (tile + (int)gridDim.x < ntile) CV_LOAD(tile + (int)gridDim.x)
    {
      int c = tidv;
      int nn = c >> 3, kc = c & 7;
      if (n0 + nn < N && k0 + kc * 8 < dK) {
        uint4 o;
        o.x = pack2(t[(kc * 8 + 0) * 65 + nn], t[(kc * 8 + 1) * 65 + nn]);
        o.y = pack2(t[(kc * 8 + 2) * 65 + nn], t[(kc * 8 + 3) * 65 + nn]);
        o.z = pack2(t[(kc * 8 + 4) * 65 + nn], t[(kc * 8 + 5) * 65 + nn]);
        o.w = pack2(t[(kc * 8 + 6) * 65 + nn], t[(kc * 8 + 7) * 65 + nn]);
        *(uint4*)(dst + (size_t)(n0 + nn) * dK + k0 + kc * 8) = o;
      }
    }
  }
#undef CV_LOAD
}

DEV void phase_convw(int tidv, int bidv, const Params& p, int l, char* smem) {
  bf16* wb = (bf16*)(p.ws + B_WB);
  convT(tidv, bidv, p.in[8] + (size_t)l * 2048 * NIN, wb + OW_IN, 2048, NIN, nullptr, smem);
  convT(tidv, bidv, p.in[40] + (size_t)l * 2048 * 8192, wb + OW_M1, 2048, 8192, nullptr, smem);
  convT(tidv, bidv, p.in[41] + (size_t)l * 8192 * 2048, wb + OW_M2, 8192, 2048, nullptr, smem);
  for (int n = 0; n < 3; n++)
    convT(tidv, bidv, p.in[38] + (size_t)(l * 3 + n) * 1024 * 2048, wb + OW_BR + (size_t)n * 2048 * 1024, 1024, 2048, nullptr, smem);
  convT(tidv, bidv, p.in[39] + (size_t)l * 2048 * 2048, wb + OW_OUT, 2048, 2048, nullptr, smem);
  convT(tidv, bidv, p.in[11] + (size_t)l * 512 * 1536, wb + OW_UQ, 512, 1536, p.in[9] + l * 512, smem);
  convT(tidv, bidv, p.in[12] + (size_t)l * 512 * 2048, wb + OW_UKV, 512, 2048, p.in[10] + l * 512, smem);
  convT(tidv, bidv, p.in[36] + (size_t)l * 1024 * 1024, wb + OW_GLU, 1024, 1024, nullptr, smem);
  for (int d = 0; d < 2; d++) {
    convT(tidv, bidv, p.in[19] + (size_t)(l * 2 + d) * 64 * 1024, wb + OW_W2 + (size_t)d * 65536, 64, 1024, nullptr, smem);
    convT(tidv, bidv, p.in[21] + (size_t)(l * 2 + d) * 64 * 1024, wb + OW_A2 + (size_t)d * 65536, 64, 1024, nullptr, smem);
  }
  convT(tidv, bidv, p.in[22] + (size_t)l * 160 * 1024, wb + OW_G2, 160, 1024, nullptr, smem, 192);
}

DEV void phase_norm(int tidv, int bidv, const float* xlat, const float* xctx, const float* g, const float* mod, int shOff, int scOff, bf16* H, int nrows) {
  int wave = tidv >> 6, lane = tidv & 63;
  for (int row = bidv * NW + wave; row < nrows; row += gridDim.x * NW) {
    const float* x = row < ML ? xlat + (size_t)row * 2048 : xctx + (size_t)(row - ML) * 2048;
    int b = row < ML ? (row >> 12) : 4;
    const float* sh = mod + b * 12288 + shOff;
    const float* sc = mod + b * 12288 + scOff;
    float4 v[8];
    float ss = 0.f;
#pragma unroll
    for (int i = 0; i < 8; i++) {
      v[i] = *(const float4*)(x + i * 256 + lane * 4);
      ss += v[i].x * v[i].x + v[i].y * v[i].y + v[i].z * v[i].z + v[i].w * v[i].w;
    }
    ss = wsum_fast(ss);
    float rinv = rsqrtf(ss * (1.f / 2048.f) + 1e-6f);
#pragma unroll
    for (int i = 0; i < 8; i++) {
      int c = i * 256 + lane * 4;
      float4 g4 = *(const float4*)(g + c), s4 = *(const float4*)(sc + c), h4 = *(const float4*)(sh + c);
      float y0 = v[i].x * rinv * g4.x * (1.f + s4.x) + h4.x;
      float y1 = v[i].y * rinv * g4.y * (1.f + s4.y) + h4.y;
      float y2 = v[i].z * rinv * g4.z * (1.f + s4.z) + h4.z;
      float y3 = v[i].w * rinv * g4.w * (1.f + s4.w) + h4.w;
      uint2 o;
      o.x = pack2(y0, y1);
      o.y = pack2(y2, y3);
      *(uint2*)(H + (size_t)row * 2048 + c) = o;
    }
  }
}

constexpr int LDT = 72;
constexpr int GA_BYTES = 256 * LDT * 2;
constexpr int GSTAGE = 512 * LDT * 2;
constexpr int SM_RINV = 2 * GSTAGE;
constexpr int SM_ITEM = SM_RINV + 1024;
constexpr int LDS_BYTES = SM_ITEM + 16;
DEV float sumsq8(uint4 r) {
  float s = 0.f, x;
  x = bf2f((bf16)(r.x & 0xffff)); s += x * x; x = bf2f((bf16)(r.x >> 16)); s += x * x;
  x = bf2f((bf16)(r.y & 0xffff)); s += x * x; x = bf2f((bf16)(r.y >> 16)); s += x * x;
  x = bf2f((bf16)(r.z & 0xffff)); s += x * x; x = bf2f((bf16)(r.z >> 16)); s += x * x;
  x = bf2f((bf16)(r.w & 0xffff)); s += x * x; x = bf2f((bf16)(r.w >> 16)); s += x * x;
  return s;
}

template <bool ROWNORM>
DEV void gemm_mainloop(int tidv, int bidv, const bf16* __restrict__ A, int lda, bool amap, const bf16* __restrict__ Bt, int K, int N, int m0, int n0,
                       char* smem, f32x16 (&acc)[4][2]) {
  float* srinv = (float*)(smem + SM_RINV);
  const int tid = tidv, lane = tid & 63, wave = tid >> 6;
  const int wm = wave >> 2, wn = wave & 3;
  const int lr = tid >> 3, kc = tid & 7;
  const char* abase = (const char*)(A + (size_t)m0 * lda);
  const char* bbase = (const char*)(Bt + (size_t)n0 * K);
  const uint32_t voa = (uint32_t)(lr * lda + kc * 8) * 2u;
  const uint32_t astep = (uint32_t)(64 * lda) * 2u;
  const uint32_t vob0 = (uint32_t)(lr * K + kc * 8) * 2u;
  const uint32_t bstep = (uint32_t)(64 * K) * 2u;
  const uint32_t lds_st = (uint32_t)(lr * LDT + kc * 8) * 2u;
  const int nk = K >> 6;
  uint4 xa0, xa1, xa2, xa3, xb0, xb1, xb2, xb3;
#define G_LOAD(KT)                                                         \
  {                                                                        \
    const int k0_ = (KT) << 6;                                             \
    const int ka_ = amap ? ((k0_ >> 7) * 192 + (k0_ & 127)) : k0_;         \
    xa0 = *(const uint4*)(abase + (size_t)ka_ * 2 + voa);                  \
    xa1 = *(const uint4*)(abase + (size_t)ka_ * 2 + astep + voa);          \
    xa2 = *(const uint4*)(abase + (size_t)ka_ * 2 + 2 * astep + voa);      \
    xa3 = *(const uint4*)(abase + (size_t)ka_ * 2 + 3 * astep + voa);      \
    xb0 = *(const uint4*)(bbase + (size_t)k0_ * 2 + vob0);                 \
    xb1 = *(const uint4*)(bbase + (size_t)k0_ * 2 + bstep + vob0);         \
    xb2 = *(const uint4*)(bbase + (size_t)k0_ * 2 + 2 * bstep + vob0);     \
    xb3 = *(const uint4*)(bbase + (size_t)k0_ * 2 + 3 * bstep + vob0);     \
  }
#define G_STORE(SN)                                                  \
  *(uint4*)((SN) + lds_st) = xa0;                                    \
  *(uint4*)((SN) + 1 * (64 * LDT * 2) + lds_st) = xa1;               \
  *(uint4*)((SN) + 2 * (64 * LDT * 2) + lds_st) = xa2;               \
  *(uint4*)((SN) + 3 * (64 * LDT * 2) + lds_st) = xa3;               \
  *(uint4*)((SN) + GA_BYTES + lds_st) = xb0;                         \
  *(uint4*)((SN) + GA_BYTES + 1 * (64 * LDT * 2) + lds_st) = xb1;    \
  *(uint4*)((SN) + GA_BYTES + 2 * (64 * LDT * 2) + lds_st) = xb2;    \
  *(uint4*)((SN) + GA_BYTES + 3 * (64 * LDT * 2) + lds_st) = xb3;
  const uint32_t fa = (uint32_t)((wm * 128 + (lane & 31)) * LDT + (lane >> 5) * 8) * 2u;
  const uint32_t fb = (uint32_t)GA_BYTES + (uint32_t)((wn * 64 + (lane & 31)) * LDT + (lane >> 5) * 8) * 2u;
  const int nkm = nk - 1;
  if (ROWNORM) {
    __syncthreads();
#pragma unroll 1
    for (int i = 0; i < 4; i++) {
      float ss = 0.f;
      for (int kk = 0; kk < nk; kk++) ss += sumsq8(*(const uint4*)(abase + (size_t)kk * 128 + i * astep + voa));
      ss += __shfl_xor(ss, 1); ss += __shfl_xor(ss, 2); ss += __shfl_xor(ss, 4);
      if (kc == 0) srinv[lr + 64 * i] = rsqrtf(ss / (float)K + 1e-6f);
    }
  }
  G_LOAD(0)
  __syncthreads();
  G_STORE(smem)
  G_LOAD((1 < nkm ? 1 : nkm))
  __syncthreads();
#define G_FRAG(P, ST, KS)                                                            \
  P##a0 = *(const bf16x8*)((ST) + fa + 0 * (32 * LDT * 2) + (KS) * 32);                \
  P##a1 = *(const bf16x8*)((ST) + fa + 1 * (32 * LDT * 2) + (KS) * 32);                \
  P##a2 = *(const bf16x8*)((ST) + fa + 2 * (32 * LDT * 2) + (KS) * 32);                \
  P##a3 = *(const bf16x8*)((ST) + fa + 3 * (32 * LDT * 2) + (KS) * 32);                \
  P##b0 = *(const bf16x8*)((ST) + fb + 0 * (32 * LDT * 2) + (KS) * 32);                \
  P##b1 = *(const bf16x8*)((ST) + fb + 1 * (32 * LDT * 2) + (KS) * 32);
#define G_MMA(P)                                                                              \
  acc[0][0] = __builtin_amdgcn_mfma_f32_32x32x16_bf16(P##b0, P##a0, acc[0][0], 0, 0, 0);      \
  acc[0][1] = __builtin_amdgcn_mfma_f32_32x32x16_bf16(P##b1, P##a0, acc[0][1], 0, 0, 0);      \
  acc[1][0] = __builtin_amdgcn_mfma_f32_32x32x16_bf16(P##b0, P##a1, acc[1][0], 0, 0, 0);      \
  acc[1][1] = __builtin_amdgcn_mfma_f32_32x32x16_bf16(P##b1, P##a1, acc[1][1], 0, 0, 0);      \
  acc[2][0] = __builtin_amdgcn_mfma_f32_32x32x16_bf16(P##b0, P##a2, acc[2][0], 0, 0, 0);      \
  acc[2][1] = __builtin_amdgcn_mfma_f32_32x32x16_bf16(P##b1, P##a2, acc[2][1], 0, 0, 0);      \
  acc[3][0] = __builtin_amdgcn_mfma_f32_32x32x16_bf16(P##b0, P##a3, acc[3][0], 0, 0, 0);      \
  acc[3][1] = __builtin_amdgcn_mfma_f32_32x32x16_bf16(P##b1, P##a3, acc[3][1], 0, 0, 0);
  bf16x8 pa0, pa1, pa2, pa3, pb0, pb1, qa0, qa1, qa2, qa3, qb0, qb1;
#pragma unroll 1
  for (int kt = 0; kt < nk; kt++) {
    const char* st = smem + (kt & 1) * GSTAGE;
    char* sn = smem + ((kt + 1) & 1) * GSTAGE;
    if (!ROWNORM) {
      G_FRAG(p, st, 0)
      G_FRAG(q, st, 1)
      __builtin_amdgcn_sched_barrier(0);
      G_MMA(p)
      __builtin_amdgcn_sched_barrier(0);
      G_FRAG(p, st, 2)
      __builtin_amdgcn_sched_barrier(0);
      G_MMA(q)
      __builtin_amdgcn_sched_barrier(0);
      G_FRAG(q, st, 3)
      if (kt + 1 < nk) { G_STORE(sn) }
      G_LOAD((kt + 2 < nkm ? kt + 2 : nkm))
      __builtin_amdgcn_sched_barrier(0);
      G_MMA(p)
      __builtin_amdgcn_sched_barrier(0);
      G_MMA(q)
    } else {
      G_FRAG(p, st, 0)
      __builtin_amdgcn_sched_barrier(0);
      G_MMA(p)
      __builtin_amdgcn_sched_barrier(0);
      G_FRAG(p, st, 1)
      __builtin_amdgcn_sched_barrier(0);
      G_MMA(p)
      __builtin_amdgcn_sched_barrier(0);
      G_FRAG(p, st, 2)
      if (kt + 1 < nk) { G_STORE(sn) }
      G_LOAD((kt + 2 < nkm ? kt + 2 : nkm))
      __builtin_amdgcn_sched_barrier(0);
      G_MMA(p)
      __builtin_amdgcn_sched_barrier(0);
      G_FRAG(p, st, 3)
      __builtin_amdgcn_sched_barrier(0);
      G_MMA(p)
    }
    __syncthreads();
  }
#undef G_FRAG
#undef G_MMA
#undef G_LOAD
#undef G_STORE
}

DEV void zero_acc(f32x16 (&acc)[4][2]) {
#pragma unroll
  for (int i = 0; i < 4; i++)
#pragma unroll
    for (int j = 0; j < 2; j++)
#pragma unroll
      for (int e = 0; e < 16; e++) acc[i][j][e] = 0.f;
}

template <class F>
DEV void epi_loop(int tidv, int bidv, f32x16 (&acc)[4][2], int m0, int n0, int N, F f) {
  const int lane = tidv & 63, wave = tidv >> 6;
  const int wm = wave >> 2, wn = wave & 3;
#pragma unroll
  for (int i = 0; i < 4; i++) {
    const int lrow = wm * 128 + i * 32 + (lane & 31);
#pragma unroll
    for (int j = 0; j < 2; j++) {
#pragma unroll
      for (int g = 0; g < 4; g++) {
        int col = n0 + wn * 64 + j * 32 + 8 * g + 4 * (lane >> 5);
        f32x4 v = {acc[i][j][4 * g], acc[i][j][4 * g + 1], acc[i][j][4 * g + 2], acc[i][j][4 * g + 3]};
        if (col < N) f(m0 + lrow, lrow, col, v);
      }
    }
    __builtin_amdgcn_sched_barrier(0);
  }
}

DEV uint2 pack4(f32x4 v) {
  uint2 o;
  o.x = pack2(v[0], v[1]);
  o.y = pack2(v[2], v[3]);
  return o;
}
DEV f32x4 unpack4(uint2 u) {
  f32x4 v;
  v[0] = bf2f((bf16)(u.x & 0xffff)); v[1] = bf2f((bf16)(u.x >> 16));
  v[2] = bf2f((bf16)(u.y & 0xffff)); v[3] = bf2f((bf16)(u.y >> 16));
  return v;
}

enum { G_IN = 0, G_UQ, G_UKV, G_W2, G_A2, G_G2, G_GLU, G_OUT, G_M1, G_M2, G_MG0, G_MG1, G_MG2 };

template <int MODE>
DEV void run_gemm(int tidv, int bidv, const Params& p, int l, char* smem, const bf16* A, int lda, const bf16* Bt, int K, int N, int M, int aux,
                  const float* xin_lat, const float* xin_ctx, float* xout_lat, float* xout_ctx, int rot = 0) {
  const int nt = (N + 255) >> 8, mt = M >> 8;
  char* ws = p.ws;
  bf16* Z = (bf16*)(ws + B_ZB);
  const float* srinv = (const float*)(smem + SM_RINV);
  const float* mod = (const float*)(ws + B_MOD) + (size_t)l * 5 * 12288;
  for (int tile = (bidv + rot) % (int)gridDim.x; tile < nt * mt; tile += gridDim.x) {
    int m0 = (tile / nt) << 8, n0 = (tile % nt) << 8;
    f32x16 acc[4][2];
    zero_acc(acc);
    gemm_mainloop<(MODE == G_UQ || MODE == G_UKV)>(tidv, bidv, A, lda, MODE == G_MG0, Bt, K, N, m0, n0, smem, acc);
    if constexpr (MODE != G_OUT && MODE != G_M2)
    epi_loop(tidv, bidv, acc, m0, n0, N, [&](int row, int lrow, int col, f32x4 v) {
      if constexpr (MODE == G_IN) {
        f32x4 o = v;
        if (col >= C_GATE || (col >= C_GD && col < C_U)) {
#pragma unroll
          for (int r = 0; r < 4; r++) o[r] = sigmoidf_(v[r]);
        } else if (col >= C_WD && col < C_AD) {
#pragma unroll
          for (int r = 0; r < 4; r++) o[r] = tanhf(v[r]);
        }
        *(uint2*)(smem + ((size_t)lrow * 264 + (col - n0)) * 2) = pack4(o);
      } else if constexpr (MODE == G_UQ) {
        float ri = srinv[lrow];
        *(uint2*)((bf16*)(ws + B_QB) + (size_t)row * 1536 + col) = pack4(v * ri);
      } else if constexpr (MODE == G_UKV) {
        float ri = srinv[lrow];
        f32x4 o = v * ri;
        int h = col >> 8, c = col & 255;
        if (c < 128) {
          *(uint2*)((bf16*)(ws + B_KN) + (size_t)row * 1024 + h * 128 + c) = pack4(o);
        } else {
          int b, kp;
          if (row < ML) { b = row >> 12; kp = row & 4095; } else { int r2 = row - ML; b = r2 >> 8; kp = 4096 + (r2 & 255); }
          bf16* vt = (bf16*)(ws + B_VT) + ((size_t)((b * 8 + h) * 128 + (c - 128))) * NKEY + kp;
#pragma unroll
          for (int r = 0; r < 4; r++) vt[(size_t)r * NKEY] = f2bf(o[r]);
        }
      } else if constexpr (MODE == G_W2) {
        float4 w0 = *(const float4*)(p.in[18] + (l * 2 + aux) * 1024 + col);
        f32x4 o;
        o[0] = 0.60653066f * sigmoidf_(w0.x + v[0]);
        o[1] = 0.60653066f * sigmoidf_(w0.y + v[1]);
        o[2] = 0.60653066f * sigmoidf_(w0.z + v[2]);
        o[3] = 0.60653066f * sigmoidf_(w0.w + v[3]);
        *(uint2*)((bf16*)(ws + B_HB + (size_t)aux * SZ1K) + (size_t)row * 1024 + col) = pack4(o);
      } else if constexpr (MODE == G_A2) {
        float4 a0 = *(const float4*)(p.in[20] + (l * 2 + aux) * 1024 + col);
        f32x4 o;
        o[0] = sigmoidf_(a0.x + v[0]);
        o[1] = sigmoidf_(a0.y + v[1]);
        o[2] = sigmoidf_(a0.z + v[2]);
        o[3] = sigmoidf_(a0.w + v[3]);
        *(uint2*)((bf16*)(ws + (aux ? B_AB : B_AF)) + (size_t)row * 1024 + col) = pack4(o);
      } else if constexpr (MODE == G_G2) {
        *(uint2*)((bf16*)(ws + B_GB) + (size_t)row * 1024 + col) = pack4(v);
      } else if constexpr (MODE == G_GLU) {
        f32x4 zz = unpack4(*(const uint2*)((const bf16*)(ws + B_SY) + (size_t)row * 1024 + col));
        float4 gb = *(const float4*)(p.in[37] + l * 1024 + col);
        f32x4 o;
        o[0] = zz[0] * sigmoidf_(v[0] + gb.x);
        o[1] = zz[1] * sigmoidf_(v[1] + gb.y);
        o[2] = zz[2] * sigmoidf_(v[2] + gb.z);
        o[3] = zz[3] * sigmoidf_(v[3] + gb.w);
        *(uint2*)(smem + ((size_t)lrow * 264 + (col - n0)) * 2) = pack4(o);
      } else if constexpr (MODE == G_OUT || MODE == G_M2) {
      } else if constexpr (MODE == G_M1) {
        f32x4 o;
#pragma unroll
        for (int r = 0; r < 4; r++) { float t = fmaxf(v[r], 0.f); o[r] = t * t; }
        *(uint2*)(smem + ((size_t)lrow * 264 + (col - n0)) * 2) = pack4(o);
      } else if constexpr (MODE == G_MG0 || MODE == G_MG1 || MODE == G_MG2) {
        *(uint2*)(smem + ((size_t)lrow * 264 + (col - n0)) * 2) = pack4(v);
      }
    });
    if constexpr (MODE == G_OUT || MODE == G_M2) {
      float* tilef = (float*)smem;
      constexpr int GOFF = (MODE == G_OUT) ? 4096 : 10240;
      const int wn_ = (tidv >> 6) & 3;
#pragma unroll 1
      for (int half = 0; half < 2; half++) {
        if ((wn_ >> 1) == half) {
          epi_loop(tidv, bidv, acc, m0, n0, N, [&](int row, int lrow, int col, f32x4 v) {
            *(f32x4*)(tilef + (size_t)lrow * 132 + (col - n0 - half * 128)) = v;
          });
        }
        __syncthreads();
#pragma unroll 2
        for (int it = 0; it < 16; it++) {
          int c = it * NT + tidv;
          int r = c >> 5, ch = c & 31;
          int row = m0 + r, col = n0 + half * 128 + ch * 4;
          int b = row < ML ? (row >> 12) : 4;
          float4 g = *(const float4*)(mod + b * 12288 + GOFF + col);
          const float* xi;
          if constexpr (MODE == G_OUT) xi = row < ML ? xin_lat + (size_t)row * 2048 : xin_ctx + (size_t)(row - ML) * 2048;
          else xi = row < ML ? xout_lat + (size_t)row * 2048 : xout_ctx + (size_t)(row - ML) * 2048;
          float* xo = row < ML ? xout_lat + (size_t)row * 2048 : xout_ctx + (size_t)(row - ML) * 2048;
          float4 x = *(const float4*)(xi + col);
          f32x4 v = *(const f32x4*)(tilef + (size_t)r * 132 + ch * 4);
          x.x += g.x * v[0]; x.y += g.y * v[1]; x.z += g.z * v[2]; x.w += g.w * v[3];
          *(float4*)(xo + col) = x;
        }
        __syncthreads();
      }
    }
    if constexpr (MODE == G_MG0 || MODE == G_MG1 || MODE == G_MG2) {
      constexpr int nb = MODE - G_MG0;
      bf16* MG = (bf16*)(ws + B_HB);
      __syncthreads();
#pragma unroll 2
      for (int it = 0; it < 16; it++) {
        int c = it * NT + tidv;
        int r = c >> 5, ch = c & 31;
        int col = n0 + ch * 8;
        uint4 pv = *(const uint4*)(smem + ((size_t)r * 264 + ch * 8) * 2);
        uint4 gv = *(const uint4*)(Z + (size_t)(m0 + r) * NIN + C_GATE + nb * 2048 + col);
        f32x4 p0 = unpack4(uint2{pv.x, pv.y}), p1 = unpack4(uint2{pv.z, pv.w});
        f32x4 g0 = unpack4(uint2{gv.x, gv.y}), g1 = unpack4(uint2{gv.z, gv.w});
        f32x4 o0 = g0 * p0, o1 = g1 * p1;
        if constexpr (nb > 0) {
          uint4 qv = *(const uint4*)(MG + (size_t)(m0 + r) * 2048 + col);
          o0 += unpack4(uint2{qv.x, qv.y});
          o1 += unpack4(uint2{qv.z, qv.w});
        }
        uint2 a = pack4(o0), b = pack4(o1);
        *(uint4*)(MG + (size_t)(m0 + r) * 2048 + col) = uint4{a.x, a.y, b.x, b.y};
      }
    }
    if constexpr (MODE == G_IN || MODE == G_GLU || MODE == G_M1) {
      bf16* dst;
      int ld;
      if constexpr (MODE == G_IN || MODE == G_GLU) { dst = Z; ld = NIN; }
      else { dst = Z; ld = DFF; }
      __syncthreads();
#pragma unroll 4
      for (int it = 0; it < 16; it++) {
        int c = it * NT + tidv;
        int r = c >> 5, ch = c & 31;
        int col = n0 + ch * 8;
        if (col < N) *(uint4*)(dst + (size_t)(m0 + r) * ld + col) = *(const uint4*)(smem + ((size_t)r * 264 + ch * 8) * 2);
      }
    }
  }
}

DEV void phase_mla_post(int tidv, int bidv, const Params& p, int l) {
  char* ws = p.ws;
  const float* qng = p.in[13] + l * 128;
  const float* qrg = p.in[14] + l * 64;
  const float* kng = p.in[15] + l * 128;
  const float* krg = p.in[16] + l * 64;
  bf16* QB = (bf16*)(ws + B_QB);
  bf16* KN = (bf16*)(ws + B_KN);
  bf16* KR = (bf16*)(ws + B_KR);
  const bf16* Z = (const bf16*)(ws + B_ZB);
  const int wave = tidv >> 6, lane = tidv & 63;
  const float QS = 1.4426950408889634f * 0.07216878364870322f;
  const int idx = lane & 31;
  const float inv = powf(10000.f, -(float)(idx & 15) / 16.f);
  const float gq0 = qng[2 * lane], gq1 = qng[2 * lane + 1], gk0 = kng[2 * lane], gk1 = kng[2 * lane + 1];
  const float gqr = qrg[lane], gkr = krg[lane];
  for (int row = bidv * NW + wave; row < MT; row += gridDim.x * NW) {
    bool lat = row < ML;
    int t = row & 4095;
    float pos = (idx < 16) ? (float)(t >> 6) : (float)(t & 63);
    float ang = pos * inv;
    float cs = 1.f, sn = 0.f;
    if (lat) { cs = cosf(ang); sn = sinf(ang); }
#pragma unroll 1
    for (int h = 0; h < 8; h++) {
      bf16* q = QB + (size_t)row * 1536 + h * 192;
      uint32_t u = *(const uint32_t*)(q + 2 * lane);
      float x0 = bf2f((bf16)(u & 0xffff)), x1 = bf2f((bf16)(u >> 16));
      float ss = wsum_fast(x0 * x0 + x1 * x1);
      float rinv = rsqrtf(ss * (1.f / 128.f) + 1e-6f) * QS;
      *(uint32_t*)(q + 2 * lane) = pack2(x0 * rinv * gq0, x1 * rinv * gq1);
      float xr = bf2f(q[128 + lane]);
      float ss2 = wsum_fast(xr * xr);
      float y = xr * rsqrtf(ss2 * (1.f / 64.f) + 1e-6f) * gqr;
      float yp = __shfl_xor(y, 32);
      float o = lane < 32 ? (y * cs - yp * sn) : (yp * sn + y * cs);
      q[128 + lane] = f2bf(o * QS);
      bf16* k = KN + (size_t)row * 1024 + h * 128;
      uint32_t uk = *(const uint32_t*)(k + 2 * lane);
      float k0 = bf2f((bf16)(uk & 0xffff)), k1 = bf2f((bf16)(uk >> 16));
      float ssk = wsum_fast(k0 * k0 + k1 * k1);
      float rk = rsqrtf(ssk * (1.f / 128.f) + 1e-6f);
      *(uint32_t*)(k + 2 * lane) = pack2(k0 * rk * gk0, k1 * rk * gk1);
    }
    {
      float xr = bf2f(Z[(size_t)row * NIN + C_KR + lane]);
      float ss2 = wsum_fast(xr * xr);
      float y = xr * rsqrtf(ss2 * (1.f / 64.f) + 1e-6f) * gkr;
      float yp = __shfl_xor(y, 32);
      float o = lane < 32 ? (y * cs - yp * sn) : (yp * sn + y * cs);
      KR[(size_t)row * 64 + lane] = f2bf(o);
    }
  }
}

DEV void step_row(int s, int d, int b, int& row, int& tau, int& len) {
  if (s < 256) { tau = d ? 255 - s : s; len = 256; row = ML + b * 256 + tau; }
  else { int q = s - 256; tau = d ? 4095 - q : q; len = 4096; row = b * 4096 + tau; }
}

struct RwPre { bf16 r0, r1, r2, k0, k1, k2, v0, v1, v2, a, e; };

DEV void rwkv_fetch(RwPre& q, const bf16* Z, const bf16* AD, const bf16* ED, int s, int d, int b, int ch) {
  int row, tau, len;
  step_row(s, d, b, row, tau, len);
  const bf16* z = Z + (size_t)row * NIN + C_R + ch;
  q.r1 = z[0]; q.k1 = z[1024]; q.v1 = z[2048];
  q.r0 = 0; q.k0 = 0; q.v0 = 0; q.r2 = 0; q.k2 = 0; q.v2 = 0;
  if (tau > 0) { const bf16* zm = z - NIN; q.r0 = zm[0]; q.k0 = zm[1024]; q.v0 = zm[2048]; }
  if (tau < len - 1) { const bf16* zp = z + NIN; q.r2 = zp[0]; q.k2 = zp[1024]; q.v2 = zp[2048]; }
  q.a = AD[(size_t)row * 1024 + ch];
  q.e = ED[(size_t)row * 1024 + ch];
}

typedef float f2v __attribute__((ext_vector_type(2)));
DEV float dpp_hmirror(float v) {
  int i = __float_as_int(v);
  return __int_as_float(__builtin_amdgcn_update_dpp(0, i, 0x141, 0xF, 0xF, true));
}
DEV f2v lo2(float4 v) { return f2v{v.x, v.y}; }
DEV f2v hi2(float4 v) { return f2v{v.z, v.w}; }

DEV void rwkv_scan(int tidv, int bidv, const Params& p, int l, int chain, char* smem, int dry) {
  char* ws = p.ws;
  float* op = (float*)smem;
  float* vb = op + 16 * 320;
  float* yb = vb + 16 * 64;
  const int tid = tidv, wave = tid >> 6, lane = tid & 63;
  const int d = chain & 1, h = (chain >> 1) & 15, b = chain >> 5;
  const int ch = h * 64 + lane;
  const float* cw = p.in[17] + (size_t)l * 3 * 3072;
  const float cr0 = cw[ch], cr1 = cw[3072 + ch], cr2 = cw[6144 + ch];
  const float ck0 = cw[1024 + ch], ck1 = cw[3072 + 1024 + ch], ck2 = cw[6144 + 1024 + ch];
  const float cv0 = cw[2048 + ch], cv1 = cw[3072 + 2048 + ch], cv2 = cw[6144 + 2048 + ch];
  const float kkc = p.in[23][l * 1024 + ch], kac = p.in[24][l * 1024 + ch];
  const bf16* Z = (const bf16*)(ws + B_ZB);
  bf16* ED = (bf16*)(ws + B_HB + (size_t)d * SZ1K);
  const bf16* AD = (const bf16*)(ws + (d ? B_AB : B_AF));
  f2v A0 = {0.f, 0.f}, A1 = {0.f, 0.f}, B0 = {0.f, 0.f}, B1 = {0.f, 0.f};
  const int ri = lane >> 4, jo = lane & 15, rA = wave * 8 + ri, rB = rA + 4;
  RwPre pre[2];
#pragma unroll
  for (int si = 0; si < 2; si++) rwkv_fetch(pre[si], Z, AD, ED, wave * 2 + si, d, b, ch);
  for (int chunk = 0; chunk < 272; chunk++) {
#pragma unroll
    for (int si = 0; si < 2; si++) {
      int t = wave * 2 + si;
      const RwPre& q = pre[si];
      float rr = cr0 * bf2f(q.r0) + cr1 * bf2f(q.r1) + cr2 * bf2f(q.r2);
      float kk_ = ck0 * bf2f(q.k0) + ck1 * bf2f(q.k1) + ck2 * bf2f(q.k2);
      float vv = cv0 * bf2f(q.v0) + cv1 * bf2f(q.v1) + cv2 * bf2f(q.v2);
      float kkv = kk_ * kkc;
      float ssq = wsum_fast(kkv * kkv);
      float kn = kkv * rsqrtf(ssq + 1e-12f);
      float a = bf2f(q.a);
      float w = __expf(-bf2f(q.e));
      float krep = kk_ * (1.f + (a - 1.f) * kac);
      float* o = op + t * 320;
      o[lane] = w;
      o[64 + lane] = kn * a;
      o[128 + lane] = krep;
      o[192 + lane] = -kn;
      o[256 + lane] = rr;
      vb[t * 64 + lane] = vv;
    }
    __syncthreads();
    if (chunk + 1 < 272) {
#pragma unroll
      for (int si = 0; si < 2; si++) rwkv_fetch(pre[si], Z, AD, ED, (chunk + 1) * 16 + wave * 2 + si, d, b, ch);
    }
    {
      const float4* o4 = (const float4*)op + jo;
      float4 nn = o4[48];
#pragma unroll 4
      for (int t = 0; t < 16; t++) {
        const float4* ot = o4 + t * 80;
        const float4 w = ot[0], a = ot[16], k = ot[32], r = ot[64];
        const float viA = vb[t * 64 + rA], viB = vb[t * 64 + rB];
        const int tn = t < 15 ? t + 1 : 15;
        const float4 mm = o4[tn * 80 + 48];
        f2v svA = A0 * lo2(nn) + A1 * hi2(nn);
        f2v svB = B0 * lo2(nn) + B1 * hi2(nn);
        float saA = svA.x + svA.y, saB = svB.x + svB.y;
        saA += dpp_xor1(saA); saB += dpp_xor1(saB);
        saA += dpp_xor2(saA); saB += dpp_xor2(saB);
        saA += dpp_hmirror(saA); saB += dpp_hmirror(saB);
        saA += dpp_rmirror(saA); saB += dpp_rmirror(saB);
        const f2v sA2 = {saA, saA}, vA2 = {viA, viA}, sB2 = {saB, saB}, vB2 = {viB, viB};
        A0 = A0 * lo2(w) + sA2 * lo2(a) + vA2 * lo2(k);
        B0 = B0 * lo2(w) + sB2 * lo2(a) + vB2 * lo2(k);
        A1 = A1 * hi2(w) + sA2 * hi2(a) + vA2 * hi2(k);
        B1 = B1 * hi2(w) + sB2 * hi2(a) + vB2 * hi2(k);
        f2v yvA = A0 * lo2(r) + A1 * hi2(r);
        f2v yvB = B0 * lo2(r) + B1 * hi2(r);
        yb[(t * 64 + rA) * 16 + jo] = yvA.x + yvA.y;
        yb[(t * 64 + rB) * 16 + jo] = yvB.x + yvB.y;
        nn = mm;
      }
    }
    __syncthreads();
#pragma unroll
    for (int it = 0; it < 2; it++) {
      int idx = it * NT + tid;
      int t = idx >> 6, i = idx & 63;
      int row, tau, len;
      step_row(chunk * 16 + t, d, b, row, tau, len);
      size_t off = (size_t)row * 1024 + h * 64 + i;
      bf16* yd = dry ? (bf16*)(ws + B_END) + (off & 0x3fffff) : ED + off;
      const float4* yp = (const float4*)(yb + (t * 64 + i) * 16);
      const float4 ya = yp[0], yc = yp[1], ye = yp[2], yg = yp[3];
      *yd = f2bf((((ya.x + ya.y) + (ya.z + ya.w)) + ((yc.x + yc.y) + (yc.z + yc.w))) + (((ye.x + ye.y) + (ye.z + ye.w)) + ((yg.x + yg.y) + (yg.z + yg.w))));
    }
  }
}

DEV void s5_scan(int tidv, int bidv, const Params& p, int l, int chain, char* smemw, int dry) {
  char* ws = p.ws;
  const int lane = tidv & 63;
  const int d = chain & 1, g = (chain >> 1) & 63, b = chain >> 7;
  float* ub = (float*)smemw;
  float* hb = ub + 256;
  const size_t pg = (size_t)(l * 2 + d) * 64 + g;
  const float lre = p.in[28][pg * 64 + lane], lim = p.in[29][pg * 64 + lane];
  const float dt = expf(p.in[30][pg]);
  const float mag = expf(lre * dt);
  const float are = mag * cosf(lim * dt), aim = mag * sinf(lim * dt);
  const float den = lre * lre + lim * lim;
  const float qre = ((are - 1.f) * lre + aim * lim) / den;
  const float qim = (aim * lre - (are - 1.f) * lim) / den;
  float bbre[16], bbim[16];
  {
    const float* br = p.in[31] + (pg * 64 + lane) * 16;
    const float* bi = p.in[32] + (pg * 64 + lane) * 16;
#pragma unroll
    for (int i = 0; i < 16; i++) {
      float x = br[i], y = bi[i];
      bbre[i] = qre * x - qim * y;
      bbim[i] = qre * y + qim * x;
    }
  }
  bf16x8 cfr[4];
  {
    const int i = lane & 15, quad = lane >> 4;
    const float* cre = p.in[33] + (pg * 16 + i) * 64;
    const float* cim = p.in[34] + (pg * 16 + i) * 64;
#pragma unroll
    for (int ks = 0; ks < 4; ks++)
#pragma unroll
      for (int j = 0; j < 8; j++) {
        int k = ks * 32 + quad * 8 + j;
        float c = ks < 2 ? cre[k] : -cim[k - 64];
        cfr[ks][j] = (short)f2bf(c);
      }
  }
  float hre = 0.f, him = 0.f;
  const bf16* Z = (const bf16*)(ws + B_ZB);
  const int tt = lane >> 2, i0 = (lane & 3) * 4;
  uint2 unext;
  {
    int row, tau, len;
    step_row(tt, d, b, row, tau, len);
    unext = *(const uint2*)(Z + (size_t)row * NIN + C_U + g * 16 + i0);
  }
  for (int chunk = 0; chunk < 272; chunk++) {
    {
      uint2 u = unext;
      float4 f;
      f.x = bf2f((bf16)(u.x & 0xffff)); f.y = bf2f((bf16)(u.x >> 16));
      f.z = bf2f((bf16)(u.y & 0xffff)); f.w = bf2f((bf16)(u.y >> 16));
      *(float4*)(ub + tt * 16 + i0) = f;
    }
    __syncthreads();
    if (chunk + 1 < 272) {
      int row, tau, len;
      step_row((chunk + 1) * 16 + tt, d, b, row, tau, len);
      unext = *(const uint2*)(Z + (size_t)row * NIN + C_U + g * 16 + i0);
    }
#pragma unroll 2
    for (int t = 0; t < 16; t++) {
      const float* u = ub + t * 16;
      float br0 = 0.f, bi0 = 0.f;
#pragma unroll
      for (int i = 0; i < 16; i++) { float uv = u[i]; br0 += bbre[i] * uv; bi0 += bbim[i] * uv; }
      float nr = are * hre - aim * him + br0;
      float ni = are * him + aim * hre + bi0;
      hre = nr; him = ni;
      hb[t * 132 + lane] = hre;
      hb[t * 132 + 64 + lane] = him;
    }
    __syncthreads();
    {
      f32x4 yacc = {0.f, 0.f, 0.f, 0.f};
      const float* hr = hb + (lane & 15) * 132 + (lane >> 4) * 8;
#pragma unroll
      for (int ks = 0; ks < 4; ks++) {
        float4 x0 = *(const float4*)(hr + ks * 32), x1 = *(const float4*)(hr + ks * 32 + 4);
        union { bf16x8 v; uint32_t u[4]; } af;
        af.u[0] = pack2(x0.x, x0.y); af.u[1] = pack2(x0.z, x0.w);
        af.u[2] = pack2(x1.x, x1.y); af.u[3] = pack2(x1.z, x1.w);
        yacc = __builtin_amdgcn_mfma_f32_16x16x32_bf16(af.v, cfr[ks], yacc, 0, 0, 0);
      }
      const int ii = lane & 15;
#pragma unroll
      for (int r = 0; r < 4; r++) {
        int row, tau, len;
        step_row(chunk * 16 + (lane >> 4) * 4 + r, d, b, row, tau, len);
        bf16* dst = d == 0 ? (bf16*)(ws + B_SY) + (size_t)row * 1024 + g * 16 + ii : (bf16*)(ws + B_ZB) + (size_t)row * NIN + g * 16 + ii;
        if (dry) dst = (bf16*)(ws + B_END) + ((((size_t)row * 1024 + g * 16 + ii)) & 0x3fffff);
        *dst = f2bf(yacc[r]);
      }
    }
    __syncthreads();
  }
}

DEV int perm23(int r) { return (r & 0x13) | ((r & 4) << 1) | ((r & 8) >> 1); }

DEV void attn_item(int tidv, int bidv, const Params& p, int item, bool ctxq, char* smem, int dry) {
  char* ws = p.ws;
  bf16* sK = (bf16*)smem;
  bf16* sV = sK + 64 * 200;
  const int tid = tidv, wave = tid >> 6, lane = tid & 63;
  const int r = lane & 31, hf = lane >> 5;
  int b, hd, qt;
  if (!ctxq) { b = item >> 7; hd = (item >> 4) & 7; qt = item & 15; }
  else { b = item >> 3; hd = item & 7; qt = 0; }
  const int qrow0 = ctxq ? ML + b * 256 : b * 4096 + qt * 256;
  const int kt0 = ctxq ? 64 : 0, kt1 = 68;
  bf16* QB = (bf16*)(ws + B_QB);
  const bf16* KN = (const bf16*)(ws + B_KN);
  const bf16* KR = (const bf16*)(ws + B_KR);
  const bf16* VT = (const bf16*)(ws + B_VT);
  bf16x8 qf[12];
  {
    const bf16* qp = QB + (size_t)(qrow0 + wave * 32 + r) * 1536 + hd * 192 + hf * 8;
#pragma unroll
    for (int kk = 0; kk < 12; kk++) qf[kk] = *(const bf16x8*)(qp + kk * 16);
  }
  f32x16 oacc[4];
#pragma unroll
  for (int i = 0; i < 4; i++)
#pragma unroll
    for (int e = 0; e < 16; e++) oacc[i][e] = 0.f;
  float mrun = -1e30f, lrun = 0.f;
  const int pr = perm23(r);
  const uint32_t vo_n = (uint32_t)((tid >> 4) * 2048 + (tid & 15) * 16);
  const uint32_t lo_n = (uint32_t)((tid >> 4) * 400 + (tid & 15) * 16);
  const uint32_t vo_r = (uint32_t)((tid >> 3) * 128 + (tid & 7) * 16);
  const uint32_t lo_r = (uint32_t)((tid >> 3) * 400 + 256 + (tid & 7) * 16);
  const uint32_t vo_v = (uint32_t)((tid >> 3) * (NKEY * 2) + (tid & 7) * 16);
  const uint32_t lo_v = (uint32_t)((tid >> 3) * 144 + (tid & 7) * 16);
  uint4 t0, t1, t4, u0, u1;
#define ATT_LOAD(KT)                                                                                   \
  {                                                                                                    \
    const int key0_ = (KT) * 64;                                                                       \
    const int rowbase_ = key0_ < 4096 ? b * 4096 + key0_ : ML + b * 256 + (key0_ - 4096);               \
    const char* bk = (const char*)(KN + (size_t)rowbase_ * 1024 + hd * 128);                           \
    const char* br = (const char*)(KR + (size_t)rowbase_ * 64);                                        \
    const char* bv = (const char*)(VT + ((size_t)((b * 8 + hd) * 128)) * NKEY + key0_);                \
    t0 = *(const uint4*)(bk + vo_n);                                                                   \
    t1 = *(const uint4*)(bk + 32 * 2048 + vo_n);                                                       \
    t4 = *(const uint4*)(br + vo_r);                                                                   \
    u0 = *(const uint4*)(bv + vo_v);                                                                   \
    u1 = *(const uint4*)(bv + (size_t)64 * NKEY * 2 + vo_v);                                           \
  }
  ATT_LOAD(kt0)
  for (int kt = kt0; kt < kt1; kt++) {
    __syncthreads();
    *(uint4*)((char*)sK + lo_n) = t0;
    *(uint4*)((char*)sK + 32 * 400 + lo_n) = t1;
    *(uint4*)((char*)sK + lo_r) = t4;
    *(uint4*)((char*)sV + lo_v) = u0;
    *(uint4*)((char*)sV + 64 * 144 + lo_v) = u1;
    __syncthreads();
    ATT_LOAD((kt + 1 < kt1 ? kt + 1 : kt1 - 1))
    f32x16 sacc[2];
#pragma unroll
    for (int m = 0; m < 2; m++) {
#pragma unroll
      for (int e = 0; e < 16; e++) sacc[m][e] = 0.f;
      const bf16* kp = sK + (m * 32 + pr) * 200 + hf * 8;
#pragma unroll
      for (int kk = 0; kk < 12; kk++) {
        bf16x8 kf = *(const bf16x8*)(kp + kk * 16);
        sacc[m] = __builtin_amdgcn_mfma_f32_32x32x16_bf16(kf, qf[kk], sacc[m], 0, 0, 0);
        if ((kk & 3) == 3) __builtin_amdgcn_sched_barrier(0);
      }
      __builtin_amdgcn_sched_barrier(0);
    }
    float tmax = sacc[0][0];
#pragma unroll
    for (int e = 1; e < 16; e++) tmax = fmaxf(tmax, sacc[0][e]);
#pragma unroll
    for (int e = 0; e < 16; e++) tmax = fmaxf(tmax, sacc[1][e]);
    tmax = fmaxf(tmax, __shfl_xor(tmax, 32));
    float mnew = fmaxf(mrun, tmax);
    float alpha = __builtin_amdgcn_exp2f(mrun - mnew);
    mrun = mnew;
    float psum = 0.f;
#pragma unroll
    for (int m = 0; m < 2; m++)
#pragma unroll
      for (int e = 0; e < 16; e++) { float pv = __builtin_amdgcn_exp2f(sacc[m][e] - mnew); sacc[m][e] = pv; psum += pv; }
    lrun = lrun * alpha + psum;
#pragma unroll
    for (int i = 0; i < 4; i++)
#pragma unroll
      for (int e = 0; e < 16; e++) oacc[i][e] *= alpha;
#pragma unroll
    for (int s = 0; s < 4; s++) {
      const int m = s >> 1, s2 = s & 1;
      bf16x8 pf;
#pragma unroll
      for (int j = 0; j < 8; j++) pf[j] = (short)f2bf(sacc[m][8 * s2 + j]);
#pragma unroll
      for (int i = 0; i < 4; i++) {
        bf16x8 vf = *(const bf16x8*)(sV + (i * 32 + r) * 72 + m * 32 + s2 * 16 + hf * 8);
        oacc[i] = __builtin_amdgcn_mfma_f32_32x32x16_bf16(vf, pf, oacc[i], 0, 0, 0);
      }
      __builtin_amdgcn_sched_barrier(0);
    }
  }
#undef ATT_LOAD
  lrun += __shfl_xor(lrun, 32);
  const float inv = 1.f / lrun;
  bf16* op = QB + (size_t)(qrow0 + wave * 32 + r) * 1536 + hd * 192;
  if (dry) op = (bf16*)(ws + B_END) + ((((size_t)(qrow0 + wave * 32 + r) * 1536 + hd * 192)) & 0x3ffff8);
#pragma unroll
  for (int i = 0; i < 4; i++)
#pragma unroll
    for (int g = 0; g < 4; g++) {
      uint2 o;
      o.x = pack2(oacc[i][4 * g] * inv, oacc[i][4 * g + 1] * inv);
      o.y = pack2(oacc[i][4 * g + 2] * inv, oacc[i][4 * g + 3] * inv);
      *(uint2*)(op + 32 * i + 8 * g + 4 * hf) = o;
    }
}

DEV void phase_mixers(int tidv, int bidv, const Params& p, int l, char* smem, int dry) {
  int* s_item = (int*)(smem + SM_ITEM);
#ifdef PROBE_PARTS
  const int parts = dry ? PROBE_PARTS : 7;
#else
  const int parts = 7;
#endif
  for (int task = bidv; task < 192; task += gridDim.x) {
    if (task < 128 && !(parts & 1)) continue;
    if (task >= 128 && !(parts & 2)) continue;
    if (task < 128) rwkv_scan(tidv, bidv, p, l, task, smem, dry);
    else s5_scan(tidv, bidv, p, l, (task - 128) * 8 + (tidv >> 6), smem + (tidv >> 6) * 9472, dry);
  }
  const int nlat = 512, ntot = (parts & 4) ? ((l == 0) ? 544 : 512) : 0;
  int* cnt = (int*)(p.ws + B_CNT) + l + 2 * dry;
#if !defined(MIX_ONLY) || MIX_ONLY == 2
  while (true) {
    __syncthreads();
    if (tidv == 0) *s_item = atomicAdd(cnt, 1);
    __syncthreads();
    int item = *s_item;
    if (item >= ntot) break;
    if (item < nlat) attn_item(tidv, bidv, p, item, false, smem, dry);
    else attn_item(tidv, bidv, p, item - nlat, true, smem, dry);
  }
#endif
}

DEV float gelu_tanh(float x) {
  float u = 0.7978845608028654f * (x + 0.044715f * x * x * x);
  return 0.5f * x * (1.f + tanhf(u));
}

DEV void phase_post(int tidv, int bidv, const Params& p, int l, int M) {
  char* ws = p.ws;
  const bf16* Z = (const bf16*)(ws + B_ZB);
  const int wave = tidv >> 6, lane = tidv & 63;
  const float* cw = p.in[17] + (size_t)l * 3 * 3072;
  const bf16* YF = (const bf16*)(ws + B_HB);
  const bf16* YB = (const bf16*)(ws + B_HB + SZ1K);
  const bf16* AF = (const bf16*)(ws + B_AF);
  const bf16* AB = (const bf16*)(ws + B_AB);
  bf16* GB = (bf16*)(ws + B_GB);
  {
    const int gw = bidv * NW + wave, nwv = gridDim.x * NW;
    const int h = gw & 15, ch = h * 64 + lane;
    const float c_r0 = cw[ch], c_r1 = cw[3072 + ch], c_r2 = cw[6144 + ch];
    const float c_k0 = cw[1024 + ch], c_k1 = cw[3072 + 1024 + ch], c_k2 = cw[6144 + 1024 + ch];
    const float c_v0 = cw[2048 + ch], c_v1 = cw[3072 + 2048 + ch], c_v2 = cw[6144 + 2048 + ch];
    const float lng = p.in[26][l * 1024 + ch], lnb = p.in[27][l * 1024 + ch];
    const float kac = p.in[24][l * 1024 + ch], rkc = p.in[25][l * 1024 + ch];
    for (int row = gw >> 4; row < M; row += (nwv >> 4)) {
      int tau, len;
      if (row < ML) { tau = row & 4095; len = 4096; } else { tau = (row - ML) & 255; len = 256; }
      size_t o = (size_t)row * 1024 + ch;
      float y = bf2f(YF[o]) + bf2f(YB[o]);
      const bf16* z = Z + (size_t)row * NIN + C_R + ch;
      float r1 = bf2f(z[0]), k1 = bf2f(z[1024]), v1 = bf2f(z[2048]);
      float r0 = 0.f, k0 = 0.f, v0 = 0.f, r2 = 0.f, k2 = 0.f, v2 = 0.f;
      if (tau > 0) { const bf16* zm = z - NIN; r0 = bf2f(zm[0]); k0 = bf2f(zm[1024]); v0 = bf2f(zm[2048]); }
      if (tau < len - 1) { const bf16* zp = z + NIN; r2 = bf2f(zp[0]); k2 = bf2f(zp[1024]); v2 = bf2f(zp[2048]); }
      float am = 0.5f * (bf2f(AF[o]) + bf2f(AB[o]));
      float gate = bf2f(GB[o]);
      float mu = wsum_fast(y) * (1.f / 64.f);
      float dv = y - mu;
      float var = wsum_fast(dv * dv) * (1.f / 64.f);
      float yn = dv * rsqrtf(var + 64e-5f) * lng + lnb;
      float rr = c_r0 * r0 + c_r1 * r1 + c_r2 * r2;
      float kk = c_k0 * k0 + c_k1 * k1 + c_k2 * k2;
      float vv = c_v0 * v0 + c_v1 * v1 + c_v2 * v2;
      float kbon = kk * (1.f + (am - 1.f) * kac);
      float s = wsum_fast(rr * kbon * rkc);
      GB[o] = f2bf((yn + s * vv) * gate);
    }
  }
  bf16* SY = (bf16*)(ws + B_SY);
  const float* dsk = p.in[35] + l * 1024;
  const int n4 = M * 256;
  for (int i = bidv * NT + tidv; i < n4; i += gridDim.x * NT) {
    int row = i >> 8, c = (i & 255) * 4;
    uint2 a = *(const uint2*)(SY + (size_t)row * 1024 + c);
    uint2 bq = *(const uint2*)(Z + (size_t)row * NIN + c);
    uint2 u = *(const uint2*)(Z + (size_t)row * NIN + C_U + c);
    float4 dd = *(const float4*)(dsk + c);
    float y0 = bf2f((bf16)(a.x & 0xffff)) + bf2f((bf16)(bq.x & 0xffff)) + dd.x * bf2f((bf16)(u.x & 0xffff));
    float y1 = bf2f((bf16)(a.x >> 16)) + bf2f((bf16)(bq.x >> 16)) + dd.y * bf2f((bf16)(u.x >> 16));
    float y2 = bf2f((bf16)(a.y & 0xffff)) + bf2f((bf16)(bq.y & 0xffff)) + dd.z * bf2f((bf16)(u.y & 0xffff));
    float y3 = bf2f((bf16)(a.y >> 16)) + bf2f((bf16)(bq.y >> 16)) + dd.w * bf2f((bf16)(u.y >> 16));
    uint2 o;
    o.x = pack2(gelu_tanh(y0), gelu_tanh(y1));
    o.y = pack2(gelu_tanh(y2), gelu_tanh(y3));
    *(uint2*)(SY + (size_t)row * 1024 + c) = o;
  }
}

constexpr int NPH = 25;

DEV void run_phase(int tidv, int bidv, const Params& p, int ph, char* smem, int dry) {
  char* ws = p.ws;
#ifndef ONLY_S
  if (ph == 0) {
    if (bidv == 0 && tidv < 4) ((int*)(ws + B_CNT))[tidv] = 0;
    phase_mod(tidv, bidv, p, smem);
    phase_convw(tidv, bidv, p, 0, smem);
    return;
  }
#endif
  const int l = (ph - 1) / 12, s = (ph - 1) % 12;
#ifdef ONLY_S
  if (s != ONLY_S) return;
#endif
  const bf16* wb = (const bf16*)(ws + B_WB);
  const float* mod = (const float*)(ws + B_MOD) + (size_t)l * 5 * 12288;
  float* XC = (float*)(ws + B_XC);
  const float* xin_lat = l == 0 ? p.in[0] : p.out;
  const float* xin_ctx = l == 0 ? p.in[2] : XC;
  bf16* HB = (bf16*)(ws + B_HB);
  bf16* Z = (bf16*)(ws + B_ZB);
  bf16* H2 = (bf16*)(ws + B_KN);
  const int Mpost = l == 0 ? MT : ML;
  switch (s) {
    case 0:
      if (l == 1) phase_convw(tidv, bidv, p, 1, smem);
      phase_norm(tidv, bidv, xin_lat, xin_ctx, p.in[6] + l * 2048, mod, 0, 2048, HB, MT);
      break;
    case 1:
      run_gemm<G_IN>(tidv, bidv, p, l, smem, HB, 2048, wb + OW_IN, 2048, NIN, MT, 0, nullptr, nullptr, nullptr, nullptr);
      break;
    case 2:
#if !defined(PH2_ONLY) || PH2_ONLY == 0
      run_gemm<G_UKV>(tidv, bidv, p, l, smem, Z + C_CKV, NIN, wb + OW_UKV, 512, 2048, MT, 0, nullptr, nullptr, nullptr, nullptr);
#endif
#if !defined(PH2_ONLY) || PH2_ONLY == 1
      run_gemm<G_UQ>(tidv, bidv, p, l, smem, Z + C_CQ, NIN, wb + OW_UQ, 512, 1536, MT, 0, nullptr, nullptr, nullptr, nullptr, 224);
#endif
#if !defined(PH2_ONLY) || PH2_ONLY == 2
      run_gemm<G_G2>(tidv, bidv, p, l, smem, Z + C_GD, NIN, wb + OW_G2, 192, 1024, MT, 0, nullptr, nullptr, nullptr, nullptr, 72);
#endif
#if !defined(PH2_ONLY) || PH2_ONLY == 3
      for (int d = 0; d < 2; d++) {
        run_gemm<G_W2>(tidv, bidv, p, l, smem, Z + C_WD + 64 * d, NIN, wb + OW_W2 + (size_t)d * 65536, 64, 1024, MT, d, nullptr, nullptr, nullptr, nullptr, 56 - 32 * d);
        run_gemm<G_A2>(tidv, bidv, p, l, smem, Z + C_AD + 64 * d, NIN, wb + OW_A2 + (size_t)d * 65536, 64, 1024, MT, d, nullptr, nullptr, nullptr, nullptr, 40 - 32 * d);
      }
#endif
      break;
    case 3: phase_mla_post(tidv, bidv, p, l); break;
    case 4: phase_mixers(tidv, bidv, p, l, smem, dry); break;
    case 5: phase_post(tidv, bidv, p, l, Mpost); break;
    case 6:
      run_gemm<G_GLU>(tidv, bidv, p, l, smem, (const bf16*)(ws + B_SY), 1024, wb + OW_GLU, 1024, 1024, Mpost, 0, nullptr, nullptr, nullptr, nullptr);
      break;
    case 7:
      run_gemm<G_MG0>(tidv, bidv, p, l, smem, (const bf16*)(ws + B_QB), 1536, wb + OW_BR, 1024, 2048, Mpost, 0, nullptr, nullptr, nullptr, nullptr);
      run_gemm<G_MG1>(tidv, bidv, p, l, smem, (const bf16*)(ws + B_GB), 1024, wb + OW_BR + (size_t)2048 * 1024, 1024, 2048, Mpost, 0, nullptr, nullptr, nullptr, nullptr);
      run_gemm<G_MG2>(tidv, bidv, p, l, smem, Z, NIN, wb + OW_BR + (size_t)2 * 2048 * 1024, 1024, 2048, Mpost, 0, nullptr, nullptr, nullptr, nullptr);
      break;
    case 8:
      run_gemm<G_OUT>(tidv, bidv, p, l, smem, HB, 2048, wb + OW_OUT, 2048, 2048, Mpost, 0, xin_lat, xin_ctx, p.out, XC);
      break;
    case 9:
      phase_norm(tidv, bidv, p.out, XC, p.in[7] + l * 2048, mod, 6144, 8192, H2, Mpost);
      break;
    case 10:
      run_gemm<G_M1>(tidv, bidv, p, l, smem, H2, 2048, wb + OW_M1, 2048, 8192, Mpost, 0, nullptr, nullptr, nullptr, nullptr);
      break;
    case 11:
      run_gemm<G_M2>(tidv, bidv, p, l, smem, Z, 8192, wb + OW_M2, 8192, 2048, Mpost, 0, nullptr, nullptr, p.out, XC);
      break;
  }
}

DEV void grid_barrier(unsigned* cnt, unsigned target) {
  asm volatile("s_waitcnt vmcnt(0)" ::: "memory");
  __syncthreads();
  if (threadIdx.x == 0) {
    __builtin_amdgcn_fence(__ATOMIC_RELEASE, "agent");
    asm volatile("s_waitcnt vmcnt(0)" ::: "memory");
    __hip_atomic_fetch_add(cnt, 1u, __ATOMIC_RELAXED, __HIP_MEMORY_SCOPE_AGENT);
    unsigned spins = 0;
    while (__hip_atomic_load(cnt, __ATOMIC_RELAXED, __HIP_MEMORY_SCOPE_AGENT) < target) {
      __builtin_amdgcn_s_sleep(1);
      if (++spins > (1u << 21)) break;
    }
    __builtin_amdgcn_fence(__ATOMIC_ACQUIRE, "agent");
    asm volatile("s_waitcnt vmcnt(0)" ::: "memory");
  }
  __syncthreads();
}

__global__ void __launch_bounds__(NT) fwd_megakernel(Params p, int ph0, int ph1, int dryflag) {
  extern __shared__ __attribute__((aligned(16))) char smem[];
  for (int ph = ph0; ph < ph1; ph++) {
    int tidv = threadIdx.x, bidv = blockIdx.x;
    asm volatile("" : "+v"(tidv));
    asm volatile("" : "+s"(bidv));
#ifdef PROBE_MASK
    if (dryflag && ((ph == 0 && (PROBE_MASK & 0x1000)) || (ph > 0 && ((PROBE_MASK >> ((ph - 1) % 12)) & 1)))) {
      run_phase(tidv, bidv, p, ph, smem, dryflag);
      cg::this_grid().sync();
    }
#endif
    run_phase(tidv, bidv, p, ph, smem, 0);
    if (ph + 1 < ph1) {
      if (ph == ph0) cg::this_grid().sync();
      else grid_barrier((unsigned*)(p.ws + B_FLG), (unsigned)(ph - ph0) * gridDim.x);
    }
  }
}

extern "C" void kernel_launch(void* const* d_in, const int* in_sizes, int n_in, void* d_out, int out_size, void* d_ws, size_t ws_size,
                              hipStream_t stream) {
  static int grid_blocks = 0;
  if (!grid_blocks) {
    int dev = 0, cus = 0, per_cu = 0;
    (void)hipGetDevice(&dev);
    (void)hipDeviceGetAttribute(&cus, hipDeviceAttributeMultiprocessorCount, dev);
    if (hipFuncSetAttribute((const void*)fwd_megakernel, hipFuncAttributeMaxDynamicSharedMemorySize, LDS_BYTES) != hipSuccess) {
      fprintf(stderr, "hipFuncSetAttribute(%d B dynamic LDS) failed\n", LDS_BYTES);
      return;
    }
    if (hipOccupancyMaxActiveBlocksPerMultiprocessor(&per_cu, (const void*)fwd_megakernel, NT, LDS_BYTES) != hipSuccess || per_cu < 1) {
      fprintf(stderr, "occupancy query failed / kernel not resident\n");
      return;
    }
    grid_blocks = cus;
  }
  Params p{};
  for (int i = 0; i < 42; i++) p.in[i] = (const float*)d_in[i];
  p.out = (float*)d_out;
  p.ws = (char*)d_ws;
  if (ws_size < B_END + (8u << 20)) { fprintf(stderr, "workspace too small\n"); return; }
  int ph0 = 0, ph1 = NPH;
  int dryflag = 1;
  void* args[] = {&p, &ph0, &ph1, &dryflag};
  (void)hipMemsetAsync((char*)d_ws + B_FLG, 0, 4096, stream);
  hipError_t e = hipLaunchCooperativeKernel((void*)fwd_megakernel, dim3(grid_blocks), dim3(NT), args, LDS_BYTES, stream);
  if (e != hipSuccess) fprintf(stderr, "cooperative launch failed: %s (grid %d)\n", hipGetErrorString(e), grid_blocks);
}
```

```cpp
#include <hip/hip_runtime.h>
#include <hip/hip_cooperative_groups.h>
#include <stdint.h>
#include <cstdio>
namespace cg = cooperative_groups;

#ifndef MULTI_LAUNCH
#define MULTI_LAUNCH 0
#endif

typedef unsigned short bf16;
using bf16x8 = __attribute__((ext_vector_type(8))) short;
using f32x4 = __attribute__((ext_vector_type(4))) float;
using f32x16 = __attribute__((ext_vector_type(16))) float;

#define DEV __device__ __forceinline__
constexpr int NT = 512, NW = 8;

constexpr int DM = 2048, ML = 16384, MC = 1024, MT = 17408, NIN = 11744, DFF = 8192, NKEY = 4352;
constexpr int C_CQ = 0, C_CKV = 512, C_KR = 1024, C_R = 1088, C_WD = 4160, C_AD = 4288, C_GD = 4416, C_U = 4576, C_GATE = 5600;

constexpr size_t OW_IN = 0;
constexpr size_t OW_UQ = OW_IN + (size_t)NIN * 2048;
constexpr size_t OW_UKV = OW_UQ + 1536 * 512;
constexpr size_t OW_W2 = OW_UKV + 2048 * 512;
constexpr size_t OW_A2 = OW_W2 + 2 * 1024 * 64;
constexpr size_t OW_G2 = OW_A2 + 2 * 1024 * 64;
constexpr size_t OW_GLU = OW_G2 + 1024 * 192;
constexpr size_t OW_BR = OW_GLU + 1024 * 1024;
constexpr size_t OW_OUT = OW_BR + (size_t)3 * 2048 * 1024;
constexpr size_t OW_M1 = OW_OUT + (size_t)2048 * 2048;
constexpr size_t OW_M2 = OW_M1 + (size_t)8192 * 2048;
constexpr size_t OW_END = OW_M2 + (size_t)8192 * 2048;

constexpr size_t SZ1K = (size_t)MT * 1024 * 2;
constexpr size_t B_WB = 0;
constexpr size_t B_HB = B_WB + OW_END * 2;
constexpr size_t B_ZB = B_HB + (size_t)MT * 2048 * 2;
constexpr size_t B_QB = B_ZB + (size_t)MT * NIN * 2;
constexpr size_t B_KN = B_QB + (size_t)MT * 1536 * 2;
constexpr size_t B_VT = B_KN + SZ1K;
constexpr size_t B_KR = B_VT + SZ1K;
constexpr size_t B_AF = B_KR + (size_t)MT * 64 * 2;
constexpr size_t B_AB = B_AF + SZ1K;
constexpr size_t B_GB = B_AB + SZ1K;
constexpr size_t B_SY = B_GB + SZ1K;
constexpr size_t B_XC = B_SY + SZ1K;
constexpr size_t B_MOD = B_XC + (size_t)MC * 2048 * 4;
constexpr size_t B_CNT = B_MOD + (size_t)2 * 5 * 12288 * 4;
constexpr size_t B_FLG = B_CNT + 256;
constexpr size_t B_END = B_FLG + 4096;

struct Params {
  const float* in[42];
  float* out;
  char* ws;
};

typedef __attribute__((ext_vector_type(2))) __bf16 hbf2;
DEV bf16 f2bf(float f) {
  __bf16 h = (__bf16)f;
  return *(unsigned short*)&h;
}
DEV float bf2f(bf16 h) { return __uint_as_float(((uint32_t)h) << 16); }
DEV uint32_t pack2(float a, float b) {
  hbf2 v;
  v[0] = (__bf16)a;
  v[1] = (__bf16)b;
  return *(uint32_t*)&v;
}
DEV float wsum(float v) {
#pragma unroll
  for (int o = 32; o > 0; o >>= 1) v += __shfl_xor(v, o);
  return v;
}
DEV float dpp_xor1(float v) {
  int i = __float_as_int(v);
  return __int_as_float(__builtin_amdgcn_update_dpp(0, i, 0xB1, 0xF, 0xF, true));
}
DEV float dpp_xor2(float v) {
  int i = __float_as_int(v);
  return __int_as_float(__builtin_amdgcn_update_dpp(0, i, 0x4E, 0xF, 0xF, true));
}
DEV float dpp_rmirror(float v) {
  int i = __float_as_int(v);
  return __int_as_float(__builtin_amdgcn_update_dpp(0, i, 0x140, 0xF, 0xF, true));
}
DEV float dpp_hmirror0(float v) {
  int i = __float_as_int(v);
  return __int_as_float(__builtin_amdgcn_update_dpp(0, i, 0x141, 0xF, 0xF, true));
}
DEV float wsum_fast(float v) {
  v += dpp_xor1(v);
  v += dpp_xor2(v);
  v += dpp_hmirror0(v);
  v += dpp_rmirror(v);
  v += __shfl_xor(v, 16);
  v += __shfl_xor(v, 32);
  return v;
}
DEV float sigmoidf_(float x) { return __builtin_amdgcn_rcpf(1.f + __expf(-x)); }

DEV void phase_mod(int tidv, int bidv, const Params& p, char* smem) {
  float* s_in = (float*)smem;
  float* red = s_in + 5 * 2048;
  float* mod = (float*)(p.ws + B_MOD);
  for (int i = tidv; i < 5 * 2048; i += NT) {
    int r = i >> 11, k = i & 2047;
    float v = r < 4 ? p.in[1][r * 2048 + k] : p.in[3][k];
    s_in[i] = v / (1.f + expf(-v));
  }
  __syncthreads();
  int kg = tidv >> 6, c = tidv & 63;
  for (int task = bidv; task < 2 * 192; task += gridDim.x) {
    int l = task / 192, n = (task % 192) * 64 + c;
    const float* w = p.in[4] + (size_t)l * 2048 * 12288 + n;
    float a0 = 0, a1 = 0, a2 = 0, a3 = 0, a4 = 0;
    int kb = kg * 256;
#pragma unroll 8
    for (int k = 0; k < 256; k++) {
      float wv = w[(size_t)(kb + k) * 12288];
      a0 += s_in[kb + k] * wv;
      a1 += s_in[2048 + kb + k] * wv;
      a2 += s_in[4096 + kb + k] * wv;
      a3 += s_in[6144 + kb + k] * wv;
      a4 += s_in[8192 + kb + k] * wv;
    }
    red[(kg * 5 + 0) * 64 + c] = a0;
    red[(kg * 5 + 1) * 64 + c] = a1;
    red[(kg * 5 + 2) * 64 + c] = a2;
    red[(kg * 5 + 3) * 64 + c] = a3;
    red[(kg * 5 + 4) * 64 + c] = a4;
    __syncthreads();
    if (kg == 0) {
      float bias = p.in[5][l * 12288 + n];
#pragma unroll
      for (int r = 0; r < 5; r++) {
        float v = 0.f;
#pragma unroll
        for (int g = 0; g < 8; g++) v += red[(g * 5 + r) * 64 + c];
        mod[(size_t)(l * 5 + r) * 12288 + n] = v + bias;
      }
    }
    __syncthreads();
  }
}

DEV void convT(int tidv, int bidv, const float* __restrict__ src, bf16* __restrict__ dst, int K, int N, const float* __restrict__ gain, char* smem, int dK = 0) {
  if (dK == 0) dK = K;
  float* t = (float*)smem;
  const int tk = (K + 63) >> 6, tn = (N + 63) >> 6, ntile = tk * tn;
  const int kk = tidv >> 4, n4 = (tidv & 15) * 4;
  float4 c0 = {0.f, 0.f, 0.f, 0.f}, c1 = {0.f, 0.f, 0.f, 0.f};
#define CV_LOAD(TILE)                                                                      \
  {                                                                                        \
    const int k0_ = ((TILE) / tn) * 64, n0_ = ((TILE) % tn) * 64;                          \
    c0 = float4{0.f, 0.f, 0.f, 0.f}; c1 = c0;                                              \
    if (n0_ + n4 < N) {                                                                    \
      if (k0_ + kk < K) { c0 = *(const float4*)(src + (size_t)(k0_ + kk) * N + n0_ + n4);  \
        if (gain) { float g = gain[k0_ + kk]; c0.x *= g; c0.y *= g; c0.z *= g; c0.w *= g; } }          \
      if (k0_ + kk + 32 < K) { c1 = *(const float4*)(src + (size_t)(k0_ + kk + 32) * N + n0_ + n4);    \
        if (gain) { float g = gain[k0_ + kk + 32]; c1.x *= g; c1.y *= g; c1.z *= g; c1.w *= g; } }     \
    }                                                                                      \
  }
  if (bidv < ntile) CV_LOAD(bidv)
  for (int tile = bidv; tile < ntile; tile += gridDim.x) {
    int k0 = (tile / tn) * 64, n0 = (tile % tn) * 64;
    __syncthreads();
    t[kk * 65 + n4 + 0] = c0.x; t[kk * 65 + n4 + 1] = c0.y; t[kk * 65 + n4 + 2] = c0.z; t[kk * 65 + n4 + 3] = c0.w;
    t[(kk + 32) * 65 + n4 + 0] = c1.x; t[(kk + 32) * 65 + n4 + 1] = c1.y; t[(kk + 32) * 65 + n4 + 2] = c1.z; t[(kk + 32) * 65 + n4 + 3] = c1.w;
    __syncthreads();
    if (tile + (int)gridDim.x < ntile) CV_LOAD(tile + (int)gridDim.x)
    {
      int c = tidv;
      int nn = c >> 3, kc = c & 7;
      if (n0 + nn < N && k0 + kc * 8 < dK) {
        uint4 o;
        o.x = pack2(t[(kc * 8 + 0) * 65 + nn], t[(kc * 8 + 1) * 65 + nn]);
        o.y = pack2(t[(kc * 8 + 2) * 65 + nn], t[(kc * 8 + 3) * 65 + nn]);
        o.z = pack2(t[(kc * 8 + 4) * 65 + nn], t[(kc * 8 + 5) * 65 + nn]);
        o.w = pack2(t[(kc * 8 + 6) * 65 + nn], t[(kc * 8 + 7) * 65 + nn]);
        *(uint4*)(dst + (size_t)(n0 + nn) * dK + k0 + kc * 8) = o;
      }
    }
  }
#undef CV_LOAD
}

DEV void phase_convw(int tidv, int bidv, const Params& p, int l, char* smem) {
  bf16* wb = (bf16*)(p.ws + B_WB);
  convT(tidv, bidv, p.in[8] + (size_t)l * 2048 * NIN, wb + OW_IN, 2048, NIN, nullptr, smem);
  convT(tidv, bidv, p.in[40] + (size_t)l * 2048 * 8192, wb + OW_M1, 2048, 8192, nullptr, smem);
  convT(tidv, bidv, p.in[41] + (size_t)l * 8192 * 2048, wb + OW_M2, 8192, 2048, nullptr, smem);
  for (int n = 0; n < 3; n++)
    convT(tidv, bidv, p.in[38] + (size_t)(l * 3 + n) * 1024 * 2048, wb + OW_BR + (size_t)n * 2048 * 1024, 1024, 2048, nullptr, smem);
  convT(tidv, bidv, p.in[39] + (size_t)l * 2048 * 2048, wb + OW_OUT, 2048, 2048, nullptr, smem);
  convT(tidv, bidv, p.in[11] + (size_t)l * 512 * 1536, wb + OW_UQ, 512, 1536, p.in[9] + l * 512, smem);
  convT(tidv, bidv, p.in[12] + (size_t)l * 512 * 2048, wb + OW_UKV, 512, 2048, p.in[10] + l * 512, smem);
  convT(tidv, bidv, p.in[36] + (size_t)l * 1024 * 1024, wb + OW_GLU, 1024, 1024, nullptr, smem);
  for (int d = 0; d < 2; d++) {
    convT(tidv, bidv, p.in[19] + (size_t)(l * 2 + d) * 64 * 1024, wb + OW_W2 + (size_t)d * 65536, 64, 1024, nullptr, smem);
    convT(tidv, bidv, p.in[21] + (size_t)(l * 2 + d) * 64 * 1024, wb + OW_A2 + (size_t)d * 65536, 64, 1024, nullptr, smem);
  }
  convT(tidv, bidv, p.in[22] + (size_t)l * 160 * 1024, wb + OW_G2, 160, 1024, nullptr, smem, 192);
}

DEV void phase_norm(int tidv, int bidv, const float* xlat, const float* xctx, const float* g, const float* mod, int shOff, int scOff, bf16* H, int nrows) {
  int wave = tidv >> 6, lane = tidv & 63;
  for (int row = bidv * NW + wave; row < nrows; row += gridDim.x * NW) {
    const float* x = row < ML ? xlat + (size_t)row * 2048 : xctx + (size_t)(row - ML) * 2048;
    int b = row < ML ? (row >> 12) : 4;
    const float* sh = mod + b * 12288 + shOff;
    const float* sc = mod + b * 12288 + scOff;
    float4 v[8];
    float ss = 0.f;
#pragma unroll
    for (int i = 0; i < 8; i++) {
      v[i] = *(const float4*)(x + i * 256 + lane * 4);
      ss += v[i].x * v[i].x + v[i].y * v[i].y + v[i].z * v[i].z + v[i].w * v[i].w;
    }
    ss = wsum_fast(ss);
    float rinv = rsqrtf(ss * (1.f / 2048.f) + 1e-6f);
#pragma unroll
    for (int i = 0; i < 8; i++) {
      int c = i * 256 + lane * 4;
      float4 g4 = *(const float4*)(g + c), s4 = *(const float4*)(sc + c), h4 = *(const float4*)(sh + c);
      float y0 = v[i].x * rinv * g4.x * (1.f + s4.x) + h4.x;
      float y1 = v[i].y * rinv * g4.y * (1.f + s4.y) + h4.y;
      float y2 = v[i].z * rinv * g4.z * (1.f + s4.z) + h4.z;
      float y3 = v[i].w * rinv * g4.w * (1.f + s4.w) + h4.w;
      uint2 o;
      o.x = pack2(y0, y1);
      o.y = pack2(y2, y3);
      *(uint2*)(H + (size_t)row * 2048 + c) = o;
    }
  }
}

constexpr int LDT = 72;
constexpr int GA_BYTES = 256 * LDT * 2;
constexpr int GSTAGE = 512 * LDT * 2;
constexpr int SM_RINV = 2 * GSTAGE;
constexpr int SM_ITEM = SM_RINV + 1024;
constexpr int LDS_BYTES = SM_ITEM + 16;
DEV float sumsq8(uint4 r) {
  float s = 0.f, x;
  x = bf2f((bf16)(r.x & 0xffff)); s += x * x; x = bf2f((bf16)(r.x >> 16)); s += x * x;
  x = bf2f((bf16)(r.y & 0xffff)); s += x * x; x = bf2f((bf16)(r.y >> 16)); s += x * x;
  x = bf2f((bf16)(r.z & 0xffff)); s += x * x; x = bf2f((bf16)(r.z >> 16)); s += x * x;
  x = bf2f((bf16)(r.w & 0xffff)); s += x * x; x = bf2f((bf16)(r.w >> 16)); s += x * x;
  return s;
}

template <bool ROWNORM>
DEV void gemm_mainloop(int tidv, int bidv, const bf16* __restrict__ A, int lda, bool amap, const bf16* __restrict__ Bt, int K, int N, int m0, int n0,
                       char* smem, f32x16 (&acc)[4][2]) {
  float* srinv = (float*)(smem + SM_RINV);
  const int tid = tidv, lane = tid & 63, wave = tid >> 6;
  const int wm = wave >> 2, wn = wave & 3;
  const int lr = tid >> 3, kc = tid & 7;
  const char* abase = (const char*)(A + (size_t)m0 * lda);
  const char* bbase = (const char*)(Bt + (size_t)n0 * K);
  const uint32_t voa = (uint32_t)(lr * lda + kc * 8) * 2u;
  const uint32_t astep = (uint32_t)(64 * lda) * 2u;
  const uint32_t vob0 = (uint32_t)(lr * K + kc * 8) * 2u;
  const uint32_t bstep = (uint32_t)(64 * K) * 2u;
  const uint32_t lds_st = (uint32_t)(lr * LDT + kc * 8) * 2u;
  const int nk = K >> 6;
  uint4 xa0, xa1, xa2, xa3, xb0, xb1, xb2, xb3;
#define G_LOAD(KT)                                                         \
  {                                                                        \
    const int k0_ = (KT) << 6;                                             \
    const int ka_ = amap ? ((k0_ >> 7) * 192 + (k0_ & 127)) : k0_;         \
    xa0 = *(const uint4*)(abase + (size_t)ka_ * 2 + voa);                  \
    xa1 = *(const uint4*)(abase + (size_t)ka_ * 2 + astep + voa);          \
    xa2 = *(const uint4*)(abase + (size_t)ka_ * 2 + 2 * astep + voa);      \
    xa3 = *(const uint4*)(abase + (size_t)ka_ * 2 + 3 * astep + voa);      \
    xb0 = *(const uint4*)(bbase + (size_t)k0_ * 2 + vob0);                 \
    xb1 = *(const uint4*)(bbase + (size_t)k0_ * 2 + bstep + vob0);         \
    xb2 = *(const uint4*)(bbase + (size_t)k0_ * 2 + 2 * bstep + vob0);     \
    xb3 = *(const uint4*)(bbase + (size_t)k0_ * 2 + 3 * bstep + vob0);     \
  }
#define G_STORE(SN)                                                  \
  *(uint4*)((SN) + lds_st) = xa0;                                    \
  *(uint4*)((SN) + 1 * (64 * LDT * 2) + lds_st) = xa1;               \
  *(uint4*)((SN) + 2 * (64 * LDT * 2) + lds_st) = xa2;               \
  *(uint4*)((SN) + 3 * (64 * LDT * 2) + lds_st) = xa3;               \
  *(uint4*)((SN) + GA_BYTES + lds_st) = xb0;                         \
  *(uint4*)((SN) + GA_BYTES + 1 * (64 * LDT * 2) + lds_st) = xb1;    \
  *(uint4*)((SN) + GA_BYTES + 2 * (64 * LDT * 2) + lds_st) = xb2;    \
  *(uint4*)((SN) + GA_BYTES + 3 * (64 * LDT * 2) + lds_st) = xb3;
  const uint32_t fa = (uint32_t)((wm * 128 + (lane & 31)) * LDT + (lane >> 5) * 8) * 2u;
  const uint32_t fb = (uint32_t)GA_BYTES + (uint32_t)((wn * 64 + (lane & 31)) * LDT + (lane >> 5) * 8) * 2u;
  const int nkm = nk - 1;
  if (ROWNORM) {
    __syncthreads();
#pragma unroll 1
    for (int i = 0; i < 4; i++) {
      float ss = 0.f;
      for (int kk = 0; kk < nk; kk++) ss += sumsq8(*(const uint4*)(abase + (size_t)kk * 128 + i * astep + voa));
      ss += __shfl_xor(ss, 1); ss += __shfl_xor(ss, 2); ss += __shfl_xor(ss, 4);
      if (kc == 0) srinv[lr + 64 * i] = rsqrtf(ss / (float)K + 1e-6f);
    }
  }
  G_LOAD(0)
  __syncthreads();
  G_STORE(smem)
  G_LOAD((1 < nkm ? 1 : nkm))
  __syncthreads();
#define G_FRAG(P, ST, KS)                                                            \
  P##a0 = *(const bf16x8*)((ST) + fa + 0 * (32 * LDT * 2) + (KS) * 32);                \
  P##a1 = *(const bf16x8*)((ST) + fa + 1 * (32 * LDT * 2) + (KS) * 32);                \
  P##a2 = *(const bf16x8*)((ST) + fa + 2 * (32 * LDT * 2) + (KS) * 32);                \
  P##a3 = *(const bf16x8*)((ST) + fa + 3 * (32 * LDT * 2) + (KS) * 32);                \
  P##b0 = *(const bf16x8*)((ST) + fb + 0 * (32 * LDT * 2) + (KS) * 32);                \
  P##b1 = *(const bf16x8*)((ST) + fb + 1 * (32 * LDT * 2) + (KS) * 32);
#define G_MMA(P)                                                                              \
  acc[0][0] = __builtin_amdgcn_mfma_f32_32x32x16_bf16(P##b0, P##a0, acc[0][0], 0, 0, 0);      \
  acc[0][1] = __builtin_amdgcn_mfma_f32_32x32x16_bf16(P##b1, P##a0, acc[0][1], 0, 0, 0);      \
  acc[1][0] = __builtin_amdgcn_mfma_f32_32x32x16_bf16(P##b0, P##a1, acc[1][0], 0, 0, 0);      \
  acc[1][1] = __builtin_amdgcn_mfma_f32_32x32x16_bf16(P##b1, P##a1, acc[1][1], 0, 0, 0);      \
  acc[2][0] = __builtin_amdgcn_mfma_f32_32x32x16_bf16(P##b0, P##a2, acc[2][0], 0, 0, 0);      \
  acc[2][1] = __builtin_amdgcn_mfma_f32_32x32x16_bf16(P##b1, P##a2, acc[2][1], 0, 0, 0);      \
  acc[3][0] = __builtin_amdgcn_mfma_f32_32x32x16_bf16(P##b0, P##a3, acc[3][0], 0, 0, 0);      \
  acc[3][1] = __builtin_amdgcn_mfma_f32_32x32x16_bf16(P##b1, P##a3, acc[3][1], 0, 0, 0);
  bf16x8 pa0, pa1, pa2, pa3, pb0, pb1, qa0, qa1, qa2, qa3, qb0, qb1;
#pragma unroll 1
  for (int kt = 0; kt < nk; kt++) {
    const char* st = smem + (kt & 1) * GSTAGE;
    char* sn = smem + ((kt + 1) & 1) * GSTAGE;
    if (!ROWNORM) {
      G_FRAG(p, st, 0)
      G_FRAG(q, st, 1)
      __builtin_amdgcn_sched_barrier(0);
      G_MMA(p)
      __builtin_amdgcn_sched_barrier(0);
      G_FRAG(p, st, 2)
      __builtin_amdgcn_sched_barrier(0);
      G_MMA(q)
      __builtin_amdgcn_sched_barrier(0);
      G_FRAG(q, st, 3)
      if (kt + 1 < nk) { G_STORE(sn) }
      G_LOAD((kt + 2 < nkm ? kt + 2 : nkm))
      __builtin_amdgcn_sched_barrier(0);
      G_MMA(p)
      __builtin_amdgcn_sched_barrier(0);
      G_MMA(q)
    } else {
      G_FRAG(p, st, 0)
      __builtin_amdgcn_sched_barrier(0);
      G_MMA(p)
      __builtin_amdgcn_sched_barrier(0);
      G_FRAG(p, st, 1)
      __builtin_amdgcn_sched_barrier(0);
      G_MMA(p)
      __builtin_amdgcn_sched_barrier(0);
      G_FRAG(p, st, 2)
      if (kt + 1 < nk) { G_STORE(sn) }
      G_LOAD((kt + 2 < nkm ? kt + 2 : nkm))
      __builtin_amdgcn_sched_barrier(0);
      G_MMA(p)
      __builtin_amdgcn_sched_barrier(0);
      G_FRAG(p, st, 3)
      __builtin_amdgcn_sched_barrier(0);
      G_MMA(p)
    }
    __syncthreads();
  }
#undef G_FRAG
#undef G_MMA
#undef G_LOAD
#undef G_STORE
}

DEV void zero_acc(f32x16 (&acc)[4][2]) {
#pragma unroll
  for (int i = 0; i < 4; i++)
#pragma unroll
    for (int j = 0; j < 2; j++)
#pragma unroll
      for (int e = 0; e < 16; e++) acc[i][j][e] = 0.f;
}

template <class F>
DEV void epi_loop(int tidv, int bidv, f32x16 (&acc)[4][2], int m0, int n0, int N, F f) {
  const int lane = tidv & 63, wave = tidv >> 6;
  const int wm = wave >> 2, wn = wave & 3;
#pragma unroll
  for (int i = 0; i < 4; i++) {
    const int lrow = wm * 128 + i * 32 + (lane & 31);
#pragma unroll
    for (int j = 0; j < 2; j++) {
#pragma unroll
      for (int g = 0; g < 4; g++) {
        int col = n0 + wn * 64 + j * 32 + 8 * g + 4 * (lane >> 5);
        f32x4 v = {acc[i][j][4 * g], acc[i][j][4 * g + 1], acc[i][j][4 * g + 2], acc[i][j][4 * g + 3]};
        if (col < N) f(m0 + lrow, lrow, col, v);
      }
    }
    __builtin_amdgcn_sched_barrier(0);
  }
}

DEV uint2 pack4(f32x4 v) {
  uint2 o;
  o.x = pack2(v[0], v[1]);
  o.y = pack2(v[2], v[3]);
  return o;
}
DEV f32x4 unpack4(uint2 u) {
  f32x4 v;
  v[0] = bf2f((bf16)(u.x & 0xffff)); v[1] = bf2f((bf16)(u.x >> 16));
  v[2] = bf2f((bf16)(u.y & 0xffff)); v[3] = bf2f((bf16)(u.y >> 16));
  return v;
}

enum { G_IN = 0, G_UQ, G_UKV, G_W2, G_A2, G_G2, G_GLU, G_OUT, G_M1, G_M2, G_MG0, G_MG1, G_MG2 };

template <int MODE>
DEV void run_gemm(int tidv, int bidv, const Params& p, int l, char* smem, const bf16* A, int lda, const bf16* Bt, int K, int N, int M, int aux,
                  const float* xin_lat, const float* xin_ctx, float* xout_lat, float* xout_ctx, int rot = 0) {
  const int nt = (N + 255) >> 8, mt = M >> 8;
  char* ws = p.ws;
  bf16* Z = (bf16*)(ws + B_ZB);
  const float* srinv = (const float*)(smem + SM_RINV);
  const float* mod = (const float*)(ws + B_MOD) + (size_t)l * 5 * 12288;
  for (int tile = (bidv + rot) % (int)gridDim.x; tile < nt * mt; tile += gridDim.x) {
    int m0 = (tile / nt) << 8, n0 = (tile % nt) << 8;
    f32x16 acc[4][2];
    zero_acc(acc);
    gemm_mainloop<(MODE == G_UQ || MODE == G_UKV)>(tidv, bidv, A, lda, MODE == G_MG0, Bt, K, N, m0, n0, smem, acc);
    if constexpr (MODE != G_OUT && MODE != G_M2)
    epi_loop(tidv, bidv, acc, m0, n0, N, [&](int row, int lrow, int col, f32x4 v) {
      if constexpr (MODE == G_IN) {
        f32x4 o = v;
        if (col >= C_GATE || (col >= C_GD && col < C_U)) {
#pragma unroll
          for (int r = 0; r < 4; r++) o[r] = sigmoidf_(v[r]);
        } else if (col >= C_WD && col < C_AD) {
#pragma unroll
          for (int r = 0; r < 4; r++) o[r] = tanhf(v[r]);
        }
        *(uint2*)(smem + ((size_t)lrow * 264 + (col - n0)) * 2) = pack4(o);
      } else if constexpr (MODE == G_UQ) {
        float ri = srinv[lrow];
        *(uint2*)((bf16*)(ws + B_QB) + (size_t)row * 1536 + col) = pack4(v * ri);
      } else if constexpr (MODE == G_UKV) {
        float ri = srinv[lrow];
        f32x4 o = v * ri;
        int h = col >> 8, c = col & 255;
        if (c < 128) {
          *(uint2*)((bf16*)(ws + B_KN) + (size_t)row * 1024 + h * 128 + c) = pack4(o);
        } else {
          int b, kp;
          if (row < ML) { b = row >> 12; kp = row & 4095; } else { int r2 = row - ML; b = r2 >> 8; kp = 4096 + (r2 & 255); }
          bf16* vt = (bf16*)(ws + B_VT) + ((size_t)((b * 8 + h) * 128 + (c - 128))) * NKEY + kp;
#pragma unroll
          for (int r = 0; r < 4; r++) vt[(size_t)r * NKEY] = f2bf(o[r]);
        }
      } else if constexpr (MODE == G_W2) {
        float4 w0 = *(const float4*)(p.in[18] + (l * 2 + aux) * 1024 + col);
        f32x4 o;
        o[0] = 0.60653066f * sigmoidf_(w0.x + v[0]);
        o[1] = 0.60653066f * sigmoidf_(w0.y + v[1]);
        o[2] = 0.60653066f * sigmoidf_(w0.z + v[2]);
        o[3] = 0.60653066f * sigmoidf_(w0.w + v[3]);
        *(uint2*)((bf16*)(ws + B_HB + (size_t)aux * SZ1K) + (size_t)row * 1024 + col) = pack4(o);
      } else if constexpr (MODE == G_A2) {
        float4 a0 = *(const float4*)(p.in[20] + (l * 2 + aux) * 1024 + col);
        f32x4 o;
        o[0] = sigmoidf_(a0.x + v[0]);
        o[1] = sigmoidf_(a0.y + v[1]);
        o[2] = sigmoidf_(a0.z + v[2]);
        o[3] = sigmoidf_(a0.w + v[3]);
        *(uint2*)((bf16*)(ws + (aux ? B_AB : B_AF)) + (size_t)row * 1024 + col) = pack4(o);
      } else if constexpr (MODE == G_G2) {
        *(uint2*)((bf16*)(ws + B_GB) + (size_t)row * 1024 + col) = pack4(v);
      } else if constexpr (MODE == G_GLU) {
        f32x4 zz = unpack4(*(const uint2*)((const bf16*)(ws + B_SY) + (size_t)row * 1024 + col));
        float4 gb = *(const float4*)(p.in[37] + l * 1024 + col);
        f32x4 o;
        o[0] = zz[0] * sigmoidf_(v[0] + gb.x);
        o[1] = zz[1] * sigmoidf_(v[1] + gb.y);
        o[2] = zz[2] * sigmoidf_(v[2] + gb.z);
        o[3] = zz[3] * sigmoidf_(v[3] + gb.w);
        *(uint2*)(smem + ((size_t)lrow * 264 + (col - n0)) * 2) = pack4(o);
      } else if constexpr (MODE == G_OUT || MODE == G_M2) {
      } else if constexpr (MODE == G_M1) {
        f32x4 o;
#pragma unroll
        for (int r = 0; r < 4; r++) { float t = fmaxf(v[r], 0.f); o[r] = t * t; }
        *(uint2*)(smem + ((size_t)lrow * 264 + (col - n0)) * 2) = pack4(o);
      } else if constexpr (MODE == G_MG0 || MODE == G_MG1 || MODE == G_MG2) {
        *(uint2*)(smem + ((size_t)lrow * 264 + (col - n0)) * 2) = pack4(v);
      }
    });
    if constexpr (MODE == G_OUT || MODE == G_M2) {
      float* tilef = (float*)smem;
      constexpr int GOFF = (MODE == G_OUT) ? 4096 : 10240;
      const int wn_ = (tidv >> 6) & 3;
#pragma unroll 1
      for (int half = 0; half < 2; half++) {
        if ((wn_ >> 1) == half) {
          epi_loop(tidv, bidv, acc, m0, n0, N, [&](int row, int lrow, int col, f32x4 v) {
            *(f32x4*)(tilef + (size_t)lrow * 132 + (col - n0 - half * 128)) = v;
          });
        }
        __syncthreads();
#pragma unroll 2
        for (int it = 0; it < 16; it++) {
          int c = it * NT + tidv;
          int r = c >> 5, ch = c & 31;
          int row = m0 + r, col = n0 + half * 128 + ch * 4;
          int b = row < ML ? (row >> 12) : 4;
          float4 g = *(const float4*)(mod + b * 12288 + GOFF + col);
          const float* xi;
          if constexpr (MODE == G_OUT) xi = row < ML ? xin_lat + (size_t)row * 2048 : xin_ctx + (size_t)(row - ML) * 2048;
          else xi = row < ML ? xout_lat + (size_t)row * 2048 : xout_ctx + (size_t)(row - ML) * 2048;
          float* xo = row < ML ? xout_lat + (size_t)row * 2048 : xout_ctx + (size_t)(row - ML) * 2048;
          float4 x = *(const float4*)(xi + col);
          f32x4 v = *(const f32x4*)(tilef + (size_t)r * 132 + ch * 4);
          x.x += g.x * v[0]; x.y += g.y * v[1]; x.z += g.z * v[2]; x.w += g.w * v[3];
          *(float4*)(xo + col) = x;
        }
        __syncthreads();
      }
    }
    if constexpr (MODE == G_MG0 || MODE == G_MG1 || MODE == G_MG2) {
      constexpr int nb = MODE - G_MG0;
      bf16* MG = (bf16*)(ws + B_HB);
      __syncthreads();
#pragma unroll 2
      for (int it = 0; it < 16; it++) {
        int c = it * NT + tidv;
        int r = c >> 5, ch = c & 31;
        int col = n0 + ch * 8;
        uint4 pv = *(const uint4*)(smem + ((size_t)r * 264 + ch * 8) * 2);
        uint4 gv = *(const uint4*)(Z + (size_t)(m0 + r) * NIN + C_GATE + nb * 2048 + col);
        f32x4 p0 = unpack4(uint2{pv.x, pv.y}), p1 = unpack4(uint2{pv.z, pv.w});
        f32x4 g0 = unpack4(uint2{gv.x, gv.y}), g1 = unpack4(uint2{gv.z, gv.w});
        f32x4 o0 = g0 * p0, o1 = g1 * p1;
        if constexpr (nb > 0) {
          uint4 qv = *(const uint4*)(MG + (size_t)(m0 + r) * 2048 + col);
          o0 += unpack4(uint2{qv.x, qv.y});
          o1 += unpack4(uint2{qv.z, qv.w});
        }
        uint2 a = pack4(o0), b = pack4(o1);
        *(uint4*)(MG + (size_t)(m0 + r) * 2048 + col) = uint4{a.x, a.y, b.x, b.y};
      }
    }
    if constexpr (MODE == G_IN || MODE == G_GLU || MODE == G_M1) {
      bf16* dst;
      int ld;
      if constexpr (MODE == G_IN || MODE == G_GLU) { dst = Z; ld = NIN; }
      else { dst = Z; ld = DFF; }
      __syncthreads();
#pragma unroll 4
      for (int it = 0; it < 16; it++) {
        int c = it * NT + tidv;
        int r = c >> 5, ch = c & 31;
        int col = n0 + ch * 8;
        if (col < N) *(uint4*)(dst + (size_t)(m0 + r) * ld + col) = *(const uint4*)(smem + ((size_t)r * 264 + ch * 8) * 2);
      }
    }
  }
}

DEV void phase_mla_post(int tidv, int bidv, const Params& p, int l) {
  char* ws = p.ws;
  const float* qng = p.in[13] + l * 128;
  const float* qrg = p.in[14] + l * 64;
  const float* kng = p.in[15] + l * 128;
  const float* krg = p.in[16] + l * 64;
  bf16* QB = (bf16*)(ws + B_QB);
  bf16* KN = (bf16*)(ws + B_KN);
  bf16* KR = (bf16*)(ws + B_KR);
  const bf16* Z = (const bf16*)(ws + B_ZB);
  const int wave = tidv >> 6, lane = tidv & 63;
  const float QS = 1.4426950408889634f * 0.07216878364870322f;
  const int idx = lane & 31;
  const float inv = powf(10000.f, -(float)(idx & 15) / 16.f);
  const float gq0 = qng[2 * lane], gq1 = qng[2 * lane + 1], gk0 = kng[2 * lane], gk1 = kng[2 * lane + 1];
  const float gqr = qrg[lane], gkr = krg[lane];
  for (int row = bidv * NW + wave; row < MT; row += gridDim.x * NW) {
    bool lat = row < ML;
    int t = row & 4095;
    float pos = (idx < 16) ? (float)(t >> 6) : (float)(t & 63);
    float ang = pos * inv;
    float cs = 1.f, sn = 0.f;
    if (lat) { cs = cosf(ang); sn = sinf(ang); }
#pragma unroll 1
    for (int h = 0; h < 8; h++) {
      bf16* q = QB + (size_t)row * 1536 + h * 192;
      uint32_t u = *(const uint32_t*)(q + 2 * lane);
      float x0 = bf2f((bf16)(u & 0xffff)), x1 = bf2f((bf16)(u >> 16));
      float ss = wsum_fast(x0 * x0 + x1 * x1);
      float rinv = rsqrtf(ss * (1.f / 128.f) + 1e-6f) * QS;
      *(uint32_t*)(q + 2 * lane) = pack2(x0 * rinv * gq0, x1 * rinv * gq1);
      float xr = bf2f(q[128 + lane]);
      float ss2 = wsum_fast(xr * xr);
      float y = xr * rsqrtf(ss2 * (1.f / 64.f) + 1e-6f) * gqr;
      float yp = __shfl_xor(y, 32);
      float o = lane < 32 ? (y * cs - yp * sn) : (yp * sn + y * cs);
      q[128 + lane] = f2bf(o * QS);
      bf16* k = KN + (size_t)row * 1024 + h * 128;
      uint32_t uk = *(const uint32_t*)(k + 2 * lane);
      float k0 = bf2f((bf16)(uk & 0xffff)), k1 = bf2f((bf16)(uk >> 16));
      float ssk = wsum_fast(k0 * k0 + k1 * k1);
      float rk = rsqrtf(ssk * (1.f / 128.f) + 1e-6f);
      *(uint32_t*)(k + 2 * lane) = pack2(k0 * rk * gk0, k1 * rk * gk1);
    }
    {
      float xr = bf2f(Z[(size_t)row * NIN + C_KR + lane]);
      float ss2 = wsum_fast(xr * xr);
      float y = xr * rsqrtf(ss2 * (1.f / 64.f) + 1e-6f) * gkr;
      float yp = __shfl_xor(y, 32);
      float o = lane < 32 ? (y * cs - yp * sn) : (yp * sn + y * cs);
      KR[(size_t)row * 64 + lane] = f2bf(o);
    }
  }
}

DEV void step_row(int s, int d, int b, int& row, int& tau, int& len) {
  if (s < 256) { tau = d ? 255 - s : s; len = 256; row = ML + b * 256 + tau; }
  else { int q = s - 256; tau = d ? 4095 - q : q; len = 4096; row = b * 4096 + tau; }
}

struct RwPre { bf16 r0, r1, r2, k0, k1, k2, v0, v1, v2, a, e; };

DEV void rwkv_fetch(RwPre& q, const bf16* Z, const bf16* AD, const bf16* ED, int s, int d, int b, int ch) {
  int row, tau, len;
  step_row(s, d, b, row, tau, len);
  const bf16* z = Z + (size_t)row * NIN + C_R + ch;
  q.r1 = z[0]; q.k1 = z[1024]; q.v1 = z[2048];
  q.r0 = 0; q.k0 = 0; q.v0 = 0; q.r2 = 0; q.k2 = 0; q.v2 = 0;
  if (tau > 0) { const bf16* zm = z - NIN; q.r0 = zm[0]; q.k0 = zm[1024]; q.v0 = zm[2048]; }
  if (tau < len - 1) { const bf16* zp = z + NIN; q.r2 = zp[0]; q.k2 = zp[1024]; q.v2 = zp[2048]; }
  q.a = AD[(size_t)row * 1024 + ch];
  q.e = ED[(size_t)row * 1024 + ch];
}

typedef float f2v __attribute__((ext_vector_type(2)));
DEV float dpp_hmirror(float v) {
  int i = __float_as_int(v);
  return __int_as_float(__builtin_amdgcn_update_dpp(0, i, 0x141, 0xF, 0xF, true));
}
DEV f2v lo2(float4 v) { return f2v{v.x, v.y}; }
DEV f2v hi2(float4 v) { return f2v{v.z, v.w}; }

DEV void rwkv_scan(int tidv, int bidv, const Params& p, int l, int chain, char* smem, int dry) {
  char* ws = p.ws;
  float* op = (float*)smem;
  float* vb = op + 16 * 320;
  float* yb = vb + 16 * 64;
  const int tid = tidv, wave = tid >> 6, lane = tid & 63;
  const int d = chain & 1, h = (chain >> 1) & 15, b = chain >> 5;
  const int ch = h * 64 + lane;
  const float* cw = p.in[17] + (size_t)l * 3 * 3072;
  const float cr0 = cw[ch], cr1 = cw[3072 + ch], cr2 = cw[6144 + ch];
  const float ck0 = cw[1024 + ch], ck1 = cw[3072 + 1024 + ch], ck2 = cw[6144 + 1024 + ch];
  const float cv0 = cw[2048 + ch], cv1 = cw[3072 + 2048 + ch], cv2 = cw[6144 + 2048 + ch];
  const float kkc = p.in[23][l * 1024 + ch], kac = p.in[24][l * 1024 + ch];
  const bf16* Z = (const bf16*)(ws + B_ZB);
  bf16* ED = (bf16*)(ws + B_HB + (size_t)d * SZ1K);
  const bf16* AD = (const bf16*)(ws + (d ? B_AB : B_AF));
  f2v A0 = {0.f, 0.f}, A1 = {0.f, 0.f}, B0 = {0.f, 0.f}, B1 = {0.f, 0.f};
  const int ri = lane >> 4, jo = lane & 15, rA = wave * 8 + ri, rB = rA + 4;
  RwPre pre[2];
#pragma unroll
  for (int si = 0; si < 2; si++) rwkv_fetch(pre[si], Z, AD, ED, wave * 2 + si, d, b, ch);
  for (int chunk = 0; chunk < 272; chunk++) {
#pragma unroll
    for (int si = 0; si < 2; si++) {
      int t = wave * 2 + si;
      const RwPre& q = pre[si];
      float rr = cr0 * bf2f(q.r0) + cr1 * bf2f(q.r1) + cr2 * bf2f(q.r2);
      float kk_ = ck0 * bf2f(q.k0) + ck1 * bf2f(q.k1) + ck2 * bf2f(q.k2);
      float vv = cv0 * bf2f(q.v0) + cv1 * bf2f(q.v1) + cv2 * bf2f(q.v2);
      float kkv = kk_ * kkc;
      float ssq = wsum_fast(kkv * kkv);
      float kn = kkv * rsqrtf(ssq + 1e-12f);
      float a = bf2f(q.a);
      float w = __expf(-bf2f(q.e));
      float krep = kk_ * (1.f + (a - 1.f) * kac);
      float* o = op + t * 320;
      o[lane] = w;
      o[64 + lane] = kn * a;
      o[128 + lane] = krep;
      o[192 + lane] = -kn;
      o[256 + lane] = rr;
      vb[t * 64 + lane] = vv;
    }
    __syncthreads();
    if (chunk + 1 < 272) {
#pragma unroll
      for (int si = 0; si < 2; si++) rwkv_fetch(pre[si], Z, AD, ED, (chunk + 1) * 16 + wave * 2 + si, d, b, ch);
    }
    {
      const float4* o4 = (const float4*)op + jo;
      float4 nn = o4[48];
#pragma unroll 4
      for (int t = 0; t < 16; t++) {
        const float4* ot = o4 + t * 80;
        const float4 w = ot[0], a = ot[16], k = ot[32], r = ot[64];
        const float viA = vb[t * 64 + rA], viB = vb[t * 64 + rB];
        const int tn = t < 15 ? t + 1 : 15;
        const float4 mm = o4[tn * 80 + 48];
        f2v svA = A0 * lo2(nn) + A1 * hi2(nn);
        f2v svB = B0 * lo2(nn) + B1 * hi2(nn);
        float saA = svA.x + svA.y, saB = svB.x + svB.y;
        saA += dpp_xor1(saA); saB += dpp_xor1(saB);
        saA += dpp_xor2(saA); saB += dpp_xor2(saB);
        saA += dpp_hmirror(saA); saB += dpp_hmirror(saB);
        saA += dpp_rmirror(saA); saB += dpp_rmirror(saB);
        const f2v sA2 = {saA, saA}, vA2 = {viA, viA}, sB2 = {saB, saB}, vB2 = {viB, viB};
        A0 = A0 * lo2(w) + sA2 * lo2(a) + vA2 * lo2(k);
        B0 = B0 * lo2(w) + sB2 * lo2(a) + vB2 * lo2(k);
        A1 = A1 * hi2(w) + sA2 * hi2(a) + vA2 * hi2(k);
        B1 = B1 * hi2(w) + sB2 * hi2(a) + vB2 * hi2(k);
        f2v yvA = A0 * lo2(r) + A1 * hi2(r);
        f2v yvB = B0 * lo2(r) + B1 * hi2(r);
        yb[(t * 64 + rA) * 16 + jo] = yvA.x + yvA.y;
        yb[(t * 64 + rB) * 16 + jo] = yvB.x + yvB.y;
        nn = mm;
      }
    }
    __syncthreads();
#pragma unroll
    for (int it = 0; it < 2; it++) {
      int idx = it * NT + tid;
      int t = idx >> 6, i = idx & 63;
      int row, tau, len;
      step_row(chunk * 16 + t, d, b, row, tau, len);
      size_t off = (size_t)row * 1024 + h * 64 + i;
      bf16* yd = dry ? (bf16*)(ws + B_END) + (off & 0x3fffff) : ED + off;
      const float4* yp = (const float4*)(yb + (t * 64 + i) * 16);
      const float4 ya = yp[0], yc = yp[1], ye = yp[2], yg = yp[3];
      *yd = f2bf((((ya.x + ya.y) + (ya.z + ya.w)) + ((yc.x + yc.y) + (yc.z + yc.w))) + (((ye.x + ye.y) + (ye.z + ye.w)) + ((yg.x + yg.y) + (yg.z + yg.w))));
    }
  }
}

DEV void s5_scan(int tidv, int bidv, const Params& p, int l, int chain, char* smemw, int dry) {
  char* ws = p.ws;
  const int lane = tidv & 63;
  const int d = chain & 1, g = (chain >> 1) & 63, b = chain >> 7;
  float* ub = (float*)smemw;
  float* hb = ub + 256;
  const size_t pg = (size_t)(l * 2 + d) * 64 + g;
  const float lre = p.in[28][pg * 64 + lane], lim = p.in[29][pg * 64 + lane];
  const float dt = expf(p.in[30][pg]);
  const float mag = expf(lre * dt);
  const float are = mag * cosf(lim * dt), aim = mag * sinf(lim * dt);
  const float den = lre * lre + lim * lim;
  const float qre = ((are - 1.f) * lre + aim * lim) / den;
  const float qim = (aim * lre - (are - 1.f) * lim) / den;
  f2v bb[16];
  {
    const float* br = p.in[31] + (pg * 64 + lane) * 16;
    const float* bi = p.in[32] + (pg * 64 + lane) * 16;
#pragma unroll
    for (int i = 0; i < 16; i++) {
      float x = br[i], y = bi[i];
      bb[i] = f2v{qre * x - qim * y, qre * y + qim * x};
    }
  }
  bf16x8 cfr[4];
  {
    const int i = lane & 15, quad = lane >> 4;
    const float* cre = p.in[33] + (pg * 16 + i) * 64;
    const float* cim = p.in[34] + (pg * 16 + i) * 64;
#pragma unroll
    for (int ks = 0; ks < 4; ks++)
#pragma unroll
      for (int j = 0; j < 8; j++) {
        int k = ks * 32 + quad * 8 + j;
        float c = ks < 2 ? cre[k] : -cim[k - 64];
        cfr[ks][j] = (short)f2bf(c);
      }
  }
  float hre = 0.f, him = 0.f;
  const bf16* Z = (const bf16*)(ws + B_ZB);
  const int tt = lane >> 2, i0 = (lane & 3) * 4;
  uint2 unext;
  {
    int row, tau, len;
    step_row(tt, d, b, row, tau, len);
    unext = *(const uint2*)(Z + (size_t)row * NIN + C_U + g * 16 + i0);
  }
  for (int chunk = 0; chunk < 272; chunk++) {
    {
      uint2 u = unext;
      float4 f;
      f.x = bf2f((bf16)(u.x & 0xffff)); f.y = bf2f((bf16)(u.x >> 16));
      f.z = bf2f((bf16)(u.y & 0xffff)); f.w = bf2f((bf16)(u.y >> 16));
      *(float4*)(ub + tt * 16 + i0) = f;
    }
    __syncthreads();
    if (chunk + 1 < 272) {
      int row, tau, len;
      step_row((chunk + 1) * 16 + tt, d, b, row, tau, len);
      unext = *(const uint2*)(Z + (size_t)row * NIN + C_U + g * 16 + i0);
    }
#pragma unroll 2
    for (int t = 0; t < 16; t++) {
      const float* u = ub + t * 16;
      f2v bu0 = {0.f, 0.f}, bu1 = {0.f, 0.f};
#pragma unroll
      for (int i = 0; i < 16; i += 2) {
        const float ua = u[i], uc = u[i + 1];
        bu0 += bb[i] * f2v{ua, ua};
        bu1 += bb[i + 1] * f2v{uc, uc};
      }
      const f2v bu = bu0 + bu1;
      float nr = are * hre - aim * him + bu.x;
      float ni = are * him + aim * hre + bu.y;
      hre = nr; him = ni;
      hb[t * 132 + lane] = hre;
      hb[t * 132 + 64 + lane] = him;
    }
    __syncthreads();
    {
      f32x4 yacc = {0.f, 0.f, 0.f, 0.f};
      const float* hr = hb + (lane & 15) * 132 + (lane >> 4) * 8;
#pragma unroll
      for (int ks = 0; ks < 4; ks++) {
        float4 x0 = *(const float4*)(hr + ks * 32), x1 = *(const float4*)(hr + ks * 32 + 4);
        union { bf16x8 v; uint32_t u[4]; } af;
        af.u[0] = pack2(x0.x, x0.y); af.u[1] = pack2(x0.z, x0.w);
        af.u[2] = pack2(x1.x, x1.y); af.u[3] = pack2(x1.z, x1.w);
        yacc = __builtin_amdgcn_mfma_f32_16x16x32_bf16(af.v, cfr[ks], yacc, 0, 0, 0);
      }
      const int ii = lane & 15;
#pragma unroll
      for (int r = 0; r < 4; r++) {
        int row, tau, len;
        step_row(chunk * 16 + (lane >> 4) * 4 + r, d, b, row, tau, len);
        bf16* dst = d == 0 ? (bf16*)(ws + B_SY) + (size_t)row * 1024 + g * 16 + ii : (bf16*)(ws + B_ZB) + (size_t)row * NIN + g * 16 + ii;
        if (dry) dst = (bf16*)(ws + B_END) + ((((size_t)row * 1024 + g * 16 + ii)) & 0x3fffff);
        *dst = f2bf(yacc[r]);
      }
    }
    __syncthreads();
  }
}

DEV int perm23(int r) { return (r & 0x13) | ((r & 4) << 1) | ((r & 8) >> 1); }

DEV void attn_item(int tidv, int bidv, const Params& p, int item, bool ctxq, char* smem, int dry) {
  char* ws = p.ws;
  bf16* sK = (bf16*)smem;
  bf16* sV = sK + 64 * 200;
  const int tid = tidv, wave = tid >> 6, lane = tid & 63;
  const int r = lane & 31, hf = lane >> 5;
  int b, hd, qt;
  if (!ctxq) { b = item >> 7; hd = (item >> 4) & 7; qt = item & 15; }
  else { b = item >> 3; hd = item & 7; qt = 0; }
  const int qrow0 = ctxq ? ML + b * 256 : b * 4096 + qt * 256;
  const int kt0 = ctxq ? 64 : 0, kt1 = 68;
  bf16* QB = (bf16*)(ws + B_QB);
  const bf16* KN = (const bf16*)(ws + B_KN);
  const bf16* KR = (const bf16*)(ws + B_KR);
  const bf16* VT = (const bf16*)(ws + B_VT);
  bf16x8 qf[12];
  {
    const bf16* qp = QB + (size_t)(qrow0 + wave * 32 + r) * 1536 + hd * 192 + hf * 8;
#pragma unroll
    for (int kk = 0; kk < 12; kk++) qf[kk] = *(const bf16x8*)(qp + kk * 16);
  }
  f32x16 oacc[4];
#pragma unroll
  for (int i = 0; i < 4; i++)
#pragma unroll
    for (int e = 0; e < 16; e++) oacc[i][e] = 0.f;
  float mrun = -1e30f, lrun = 0.f;
  const int pr = perm23(r);
  const uint32_t vo_n = (uint32_t)((tid >> 4) * 2048 + (tid & 15) * 16);
  const uint32_t lo_n = (uint32_t)((tid >> 4) * 400 + (tid & 15) * 16);
  const uint32_t vo_r = (uint32_t)((tid >> 3) * 128 + (tid & 7) * 16);
  const uint32_t lo_r = (uint32_t)((tid >> 3) * 400 + 256 + (tid & 7) * 16);
  const uint32_t vo_v = (uint32_t)((tid >> 3) * (NKEY * 2) + (tid & 7) * 16);
  const uint32_t lo_v = (uint32_t)((tid >> 3) * 144 + (tid & 7) * 16);
  uint4 t0, t1, t4, u0, u1;
#define ATT_LOAD(KT)                                                                                   \
  {                                                                                                    \
    const int key0_ = (KT) * 64;                                                                       \
    const int rowbase_ = key0_ < 4096 ? b * 4096 + key0_ : ML + b * 256 + (key0_ - 4096);               \
    const char* bk = (const char*)(KN + (size_t)rowbase_ * 1024 + hd * 128);                           \
    const char* br = (const char*)(KR + (size_t)rowbase_ * 64);                                        \
    const char* bv = (const char*)(VT + ((size_t)((b * 8 + hd) * 128)) * NKEY + key0_);                \
    t0 = *(const uint4*)(bk + vo_n);                                                                   \
    t1 = *(const uint4*)(bk + 32 * 2048 + vo_n);                                                       \
    t4 = *(const uint4*)(br + vo_r);                                                                   \
    u0 = *(const uint4*)(bv + vo_v);                                                                   \
    u1 = *(const uint4*)(bv + (size_t)64 * NKEY * 2 + vo_v);                                           \
  }
  ATT_LOAD(kt0)
  for (int kt = kt0; kt < kt1; kt++) {
    __syncthreads();
    *(uint4*)((char*)sK + lo_n) = t0;
    *(uint4*)((char*)sK + 32 * 400 + lo_n) = t1;
    *(uint4*)((char*)sK + lo_r) = t4;
    *(uint4*)((char*)sV + lo_v) = u0;
    *(uint4*)((char*)sV + 64 * 144 + lo_v) = u1;
    __syncthreads();
    ATT_LOAD((kt + 1 < kt1 ? kt + 1 : kt1 - 1))
    f32x16 sacc[2];
#pragma unroll
    for (int m = 0; m < 2; m++) {
#pragma unroll
      for (int e = 0; e < 16; e++) sacc[m][e] = 0.f;
      const bf16* kp = sK + (m * 32 + pr) * 200 + hf * 8;
#pragma unroll
      for (int kk = 0; kk < 12; kk++) {
        bf16x8 kf = *(const bf16x8*)(kp + kk * 16);
        sacc[m] = __builtin_amdgcn_mfma_f32_32x32x16_bf16(kf, qf[kk], sacc[m], 0, 0, 0);
        if ((kk & 3) == 3) __builtin_amdgcn_sched_barrier(0);
      }
      __builtin_amdgcn_sched_barrier(0);
    }
    float tmax = sacc[0][0];
#pragma unroll
    for (int e = 1; e < 16; e++) tmax = fmaxf(tmax, sacc[0][e]);
#pragma unroll
    for (int e = 0; e < 16; e++) tmax = fmaxf(tmax, sacc[1][e]);
    tmax = fmaxf(tmax, __shfl_xor(tmax, 32));
    float mnew = fmaxf(mrun, tmax);
    float alpha = __builtin_amdgcn_exp2f(mrun - mnew);
    mrun = mnew;
    float psum = 0.f;
#pragma unroll
    for (int m = 0; m < 2; m++)
#pragma unroll
      for (int e = 0; e < 16; e++) { float pv = __builtin_amdgcn_exp2f(sacc[m][e] - mnew); sacc[m][e] = pv; psum += pv; }
    lrun = lrun * alpha + psum;
    if (__any(alpha != 1.f)) {
#pragma unroll
      for (int i = 0; i < 4; i++)
#pragma unroll
        for (int e = 0; e < 16; e++) oacc[i][e] *= alpha;
    }
#pragma unroll
    for (int s = 0; s < 4; s++) {
      const int m = s >> 1, s2 = s & 1;
      bf16x8 pf;
#pragma unroll
      for (int j = 0; j < 8; j++) pf[j] = (short)f2bf(sacc[m][8 * s2 + j]);
#pragma unroll
      for (int i = 0; i < 4; i++) {
        bf16x8 vf = *(const bf16x8*)(sV + (i * 32 + r) * 72 + m * 32 + s2 * 16 + hf * 8);
        oacc[i] = __builtin_amdgcn_mfma_f32_32x32x16_bf16(vf, pf, oacc[i], 0, 0, 0);
      }
      __builtin_amdgcn_sched_barrier(0);
    }
  }
#undef ATT_LOAD
  lrun += __shfl_xor(lrun, 32);
  const float inv = 1.f / lrun;
  bf16* op = QB + (size_t)(qrow0 + wave * 32 + r) * 1536 + hd * 192;
  if (dry) op = (bf16*)(ws + B_END) + ((((size_t)(qrow0 + wave * 32 + r) * 1536 + hd * 192)) & 0x3ffff8);
#pragma unroll
  for (int i = 0; i < 4; i++)
#pragma unroll
    for (int g = 0; g < 4; g++) {
      uint2 o;
      o.x = pack2(oacc[i][4 * g] * inv, oacc[i][4 * g + 1] * inv);
      o.y = pack2(oacc[i][4 * g + 2] * inv, oacc[i][4 * g + 3] * inv);
      *(uint2*)(op + 32 * i + 8 * g + 4 * hf) = o;
    }
}

DEV void phase_mixers(int tidv, int bidv, const Params& p, int l, char* smem, int dry) {
  int* s_item = (int*)(smem + SM_ITEM);
#ifdef PROBE_PARTS
  const int parts = dry ? PROBE_PARTS : 7;
#else
  const int parts = 7;
#endif
  for (int task = bidv; task < 192; task += gridDim.x) {
    if (task < 128 && !(parts & 1)) continue;
    if (task >= 128 && !(parts & 2)) continue;
    if (task < 128) rwkv_scan(tidv, bidv, p, l, task, smem, dry);
    else s5_scan(tidv, bidv, p, l, (task - 128) * 8 + (tidv >> 6), smem + (tidv >> 6) * 9472, dry);
  }
  const int nlat = 512, ntot = (parts & 4) ? ((l == 0) ? 544 : 512) : 0;
  int* cnt = (int*)(p.ws + B_CNT) + l + 2 * dry;
#if !defined(MIX_ONLY) || MIX_ONLY == 2
  while (true) {
    __syncthreads();
    if (tidv == 0) *s_item = atomicAdd(cnt, 1);
    __syncthreads();
    int item = *s_item;
    if (item >= ntot) break;
    if (item < nlat) attn_item(tidv, bidv, p, item, false, smem, dry);
    else attn_item(tidv, bidv, p, item - nlat, true, smem, dry);
  }
#endif
}

DEV float gelu_tanh(float x) {
  float u = 0.7978845608028654f * (x + 0.044715f * x * x * x);
  return 0.5f * x * (1.f + tanhf(u));
}

DEV void phase_post(int tidv, int bidv, const Params& p, int l, int M) {
  char* ws = p.ws;
  const bf16* Z = (const bf16*)(ws + B_ZB);
  const int wave = tidv >> 6, lane = tidv & 63;
  const float* cw = p.in[17] + (size_t)l * 3 * 3072;
  const bf16* YF = (const bf16*)(ws + B_HB);
  const bf16* YB = (const bf16*)(ws + B_HB + SZ1K);
  const bf16* AF = (const bf16*)(ws + B_AF);
  const bf16* AB = (const bf16*)(ws + B_AB);
  bf16* GB = (bf16*)(ws + B_GB);
  {
    const int gw = bidv * NW + wave, nwv = gridDim.x * NW;
    const int h = gw & 15, ch = h * 64 + lane;
    const float c_r0 = cw[ch], c_r1 = cw[3072 + ch], c_r2 = cw[6144 + ch];
    const float c_k0 = cw[1024 + ch], c_k1 = cw[3072 + 1024 + ch], c_k2 = cw[6144 + 1024 + ch];
    const float c_v0 = cw[2048 + ch], c_v1 = cw[3072 + 2048 + ch], c_v2 = cw[6144 + 2048 + ch];
    const float lng = p.in[26][l * 1024 + ch], lnb = p.in[27][l * 1024 + ch];
    const float kac = p.in[24][l * 1024 + ch], rkc = p.in[25][l * 1024 + ch];
    for (int row = gw >> 4; row < M; row += (nwv >> 4)) {
      int tau, len;
      if (row < ML) { tau = row & 4095; len = 4096; } else { tau = (row - ML) & 255; len = 256; }
      size_t o = (size_t)row * 1024 + ch;
      float y = bf2f(YF[o]) + bf2f(YB[o]);
      const bf16* z = Z + (size_t)row * NIN + C_R + ch;
      float r1 = bf2f(z[0]), k1 = bf2f(z[1024]), v1 = bf2f(z[2048]);
      float r0 = 0.f, k0 = 0.f, v0 = 0.f, r2 = 0.f, k2 = 0.f, v2 = 0.f;
      if (tau > 0) { const bf16* zm = z - NIN; r0 = bf2f(zm[0]); k0 = bf2f(zm[1024]); v0 = bf2f(zm[2048]); }
      if (tau < len - 1) { const bf16* zp = z + NIN; r2 = bf2f(zp[0]); k2 = bf2f(zp[1024]); v2 = bf2f(zp[2048]); }
      float am = 0.5f * (bf2f(AF[o]) + bf2f(AB[o]));
      float gate = bf2f(GB[o]);
      float mu = wsum_fast(y) * (1.f / 64.f);
      float dv = y - mu;
      float var = wsum_fast(dv * dv) * (1.f / 64.f);
      float yn = dv * rsqrtf(var + 64e-5f) * lng + lnb;
      float rr = c_r0 * r0 + c_r1 * r1 + c_r2 * r2;
      float kk = c_k0 * k0 + c_k1 * k1 + c_k2 * k2;
      float vv = c_v0 * v0 + c_v1 * v1 + c_v2 * v2;
      float kbon = kk * (1.f + (am - 1.f) * kac);
      float s = wsum_fast(rr * kbon * rkc);
      GB[o] = f2bf((yn + s * vv) * gate);
    }
  }
  bf16* SY = (bf16*)(ws + B_SY);
  const float* dsk = p.in[35] + l * 1024;
  const int n4 = M * 256;
  for (int i = bidv * NT + tidv; i < n4; i += gridDim.x * NT) {
    int row = i >> 8, c = (i & 255) * 4;
    uint2 a = *(const uint2*)(SY + (size_t)row * 1024 + c);
    uint2 bq = *(const uint2*)(Z + (size_t)row * NIN + c);
    uint2 u = *(const uint2*)(Z + (size_t)row * NIN + C_U + c);
    float4 dd = *(const float4*)(dsk + c);
    float y0 = bf2f((bf16)(a.x & 0xffff)) + bf2f((bf16)(bq.x & 0xffff)) + dd.x * bf2f((bf16)(u.x & 0xffff));
    float y1 = bf2f((bf16)(a.x >> 16)) + bf2f((bf16)(bq.x >> 16)) + dd.y * bf2f((bf16)(u.x >> 16));
    float y2 = bf2f((bf16)(a.y & 0xffff)) + bf2f((bf16)(bq.y & 0xffff)) + dd.z * bf2f((bf16)(u.y & 0xffff));
    float y3 = bf2f((bf16)(a.y >> 16)) + bf2f((bf16)(bq.y >> 16)) + dd.w * bf2f((bf16)(u.y >> 16));
    uint2 o;
    o.x = pack2(gelu_tanh(y0), gelu_tanh(y1));
    o.y = pack2(gelu_tanh(y2), gelu_tanh(y3));
    *(uint2*)(SY + (size_t)row * 1024 + c) = o;
  }
}

constexpr int NPH = 25;

DEV void run_phase(int tidv, int bidv, const Params& p, int ph, char* smem, int dry) {
  char* ws = p.ws;
#ifndef ONLY_S
  if (ph == 0) {
    if (bidv == 0 && tidv < 4) ((int*)(ws + B_CNT))[tidv] = 0;
    phase_mod(tidv, bidv, p, smem);
    phase_convw(tidv, bidv, p, 0, smem);
    return;
  }
#endif
  const int l = (ph - 1) / 12, s = (ph - 1) % 12;
#ifdef ONLY_S
  if (s != ONLY_S) return;
#endif
  const bf16* wb = (const bf16*)(ws + B_WB);
  const float* mod = (const float*)(ws + B_MOD) + (size_t)l * 5 * 12288;
  float* XC = (float*)(ws + B_XC);
  const float* xin_lat = l == 0 ? p.in[0] : p.out;
  const float* xin_ctx = l == 0 ? p.in[2] : XC;
  bf16* HB = (bf16*)(ws + B_HB);
  bf16* Z = (bf16*)(ws + B_ZB);
  bf16* H2 = (bf16*)(ws + B_KN);
  const int Mpost = l == 0 ? MT : ML;
  switch (s) {
    case 0:
      if (l == 1) phase_convw(tidv, bidv, p, 1, smem);
      phase_norm(tidv, bidv, xin_lat, xin_ctx, p.in[6] + l * 2048, mod, 0, 2048, HB, MT);
      break;
    case 1:
      run_gemm<G_IN>(tidv, bidv, p, l, smem, HB, 2048, wb + OW_IN, 2048, NIN, MT, 0, nullptr, nullptr, nullptr, nullptr);
      break;
    case 2:
#if !defined(PH2_ONLY) || PH2_ONLY == 0
      run_gemm<G_UKV>(tidv, bidv, p, l, smem, Z + C_CKV, NIN, wb + OW_UKV, 512, 2048, MT, 0, nullptr, nullptr, nullptr, nullptr);
#endif
#if !defined(PH2_ONLY) || PH2_ONLY == 1
      run_gemm<G_UQ>(tidv, bidv, p, l, smem, Z + C_CQ, NIN, wb + OW_UQ, 512, 1536, MT, 0, nullptr, nullptr, nullptr, nullptr, 224);
#endif
#if !defined(PH2_ONLY) || PH2_ONLY == 2
      run_gemm<G_G2>(tidv, bidv, p, l, smem, Z + C_GD, NIN, wb + OW_G2, 192, 1024, MT, 0, nullptr, nullptr, nullptr, nullptr, 72);
#endif
#if !defined(PH2_ONLY) || PH2_ONLY == 3
      for (int d = 0; d < 2; d++) {
        run_gemm<G_W2>(tidv, bidv, p, l, smem, Z + C_WD + 64 * d, NIN, wb + OW_W2 + (size_t)d * 65536, 64, 1024, MT, d, nullptr, nullptr, nullptr, nullptr, 56 - 32 * d);
        run_gemm<G_A2>(tidv, bidv, p, l, smem, Z + C_AD + 64 * d, NIN, wb + OW_A2 + (size_t)d * 65536, 64, 1024, MT, d, nullptr, nullptr, nullptr, nullptr, 40 - 32 * d);
      }
#endif
      break;
    case 3: phase_mla_post(tidv, bidv, p, l); break;
    case 4: phase_mixers(tidv, bidv, p, l, smem, dry); break;
    case 5: phase_post(tidv, bidv, p, l, Mpost); break;
    case 6:
      run_gemm<G_GLU>(tidv, bidv, p, l, smem, (const bf16*)(ws + B_SY), 1024, wb + OW_GLU, 1024, 1024, Mpost, 0, nullptr, nullptr, nullptr, nullptr);
      break;
    case 7:
      run_gemm<G_MG0>(tidv, bidv, p, l, smem, (const bf16*)(ws + B_QB), 1536, wb + OW_BR, 1024, 2048, Mpost, 0, nullptr, nullptr, nullptr, nullptr);
      run_gemm<G_MG1>(tidv, bidv, p, l, smem, (const bf16*)(ws + B_GB), 1024, wb + OW_BR + (size_t)2048 * 1024, 1024, 2048, Mpost, 0, nullptr, nullptr, nullptr, nullptr);
      run_gemm<G_MG2>(tidv, bidv, p, l, smem, Z, NIN, wb + OW_BR + (size_t)2 * 2048 * 1024, 1024, 2048, Mpost, 0, nullptr, nullptr, nullptr, nullptr);
      break;
    case 8:
      run_gemm<G_OUT>(tidv, bidv, p, l, smem, HB, 2048, wb + OW_OUT, 2048, 2048, Mpost, 0, xin_lat, xin_ctx, p.out, XC);
      break;
    case 9:
      phase_norm(tidv, bidv, p.out, XC, p.in[7] + l * 2048, mod, 6144, 8192, H2, Mpost);
      break;
    case 10:
      run_gemm<G_M1>(tidv, bidv, p, l, smem, H2, 2048, wb + OW_M1, 2048, 8192, Mpost, 0, nullptr, nullptr, nullptr, nullptr);
      break;
    case 11:
      run_gemm<G_M2>(tidv, bidv, p, l, smem, Z, 8192, wb + OW_M2, 8192, 2048, Mpost, 0, nullptr, nullptr, p.out, XC);
      break;
  }
}

DEV void grid_barrier(unsigned* cnt, unsigned target) {
  asm volatile("s_waitcnt vmcnt(0)" ::: "memory");
  __syncthreads();
  if (threadIdx.x == 0) {
    __builtin_amdgcn_fence(__ATOMIC_RELEASE, "agent");
    asm volatile("s_waitcnt vmcnt(0)" ::: "memory");
    __hip_atomic_fetch_add(cnt, 1u, __ATOMIC_RELAXED, __HIP_MEMORY_SCOPE_AGENT);
    unsigned spins = 0;
    while (__hip_atomic_load(cnt, __ATOMIC_RELAXED, __HIP_MEMORY_SCOPE_AGENT) < target) {
      __builtin_amdgcn_s_sleep(1);
      if (++spins > (1u << 21)) break;
    }
    __builtin_amdgcn_fence(__ATOMIC_ACQUIRE, "agent");
    asm volatile("s_waitcnt vmcnt(0)" ::: "memory");
  }
  __syncthreads();
}

__global__ void __launch_bounds__(NT) fwd_megakernel(Params p, int ph0, int ph1, int dryflag) {
  extern __shared__ __attribute__((aligned(16))) char smem[];
  for (int ph = ph0; ph < ph1; ph++) {
    int tidv = threadIdx.x, bidv = blockIdx.x;
    asm volatile("" : "+v"(tidv));
    asm volatile("" : "+s"(bidv));
#ifdef PROBE_MASK
    if (dryflag && ((ph == 0 && (PROBE_MASK & 0x1000)) || (ph > 0 && ((PROBE_MASK >> ((ph - 1) % 12)) & 1)))) {
      run_phase(tidv, bidv, p, ph, smem, dryflag);
      cg::this_grid().sync();
    }
#endif
    run_phase(tidv, bidv, p, ph, smem, 0);
    if (ph + 1 < ph1) {
      if (ph == ph0) cg::this_grid().sync();
      else grid_barrier((unsigned*)(p.ws + B_FLG), (unsigned)(ph - ph0) * gridDim.x);
    }
  }
}

extern "C" void kernel_launch(void* const* d_in, const int* in_sizes, int n_in, void* d_out, int out_size, void* d_ws, size_t ws_size,
                              hipStream_t stream) {
  static int grid_blocks = 0;
  if (!grid_blocks) {
    int dev = 0, cus = 0, per_cu = 0;
    (void)hipGetDevice(&dev);
    (void)hipDeviceGetAttribute(&cus, hipDeviceAttributeMultiprocessorCount, dev);
    if (hipFuncSetAttribute((const void*)fwd_megakernel, hipFuncAttributeMaxDynamicSharedMemorySize, LDS_BYTES) != hipSuccess) {
      fprintf(stderr, "hipFuncSetAttribute(%d B dynamic LDS) failed\n", LDS_BYTES);
      return;
    }
    if (hipOccupancyMaxActiveBlocksPerMultiprocessor(&per_cu, (const void*)fwd_megakernel, NT, LDS_BYTES) != hipSuccess || per_cu < 1) {
      fprintf(stderr, "occupancy query failed / kernel not resident\n");
      return;
    }
    grid_blocks = cus;
  }
  Params p{};
  for (int i = 0; i < 42; i++) p.in[i] = (const float*)d_in[i];
  p.out = (float*)d_out;
  p.ws = (char*)d_ws;
  if (ws_size < B_END + (8u << 20)) { fprintf(stderr, "workspace too small\n"); return; }
  int ph0 = 0, ph1 = NPH;
  int dryflag = 1;
  void* args[] = {&p, &ph0, &ph1, &dryflag};
  (void)hipMemsetAsync((char*)d_ws + B_FLG, 0, 4096, stream);
  hipError_t e = hipLaunchCooperativeKernel((void*)fwd_megakernel, dim3(grid_blocks), dim3(NT), args, LDS_BYTES, stream);
  if (e != hipSuccess) fprintf(stderr, "cooperative launch failed: %s (grid %d)\n", hipGetErrorString(e), grid_blocks);
}
```

```cpp
#include <hip/hip_runtime.h>
#include <hip/hip_cooperative_groups.h>
#include <stdint.h>
#include <cstdio>
namespace cg = cooperative_groups;

#ifndef MULTI_LAUNCH
#define MULTI_LAUNCH 0
#endif

typedef unsigned short bf16;
using bf16x8 = __attribute__((ext_vector_type(8))) short;
using f32x4 = __attribute__((ext_vector_type(4))) float;
using f32x16 = __attribute__((ext_vector_type(16))) float;

#define DEV __device__ __forceinline__
constexpr int NT = 512, NW = 8;

constexpr int DM = 2048, ML = 16384, MC = 1024, MT = 17408, NIN = 11744, DFF = 8192, NKEY = 4352;
constexpr int C_CQ = 0, C_CKV = 512, C_KR = 1024, C_R = 1088, C_WD = 4160, C_AD = 4288, C_GD = 4416, C_U = 4576, C_GATE = 5600;

constexpr size_t OW_IN = 0;
constexpr size_t OW_UQ = OW_IN + (size_t)NIN * 2048;
constexpr size_t OW_UKV = OW_UQ + 1536 * 512;
constexpr size_t OW_W2 = OW_UKV + 2048 * 512;
constexpr size_t OW_A2 = OW_W2 + 2 * 1024 * 64;
constexpr size_t OW_G2 = OW_A2 + 2 * 1024 * 64;
constexpr size_t OW_GLU = OW_G2 + 1024 * 192;
constexpr size_t OW_BR = OW_GLU + 1024 * 1024;
constexpr size_t OW_OUT = OW_BR + (size_t)3 * 2048 * 1024;
constexpr size_t OW_M1 = OW_OUT + (size_t)2048 * 2048;
constexpr size_t OW_M2 = OW_M1 + (size_t)8192 * 2048;
constexpr size_t OW_END = OW_M2 + (size_t)8192 * 2048;

constexpr size_t SZ1K = (size_t)MT * 1024 * 2;
constexpr size_t B_WB = 0;
constexpr size_t B_HB = B_WB + OW_END * 2;
constexpr size_t B_ZB = B_HB + (size_t)MT * 2048 * 2;
constexpr size_t B_QB = B_ZB + (size_t)MT * NIN * 2;
constexpr size_t B_KN = B_QB + (size_t)MT * 1536 * 2;
constexpr size_t B_VT = B_KN + SZ1K;
constexpr size_t B_KR = B_VT + SZ1K;
constexpr size_t B_AF = B_KR + (size_t)MT * 64 * 2;
constexpr size_t B_AB = B_AF + SZ1K;
constexpr size_t B_GB = B_AB + SZ1K;
constexpr size_t B_SY = B_GB + SZ1K;
constexpr size_t B_XC = B_SY + SZ1K;
constexpr size_t B_MOD = B_XC + (size_t)MC * 2048 * 4;
constexpr size_t B_CNT = B_MOD + (size_t)2 * 5 * 12288 * 4;
constexpr size_t B_FLG = B_CNT + 256;
constexpr size_t B_END = B_FLG + 4096;

struct Params {
  const float* in[42];
  float* out;
  char* ws;
};

typedef __attribute__((ext_vector_type(2))) __bf16 hbf2;
DEV bf16 f2bf(float f) {
  __bf16 h = (__bf16)f;
  return *(unsigned short*)&h;
}
DEV float bf2f(bf16 h) { return __uint_as_float(((uint32_t)h) << 16); }
DEV uint32_t pack2(float a, float b) {
  hbf2 v;
  v[0] = (__bf16)a;
  v[1] = (__bf16)b;
  return *(uint32_t*)&v;
}
DEV float wsum(float v) {
#pragma unroll
  for (int o = 32; o > 0; o >>= 1) v += __shfl_xor(v, o);
  return v;
}
DEV float dpp_xor1(float v) {
  int i = __float_as_int(v);
  return __int_as_float(__builtin_amdgcn_update_dpp(0, i, 0xB1, 0xF, 0xF, true));
}
DEV float dpp_xor2(float v) {
  int i = __float_as_int(v);
  return __int_as_float(__builtin_amdgcn_update_dpp(0, i, 0x4E, 0xF, 0xF, true));
}
DEV float dpp_rmirror(float v) {
  int i = __float_as_int(v);
  return __int_as_float(__builtin_amdgcn_update_dpp(0, i, 0x140, 0xF, 0xF, true));
}
DEV float dpp_hmirror0(float v) {
  int i = __float_as_int(v);
  return __int_as_float(__builtin_amdgcn_update_dpp(0, i, 0x141, 0xF, 0xF, true));
}
DEV float wsum_fast(float v) {
  v += dpp_xor1(v);
  v += dpp_xor2(v);
  v += dpp_hmirror0(v);
  v += dpp_rmirror(v);
  v += __shfl_xor(v, 16);
  v += __shfl_xor(v, 32);
  return v;
}
DEV float sigmoidf_(float x) { return __builtin_amdgcn_rcpf(1.f + __expf(-x)); }

DEV void phase_mod(int tidv, int bidv, const Params& p, char* smem) {
  float* s_in = (float*)smem;
  float* red = s_in + 5 * 2048;
  float* mod = (float*)(p.ws + B_MOD);
  for (int i = tidv; i < 5 * 2048; i += NT) {
    int r = i >> 11, k = i & 2047;
    float v = r < 4 ? p.in[1][r * 2048 + k] : p.in[3][k];
    s_in[i] = v / (1.f + expf(-v));
  }
  __syncthreads();
  int kg = tidv >> 6, c = tidv & 63;
  for (int task = bidv; task < 2 * 192; task += gridDim.x) {
    int l = task / 192, n = (task % 192) * 64 + c;
    const float* w = p.in[4] + (size_t)l * 2048 * 12288 + n;
    float a0 = 0, a1 = 0, a2 = 0, a3 = 0, a4 = 0;
    int kb = kg * 256;
#pragma unroll 8
    for (int k = 0; k < 256; k++) {
      float wv = w[(size_t)(kb + k) * 12288];
      a0 += s_in[kb + k] * wv;
      a1 += s_in[2048 + kb + k] * wv;
      a2 += s_in[4096 + kb + k] * wv;
      a3 += s_in[6144 + kb + k] * wv;
      a4 += s_in[8192 + kb + k] * wv;
    }
    red[(kg * 5 + 0) * 64 + c] = a0;
    red[(kg * 5 + 1) * 64 + c] = a1;
    red[(kg * 5 + 2) * 64 + c] = a2;
    red[(kg * 5 + 3) * 64 + c] = a3;
    red[(kg * 5 + 4) * 64 + c] = a4;
    __syncthreads();
    if (kg == 0) {
      float bias = p.in[5][l * 12288 + n];
#pragma unroll
      for (int r = 0; r < 5; r++) {
        float v = 0.f;
#pragma unroll
        for (int g = 0; g < 8; g++) v += red[(g * 5 + r) * 64 + c];
        mod[(size_t)(l * 5 + r) * 12288 + n] = v + bias;
      }
    }
    __syncthreads();
  }
}

DEV void convT(int tidv, int bidv, const float* __restrict__ src, bf16* __restrict__ dst, int K, int N, const float* __restrict__ gain, char* smem, int dK, int vb, int nvb) {
  if (dK == 0) dK = K;
  float* t = (float*)smem;
  const int tk = (K + 63) >> 6, tn = (N + 63) >> 6, ntile = tk * tn;
  const int kk = tidv >> 4, n4 = (tidv & 15) * 4;
  float4 c0 = {0.f, 0.f, 0.f, 0.f}, c1 = {0.f, 0.f, 0.f, 0.f};
#define CV_LOAD(TILE)                                                                      \
  {                                                                                        \
    const int k0_ = ((TILE) / tn) * 64, n0_ = ((TILE) % tn) * 64;                          \
    c0 = float4{0.f, 0.f, 0.f, 0.f}; c1 = c0;                                              \
    if (n0_ + n4 < N) {                                                                    \
      if (k0_ + kk < K) { c0 = *(const float4*)(src + (size_t)(k0_ + kk) * N + n0_ + n4);  \
        if (gain) { float g = gain[k0_ + kk]; c0.x *= g; c0.y *= g; c0.z *= g; c0.w *= g; } }          \
      if (k0_ + kk + 32 < K) { c1 = *(const float4*)(src + (size_t)(k0_ + kk + 32) * N + n0_ + n4);    \
        if (gain) { float g = gain[k0_ + kk + 32]; c1.x *= g; c1.y *= g; c1.z *= g; c1.w *= g; } }     \
    }                                                                                      \
  }
  if (vb < ntile) CV_LOAD(vb)
  for (int tile = vb; tile < ntile; tile += nvb) {
    int k0 = (tile / tn) * 64, n0 = (tile % tn) * 64;
    __syncthreads();
    t[kk * 65 + n4 + 0] = c0.x; t[kk * 65 + n4 + 1] = c0.y; t[kk * 65 + n4 + 2] = c0.z; t[kk * 65 + n4 + 3] = c0.w;
    t[(kk + 32) * 65 + n4 + 0] = c1.x; t[(kk + 32) * 65 + n4 + 1] = c1.y; t[(kk + 32) * 65 + n4 + 2] = c1.z; t[(kk + 32) * 65 + n4 + 3] = c1.w;
    __syncthreads();
    if (tile + nvb < ntile) CV_LOAD(tile + nvb)
    {
      int c = tidv;
      int nn = c >> 3, kc = c & 7;
      if (n0 + nn < N && k0 + kc * 8 < dK) {
        uint4 o;
        o.x = pack2(t[(kc * 8 + 0) * 65 + nn], t[(kc * 8 + 1) * 65 + nn]);
        o.y = pack2(t[(kc * 8 + 2) * 65 + nn], t[(kc * 8 + 3) * 65 + nn]);
        o.z = pack2(t[(kc * 8 + 4) * 65 + nn], t[(kc * 8 + 5) * 65 + nn]);
        o.w = pack2(t[(kc * 8 + 6) * 65 + nn], t[(kc * 8 + 7) * 65 + nn]);
        *(uint4*)(dst + (size_t)(n0 + nn) * dK + k0 + kc * 8) = o;
      }
    }
  }
#undef CV_LOAD
}

DEV void phase_convw(int tidv, int bidv, const Params& p, int l, char* smem, int which, int vb, int nvb) {
  bf16* wb = (bf16*)(p.ws + B_WB);
  if (which & 2) convT(tidv, bidv, p.in[41] + (size_t)l * 8192 * 2048, wb + OW_M2, 8192, 2048, nullptr, smem, 0, vb, nvb);
  if (!(which & 1)) return;
  convT(tidv, bidv, p.in[8] + (size_t)l * 2048 * NIN, wb + OW_IN, 2048, NIN, nullptr, smem, 0, vb, nvb);
  convT(tidv, bidv, p.in[40] + (size_t)l * 2048 * 8192, wb + OW_M1, 2048, 8192, nullptr, smem, 0, vb, nvb);
  for (int n = 0; n < 3; n++)
    convT(tidv, bidv, p.in[38] + (size_t)(l * 3 + n) * 1024 * 2048, wb + OW_BR + (size_t)n * 2048 * 1024, 1024, 2048, nullptr, smem, 0, vb, nvb);
  convT(tidv, bidv, p.in[39] + (size_t)l * 2048 * 2048, wb + OW_OUT, 2048, 2048, nullptr, smem, 0, vb, nvb);
  convT(tidv, bidv, p.in[11] + (size_t)l * 512 * 1536, wb + OW_UQ, 512, 1536, p.in[9] + l * 512, smem, 0, vb, nvb);
  convT(tidv, bidv, p.in[12] + (size_t)l * 512 * 2048, wb + OW_UKV, 512, 2048, p.in[10] + l * 512, smem, 0, vb, nvb);
  convT(tidv, bidv, p.in[36] + (size_t)l * 1024 * 1024, wb + OW_GLU, 1024, 1024, nullptr, smem, 0, vb, nvb);
  for (int d = 0; d < 2; d++) {
    convT(tidv, bidv, p.in[19] + (size_t)(l * 2 + d) * 64 * 1024, wb + OW_W2 + (size_t)d * 65536, 64, 1024, nullptr, smem, 0, vb, nvb);
    convT(tidv, bidv, p.in[21] + (size_t)(l * 2 + d) * 64 * 1024, wb + OW_A2 + (size_t)d * 65536, 64, 1024, nullptr, smem, 0, vb, nvb);
  }
  convT(tidv, bidv, p.in[22] + (size_t)l * 160 * 1024, wb + OW_G2, 160, 1024, nullptr, smem, 192, vb, nvb);
}

DEV void phase_norm(int tidv, int bidv, const float* xlat, const float* xctx, const float* g, const float* mod, int shOff, int scOff, bf16* H, int nrows) {
  int wave = tidv >> 6, lane = tidv & 63;
  for (int row = bidv * NW + wave; row < nrows; row += gridDim.x * NW) {
    const float* x = row < ML ? xlat + (size_t)row * 2048 : xctx + (size_t)(row - ML) * 2048;
    int b = row < ML ? (row >> 12) : 4;
    const float* sh = mod + b * 12288 + shOff;
    const float* sc = mod + b * 12288 + scOff;
    float4 v[8];
    float ss = 0.f;
#pragma unroll
    for (int i = 0; i < 8; i++) {
      v[i] = *(const float4*)(x + i * 256 + lane * 4);
      ss += v[i].x * v[i].x + v[i].y * v[i].y + v[i].z * v[i].z + v[i].w * v[i].w;
    }
    ss = wsum_fast(ss);
    float rinv = rsqrtf(ss * (1.f / 2048.f) + 1e-6f);
#pragma unroll
    for (int i = 0; i < 8; i++) {
      int c = i * 256 + lane * 4;
      float4 g4 = *(const float4*)(g + c), s4 = *(const float4*)(sc + c), h4 = *(const float4*)(sh + c);
      float y0 = v[i].x * rinv * g4.x * (1.f + s4.x) + h4.x;
      float y1 = v[i].y * rinv * g4.y * (1.f + s4.y) + h4.y;
      float y2 = v[i].z * rinv * g4.z * (1.f + s4.z) + h4.z;
      float y3 = v[i].w * rinv * g4.w * (1.f + s4.w) + h4.w;
      uint2 o;
      o.x = pack2(y0, y1);
      o.y = pack2(y2, y3);
      *(uint2*)(H + (size_t)row * 2048 + c) = o;
    }
  }
}

constexpr int LDT = 72;
constexpr int GA_BYTES = 256 * LDT * 2;
constexpr int GSTAGE = 512 * LDT * 2;
constexpr int SM_RINV = 2 * GSTAGE;
constexpr int SM_ITEM = SM_RINV + 1024;
constexpr int LDS_BYTES = SM_ITEM + 16;
DEV float sumsq8(uint4 r) {
  float s = 0.f, x;
  x = bf2f((bf16)(r.x & 0xffff)); s += x * x; x = bf2f((bf16)(r.x >> 16)); s += x * x;
  x = bf2f((bf16)(r.y & 0xffff)); s += x * x; x = bf2f((bf16)(r.y >> 16)); s += x * x;
  x = bf2f((bf16)(r.z & 0xffff)); s += x * x; x = bf2f((bf16)(r.z >> 16)); s += x * x;
  x = bf2f((bf16)(r.w & 0xffff)); s += x * x; x = bf2f((bf16)(r.w >> 16)); s += x * x;
  return s;
}

template <bool ROWNORM>
DEV void gemm_mainloop(int tidv, int bidv, const bf16* __restrict__ A, int lda, bool amap, const bf16* __restrict__ Bt, int K, int N, int m0, int n0,
                       char* smem, f32x16 (&acc)[4][2]) {
  float* srinv = (float*)(smem + SM_RINV);
  const int tid = tidv, lane = tid & 63, wave = tid >> 6;
  const int wm = wave >> 2, wn = wave & 3;
  const int lr = tid >> 3, kc = tid & 7;
  const char* abase = (const char*)(A + (size_t)m0 * lda);
  const char* bbase = (const char*)(Bt + (size_t)n0 * K);
  const uint32_t voa = (uint32_t)(lr * lda + kc * 8) * 2u;
  const uint32_t astep = (uint32_t)(64 * lda) * 2u;
  const uint32_t vob0 = (uint32_t)(lr * K + kc * 8) * 2u;
  const uint32_t bstep = (uint32_t)(64 * K) * 2u;
  const uint32_t lds_st = (uint32_t)(lr * LDT + kc * 8) * 2u;
  const int nk = K >> 6;
  uint4 xa0, xa1, xa2, xa3, xb0, xb1, xb2, xb3;
#define G_LOAD(KT)                                                         \
  {                                                                        \
    const int k0_ = (KT) << 6;                                             \
    const int ka_ = amap ? ((k0_ >> 7) * 192 + (k0_ & 127)) : k0_;         \
    xa0 = *(const uint4*)(abase + (size_t)ka_ * 2 + voa);                  \
    xa1 = *(const uint4*)(abase + (size_t)ka_ * 2 + astep + voa);          \
    xa2 = *(const uint4*)(abase + (size_t)ka_ * 2 + 2 * astep + voa);      \
    xa3 = *(const uint4*)(abase + (size_t)ka_ * 2 + 3 * astep + voa);      \
    xb0 = *(const uint4*)(bbase + (size_t)k0_ * 2 + vob0);                 \
    xb1 = *(const uint4*)(bbase + (size_t)k0_ * 2 + bstep + vob0);         \
    xb2 = *(const uint4*)(bbase + (size_t)k0_ * 2 + 2 * bstep + vob0);     \
    xb3 = *(const uint4*)(bbase + (size_t)k0_ * 2 + 3 * bstep + vob0);     \
  }
#define G_STORE(SN)                                                  \
  *(uint4*)((SN) + lds_st) = xa0;                                    \
  *(uint4*)((SN) + 1 * (64 * LDT * 2) + lds_st) = xa1;               \
  *(uint4*)((SN) + 2 * (64 * LDT * 2) + lds_st) = xa2;               \
  *(uint4*)((SN) + 3 * (64 * LDT * 2) + lds_st) = xa3;               \
  *(uint4*)((SN) + GA_BYTES + lds_st) = xb0;                         \
  *(uint4*)((SN) + GA_BYTES + 1 * (64 * LDT * 2) + lds_st) = xb1;    \
  *(uint4*)((SN) + GA_BYTES + 2 * (64 * LDT * 2) + lds_st) = xb2;    \
  *(uint4*)((SN) + GA_BYTES + 3 * (64 * LDT * 2) + lds_st) = xb3;
  const uint32_t fa = (uint32_t)((wm * 128 + (lane & 31)) * LDT + (lane >> 5) * 8) * 2u;
  const uint32_t fb = (uint32_t)GA_BYTES + (uint32_t)((wn * 64 + (lane & 31)) * LDT + (lane >> 5) * 8) * 2u;
  const int nkm = nk - 1;
  if (ROWNORM) {
    __syncthreads();
#pragma unroll 1
    for (int i = 0; i < 4; i++) {
      float ss = 0.f;
      for (int kk = 0; kk < nk; kk++) ss += sumsq8(*(const uint4*)(abase + (size_t)kk * 128 + i * astep + voa));
      ss += __shfl_xor(ss, 1); ss += __shfl_xor(ss, 2); ss += __shfl_xor(ss, 4);
      if (kc == 0) srinv[lr + 64 * i] = rsqrtf(ss / (float)K + 1e-6f);
    }
  }
  G_LOAD(0)
  __syncthreads();
  G_STORE(smem)
  G_LOAD((1 < nkm ? 1 : nkm))
  __syncthreads();
#define G_FRAG(P, ST, KS)                                                            \
  P##a0 = *(const bf16x8*)((ST) + fa + 0 * (32 * LDT * 2) + (KS) * 32);                \
  P##a1 = *(const bf16x8*)((ST) + fa + 1 * (32 * LDT * 2) + (KS) * 32);                \
  P##a2 = *(const bf16x8*)((ST) + fa + 2 * (32 * LDT * 2) + (KS) * 32);                \
  P##a3 = *(const bf16x8*)((ST) + fa + 3 * (32 * LDT * 2) + (KS) * 32);                \
  P##b0 = *(const bf16x8*)((ST) + fb + 0 * (32 * LDT * 2) + (KS) * 32);                \
  P##b1 = *(const bf16x8*)((ST) + fb + 1 * (32 * LDT * 2) + (KS) * 32);
#define G_MMA(P)                                                                              \
  acc[0][0] = __builtin_amdgcn_mfma_f32_32x32x16_bf16(P##b0, P##a0, acc[0][0], 0, 0, 0);      \
  acc[0][1] = __builtin_amdgcn_mfma_f32_32x32x16_bf16(P##b1, P##a0, acc[0][1], 0, 0, 0);      \
  acc[1][0] = __builtin_amdgcn_mfma_f32_32x32x16_bf16(P##b0, P##a1, acc[1][0], 0, 0, 0);      \
  acc[1][1] = __builtin_amdgcn_mfma_f32_32x32x16_bf16(P##b1, P##a1, acc[1][1], 0, 0, 0);      \
  acc[2][0] = __builtin_amdgcn_mfma_f32_32x32x16_bf16(P##b0, P##a2, acc[2][0], 0, 0, 0);      \
  acc[2][1] = __builtin_amdgcn_mfma_f32_32x32x16_bf16(P##b1, P##a2, acc[2][1], 0, 0, 0);      \
  acc[3][0] = __builtin_amdgcn_mfma_f32_32x32x16_bf16(P##b0, P##a3, acc[3][0], 0, 0, 0);      \
  acc[3][1] = __builtin_amdgcn_mfma_f32_32x32x16_bf16(P##b1, P##a3, acc[3][1], 0, 0, 0);
  bf16x8 pa0, pa1, pa2, pa3, pb0, pb1, qa0, qa1, qa2, qa3, qb0, qb1;
#pragma unroll 1
  for (int kt = 0; kt < nk; kt++) {
    const char* st = smem + (kt & 1) * GSTAGE;
    char* sn = smem + ((kt + 1) & 1) * GSTAGE;
    if (!ROWNORM) {
      G_FRAG(p, st, 0)
      G_FRAG(q, st, 1)
      __builtin_amdgcn_sched_barrier(0);
      G_MMA(p)
      __builtin_amdgcn_sched_barrier(0);
      G_FRAG(p, st, 2)
      __builtin_amdgcn_sched_barrier(0);
      G_MMA(q)
      __builtin_amdgcn_sched_barrier(0);
      G_FRAG(q, st, 3)
      if (kt + 1 < nk) { G_STORE(sn) }
      G_LOAD((kt + 2 < nkm ? kt + 2 : nkm))
      __builtin_amdgcn_sched_barrier(0);
      G_MMA(p)
      __builtin_amdgcn_sched_barrier(0);
      G_MMA(q)
    } else {
      G_FRAG(p, st, 0)
      __builtin_amdgcn_sched_barrier(0);
      G_MMA(p)
      __builtin_amdgcn_sched_barrier(0);
      G_FRAG(p, st, 1)
      __builtin_amdgcn_sched_barrier(0);
      G_MMA(p)
      __builtin_amdgcn_sched_barrier(0);
      G_FRAG(p, st, 2)
      if (kt + 1 < nk) { G_STORE(sn) }
      G_LOAD((kt + 2 < nkm ? kt + 2 : nkm))
      __builtin_amdgcn_sched_barrier(0);
      G_MMA(p)
      __builtin_amdgcn_sched_barrier(0);
      G_FRAG(p, st, 3)
      __builtin_amdgcn_sched_barrier(0);
      G_MMA(p)
    }
    __syncthreads();
  }
#undef G_FRAG
#undef G_MMA
#undef G_LOAD
#undef G_STORE
}

DEV void zero_acc(f32x16 (&acc)[4][2]) {
#pragma unroll
  for (int i = 0; i < 4; i++)
#pragma unroll
    for (int j = 0; j < 2; j++)
#pragma unroll
      for (int e = 0; e < 16; e++) acc[i][j][e] = 0.f;
}

template <class F>
DEV void epi_loop(int tidv, int bidv, f32x16 (&acc)[4][2], int m0, int n0, int N, F f) {
  const int lane = tidv & 63, wave = tidv >> 6;
  const int wm = wave >> 2, wn = wave & 3;
#pragma unroll
  for (int i = 0; i < 4; i++) {
    const int lrow = wm * 128 + i * 32 + (lane & 31);
#pragma unroll
    for (int j = 0; j < 2; j++) {
#pragma unroll
      for (int g = 0; g < 4; g++) {
        int col = n0 + wn * 64 + j * 32 + 8 * g + 4 * (lane >> 5);
        f32x4 v = {acc[i][j][4 * g], acc[i][j][4 * g + 1], acc[i][j][4 * g + 2], acc[i][j][4 * g + 3]};
        if (col < N) f(m0 + lrow, lrow, col, v);
      }
    }
    __builtin_amdgcn_sched_barrier(0);
  }
}

DEV uint2 pack4(f32x4 v) {
  uint2 o;
  o.x = pack2(v[0], v[1]);
  o.y = pack2(v[2], v[3]);
  return o;
}
DEV f32x4 unpack4(uint2 u) {
  f32x4 v;
  v[0] = bf2f((bf16)(u.x & 0xffff)); v[1] = bf2f((bf16)(u.x >> 16));
  v[2] = bf2f((bf16)(u.y & 0xffff)); v[3] = bf2f((bf16)(u.y >> 16));
  return v;
}

enum { G_IN = 0, G_UQ, G_UKV, G_W2, G_A2, G_G2, G_GLU, G_OUT, G_M1, G_M2, G_MG0, G_MG1, G_MG2 };

template <int MODE>
DEV void run_gemm(int tidv, int bidv, const Params& p, int l, char* smem, const bf16* A, int lda, const bf16* Bt, int K, int N, int M, int aux,
                  const float* xin_lat, const float* xin_ctx, float* xout_lat, float* xout_ctx, int rot = 0) {
  const int nt = (N + 255) >> 8, mt = M >> 8;
  char* ws = p.ws;
  bf16* Z = (bf16*)(ws + B_ZB);
  const float* srinv = (const float*)(smem + SM_RINV);
  const float* mod = (const float*)(ws + B_MOD) + (size_t)l * 5 * 12288;
  for (int tile = (bidv + rot) % (int)gridDim.x; tile < nt * mt; tile += gridDim.x) {
    int m0 = (tile / nt) << 8, n0 = (tile % nt) << 8;
    f32x16 acc[4][2];
    zero_acc(acc);
    gemm_mainloop<(MODE == G_UQ || MODE == G_UKV)>(tidv, bidv, A, lda, MODE == G_MG0, Bt, K, N, m0, n0, smem, acc);
    if constexpr (MODE != G_OUT && MODE != G_M2)
    epi_loop(tidv, bidv, acc, m0, n0, N, [&](int row, int lrow, int col, f32x4 v) {
      if constexpr (MODE == G_IN) {
        f32x4 o = v;
        if (col >= C_GATE || (col >= C_GD && col < C_U)) {
#pragma unroll
          for (int r = 0; r < 4; r++) o[r] = sigmoidf_(v[r]);
        } else if (col >= C_WD && col < C_AD) {
#pragma unroll
          for (int r = 0; r < 4; r++) o[r] = tanhf(v[r]);
        }
        *(uint2*)(smem + ((size_t)lrow * 264 + (col - n0)) * 2) = pack4(o);
      } else if constexpr (MODE == G_UQ) {
        float ri = srinv[lrow];
        *(uint2*)((bf16*)(ws + B_QB) + (size_t)row * 1536 + col) = pack4(v * ri);
      } else if constexpr (MODE == G_UKV) {
        float ri = srinv[lrow];
        f32x4 o = v * ri;
        int h = col >> 8, c = col & 255;
        if (c < 128) {
          *(uint2*)((bf16*)(ws + B_KN) + (size_t)row * 1024 + h * 128 + c) = pack4(o);
        } else {
          int b, kp;
          if (row < ML) { b = row >> 12; kp = row & 4095; } else { int r2 = row - ML; b = r2 >> 8; kp = 4096 + (r2 & 255); }
          bf16* vt = (bf16*)(ws + B_VT) + ((size_t)((b * 8 + h) * 128 + (c - 128))) * NKEY + kp;
#pragma unroll
          for (int r = 0; r < 4; r++) vt[(size_t)r * NKEY] = f2bf(o[r]);
        }
      } else if constexpr (MODE == G_W2) {
        float4 w0 = *(const float4*)(p.in[18] + (l * 2 + aux) * 1024 + col);
        f32x4 o;
        o[0] = 0.60653066f * sigmoidf_(w0.x + v[0]);
        o[1] = 0.60653066f * sigmoidf_(w0.y + v[1]);
        o[2] = 0.60653066f * sigmoidf_(w0.z + v[2]);
        o[3] = 0.60653066f * sigmoidf_(w0.w + v[3]);
        *(uint2*)((bf16*)(ws + B_HB + (size_t)aux * SZ1K) + (size_t)row * 1024 + col) = pack4(o);
      } else if constexpr (MODE == G_A2) {
        float4 a0 = *(const float4*)(p.in[20] + (l * 2 + aux) * 1024 + col);
        f32x4 o;
        o[0] = sigmoidf_(a0.x + v[0]);
        o[1] = sigmoidf_(a0.y + v[1]);
        o[2] = sigmoidf_(a0.z + v[2]);
        o[3] = sigmoidf_(a0.w + v[3]);
        *(uint2*)((bf16*)(ws + (aux ? B_AB : B_AF)) + (size_t)row * 1024 + col) = pack4(o);
      } else if constexpr (MODE == G_G2) {
        *(uint2*)((bf16*)(ws + B_GB) + (size_t)row * 1024 + col) = pack4(v);
      } else if constexpr (MODE == G_GLU) {
        f32x4 zz = unpack4(*(const uint2*)((const bf16*)(ws + B_SY) + (size_t)row * 1024 + col));
        float4 gb = *(const float4*)(p.in[37] + l * 1024 + col);
        f32x4 o;
        o[0] = zz[0] * sigmoidf_(v[0] + gb.x);
        o[1] = zz[1] * sigmoidf_(v[1] + gb.y);
        o[2] = zz[2] * sigmoidf_(v[2] + gb.z);
        o[3] = zz[3] * sigmoidf_(v[3] + gb.w);
        *(uint2*)(smem + ((size_t)lrow * 264 + (col - n0)) * 2) = pack4(o);
      } else if constexpr (MODE == G_OUT || MODE == G_M2) {
      } else if constexpr (MODE == G_M1) {
        f32x4 o;
#pragma unroll
        for (int r = 0; r < 4; r++) { float t = fmaxf(v[r], 0.f); o[r] = t * t; }
        *(uint2*)(smem + ((size_t)lrow * 264 + (col - n0)) * 2) = pack4(o);
      } else if constexpr (MODE == G_MG0 || MODE == G_MG1 || MODE == G_MG2) {
        *(uint2*)(smem + ((size_t)lrow * 264 + (col - n0)) * 2) = pack4(v);
      }
    });
    if constexpr (MODE == G_OUT || MODE == G_M2) {
      float* tilef = (float*)smem;
      constexpr int GOFF = (MODE == G_OUT) ? 4096 : 10240;
      const int wn_ = (tidv >> 6) & 3;
#pragma unroll 1
      for (int half = 0; half < 2; half++) {
        if ((wn_ >> 1) == half) {
          epi_loop(tidv, bidv, acc, m0, n0, N, [&](int row, int lrow, int col, f32x4 v) {
            *(f32x4*)(tilef + (size_t)lrow * 132 + (col - n0 - half * 128)) = v;
          });
        }
        __syncthreads();
#pragma unroll 2
        for (int it = 0; it < 16; it++) {
          int c = it * NT + tidv;
          int r = c >> 5, ch = c & 31;
          int row = m0 + r, col = n0 + half * 128 + ch * 4;
          int b = row < ML ? (row >> 12) : 4;
          float4 g = *(const float4*)(mod + b * 12288 + GOFF + col);
          const float* xi;
          if constexpr (MODE == G_OUT) xi = row < ML ? xin_lat + (size_t)row * 2048 : xin_ctx + (size_t)(row - ML) * 2048;
          else xi = row < ML ? xout_lat + (size_t)row * 2048 : xout_ctx + (size_t)(row - ML) * 2048;
          float* xo = row < ML ? xout_lat + (size_t)row * 2048 : xout_ctx + (size_t)(row - ML) * 2048;
          float4 x = *(const float4*)(xi + col);
          f32x4 v = *(const f32x4*)(tilef + (size_t)r * 132 + ch * 4);
          x.x += g.x * v[0]; x.y += g.y * v[1]; x.z += g.z * v[2]; x.w += g.w * v[3];
          *(float4*)(xo + col) = x;
        }
        __syncthreads();
      }
    }
    if constexpr (MODE == G_MG0 || MODE == G_MG1 || MODE == G_MG2) {
      constexpr int nb = MODE - G_MG0;
      bf16* MG = (bf16*)(ws + B_HB);
      __syncthreads();
#pragma unroll 2
      for (int it = 0; it < 16; it++) {
        int c = it * NT + tidv;
        int r = c >> 5, ch = c & 31;
        int col = n0 + ch * 8;
        uint4 pv = *(const uint4*)(smem + ((size_t)r * 264 + ch * 8) * 2);
        uint4 gv = *(const uint4*)(Z + (size_t)(m0 + r) * NIN + C_GATE + nb * 2048 + col);
        f32x4 p0 = unpack4(uint2{pv.x, pv.y}), p1 = unpack4(uint2{pv.z, pv.w});
        f32x4 g0 = unpack4(uint2{gv.x, gv.y}), g1 = unpack4(uint2{gv.z, gv.w});
        f32x4 o0 = g0 * p0, o1 = g1 * p1;
        if constexpr (nb > 0) {
          uint4 qv = *(const uint4*)(MG + (size_t)(m0 + r) * 2048 + col);
          o0 += unpack4(uint2{qv.x, qv.y});
          o1 += unpack4(uint2{qv.z, qv.w});
        }
        uint2 a = pack4(o0), b = pack4(o1);
        *(uint4*)(MG + (size_t)(m0 + r) * 2048 + col) = uint4{a.x, a.y, b.x, b.y};
      }
    }
    if constexpr (MODE == G_IN || MODE == G_GLU || MODE == G_M1) {
      bf16* dst;
      int ld;
      if constexpr (MODE == G_IN || MODE == G_GLU) { dst = Z; ld = NIN; }
      else { dst = Z; ld = DFF; }
      __syncthreads();
#pragma unroll 4
      for (int it = 0; it < 16; it++) {
        int c = it * NT + tidv;
        int r = c >> 5, ch = c & 31;
        int col = n0 + ch * 8;
        if (col < N) *(uint4*)(dst + (size_t)(m0 + r) * ld + col) = *(const uint4*)(smem + ((size_t)r * 264 + ch * 8) * 2);
      }
    }
  }
}

DEV void phase_mla_post(int tidv, int bidv, const Params& p, int l) {
  char* ws = p.ws;
  const float* qng = p.in[13] + l * 128;
  const float* qrg = p.in[14] + l * 64;
  const float* kng = p.in[15] + l * 128;
  const float* krg = p.in[16] + l * 64;
  bf16* QB = (bf16*)(ws + B_QB);
  bf16* KN = (bf16*)(ws + B_KN);
  bf16* KR = (bf16*)(ws + B_KR);
  const bf16* Z = (const bf16*)(ws + B_ZB);
  const int wave = tidv >> 6, lane = tidv & 63;
  const float QS = 1.4426950408889634f * 0.07216878364870322f;
  const int idx = lane & 31;
  const float inv = powf(10000.f, -(float)(idx & 15) / 16.f);
  const float gq0 = qng[2 * lane], gq1 = qng[2 * lane + 1], gk0 = kng[2 * lane], gk1 = kng[2 * lane + 1];
  const float gqr = qrg[lane], gkr = krg[lane];
  for (int row = bidv * NW + wave; row < MT; row += gridDim.x * NW) {
    bool lat = row < ML;
    int t = row & 4095;
    float pos = (idx < 16) ? (float)(t >> 6) : (float)(t & 63);
    float ang = pos * inv;
    float cs = 1.f, sn = 0.f;
    if (lat) { cs = cosf(ang); sn = sinf(ang); }
#pragma unroll 1
    for (int h = 0; h < 8; h++) {
      bf16* q = QB + (size_t)row * 1536 + h * 192;
      uint32_t u = *(const uint32_t*)(q + 2 * lane);
      float x0 = bf2f((bf16)(u & 0xffff)), x1 = bf2f((bf16)(u >> 16));
      float ss = wsum_fast(x0 * x0 + x1 * x1);
      float rinv = rsqrtf(ss * (1.f / 128.f) + 1e-6f) * QS;
      *(uint32_t*)(q + 2 * lane) = pack2(x0 * rinv * gq0, x1 * rinv * gq1);
      float xr = bf2f(q[128 + lane]);
      float ss2 = wsum_fast(xr * xr);
      float y = xr * rsqrtf(ss2 * (1.f / 64.f) + 1e-6f) * gqr;
      float yp = __shfl_xor(y, 32);
      float o = lane < 32 ? (y * cs - yp * sn) : (yp * sn + y * cs);
      q[128 + lane] = f2bf(o * QS);
      bf16* k = KN + (size_t)row * 1024 + h * 128;
      uint32_t uk = *(const uint32_t*)(k + 2 * lane);
      float k0 = bf2f((bf16)(uk & 0xffff)), k1 = bf2f((bf16)(uk >> 16));
      float ssk = wsum_fast(k0 * k0 + k1 * k1);
      float rk = rsqrtf(ssk * (1.f / 128.f) + 1e-6f);
      *(uint32_t*)(k + 2 * lane) = pack2(k0 * rk * gk0, k1 * rk * gk1);
    }
    {
      float xr = bf2f(Z[(size_t)row * NIN + C_KR + lane]);
      float ss2 = wsum_fast(xr * xr);
      float y = xr * rsqrtf(ss2 * (1.f / 64.f) + 1e-6f) * gkr;
      float yp = __shfl_xor(y, 32);
      float o = lane < 32 ? (y * cs - yp * sn) : (yp * sn + y * cs);
      KR[(size_t)row * 64 + lane] = f2bf(o);
    }
  }
}

DEV void step_row(int s, int d, int b, int& row, int& tau, int& len) {
  if (s < 256) { tau = d ? 255 - s : s; len = 256; row = ML + b * 256 + tau; }
  else { int q = s - 256; tau = d ? 4095 - q : q; len = 4096; row = b * 4096 + tau; }
}

struct RwPre { bf16 r0, r1, r2, k0, k1, k2, v0, v1, v2, a, e; };

DEV void rwkv_fetch(RwPre& q, const bf16* Z, const bf16* AD, const bf16* ED, int s, int d, int b, int ch) {
  int row, tau, len;
  step_row(s, d, b, row, tau, len);
  const bf16* z = Z + (size_t)row * NIN + C_R + ch;
  q.r1 = z[0]; q.k1 = z[1024]; q.v1 = z[2048];
  q.r0 = 0; q.k0 = 0; q.v0 = 0; q.r2 = 0; q.k2 = 0; q.v2 = 0;
  if (tau > 0) { const bf16* zm = z - NIN; q.r0 = zm[0]; q.k0 = zm[1024]; q.v0 = zm[2048]; }
  if (tau < len - 1) { const bf16* zp = z + NIN; q.r2 = zp[0]; q.k2 = zp[1024]; q.v2 = zp[2048]; }
  q.a = AD[(size_t)row * 1024 + ch];
  q.e = ED[(size_t)row * 1024 + ch];
}

typedef float f2v __attribute__((ext_vector_type(2)));
DEV float dpp_hmirror(float v) {
  int i = __float_as_int(v);
  return __int_as_float(__builtin_amdgcn_update_dpp(0, i, 0x141, 0xF, 0xF, true));
}
DEV f2v lo2(float4 v) { return f2v{v.x, v.y}; }
DEV f2v hi2(float4 v) { return f2v{v.z, v.w}; }

DEV void rwkv_scan(int tidv, int bidv, const Params& p, int l, int chain, char* smem, int dry) {
  char* ws = p.ws;
  float* op = (float*)smem;
  float* vb = op + 16 * 320;
  float* yb = vb + 16 * 64;
  const int tid = tidv, wave = tid >> 6, lane = tid & 63;
  const int d = chain & 1, h = (chain >> 1) & 15, b = chain >> 5;
  const int ch = h * 64 + lane;
  const float* cw = p.in[17] + (size_t)l * 3 * 3072;
  const float cr0 = cw[ch], cr1 = cw[3072 + ch], cr2 = cw[6144 + ch];
  const float ck0 = cw[1024 + ch], ck1 = cw[3072 + 1024 + ch], ck2 = cw[6144 + 1024 + ch];
  const float cv0 = cw[2048 + ch], cv1 = cw[3072 + 2048 + ch], cv2 = cw[6144 + 2048 + ch];
  const float kkc = p.in[23][l * 1024 + ch], kac = p.in[24][l * 1024 + ch];
  const bf16* Z = (const bf16*)(ws + B_ZB);
  bf16* ED = (bf16*)(ws + B_HB + (size_t)d * SZ1K);
  const bf16* AD = (const bf16*)(ws + (d ? B_AB : B_AF));
  f2v A0 = {0.f, 0.f}, A1 = {0.f, 0.f}, B0 = {0.f, 0.f}, B1 = {0.f, 0.f};
  const int ri = lane >> 4, jo = lane & 15, rA = wave * 8 + ri, rB = rA + 4;
  RwPre pre[2];
#pragma unroll
  for (int si = 0; si < 2; si++) rwkv_fetch(pre[si], Z, AD, ED, wave * 2 + si, d, b, ch);
  for (int chunk = 0; chunk < 272; chunk++) {
#pragma unroll
    for (int si = 0; si < 2; si++) {
      int t = wave * 2 + si;
      const RwPre& q = pre[si];
      float rr = cr0 * bf2f(q.r0) + cr1 * bf2f(q.r1) + cr2 * bf2f(q.r2);
      float kk_ = ck0 * bf2f(q.k0) + ck1 * bf2f(q.k1) + ck2 * bf2f(q.k2);
      float vv = cv0 * bf2f(q.v0) + cv1 * bf2f(q.v1) + cv2 * bf2f(q.v2);
      float kkv = kk_ * kkc;
      float ssq = wsum_fast(kkv * kkv);
      float kn = kkv * rsqrtf(ssq + 1e-12f);
      float a = bf2f(q.a);
      float w = __expf(-bf2f(q.e));
      float krep = kk_ * (1.f + (a - 1.f) * kac);
      float* o = op + t * 320;
      o[lane] = w;
      o[64 + lane] = kn * a;
      o[128 + lane] = krep;
      o[192 + lane] = -kn;
      o[256 + lane] = rr;
      vb[t * 64 + lane] = vv;
    }
    __syncthreads();
    if (chunk + 1 < 272) {
#pragma unroll
      for (int si = 0; si < 2; si++) rwkv_fetch(pre[si], Z, AD, ED, (chunk + 1) * 16 + wave * 2 + si, d, b, ch);
    }
    {
      const float4* o4 = (const float4*)op + jo;
      float4 nn = o4[48];
#pragma unroll 4
      for (int t = 0; t < 16; t++) {
        const float4* ot = o4 + t * 80;
        const float4 w = ot[0], a = ot[16], k = ot[32], r = ot[64];
        const float viA = vb[t * 64 + rA], viB = vb[t * 64 + rB];
        const int tn = t < 15 ? t + 1 : 15;
        const float4 mm = o4[tn * 80 + 48];
        f2v svA = A0 * lo2(nn) + A1 * hi2(nn);
        f2v svB = B0 * lo2(nn) + B1 * hi2(nn);
        float saA = svA.x + svA.y, saB = svB.x + svB.y;
        saA += dpp_xor1(saA); saB += dpp_xor1(saB);
        saA += dpp_xor2(saA); saB += dpp_xor2(saB);
        saA += dpp_hmirror(saA); saB += dpp_hmirror(saB);
        saA += dpp_rmirror(saA); saB += dpp_rmirror(saB);
        const f2v sA2 = {saA, saA}, vA2 = {viA, viA}, sB2 = {saB, saB}, vB2 = {viB, viB};
        A0 = A0 * lo2(w) + sA2 * lo2(a) + vA2 * lo2(k);
        B0 = B0 * lo2(w) + sB2 * lo2(a) + vB2 * lo2(k);
        A1 = A1 * hi2(w) + sA2 * hi2(a) + vA2 * hi2(k);
        B1 = B1 * hi2(w) + sB2 * hi2(a) + vB2 * hi2(k);
        f2v yvA = A0 * lo2(r) + A1 * hi2(r);
        f2v yvB = B0 * lo2(r) + B1 * hi2(r);
        yb[(t * 64 + rA) * 16 + jo] = yvA.x + yvA.y;
        yb[(t * 64 + rB) * 16 + jo] = yvB.x + yvB.y;
        nn = mm;
      }
    }
    __syncthreads();
#pragma unroll
    for (int it = 0; it < 2; it++) {
      int idx = it * NT + tid;
      int t = idx >> 6, i = idx & 63;
      int row, tau, len;
      step_row(chunk * 16 + t, d, b, row, tau, len);
      size_t off = (size_t)row * 1024 + h * 64 + i;
      bf16* yd = dry ? (bf16*)(ws + B_END) + (off & 0x3fffff) : ED + off;
      const float4* yp = (const float4*)(yb + (t * 64 + i) * 16);
      const float4 ya = yp[0], yc = yp[1], ye = yp[2], yg = yp[3];
      *yd = f2bf((((ya.x + ya.y) + (ya.z + ya.w)) + ((yc.x + yc.y) + (yc.z + yc.w))) + (((ye.x + ye.y) + (ye.z + ye.w)) + ((yg.x + yg.y) + (yg.z + yg.w))));
    }
  }
}

DEV void s5_scan(int tidv, int bidv, const Params& p, int l, int chain, char* smemw, int dry) {
  char* ws = p.ws;
  const int lane = tidv & 63;
  const int d = chain & 1, g = (chain >> 1) & 63, b = chain >> 7;
  float* ub = (float*)smemw;
  float* hb = ub + 256;
  const size_t pg = (size_t)(l * 2 + d) * 64 + g;
  const float lre = p.in[28][pg * 64 + lane], lim = p.in[29][pg * 64 + lane];
  const float dt = expf(p.in[30][pg]);
  const float mag = expf(lre * dt);
  const float are = mag * cosf(lim * dt), aim = mag * sinf(lim * dt);
  const float den = lre * lre + lim * lim;
  const float qre = ((are - 1.f) * lre + aim * lim) / den;
  const float qim = (aim * lre - (are - 1.f) * lim) / den;
  f2v bb[16];
  {
    const float* br = p.in[31] + (pg * 64 + lane) * 16;
    const float* bi = p.in[32] + (pg * 64 + lane) * 16;
#pragma unroll
    for (int i = 0; i < 16; i++) {
      float x = br[i], y = bi[i];
      bb[i] = f2v{qre * x - qim * y, qre * y + qim * x};
    }
  }
  bf16x8 cfr[4];
  {
    const int i = lane & 15, quad = lane >> 4;
    const float* cre = p.in[33] + (pg * 16 + i) * 64;
    const float* cim = p.in[34] + (pg * 16 + i) * 64;
#pragma unroll
    for (int ks = 0; ks < 4; ks++)
#pragma unroll
      for (int j = 0; j < 8; j++) {
        int k = ks * 32 + quad * 8 + j;
        float c = ks < 2 ? cre[k] : -cim[k - 64];
        cfr[ks][j] = (short)f2bf(c);
      }
  }
  float hre = 0.f, him = 0.f;
  const bf16* Z = (const bf16*)(ws + B_ZB);
  const int tt = lane >> 2, i0 = (lane & 3) * 4;
  uint2 unext;
  {
    int row, tau, len;
    step_row(tt, d, b, row, tau, len);
    unext = *(const uint2*)(Z + (size_t)row * NIN + C_U + g * 16 + i0);
  }
  for (int chunk = 0; chunk < 272; chunk++) {
    {
      uint2 u = unext;
      float4 f;
      f.x = bf2f((bf16)(u.x & 0xffff)); f.y = bf2f((bf16)(u.x >> 16));
      f.z = bf2f((bf16)(u.y & 0xffff)); f.w = bf2f((bf16)(u.y >> 16));
      *(float4*)(ub + tt * 16 + i0) = f;
    }
    __syncthreads();
    if (chunk + 1 < 272) {
      int row, tau, len;
      step_row((chunk + 1) * 16 + tt, d, b, row, tau, len);
      unext = *(const uint2*)(Z + (size_t)row * NIN + C_U + g * 16 + i0);
    }
#pragma unroll 2
    for (int t = 0; t < 16; t++) {
      const float* u = ub + t * 16;
      f2v bu0 = {0.f, 0.f}, bu1 = {0.f, 0.f};
#pragma unroll
      for (int i = 0; i < 16; i += 2) {
        const float ua = u[i], uc = u[i + 1];
        bu0 += bb[i] * f2v{ua, ua};
        bu1 += bb[i + 1] * f2v{uc, uc};
      }
      const f2v bu = bu0 + bu1;
      float nr = are * hre - aim * him + bu.x;
      float ni = are * him + aim * hre + bu.y;
      hre = nr; him = ni;
      hb[t * 132 + lane] = hre;
      hb[t * 132 + 64 + lane] = him;
    }
    __syncthreads();
    {
      f32x4 yacc = {0.f, 0.f, 0.f, 0.f};
      const float* hr = hb + (lane & 15) * 132 + (lane >> 4) * 8;
#pragma unroll
      for (int ks = 0; ks < 4; ks++) {
        float4 x0 = *(const float4*)(hr + ks * 32), x1 = *(const float4*)(hr + ks * 32 + 4);
        union { bf16x8 v; uint32_t u[4]; } af;
        af.u[0] = pack2(x0.x, x0.y); af.u[1] = pack2(x0.z, x0.w);
        af.u[2] = pack2(x1.x, x1.y); af.u[3] = pack2(x1.z, x1.w);
        yacc = __builtin_amdgcn_mfma_f32_16x16x32_bf16(af.v, cfr[ks], yacc, 0, 0, 0);
      }
      const int ii = lane & 15;
#pragma unroll
      for (int r = 0; r < 4; r++) {
        int row, tau, len;
        step_row(chunk * 16 + (lane >> 4) * 4 + r, d, b, row, tau, len);
        bf16* dst = d == 0 ? (bf16*)(ws + B_SY) + (size_t)row * 1024 + g * 16 + ii : (bf16*)(ws + B_ZB) + (size_t)row * NIN + g * 16 + ii;
        if (dry) dst = (bf16*)(ws + B_END) + ((((size_t)row * 1024 + g * 16 + ii)) & 0x3fffff);
        *dst = f2bf(yacc[r]);
      }
    }
    __syncthreads();
  }
}

DEV int perm23(int r) { return (r & 0x13) | ((r & 4) << 1) | ((r & 8) >> 1); }

DEV void attn_item(int tidv, int bidv, const Params& p, int item, bool ctxq, char* smem, int dry) {
  char* ws = p.ws;
  bf16* sK = (bf16*)smem;
  bf16* sV = sK + 64 * 200;
  const int tid = tidv, wave = tid >> 6, lane = tid & 63;
  const int r = lane & 31, hf = lane >> 5;
  int b, hd, qt;
  if (!ctxq) { b = item >> 7; hd = (item >> 4) & 7; qt = item & 15; }
  else { b = item >> 3; hd = item & 7; qt = 0; }
  const int qrow0 = ctxq ? ML + b * 256 : b * 4096 + qt * 256;
  const int kt0 = ctxq ? 64 : 0, kt1 = 68;
  bf16* QB = (bf16*)(ws + B_QB);
  const bf16* KN = (const bf16*)(ws + B_KN);
  const bf16* KR = (const bf16*)(ws + B_KR);
  const bf16* VT = (const bf16*)(ws + B_VT);
  bf16x8 qf[12];
  {
    const bf16* qp = QB + (size_t)(qrow0 + wave * 32 + r) * 1536 + hd * 192 + hf * 8;
#pragma unroll
    for (int kk = 0; kk < 12; kk++) qf[kk] = *(const bf16x8*)(qp + kk * 16);
  }
  f32x16 oacc[4];
#pragma unroll
  for (int i = 0; i < 4; i++)
#pragma unroll
    for (int e = 0; e < 16; e++) oacc[i][e] = 0.f;
  float mrun = -1e30f, lrun = 0.f;
  const int pr = perm23(r);
  const uint32_t vo_n = (uint32_t)((tid >> 4) * 2048 + (tid & 15) * 16);
  const uint32_t lo_n = (uint32_t)((tid >> 4) * 400 + (tid & 15) * 16);
  const uint32_t vo_r = (uint32_t)((tid >> 3) * 128 + (tid & 7) * 16);
  const uint32_t lo_r = (uint32_t)((tid >> 3) * 400 + 256 + (tid & 7) * 16);
  const uint32_t vo_v = (uint32_t)((tid >> 3) * (NKEY * 2) + (tid & 7) * 16);
  const uint32_t lo_v = (uint32_t)((tid >> 3) * 144 + (tid & 7) * 16);
  uint4 t0, t1, t4, u0, u1;
#define ATT_LOAD(KT)                                                                                   \
  {                                                                                                    \
    const int key0_ = (KT) * 64;                                                                       \
    const int rowbase_ = key0_ < 4096 ? b * 4096 + key0_ : ML + b * 256 + (key0_ - 4096);               \
    const char* bk = (const char*)(KN + (size_t)rowbase_ * 1024 + hd * 128);                           \
    const char* br = (const char*)(KR + (size_t)rowbase_ * 64);                                        \
    const char* bv = (const char*)(VT + ((size_t)((b * 8 + hd) * 128)) * NKEY + key0_);                \
    t0 = *(const uint4*)(bk + vo_n);                                                                   \
    t1 = *(const uint4*)(bk + 32 * 2048 + vo_n);                                                       \
    t4 = *(const uint4*)(br + vo_r);                                                                   \
    u0 = *(const uint4*)(bv + vo_v);                                                                   \
    u1 = *(const uint4*)(bv + (size_t)64 * NKEY * 2 + vo_v);                                           \
  }
  ATT_LOAD(kt0)
  for (int kt = kt0; kt < kt1; kt++) {
    __syncthreads();
    *(uint4*)((char*)sK + lo_n) = t0;
    *(uint4*)((char*)sK + 32 * 400 + lo_n) = t1;
    *(uint4*)((char*)sK + lo_r) = t4;
    *(uint4*)((char*)sV + lo_v) = u0;
    *(uint4*)((char*)sV + 64 * 144 + lo_v) = u1;
    __syncthreads();
    ATT_LOAD((kt + 1 < kt1 ? kt + 1 : kt1 - 1))
    f32x16 sacc[2];
#pragma unroll
    for (int m = 0; m < 2; m++) {
#pragma unroll
      for (int e = 0; e < 16; e++) sacc[m][e] = 0.f;
      const bf16* kp = sK + (m * 32 + pr) * 200 + hf * 8;
#pragma unroll
      for (int kk = 0; kk < 12; kk++) {
        bf16x8 kf = *(const bf16x8*)(kp + kk * 16);
        sacc[m] = __builtin_amdgcn_mfma_f32_32x32x16_bf16(kf, qf[kk], sacc[m], 0, 0, 0);
        if ((kk & 3) == 3) __builtin_amdgcn_sched_barrier(0);
      }
      __builtin_amdgcn_sched_barrier(0);
    }
    float tmax = sacc[0][0];
#pragma unroll
    for (int e = 1; e < 16; e++) tmax = fmaxf(tmax, sacc[0][e]);
#pragma unroll
    for (int e = 0; e < 16; e++) tmax = fmaxf(tmax, sacc[1][e]);
    tmax = fmaxf(tmax, __shfl_xor(tmax, 32));
    float mnew = fmaxf(mrun, tmax);
    float alpha = __builtin_amdgcn_exp2f(mrun - mnew);
    mrun = mnew;
    float psum = 0.f;
#pragma unroll
    for (int m = 0; m < 2; m++)
#pragma unroll
      for (int e = 0; e < 16; e++) { float pv = __builtin_amdgcn_exp2f(sacc[m][e] - mnew); sacc[m][e] = pv; psum += pv; }
    lrun = lrun * alpha + psum;
    if (__any(alpha != 1.f)) {
#pragma unroll
      for (int i = 0; i < 4; i++)
#pragma unroll
        for (int e = 0; e < 16; e++) oacc[i][e] *= alpha;
    }
#pragma unroll
    for (int s = 0; s < 4; s++) {
      const int m = s >> 1, s2 = s & 1;
      bf16x8 pf;
#pragma unroll
      for (int j = 0; j < 8; j++) pf[j] = (short)f2bf(sacc[m][8 * s2 + j]);
#pragma unroll
      for (int i = 0; i < 4; i++) {
        bf16x8 vf = *(const bf16x8*)(sV + (i * 32 + r) * 72 + m * 32 + s2 * 16 + hf * 8);
        oacc[i] = __builtin_amdgcn_mfma_f32_32x32x16_bf16(vf, pf, oacc[i], 0, 0, 0);
      }
      __builtin_amdgcn_sched_barrier(0);
    }
  }
#undef ATT_LOAD
  lrun += __shfl_xor(lrun, 32);
  const float inv = 1.f / lrun;
  bf16* op = QB + (size_t)(qrow0 + wave * 32 + r) * 1536 + hd * 192;
  if (dry) op = (bf16*)(ws + B_END) + ((((size_t)(qrow0 + wave * 32 + r) * 1536 + hd * 192)) & 0x3ffff8);
#pragma unroll
  for (int i = 0; i < 4; i++)
#pragma unroll
    for (int g = 0; g < 4; g++) {
      uint2 o;
      o.x = pack2(oacc[i][4 * g] * inv, oacc[i][4 * g + 1] * inv);
      o.y = pack2(oacc[i][4 * g + 2] * inv, oacc[i][4 * g + 3] * inv);
      *(uint2*)(op + 32 * i + 8 * g + 4 * hf) = o;
    }
}

DEV void phase_mixers(int tidv, int bidv, const Params& p, int l, char* smem, int dry) {
  int* s_item = (int*)(smem + SM_ITEM);
#ifdef PROBE_PARTS
  const int parts = dry ? PROBE_PARTS : 7;
#else
  const int parts = 7;
#endif
  for (int task = bidv; task < 192; task += gridDim.x) {
    if (task < 128 && !(parts & 1)) continue;
    if (task >= 128 && !(parts & 2)) continue;
    if (task < 128) rwkv_scan(tidv, bidv, p, l, task, smem, dry);
    else s5_scan(tidv, bidv, p, l, (task - 128) * 8 + (tidv >> 6), smem + (tidv >> 6) * 9472, dry);
  }
  const int nlat = 512, ntot = (parts & 4) ? ((l == 0) ? 544 : 512) : 0;
  int* cnt = (int*)(p.ws + B_CNT) + l + 2 * dry;
#if !defined(MIX_ONLY) || MIX_ONLY == 2
  while (true) {
    __syncthreads();
    if (tidv == 0) *s_item = atomicAdd(cnt, 1);
    __syncthreads();
    int item = *s_item;
    if (item >= ntot) break;
    if (item < nlat) attn_item(tidv, bidv, p, item, false, smem, dry);
    else attn_item(tidv, bidv, p, item - nlat, true, smem, dry);
  }
#endif
}

DEV float gelu_tanh(float x) {
  float u = 0.7978845608028654f * (x + 0.044715f * x * x * x);
  return 0.5f * x * (1.f + tanhf(u));
}

DEV void phase_post(int tidv, int bidv, const Params& p, int l, int M) {
  char* ws = p.ws;
  const bf16* Z = (const bf16*)(ws + B_ZB);
  const int wave = tidv >> 6, lane = tidv & 63;
  const float* cw = p.in[17] + (size_t)l * 3 * 3072;
  const bf16* YF = (const bf16*)(ws + B_HB);
  const bf16* YB = (const bf16*)(ws + B_HB + SZ1K);
  const bf16* AF = (const bf16*)(ws + B_AF);
  const bf16* AB = (const bf16*)(ws + B_AB);
  bf16* GB = (bf16*)(ws + B_GB);
  {
    const int gw = bidv * NW + wave, nwv = gridDim.x * NW;
    const int h = gw & 15, ch = h * 64 + lane;
    const float c_r0 = cw[ch], c_r1 = cw[3072 + ch], c_r2 = cw[6144 + ch];
    const float c_k0 = cw[1024 + ch], c_k1 = cw[3072 + 1024 + ch], c_k2 = cw[6144 + 1024 + ch];
    const float c_v0 = cw[2048 + ch], c_v1 = cw[3072 + 2048 + ch], c_v2 = cw[6144 + 2048 + ch];
    const float lng = p.in[26][l * 1024 + ch], lnb = p.in[27][l * 1024 + ch];
    const float kac = p.in[24][l * 1024 + ch], rkc = p.in[25][l * 1024 + ch];
    for (int row = gw >> 4; row < M; row += (nwv >> 4)) {
      int tau, len;
      if (row < ML) { tau = row & 4095; len = 4096; } else { tau = (row - ML) & 255; len = 256; }
      size_t o = (size_t)row * 1024 + ch;
      float y = bf2f(YF[o]) + bf2f(YB[o]);
      const bf16* z = Z + (size_t)row * NIN + C_R + ch;
      float r1 = bf2f(z[0]), k1 = bf2f(z[1024]), v1 = bf2f(z[2048]);
      float r0 = 0.f, k0 = 0.f, v0 = 0.f, r2 = 0.f, k2 = 0.f, v2 = 0.f;
      if (tau > 0) { const bf16* zm = z - NIN; r0 = bf2f(zm[0]); k0 = bf2f(zm[1024]); v0 = bf2f(zm[2048]); }
      if (tau < len - 1) { const bf16* zp = z + NIN; r2 = bf2f(zp[0]); k2 = bf2f(zp[1024]); v2 = bf2f(zp[2048]); }
      float am = 0.5f * (bf2f(AF[o]) + bf2f(AB[o]));
      float gate = bf2f(GB[o]);
      float mu = wsum_fast(y) * (1.f / 64.f);
      float dv = y - mu;
      float var = wsum_fast(dv * dv) * (1.f / 64.f);
      float yn = dv * rsqrtf(var + 64e-5f) * lng + lnb;
      float rr = c_r0 * r0 + c_r1 * r1 + c_r2 * r2;
      float kk = c_k0 * k0 + c_k1 * k1 + c_k2 * k2;
      float vv = c_v0 * v0 + c_v1 * v1 + c_v2 * v2;
      float kbon = kk * (1.f + (am - 1.f) * kac);
      float s = wsum_fast(rr * kbon * rkc);
      GB[o] = f2bf((yn + s * vv) * gate);
    }
  }
  bf16* SY = (bf16*)(ws + B_SY);
  const float* dsk = p.in[35] + l * 1024;
  const int n4 = M * 256;
  for (int i = bidv * NT + tidv; i < n4; i += gridDim.x * NT) {
    int row = i >> 8, c = (i & 255) * 4;
    uint2 a = *(const uint2*)(SY + (size_t)row * 1024 + c);
    uint2 bq = *(const uint2*)(Z + (size_t)row * NIN + c);
    uint2 u = *(const uint2*)(Z + (size_t)row * NIN + C_U + c);
    float4 dd = *(const float4*)(dsk + c);
    float y0 = bf2f((bf16)(a.x & 0xffff)) + bf2f((bf16)(bq.x & 0xffff)) + dd.x * bf2f((bf16)(u.x & 0xffff));
    float y1 = bf2f((bf16)(a.x >> 16)) + bf2f((bf16)(bq.x >> 16)) + dd.y * bf2f((bf16)(u.x >> 16));
    float y2 = bf2f((bf16)(a.y & 0xffff)) + bf2f((bf16)(bq.y & 0xffff)) + dd.z * bf2f((bf16)(u.y & 0xffff));
    float y3 = bf2f((bf16)(a.y >> 16)) + bf2f((bf16)(bq.y >> 16)) + dd.w * bf2f((bf16)(u.y >> 16));
    uint2 o;
    o.x = pack2(gelu_tanh(y0), gelu_tanh(y1));
    o.y = pack2(gelu_tanh(y2), gelu_tanh(y3));
    *(uint2*)(SY + (size_t)row * 1024 + c) = o;
  }
}

constexpr int NPH = 25;

DEV void run_phase(int tidv, int bidv, const Params& p, int ph, char* smem, int dry) {
  char* ws = p.ws;
#ifndef ONLY_S
  if (ph == 0) {
    if (bidv == 0 && tidv < 4) ((int*)(ws + B_CNT))[tidv] = 0;
    phase_mod(tidv, bidv, p, smem);
    phase_convw(tidv, bidv, p, 0, smem, 3, bidv, (int)gridDim.x);
    return;
  }
#endif
  const int l = (ph - 1) / 12, s = (ph - 1) % 12;
#ifdef ONLY_S
  if (s != ONLY_S) return;
#endif
  const bf16* wb = (const bf16*)(ws + B_WB);
  const float* mod = (const float*)(ws + B_MOD) + (size_t)l * 5 * 12288;
  float* XC = (float*)(ws + B_XC);
  const float* xin_lat = l == 0 ? p.in[0] : p.out;
  const float* xin_ctx = l == 0 ? p.in[2] : XC;
  bf16* HB = (bf16*)(ws + B_HB);
  bf16* Z = (bf16*)(ws + B_ZB);
  bf16* H2 = (bf16*)(ws + B_KN);
  const int Mpost = l == 0 ? MT : ML;
  switch (s) {
    case 0:
      if (l == 1) phase_convw(tidv, bidv, p, 1, smem, 2, bidv, (int)gridDim.x);
      phase_norm(tidv, bidv, xin_lat, xin_ctx, p.in[6] + l * 2048, mod, 0, 2048, HB, MT);
      break;
    case 1:
      run_gemm<G_IN>(tidv, bidv, p, l, smem, HB, 2048, wb + OW_IN, 2048, NIN, MT, 0, nullptr, nullptr, nullptr, nullptr);
      break;
    case 2:
#if !defined(PH2_ONLY) || PH2_ONLY == 0
      run_gemm<G_UKV>(tidv, bidv, p, l, smem, Z + C_CKV, NIN, wb + OW_UKV, 512, 2048, MT, 0, nullptr, nullptr, nullptr, nullptr);
#endif
#if !defined(PH2_ONLY) || PH2_ONLY == 1
      run_gemm<G_UQ>(tidv, bidv, p, l, smem, Z + C_CQ, NIN, wb + OW_UQ, 512, 1536, MT, 0, nullptr, nullptr, nullptr, nullptr, 224);
#endif
#if !defined(PH2_ONLY) || PH2_ONLY == 2
      run_gemm<G_G2>(tidv, bidv, p, l, smem, Z + C_GD, NIN, wb + OW_G2, 192, 1024, MT, 0, nullptr, nullptr, nullptr, nullptr, 72);
#endif
#if !defined(PH2_ONLY) || PH2_ONLY == 3
      for (int d = 0; d < 2; d++) {
        run_gemm<G_W2>(tidv, bidv, p, l, smem, Z + C_WD + 64 * d, NIN, wb + OW_W2 + (size_t)d * 65536, 64, 1024, MT, d, nullptr, nullptr, nullptr, nullptr, 56 - 32 * d);
        run_gemm<G_A2>(tidv, bidv, p, l, smem, Z + C_AD + 64 * d, NIN, wb + OW_A2 + (size_t)d * 65536, 64, 1024, MT, d, nullptr, nullptr, nullptr, nullptr, 40 - 32 * d);
      }
#endif
      break;
    case 3: phase_mla_post(tidv, bidv, p, l); break;
    case 4: phase_mixers(tidv, bidv, p, l, smem, dry); break;
    case 5: phase_post(tidv, bidv, p, l, Mpost); break;
    case 6:
      run_gemm<G_GLU>(tidv, bidv, p, l, smem, (const bf16*)(ws + B_SY), 1024, wb + OW_GLU, 1024, 1024, Mpost, 0, nullptr, nullptr, nullptr, nullptr);
      break;
    case 7:
      run_gemm<G_MG0>(tidv, bidv, p, l, smem, (const bf16*)(ws + B_QB), 1536, wb + OW_BR, 1024, 2048, Mpost, 0, nullptr, nullptr, nullptr, nullptr);
      run_gemm<G_MG1>(tidv, bidv, p, l, smem, (const bf16*)(ws + B_GB), 1024, wb + OW_BR + (size_t)2048 * 1024, 1024, 2048, Mpost, 0, nullptr, nullptr, nullptr, nullptr);
      run_gemm<G_MG2>(tidv, bidv, p, l, smem, Z, NIN, wb + OW_BR + (size_t)2 * 2048 * 1024, 1024, 2048, Mpost, 0, nullptr, nullptr, nullptr, nullptr);
      break;
    case 8:
      run_gemm<G_OUT>(tidv, bidv, p, l, smem, HB, 2048, wb + OW_OUT, 2048, 2048, Mpost, 0, xin_lat, xin_ctx, p.out, XC);
      break;
    case 9:
      phase_norm(tidv, bidv, p.out, XC, p.in[7] + l * 2048, mod, 6144, 8192, H2, Mpost);
      break;
    case 10:
      run_gemm<G_M1>(tidv, bidv, p, l, smem, H2, 2048, wb + OW_M1, 2048, 8192, Mpost, 0, nullptr, nullptr, nullptr, nullptr);
      break;
    case 11:
      run_gemm<G_M2>(tidv, bidv, p, l, smem, Z, 8192, wb + OW_M2, 8192, 2048, Mpost, 0, nullptr, nullptr, p.out, XC);
      if (l == 0) {
        const int ex = ((Mpost >> 8) * 8) % (int)gridDim.x;
        if (bidv >= ex) phase_convw(tidv, bidv, p, 1, smem, 1, bidv - ex, (int)gridDim.x - ex);
      }
      break;
  }
}

DEV void grid_barrier(unsigned* cnt, unsigned target) {
  asm volatile("s_waitcnt vmcnt(0)" ::: "memory");
  __syncthreads();
  if (threadIdx.x == 0) {
    __builtin_amdgcn_fence(__ATOMIC_RELEASE, "agent");
    asm volatile("s_waitcnt vmcnt(0)" ::: "memory");
    __hip_atomic_fetch_add(cnt, 1u, __ATOMIC_RELAXED, __HIP_MEMORY_SCOPE_AGENT);
    unsigned spins = 0;
    while (__hip_atomic_load(cnt, __ATOMIC_RELAXED, __HIP_MEMORY_SCOPE_AGENT) < target) {
      __builtin_amdgcn_s_sleep(1);
      if (++spins > (1u << 21)) break;
    }
    __builtin_amdgcn_fence(__ATOMIC_ACQUIRE, "agent");
    asm volatile("s_waitcnt vmcnt(0)" ::: "memory");
  }
  __syncthreads();
}

__global__ void __launch_bounds__(NT) fwd_megakernel(Params p, int ph0, int ph1, int dryflag) {
  extern __shared__ __attribute__((aligned(16))) char smem[];
  for (int ph = ph0; ph < ph1; ph++) {
    int tidv = threadIdx.x, bidv = blockIdx.x;
    asm volatile("" : "+v"(tidv));
    asm volatile("" : "+s"(bidv));
#ifdef PROBE_MASK
    if (dryflag && ((ph == 0 && (PROBE_MASK & 0x1000)) || (ph > 0 && ((PROBE_MASK >> ((ph - 1) % 12)) & 1)))) {
      run_phase(tidv, bidv, p, ph, smem, dryflag);
      cg::this_grid().sync();
    }
#endif
    run_phase(tidv, bidv, p, ph, smem, 0);
    if (ph + 1 < ph1) {
      if (ph == ph0) cg::this_grid().sync();
      else grid_barrier((unsigned*)(p.ws + B_FLG), (unsigned)(ph - ph0) * gridDim.x);
    }
  }
}

extern "C" void kernel_launch(void* const* d_in, const int* in_sizes, int n_in, void* d_out, int out_size, void* d_ws, size_t ws_size,
                              hipStream_t stream) {
  static int grid_blocks = 0;
  if (!grid_blocks) {
    int dev = 0, cus = 0, per_cu = 0;
    (void)hipGetDevice(&dev);
    (void)hipDeviceGetAttribute(&cus, hipDeviceAttributeMultiprocessorCount, dev);
    if (hipFuncSetAttribute((const void*)fwd_megakernel, hipFuncAttributeMaxDynamicSharedMemorySize, LDS_BYTES) != hipSuccess) {
      fprintf(stderr, "hipFuncSetAttribute(%d B dynamic LDS) failed\n", LDS_BYTES);
      return;
    }
    if (hipOccupancyMaxActiveBlocksPerMultiprocessor(&per_cu, (const void*)fwd_megakernel, NT, LDS_BYTES) != hipSuccess || per_cu < 1) {
      fprintf(stderr, "occupancy query failed / kernel not resident\n");
      return;
    }
    grid_blocks = cus;
  }
  Params p{};
  for (int i = 0; i < 42; i++) p.in[i] = (const float*)d_in[i];
  p.out = (float*)d_out;
  p.ws = (char*)d_ws;
  if (ws_size < B_END + (8u << 20)) { fprintf(stderr, "workspace too small\n"); return; }
  int ph0 = 0, ph1 = NPH;
  int dryflag = 1;
  void* args[] = {&p, &ph0, &ph1, &dryflag};
  (void)hipMemsetAsync((char*)d_ws + B_FLG, 0, 4096, stream);
  hipError_t e = hipLaunchCooperativeKernel((void*)fwd_megakernel, dim3(grid_blocks), dim3(NT), args, LDS_BYTES, stream);
  if (e != hipSuccess) fprintf(stderr, "cooperative launch failed: %s (grid %d)\n", hipGetErrorString(e), grid_blocks);
}
```
